# Optimizing an MI355X kernel written in HIP

```python
import jax
import jax.numpy as jnp
from jax import lax
import numpy as np

D_MODEL = 1024
BATCH = 32
SEQ = 256
DEPTH = 2
DEC_BATCH = 2
DEC_SEQ = 2048
PAST_LEN = 512

GRID_W = 64
N_BRANCH = 4
BRANCH_W = 512
H_A = 8
N_A = 64
LORA_W = 64
LORA_A = 64
RWKV_GN_EPS = 64e-5
H_B = 8
NOPE = 64
ROPE = 32
VDIM = 64
Q_LORA = 256
KV_LORA = 128
ROPE_BASE = 10000.0
Q_BLOCK = 128
G_C = 4
CHUNK = 128
G_D = 4
NORM_EPS = 1e-6
IN_W = 5728
SHIFT_W = 1728
IN_SPLITS = (512, 1024, 1536, 1600, 1664, 1728, 2240, 2496, 2624, 2656, 3168, 3680, 4192, 4704, 5216)

kernel_name = 'hybrid_rwkv_mla_gmlp_fnet_diffusion_step'


def rms_norm(x, g):
    xf = x.astype(jnp.float32)
    y = xf * lax.rsqrt(jnp.mean(xf * xf, axis=-1, keepdims=True) + NORM_EPS)
    return (y * g.astype(jnp.float32)).astype(x.dtype)


def layer_norm(x, g, b):
    xf = x.astype(jnp.float32)
    mu = jnp.mean(xf, axis=-1, keepdims=True)
    var = jnp.mean(jnp.square(xf - mu), axis=-1, keepdims=True)
    y = (xf - mu) * lax.rsqrt(var + 1e-5) * g.astype(jnp.float32) + b.astype(jnp.float32)
    return y.astype(x.dtype)


def head_group_norm(o, g, b):
    B, T, H, N = o.shape
    mu = jnp.mean(o, axis=-1, keepdims=True)
    var = jnp.mean(jnp.square(o - mu), axis=-1, keepdims=True)
    y = ((o - mu) * lax.rsqrt(var + RWKV_GN_EPS)).reshape(B, T, H * N)
    return y * g.astype(jnp.float32) + b.astype(jnp.float32)


def centred_shift(z):
    prev = jnp.pad(z[:, :-1], ((0, 0), (1, 0), (0, 0)))
    nxt = jnp.pad(z[:, 1:], ((0, 0), (0, 1), (0, 0)))
    return 0.5 * (prev + nxt)


def axial_rope(n_tokens):
    rows = n_tokens // GRID_W
    row = jnp.repeat(jnp.arange(rows, dtype=jnp.float32), GRID_W)
    col = jnp.tile(jnp.arange(GRID_W, dtype=jnp.float32), rows)
    n_freq = ROPE // 4
    inv = ROPE_BASE ** (-jnp.arange(n_freq, dtype=jnp.float32) / n_freq)
    ang = jnp.concatenate([row[:, None] * inv, col[:, None] * inv], axis=-1)
    return jnp.cos(ang)[:, None, :], jnp.sin(ang)[:, None, :]


def apply_rope(x, cos, sin):
    xf = x.astype(jnp.float32).reshape(*x.shape[:-1], ROPE // 2, 2)
    x0, x1 = xf[..., 0], xf[..., 1]
    out = jnp.stack([x0 * cos - x1 * sin, x0 * sin + x1 * cos], axis=-1)
    return out.reshape(x.shape).astype(x.dtype)


def block_attention(q, k, v):
    B, S, H, Dq = q.shape
    scale = (NOPE + ROPE) ** -0.5
    qb = jnp.moveaxis(q.reshape(B, S // Q_BLOCK, Q_BLOCK, H, Dq), 1, 0)

    def one_block(qi):
        s = jnp.einsum('bqhd,bkhd->bhqk', qi, k).astype(jnp.float32) * scale
        pr = jax.nn.softmax(s, axis=-1).astype(v.dtype)
        return jnp.einsum('bhqk,bkhd->bqhd', pr, v)

    o = lax.map(one_block, qb)
    return jnp.moveaxis(o, 0, 1).reshape(B, S, H, v.shape[-1])


def wkv_scan(r, w, k, v, kk, a, s0, reverse):
    xs = tuple(jnp.moveaxis(t, 1, 0) for t in (r, w, k, v, kk, a))

    def step(S, inp):
        r_t, w_t, k_t, v_t, kk_t, a_t = inp
        sa = jnp.einsum('bhvk,bhk->bhv', S, -kk_t)
        S = (S * w_t[:, :, None, :] + sa[..., None] * (kk_t * a_t)[:, :, None, :]
             + v_t[..., None] * k_t[:, :, None, :])
        return S, jnp.einsum('bhvk,bhk->bhv', S, r_t)

    s_fin, ys = lax.scan(step, s0, xs, reverse=reverse)
    return jnp.moveaxis(ys, 0, 1), s_fin


def rwkv_branch(r, k, v, wdf, wdb, ad, g, p, s0_f, s0_b):
    B, T, _ = r.shape
    f32 = jnp.float32

    def heads(t):
        return t.astype(f32).reshape(B, T, H_A, N_A)

    rh, kh, vh = heads(r), heads(k), heads(v)
    kk = heads(k * p['rwkv_k_k'])
    kk = kk / jnp.maximum(jnp.linalg.norm(kk, axis=-1, keepdims=True), 1e-12)
    k_a = p['rwkv_k_a'].astype(f32).reshape(H_A, N_A)
    r_k = p['rwkv_r_k'].astype(f32)
    outs, bonuses, finals = [], [], []
    for d, (wd, s0) in enumerate(((wdf, s0_f), (wdb, s0_b))):
        pre = (p['rwkv_w0'][d] + jnp.tanh(wd) @ p['rwkv_w_up'][d]).astype(f32)
        decay = jnp.exp(-jnp.exp(-jax.nn.softplus(-pre) - 0.5))
        ah = heads(jax.nn.sigmoid(p['rwkv_a0'][d] + ad @ p['rwkv_a_up'][d]))
        kt = kh * (1.0 + (ah - 1.0) * k_a)
        od, sf = wkv_scan(rh, heads(decay), kt, vh, kk, ah, s0.astype(f32), reverse=(d == 1))
        outs.append(od)
        bonuses.append(jnp.sum(rh * kt * r_k, axis=-1, keepdims=True) * vh)
        finals.append(sf)
    y = head_group_norm(outs[0] + outs[1], p['rwkv_ln_g'], p['rwkv_ln_b'])
    y = y + (bonuses[0] + bonuses[1]).reshape(B, T, BRANCH_W)
    return y.astype(r.dtype) * jax.nn.silu(g), finals[0], finals[1]


def mla_queries(qd, kvd, kr, p, rope):
    B, T, _ = qd.shape
    q = (rms_norm(qd, p['mla_q_norm']) @ p['mla_w_q_up']).reshape(B, T, H_B, NOPE + ROPE)
    ckv = rms_norm(kvd, p['mla_kv_norm'])
    kr = kr.reshape(B, T, 1, ROPE)
    q_nope, q_rope = q[..., :NOPE], q[..., NOPE:]
    if rope is not None:
        q_rope = apply_rope(q_rope, rope[0], rope[1])
        kr = apply_rope(kr, rope[0], rope[1])
    return jnp.concatenate([q_nope, q_rope], axis=-1), ckv, kr.reshape(B, T, ROPE)


def mla_expand(ckv, kr, p):
    B, T, _ = ckv.shape
    kv = (ckv @ p['mla_w_kv_up']).reshape(B, T, H_B, NOPE + VDIM)
    k_rope = jnp.broadcast_to(kr.reshape(B, T, 1, ROPE), (B, T, H_B, ROPE)).astype(kv.dtype)
    return jnp.concatenate([kv[..., :NOPE], k_rope], axis=-1), kv[..., NOPE:]


def gmlp_branch(u, vc, g, p):
    B, T, _ = vc.shape
    u = jax.nn.gelu(u)
    vc = layer_norm(jax.nn.gelu(vc), p['gmlp_ln_g'], p['gmlp_ln_b'])
    vg = vc.reshape(B, T // CHUNK, CHUNK, G_C, BRANCH_W // G_C)
    mixed = jnp.einsum('gpq,bcqgd->bcpgd', p['gmlp_w_s'], vg) + p['gmlp_b_s'].T[:, :, None]
    return u * mixed.reshape(B, T, BRANCH_W) * jax.nn.silu(g)


def fourier_branch(f, g):
    B, T, _ = f.shape
    fg = f.astype(jnp.float32).reshape(B, T, G_D, BRANCH_W // G_D)
    y = jnp.fft.fft2(fg, axes=(1, 3), norm='ortho').real
    return y.reshape(B, T, BRANCH_W).astype(f.dtype) * jax.nn.silu(g)


def trunk_layer(x, cond, p, rope, ctx):
    B, T, _ = x.shape
    mod = jax.nn.silu(cond) @ p['w_ada'] + p['b_ada']
    shift, scale, gate = jnp.split(mod[..., None, :], 3, axis=-1)
    h = rms_norm(x, p['norm_g']) * (1.0 + scale) + shift
    z = h @ p['w_in']
    zs = z[..., :SHIFT_W]
    zs = zs + (centred_shift(zs) - zs) * p['shift_mu']
    z = jnp.concatenate([zs, z[..., SHIFT_W:]], axis=-1)
    (r, k, v, wdf, wdb, ad, g_a, qd, kvd, kr, g_b, u, vc, g_c, f, g_d) = jnp.split(z, IN_SPLITS, axis=-1)
    if ctx is None:
        s0_f = jnp.zeros((B, H_A, N_A, N_A), jnp.float32)
        s0_b = s0_f
    else:
        s0_f, s0_b, ckv_c, kr_c = ctx
    o_a, s_f, s_b = rwkv_branch(r, k, v, wdf, wdb, ad, g_a, p, s0_f, s0_b)
    q, ckv, kr_t = mla_queries(qd, kvd, kr, p, rope)
    k_all, v_all = mla_expand(ckv, kr_t, p)
    if ctx is not None:
        k_c, v_c = mla_expand(ckv_c.astype(ckv.dtype), kr_c, p)
        k_all = jnp.concatenate([k_all, k_c], axis=1)
        v_all = jnp.concatenate([v_all, v_c], axis=1)
    o_b = block_attention(q, k_all, v_all).reshape(B, T, H_B * VDIM) * jax.nn.silu(g_b)
    o_c = gmlp_branch(u, vc, g_c, p)
    o_d = fourier_branch(f, g_d)
    proj = jnp.einsum('nbtw,nwd->nbtd', jnp.stack([o_a, o_b, o_c, o_d]), p['w_branch'])
    gates = jax.nn.sigmoid(h @ p['w_merge'] + p['b_merge']).reshape(B, T, N_BRANCH, D_MODEL)
    merged = jnp.einsum('nbtd,btnd->btd', proj, gates)
    x = x + gate * (merged @ p['w_out'])
    return x, s_f, s_b, ckv, kr_t


def setup_inputs(seed: int = 0) -> dict:
    key = jax.random.key(seed)
    keys = list(jax.random.split(key, 40))
    f32 = jnp.float32

    def nrm(i, shape, s):
        return jax.random.normal(keys[i], shape, f32) * s

    def unif(i, shape, lo, hi):
        return jax.random.uniform(keys[i], shape, f32, lo, hi)

    D = D_MODEL
    return {
        'x_prompt': nrm(0, (BATCH, SEQ, D), 1.0),
        'x_sample': nrm(1, (DEC_BATCH, DEC_SEQ, D), 1.0),
        'state_rwkv_fwd': nrm(2, (DEC_BATCH, DEPTH, H_A, N_A, N_A), 0.3),
        'state_rwkv_bwd': nrm(3, (DEC_BATCH, DEPTH, H_A, N_A, N_A), 0.3),
        'cache_mla_ckv': nrm(4, (DEC_BATCH, DEPTH, PAST_LEN, KV_LORA), 1.0),
        'cache_mla_krope': nrm(5, (DEC_BATCH, DEPTH, PAST_LEN, ROPE), 1.0),
        'c': nrm(6, (DEC_BATCH, D), 1.0),
        'c_ctx': nrm(7, (D,), 1.0),
        'norm_g': 1.0 + nrm(8, (DEPTH, D), 0.02),
        'w_ada': nrm(9, (DEPTH, D, 3 * D), 0.5 * D ** -0.5),
        'b_ada': nrm(10, (DEPTH, 3 * D), 0.02),
        'w_in': nrm(11, (DEPTH, D, IN_W), D ** -0.5),
        'shift_mu': unif(12, (DEPTH, SHIFT_W), 0.0, 1.0),
        'rwkv_w0': unif(13, (DEPTH, 2, BRANCH_W), -6.0, 1.0),
        'rwkv_w_up': nrm(14, (DEPTH, 2, LORA_W, BRANCH_W), 0.5 * LORA_W ** -0.5),
        'rwkv_a0': nrm(15, (DEPTH, 2, BRANCH_W), 0.5),
        'rwkv_a_up': nrm(16, (DEPTH, 2, LORA_A, BRANCH_W), 0.3 * LORA_A ** -0.5),
        'rwkv_k_k': 0.85 + nrm(17, (DEPTH, BRANCH_W), 0.02),
        'rwkv_k_a': 1.0 + nrm(18, (DEPTH, BRANCH_W), 0.02),
        'rwkv_r_k': nrm(19, (DEPTH, H_A, N_A), 0.1),
        'rwkv_ln_g': 1.0 + nrm(20, (DEPTH, BRANCH_W), 0.02),
        'rwkv_ln_b': nrm(21, (DEPTH, BRANCH_W), 0.02),
        'mla_q_norm': 1.0 + nrm(22, (DEPTH, Q_LORA), 0.02),
        'mla_w_q_up': nrm(23, (DEPTH, Q_LORA, H_B * (NOPE + ROPE)), Q_LORA ** -0.5),
        'mla_kv_norm': 1.0 + nrm(24, (DEPTH, KV_LORA), 0.02),
        'mla_w_kv_up': nrm(25, (DEPTH, KV_LORA, H_B * (NOPE + VDIM)), KV_LORA ** -0.5),
        'gmlp_ln_g': 1.0 + nrm(26, (DEPTH, BRANCH_W), 0.02),
        'gmlp_ln_b': nrm(27, (DEPTH, BRANCH_W), 0.02),
        'gmlp_w_s': nrm(28, (DEPTH, G_C, CHUNK, CHUNK), CHUNK ** -0.5),
        'gmlp_b_s': 1.0 + nrm(29, (DEPTH, G_C, CHUNK), 0.02),
        'w_branch': nrm(30, (DEPTH, N_BRANCH, BRANCH_W, D), BRANCH_W ** -0.5),
        'w_merge': nrm(31, (DEPTH, D, N_BRANCH * D), D ** -0.5),
        'b_merge': nrm(32, (DEPTH, N_BRANCH * D), 0.02),
        'w_out': nrm(33, (DEPTH, D, D), D ** -0.5),
        'final_norm_g': 1.0 + nrm(34, (D,), 0.02),
    }


def reference(x_prompt, x_sample, state_rwkv_fwd, state_rwkv_bwd, cache_mla_ckv, cache_mla_krope,
              c, c_ctx, norm_g, w_ada, b_ada, w_in, shift_mu, rwkv_w0, rwkv_w_up, rwkv_a0, rwkv_a_up,
              rwkv_k_k, rwkv_k_a, rwkv_r_k, rwkv_ln_g, rwkv_ln_b, mla_q_norm, mla_w_q_up, mla_kv_norm,
              mla_w_kv_up, gmlp_ln_g, gmlp_ln_b, gmlp_w_s, gmlp_b_s, w_branch, w_merge, b_merge, w_out,
              final_norm_g):
    rope = axial_rope(x_sample.shape[1])
    xc = x_prompt
    xl = x_sample
    sf_list, sb_list, ckv_list, kr_list = [], [], [], []
    for l in range(DEPTH):
        p = {
            'norm_g': norm_g[l], 'w_ada': w_ada[l], 'b_ada': b_ada[l], 'w_in': w_in[l],
            'shift_mu': shift_mu[l], 'rwkv_w0': rwkv_w0[l], 'rwkv_w_up': rwkv_w_up[l],
            'rwkv_a0': rwkv_a0[l], 'rwkv_a_up': rwkv_a_up[l], 'rwkv_k_k': rwkv_k_k[l],
            'rwkv_k_a': rwkv_k_a[l], 'rwkv_r_k': rwkv_r_k[l], 'rwkv_ln_g': rwkv_ln_g[l],
            'rwkv_ln_b': rwkv_ln_b[l], 'mla_q_norm': mla_q_norm[l], 'mla_w_q_up': mla_w_q_up[l],
            'mla_kv_norm': mla_kv_norm[l], 'mla_w_kv_up': mla_w_kv_up[l], 'gmlp_ln_g': gmlp_ln_g[l],
            'gmlp_ln_b': gmlp_ln_b[l], 'gmlp_w_s': gmlp_w_s[l], 'gmlp_b_s': gmlp_b_s[l],
            'w_branch': w_branch[l], 'w_merge': w_merge[l], 'b_merge': b_merge[l], 'w_out': w_out[l],
        }
        xc, s_f, s_b, ckv, kr = trunk_layer(xc, c_ctx, p, None, None)
        sf_list.append(s_f)
        sb_list.append(s_b)
        ckv_list.append(ckv)
        kr_list.append(kr)
        ctx = (state_rwkv_fwd[:, l], state_rwkv_bwd[:, l], cache_mla_ckv[:, l], cache_mla_krope[:, l])
        xl = trunk_layer(xl, c, p, rope, ctx)[0]
    y_prompt = rms_norm(xc, final_norm_g)
    y_sample = rms_norm(xl, final_norm_g)
    new_state_rwkv_fwd = jnp.stack(sf_list, axis=1).astype(x_prompt.dtype)
    new_state_rwkv_bwd = jnp.stack(sb_list, axis=1).astype(x_prompt.dtype)
    new_cache_mla_ckv = jnp.stack(ckv_list, axis=1)
    new_cache_mla_krope = jnp.stack(kr_list, axis=1)
    return (y_prompt, y_sample, new_state_rwkv_fwd, new_state_rwkv_bwd, new_cache_mla_ckv, new_cache_mla_krope)
```

```cpp
#ifdef EMU
#include "hip_emu.h"
#else
#include <hip/hip_runtime.h>
#include <hip/hip_cooperative_groups.h>
#endif
#include <stdint.h>

#ifndef CFG_BATCH
#define CFG_BATCH 32
#define CFG_SEQ 256
#define CFG_DEC_BATCH 2
#define CFG_DEC_SEQ 2048
#define CFG_PAST 512
#define CFG_NGRP_C 2
#endif
constexpr int D = 1024, NL = 2;
constexpr int NB_C = CFG_BATCH, T_C = CFG_SEQ, NB_D = CFG_DEC_BATCH, T_D = CFG_DEC_SEQ, PAST = CFG_PAST;
constexpr int M_C = NB_C * T_C, M_D = NB_D * T_D, M = M_C + M_D;
constexpr int NGRP_C = CFG_NGRP_C, NGRP = 1 + NGRP_C;
constexpr int MGC = M_C / NGRP_C, SEQ_PER_CG = NB_C / NGRP_C;
constexpr int MG = MGC > M_D ? MGC : M_D;
constexpr int MKV = MG + NB_D * PAST;
constexpr int KEYS_D = T_D + PAST;
constexpr int IN_W = 5728;
constexpr int ZC_R = 0, ZC_K = 512, ZC_V = 1024, ZC_WDF = 1536, ZC_GA = 1728, ZC_QD = 2240, ZC_KVD = 2496, ZC_KR = 2624,
              ZC_GB = 2656, ZC_U = 3168, ZC_VC = 3680, ZC_GC = 4192, ZC_F = 4704, ZC_GD = 5216;
constexpr int SHIFT_W = 1728;
static_assert(M_C % NGRP_C == 0 && NB_C % NGRP_C == 0, "ctx groups");
static_assert(T_C % 128 == 0 && T_D % 128 == 0 && PAST % 32 == 0, "seq multiples");

typedef unsigned short bf16_t;
typedef short s8v __attribute__((ext_vector_type(8)));
typedef float f4v __attribute__((ext_vector_type(4)));
typedef float f16v __attribute__((ext_vector_type(16)));
typedef unsigned u4v __attribute__((ext_vector_type(4)));
typedef unsigned u2v __attribute__((ext_vector_type(2)));

struct Params {
  const float *x_prompt, *x_sample, *st_f, *st_b, *c_ckv, *c_kr, *c, *c_ctx, *norm_g, *w_ada, *b_ada, *w_in, *shift_mu, *w0, *w_up,
      *a0, *a_up, *k_k, *k_a, *r_k, *ln_g, *ln_b, *q_norm, *w_q_up, *kv_norm, *w_kv_up, *g_ln_g, *g_ln_b, *g_w_s, *g_b_s, *w_branch,
      *w_merge, *b_merge, *w_out, *final_g;
  float* out;
  char* ws;
};

struct Grp { int isden, m0, mg, nseq, T, b0, nkeys, mkv; };
__host__ __device__ __forceinline__ Grp get_grp(int gi) {
  Grp g;
  if (gi == 0) { g.isden = 1; g.m0 = M_C; g.mg = M_D; g.nseq = NB_D; g.T = T_D; g.b0 = 0; g.nkeys = KEYS_D; g.mkv = M_D + NB_D * PAST; }
  else { g.isden = 0; g.m0 = (gi - 1) * MGC; g.mg = MGC; g.nseq = SEQ_PER_CG; g.T = T_C; g.b0 = (gi - 1) * SEQ_PER_CG; g.nkeys = T_C; g.mkv = MGC; }
  return g;
}

constexpr size_t al256(size_t x) { return (x + 255) & ~(size_t)255; }
constexpr size_t O_WINT = 0;
constexpr size_t O_WMT = O_WINT + al256((size_t)IN_W * 1024 * 2);
constexpr size_t O_WBRT = O_WMT + al256((size_t)4096 * 1024 * 2);
constexpr size_t O_WOUTT = O_WBRT + al256((size_t)4 * 1024 * 512 * 2);
constexpr size_t O_WQT = O_WOUTT + al256((size_t)1024 * 1024 * 2);
constexpr size_t O_WKVT = O_WQT + al256((size_t)768 * 256 * 2);
constexpr size_t O_WUPT = O_WKVT + al256((size_t)1024 * 128 * 2);
constexpr size_t O_WS = O_WUPT + al256((size_t)4 * 512 * 64 * 2);
constexpr size_t O_CS128 = O_WS + al256((size_t)4 * 128 * 128 * 2);
constexpr size_t O_A2C = O_CS128 + al256((size_t)256 * 128 * 2);
constexpr size_t O_A2D = O_A2C + al256((size_t)T_C * 2 * T_C * 2);
constexpr size_t O_ROPE = O_A2D + al256((size_t)T_D * 2 * T_D * 2);
constexpr size_t O_MOD = O_ROPE + al256((size_t)T_D * 32 * 4);
constexpr size_t O_H = O_MOD + al256((size_t)NL * 3 * 3072 * 4);
constexpr size_t O_Z = O_H + al256((size_t)MG * 1024 * 2);
constexpr size_t O_SR = O_Z + al256((size_t)MG * IN_W * 2);
constexpr size_t O_SK = O_SR + al256((size_t)MG * 512 * 2);
constexpr size_t O_SV = O_SK + al256((size_t)MG * 512 * 2);
constexpr size_t O_SKK = O_SV + al256((size_t)MG * 512 * 2);
constexpr size_t O_SD = O_SKK + al256((size_t)MG * 512 * 2);
constexpr size_t O_SB = O_SD + al256((size_t)2 * MG * 512 * 2);
constexpr size_t O_SKT = O_SB + al256((size_t)2 * MG * 512 * 2);
constexpr size_t O_YS = O_SKT + al256((size_t)2 * MG * 512 * 2);
constexpr size_t O_BON = O_YS + al256((size_t)2 * MG * 512 * 4);
constexpr size_t O_LORA = O_BON + al256((size_t)MG * 8 * 4);
constexpr size_t O_PRE = O_LORA + al256((size_t)MG * 192 * 2);
constexpr size_t O_QDN = O_PRE + al256((size_t)MG * 2048 * 2);
constexpr size_t O_CKV = O_QDN + al256((size_t)MG * 256 * 2);
constexpr size_t O_KR = O_CKV + al256((size_t)MKV * 128 * 2);
constexpr size_t O_Q = O_KR + al256((size_t)MKV * 32 * 2);
constexpr size_t O_KN = O_Q + al256((size_t)MG * 768 * 2);
constexpr size_t O_VT = O_KN + al256((size_t)MKV * 512 * 2);
constexpr size_t O_VCNT = O_VT + al256((size_t)MKV * 512 * 2);
constexpr size_t O_YT = O_VCNT + al256((size_t)MG * 512 * 2);
constexpr size_t O_OBR = O_YT + al256((size_t)MG * 1024 * 2);
constexpr size_t O_MERGED = O_OBR + al256((size_t)4 * MG * 512 * 2);
constexpr size_t O_END = O_MERGED + al256((size_t)MG * 1024 * 2);
static_assert(O_END <= ((size_t)256 << 20), "workspace must fit 256 MiB");

constexpr size_t OUT_SF = (size_t)M * D, OUT_SB = OUT_SF + (size_t)NB_C * NL * 8 * 64 * 64,
                 OUT_CKV = OUT_SB + (size_t)NB_C * NL * 8 * 64 * 64, OUT_KR = OUT_CKV + (size_t)NB_C * NL * T_C * 128;

__device__ __forceinline__ unsigned f_as_u(float f) { return __builtin_bit_cast(unsigned, f); }
__device__ __forceinline__ float u_as_f(unsigned u) { return __builtin_bit_cast(float, u); }
__device__ __forceinline__ bf16_t f2bf(float f) { unsigned u = f_as_u(f); u += 0x7FFFu + ((u >> 16) & 1u); return (bf16_t)(u >> 16); }
__device__ __forceinline__ float bf2f(bf16_t h) { return u_as_f(((unsigned)h) << 16); }
__device__ __forceinline__ float bflo(unsigned u) { return u_as_f(u << 16); }
__device__ __forceinline__ float bfhi(unsigned u) { return u_as_f(u & 0xFFFF0000u); }
__device__ __forceinline__ float sigmoidf_(float x) { return 1.f / (1.f + expf(-x)); }
__device__ __forceinline__ float siluf_(float x) { return x / (1.f + expf(-x)); }
__device__ __forceinline__ float geluf_(float x) { return 0.5f * x * (1.f + tanhf(0.7978845608028654f * (x + 0.044715f * x * x * x))); }
__device__ __forceinline__ float wave_sum(float v) {
#pragma unroll
  for (int o = 32; o >= 1; o >>= 1) v += __shfl_xor(v, o);
  return v;
}

constexpr int LDS_STR = 72;
constexpr int SMEM_BYTES = 65536;

template <int NJ>
__device__ __forceinline__ void zero_acc(f4v (&acc)[4][NJ]) {
#pragma unroll
  for (int i = 0; i < 4; ++i)
#pragma unroll
    for (int j = 0; j < NJ; ++j) acc[i][j] = f4v{0.f, 0.f, 0.f, 0.f};
}

template <int NJ>
__device__ __forceinline__ void gemm_mainloop(const bf16_t* __restrict__ A, long lda, int arow0, int arows, const bf16_t* __restrict__ B,
                                              long ldb, int brow0, int brows, int K, char* smem, f4v (&acc)[4][NJ]) {
  bf16_t* sA = (bf16_t*)smem;
  bf16_t* sB = sA + 128 * LDS_STR;
  const int tid = threadIdx.x, lane = tid & 63, wid = tid >> 6, wm = wid >> 1, wn = wid & 1;
  for (int k0 = 0; k0 < K; k0 += 64) {
    u4v ra[4], rb[NJ];
#pragma unroll
    for (int i = 0; i < 4; ++i) {
      int c = tid + 256 * i, r = c >> 3, cc = c & 7;
      int ar = arow0 + r; ar = ar < arows ? ar : arows - 1;
      ra[i] = *(const u4v*)(A + (long)ar * lda + k0 + cc * 8);
    }
#pragma unroll
    for (int i = 0; i < NJ; ++i) {
      int c = tid + 256 * i, r = c >> 3, cc = c & 7;
      int br = brow0 + r; br = br < brows ? br : brows - 1;
      rb[i] = *(const u4v*)(B + (long)br * ldb + k0 + cc * 8);
    }
    __syncthreads();
#pragma unroll
    for (int i = 0; i < 4; ++i) { int c = tid + 256 * i, r = c >> 3, cc = c & 7; *(u4v*)(sA + r * LDS_STR + cc * 8) = ra[i]; }
#pragma unroll
    for (int i = 0; i < NJ; ++i) { int c = tid + 256 * i, r = c >> 3, cc = c & 7; *(u4v*)(sB + r * LDS_STR + cc * 8) = rb[i]; }
    __syncthreads();
#pragma unroll
    for (int ks = 0; ks < 2; ++ks) {
      s8v af[4], bf[NJ];
#pragma unroll
      for (int i = 0; i < 4; ++i) af[i] = *(const s8v*)(sA + (wm * 64 + i * 16 + (lane & 15)) * LDS_STR + ks * 32 + (lane >> 4) * 8);
#pragma unroll
      for (int j = 0; j < NJ; ++j) bf[j] = *(const s8v*)(sB + (wn * NJ * 16 + j * 16 + (lane & 15)) * LDS_STR + ks * 32 + (lane >> 4) * 8);
#pragma unroll
      for (int i = 0; i < 4; ++i)
#pragma unroll
        for (int j = 0; j < NJ; ++j) acc[i][j] = __builtin_amdgcn_mfma_f32_16x16x32_bf16(af[i], bf[j], acc[i][j], 0, 0, 0);
    }
  }
}

template <int NJ, class F>
__device__ __forceinline__ void epi_foreach(f4v (&acc)[4][NJ], int row0, int col0, F f) {
  const int tid = threadIdx.x, lane = tid & 63, wid = tid >> 6, wm = wid >> 1, wn = wid & 1;
#pragma unroll
  for (int i = 0; i < 4; ++i)
#pragma unroll
    for (int j = 0; j < NJ; ++j) f(row0 + wm * 64 + i * 16 + (lane >> 4) * 4, col0 + wn * NJ * 16 + j * 16 + (lane & 15), acc[i][j]);
}

struct TJob { const float* src; int K, N; long lds; bf16_t* dst; long ldd; };
__device__ __forceinline__ TJob get_tjob(const Params& p, int l, int j) {
  TJob t; char* ws = p.ws;
  if (j == 0) { t.src = p.w_in + (size_t)l * 1024 * IN_W; t.K = 1024; t.N = IN_W; t.lds = IN_W; t.dst = (bf16_t*)(ws + O_WINT); t.ldd = 1024; }
  else if (j == 1) { t.src = p.w_merge + (size_t)l * 1024 * 4096; t.K = 1024; t.N = 4096; t.lds = 4096; t.dst = (bf16_t*)(ws + O_WMT); t.ldd = 1024; }
  else if (j < 6) { int n = j - 2; t.src = p.w_branch + ((size_t)l * 4 + n) * 512 * 1024; t.K = 512; t.N = 1024; t.lds = 1024; t.dst = (bf16_t*)(ws + O_WBRT) + (size_t)n * 1024 * 512; t.ldd = 512; }
  else if (j == 6) { t.src = p.w_out + (size_t)l * 1024 * 1024; t.K = 1024; t.N = 1024; t.lds = 1024; t.dst = (bf16_t*)(ws + O_WOUTT); t.ldd = 1024; }
  else if (j == 7) { t.src = p.w_q_up + (size_t)l * 256 * 768; t.K = 256; t.N = 768; t.lds = 768; t.dst = (bf16_t*)(ws + O_WQT); t.ldd = 256; }
  else if (j == 8) { t.src = p.w_kv_up + (size_t)l * 128 * 1024; t.K = 128; t.N = 1024; t.lds = 1024; t.dst = (bf16_t*)(ws + O_WKVT); t.ldd = 128; }
  else { int n = j - 9;
    t.src = (n < 2 ? p.w_up : p.a_up) + ((size_t)l * 2 + (n & 1)) * 64 * 512; t.K = 64; t.N = 512; t.lds = 512;
    t.dst = (bf16_t*)(ws + O_WUPT) + (size_t)n * 512 * 64; t.ldd = 64; }
  return t;
}
constexpr int NTJOBS = 13;

__device__ __forceinline__ void stage_prep(const Params& p, int l, int bid, int nb, char* smem) {
  const int tid = threadIdx.x;
  char* ws = p.ws;
  {
    float* tile = (float*)smem;
    long base = 0;
    for (int j = 0; j < NTJOBS; ++j) {
      TJob t = get_tjob(p, l, j);
      int tk = t.K / 32, tn = t.N / 32, nt = tk * tn;
      long first = ((bid - base) % nb + nb) % nb;
      for (long q = first; q < nt; q += nb) {
        int kt = (int)(q / tn), nt_ = (int)(q % tn);
        __syncthreads();
#pragma unroll
        for (int i = 0; i < 4; ++i) { int e = tid + 256 * i, r = e >> 5, c = e & 31; tile[r * 33 + c] = t.src[(long)(kt * 32 + r) * t.lds + nt_ * 32 + c]; }
        __syncthreads();
#pragma unroll
        for (int i = 0; i < 4; ++i) { int e = tid + 256 * i, r = e >> 5, c = e & 31; t.dst[(long)(nt_ * 32 + r) * t.ldd + kt * 32 + c] = f2bf(tile[c * 33 + r]); }
      }
      base += nt;
    }
    __syncthreads();
  }
  const long gtid = (long)bid * 256 + tid, gn = (long)nb * 256;
  { bf16_t* d = (bf16_t*)(ws + O_WS); const float* s = p.g_w_s + (size_t)l * 4 * 128 * 128; for (long i = gtid; i < (long)4 * 128 * 128; i += gn) d[i] = f2bf(s[i]); }
  if (l != 0) return;
  { bf16_t* d = (bf16_t*)(ws + O_CS128);
    for (long i = gtid; i < 256 * 128; i += gn) { int j = (int)(i >> 7), c = (int)(i & 127); int mm = ((j & 127) * c) & 127; float x = 2.0f * mm / 128.f; d[i] = f2bf(j < 128 ? cospif(x) : sinpif(x)); } }
  { bf16_t* d = (bf16_t*)(ws + O_A2C);
    for (long i = gtid; i < (long)T_C * 2 * T_C; i += gn) { int tp = (int)(i / (2 * T_C)), tt = (int)(i % (2 * T_C)); int half = tt >= T_C; int t = half ? tt - T_C : tt; int mm = (int)(((long)tp * t) % T_C); float x = 2.0f * mm / (float)T_C; d[i] = f2bf(half ? -sinpif(x) : cospif(x)); } }
  { bf16_t* d = (bf16_t*)(ws + O_A2D);
    for (long i = gtid; i < (long)T_D * 2 * T_D; i += gn) { int tp = (int)(i / (2 * T_D)), tt = (int)(i % (2 * T_D)); int half = tt >= T_D; int t = half ? tt - T_D : tt; int mm = (int)(((long)tp * t) % T_D); float x = 2.0f * mm / (float)T_D; d[i] = f2bf(half ? -sinpif(x) : cospif(x)); } }
  { float* d = (float*)(ws + O_ROPE);
    for (long i = gtid; i < (long)T_D * 16; i += gn) { int t = (int)(i >> 4), pi = (int)(i & 15); float pos = (pi < 8) ? (float)(t / 64) : (float)(t % 64); float inv = expf(-(float)(pi & 7) * (9.210340371976184f / 8.f)); float a = pos * inv; d[2 * i] = cosf(a); d[2 * i + 1] = sinf(a); } }
  { float4* d = (float4*)p.out; const float4* s0 = (const float4*)p.x_prompt; const float4* s1 = (const float4*)p.x_sample;
    for (long i = gtid; i < (long)M * 256; i += gn) d[i] = (i < (long)M_C * 256) ? s0[i] : s1[i - (long)M_C * 256]; }
  {
    float* red = (float*)smem;
    float* modp = (float*)(ws + O_MOD);
    for (int u = bid; u < NL * 48; u += nb) {
      int ll = u / 48, cg = u % 48; int col = cg * 64 + (tid & 63), kq = tid >> 6;
      float a0 = 0.f, a1 = 0.f, a2 = 0.f;
      const float* w = p.w_ada + (size_t)ll * 1024 * 3072 + col;
      for (int k = kq * 256; k < kq * 256 + 256; ++k) {
        float wv = w[(size_t)k * 3072];
        a0 += siluf_(p.c_ctx[k]) * wv; a1 += siluf_(p.c[k]) * wv; a2 += siluf_(p.c[(NB_D > 1 ? 1024 : 0) + k]) * wv;
      }
      __syncthreads();
      red[(kq * 3 + 0) * 64 + (tid & 63)] = a0; red[(kq * 3 + 1) * 64 + (tid & 63)] = a1; red[(kq * 3 + 2) * 64 + (tid & 63)] = a2;
      __syncthreads();
      if (tid < 192) { int mi = tid >> 6, cc = tid & 63; float s = red[(0 * 3 + mi) * 64 + cc] + red[(1 * 3 + mi) * 64 + cc] + red[(2 * 3 + mi) * 64 + cc] + red[(3 * 3 + mi) * 64 + cc];
        modp[((size_t)ll * 3 + mi) * 3072 + cg * 64 + cc] = s + p.b_ada[(size_t)ll * 3072 + cg * 64 + cc]; }
    }
  }
}

__device__ __forceinline__ int mod_index(const Grp& g, int lm) { return g.isden ? 1 + lm / T_D : 0; }

__device__ __forceinline__ void stage_h(const Params& p, const Grp& g, int l, int bid, int nb) {
  const int lane = threadIdx.x & 63, wid = threadIdx.x >> 6;
  const float* X = p.out + (size_t)g.m0 * 1024;
  bf16_t* H = (bf16_t*)(p.ws + O_H);
  const float* modp = (const float*)(p.ws + O_MOD) + (size_t)l * 3 * 3072;
  const float* gam = p.norm_g + (size_t)l * 1024;
  for (int m = bid * 4 + wid; m < g.mg; m += nb * 4) {
    const float* xr = X + (size_t)m * 1024; float v[16]; float ss = 0.f;
#pragma unroll
    for (int i = 0; i < 4; ++i) { float4 q = *(const float4*)(xr + i * 256 + lane * 4); v[4 * i] = q.x; v[4 * i + 1] = q.y; v[4 * i + 2] = q.z; v[4 * i + 3] = q.w; ss += q.x * q.x + q.y * q.y + q.z * q.z + q.w * q.w; }
    ss = wave_sum(ss); float rs = rsqrtf(ss * (1.f / 1024.f) + 1e-6f);
    const float* mo = modp + (size_t)mod_index(g, m) * 3072;
#pragma unroll
    for (int i = 0; i < 4; ++i) {
      int c = i * 256 + lane * 4; bf16_t o[4];
#pragma unroll
      for (int e = 0; e < 4; ++e) o[e] = f2bf(v[4 * i + e] * rs * gam[c + e] * (1.f + mo[1024 + c + e]) + mo[c + e]);
      *(uint2*)(H + (size_t)m * 1024 + c) = make_uint2((unsigned)o[0] | ((unsigned)o[1] << 16), (unsigned)o[2] | ((unsigned)o[3] << 16));
    }
  }
}

__device__ __forceinline__ void stage_g1(const Params& p, const Grp& g, int bid, int nb, char* smem) {
  const bf16_t* H = (const bf16_t*)(p.ws + O_H);
  const bf16_t* W = (const bf16_t*)(p.ws + O_WINT);
  bf16_t* Z = (bf16_t*)(p.ws + O_Z);
  const int TM = (g.mg + 127) / 128; constexpr int TN = (IN_W + 127) / 128;
  for (int t = bid; t < TM * TN; t += nb) {
    int tn = t / TM, tm = t % TM; f4v acc[4][4]; zero_acc<4>(acc);
    gemm_mainloop<4>(H, 1024, tm * 128, g.mg, W, 1024, tn * 128, IN_W, 1024, smem, acc);
    const int mg = g.mg;
    epi_foreach<4>(acc, tm * 128, tn * 128, [&](int rb, int col, f4v v) {
      if (col < IN_W) {
#pragma unroll
        for (int e = 0; e < 4; ++e) if (rb + e < mg) Z[(size_t)(rb + e) * IN_W + col] = f2bf(v[e]);
      }
    });
  }
}

__device__ __forceinline__ void stage_e1(const Params& p, const Grp& g, int l, int bid, int nb) {
  const int lane = threadIdx.x & 63, wid = threadIdx.x >> 6;
  char* ws = p.ws;
  const bf16_t* Z = (const bf16_t*)(ws + O_Z);
  bf16_t* SR = (bf16_t*)(ws + O_SR); bf16_t* SK = (bf16_t*)(ws + O_SK); bf16_t* SV = (bf16_t*)(ws + O_SV);
  bf16_t* LORA = (bf16_t*)(ws + O_LORA); bf16_t* QDN = (bf16_t*)(ws + O_QDN); bf16_t* CKV = (bf16_t*)(ws + O_CKV); bf16_t* KR = (bf16_t*)(ws + O_KR);
  bf16_t* VCNT = (bf16_t*)(ws + O_VCNT);
  const float* rope = (const float*)(ws + O_ROPE);
  const float* mu = p.shift_mu + (size_t)l * SHIFT_W;
  const int isden = g.isden, T = g.T;
  for (int m = bid * 4 + wid; m < g.mkv; m += nb * 4) {
    if (m >= g.mg) {
      int r = m - g.mg, b = r / PAST, j = r % PAST;
      const float* s = p.c_ckv + (((size_t)b * NL + l) * PAST + j) * 128;
      CKV[(size_t)m * 128 + lane] = f2bf(s[lane]); CKV[(size_t)m * 128 + 64 + lane] = f2bf(s[64 + lane]);
      if (lane < 32) KR[(size_t)m * 32 + lane] = f2bf(p.c_kr[(((size_t)b * NL + l) * PAST + j) * 32 + lane]);
      continue;
    }
    const int sq = m / T, t = m % T, b = g.b0 + sq;
    const bf16_t* z = Z + (size_t)m * IN_W;
    const bool hp = t > 0, hn = t < T - 1;
#pragma unroll 4
    for (int i = 0; i < 24; ++i) {
      int c = lane + 64 * i; float zc = bf2f(z[c]);
      float pv = hp ? bf2f(z[c - IN_W]) : 0.f, nv = hn ? bf2f(z[c + IN_W]) : 0.f;
      bf16_t s = f2bf(zc + (0.5f * (pv + nv) - zc) * mu[c]);
      if (i < 8) SR[(size_t)m * 512 + c] = s; else if (i < 16) SK[(size_t)m * 512 + c - 512] = s; else SV[(size_t)m * 512 + c - 1024] = s;
    }
#pragma unroll
    for (int i = 0; i < 3; ++i) {
      int c = ZC_WDF + lane + 64 * i; float zc = bf2f(z[c]);
      float pv = hp ? bf2f(z[c - IN_W]) : 0.f, nv = hn ? bf2f(z[c + IN_W]) : 0.f;
      float s = zc + (0.5f * (pv + nv) - zc) * mu[c];
      LORA[(size_t)m * 192 + lane + 64 * i] = f2bf(i < 2 ? tanhf(s) : s);
    }
    { float v[4]; float ss = 0.f;
#pragma unroll
      for (int i = 0; i < 4; ++i) { v[i] = bf2f(z[ZC_QD + lane + 64 * i]); ss += v[i] * v[i]; }
      ss = wave_sum(ss); float rs = rsqrtf(ss * (1.f / 256.f) + 1e-6f);
#pragma unroll
      for (int i = 0; i < 4; ++i) QDN[(size_t)m * 256 + lane + 64 * i] = f2bf(v[i] * rs * p.q_norm[(size_t)l * 256 + lane + 64 * i]); }
    { float v[2]; float ss = 0.f;
#pragma unroll
      for (int i = 0; i < 2; ++i) { v[i] = bf2f(z[ZC_KVD + lane + 64 * i]); ss += v[i] * v[i]; }
      ss = wave_sum(ss); float rs = rsqrtf(ss * (1.f / 128.f) + 1e-6f);
#pragma unroll
      for (int i = 0; i < 2; ++i) { float o = v[i] * rs * p.kv_norm[(size_t)l * 128 + lane + 64 * i];
        CKV[(size_t)m * 128 + lane + 64 * i] = f2bf(o);
        if (!isden) p.out[OUT_CKV + (((size_t)b * NL + l) * T_C + t) * 128 + lane + 64 * i] = o; } }
    { float v = lane < 32 ? bf2f(z[ZC_KR + (lane & 31)]) : 0.f; float pr = __shfl_xor(v, 1); float o = v;
      if (isden) { int pi = (lane & 31) >> 1; float cs = rope[((size_t)t * 16 + pi) * 2], sn = rope[((size_t)t * 16 + pi) * 2 + 1];
        o = (lane & 1) ? (pr * sn + v * cs) : (v * cs - pr * sn); }
      if (lane < 32) { KR[(size_t)m * 32 + lane] = f2bf(o); if (!isden) p.out[OUT_KR + (((size_t)b * NL + l) * T_C + t) * 32 + lane] = v; } }
    { float v[8]; float s1 = 0.f;
#pragma unroll
      for (int i = 0; i < 8; ++i) { v[i] = geluf_(bf2f(z[ZC_VC + lane + 64 * i])); s1 += v[i]; }
      s1 = wave_sum(s1); float mean = s1 * (1.f / 512.f); float s2 = 0.f;
#pragma unroll
      for (int i = 0; i < 8; ++i) { float d = v[i] - mean; s2 += d * d; }
      s2 = wave_sum(s2); float rs = rsqrtf(s2 * (1.f / 512.f) + 1e-5f);
#pragma unroll
      for (int i = 0; i < 8; ++i) { int ch = lane + 64 * i; float o = (v[i] - mean) * rs * p.g_ln_g[(size_t)l * 512 + ch] + p.g_ln_b[(size_t)l * 512 + ch];
        VCNT[(((size_t)(m >> 7) * 4 + (ch >> 7)) * 128 + (ch & 127)) * 128 + (m & 127)] = f2bf(o); } }
  }
}

__device__ __forceinline__ void stage_g2(const Params& p, const Grp& g, int l, int bid, int nb, char* smem) {
  char* ws = p.ws;
  const bf16_t* Z = (const bf16_t*)(ws + O_Z);
  const float* rope = (const float*)(ws + O_ROPE);
  const int mg = g.mg, mkv = g.mkv, T = g.T, isden = g.isden, nkeys = g.nkeys;
  const int TM_M = (mg + 127) / 128, TM_KV = (mkv + 127) / 128;
  const int NT_Q = TM_M * 6, NT_KV = TM_KV * 8, NT_LORA = TM_M * 16, NT_GM = (mg / 128) * 4, ntt = T / 128, NT_D1 = g.nseq * 8 * ntt;
  const int NT = NT_Q + NT_KV + NT_LORA + NT_GM + NT_D1;
  for (int t0 = bid; t0 < NT; t0 += nb) {
    int t = t0; f4v acc[4][4]; zero_acc<4>(acc);
    if (t < NT_Q) {
      int tn = t / TM_M, tm = t % TM_M;
      gemm_mainloop<4>((const bf16_t*)(ws + O_QDN), 256, tm * 128, mg, (const bf16_t*)(ws + O_WQT), 256, tn * 128, 768, 256, smem, acc);
      bf16_t* Q = (bf16_t*)(ws + O_Q);
      const float scale = 0.10206207261596575f;
      epi_foreach<4>(acc, tm * 128, tn * 128, [&](int rb, int col, f4v v) {
        int cw = col % 96; bool isr = cw >= 64; int pi = (cw - 64) >> 1;
#pragma unroll
        for (int e = 0; e < 4; ++e) {
          int row = rb + e; float x = v[e]; float pr = __shfl_xor(x, 1); float o = x;
          if (isr && isden && row < mg) { int tt = row % T_D; float cs = rope[((size_t)tt * 16 + pi) * 2], sn = rope[((size_t)tt * 16 + pi) * 2 + 1];
            o = (col & 1) ? (pr * sn + x * cs) : (x * cs - pr * sn); }
          if (row < mg) Q[(size_t)row * 768 + col] = f2bf(o * scale);
        }
      });
      continue;
    }
    t -= NT_Q;
    if (t < NT_KV) {
      int tn = t / TM_KV, tm = t % TM_KV;
      gemm_mainloop<4>((const bf16_t*)(ws + O_CKV), 128, tm * 128, mkv, (const bf16_t*)(ws + O_WKVT), 128, tn * 128, 1024, 128, smem, acc);
      bf16_t* KN = (bf16_t*)(ws + O_KN); bf16_t* VT = (bf16_t*)(ws + O_VT);
      epi_foreach<4>(acc, tm * 128, tn * 128, [&](int rb, int col, f4v v) {
        int h = col >> 7, w = col & 127;
#pragma unroll
        for (int e = 0; e < 4; ++e) {
          int row = rb + e; if (row >= mkv) continue;
          if (w < 64) KN[(size_t)row * 512 + h * 64 + w] = f2bf(v[e]);
          else { int dv = w - 64; int sq, key;
            if (row < mg) { sq = row / T; key = row % T; } else { int r = row - mg; sq = r / PAST; key = T + r % PAST; }
            VT[(((size_t)sq * 8 + h) * 64 + dv) * nkeys + key] = f2bf(v[e]); }
        }
      });
      continue;
    }
    t -= NT_KV;
    if (t < NT_LORA) {
      int g4 = t / (TM_M * 4), r = t % (TM_M * 4), tn = r / TM_M, tm = r % TM_M;
      int koff = g4 == 0 ? 0 : (g4 == 1 ? 64 : 128);
      gemm_mainloop<4>((const bf16_t*)(ws + O_LORA) + koff, 192, tm * 128, mg, (const bf16_t*)(ws + O_WUPT) + (size_t)g4 * 512 * 64, 64, tn * 128, 512, 64, smem, acc);
      bf16_t* PRE = (bf16_t*)(ws + O_PRE);
      const float* bias = (g4 < 2 ? p.w0 : p.a0) + ((size_t)l * 2 + (g4 & 1)) * 512;
      epi_foreach<4>(acc, tm * 128, tn * 128, [&](int rb, int col, f4v v) {
        float bb = bias[col];
#pragma unroll
        for (int e = 0; e < 4; ++e) if (rb + e < mg) PRE[((size_t)(rb + e) * 4 + g4) * 512 + col] = f2bf(v[e] + bb);
      });
      continue;
    }
    t -= NT_LORA;
    if (t < NT_GM) {
      int ch = t >> 2, gg = t & 3;
      gemm_mainloop<4>((const bf16_t*)(ws + O_WS) + (size_t)gg * 128 * 128, 128, 0, 128, (const bf16_t*)(ws + O_VCNT) + ((size_t)ch * 4 + gg) * 128 * 128, 128, 0, 128, 128, smem, acc);
      bf16_t* O = (bf16_t*)(ws + O_OBR) + (size_t)2 * MG * 512;
      const float* bs = p.g_b_s + ((size_t)l * 4 + gg) * 128;
      epi_foreach<4>(acc, 0, 0, [&](int rb, int col, f4v v) {
#pragma unroll
        for (int e = 0; e < 4; ++e) { int pp = rb + e; int m = ch * 128 + pp; int c = gg * 128 + col;
          float u = geluf_(bf2f(Z[(size_t)m * IN_W + ZC_U + c])); float gc = siluf_(bf2f(Z[(size_t)m * IN_W + ZC_GC + c]));
          O[(size_t)m * 512 + c] = f2bf(u * (v[e] + bs[pp]) * gc); }
      });
      continue;
    }
    t -= NT_GM;
    {
      int per_seq = 8 * ntt; int sq = t / per_seq; int r = t % per_seq; int gg = r / (2 * ntt); int r2 = r % (2 * ntt); int tj = r2 / ntt, tt = r2 % ntt;
      long mbase = (long)sq * T;
      gemm_mainloop<4>((const bf16_t*)(ws + O_CS128), 128, tj * 128, 256, Z + (size_t)mbase * IN_W + ZC_F + gg * 128, IN_W, tt * 128, T, 128, smem, acc);
      bf16_t* YT = (bf16_t*)(ws + O_YT) + (size_t)mbase * 1024 + (size_t)gg * 128 * 2 * T;
      epi_foreach<4>(acc, tj * 128, tt * 128, [&](int rb, int col, f4v v) {
#pragma unroll
        for (int e = 0; e < 4; ++e) { int j = rb + e; YT[(size_t)(j & 127) * 2 * T + (size_t)(j >> 7) * T + col] = f2bf(v[e]); }
      });
    }
  }
}

__device__ __forceinline__ void stage_e2(const Params& p, const Grp& g, int l, int bid, int nb) {
  const int lane = threadIdx.x & 63, wid = threadIdx.x >> 6;
  char* ws = p.ws;
  const bf16_t* SR = (const bf16_t*)(ws + O_SR); const bf16_t* SK = (const bf16_t*)(ws + O_SK);
  bf16_t* SKK = (bf16_t*)(ws + O_SKK); bf16_t* SD = (bf16_t*)(ws + O_SD); bf16_t* SB = (bf16_t*)(ws + O_SB); bf16_t* SKT = (bf16_t*)(ws + O_SKT);
  float* BON = (float*)(ws + O_BON); const bf16_t* PRE = (const bf16_t*)(ws + O_PRE);
  for (int m = bid * 4 + wid; m < g.mg; m += nb * 4) {
#pragma unroll 2
    for (int i = 0; i < 8; ++i) {
      int c = lane + 64 * i;
      float k = bf2f(SK[(size_t)m * 512 + c]), r = bf2f(SR[(size_t)m * 512 + c]);
      float kr = k * p.k_k[(size_t)l * 512 + c];
      float n2 = wave_sum(kr * kr); float kk = kr / fmaxf(sqrtf(n2), 1e-12f);
      SKK[(size_t)m * 512 + c] = f2bf(kk);
      float bon = 0.f;
#pragma unroll
      for (int d = 0; d < 2; ++d) {
        float pw = bf2f(PRE[((size_t)m * 4 + d) * 512 + c]), pa = bf2f(PRE[((size_t)m * 4 + 2 + d) * 512 + c]);
        float dec = expf(-0.6065306597126334f * sigmoidf_(pw));
        float a = sigmoidf_(pa);
        float kt = k * (1.f + (a - 1.f) * p.k_a[(size_t)l * 512 + c]);
        SD[((size_t)d * MG + m) * 512 + c] = f2bf(1.f - dec); SB[((size_t)d * MG + m) * 512 + c] = f2bf(kk * a); SKT[((size_t)d * MG + m) * 512 + c] = f2bf(kt);
        bon += r * kt * p.r_k[(size_t)l * 512 + c];
      }
      bon = wave_sum(bon);
      if (lane == 0) BON[(size_t)m * 8 + i] = bon;
    }
  }
}

__device__ __forceinline__ void attention_item(const Params& p, const Grp& g, int sq, int h, int qb) {
  char* ws = p.ws;
  const int lane = threadIdx.x & 63, wid = threadIdx.x >> 6, ql = lane & 31, hh = lane >> 5;
  const int T = g.T, nkeys = g.nkeys;
  const long mbase = (long)sq * T;
  const bf16_t* Q = (const bf16_t*)(ws + O_Q); const bf16_t* KN = (const bf16_t*)(ws + O_KN); const bf16_t* KRp = (const bf16_t*)(ws + O_KR);
  const bf16_t* VT = (const bf16_t*)(ws + O_VT) + ((size_t)sq * 8 + h) * 64 * nkeys;
  const long mq = mbase + qb * 128 + wid * 32 + ql;
  s8v qf[6];
#pragma unroll
  for (int s = 0; s < 6; ++s) qf[s] = *(const s8v*)(Q + (size_t)mq * 768 + h * 96 + 16 * s + 8 * hh);
  f16v o0, o1;
#pragma unroll
  for (int i = 0; i < 16; ++i) { o0[i] = 0.f; o1[i] = 0.f; }
  float mrun = -1e30f, lrun = 0.f;
  for (int k0 = 0; k0 < nkeys; k0 += 32) {
    long krow = (k0 < T) ? mbase + k0 + ql : (long)g.mg + (long)sq * PAST + (k0 - T) + ql;
    f16v s;
#pragma unroll
    for (int i = 0; i < 16; ++i) s[i] = 0.f;
#pragma unroll
    for (int st = 0; st < 6; ++st) {
      s8v kf = (st < 4) ? *(const s8v*)(KN + (size_t)krow * 512 + h * 64 + 16 * st + 8 * hh) : *(const s8v*)(KRp + (size_t)krow * 32 + 16 * (st - 4) + 8 * hh);
      s = __builtin_amdgcn_mfma_f32_32x32x16_bf16(kf, qf[st], s, 0, 0, 0);
    }
    float mx = s[0];
#pragma unroll
    for (int i = 1; i < 16; ++i) mx = fmaxf(mx, s[i]);
    mx = fmaxf(mx, __shfl_xor(mx, 32));
    float mnew = fmaxf(mrun, mx); float alpha = expf(mrun - mnew); mrun = mnew;
    float ps = 0.f; bf16_t pb[16];
#pragma unroll
    for (int i = 0; i < 16; ++i) { float e = expf(s[i] - mnew); ps += e; pb[i] = f2bf(e); }
    lrun = lrun * alpha + ps;
#pragma unroll
    for (int i = 0; i < 16; ++i) { o0[i] *= alpha; o1[i] *= alpha; }
#pragma unroll
    for (int st = 0; st < 2; ++st) {
      s8v pf;
#pragma unroll
      for (int j = 0; j < 8; ++j) pf[j] = (short)pb[8 * st + j];
#pragma unroll
      for (int db = 0; db < 2; ++db) {
        const bf16_t* vp = VT + (size_t)(db * 32 + ql) * nkeys + k0 + 16 * st + 4 * hh;
        u2v a = *(const u2v*)vp, b2 = *(const u2v*)(vp + 8);
        s8v vf = __builtin_bit_cast(s8v, u4v{a.x, a.y, b2.x, b2.y});
        if (db == 0) o0 = __builtin_amdgcn_mfma_f32_32x32x16_bf16(vf, pf, o0, 0, 0, 0);
        else o1 = __builtin_amdgcn_mfma_f32_32x32x16_bf16(vf, pf, o1, 0, 0, 0);
      }
    }
  }
  float ltot = lrun + __shfl_xor(lrun, 32); float inv = 1.f / ltot;
  const bf16_t* Z = (const bf16_t*)(ws + O_Z);
  bf16_t* O = (bf16_t*)(ws + O_OBR) + (size_t)1 * MG * 512;
#pragma unroll
  for (int db = 0; db < 2; ++db)
#pragma unroll
    for (int i = 0; i < 16; ++i) {
      int dv = db * 32 + (i & 3) + 8 * (i >> 2) + 4 * hh; float ov = (db == 0 ? o0[i] : o1[i]) * inv;
      float gt = siluf_(bf2f(Z[(size_t)mq * IN_W + ZC_GB + h * 64 + dv]));
      O[(size_t)mq * 512 + h * 64 + dv] = f2bf(ov * gt);
    }
}

__device__ __forceinline__ void stage_att(const Params& p, const Grp& g, int bid, int nb, char* smem) {
  char* ws = p.ws;
  const bf16_t* Z = (const bf16_t*)(ws + O_Z);
  const int T = g.T, ntt = T / 128;
  const int NI_A = g.nseq * 8 * ntt, NT_D2 = g.nseq * 4 * ntt;
  for (int t0 = bid; t0 < NI_A + NT_D2; t0 += nb) {
    int t = t0;
    if (t < NI_A) { int sq = t / (8 * ntt), r = t % (8 * ntt); attention_item(p, g, sq, r / ntt, r % ntt); continue; }
    t -= NI_A;
    {
      int sq = t / (4 * ntt), r = t % (4 * ntt), gg = r / ntt, tt = r % ntt;
      long mbase = (long)sq * T;
      f4v acc[4][4]; zero_acc<4>(acc);
      gemm_mainloop<4>((const bf16_t*)(ws + (g.isden ? O_A2D : O_A2C)), 2 * T, tt * 128, T, (const bf16_t*)(ws + O_YT) + (size_t)mbase * 1024 + (size_t)gg * 128 * 2 * T, 2 * T, 0, 128, 2 * T, smem, acc);
      bf16_t* O = (bf16_t*)(ws + O_OBR) + (size_t)3 * MG * 512;
      const float sc = rsqrtf(128.f * (float)T);
      epi_foreach<4>(acc, tt * 128, 0, [&](int rb, int col, f4v v) {
#pragma unroll
        for (int e = 0; e < 4; ++e) { long m = mbase + rb + e; int c = gg * 128 + col; float gd = siluf_(bf2f(Z[(size_t)m * IN_W + ZC_GD + c]));
          O[(size_t)m * 512 + c] = f2bf(v[e] * sc * gd); }
      });
    }
  }
}

__device__ __forceinline__ float row16_sum(float v) {
  v += __shfl_xor(v, 1); v += __shfl_xor(v, 2); v += __shfl_xor(v, 4); v += __shfl_xor(v, 8); return v;
}
__device__ __forceinline__ void stage_scan(const Params& p, const Grp& g, int l, int bid, int nb) {
  char* ws = p.ws;
  const int tid = threadIdx.x, lane = tid & 63, wid = tid >> 6;
  const bf16_t* SR = (const bf16_t*)(ws + O_SR); const bf16_t* SV = (const bf16_t*)(ws + O_SV); const bf16_t* SKK = (const bf16_t*)(ws + O_SKK);
  const int T = g.T;
  const int NIT = g.nseq * 16 * 4;
  for (int it = bid; it < NIT; it += nb) {
    int ch = it >> 2, rg = it & 3;
    int dir = ch & 1, h = (ch >> 1) & 7, sq = ch >> 4;
    long mbase = (long)sq * T;
    int row = rg * 16 + wid * 4 + (lane >> 4), ks = (lane & 15) * 4;
    const bf16_t* SD = (const bf16_t*)(ws + O_SD) + (size_t)dir * MG * 512; const bf16_t* SB = (const bf16_t*)(ws + O_SB) + (size_t)dir * MG * 512;
    const bf16_t* SKT = (const bf16_t*)(ws + O_SKT) + (size_t)dir * MG * 512;
    float* YS = (float*)(ws + O_YS) + (size_t)dir * MG * 512;
    float s0 = 0.f, s1 = 0.f, s2 = 0.f, s3 = 0.f;
    if (g.isden) { const float* st = (dir ? p.st_b : p.st_f) + ((((size_t)sq * NL + l) * 8 + h) * 64 + row) * 64 + ks; s0 = st[0]; s1 = st[1]; s2 = st[2]; s3 = st[3]; }
    for (int i = 0; i < T; ++i) {
      int t = dir ? T - 1 - i : i; size_t o = (size_t)(mbase + t) * 512 + h * 64;
      uint2 dd = *(const uint2*)(SD + o + ks), kk = *(const uint2*)(SKK + o + ks), bb = *(const uint2*)(SB + o + ks), kt = *(const uint2*)(SKT + o + ks), r = *(const uint2*)(SR + o + ks);
      float v = bf2f(SV[o + row]);
      float sa = -row16_sum(s0 * bflo(kk.x) + s1 * bfhi(kk.x) + s2 * bflo(kk.y) + s3 * bfhi(kk.y));
      s0 = s0 - s0 * bflo(dd.x) + sa * bflo(bb.x) + v * bflo(kt.x); s1 = s1 - s1 * bfhi(dd.x) + sa * bfhi(bb.x) + v * bfhi(kt.x);
      s2 = s2 - s2 * bflo(dd.y) + sa * bflo(bb.y) + v * bflo(kt.y); s3 = s3 - s3 * bfhi(dd.y) + sa * bfhi(bb.y) + v * bfhi(kt.y);
      float y = row16_sum(s0 * bflo(r.x) + s1 * bfhi(r.x) + s2 * bflo(r.y) + s3 * bfhi(r.y));
      if ((lane & 15) == 0) YS[o + row] = y;
    }
    if (!g.isden) { float* so = p.out + (dir ? OUT_SB : OUT_SF) + ((((size_t)(g.b0 + sq) * NL + l) * 8 + h) * 64 + row) * 64 + ks; *(float4*)so = make_float4(s0, s1, s2, s3); }
  }
}

__device__ __forceinline__ void stage_e3(const Params& p, const Grp& g, int l, int bid, int nb) {
  const int lane = threadIdx.x & 63, wid = threadIdx.x >> 6;
  char* ws = p.ws;
  const float* YS = (const float*)(ws + O_YS); const bf16_t* SV = (const bf16_t*)(ws + O_SV); const float* BON = (const float*)(ws + O_BON);
  const bf16_t* Z = (const bf16_t*)(ws + O_Z); bf16_t* O = (bf16_t*)(ws + O_OBR);
  for (int m = bid * 4 + wid; m < g.mg; m += nb * 4) {
#pragma unroll 2
    for (int i = 0; i < 8; ++i) {
      int c = lane + 64 * i;
      float o = YS[(size_t)m * 512 + c] + YS[((size_t)MG + m) * 512 + c];
      float mean = wave_sum(o) * (1.f / 64.f); float d = o - mean; float var = wave_sum(d * d) * (1.f / 64.f);
      float y = d * rsqrtf(var + 64e-5f) * p.ln_g[(size_t)l * 512 + c] + p.ln_b[(size_t)l * 512 + c] + BON[(size_t)m * 8 + i] * bf2f(SV[(size_t)m * 512 + c]);
      O[(size_t)m * 512 + c] = f2bf(y * siluf_(bf2f(Z[(size_t)m * IN_W + ZC_GA + c])));
    }
  }
}

__device__ __forceinline__ void stage_g8(const Params& p, const Grp& g, int l, int bid, int nb, char* smem) {
  char* ws = p.ws;
  bf16_t* MGD = (bf16_t*)(ws + O_MERGED);
  const bf16_t* H = (const bf16_t*)(ws + O_H);
  const int TM = (g.mg + 127) / 128, mg = g.mg;
  for (int t = bid; t < TM * 16; t += nb) {
    int tn = t / TM, tm = t % TM;
    f4v macc[4][2]; zero_acc<2>(macc);
    for (int n = 0; n < 4; ++n) {
      f4v ag[4][2]; zero_acc<2>(ag);
      gemm_mainloop<2>(H, 1024, tm * 128, mg, (const bf16_t*)(ws + O_WMT) + (size_t)n * 1024 * 1024, 1024, tn * 64, 1024, 1024, smem, ag);
      const float* bm = p.b_merge + (size_t)l * 4096 + n * 1024;
      {
        const int lane = threadIdx.x & 63, wn = (threadIdx.x >> 6) & 1;
#pragma unroll
        for (int i = 0; i < 4; ++i)
#pragma unroll
          for (int j = 0; j < 2; ++j) { float bb = bm[tn * 64 + wn * 32 + j * 16 + (lane & 15)];
#pragma unroll
            for (int e = 0; e < 4; ++e) ag[i][j][e] = sigmoidf_(ag[i][j][e] + bb); }
      }
      f4v ap[4][2]; zero_acc<2>(ap);
      gemm_mainloop<2>((const bf16_t*)(ws + O_OBR) + (size_t)n * MG * 512, 512, tm * 128, mg, (const bf16_t*)(ws + O_WBRT) + (size_t)n * 1024 * 512, 512, tn * 64, 1024, 512, smem, ap);
#pragma unroll
      for (int i = 0; i < 4; ++i)
#pragma unroll
        for (int j = 0; j < 2; ++j)
#pragma unroll
          for (int e = 0; e < 4; ++e) macc[i][j][e] += ag[i][j][e] * ap[i][j][e];
    }
    epi_foreach<2>(macc, tm * 128, tn * 64, [&](int rb, int col, f4v v) {
#pragma unroll
      for (int e = 0; e < 4; ++e) if (rb + e < mg) MGD[(size_t)(rb + e) * 1024 + col] = f2bf(v[e]);
    });
  }
}

__device__ __forceinline__ void stage_g9(const Params& p, const Grp& g, int l, int bid, int nb, char* smem) {
  char* ws = p.ws;
  float* X = p.out + (size_t)g.m0 * 1024;
  const float* modp = (const float*)(ws + O_MOD) + (size_t)l * 3 * 3072 + 2048;
  const int TM = (g.mg + 127) / 128, mg = g.mg;
  for (int t = bid; t < TM * 8; t += nb) {
    int tn = t / TM, tm = t % TM;
    f4v acc[4][4]; zero_acc<4>(acc);
    gemm_mainloop<4>((const bf16_t*)(ws + O_MERGED), 1024, tm * 128, mg, (const bf16_t*)(ws + O_WOUTT), 1024, tn * 128, 1024, 1024, smem, acc);
    epi_foreach<4>(acc, tm * 128, tn * 128, [&](int rb, int col, f4v v) {
#pragma unroll
      for (int e = 0; e < 4; ++e) { int row = rb + e; if (row < mg) { float gt = modp[(size_t)mod_index(g, row) * 3072 + col]; X[(size_t)row * 1024 + col] += gt * v[e]; } }
    });
  }
}

__device__ __forceinline__ void stage_final(const Params& p, int bid, int nb) {
  const int lane = threadIdx.x & 63, wid = threadIdx.x >> 6;
  for (int m = bid * 4 + wid; m < M; m += nb * 4) {
    float* xr = p.out + (size_t)m * 1024; float4 q[4]; float ss = 0.f;
#pragma unroll
    for (int i = 0; i < 4; ++i) { q[i] = *(const float4*)(xr + i * 256 + lane * 4); ss += q[i].x * q[i].x + q[i].y * q[i].y + q[i].z * q[i].z + q[i].w * q[i].w; }
    ss = wave_sum(ss); float rs = rsqrtf(ss * (1.f / 1024.f) + 1e-6f);
#pragma unroll
    for (int i = 0; i < 4; ++i) { int c = i * 256 + lane * 4; float4 gm = *(const float4*)(p.final_g + c);
      *(float4*)(xr + c) = make_float4(q[i].x * rs * gm.x, q[i].y * rs * gm.y, q[i].z * rs * gm.z, q[i].w * rs * gm.w); }
  }
}

#ifdef EMU
#define DECL_SMEM(name) char* name = emu::smem()
#else
#define DECL_SMEM(name) __shared__ __attribute__((aligned(16))) char name[SMEM_BYTES]
#endif

enum { ST_PREP = 0, ST_H, ST_G1, ST_E1, ST_G2, ST_E2, ST_ATT, ST_SCAN, ST_E3, ST_G8, ST_G9, ST_FINAL };

__device__ __forceinline__ void run_stage(const Params& p, int st, int l, int gi, int bid, int nb, char* smem) {
  Grp g = get_grp(gi);
  switch (st) {
    case ST_PREP: stage_prep(p, l, bid, nb, smem); break;
    case ST_H: stage_h(p, g, l, bid, nb); break;
    case ST_G1: stage_g1(p, g, bid, nb, smem); break;
    case ST_E1: stage_e1(p, g, l, bid, nb); break;
    case ST_G2: stage_g2(p, g, l, bid, nb, smem); break;
    case ST_E2: stage_e2(p, g, l, bid, nb); break;
    case ST_ATT: stage_att(p, g, bid, nb, smem); break;
    case ST_SCAN: stage_scan(p, g, l, bid, nb); break;
    case ST_E3: stage_e3(p, g, l, bid, nb); break;
    case ST_G8: stage_g8(p, g, l, bid, nb, smem); break;
    case ST_G9: stage_g9(p, g, l, bid, nb, smem); break;
    case ST_FINAL: stage_final(p, bid, nb); break;
  }
}

template <int ST>
__global__ void __launch_bounds__(256) stage_kernel(Params p, int l, int gi) {
  DECL_SMEM(smem);
  run_stage(p, ST, l, gi, blockIdx.x, gridDim.x, smem);
}

#ifdef EMU
#define LAUNCH_STAGE(ST, grid, l, gi) emu_launch(dim3(grid), dim3(256), [=]() { stage_kernel<ST>(p, l, gi); })
#else
#define LAUNCH_STAGE(ST, grid, l, gi) stage_kernel<ST><<<dim3(grid), dim3(256), 0, stream>>>(p, l, gi)
#endif

extern "C" void kernel_launch(void* const* d_in, const int* in_sizes, int n_in, void* d_out, int out_size, void* d_ws, size_t ws_size,
                              hipStream_t stream) {
  Params p{};
  const float** pp = (const float**)&p;
  for (int i = 0; i < 35; ++i) pp[i] = (const float*)d_in[i];
  p.out = (float*)d_out; p.ws = (char*)d_ws;
#ifdef EMU
  const int G = 16;
#else
  const int G = 1024;
#endif
  for (int l = 0; l < NL; ++l) {
    LAUNCH_STAGE(ST_PREP, G, l, 0);
    for (int gi = 0; gi < NGRP; ++gi) {
      LAUNCH_STAGE(ST_H, G, l, gi);
      LAUNCH_STAGE(ST_G1, G, l, gi);
      LAUNCH_STAGE(ST_E1, G, l, gi);
      LAUNCH_STAGE(ST_G2, G, l, gi);
      LAUNCH_STAGE(ST_E2, G, l, gi);
      LAUNCH_STAGE(ST_ATT, G, l, gi);
      LAUNCH_STAGE(ST_SCAN, G, l, gi);
      LAUNCH_STAGE(ST_E3, G, l, gi);
      LAUNCH_STAGE(ST_G8, G, l, gi);
      LAUNCH_STAGE(ST_G9, G, l, gi);
    }
  }
  LAUNCH_STAGE(ST_FINAL, G, 0, 0);
  (void)in_sizes; (void)n_in; (void)out_size; (void)ws_size;
}
```

```cpp
#ifdef EMU
#include "hip_emu.h"
#else
#include <hip/hip_runtime.h>
#include <hip/hip_cooperative_groups.h>
#endif
#include <stdint.h>

#ifndef CFG_BATCH
#define CFG_BATCH 32
#define CFG_SEQ 256
#define CFG_DEC_BATCH 2
#define CFG_DEC_SEQ 2048
#define CFG_PAST 512
#define CFG_NGRP_C 2
#endif
constexpr int D = 1024, NL = 2;
constexpr int NB_C = CFG_BATCH, T_C = CFG_SEQ, NB_D = CFG_DEC_BATCH, T_D = CFG_DEC_SEQ, PAST = CFG_PAST;
constexpr int M_C = NB_C * T_C, M_D = NB_D * T_D, M = M_C + M_D;
constexpr int NGRP_C = CFG_NGRP_C, NGRP = 1 + NGRP_C;
constexpr int MGC = M_C / NGRP_C, SEQ_PER_CG = NB_C / NGRP_C;
constexpr int MG = MGC > M_D ? MGC : M_D;
constexpr int MKV = MG + NB_D * PAST;
constexpr int KEYS_D = T_D + PAST;
constexpr int IN_W = 5728;
constexpr int ZC_R = 0, ZC_K = 512, ZC_V = 1024, ZC_WDF = 1536, ZC_GA = 1728, ZC_QD = 2240, ZC_KVD = 2496, ZC_KR = 2624,
              ZC_GB = 2656, ZC_U = 3168, ZC_VC = 3680, ZC_GC = 4192, ZC_F = 4704, ZC_GD = 5216;
constexpr int SHIFT_W = 1728;
static_assert(M_C % NGRP_C == 0 && NB_C % NGRP_C == 0, "ctx groups");
static_assert(T_C % 128 == 0 && T_D % 128 == 0 && PAST % 32 == 0, "seq multiples");

typedef unsigned short bf16_t;
typedef short s8v __attribute__((ext_vector_type(8)));
typedef float f4v __attribute__((ext_vector_type(4)));
typedef float f16v __attribute__((ext_vector_type(16)));
typedef unsigned u4v __attribute__((ext_vector_type(4)));
typedef unsigned u2v __attribute__((ext_vector_type(2)));

struct Params {
  const float *x_prompt, *x_sample, *st_f, *st_b, *c_ckv, *c_kr, *c, *c_ctx, *norm_g, *w_ada, *b_ada, *w_in, *shift_mu, *w0, *w_up,
      *a0, *a_up, *k_k, *k_a, *r_k, *ln_g, *ln_b, *q_norm, *w_q_up, *kv_norm, *w_kv_up, *g_ln_g, *g_ln_b, *g_w_s, *g_b_s, *w_branch,
      *w_merge, *b_merge, *w_out, *final_g;
  float* out;
  char* ws;
};

struct Grp { int isden, m0, mg, nseq, T, b0, nkeys, mkv; };
__host__ __device__ __forceinline__ Grp get_grp(int gi) {
  Grp g;
  if (gi == 0) { g.isden = 1; g.m0 = M_C; g.mg = M_D; g.nseq = NB_D; g.T = T_D; g.b0 = 0; g.nkeys = KEYS_D; g.mkv = M_D + NB_D * PAST; }
  else { g.isden = 0; g.m0 = (gi - 1) * MGC; g.mg = MGC; g.nseq = SEQ_PER_CG; g.T = T_C; g.b0 = (gi - 1) * SEQ_PER_CG; g.nkeys = T_C; g.mkv = MGC; }
  return g;
}

constexpr size_t al256(size_t x) { return (x + 255) & ~(size_t)255; }
constexpr size_t O_WINT = 0;
constexpr size_t O_WMT = O_WINT + al256((size_t)IN_W * 1024 * 2);
constexpr size_t O_WBRT = O_WMT + al256((size_t)4096 * 1024 * 2);
constexpr size_t O_WOUTT = O_WBRT + al256((size_t)4 * 1024 * 512 * 2);
constexpr size_t O_WQT = O_WOUTT + al256((size_t)1024 * 1024 * 2);
constexpr size_t O_WKVT = O_WQT + al256((size_t)768 * 256 * 2);
constexpr size_t O_WUPT = O_WKVT + al256((size_t)1024 * 128 * 2);
constexpr size_t O_WS = O_WUPT + al256((size_t)4 * 512 * 64 * 2);
constexpr size_t O_CS128 = O_WS + al256((size_t)4 * 128 * 128 * 2);
constexpr size_t O_A2C = O_CS128 + al256((size_t)256 * 128 * 2);
constexpr size_t O_A2D = O_A2C + al256((size_t)T_C * 2 * T_C * 2);
constexpr size_t O_ROPE = O_A2D + al256((size_t)T_D * 2 * T_D * 2);
constexpr size_t O_MOD = O_ROPE + al256((size_t)T_D * 32 * 4);
constexpr size_t O_H = O_MOD + al256((size_t)NL * 3 * 3072 * 4);
constexpr size_t O_Z = O_H + al256((size_t)MG * 1024 * 2);
constexpr size_t O_SR = O_Z + al256((size_t)MG * IN_W * 2);
constexpr size_t O_SK = O_SR + al256((size_t)MG * 512 * 2);
constexpr size_t O_SV = O_SK + al256((size_t)MG * 512 * 2);
constexpr size_t O_SKK = O_SV + al256((size_t)MG * 512 * 2);
constexpr size_t O_SD = O_SKK + al256((size_t)MG * 512 * 2);
constexpr size_t O_SB = O_SD + al256((size_t)2 * MG * 512 * 2);
constexpr size_t O_SKT = O_SB + al256((size_t)2 * MG * 512 * 2);
constexpr size_t O_YS = O_SKT + al256((size_t)2 * MG * 512 * 2);
constexpr size_t O_BON = O_YS + al256((size_t)2 * MG * 512 * 4);
constexpr size_t O_LORA = O_BON + al256((size_t)MG * 8 * 4);
constexpr size_t O_PRE = O_LORA + al256((size_t)MG * 192 * 2);
constexpr size_t O_QDN = O_PRE + al256((size_t)MG * 2048 * 2);
constexpr size_t O_CKV = O_QDN + al256((size_t)MG * 256 * 2);
constexpr size_t O_KR = O_CKV + al256((size_t)MKV * 128 * 2);
constexpr size_t O_Q = O_KR + al256((size_t)MKV * 32 * 2);
constexpr size_t O_KN = O_Q + al256((size_t)MG * 768 * 2);
constexpr size_t O_VT = O_KN + al256((size_t)MKV * 512 * 2);
constexpr size_t O_VCNT = O_VT + al256((size_t)MKV * 512 * 2);
constexpr size_t O_YT = O_VCNT + al256((size_t)MG * 512 * 2);
constexpr size_t O_OBR = O_YT + al256((size_t)MG * 1024 * 2);
constexpr size_t O_MERGED = O_OBR + al256((size_t)4 * MG * 512 * 2);
constexpr size_t O_END = O_MERGED + al256((size_t)MG * 1024 * 2);
static_assert(O_END <= ((size_t)256 << 20), "workspace must fit 256 MiB");

constexpr size_t OUT_SF = (size_t)M * D, OUT_SB = OUT_SF + (size_t)NB_C * NL * 8 * 64 * 64,
                 OUT_CKV = OUT_SB + (size_t)NB_C * NL * 8 * 64 * 64, OUT_KR = OUT_CKV + (size_t)NB_C * NL * T_C * 128;

__device__ __forceinline__ unsigned f_as_u(float f) { return __builtin_bit_cast(unsigned, f); }
__device__ __forceinline__ float u_as_f(unsigned u) { return __builtin_bit_cast(float, u); }
__device__ __forceinline__ bf16_t f2bf(float f) { unsigned u = f_as_u(f); u += 0x7FFFu + ((u >> 16) & 1u); return (bf16_t)(u >> 16); }
__device__ __forceinline__ float bf2f(bf16_t h) { return u_as_f(((unsigned)h) << 16); }
__device__ __forceinline__ float bflo(unsigned u) { return u_as_f(u << 16); }
__device__ __forceinline__ float bfhi(unsigned u) { return u_as_f(u & 0xFFFF0000u); }
__device__ __forceinline__ float sigmoidf_(float x) { return 1.f / (1.f + expf(-x)); }
__device__ __forceinline__ float siluf_(float x) { return x / (1.f + expf(-x)); }
__device__ __forceinline__ float geluf_(float x) { return 0.5f * x * (1.f + tanhf(0.7978845608028654f * (x + 0.044715f * x * x * x))); }
__device__ __forceinline__ float wave_sum(float v) {
#pragma unroll
  for (int o = 32; o >= 1; o >>= 1) v += __shfl_xor(v, o);
  return v;
}

constexpr int LDS_STR = 72;
constexpr int SMEM_BYTES = 65536;

template <int NJ>
__device__ __forceinline__ void zero_acc(f4v (&acc)[4][NJ]) {
#pragma unroll
  for (int i = 0; i < 4; ++i)
#pragma unroll
    for (int j = 0; j < NJ; ++j) acc[i][j] = f4v{0.f, 0.f, 0.f, 0.f};
}

template <int NJ>
__device__ __forceinline__ void gemm_mainloop(const bf16_t* __restrict__ A, long lda, int arow0, int arows, const bf16_t* __restrict__ B,
                                              long ldb, int brow0, int brows, int K, char* smem, f4v (&acc)[4][NJ]) {
  bf16_t* sA = (bf16_t*)smem;
  bf16_t* sB = sA + 128 * LDS_STR;
  const int tid = threadIdx.x, lane = tid & 63, wid = tid >> 6, wm = wid >> 1, wn = wid & 1;
  for (int k0 = 0; k0 < K; k0 += 64) {
    u4v ra[4], rb[NJ];
#pragma unroll
    for (int i = 0; i < 4; ++i) {
      int c = tid + 256 * i, r = c >> 3, cc = c & 7;
      int ar = arow0 + r; ar = ar < arows ? ar : arows - 1;
      ra[i] = *(const u4v*)(A + (long)ar * lda + k0 + cc * 8);
    }
#pragma unroll
    for (int i = 0; i < NJ; ++i) {
      int c = tid + 256 * i, r = c >> 3, cc = c & 7;
      int br = brow0 + r; br = br < brows ? br : brows - 1;
      rb[i] = *(const u4v*)(B + (long)br * ldb + k0 + cc * 8);
    }
    __syncthreads();
#pragma unroll
    for (int i = 0; i < 4; ++i) { int c = tid + 256 * i, r = c >> 3, cc = c & 7; *(u4v*)(sA + r * LDS_STR + cc * 8) = ra[i]; }
#pragma unroll
    for (int i = 0; i < NJ; ++i) { int c = tid + 256 * i, r = c >> 3, cc = c & 7; *(u4v*)(sB + r * LDS_STR + cc * 8) = rb[i]; }
    __syncthreads();
#pragma unroll
    for (int ks = 0; ks < 2; ++ks) {
      s8v af[4], bf[NJ];
#pragma unroll
      for (int i = 0; i < 4; ++i) af[i] = *(const s8v*)(sA + (wm * 64 + i * 16 + (lane & 15)) * LDS_STR + ks * 32 + (lane >> 4) * 8);
#pragma unroll
      for (int j = 0; j < NJ; ++j) bf[j] = *(const s8v*)(sB + (wn * NJ * 16 + j * 16 + (lane & 15)) * LDS_STR + ks * 32 + (lane >> 4) * 8);
#pragma unroll
      for (int i = 0; i < 4; ++i)
#pragma unroll
        for (int j = 0; j < NJ; ++j) acc[i][j] = __builtin_amdgcn_mfma_f32_16x16x32_bf16(af[i], bf[j], acc[i][j], 0, 0, 0);
    }
  }
}

template <int NJ, class F>
__device__ __forceinline__ void epi_foreach(f4v (&acc)[4][NJ], int row0, int col0, F f) {
  const int tid = threadIdx.x, lane = tid & 63, wid = tid >> 6, wm = wid >> 1, wn = wid & 1;
#pragma unroll
  for (int i = 0; i < 4; ++i)
#pragma unroll
    for (int j = 0; j < NJ; ++j) f(row0 + wm * 64 + i * 16 + (lane >> 4) * 4, col0 + wn * NJ * 16 + j * 16 + (lane & 15), acc[i][j]);
}

struct TJob { const float* src; int K, N; long lds; bf16_t* dst; long ldd; };
__device__ __forceinline__ TJob get_tjob(const Params& p, int l, int j) {
  TJob t; char* ws = p.ws;
  if (j == 0) { t.src = p.w_in + (size_t)l * 1024 * IN_W; t.K = 1024; t.N = IN_W; t.lds = IN_W; t.dst = (bf16_t*)(ws + O_WINT); t.ldd = 1024; }
  else if (j == 1) { t.src = p.w_merge + (size_t)l * 1024 * 4096; t.K = 1024; t.N = 4096; t.lds = 4096; t.dst = (bf16_t*)(ws + O_WMT); t.ldd = 1024; }
  else if (j < 6) { int n = j - 2; t.src = p.w_branch + ((size_t)l * 4 + n) * 512 * 1024; t.K = 512; t.N = 1024; t.lds = 1024; t.dst = (bf16_t*)(ws + O_WBRT) + (size_t)n * 1024 * 512; t.ldd = 512; }
  else if (j == 6) { t.src = p.w_out + (size_t)l * 1024 * 1024; t.K = 1024; t.N = 1024; t.lds = 1024; t.dst = (bf16_t*)(ws + O_WOUTT); t.ldd = 1024; }
  else if (j == 7) { t.src = p.w_q_up + (size_t)l * 256 * 768; t.K = 256; t.N = 768; t.lds = 768; t.dst = (bf16_t*)(ws + O_WQT); t.ldd = 256; }
  else if (j == 8) { t.src = p.w_kv_up + (size_t)l * 128 * 1024; t.K = 128; t.N = 1024; t.lds = 1024; t.dst = (bf16_t*)(ws + O_WKVT); t.ldd = 128; }
  else { int n = j - 9;
    t.src = (n < 2 ? p.w_up : p.a_up) + ((size_t)l * 2 + (n & 1)) * 64 * 512; t.K = 64; t.N = 512; t.lds = 512;
    t.dst = (bf16_t*)(ws + O_WUPT) + (size_t)n * 512 * 64; t.ldd = 64; }
  return t;
}
constexpr int NTJOBS = 13;

__device__ __forceinline__ void stage_prep(const Params& p, int l, int bid, int nb, char* smem) {
  const int tid = threadIdx.x;
  char* ws = p.ws;
  {
    float* tile = (float*)smem;
    long base = 0;
    for (int j = 0; j < NTJOBS; ++j) {
      TJob t = get_tjob(p, l, j);
      int tk = t.K / 32, tn = t.N / 32, nt = tk * tn;
      long first = ((bid - base) % nb + nb) % nb;
      for (long q = first; q < nt; q += nb) {
        int kt = (int)(q / tn), nt_ = (int)(q % tn);
        __syncthreads();
#pragma unroll
        for (int i = 0; i < 4; ++i) { int e = tid + 256 * i, r = e >> 5, c = e & 31; tile[r * 33 + c] = t.src[(long)(kt * 32 + r) * t.lds + nt_ * 32 + c]; }
        __syncthreads();
#pragma unroll
        for (int i = 0; i < 4; ++i) { int e = tid + 256 * i, r = e >> 5, c = e & 31; t.dst[(long)(nt_ * 32 + r) * t.ldd + kt * 32 + c] = f2bf(tile[c * 33 + r]); }
      }
      base += nt;
    }
    __syncthreads();
  }
  const long gtid = (long)bid * 256 + tid, gn = (long)nb * 256;
  { bf16_t* d = (bf16_t*)(ws + O_WS); const float* s = p.g_w_s + (size_t)l * 4 * 128 * 128; for (long i = gtid; i < (long)4 * 128 * 128; i += gn) d[i] = f2bf(s[i]); }
  if (l != 0) return;
  { bf16_t* d = (bf16_t*)(ws + O_CS128);
    for (long i = gtid; i < 256 * 128; i += gn) { int j = (int)(i >> 7), c = (int)(i & 127); int mm = ((j & 127) * c) & 127; float x = 2.0f * mm / 128.f; d[i] = f2bf(j < 128 ? cospif(x) : sinpif(x)); } }
  { bf16_t* d = (bf16_t*)(ws + O_A2C);
    for (long i = gtid; i < (long)T_C * 2 * T_C; i += gn) { int tp = (int)(i / (2 * T_C)), tt = (int)(i % (2 * T_C)); int half = tt >= T_C; int t = half ? tt - T_C : tt; int mm = (int)(((long)tp * t) % T_C); float x = 2.0f * mm / (float)T_C; d[i] = f2bf(half ? -sinpif(x) : cospif(x)); } }
  { bf16_t* d = (bf16_t*)(ws + O_A2D);
    for (long i = gtid; i < (long)T_D * 2 * T_D; i += gn) { int tp = (int)(i / (2 * T_D)), tt = (int)(i % (2 * T_D)); int half = tt >= T_D; int t = half ? tt - T_D : tt; int mm = (int)(((long)tp * t) % T_D); float x = 2.0f * mm / (float)T_D; d[i] = f2bf(half ? -sinpif(x) : cospif(x)); } }
  { float* d = (float*)(ws + O_ROPE);
    for (long i = gtid; i < (long)T_D * 16; i += gn) { int t = (int)(i >> 4), pi = (int)(i & 15); float pos = (pi < 8) ? (float)(t / 64) : (float)(t % 64); float inv = expf(-(float)(pi & 7) * (9.210340371976184f / 8.f)); float a = pos * inv; d[2 * i] = cosf(a); d[2 * i + 1] = sinf(a); } }
  { float4* d = (float4*)p.out; const float4* s0 = (const float4*)p.x_prompt; const float4* s1 = (const float4*)p.x_sample;
    for (long i = gtid; i < (long)M * 256; i += gn) d[i] = (i < (long)M_C * 256) ? s0[i] : s1[i - (long)M_C * 256]; }
  {
    float* red = (float*)smem;
    float* modp = (float*)(ws + O_MOD);
    for (int u = bid; u < NL * 48; u += nb) {
      int ll = u / 48, cg = u % 48; int col = cg * 64 + (tid & 63), kq = tid >> 6;
      float a0 = 0.f, a1 = 0.f, a2 = 0.f;
      const float* w = p.w_ada + (size_t)ll * 1024 * 3072 + col;
      for (int k = kq * 256; k < kq * 256 + 256; ++k) {
        float wv = w[(size_t)k * 3072];
        a0 += siluf_(p.c_ctx[k]) * wv; a1 += siluf_(p.c[k]) * wv; a2 += siluf_(p.c[(NB_D > 1 ? 1024 : 0) + k]) * wv;
      }
      __syncthreads();
      red[(kq * 3 + 0) * 64 + (tid & 63)] = a0; red[(kq * 3 + 1) * 64 + (tid & 63)] = a1; red[(kq * 3 + 2) * 64 + (tid & 63)] = a2;
      __syncthreads();
      if (tid < 192) { int mi = tid >> 6, cc = tid & 63; float s = red[(0 * 3 + mi) * 64 + cc] + red[(1 * 3 + mi) * 64 + cc] + red[(2 * 3 + mi) * 64 + cc] + red[(3 * 3 + mi) * 64 + cc];
        modp[((size_t)ll * 3 + mi) * 3072 + cg * 64 + cc] = s + p.b_ada[(size_t)ll * 3072 + cg * 64 + cc]; }
    }
  }
}

__device__ __forceinline__ int mod_index(const Grp& g, int lm) { return g.isden ? 1 + lm / T_D : 0; }

__device__ __forceinline__ void stage_h(const Params& p, const Grp& g, int l, int bid, int nb) {
  const int lane = threadIdx.x & 63, wid = threadIdx.x >> 6;
  const float* X = p.out + (size_t)g.m0 * 1024;
  bf16_t* H = (bf16_t*)(p.ws + O_H);
  const float* modp = (const float*)(p.ws + O_MOD) + (size_t)l * 3 * 3072;
  const float* gam = p.norm_g + (size_t)l * 1024;
  for (int m = bid * 4 + wid; m < g.mg; m += nb * 4) {
    const float* xr = X + (size_t)m * 1024; float v[16]; float ss = 0.f;
#pragma unroll
    for (int i = 0; i < 4; ++i) { float4 q = *(const float4*)(xr + i * 256 + lane * 4); v[4 * i] = q.x; v[4 * i + 1] = q.y; v[4 * i + 2] = q.z; v[4 * i + 3] = q.w; ss += q.x * q.x + q.y * q.y + q.z * q.z + q.w * q.w; }
    ss = wave_sum(ss); float rs = rsqrtf(ss * (1.f / 1024.f) + 1e-6f);
    const float* mo = modp + (size_t)mod_index(g, m) * 3072;
#pragma unroll
    for (int i = 0; i < 4; ++i) {
      int c = i * 256 + lane * 4; bf16_t o[4];
#pragma unroll
      for (int e = 0; e < 4; ++e) o[e] = f2bf(v[4 * i + e] * rs * gam[c + e] * (1.f + mo[1024 + c + e]) + mo[c + e]);
      *(uint2*)(H + (size_t)m * 1024 + c) = make_uint2((unsigned)o[0] | ((unsigned)o[1] << 16), (unsigned)o[2] | ((unsigned)o[3] << 16));
    }
  }
}

__device__ __forceinline__ void stage_g1(const Params& p, const Grp& g, int bid, int nb, char* smem) {
  const bf16_t* H = (const bf16_t*)(p.ws + O_H);
  const bf16_t* W = (const bf16_t*)(p.ws + O_WINT);
  bf16_t* Z = (bf16_t*)(p.ws + O_Z);
  const int TM = (g.mg + 127) / 128; constexpr int TN = (IN_W + 127) / 128;
  for (int t = bid; t < TM * TN; t += nb) {
    int tn = t / TM, tm = t % TM; f4v acc[4][4]; zero_acc<4>(acc);
    gemm_mainloop<4>(H, 1024, tm * 128, g.mg, W, 1024, tn * 128, IN_W, 1024, smem, acc);
    const int mg = g.mg;
    epi_foreach<4>(acc, tm * 128, tn * 128, [&](int rb, int col, f4v v) {
      if (col < IN_W) {
#pragma unroll
        for (int e = 0; e < 4; ++e) if (rb + e < mg) Z[(size_t)(rb + e) * IN_W + col] = f2bf(v[e]);
      }
    });
  }
}

__device__ __forceinline__ void stage_e1(const Params& p, const Grp& g, int l, int bid, int nb) {
  const int lane = threadIdx.x & 63, wid = threadIdx.x >> 6;
  char* ws = p.ws;
  const bf16_t* Z = (const bf16_t*)(ws + O_Z);
  bf16_t* SR = (bf16_t*)(ws + O_SR); bf16_t* SK = (bf16_t*)(ws + O_SK); bf16_t* SV = (bf16_t*)(ws + O_SV);
  bf16_t* LORA = (bf16_t*)(ws + O_LORA); bf16_t* QDN = (bf16_t*)(ws + O_QDN); bf16_t* CKV = (bf16_t*)(ws + O_CKV); bf16_t* KR = (bf16_t*)(ws + O_KR);
  bf16_t* VCNT = (bf16_t*)(ws + O_VCNT);
  const float* rope = (const float*)(ws + O_ROPE);
  const float* mu = p.shift_mu + (size_t)l * SHIFT_W;
  const int isden = g.isden, T = g.T;
  for (int m = bid * 4 + wid; m < g.mkv; m += nb * 4) {
    if (m >= g.mg) {
      int r = m - g.mg, b = r / PAST, j = r % PAST;
      const float* s = p.c_ckv + (((size_t)b * NL + l) * PAST + j) * 128;
      CKV[(size_t)m * 128 + lane] = f2bf(s[lane]); CKV[(size_t)m * 128 + 64 + lane] = f2bf(s[64 + lane]);
      if (lane < 32) KR[(size_t)m * 32 + lane] = f2bf(p.c_kr[(((size_t)b * NL + l) * PAST + j) * 32 + lane]);
      continue;
    }
    const int sq = m / T, t = m % T, b = g.b0 + sq;
    const bf16_t* z = Z + (size_t)m * IN_W;
    const bool hp = t > 0, hn = t < T - 1;
#pragma unroll 4
    for (int i = 0; i < 24; ++i) {
      int c = lane + 64 * i; float zc = bf2f(z[c]);
      float pv = hp ? bf2f(z[c - IN_W]) : 0.f, nv = hn ? bf2f(z[c + IN_W]) : 0.f;
      bf16_t s = f2bf(zc + (0.5f * (pv + nv) - zc) * mu[c]);
      if (i < 8) SR[(size_t)m * 512 + c] = s; else if (i < 16) SK[(size_t)m * 512 + c - 512] = s; else SV[(size_t)m * 512 + c - 1024] = s;
    }
#pragma unroll
    for (int i = 0; i < 3; ++i) {
      int c = ZC_WDF + lane + 64 * i; float zc = bf2f(z[c]);
      float pv = hp ? bf2f(z[c - IN_W]) : 0.f, nv = hn ? bf2f(z[c + IN_W]) : 0.f;
      float s = zc + (0.5f * (pv + nv) - zc) * mu[c];
      LORA[(size_t)m * 192 + lane + 64 * i] = f2bf(i < 2 ? tanhf(s) : s);
    }
    { float v[4]; float ss = 0.f;
#pragma unroll
      for (int i = 0; i < 4; ++i) { v[i] = bf2f(z[ZC_QD + lane + 64 * i]); ss += v[i] * v[i]; }
      ss = wave_sum(ss); float rs = rsqrtf(ss * (1.f / 256.f) + 1e-6f);
#pragma unroll
      for (int i = 0; i < 4; ++i) QDN[(size_t)m * 256 + lane + 64 * i] = f2bf(v[i] * rs * p.q_norm[(size_t)l * 256 + lane + 64 * i]); }
    { float v[2]; float ss = 0.f;
#pragma unroll
      for (int i = 0; i < 2; ++i) { v[i] = bf2f(z[ZC_KVD + lane + 64 * i]); ss += v[i] * v[i]; }
      ss = wave_sum(ss); float rs = rsqrtf(ss * (1.f / 128.f) + 1e-6f);
#pragma unroll
      for (int i = 0; i < 2; ++i) { float o = v[i] * rs * p.kv_norm[(size_t)l * 128 + lane + 64 * i];
        CKV[(size_t)m * 128 + lane + 64 * i] = f2bf(o);
        if (!isden) p.out[OUT_CKV + (((size_t)b * NL + l) * T_C + t) * 128 + lane + 64 * i] = o; } }
    { float v = lane < 32 ? bf2f(z[ZC_KR + (lane & 31)]) : 0.f; float pr = __shfl_xor(v, 1); float o = v;
      if (isden) { int pi = (lane & 31) >> 1; float cs = rope[((size_t)t * 16 + pi) * 2], sn = rope[((size_t)t * 16 + pi) * 2 + 1];
        o = (lane & 1) ? (pr * sn + v * cs) : (v * cs - pr * sn); }
      if (lane < 32) { KR[(size_t)m * 32 + lane] = f2bf(o); if (!isden) p.out[OUT_KR + (((size_t)b * NL + l) * T_C + t) * 32 + lane] = v; } }
    { float v[8]; float s1 = 0.f;
#pragma unroll
      for (int i = 0; i < 8; ++i) { v[i] = geluf_(bf2f(z[ZC_VC + lane + 64 * i])); s1 += v[i]; }
      s1 = wave_sum(s1); float mean = s1 * (1.f / 512.f); float s2 = 0.f;
#pragma unroll
      for (int i = 0; i < 8; ++i) { float d = v[i] - mean; s2 += d * d; }
      s2 = wave_sum(s2); float rs = rsqrtf(s2 * (1.f / 512.f) + 1e-5f);
#pragma unroll
      for (int i = 0; i < 8; ++i) { int ch = lane + 64 * i; float o = (v[i] - mean) * rs * p.g_ln_g[(size_t)l * 512 + ch] + p.g_ln_b[(size_t)l * 512 + ch];
        VCNT[(((size_t)(m >> 7) * 4 + (ch >> 7)) * 128 + (ch & 127)) * 128 + (m & 127)] = f2bf(o); } }
  }
}

__device__ __forceinline__ void stage_g2(const Params& p, const Grp& g, int l, int bid, int nb, char* smem) {
  char* ws = p.ws;
  const bf16_t* Z = (const bf16_t*)(ws + O_Z);
  const float* rope = (const float*)(ws + O_ROPE);
  const int mg = g.mg, mkv = g.mkv, T = g.T, isden = g.isden, nkeys = g.nkeys;
  const int TM_M = (mg + 127) / 128, TM_KV = (mkv + 127) / 128;
  const int NT_Q = TM_M * 6, NT_KV = TM_KV * 8, NT_LORA = TM_M * 16, NT_GM = (mg / 128) * 4, ntt = T / 128, NT_D1 = g.nseq * 8 * ntt;
  const int NT = NT_Q + NT_KV + NT_LORA + NT_GM + NT_D1;
  for (int t0 = bid; t0 < NT; t0 += nb) {
    int t = t0; f4v acc[4][4]; zero_acc<4>(acc);
    if (t < NT_Q) {
      int tn = t / TM_M, tm = t % TM_M;
      gemm_mainloop<4>((const bf16_t*)(ws + O_QDN), 256, tm * 128, mg, (const bf16_t*)(ws + O_WQT), 256, tn * 128, 768, 256, smem, acc);
      bf16_t* Q = (bf16_t*)(ws + O_Q);
      const float scale = 0.10206207261596575f;
      epi_foreach<4>(acc, tm * 128, tn * 128, [&](int rb, int col, f4v v) {
        int cw = col % 96; bool isr = cw >= 64; int pi = (cw - 64) >> 1;
#pragma unroll
        for (int e = 0; e < 4; ++e) {
          int row = rb + e; float x = v[e]; float pr = __shfl_xor(x, 1); float o = x;
          if (isr && isden && row < mg) { int tt = row % T_D; float cs = rope[((size_t)tt * 16 + pi) * 2], sn = rope[((size_t)tt * 16 + pi) * 2 + 1];
            o = (col & 1) ? (pr * sn + x * cs) : (x * cs - pr * sn); }
          if (row < mg) Q[(size_t)row * 768 + col] = f2bf(o * scale);
        }
      });
      continue;
    }
    t -= NT_Q;
    if (t < NT_KV) {
      int tn = t / TM_KV, tm = t % TM_KV;
      gemm_mainloop<4>((const bf16_t*)(ws + O_CKV), 128, tm * 128, mkv, (const bf16_t*)(ws + O_WKVT), 128, tn * 128, 1024, 128, smem, acc);
      bf16_t* KN = (bf16_t*)(ws + O_KN); bf16_t* VT = (bf16_t*)(ws + O_VT);
      epi_foreach<4>(acc, tm * 128, tn * 128, [&](int rb, int col, f4v v) {
        int h = col >> 7, w = col & 127;
#pragma unroll
        for (int e = 0; e < 4; ++e) {
          int row = rb + e; if (row >= mkv) continue;
          if (w < 64) KN[(size_t)row * 512 + h * 64 + w] = f2bf(v[e]);
          else { int dv = w - 64; int sq, key;
            if (row < mg) { sq = row / T; key = row % T; } else { int r = row - mg; sq = r / PAST; key = T + r % PAST; }
            VT[(((size_t)sq * 8 + h) * 64 + dv) * nkeys + key] = f2bf(v[e]); }
        }
      });
      continue;
    }
    t -= NT_KV;
    if (t < NT_LORA) {
      int g4 = t / (TM_M * 4), r = t % (TM_M * 4), tn = r / TM_M, tm = r % TM_M;
      int koff = g4 == 0 ? 0 : (g4 == 1 ? 64 : 128);
      gemm_mainloop<4>((const bf16_t*)(ws + O_LORA) + koff, 192, tm * 128, mg, (const bf16_t*)(ws + O_WUPT) + (size_t)g4 * 512 * 64, 64, tn * 128, 512, 64, smem, acc);
      bf16_t* PRE = (bf16_t*)(ws + O_PRE);
      const float* bias = (g4 < 2 ? p.w0 : p.a0) + ((size_t)l * 2 + (g4 & 1)) * 512;
      epi_foreach<4>(acc, tm * 128, tn * 128, [&](int rb, int col, f4v v) {
        float bb = bias[col];
#pragma unroll
        for (int e = 0; e < 4; ++e) if (rb + e < mg) PRE[((size_t)(rb + e) * 4 + g4) * 512 + col] = f2bf(v[e] + bb);
      });
      continue;
    }
    t -= NT_LORA;
    if (t < NT_GM) {
      int ch = t >> 2, gg = t & 3;
      gemm_mainloop<4>((const bf16_t*)(ws + O_WS) + (size_t)gg * 128 * 128, 128, 0, 128, (const bf16_t*)(ws + O_VCNT) + ((size_t)ch * 4 + gg) * 128 * 128, 128, 0, 128, 128, smem, acc);
      bf16_t* O = (bf16_t*)(ws + O_OBR) + (size_t)2 * MG * 512;
      const float* bs = p.g_b_s + ((size_t)l * 4 + gg) * 128;
      epi_foreach<4>(acc, 0, 0, [&](int rb, int col, f4v v) {
#pragma unroll
        for (int e = 0; e < 4; ++e) { int pp = rb + e; int m = ch * 128 + pp; int c = gg * 128 + col;
          float u = geluf_(bf2f(Z[(size_t)m * IN_W + ZC_U + c])); float gc = siluf_(bf2f(Z[(size_t)m * IN_W + ZC_GC + c]));
          O[(size_t)m * 512 + c] = f2bf(u * (v[e] + bs[pp]) * gc); }
      });
      continue;
    }
    t -= NT_GM;
    {
      int per_seq = 8 * ntt; int sq = t / per_seq; int r = t % per_seq; int gg = r / (2 * ntt); int r2 = r % (2 * ntt); int tj = r2 / ntt, tt = r2 % ntt;
      long mbase = (long)sq * T;
      gemm_mainloop<4>((const bf16_t*)(ws + O_CS128), 128, tj * 128, 256, Z + (size_t)mbase * IN_W + ZC_F + gg * 128, IN_W, tt * 128, T, 128, smem, acc);
      bf16_t* YT = (bf16_t*)(ws + O_YT) + (size_t)mbase * 1024 + (size_t)gg * 128 * 2 * T;
      epi_foreach<4>(acc, tj * 128, tt * 128, [&](int rb, int col, f4v v) {
#pragma unroll
        for (int e = 0; e < 4; ++e) { int j = rb + e; YT[(size_t)(j & 127) * 2 * T + (size_t)(j >> 7) * T + col] = f2bf(v[e]); }
      });
    }
  }
}

__device__ __forceinline__ void stage_e2(const Params& p, const Grp& g, int l, int bid, int nb) {
  const int lane = threadIdx.x & 63, wid = threadIdx.x >> 6;
  char* ws = p.ws;
  const bf16_t* SR = (const bf16_t*)(ws + O_SR); const bf16_t* SK = (const bf16_t*)(ws + O_SK);
  bf16_t* SKK = (bf16_t*)(ws + O_SKK); bf16_t* SD = (bf16_t*)(ws + O_SD); bf16_t* SB = (bf16_t*)(ws + O_SB); bf16_t* SKT = (bf16_t*)(ws + O_SKT);
  float* BON = (float*)(ws + O_BON); const bf16_t* PRE = (const bf16_t*)(ws + O_PRE);
  for (int m = bid * 4 + wid; m < g.mg; m += nb * 4) {
#pragma unroll 2
    for (int i = 0; i < 8; ++i) {
      int c = lane + 64 * i;
      float k = bf2f(SK[(size_t)m * 512 + c]), r = bf2f(SR[(size_t)m * 512 + c]);
      float kr = k * p.k_k[(size_t)l * 512 + c];
      float n2 = wave_sum(kr * kr); float kk = kr / fmaxf(sqrtf(n2), 1e-12f);
      SKK[(size_t)m * 512 + c] = f2bf(kk);
      float bon = 0.f;
#pragma unroll
      for (int d = 0; d < 2; ++d) {
        float pw = bf2f(PRE[((size_t)m * 4 + d) * 512 + c]), pa = bf2f(PRE[((size_t)m * 4 + 2 + d) * 512 + c]);
        float dec = expf(-0.6065306597126334f * sigmoidf_(pw));
        float a = sigmoidf_(pa);
        float kt = k * (1.f + (a - 1.f) * p.k_a[(size_t)l * 512 + c]);
        SD[((size_t)d * MG + m) * 512 + c] = f2bf(1.f - dec); SB[((size_t)d * MG + m) * 512 + c] = f2bf(kk * a); SKT[((size_t)d * MG + m) * 512 + c] = f2bf(kt);
        bon += r * kt * p.r_k[(size_t)l * 512 + c];
      }
      bon = wave_sum(bon);
      if (lane == 0) BON[(size_t)m * 8 + i] = bon;
    }
  }
}

__device__ __forceinline__ void attention_item(const Params& p, const Grp& g, int sq, int h, int qb) {
  char* ws = p.ws;
  const int lane = threadIdx.x & 63, wid = threadIdx.x >> 6, ql = lane & 31, hh = lane >> 5;
  const int T = g.T, nkeys = g.nkeys;
  const long mbase = (long)sq * T;
  const bf16_t* Q = (const bf16_t*)(ws + O_Q); const bf16_t* KN = (const bf16_t*)(ws + O_KN); const bf16_t* KRp = (const bf16_t*)(ws + O_KR);
  const bf16_t* VT = (const bf16_t*)(ws + O_VT) + ((size_t)sq * 8 + h) * 64 * nkeys;
  const long mq = mbase + qb * 128 + wid * 32 + ql;
  s8v qf[6];
#pragma unroll
  for (int s = 0; s < 6; ++s) qf[s] = *(const s8v*)(Q + (size_t)mq * 768 + h * 96 + 16 * s + 8 * hh);
  f16v o0, o1;
#pragma unroll
  for (int i = 0; i < 16; ++i) { o0[i] = 0.f; o1[i] = 0.f; }
  float mrun = -1e30f, lrun = 0.f;
  for (int k0 = 0; k0 < nkeys; k0 += 32) {
    long krow = (k0 < T) ? mbase + k0 + ql : (long)g.mg + (long)sq * PAST + (k0 - T) + ql;
    f16v s;
#pragma unroll
    for (int i = 0; i < 16; ++i) s[i] = 0.f;
#pragma unroll
    for (int st = 0; st < 6; ++st) {
      s8v kf = (st < 4) ? *(const s8v*)(KN + (size_t)krow * 512 + h * 64 + 16 * st + 8 * hh) : *(const s8v*)(KRp + (size_t)krow * 32 + 16 * (st - 4) + 8 * hh);
      s = __builtin_amdgcn_mfma_f32_32x32x16_bf16(kf, qf[st], s, 0, 0, 0);
    }
    float mx = s[0];
#pragma unroll
    for (int i = 1; i < 16; ++i) mx = fmaxf(mx, s[i]);
    mx = fmaxf(mx, __shfl_xor(mx, 32));
    float mnew = fmaxf(mrun, mx); float alpha = expf(mrun - mnew); mrun = mnew;
    float ps = 0.f; bf16_t pb[16];
#pragma unroll
    for (int i = 0; i < 16; ++i) { float e = expf(s[i] - mnew); ps += e; pb[i] = f2bf(e); }
    lrun = lrun * alpha + ps;
#pragma unroll
    for (int i = 0; i < 16; ++i) { o0[i] *= alpha; o1[i] *= alpha; }
#pragma unroll
    for (int st = 0; st < 2; ++st) {
      s8v pf;
#pragma unroll
      for (int j = 0; j < 8; ++j) pf[j] = (short)pb[8 * st + j];
#pragma unroll
      for (int db = 0; db < 2; ++db) {
        const bf16_t* vp = VT + (size_t)(db * 32 + ql) * nkeys + k0 + 16 * st + 4 * hh;
        u2v a = *(const u2v*)vp, b2 = *(const u2v*)(vp + 8);
        s8v vf = __builtin_bit_cast(s8v, u4v{a.x, a.y, b2.x, b2.y});
        if (db == 0) o0 = __builtin_amdgcn_mfma_f32_32x32x16_bf16(vf, pf, o0, 0, 0, 0);
        else o1 = __builtin_amdgcn_mfma_f32_32x32x16_bf16(vf, pf, o1, 0, 0, 0);
      }
    }
  }
  float ltot = lrun + __shfl_xor(lrun, 32); float inv = 1.f / ltot;
  const bf16_t* Z = (const bf16_t*)(ws + O_Z);
  bf16_t* O = (bf16_t*)(ws + O_OBR) + (size_t)1 * MG * 512;
#pragma unroll
  for (int db = 0; db < 2; ++db)
#pragma unroll
    for (int i = 0; i < 16; ++i) {
      int dv = db * 32 + (i & 3) + 8 * (i >> 2) + 4 * hh; float ov = (db == 0 ? o0[i] : o1[i]) * inv;
      float gt = siluf_(bf2f(Z[(size_t)mq * IN_W + ZC_GB + h * 64 + dv]));
      O[(size_t)mq * 512 + h * 64 + dv] = f2bf(ov * gt);
    }
}

__device__ __forceinline__ void stage_att(const Params& p, const Grp& g, int bid, int nb, char* smem) {
  char* ws = p.ws;
  const bf16_t* Z = (const bf16_t*)(ws + O_Z);
  const int T = g.T, ntt = T / 128;
  const int NI_A = g.nseq * 8 * ntt, NT_D2 = g.nseq * 4 * ntt;
  for (int t0 = bid; t0 < NI_A + NT_D2; t0 += nb) {
    int t = t0;
    if (t < NI_A) { int sq = t / (8 * ntt), r = t % (8 * ntt); attention_item(p, g, sq, r / ntt, r % ntt); continue; }
    t -= NI_A;
    {
      int sq = t / (4 * ntt), r = t % (4 * ntt), gg = r / ntt, tt = r % ntt;
      long mbase = (long)sq * T;
      f4v acc[4][4]; zero_acc<4>(acc);
      gemm_mainloop<4>((const bf16_t*)(ws + (g.isden ? O_A2D : O_A2C)), 2 * T, tt * 128, T, (const bf16_t*)(ws + O_YT) + (size_t)mbase * 1024 + (size_t)gg * 128 * 2 * T, 2 * T, 0, 128, 2 * T, smem, acc);
      bf16_t* O = (bf16_t*)(ws + O_OBR) + (size_t)3 * MG * 512;
      const float sc = rsqrtf(128.f * (float)T);
      epi_foreach<4>(acc, tt * 128, 0, [&](int rb, int col, f4v v) {
#pragma unroll
        for (int e = 0; e < 4; ++e) { long m = mbase + rb + e; int c = gg * 128 + col; float gd = siluf_(bf2f(Z[(size_t)m * IN_W + ZC_GD + c]));
          O[(size_t)m * 512 + c] = f2bf(v[e] * sc * gd); }
      });
    }
  }
}

__device__ __forceinline__ float row16_sum(float v) {
  v += __shfl_xor(v, 1); v += __shfl_xor(v, 2); v += __shfl_xor(v, 4); v += __shfl_xor(v, 8); return v;
}
__device__ __forceinline__ void stage_scan(const Params& p, const Grp& g, int l, int bid, int nb) {
  char* ws = p.ws;
  const int tid = threadIdx.x, lane = tid & 63, wid = tid >> 6;
  const bf16_t* SR = (const bf16_t*)(ws + O_SR); const bf16_t* SV = (const bf16_t*)(ws + O_SV); const bf16_t* SKK = (const bf16_t*)(ws + O_SKK);
  const int T = g.T;
  const int NIT = g.nseq * 16 * 4;
  for (int it = bid; it < NIT; it += nb) {
    int ch = it >> 2, rg = it & 3;
    int dir = ch & 1, h = (ch >> 1) & 7, sq = ch >> 4;
    long mbase = (long)sq * T;
    int row = rg * 16 + wid * 4 + (lane >> 4), ks = (lane & 15) * 4;
    const bf16_t* SD = (const bf16_t*)(ws + O_SD) + (size_t)dir * MG * 512; const bf16_t* SB = (const bf16_t*)(ws + O_SB) + (size_t)dir * MG * 512;
    const bf16_t* SKT = (const bf16_t*)(ws + O_SKT) + (size_t)dir * MG * 512;
    float* YS = (float*)(ws + O_YS) + (size_t)dir * MG * 512;
    float s0 = 0.f, s1 = 0.f, s2 = 0.f, s3 = 0.f;
    if (g.isden) { const float* st = (dir ? p.st_b : p.st_f) + ((((size_t)sq * NL + l) * 8 + h) * 64 + row) * 64 + ks; s0 = st[0]; s1 = st[1]; s2 = st[2]; s3 = st[3]; }
    for (int i = 0; i < T; ++i) {
      int t = dir ? T - 1 - i : i; size_t o = (size_t)(mbase + t) * 512 + h * 64;
      uint2 dd = *(const uint2*)(SD + o + ks), kk = *(const uint2*)(SKK + o + ks), bb = *(const uint2*)(SB + o + ks), kt = *(const uint2*)(SKT + o + ks), r = *(const uint2*)(SR + o + ks);
      float v = bf2f(SV[o + row]);
      float sa = -row16_sum(s0 * bflo(kk.x) + s1 * bfhi(kk.x) + s2 * bflo(kk.y) + s3 * bfhi(kk.y));
      s0 = s0 - s0 * bflo(dd.x) + sa * bflo(bb.x) + v * bflo(kt.x); s1 = s1 - s1 * bfhi(dd.x) + sa * bfhi(bb.x) + v * bfhi(kt.x);
      s2 = s2 - s2 * bflo(dd.y) + sa * bflo(bb.y) + v * bflo(kt.y); s3 = s3 - s3 * bfhi(dd.y) + sa * bfhi(bb.y) + v * bfhi(kt.y);
      float y = row16_sum(s0 * bflo(r.x) + s1 * bfhi(r.x) + s2 * bflo(r.y) + s3 * bfhi(r.y));
      if ((lane & 15) == 0) YS[o + row] = y;
    }
    if (!g.isden) { float* so = p.out + (dir ? OUT_SB : OUT_SF) + ((((size_t)(g.b0 + sq) * NL + l) * 8 + h) * 64 + row) * 64 + ks; *(float4*)so = make_float4(s0, s1, s2, s3); }
  }
}

__device__ __forceinline__ void stage_e3(const Params& p, const Grp& g, int l, int bid, int nb) {
  const int lane = threadIdx.x & 63, wid = threadIdx.x >> 6;
  char* ws = p.ws;
  const float* YS = (const float*)(ws + O_YS); const bf16_t* SV = (const bf16_t*)(ws + O_SV); const float* BON = (const float*)(ws + O_BON);
  const bf16_t* Z = (const bf16_t*)(ws + O_Z); bf16_t* O = (bf16_t*)(ws + O_OBR);
  for (int m = bid * 4 + wid; m < g.mg; m += nb * 4) {
#pragma unroll 2
    for (int i = 0; i < 8; ++i) {
      int c = lane + 64 * i;
      float o = YS[(size_t)m * 512 + c] + YS[((size_t)MG + m) * 512 + c];
      float mean = wave_sum(o) * (1.f / 64.f); float d = o - mean; float var = wave_sum(d * d) * (1.f / 64.f);
      float y = d * rsqrtf(var + 64e-5f) * p.ln_g[(size_t)l * 512 + c] + p.ln_b[(size_t)l * 512 + c] + BON[(size_t)m * 8 + i] * bf2f(SV[(size_t)m * 512 + c]);
      O[(size_t)m * 512 + c] = f2bf(y * siluf_(bf2f(Z[(size_t)m * IN_W + ZC_GA + c])));
    }
  }
}

__device__ __forceinline__ void stage_g8(const Params& p, const Grp& g, int l, int bid, int nb, char* smem) {
  char* ws = p.ws;
  bf16_t* MGD = (bf16_t*)(ws + O_MERGED);
  const bf16_t* H = (const bf16_t*)(ws + O_H);
  const int TM = (g.mg + 127) / 128, mg = g.mg;
  for (int t = bid; t < TM * 16; t += nb) {
    int tn = t / TM, tm = t % TM;
    f4v macc[4][2]; zero_acc<2>(macc);
    for (int n = 0; n < 4; ++n) {
      f4v ag[4][2]; zero_acc<2>(ag);
      gemm_mainloop<2>(H, 1024, tm * 128, mg, (const bf16_t*)(ws + O_WMT) + (size_t)n * 1024 * 1024, 1024, tn * 64, 1024, 1024, smem, ag);
      const float* bm = p.b_merge + (size_t)l * 4096 + n * 1024;
      {
        const int lane = threadIdx.x & 63, wn = (threadIdx.x >> 6) & 1;
#pragma unroll
        for (int i = 0; i < 4; ++i)
#pragma unroll
          for (int j = 0; j < 2; ++j) { float bb = bm[tn * 64 + wn * 32 + j * 16 + (lane & 15)];
#pragma unroll
            for (int e = 0; e < 4; ++e) ag[i][j][e] = sigmoidf_(ag[i][j][e] + bb); }
      }
      f4v ap[4][2]; zero_acc<2>(ap);
      gemm_mainloop<2>((const bf16_t*)(ws + O_OBR) + (size_t)n * MG * 512, 512, tm * 128, mg, (const bf16_t*)(ws + O_WBRT) + (size_t)n * 1024 * 512, 512, tn * 64, 1024, 512, smem, ap);
#pragma unroll
      for (int i = 0; i < 4; ++i)
#pragma unroll
        for (int j = 0; j < 2; ++j)
#pragma unroll
          for (int e = 0; e < 4; ++e) macc[i][j][e] += ag[i][j][e] * ap[i][j][e];
    }
    epi_foreach<2>(macc, tm * 128, tn * 64, [&](int rb, int col, f4v v) {
#pragma unroll
      for (int e = 0; e < 4; ++e) if (rb + e < mg) MGD[(size_t)(rb + e) * 1024 + col] = f2bf(v[e]);
    });
  }
}

__device__ __forceinline__ void stage_g9(const Params& p, const Grp& g, int l, int bid, int nb, char* smem) {
  char* ws = p.ws;
  float* X = p.out + (size_t)g.m0 * 1024;
  const float* modp = (const float*)(ws + O_MOD) + (size_t)l * 3 * 3072 + 2048;
  const int TM = (g.mg + 127) / 128, mg = g.mg;
  for (int t = bid; t < TM * 8; t += nb) {
    int tn = t / TM, tm = t % TM;
    f4v acc[4][4]; zero_acc<4>(acc);
    gemm_mainloop<4>((const bf16_t*)(ws + O_MERGED), 1024, tm * 128, mg, (const bf16_t*)(ws + O_WOUTT), 1024, tn * 128, 1024, 1024, smem, acc);
    epi_foreach<4>(acc, tm * 128, tn * 128, [&](int rb, int col, f4v v) {
#pragma unroll
      for (int e = 0; e < 4; ++e) { int row = rb + e; if (row < mg) { float gt = modp[(size_t)mod_index(g, row) * 3072 + col]; X[(size_t)row * 1024 + col] += gt * v[e]; } }
    });
  }
}

__device__ __forceinline__ void stage_final(const Params& p, int bid, int nb) {
  const int lane = threadIdx.x & 63, wid = threadIdx.x >> 6;
  for (int m = bid * 4 + wid; m < M; m += nb * 4) {
    float* xr = p.out + (size_t)m * 1024; float4 q[4]; float ss = 0.f;
#pragma unroll
    for (int i = 0; i < 4; ++i) { q[i] = *(const float4*)(xr + i * 256 + lane * 4); ss += q[i].x * q[i].x + q[i].y * q[i].y + q[i].z * q[i].z + q[i].w * q[i].w; }
    ss = wave_sum(ss); float rs = rsqrtf(ss * (1.f / 1024.f) + 1e-6f);
#pragma unroll
    for (int i = 0; i < 4; ++i) { int c = i * 256 + lane * 4; float4 gm = *(const float4*)(p.final_g + c);
      *(float4*)(xr + c) = make_float4(q[i].x * rs * gm.x, q[i].y * rs * gm.y, q[i].z * rs * gm.z, q[i].w * rs * gm.w); }
  }
}

#ifdef EMU
#define DECL_SMEM(name) char* name = emu::smem()
#else
#define DECL_SMEM(name) __shared__ __attribute__((aligned(16))) char name[SMEM_BYTES]
#endif

#ifndef EMU
namespace cg = cooperative_groups;
#else
namespace cg = cooperative_groups;
#endif

__global__ void __launch_bounds__(256) mega_kernel(Params p) {
  DECL_SMEM(smem);
  cg::grid_group grid = cg::this_grid();
  const int bid = blockIdx.x, nb = gridDim.x;
  for (int l = 0; l < NL; ++l) {
    stage_prep(p, l, bid, nb, smem);
    if (l == 0) grid.sync();
    { Grp g0 = get_grp(0); stage_h(p, g0, l, bid, nb); }
    grid.sync();
    for (int gi = 0; gi < NGRP; ++gi) {
      Grp g = get_grp(gi);
      stage_g1(p, g, bid, nb, smem); grid.sync();
      stage_e1(p, g, l, bid, nb); grid.sync();
      stage_g2(p, g, l, bid, nb, smem); grid.sync();
      stage_e2(p, g, l, bid, nb); grid.sync();
      stage_scan(p, g, l, bid, nb);
      stage_att(p, g, bid, nb, smem); grid.sync();
      stage_e3(p, g, l, bid, nb); grid.sync();
      stage_g8(p, g, l, bid, nb, smem); grid.sync();
      stage_g9(p, g, l, bid, nb, smem);
      if (gi + 1 < NGRP) { Grp gn = get_grp(gi + 1); stage_h(p, gn, l, bid, nb); }
      grid.sync();
    }
  }
  stage_final(p, bid, nb);
}

extern "C" void kernel_launch(void* const* d_in, const int* in_sizes, int n_in, void* d_out, int out_size, void* d_ws, size_t ws_size,
                              hipStream_t stream) {
  Params p{};
  const float** pp = (const float**)&p;
  for (int i = 0; i < 35; ++i) pp[i] = (const float*)d_in[i];
  p.out = (float*)d_out; p.ws = (char*)d_ws;
#ifdef EMU
  emu::set_coop(true);
  emu_launch(dim3(8), dim3(256), [=]() { mega_kernel(p); });
  emu::set_coop(false);
#else
  static int grid_blocks = 0;
  if (!grid_blocks) {
    int dev = 0, cus = 0, per_cu = 0;
    (void)hipGetDevice(&dev);
    (void)hipDeviceGetAttribute(&cus, hipDeviceAttributeMultiprocessorCount, dev);
    (void)hipOccupancyMaxActiveBlocksPerMultiprocessor(&per_cu, mega_kernel, 256, 0);
    if (per_cu > 2) per_cu = 2;
    if (per_cu < 1) per_cu = 1;
    grid_blocks = cus * per_cu;
  }
  void* args[] = {&p};
  (void)hipLaunchCooperativeKernel((void*)mega_kernel, dim3(grid_blocks), dim3(256), args, 0, stream);
#endif
  (void)in_sizes; (void)n_in; (void)out_size; (void)ws_size;
}
```

```cpp
#ifdef EMU
#include "hip_emu.h"
#else
#include <hip/hip_runtime.h>
#include <hip/hip_cooperative_groups.h>
#endif
#include <stdint.h>

#ifndef CFG_BATCH
#define CFG_BATCH 32
#define CFG_SEQ 256
#define CFG_DEC_BATCH 2
#define CFG_DEC_SEQ 2048
#define CFG_PAST 512
#define CFG_NGRP_C 2
#endif
constexpr int D = 1024, NL = 2;
constexpr int NB_C = CFG_BATCH, T_C = CFG_SEQ, NB_D = CFG_DEC_BATCH, T_D = CFG_DEC_SEQ, PAST = CFG_PAST;
constexpr int M_C = NB_C * T_C, M_D = NB_D * T_D, M = M_C + M_D;
constexpr int NGRP_C = CFG_NGRP_C, NGRP = 1 + NGRP_C;
constexpr int MGC = M_C / NGRP_C, SEQ_PER_CG = NB_C / NGRP_C;
constexpr int MG = MGC > M_D ? MGC : M_D;
constexpr int MKV = MG + NB_D * PAST;
constexpr int KEYS_D = T_D + PAST;
constexpr int IN_W = 5728;
constexpr int ZC_R = 0, ZC_K = 512, ZC_V = 1024, ZC_WDF = 1536, ZC_GA = 1728, ZC_QD = 2240, ZC_KVD = 2496, ZC_KR = 2624,
              ZC_GB = 2656, ZC_U = 3168, ZC_VC = 3680, ZC_GC = 4192, ZC_F = 4704, ZC_GD = 5216;
constexpr int SHIFT_W = 1728;
static_assert(M_C % NGRP_C == 0 && NB_C % NGRP_C == 0, "ctx groups");
static_assert(T_C % 128 == 0 && T_D % 128 == 0 && PAST % 32 == 0, "seq multiples");

typedef unsigned short bf16_t;
typedef short s8v __attribute__((ext_vector_type(8)));
typedef float f4v __attribute__((ext_vector_type(4)));
typedef float f16v __attribute__((ext_vector_type(16)));
typedef unsigned u4v __attribute__((ext_vector_type(4)));
typedef unsigned u2v __attribute__((ext_vector_type(2)));

struct Params {
  const float *x_prompt, *x_sample, *st_f, *st_b, *c_ckv, *c_kr, *c, *c_ctx, *norm_g, *w_ada, *b_ada, *w_in, *shift_mu, *w0, *w_up,
      *a0, *a_up, *k_k, *k_a, *r_k, *ln_g, *ln_b, *q_norm, *w_q_up, *kv_norm, *w_kv_up, *g_ln_g, *g_ln_b, *g_w_s, *g_b_s, *w_branch,
      *w_merge, *b_merge, *w_out, *final_g;
  float* out;
  char* ws;
};

struct Grp { int isden, m0, mg, nseq, T, b0, nkeys, mkv; };
__host__ __device__ __forceinline__ Grp get_grp(int gi) {
  Grp g;
  if (gi == 0) { g.isden = 1; g.m0 = M_C; g.mg = M_D; g.nseq = NB_D; g.T = T_D; g.b0 = 0; g.nkeys = KEYS_D; g.mkv = M_D + NB_D * PAST; }
  else { g.isden = 0; g.m0 = (gi - 1) * MGC; g.mg = MGC; g.nseq = SEQ_PER_CG; g.T = T_C; g.b0 = (gi - 1) * SEQ_PER_CG; g.nkeys = T_C; g.mkv = MGC; }
  return g;
}

constexpr size_t al256(size_t x) { return (x + 255) & ~(size_t)255; }
constexpr size_t O_WINT = 0;
constexpr size_t O_WMT = O_WINT + al256((size_t)IN_W * 1024 * 2);
constexpr size_t O_WBRT = O_WMT + al256((size_t)4096 * 1024 * 2);
constexpr size_t O_WOUTT = O_WBRT + al256((size_t)4 * 1024 * 512 * 2);
constexpr size_t O_WQT = O_WOUTT + al256((size_t)1024 * 1024 * 2);
constexpr size_t O_WKVT = O_WQT + al256((size_t)768 * 256 * 2);
constexpr size_t O_WUPT = O_WKVT + al256((size_t)1024 * 128 * 2);
constexpr size_t O_WS = O_WUPT + al256((size_t)4 * 512 * 64 * 2);
constexpr size_t O_CS128 = O_WS + al256((size_t)4 * 128 * 128 * 2);
constexpr size_t O_A2C = O_CS128 + al256((size_t)256 * 128 * 2);
constexpr size_t O_A2D = O_A2C + al256((size_t)T_C * 2 * T_C * 2);
constexpr size_t O_ROPE = O_A2D + al256((size_t)T_D * 2 * T_D * 2);
constexpr size_t O_MOD = O_ROPE + al256((size_t)T_D * 32 * 4);
constexpr size_t O_H = O_MOD + al256((size_t)NL * 3 * 3072 * 4);
constexpr size_t O_Z = O_H + al256((size_t)MG * 1024 * 2);
constexpr size_t O_SK = O_Z + al256((size_t)MG * IN_W * 2);
constexpr size_t O_SOP = O_SK + al256((size_t)MG * 512 * 2);
constexpr size_t O_YS = O_SOP + al256((size_t)MG * 8 * 576 * 2);
constexpr size_t O_BON = O_YS + al256((size_t)2 * MG * 512 * 4);
constexpr size_t O_LORA = O_BON + al256((size_t)MG * 8 * 4);
constexpr size_t O_PRE = O_LORA + al256((size_t)MG * 192 * 2);
constexpr size_t O_QDN = O_PRE + al256((size_t)MG * 2048 * 2);
constexpr size_t O_CKV = O_QDN + al256((size_t)MG * 256 * 2);
constexpr size_t O_KR = O_CKV + al256((size_t)MKV * 128 * 2);
constexpr size_t O_Q = O_KR + al256((size_t)MKV * 32 * 2);
constexpr size_t O_KN = O_Q + al256((size_t)MG * 768 * 2);
constexpr size_t O_VT = O_KN + al256((size_t)MKV * 512 * 2);
constexpr size_t O_VCNT = O_VT + al256((size_t)MKV * 512 * 2);
constexpr size_t O_YT = O_VCNT + al256((size_t)MG * 512 * 2);
constexpr size_t O_OBR = O_YT + al256((size_t)MG * 1024 * 2);
constexpr size_t O_MERGED = O_OBR + al256((size_t)4 * MG * 512 * 2);
constexpr size_t O_END = O_MERGED + al256((size_t)MG * 1024 * 2);
static_assert(O_END <= ((size_t)256 << 20), "workspace must fit 256 MiB");

constexpr size_t OUT_SF = (size_t)M * D, OUT_SB = OUT_SF + (size_t)NB_C * NL * 8 * 64 * 64,
                 OUT_CKV = OUT_SB + (size_t)NB_C * NL * 8 * 64 * 64, OUT_KR = OUT_CKV + (size_t)NB_C * NL * T_C * 128;

__device__ __forceinline__ int my_tid() {
#ifdef EMU
  return (int)threadIdx.x;
#else
  int t = (int)threadIdx.x; asm volatile("" : "+v"(t)); return t;
#endif
}
__device__ __forceinline__ unsigned f_as_u(float f) { return __builtin_bit_cast(unsigned, f); }
__device__ __forceinline__ float u_as_f(unsigned u) { return __builtin_bit_cast(float, u); }
__device__ __forceinline__ bf16_t f2bf(float f) { unsigned u = f_as_u(f); u += 0x7FFFu + ((u >> 16) & 1u); return (bf16_t)(u >> 16); }
__device__ __forceinline__ float bf2f(bf16_t h) { return u_as_f(((unsigned)h) << 16); }
__device__ __forceinline__ float bflo(unsigned u) { return u_as_f(u << 16); }
__device__ __forceinline__ float bfhi(unsigned u) { return u_as_f(u & 0xFFFF0000u); }
__device__ __forceinline__ float sigmoidf_(float x) { return 1.f / (1.f + expf(-x)); }
__device__ __forceinline__ float siluf_(float x) { return x / (1.f + expf(-x)); }
__device__ __forceinline__ float geluf_(float x) { return 0.5f * x * (1.f + tanhf(0.7978845608028654f * (x + 0.044715f * x * x * x))); }
__device__ __forceinline__ float wave_sum(float v) {
#pragma unroll
  for (int o = 32; o >= 1; o >>= 1) v += __shfl_xor(v, o);
  return v;
}

#ifdef EMU
#define WAVE_SYNC() emu::wave_barrier()
__device__ __forceinline__ float sum16(float v) { v += __shfl_xor(v, 1); v += __shfl_xor(v, 2); v += __shfl_xor(v, 4); v += __shfl_xor(v, 8); return v; }
#else
#define WAVE_SYNC() __builtin_amdgcn_wave_barrier()
__device__ __forceinline__ float sum16(float v) {
  v += u_as_f(__builtin_amdgcn_update_dpp(0, (int)f_as_u(v), 0xB1, 0xF, 0xF, true));
  v += u_as_f(__builtin_amdgcn_update_dpp(0, (int)f_as_u(v), 0x4E, 0xF, 0xF, true));
  v += u_as_f(__builtin_amdgcn_update_dpp(0, (int)f_as_u(v), 0x141, 0xF, 0xF, true));
  v += u_as_f(__builtin_amdgcn_update_dpp(0, (int)f_as_u(v), 0x140, 0xF, 0xF, true));
  return v;
}
#endif

constexpr int NTHR = 512, NWAVE = 8;
constexpr int LDS_STR = 72;
constexpr int SMEM_BYTES = 2 * (128 + 128) * LDS_STR * 2;

template <int NJ>
__device__ __forceinline__ void zero_acc(f4v (&acc)[2][NJ]) {
#pragma unroll
  for (int i = 0; i < 2; ++i)
#pragma unroll
    for (int j = 0; j < NJ; ++j) acc[i][j] = f4v{0.f, 0.f, 0.f, 0.f};
}

template <int NJ>
__device__ __forceinline__ void gemm_mainloop(const bf16_t* __restrict__ A, long lda, int arow0, int arows, const bf16_t* __restrict__ B,
                                              long ldb, int brow0, int brows, int K, char* smem, f4v (&acc)[2][NJ]) {
  constexpr int BROWS = 32 * NJ, NBL = NJ / 2;
  constexpr int BUF = (128 + 128) * LDS_STR;
  bf16_t* s0 = (bf16_t*)smem;
  const int tid = my_tid(), lane = tid & 63, wid = tid >> 6, wm = wid >> 1, wn = wid & 1;
  u4v ra[2], rb[NBL];
  const bf16_t* ap[2]; const bf16_t* bp[NBL];
#pragma unroll
  for (int i = 0; i < 2; ++i) { int c = tid + NTHR * i, r = c >> 3, cc = c & 7; int ar = arow0 + r; ar = ar < arows ? ar : arows - 1; ap[i] = A + (long)ar * lda + cc * 8; }
#pragma unroll
  for (int i = 0; i < NBL; ++i) { int c = tid + NTHR * i, r = c >> 3, cc = c & 7; int br = brow0 + r; br = br < brows ? br : brows - 1; bp[i] = B + (long)br * ldb + cc * 8; }
#pragma unroll
  for (int i = 0; i < 2; ++i) ra[i] = *(const u4v*)(ap[i]);
#pragma unroll
  for (int i = 0; i < NBL; ++i) rb[i] = *(const u4v*)(bp[i]);
  __syncthreads();
#pragma unroll
  for (int i = 0; i < 2; ++i) { int c = tid + NTHR * i, r = c >> 3, cc = c & 7; *(u4v*)(s0 + r * LDS_STR + cc * 8) = ra[i]; }
#pragma unroll
  for (int i = 0; i < NBL; ++i) { int c = tid + NTHR * i, r = c >> 3, cc = c & 7; *(u4v*)(s0 + (128 + r) * LDS_STR + cc * 8) = rb[i]; }
  __syncthreads();
  const int nk = K >> 6;
  for (int kt = 0; kt < nk; ++kt) {
    const bool more = kt + 1 < nk;
    if (more) {
#pragma unroll
      for (int i = 0; i < 2; ++i) ra[i] = *(const u4v*)(ap[i] + (kt + 1) * 64);
#pragma unroll
      for (int i = 0; i < NBL; ++i) rb[i] = *(const u4v*)(bp[i] + (kt + 1) * 64);
    }
    const bf16_t* sA = s0 + (kt & 1) * BUF; const bf16_t* sB = sA + 128 * LDS_STR;
#pragma unroll
    for (int ks = 0; ks < 2; ++ks) {
      s8v af[2], bf[NJ];
#pragma unroll
      for (int i = 0; i < 2; ++i) af[i] = *(const s8v*)(sA + (wm * 32 + i * 16 + (lane & 15)) * LDS_STR + ks * 32 + (lane >> 4) * 8);
#pragma unroll
      for (int j = 0; j < NJ; ++j) bf[j] = *(const s8v*)(sB + (wn * NJ * 16 + j * 16 + (lane & 15)) * LDS_STR + ks * 32 + (lane >> 4) * 8);
#pragma unroll
      for (int i = 0; i < 2; ++i)
#pragma unroll
        for (int j = 0; j < NJ; ++j) acc[i][j] = __builtin_amdgcn_mfma_f32_16x16x32_bf16(bf[j], af[i], acc[i][j], 0, 0, 0);
    }
    if (more) {
      bf16_t* dA = s0 + ((kt + 1) & 1) * BUF;
#pragma unroll
      for (int i = 0; i < 2; ++i) { int c = tid + NTHR * i, r = c >> 3, cc = c & 7; *(u4v*)(dA + r * LDS_STR + cc * 8) = ra[i]; }
#pragma unroll
      for (int i = 0; i < NBL; ++i) { int c = tid + NTHR * i, r = c >> 3, cc = c & 7; *(u4v*)(dA + (128 + r) * LDS_STR + cc * 8) = rb[i]; }
    }
    __syncthreads();
  }
  (void)BROWS;
}

template <int NJ, class F>
__device__ __forceinline__ void epi_foreach(f4v (&acc)[2][NJ], int row0, int col0, F f) {
  const int tid = my_tid(), lane = tid & 63, wid = tid >> 6, wm = wid >> 1, wn = wid & 1;
#pragma unroll
  for (int i = 0; i < 2; ++i)
#pragma unroll
    for (int j = 0; j < NJ; ++j) f(row0 + wm * 32 + i * 16 + (lane & 15), col0 + wn * NJ * 16 + j * 16 + (lane >> 4) * 4, acc[i][j]);
}
__device__ __forceinline__ u2v pack4(float a, float b, float c, float d) {
  return u2v{(unsigned)f2bf(a) | ((unsigned)f2bf(b) << 16), (unsigned)f2bf(c) | ((unsigned)f2bf(d) << 16)};
}

struct TJob { const float* src; int K, N; long lds; bf16_t* dst; long ldd; };
__device__ __forceinline__ TJob get_tjob(const Params& p, int l, int j) {
  TJob t; char* ws = p.ws;
  if (j == 0) { t.src = p.w_in + (size_t)l * 1024 * IN_W; t.K = 1024; t.N = IN_W; t.lds = IN_W; t.dst = (bf16_t*)(ws + O_WINT); t.ldd = 1024; }
  else if (j == 1) { t.src = p.w_merge + (size_t)l * 1024 * 4096; t.K = 1024; t.N = 4096; t.lds = 4096; t.dst = (bf16_t*)(ws + O_WMT); t.ldd = 1024; }
  else if (j < 6) { int n = j - 2; t.src = p.w_branch + ((size_t)l * 4 + n) * 512 * 1024; t.K = 512; t.N = 1024; t.lds = 1024; t.dst = (bf16_t*)(ws + O_WBRT) + (size_t)n * 1024 * 512; t.ldd = 512; }
  else if (j == 6) { t.src = p.w_out + (size_t)l * 1024 * 1024; t.K = 1024; t.N = 1024; t.lds = 1024; t.dst = (bf16_t*)(ws + O_WOUTT); t.ldd = 1024; }
  else if (j == 7) { t.src = p.w_q_up + (size_t)l * 256 * 768; t.K = 256; t.N = 768; t.lds = 768; t.dst = (bf16_t*)(ws + O_WQT); t.ldd = 256; }
  else if (j == 8) { t.src = p.w_kv_up + (size_t)l * 128 * 1024; t.K = 128; t.N = 1024; t.lds = 1024; t.dst = (bf16_t*)(ws + O_WKVT); t.ldd = 128; }
  else { int n = j - 9;
    t.src = (n < 2 ? p.w_up : p.a_up) + ((size_t)l * 2 + (n & 1)) * 64 * 512; t.K = 64; t.N = 512; t.lds = 512;
    t.dst = (bf16_t*)(ws + O_WUPT) + (size_t)n * 512 * 64; t.ldd = 64; }
  return t;
}
constexpr int NTJOBS = 13;

__device__ __forceinline__ void stage_prep(const Params& p, int l, int bid, int nb, char* smem) {
  const int tid = my_tid();
  char* ws = p.ws;
  {
    float* tile = (float*)smem;
    long base = 0;
    for (int j = 0; j < NTJOBS; ++j) {
      TJob t = get_tjob(p, l, j);
      int tk = t.K / 32, tn = t.N / 32, nt = tk * tn;
      long first = ((bid - base) % nb + nb) % nb;
      for (long q = first; q < nt; q += nb) {
        int kt = (int)(q / tn), nt_ = (int)(q % tn);
        __syncthreads();
#pragma unroll
        for (int i = 0; i < 2; ++i) { int e = tid + NTHR * i, r = e >> 5, c = e & 31; tile[r * 33 + c] = t.src[(long)(kt * 32 + r) * t.lds + nt_ * 32 + c]; }
        __syncthreads();
#pragma unroll
        for (int i = 0; i < 2; ++i) { int e = tid + NTHR * i, r = e >> 5, c = e & 31; t.dst[(long)(nt_ * 32 + r) * t.ldd + kt * 32 + c] = f2bf(tile[c * 33 + r]); }
      }
      base += nt;
    }
    __syncthreads();
  }
  const long gtid = (long)bid * NTHR + tid, gn = (long)nb * NTHR;
  { bf16_t* d = (bf16_t*)(ws + O_WS); const float* s = p.g_w_s + (size_t)l * 4 * 128 * 128; for (long i = gtid; i < (long)4 * 128 * 128; i += gn) d[i] = f2bf(s[i]); }
  if (l != 0) return;
  { bf16_t* d = (bf16_t*)(ws + O_CS128);
    for (long i = gtid; i < 256 * 128; i += gn) { int j = (int)(i >> 7), c = (int)(i & 127); int mm = ((j & 127) * c) & 127; float x = 2.0f * mm / 128.f; d[i] = f2bf(j < 128 ? cospif(x) : sinpif(x)); } }
  { bf16_t* d = (bf16_t*)(ws + O_A2C);
    for (long i = gtid; i < (long)T_C * 2 * T_C; i += gn) { int tp = (int)(i / (2 * T_C)), tt = (int)(i % (2 * T_C)); int half = tt >= T_C; int t = half ? tt - T_C : tt; int mm = (int)(((long)tp * t) % T_C); float x = 2.0f * mm / (float)T_C; d[i] = f2bf(half ? -sinpif(x) : cospif(x)); } }
  { bf16_t* d = (bf16_t*)(ws + O_A2D);
    for (long i = gtid; i < (long)T_D * 2 * T_D; i += gn) { int tp = (int)(i / (2 * T_D)), tt = (int)(i % (2 * T_D)); int half = tt >= T_D; int t = half ? tt - T_D : tt; int mm = (int)(((long)tp * t) % T_D); float x = 2.0f * mm / (float)T_D; d[i] = f2bf(half ? -sinpif(x) : cospif(x)); } }
  { float* d = (float*)(ws + O_ROPE);
    for (long i = gtid; i < (long)T_D * 16; i += gn) { int t = (int)(i >> 4), pi = (int)(i & 15); float pos = (pi < 8) ? (float)(t / 64) : (float)(t % 64); float inv = expf(-(float)(pi & 7) * (9.210340371976184f / 8.f)); float a = pos * inv; d[2 * i] = cosf(a); d[2 * i + 1] = sinf(a); } }
  { float4* d = (float4*)p.out; const float4* s0 = (const float4*)p.x_prompt; const float4* s1 = (const float4*)p.x_sample;
    for (long i = gtid; i < (long)M * 256; i += gn) d[i] = (i < (long)M_C * 256) ? s0[i] : s1[i - (long)M_C * 256]; }
  {
    float* red = (float*)smem;
    float* modp = (float*)(ws + O_MOD);
    for (int u = bid; u < NL * 48; u += nb) {
      int ll = u / 48, cg = u % 48; int col = cg * 64 + (tid & 63), kq = tid >> 6;
      float a0 = 0.f, a1 = 0.f, a2 = 0.f;
      const float* w = p.w_ada + (size_t)ll * 1024 * 3072 + col;
      for (int k = kq * 128; k < kq * 128 + 128; ++k) {
        float wv = w[(size_t)k * 3072];
        a0 += siluf_(p.c_ctx[k]) * wv; a1 += siluf_(p.c[k]) * wv; a2 += siluf_(p.c[(NB_D > 1 ? 1024 : 0) + k]) * wv;
      }
      __syncthreads();
      red[(kq * 3 + 0) * 64 + (tid & 63)] = a0; red[(kq * 3 + 1) * 64 + (tid & 63)] = a1; red[(kq * 3 + 2) * 64 + (tid & 63)] = a2;
      __syncthreads();
      if (tid < 192) { int mi = tid >> 6, cc = tid & 63; float s = 0.f;
#pragma unroll
        for (int q8 = 0; q8 < 8; ++q8) s += red[(q8 * 3 + mi) * 64 + cc];
        modp[((size_t)ll * 3 + mi) * 3072 + cg * 64 + cc] = s + p.b_ada[(size_t)ll * 3072 + cg * 64 + cc]; }
    }
  }
}

__device__ __forceinline__ int mod_index(const Grp& g, int lm) { return g.isden ? 1 + lm / T_D : 0; }

__device__ __forceinline__ void stage_h(const Params& p, const Grp& g, int l, int bid, int nb) {
  const int lane = my_tid() & 63, wid = my_tid() >> 6;
  const float* X = p.out + (size_t)g.m0 * 1024;
  bf16_t* H = (bf16_t*)(p.ws + O_H);
  const float* modp = (const float*)(p.ws + O_MOD) + (size_t)l * 3 * 3072;
  const float* gam = p.norm_g + (size_t)l * 1024;
  for (int m = bid * NWAVE + wid; m < g.mg; m += nb * NWAVE) {
    const float* xr = X + (size_t)m * 1024; float v[16]; float ss = 0.f;
#pragma unroll
    for (int i = 0; i < 4; ++i) { float4 q = *(const float4*)(xr + i * 256 + lane * 4); v[4 * i] = q.x; v[4 * i + 1] = q.y; v[4 * i + 2] = q.z; v[4 * i + 3] = q.w; ss += q.x * q.x + q.y * q.y + q.z * q.z + q.w * q.w; }
    ss = wave_sum(ss); float rs = rsqrtf(ss * (1.f / 1024.f) + 1e-6f);
    const float* mo = modp + (size_t)mod_index(g, m) * 3072;
#pragma unroll
    for (int i = 0; i < 4; ++i) {
      int c = i * 256 + lane * 4; bf16_t o[4];
#pragma unroll
      for (int e = 0; e < 4; ++e) o[e] = f2bf(v[4 * i + e] * rs * gam[c + e] * (1.f + mo[1024 + c + e]) + mo[c + e]);
      *(uint2*)(H + (size_t)m * 1024 + c) = make_uint2((unsigned)o[0] | ((unsigned)o[1] << 16), (unsigned)o[2] | ((unsigned)o[3] << 16));
    }
  }
}

__device__ __forceinline__ void stage_g1(const Params& p, const Grp& g, int bid, int nb, char* smem) {
  const bf16_t* H = (const bf16_t*)(p.ws + O_H);
  const bf16_t* W = (const bf16_t*)(p.ws + O_WINT);
  bf16_t* Z = (bf16_t*)(p.ws + O_Z);
  const int TM = (g.mg + 127) / 128; constexpr int TN = (IN_W + 127) / 128;
  const int mg = g.mg;
  for (int t = bid; t < TM * TN; t += nb) {
    int tn = t / TM, tm = t % TM; f4v acc[2][4]; zero_acc<4>(acc);
    gemm_mainloop<4>(H, 1024, tm * 128, mg, W, 1024, tn * 128, IN_W, 1024, smem, acc);
    epi_foreach<4>(acc, tm * 128, tn * 128, [&](int row, int c0, f4v& v) {
      if (c0 < IN_W && row < mg) *(u2v*)(Z + (size_t)row * IN_W + c0) = pack4(v[0], v[1], v[2], v[3]);
    });
  }
}

__device__ __forceinline__ void stage_e1(const Params& p, const Grp& g, int l, int bid, int nb) {
  const int lane = my_tid() & 63, wid = my_tid() >> 6;
  char* ws = p.ws;
  const bf16_t* Z = (const bf16_t*)(ws + O_Z);
  bf16_t* SK = (bf16_t*)(ws + O_SK); bf16_t* SOP = (bf16_t*)(ws + O_SOP);
  bf16_t* LORA = (bf16_t*)(ws + O_LORA); bf16_t* QDN = (bf16_t*)(ws + O_QDN); bf16_t* CKV = (bf16_t*)(ws + O_CKV); bf16_t* KR = (bf16_t*)(ws + O_KR);
  bf16_t* VCNT = (bf16_t*)(ws + O_VCNT);
  const float* rope = (const float*)(ws + O_ROPE);
  const float* mu = p.shift_mu + (size_t)l * SHIFT_W;
  const int isden = g.isden, T = g.T;
  for (int m = bid * NWAVE + wid; m < g.mkv; m += nb * NWAVE) {
    if (m >= g.mg) {
      int r = m - g.mg, b = r / PAST, j = r % PAST;
      const float* s = p.c_ckv + (((size_t)b * NL + l) * PAST + j) * 128;
      CKV[(size_t)m * 128 + lane] = f2bf(s[lane]); CKV[(size_t)m * 128 + 64 + lane] = f2bf(s[64 + lane]);
      if (lane < 32) KR[(size_t)m * 32 + lane] = f2bf(p.c_kr[(((size_t)b * NL + l) * PAST + j) * 32 + lane]);
      continue;
    }
    const int sq = m / T, t = m % T, b = g.b0 + sq;
    const bf16_t* z = Z + (size_t)m * IN_W;
    const bool hp = t > 0, hn = t < T - 1;
#pragma unroll 4
    for (int i = 0; i < 24; ++i) {
      int c = lane + 64 * i; float zc = bf2f(z[c]);
      float pv = hp ? bf2f(z[c - IN_W]) : 0.f, nv = hn ? bf2f(z[c + IN_W]) : 0.f;
      bf16_t s = f2bf(zc + (0.5f * (pv + nv) - zc) * mu[c]);
      if (i < 8) SOP[(((size_t)sq * 8 + i) * T + t) * 576 + lane] = s; else if (i < 16) SK[(size_t)m * 512 + c - 512] = s; else SOP[(((size_t)sq * 8 + (i - 16)) * T + t) * 576 + 128 + lane] = s;
    }
#pragma unroll
    for (int i = 0; i < 3; ++i) {
      int c = ZC_WDF + lane + 64 * i; float zc = bf2f(z[c]);
      float pv = hp ? bf2f(z[c - IN_W]) : 0.f, nv = hn ? bf2f(z[c + IN_W]) : 0.f;
      float s = zc + (0.5f * (pv + nv) - zc) * mu[c];
      LORA[(size_t)m * 192 + lane + 64 * i] = f2bf(i < 2 ? tanhf(s) : s);
    }
    { float v[4]; float ss = 0.f;
#pragma unroll
      for (int i = 0; i < 4; ++i) { v[i] = bf2f(z[ZC_QD + lane + 64 * i]); ss += v[i] * v[i]; }
      ss = wave_sum(ss); float rs = rsqrtf(ss * (1.f / 256.f) + 1e-6f);
#pragma unroll
      for (int i = 0; i < 4; ++i) QDN[(size_t)m * 256 + lane + 64 * i] = f2bf(v[i] * rs * p.q_norm[(size_t)l * 256 + lane + 64 * i]); }
    { float v[2]; float ss = 0.f;
#pragma unroll
      for (int i = 0; i < 2; ++i) { v[i] = bf2f(z[ZC_KVD + lane + 64 * i]); ss += v[i] * v[i]; }
      ss = wave_sum(ss); float rs = rsqrtf(ss * (1.f / 128.f) + 1e-6f);
#pragma unroll
      for (int i = 0; i < 2; ++i) { float o = v[i] * rs * p.kv_norm[(size_t)l * 128 + lane + 64 * i];
        CKV[(size_t)m * 128 + lane + 64 * i] = f2bf(o);
        if (!isden) p.out[OUT_CKV + (((size_t)b * NL + l) * T_C + t) * 128 + lane + 64 * i] = o; } }
    { float v = lane < 32 ? bf2f(z[ZC_KR + (lane & 31)]) : 0.f; float pr = __shfl_xor(v, 1); float o = v;
      if (isden) { int pi = (lane & 31) >> 1; float cs = rope[((size_t)t * 16 + pi) * 2], sn = rope[((size_t)t * 16 + pi) * 2 + 1];
        o = (lane & 1) ? (pr * sn + v * cs) : (v * cs - pr * sn); }
      if (lane < 32) { KR[(size_t)m * 32 + lane] = f2bf(o); if (!isden) p.out[OUT_KR + (((size_t)b * NL + l) * T_C + t) * 32 + lane] = v; } }
    { float v[8]; float s1 = 0.f;
#pragma unroll
      for (int i = 0; i < 8; ++i) { v[i] = geluf_(bf2f(z[ZC_VC + lane + 64 * i])); s1 += v[i]; }
      s1 = wave_sum(s1); float mean = s1 * (1.f / 512.f); float s2 = 0.f;
#pragma unroll
      for (int i = 0; i < 8; ++i) { float d = v[i] - mean; s2 += d * d; }
      s2 = wave_sum(s2); float rs = rsqrtf(s2 * (1.f / 512.f) + 1e-5f);
#pragma unroll
      for (int i = 0; i < 8; ++i) { int ch = lane + 64 * i; float o = (v[i] - mean) * rs * p.g_ln_g[(size_t)l * 512 + ch] + p.g_ln_b[(size_t)l * 512 + ch];
        VCNT[(((size_t)(m >> 7) * 4 + (ch >> 7)) * 128 + (ch & 127)) * 128 + (m & 127)] = f2bf(o); } }
  }
}

__device__ __forceinline__ void stage_g2(const Params& p, const Grp& g, int l, int bid, int nb, char* smem) {
  char* ws = p.ws;
  const bf16_t* Z = (const bf16_t*)(ws + O_Z);
  const float* rope = (const float*)(ws + O_ROPE);
  const int mg = g.mg, mkv = g.mkv, T = g.T, isden = g.isden, nkeys = g.nkeys;
  const int TM_M = (mg + 127) / 128, TM_KV = (mkv + 127) / 128;
  const int NT_Q = TM_M * 6, NT_KV = TM_KV * 8, NT_LORA = TM_M * 16, NT_GM = (mg / 128) * 4, ntt = T / 128, NT_D1 = g.nseq * 8 * ntt;
  const int NT = NT_Q + NT_KV + NT_LORA + NT_GM + NT_D1;
  for (int t0 = bid; t0 < NT; t0 += nb) {
    int t = t0; f4v acc[2][4]; zero_acc<4>(acc);
    if (t < NT_Q) {
      int tn = t / TM_M, tm = t % TM_M;
      gemm_mainloop<4>((const bf16_t*)(ws + O_QDN), 256, tm * 128, mg, (const bf16_t*)(ws + O_WQT), 256, tn * 128, 768, 256, smem, acc);
      bf16_t* Q = (bf16_t*)(ws + O_Q);
      const float scale = 0.10206207261596575f;
      epi_foreach<4>(acc, tm * 128, tn * 128, [&](int row, int c0, f4v& v) {
        if (row >= mg) return;
        int cw = c0 % 96; float o0 = v[0], o1 = v[1], o2 = v[2], o3 = v[3];
        if (cw >= 64 && isden) { int tt = row % T_D; int pi = (cw - 64) >> 1; const float* rp = rope + ((size_t)tt * 16 + pi) * 2;
          float c_a = rp[0], s_a = rp[1], c_b = rp[2], s_b = rp[3];
          o0 = v[0] * c_a - v[1] * s_a; o1 = v[0] * s_a + v[1] * c_a; o2 = v[2] * c_b - v[3] * s_b; o3 = v[2] * s_b + v[3] * c_b; }
        *(u2v*)(Q + (size_t)row * 768 + c0) = pack4(o0 * scale, o1 * scale, o2 * scale, o3 * scale);
      });
      continue;
    }
    t -= NT_Q;
    if (t < NT_KV) {
      int tn = t / TM_KV, tm = t % TM_KV;
      gemm_mainloop<4>((const bf16_t*)(ws + O_CKV), 128, tm * 128, mkv, (const bf16_t*)(ws + O_WKVT), 128, tn * 128, 1024, 128, smem, acc);
      bf16_t* KN = (bf16_t*)(ws + O_KN); bf16_t* VT = (bf16_t*)(ws + O_VT);
      epi_foreach<4>(acc, tm * 128, tn * 128, [&](int row, int c0, f4v& v) {
        if (row >= mkv) return;
        int h = c0 >> 7, w = c0 & 127;
        if (w < 64) *(u2v*)(KN + (size_t)row * 512 + h * 64 + w) = pack4(v[0], v[1], v[2], v[3]);
        else { int sq, key;
          if (row < mg) { sq = row / T; key = row % T; } else { int r = row - mg; sq = r / PAST; key = T + r % PAST; }
#pragma unroll
          for (int e = 0; e < 4; ++e) VT[(((size_t)sq * 8 + h) * 64 + (w - 64 + e)) * nkeys + key] = f2bf(v[e]); }
      });
      continue;
    }
    t -= NT_KV;
    if (t < NT_LORA) {
      int g4 = t / (TM_M * 4), r = t % (TM_M * 4), tn = r / TM_M, tm = r % TM_M;
      int koff = g4 == 0 ? 0 : (g4 == 1 ? 64 : 128);
      gemm_mainloop<4>((const bf16_t*)(ws + O_LORA) + koff, 192, tm * 128, mg, (const bf16_t*)(ws + O_WUPT) + (size_t)g4 * 512 * 64, 64, tn * 128, 512, 64, smem, acc);
      bf16_t* PRE = (bf16_t*)(ws + O_PRE);
      const float* bias = (g4 < 2 ? p.w0 : p.a0) + ((size_t)l * 2 + (g4 & 1)) * 512;
      epi_foreach<4>(acc, tm * 128, tn * 128, [&](int row, int c0, f4v& v) {
        if (row < mg) *(u2v*)(PRE + ((size_t)row * 4 + g4) * 512 + c0) = pack4(v[0] + bias[c0], v[1] + bias[c0 + 1], v[2] + bias[c0 + 2], v[3] + bias[c0 + 3]);
      });
      continue;
    }
    t -= NT_LORA;
    if (t < NT_GM) {
      int ch = t >> 2, gg = t & 3;
      gemm_mainloop<4>((const bf16_t*)(ws + O_WS) + (size_t)gg * 128 * 128, 128, 0, 128, (const bf16_t*)(ws + O_VCNT) + ((size_t)ch * 4 + gg) * 128 * 128, 128, 0, 128, 128, smem, acc);
      bf16_t* O = (bf16_t*)(ws + O_OBR) + (size_t)2 * MG * 512;
      const float* bs = p.g_b_s + ((size_t)l * 4 + gg) * 128;
      epi_foreach<4>(acc, 0, 0, [&](int pp, int c0, f4v& v) {
        int m = ch * 128 + pp; int c = gg * 128 + c0; float bb = bs[pp];
        u2v uu = *(const u2v*)(Z + (size_t)m * IN_W + ZC_U + c), gc = *(const u2v*)(Z + (size_t)m * IN_W + ZC_GC + c);
        *(u2v*)(O + (size_t)m * 512 + c) = pack4(geluf_(bflo(uu.x)) * (v[0] + bb) * siluf_(bflo(gc.x)), geluf_(bfhi(uu.x)) * (v[1] + bb) * siluf_(bfhi(gc.x)),
                                                 geluf_(bflo(uu.y)) * (v[2] + bb) * siluf_(bflo(gc.y)), geluf_(bfhi(uu.y)) * (v[3] + bb) * siluf_(bfhi(gc.y)));
      });
      continue;
    }
    t -= NT_GM;
    {
      int per_seq = 8 * ntt; int sq = t / per_seq; int r = t % per_seq; int gg = r / (2 * ntt); int r2 = r % (2 * ntt); int tj = r2 / ntt, tt = r2 % ntt;
      long mbase = (long)sq * T;
      gemm_mainloop<4>((const bf16_t*)(ws + O_CS128), 128, tj * 128, 256, Z + (size_t)mbase * IN_W + ZC_F + gg * 128, IN_W, tt * 128, T, 128, smem, acc);
      bf16_t* YT = (bf16_t*)(ws + O_YT) + (size_t)mbase * 1024 + (size_t)gg * 128 * 2 * T;
      epi_foreach<4>(acc, tj * 128, tt * 128, [&](int j, int c0, f4v& v) {
        *(u2v*)(YT + (size_t)(j & 127) * 2 * T + (size_t)(j >> 7) * T + c0) = pack4(v[0], v[1], v[2], v[3]);
      });
    }
  }
}

__device__ __forceinline__ void stage_e2(const Params& p, const Grp& g, int l, int bid, int nb) {
  const int lane = my_tid() & 63, wid = my_tid() >> 6;
  char* ws = p.ws;
  const bf16_t* SK = (const bf16_t*)(ws + O_SK); bf16_t* SOP = (bf16_t*)(ws + O_SOP);
  float* BON = (float*)(ws + O_BON); const bf16_t* PRE = (const bf16_t*)(ws + O_PRE);
  const int T = g.T;
  for (int m = bid * NWAVE + wid; m < g.mg; m += nb * NWAVE) {
    const int sq = m / T, t = m % T;
#pragma unroll 2
    for (int i = 0; i < 8; ++i) {
      int c = lane + 64 * i;
      bf16_t* rec = SOP + (((size_t)sq * 8 + i) * T + t) * 576;
      float k = bf2f(SK[(size_t)m * 512 + c]), r = bf2f(rec[lane]);
      float kr = k * p.k_k[(size_t)l * 512 + c];
      float n2 = wave_sum(kr * kr); float kk = kr / fmaxf(sqrtf(n2), 1e-12f);
      rec[64 + lane] = f2bf(kk);
      float bon = 0.f;
#pragma unroll
      for (int d = 0; d < 2; ++d) {
        float pw = bf2f(PRE[((size_t)m * 4 + d) * 512 + c]), pa = bf2f(PRE[((size_t)m * 4 + 2 + d) * 512 + c]);
        float dec = expf(-0.6065306597126334f * sigmoidf_(pw));
        float a = sigmoidf_(pa);
        float kt = k * (1.f + (a - 1.f) * p.k_a[(size_t)l * 512 + c]);
        rec[(3 + 3 * d) * 64 + lane] = f2bf(1.f - dec); rec[(4 + 3 * d) * 64 + lane] = f2bf(kk * a); rec[(5 + 3 * d) * 64 + lane] = f2bf(kt);
        bon += r * kt * p.r_k[(size_t)l * 512 + c];
      }
      bon = wave_sum(bon);
      if (lane == 0) BON[(size_t)m * 8 + i] = bon;
    }
  }
}

__device__ __forceinline__ void attention_task(const Params& p, const Grp& g, int sq, int h, int qb32) {
  char* ws = p.ws;
  const int lane = my_tid() & 63, ql = lane & 31, hh = lane >> 5;
  const int T = g.T, nkeys = g.nkeys;
  const long mbase = (long)sq * T;
  const bf16_t* Q = (const bf16_t*)(ws + O_Q); const bf16_t* KN = (const bf16_t*)(ws + O_KN); const bf16_t* KRp = (const bf16_t*)(ws + O_KR);
  const bf16_t* VT = (const bf16_t*)(ws + O_VT) + ((size_t)sq * 8 + h) * 64 * nkeys;
  const long mq = mbase + qb32 * 32 + ql;
  s8v qf[6];
#pragma unroll
  for (int s = 0; s < 6; ++s) qf[s] = *(const s8v*)(Q + (size_t)mq * 768 + h * 96 + 16 * s + 8 * hh);
  f16v o0, o1;
#pragma unroll
  for (int i = 0; i < 16; ++i) { o0[i] = 0.f; o1[i] = 0.f; }
  float mrun = -1e30f, lrun = 0.f;
  for (int k0 = 0; k0 < nkeys; k0 += 32) {
    long krow = (k0 < T) ? mbase + k0 + ql : (long)g.mg + (long)sq * PAST + (k0 - T) + ql;
    f16v s;
#pragma unroll
    for (int i = 0; i < 16; ++i) s[i] = 0.f;
#pragma unroll
    for (int st = 0; st < 6; ++st) {
      s8v kf = (st < 4) ? *(const s8v*)(KN + (size_t)krow * 512 + h * 64 + 16 * st + 8 * hh) : *(const s8v*)(KRp + (size_t)krow * 32 + 16 * (st - 4) + 8 * hh);
      s = __builtin_amdgcn_mfma_f32_32x32x16_bf16(kf, qf[st], s, 0, 0, 0);
    }
    float mx = s[0];
#pragma unroll
    for (int i = 1; i < 16; ++i) mx = fmaxf(mx, s[i]);
    mx = fmaxf(mx, __shfl_xor(mx, 32));
    float mnew = fmaxf(mrun, mx); float alpha = expf(mrun - mnew); mrun = mnew;
    float ps = 0.f; bf16_t pb[16];
#pragma unroll
    for (int i = 0; i < 16; ++i) { float e = expf(s[i] - mnew); ps += e; pb[i] = f2bf(e); }
    lrun = lrun * alpha + ps;
#pragma unroll
    for (int i = 0; i < 16; ++i) { o0[i] *= alpha; o1[i] *= alpha; }
#pragma unroll
    for (int st = 0; st < 2; ++st) {
      s8v pf;
#pragma unroll
      for (int j = 0; j < 8; ++j) pf[j] = (short)pb[8 * st + j];
#pragma unroll
      for (int db = 0; db < 2; ++db) {
        const bf16_t* vp = VT + (size_t)(db * 32 + ql) * nkeys + k0 + 16 * st + 4 * hh;
        u2v a = *(const u2v*)vp, b2 = *(const u2v*)(vp + 8);
        s8v vf = __builtin_bit_cast(s8v, u4v{a.x, a.y, b2.x, b2.y});
        if (db == 0) o0 = __builtin_amdgcn_mfma_f32_32x32x16_bf16(vf, pf, o0, 0, 0, 0);
        else o1 = __builtin_amdgcn_mfma_f32_32x32x16_bf16(vf, pf, o1, 0, 0, 0);
      }
    }
  }
  float ltot = lrun + __shfl_xor(lrun, 32); float inv = 1.f / ltot;
  const bf16_t* Z = (const bf16_t*)(ws + O_Z);
  bf16_t* O = (bf16_t*)(ws + O_OBR) + (size_t)1 * MG * 512;
#pragma unroll
  for (int db = 0; db < 2; ++db)
#pragma unroll
    for (int i = 0; i < 16; ++i) {
      int dv = db * 32 + (i & 3) + 8 * (i >> 2) + 4 * hh; float ov = (db == 0 ? o0[i] : o1[i]) * inv;
      float gt = siluf_(bf2f(Z[(size_t)mq * IN_W + ZC_GB + h * 64 + dv]));
      O[(size_t)mq * 512 + h * 64 + dv] = f2bf(ov * gt);
    }
}

__device__ __forceinline__ void stage_dft2(const Params& p, const Grp& g, int bid, int nb, char* smem) {
  char* ws = p.ws;
  const bf16_t* Z = (const bf16_t*)(ws + O_Z);
  const int T = g.T, ntt = T / 128;
  const int NT_D2 = g.nseq * 4 * ntt;
  for (int t = bid; t < NT_D2; t += nb) {
    int sq = t / (4 * ntt), r = t % (4 * ntt), gg = r / ntt, tt = r % ntt;
    long mbase = (long)sq * T;
    f4v acc[2][4]; zero_acc<4>(acc);
    gemm_mainloop<4>((const bf16_t*)(ws + (g.isden ? O_A2D : O_A2C)), 2 * T, tt * 128, T, (const bf16_t*)(ws + O_YT) + (size_t)mbase * 1024 + (size_t)gg * 128 * 2 * T, 2 * T, 0, 128, 2 * T, smem, acc);
    bf16_t* O = (bf16_t*)(ws + O_OBR) + (size_t)3 * MG * 512;
    const float sc = rsqrtf(128.f * (float)T);
    epi_foreach<4>(acc, tt * 128, 0, [&](int row, int c0, f4v& v) {
      long m = mbase + row; int c = gg * 128 + c0; u2v gd = *(const u2v*)(Z + (size_t)m * IN_W + ZC_GD + c);
      *(u2v*)(O + (size_t)m * 512 + c) = pack4(v[0] * sc * siluf_(bflo(gd.x)), v[1] * sc * siluf_(bfhi(gd.x)), v[2] * sc * siluf_(bflo(gd.y)), v[3] * sc * siluf_(bfhi(gd.y)));
    });
  }
}

constexpr int SCAN_LDS_PER_WAVE = 8 * 768;
__device__ __forceinline__ void scan_task(const Params& p, const Grp& g, int l, int task, char* wl) {
  char* ws = p.ws;
  const int lane = my_tid() & 63;
  const int T = g.T;
  const int ch = task >> 4, rg = task & 15;
  const int dir = ch & 1, h = (ch >> 1) & 7, sq = ch >> 4;
  const long mbase = (long)sq * T;
  const int row = rg * 4 + (lane >> 4), kl = lane & 15;
  const char* rec0 = (const char*)((const bf16_t*)(ws + O_SOP) + ((size_t)sq * 8 + h) * T * 576);
  float* YS = (float*)(ws + O_YS) + (size_t)dir * MG * 512;
  float s0 = 0.f, s1 = 0.f, s2 = 0.f, s3 = 0.f;
  if (g.isden) { const float* st = (dir ? p.st_b : p.st_f) + ((((size_t)sq * NL + l) * 8 + h) * 64 + row) * 64 + kl * 4; s0 = st[0]; s1 = st[1]; s2 = st[2]; s3 = st[3]; }
  int soff[6], sstep[6];
#pragma unroll
  for (int i = 0; i < 6; ++i) { int c = lane + 64 * i; int st = c / 48, w = c % 48; sstep[i] = st; soff[i] = (w < 24) ? w * 16 : ((dir ? 768 : 384) + (w - 24) * 16); }
  u4v pf[6];
  const int nbt = T >> 3;
#pragma unroll
  for (int i = 0; i < 6; ++i) { int tt = dir ? T - 1 - sstep[i] : sstep[i]; pf[i] = *(const u4v*)(rec0 + (size_t)tt * 1152 + soff[i]); }
  for (int bt = 0; bt < nbt; ++bt) {
    WAVE_SYNC();
#pragma unroll
    for (int i = 0; i < 6; ++i) *(u4v*)(wl + (lane + 64 * i) * 16) = pf[i];
    WAVE_SYNC();
    if (bt + 1 < nbt) {
#pragma unroll
      for (int i = 0; i < 6; ++i) { int st = (bt + 1) * 8 + sstep[i]; int tt = dir ? T - 1 - st : st; pf[i] = *(const u4v*)(rec0 + (size_t)tt * 1152 + soff[i]); }
    }
#pragma unroll
    for (int s = 0; s < 8; ++s) {
      const char* b = wl + s * 768;
      u2v r = *(const u2v*)(b + kl * 8), kk = *(const u2v*)(b + 128 + kl * 8), dd = *(const u2v*)(b + 384 + kl * 8), bb = *(const u2v*)(b + 512 + kl * 8), kt = *(const u2v*)(b + 640 + kl * 8);
      float v = bf2f(*(const bf16_t*)(b + 256 + row * 2));
      float sa = -sum16(s0 * bflo(kk.x) + s1 * bfhi(kk.x) + s2 * bflo(kk.y) + s3 * bfhi(kk.y));
      s0 = s0 - s0 * bflo(dd.x) + sa * bflo(bb.x) + v * bflo(kt.x); s1 = s1 - s1 * bfhi(dd.x) + sa * bfhi(bb.x) + v * bfhi(kt.x);
      s2 = s2 - s2 * bflo(dd.y) + sa * bflo(bb.y) + v * bflo(kt.y); s3 = s3 - s3 * bfhi(dd.y) + sa * bfhi(bb.y) + v * bfhi(kt.y);
      float y = sum16(s0 * bflo(r.x) + s1 * bfhi(r.x) + s2 * bflo(r.y) + s3 * bfhi(r.y));
      int st = bt * 8 + s; int tt = dir ? T - 1 - st : st;
      if (kl == 0) YS[(size_t)(mbase + tt) * 512 + h * 64 + row] = y;
    }
  }
  if (!g.isden) { float* so = p.out + (dir ? OUT_SB : OUT_SF) + ((((size_t)(g.b0 + sq) * NL + l) * 8 + h) * 64 + row) * 64 + kl * 4; *(f4v*)so = f4v{s0, s1, s2, s3}; }
}

__device__ __forceinline__ void stage_mix(const Params& p, const Grp& g, int l, int bid, int nb, char* smem) {
  const int wid = my_tid() >> 6;
  const int NS = g.nseq * 256, q32 = g.T / 32, NA = g.nseq * 8 * q32;
  char* wl = smem + wid * SCAN_LDS_PER_WAVE;
  for (int task = wid * nb + bid; task < NS + NA; task += nb * NWAVE) {
    if (task < NS) scan_task(p, g, l, task, wl);
    else { int t = task - NS; int sq = t / (8 * q32), r = t % (8 * q32); attention_task(p, g, sq, r / q32, r % q32); }
  }
}

__device__ __forceinline__ void stage_e3(const Params& p, const Grp& g, int l, int bid, int nb) {
  const int lane = my_tid() & 63, wid = my_tid() >> 6;
  char* ws = p.ws;
  const float* YS = (const float*)(ws + O_YS); const bf16_t* SOP = (const bf16_t*)(ws + O_SOP); const float* BON = (const float*)(ws + O_BON); const int T = g.T;
  const bf16_t* Z = (const bf16_t*)(ws + O_Z); bf16_t* O = (bf16_t*)(ws + O_OBR);
  for (int m = bid * NWAVE + wid; m < g.mg; m += nb * NWAVE) {
#pragma unroll 2
    for (int i = 0; i < 8; ++i) {
      int c = lane + 64 * i;
      float o = YS[(size_t)m * 512 + c] + YS[((size_t)MG + m) * 512 + c];
      float mean = wave_sum(o) * (1.f / 64.f); float d = o - mean; float var = wave_sum(d * d) * (1.f / 64.f);
      float y = d * rsqrtf(var + 64e-5f) * p.ln_g[(size_t)l * 512 + c] + p.ln_b[(size_t)l * 512 + c] + BON[(size_t)m * 8 + i] * bf2f(SOP[(((size_t)(m / T) * 8 + i) * T + (m % T)) * 576 + 128 + lane]);
      O[(size_t)m * 512 + c] = f2bf(y * siluf_(bf2f(Z[(size_t)m * IN_W + ZC_GA + c])));
    }
  }
}

__device__ __forceinline__ void stage_g8(const Params& p, const Grp& g, int l, int bid, int nb, char* smem) {
  char* ws = p.ws;
  bf16_t* MGD = (bf16_t*)(ws + O_MERGED);
  const bf16_t* H = (const bf16_t*)(ws + O_H);
  const int TM = (g.mg + 127) / 128, mg = g.mg;
  for (int t = bid; t < TM * 16; t += nb) {
    int tn = t / TM, tm = t % TM;
    f4v macc[2][2]; zero_acc<2>(macc);
    for (int n = 0; n < 4; ++n) {
      f4v ag[2][2]; zero_acc<2>(ag);
      gemm_mainloop<2>(H, 1024, tm * 128, mg, (const bf16_t*)(ws + O_WMT) + (size_t)n * 1024 * 1024, 1024, tn * 64, 1024, 1024, smem, ag);
      const float* bm = p.b_merge + (size_t)l * 4096 + n * 1024;
      epi_foreach<2>(ag, 0, tn * 64, [&](int row, int c0, f4v& v) {
#pragma unroll
        for (int e = 0; e < 4; ++e) v[e] = sigmoidf_(v[e] + bm[c0 + e]);
      });
      f4v ap[2][2]; zero_acc<2>(ap);
      gemm_mainloop<2>((const bf16_t*)(ws + O_OBR) + (size_t)n * MG * 512, 512, tm * 128, mg, (const bf16_t*)(ws + O_WBRT) + (size_t)n * 1024 * 512, 512, tn * 64, 1024, 512, smem, ap);
#pragma unroll
      for (int i = 0; i < 2; ++i)
#pragma unroll
        for (int j = 0; j < 2; ++j)
#pragma unroll
          for (int e = 0; e < 4; ++e) macc[i][j][e] += ag[i][j][e] * ap[i][j][e];
    }
    epi_foreach<2>(macc, tm * 128, tn * 64, [&](int row, int c0, f4v& v) {
      if (row < mg) *(u2v*)(MGD + (size_t)row * 1024 + c0) = pack4(v[0], v[1], v[2], v[3]);
    });
  }
}

__device__ __forceinline__ void stage_g9(const Params& p, const Grp& g, int l, int bid, int nb, char* smem) {
  char* ws = p.ws;
  float* X = p.out + (size_t)g.m0 * 1024;
  const float* modp = (const float*)(ws + O_MOD) + (size_t)l * 3 * 3072 + 2048;
  const int TM = (g.mg + 127) / 128, mg = g.mg;
  for (int t = bid; t < TM * 8; t += nb) {
    int tn = t / TM, tm = t % TM;
    f4v acc[2][4]; zero_acc<4>(acc);
    gemm_mainloop<4>((const bf16_t*)(ws + O_MERGED), 1024, tm * 128, mg, (const bf16_t*)(ws + O_WOUTT), 1024, tn * 128, 1024, 1024, smem, acc);
    epi_foreach<4>(acc, tm * 128, tn * 128, [&](int row, int c0, f4v& v) {
      if (row < mg) { const float* gt = modp + (size_t)mod_index(g, row) * 3072 + c0; f4v* xp = (f4v*)(X + (size_t)row * 1024 + c0); f4v x = *xp;
        x[0] += gt[0] * v[0]; x[1] += gt[1] * v[1]; x[2] += gt[2] * v[2]; x[3] += gt[3] * v[3]; *xp = x; }
    });
  }
}

__device__ __forceinline__ void stage_final(const Params& p, int bid, int nb) {
  const int lane = my_tid() & 63, wid = my_tid() >> 6;
  for (int m = bid * NWAVE + wid; m < M; m += nb * NWAVE) {
    float* xr = p.out + (size_t)m * 1024; float4 q[4]; float ss = 0.f;
#pragma unroll
    for (int i = 0; i < 4; ++i) { q[i] = *(const float4*)(xr + i * 256 + lane * 4); ss += q[i].x * q[i].x + q[i].y * q[i].y + q[i].z * q[i].z + q[i].w * q[i].w; }
    ss = wave_sum(ss); float rs = rsqrtf(ss * (1.f / 1024.f) + 1e-6f);
#pragma unroll
    for (int i = 0; i < 4; ++i) { int c = i * 256 + lane * 4; float4 gm = *(const float4*)(p.final_g + c);
      *(float4*)(xr + c) = make_float4(q[i].x * rs * gm.x, q[i].y * rs * gm.y, q[i].z * rs * gm.z, q[i].w * rs * gm.w); }
  }
}

#ifdef EMU
#define DECL_SMEM(name) char* name = emu::smem()
#else
#define DECL_SMEM(name) __shared__ __attribute__((aligned(16))) char name[SMEM_BYTES]
#endif

#ifndef EMU
namespace cg = cooperative_groups;
#else
namespace cg = cooperative_groups;
#endif

__global__ void __launch_bounds__(NTHR) mega_kernel(Params p) {
  DECL_SMEM(smem);
  cg::grid_group grid = cg::this_grid();
  const int bid = blockIdx.x, nb = gridDim.x;
  for (int l = 0; l < NL; ++l) {
    stage_prep(p, l, bid, nb, smem);
    if (l == 0) grid.sync();
    { Grp g0 = get_grp(0); stage_h(p, g0, l, bid, nb); }
    grid.sync();
    for (int gi = 0; gi < NGRP; ++gi) {
      Grp g = get_grp(gi);
      stage_g1(p, g, bid, nb, smem); grid.sync();
      stage_e1(p, g, l, bid, nb); grid.sync();
      stage_g2(p, g, l, bid, nb, smem); grid.sync();
      stage_e2(p, g, l, bid, nb); grid.sync();
      stage_mix(p, g, l, bid, nb, smem); grid.sync();
      stage_dft2(p, g, bid, nb, smem);
      stage_e3(p, g, l, bid, nb); grid.sync();
      stage_g8(p, g, l, bid, nb, smem); grid.sync();
      stage_g9(p, g, l, bid, nb, smem);
      if (gi + 1 < NGRP) { Grp gn = get_grp(gi + 1); stage_h(p, gn, l, bid, nb); }
      grid.sync();
    }
  }
  stage_final(p, bid, nb);
}

extern "C" void kernel_launch(void* const* d_in, const int* in_sizes, int n_in, void* d_out, int out_size, void* d_ws, size_t ws_size,
                              hipStream_t stream) {
  Params p{};
  const float** pp = (const float**)&p;
  for (int i = 0; i < 35; ++i) pp[i] = (const float*)d_in[i];
  p.out = (float*)d_out; p.ws = (char*)d_ws;
#ifdef EMU
  emu::set_coop(true);
  emu_launch(dim3(8), dim3(NTHR), [=]() { mega_kernel(p); });
  emu::set_coop(false);
#else
  static int grid_blocks = 0;
  if (!grid_blocks) {
    int dev = 0, cus = 0, per_cu = 0;
    (void)hipGetDevice(&dev);
    (void)hipDeviceGetAttribute(&cus, hipDeviceAttributeMultiprocessorCount, dev);
    (void)hipOccupancyMaxActiveBlocksPerMultiprocessor(&per_cu, mega_kernel, NTHR, 0);
    if (per_cu > 1) per_cu = 1;
    if (per_cu < 1) per_cu = 1;
    grid_blocks = cus * per_cu;
  }
  void* args[] = {&p};
  (void)hipLaunchCooperativeKernel((void*)mega_kernel, dim3(grid_blocks), dim3(NTHR), args, 0, stream);
#endif
  (void)in_sizes; (void)n_in; (void)out_size; (void)ws_size;
}
```

```cpp
#ifdef EMU
#include "hip_emu.h"
#else
#include <hip/hip_runtime.h>
#include <hip/hip_cooperative_groups.h>
#endif
#include <stdint.h>

#ifndef CFG_BATCH
#define CFG_BATCH 32
#define CFG_SEQ 256
#define CFG_DEC_BATCH 2
#define CFG_DEC_SEQ 2048
#define CFG_PAST 512
#define CFG_NGRP_C 2
#endif
constexpr int D = 1024, NL = 2;
constexpr int NB_C = CFG_BATCH, T_C = CFG_SEQ, NB_D = CFG_DEC_BATCH, T_D = CFG_DEC_SEQ, PAST = CFG_PAST;
constexpr int M_C = NB_C * T_C, M_D = NB_D * T_D, M = M_C + M_D;
constexpr int NGRP_C = CFG_NGRP_C, NGRP = 1 + NGRP_C;
constexpr int MGC = M_C / NGRP_C, SEQ_PER_CG = NB_C / NGRP_C;
constexpr int MG = MGC > M_D ? MGC : M_D;
constexpr int MKV = MG + NB_D * PAST;
constexpr int KEYS_D = T_D + PAST;
constexpr int IN_W = 5728;
constexpr int ZC_R = 0, ZC_K = 512, ZC_V = 1024, ZC_WDF = 1536, ZC_GA = 1728, ZC_QD = 2240, ZC_KVD = 2496, ZC_KR = 2624,
              ZC_GB = 2656, ZC_U = 3168, ZC_VC = 3680, ZC_GC = 4192, ZC_F = 4704, ZC_GD = 5216;
constexpr int SHIFT_W = 1728;
static_assert(M_C % NGRP_C == 0 && NB_C % NGRP_C == 0, "ctx groups");
static_assert(T_C % 128 == 0 && T_D % 128 == 0 && PAST % 32 == 0, "seq multiples");

typedef unsigned short bf16_t;
typedef short s8v __attribute__((ext_vector_type(8)));
typedef float f4v __attribute__((ext_vector_type(4)));
typedef float f16v __attribute__((ext_vector_type(16)));
typedef unsigned u4v __attribute__((ext_vector_type(4)));
typedef unsigned u2v __attribute__((ext_vector_type(2)));

struct Params {
  const float *x_prompt, *x_sample, *st_f, *st_b, *c_ckv, *c_kr, *c, *c_ctx, *norm_g, *w_ada, *b_ada, *w_in, *shift_mu, *w0, *w_up,
      *a0, *a_up, *k_k, *k_a, *r_k, *ln_g, *ln_b, *q_norm, *w_q_up, *kv_norm, *w_kv_up, *g_ln_g, *g_ln_b, *g_w_s, *g_b_s, *w_branch,
      *w_merge, *b_merge, *w_out, *final_g;
  float* out;
  char* ws;
};

struct Grp { int isden, m0, mg, nseq, T, b0, nkeys, mkv; };
__host__ __device__ __forceinline__ Grp get_grp(int gi) {
  Grp g;
  if (gi == 0) { g.isden = 1; g.m0 = M_C; g.mg = M_D; g.nseq = NB_D; g.T = T_D; g.b0 = 0; g.nkeys = KEYS_D; g.mkv = M_D + NB_D * PAST; }
  else { g.isden = 0; g.m0 = (gi - 1) * MGC; g.mg = MGC; g.nseq = SEQ_PER_CG; g.T = T_C; g.b0 = (gi - 1) * SEQ_PER_CG; g.nkeys = T_C; g.mkv = MGC; }
  return g;
}

constexpr size_t al256(size_t x) { return (x + 255) & ~(size_t)255; }
constexpr size_t O_WINT = 0;
constexpr size_t O_WMT = O_WINT + al256((size_t)IN_W * 1024 * 2);
constexpr size_t O_WBRT = O_WMT + al256((size_t)4096 * 1024 * 2);
constexpr size_t O_WOUTT = O_WBRT + al256((size_t)4 * 1024 * 512 * 2);
constexpr size_t O_WQT = O_WOUTT + al256((size_t)1024 * 1024 * 2);
constexpr size_t O_WKVT = O_WQT + al256((size_t)768 * 256 * 2);
constexpr size_t O_WUPT = O_WKVT + al256((size_t)1024 * 128 * 2);
constexpr size_t O_WS = O_WUPT + al256((size_t)4 * 512 * 64 * 2);
constexpr size_t O_CS128 = O_WS + al256((size_t)4 * 128 * 128 * 2);
constexpr size_t O_A2C = O_CS128 + al256((size_t)256 * 128 * 2);
constexpr size_t O_A2D = O_A2C + al256((size_t)T_C * 2 * T_C * 2);
constexpr size_t O_ROPE = O_A2D + al256((size_t)T_D * 2 * T_D * 2);
constexpr size_t O_MOD = O_ROPE + al256((size_t)T_D * 32 * 4);
constexpr size_t O_H = O_MOD + al256((size_t)NL * 3 * 3072 * 4);
constexpr size_t O_Z = O_H + al256((size_t)MG * 1024 * 2);
constexpr size_t O_SK = O_Z + al256((size_t)MG * IN_W * 2);
constexpr size_t O_SOP = O_SK + al256((size_t)MG * 512 * 2);
constexpr size_t O_YS = O_SOP + al256((size_t)MG * 8 * 576 * 2);
constexpr size_t O_BON = O_YS + al256((size_t)2 * MG * 512 * 4);
constexpr size_t O_LORA = O_BON + al256((size_t)MG * 8 * 4);
constexpr size_t O_PRE = O_LORA + al256((size_t)MG * 192 * 2);
constexpr size_t O_QDN = O_PRE + al256((size_t)MG * 2048 * 2);
constexpr size_t O_CKV = O_QDN + al256((size_t)MG * 256 * 2);
constexpr size_t O_KR = O_CKV + al256((size_t)MKV * 128 * 2);
constexpr size_t O_Q = O_KR + al256((size_t)MKV * 32 * 2);
constexpr size_t O_KN = O_Q + al256((size_t)MG * 768 * 2);
constexpr size_t O_VT = O_KN + al256((size_t)MKV * 512 * 2);
constexpr size_t O_VCNT = O_VT + al256((size_t)MKV * 512 * 2);
constexpr size_t O_YT = O_VCNT + al256((size_t)MG * 512 * 2);
constexpr size_t O_OBR = O_YT + al256((size_t)MG * 1024 * 2);
constexpr size_t O_MERGED = O_OBR + al256((size_t)4 * MG * 512 * 2);
constexpr size_t O_END = O_MERGED + al256((size_t)MG * 1024 * 2);
constexpr size_t O_BAR = O_END;
constexpr size_t BAR_BYTES = 3456 * 4;
static_assert(O_BAR + BAR_BYTES <= ((size_t)256 << 20), "workspace must fit 256 MiB");

constexpr size_t OUT_SF = (size_t)M * D, OUT_SB = OUT_SF + (size_t)NB_C * NL * 8 * 64 * 64,
                 OUT_CKV = OUT_SB + (size_t)NB_C * NL * 8 * 64 * 64, OUT_KR = OUT_CKV + (size_t)NB_C * NL * T_C * 128;

__device__ __forceinline__ int my_tid() {
#ifdef EMU
  return (int)threadIdx.x;
#else
  int t = (int)threadIdx.x; asm volatile("" : "+v"(t)); return t;
#endif
}
__device__ __forceinline__ unsigned f_as_u(float f) { return __builtin_bit_cast(unsigned, f); }
__device__ __forceinline__ float u_as_f(unsigned u) { return __builtin_bit_cast(float, u); }
__device__ __forceinline__ bf16_t f2bf(float f) { unsigned u = f_as_u(f); u += 0x7FFFu + ((u >> 16) & 1u); return (bf16_t)(u >> 16); }
__device__ __forceinline__ float bf2f(bf16_t h) { return u_as_f(((unsigned)h) << 16); }
__device__ __forceinline__ float bflo(unsigned u) { return u_as_f(u << 16); }
__device__ __forceinline__ float bfhi(unsigned u) { return u_as_f(u & 0xFFFF0000u); }
__device__ __forceinline__ float sigmoidf_(float x) { return 1.f / (1.f + expf(-x)); }
__device__ __forceinline__ float siluf_(float x) { return x / (1.f + expf(-x)); }
__device__ __forceinline__ float geluf_(float x) { return 0.5f * x * (1.f + tanhf(0.7978845608028654f * (x + 0.044715f * x * x * x))); }
__device__ __forceinline__ float wave_sum(float v) {
#pragma unroll
  for (int o = 32; o >= 1; o >>= 1) v += __shfl_xor(v, o);
  return v;
}

#ifdef EMU
#define WAVE_SYNC() emu::wave_barrier()
__device__ __forceinline__ float sum16(float v) { v += __shfl_xor(v, 1); v += __shfl_xor(v, 2); v += __shfl_xor(v, 4); v += __shfl_xor(v, 8); return v; }
#else
#define WAVE_SYNC() __builtin_amdgcn_wave_barrier()
__device__ __forceinline__ float sum16(float v) {
  v += u_as_f(__builtin_amdgcn_update_dpp(0, (int)f_as_u(v), 0xB1, 0xF, 0xF, true));
  v += u_as_f(__builtin_amdgcn_update_dpp(0, (int)f_as_u(v), 0x4E, 0xF, 0xF, true));
  v += u_as_f(__builtin_amdgcn_update_dpp(0, (int)f_as_u(v), 0x141, 0xF, 0xF, true));
  v += u_as_f(__builtin_amdgcn_update_dpp(0, (int)f_as_u(v), 0x140, 0xF, 0xF, true));
  return v;
}
#endif

constexpr int NTHR = 512, NWAVE = 8;
constexpr int LDS_STR = 72;
constexpr int SMEM_BYTES = 2 * (128 + 128) * LDS_STR * 2;

template <int NJ>
__device__ __forceinline__ void zero_acc(f4v (&acc)[2][NJ]) {
#pragma unroll
  for (int i = 0; i < 2; ++i)
#pragma unroll
    for (int j = 0; j < NJ; ++j) acc[i][j] = f4v{0.f, 0.f, 0.f, 0.f};
}

template <int NJ>
__device__ __forceinline__ void gemm_mainloop(const bf16_t* __restrict__ A, long lda, int arow0, int arows, const bf16_t* __restrict__ B,
                                              long ldb, int brow0, int brows, int K, char* smem, f4v (&acc)[2][NJ]) {
  constexpr int BROWS = 32 * NJ, NBL = NJ / 2;
  constexpr int BUF = (128 + 128) * LDS_STR;
  bf16_t* s0 = (bf16_t*)smem;
  const int tid = my_tid(), lane = tid & 63, wid = tid >> 6, wm = wid >> 1, wn = wid & 1;
  u4v ra[2], rb[NBL];
  const bf16_t* ap[2]; const bf16_t* bp[NBL];
#pragma unroll
  for (int i = 0; i < 2; ++i) { int c = tid + NTHR * i, r = c >> 3, cc = c & 7; int ar = arow0 + r; ar = ar < arows ? ar : arows - 1; ap[i] = A + (long)ar * lda + cc * 8; }
#pragma unroll
  for (int i = 0; i < NBL; ++i) { int c = tid + NTHR * i, r = c >> 3, cc = c & 7; int br = brow0 + r; br = br < brows ? br : brows - 1; bp[i] = B + (long)br * ldb + cc * 8; }
#pragma unroll
  for (int i = 0; i < 2; ++i) ra[i] = *(const u4v*)(ap[i]);
#pragma unroll
  for (int i = 0; i < NBL; ++i) rb[i] = *(const u4v*)(bp[i]);
  __syncthreads();
#pragma unroll
  for (int i = 0; i < 2; ++i) { int c = tid + NTHR * i, r = c >> 3, cc = c & 7; *(u4v*)(s0 + r * LDS_STR + cc * 8) = ra[i]; }
#pragma unroll
  for (int i = 0; i < NBL; ++i) { int c = tid + NTHR * i, r = c >> 3, cc = c & 7; *(u4v*)(s0 + (128 + r) * LDS_STR + cc * 8) = rb[i]; }
  __syncthreads();
  const int nk = K >> 6;
  for (int kt = 0; kt < nk; ++kt) {
    const bool more = kt + 1 < nk;
    if (more) {
#pragma unroll
      for (int i = 0; i < 2; ++i) ra[i] = *(const u4v*)(ap[i] + (kt + 1) * 64);
#pragma unroll
      for (int i = 0; i < NBL; ++i) rb[i] = *(const u4v*)(bp[i] + (kt + 1) * 64);
    }
    const bf16_t* sA = s0 + (kt & 1) * BUF; const bf16_t* sB = sA + 128 * LDS_STR;
#pragma unroll
    for (int ks = 0; ks < 2; ++ks) {
      s8v af[2], bf[NJ];
#pragma unroll
      for (int i = 0; i < 2; ++i) af[i] = *(const s8v*)(sA + (wm * 32 + i * 16 + (lane & 15)) * LDS_STR + ks * 32 + (lane >> 4) * 8);
#pragma unroll
      for (int j = 0; j < NJ; ++j) bf[j] = *(const s8v*)(sB + (wn * NJ * 16 + j * 16 + (lane & 15)) * LDS_STR + ks * 32 + (lane >> 4) * 8);
#pragma unroll
      for (int i = 0; i < 2; ++i)
#pragma unroll
        for (int j = 0; j < NJ; ++j) acc[i][j] = __builtin_amdgcn_mfma_f32_16x16x32_bf16(bf[j], af[i], acc[i][j], 0, 0, 0);
    }
    if (more) {
      bf16_t* dA = s0 + ((kt + 1) & 1) * BUF;
#pragma unroll
      for (int i = 0; i < 2; ++i) { int c = tid + NTHR * i, r = c >> 3, cc = c & 7; *(u4v*)(dA + r * LDS_STR + cc * 8) = ra[i]; }
#pragma unroll
      for (int i = 0; i < NBL; ++i) { int c = tid + NTHR * i, r = c >> 3, cc = c & 7; *(u4v*)(dA + (128 + r) * LDS_STR + cc * 8) = rb[i]; }
    }
    __syncthreads();
  }
  (void)BROWS;
}

template <int NJ, class F>
__device__ __forceinline__ void epi_foreach(f4v (&acc)[2][NJ], int row0, int col0, F f) {
  const int tid = my_tid(), lane = tid & 63, wid = tid >> 6, wm = wid >> 1, wn = wid & 1;
#pragma unroll
  for (int i = 0; i < 2; ++i)
#pragma unroll
    for (int j = 0; j < NJ; ++j) f(row0 + wm * 32 + i * 16 + (lane & 15), col0 + wn * NJ * 16 + j * 16 + (lane >> 4) * 4, acc[i][j]);
}
__device__ __forceinline__ u2v pack4(float a, float b, float c, float d) {
  return u2v{(unsigned)f2bf(a) | ((unsigned)f2bf(b) << 16), (unsigned)f2bf(c) | ((unsigned)f2bf(d) << 16)};
}

struct TJob { const float* src; int K, N; long lds; bf16_t* dst; long ldd; };
__device__ __forceinline__ TJob get_tjob(const Params& p, int l, int j) {
  TJob t; char* ws = p.ws;
  if (j == 0) { t.src = p.w_in + (size_t)l * 1024 * IN_W; t.K = 1024; t.N = IN_W; t.lds = IN_W; t.dst = (bf16_t*)(ws + O_WINT); t.ldd = 1024; }
  else if (j == 1) { t.src = p.w_merge + (size_t)l * 1024 * 4096; t.K = 1024; t.N = 4096; t.lds = 4096; t.dst = (bf16_t*)(ws + O_WMT); t.ldd = 1024; }
  else if (j < 6) { int n = j - 2; t.src = p.w_branch + ((size_t)l * 4 + n) * 512 * 1024; t.K = 512; t.N = 1024; t.lds = 1024; t.dst = (bf16_t*)(ws + O_WBRT) + (size_t)n * 1024 * 512; t.ldd = 512; }
  else if (j == 6) { t.src = p.w_out + (size_t)l * 1024 * 1024; t.K = 1024; t.N = 1024; t.lds = 1024; t.dst = (bf16_t*)(ws + O_WOUTT); t.ldd = 1024; }
  else if (j == 7) { t.src = p.w_q_up + (size_t)l * 256 * 768; t.K = 256; t.N = 768; t.lds = 768; t.dst = (bf16_t*)(ws + O_WQT); t.ldd = 256; }
  else if (j == 8) { t.src = p.w_kv_up + (size_t)l * 128 * 1024; t.K = 128; t.N = 1024; t.lds = 1024; t.dst = (bf16_t*)(ws + O_WKVT); t.ldd = 128; }
  else { int n = j - 9;
    t.src = (n < 2 ? p.w_up : p.a_up) + ((size_t)l * 2 + (n & 1)) * 64 * 512; t.K = 64; t.N = 512; t.lds = 512;
    t.dst = (bf16_t*)(ws + O_WUPT) + (size_t)n * 512 * 64; t.ldd = 64; }
  return t;
}
constexpr int NTJOBS = 13;

__device__ __forceinline__ void stage_prep(const Params& p, int l, int bid, int nb, char* smem) {
  const int tid = my_tid();
  char* ws = p.ws;
  {
    float* tile = (float*)smem;
    long base = 0;
    for (int j = 0; j < NTJOBS; ++j) {
      TJob t = get_tjob(p, l, j);
      int tk = t.K / 32, tn = t.N / 32, nt = tk * tn;
      long first = ((bid - base) % nb + nb) % nb;
      for (long q = first; q < nt; q += nb) {
        int kt = (int)(q / tn), nt_ = (int)(q % tn);
        __syncthreads();
#pragma unroll
        for (int i = 0; i < 2; ++i) { int e = tid + NTHR * i, r = e >> 5, c = e & 31; tile[r * 33 + c] = t.src[(long)(kt * 32 + r) * t.lds + nt_ * 32 + c]; }
        __syncthreads();
#pragma unroll
        for (int i = 0; i < 2; ++i) { int e = tid + NTHR * i, r = e >> 5, c = e & 31; t.dst[(long)(nt_ * 32 + r) * t.ldd + kt * 32 + c] = f2bf(tile[c * 33 + r]); }
      }
      base += nt;
    }
    __syncthreads();
  }
  const long gtid = (long)bid * NTHR + tid, gn = (long)nb * NTHR;
  { bf16_t* d = (bf16_t*)(ws + O_WS); const float* s = p.g_w_s + (size_t)l * 4 * 128 * 128; for (long i = gtid; i < (long)4 * 128 * 128; i += gn) d[i] = f2bf(s[i]); }
  if (l != 0) return;
  { bf16_t* d = (bf16_t*)(ws + O_CS128);
    for (long i = gtid; i < 256 * 128; i += gn) { int j = (int)(i >> 7), c = (int)(i & 127); int mm = ((j & 127) * c) & 127; float x = 2.0f * mm / 128.f; d[i] = f2bf(j < 128 ? cospif(x) : sinpif(x)); } }
  { bf16_t* d = (bf16_t*)(ws + O_A2C);
    for (long i = gtid; i < (long)T_C * 2 * T_C; i += gn) { int tp = (int)(i / (2 * T_C)), tt = (int)(i % (2 * T_C)); int half = tt >= T_C; int t = half ? tt - T_C : tt; int mm = (int)(((long)tp * t) % T_C); float x = 2.0f * mm / (float)T_C; d[i] = f2bf(half ? -sinpif(x) : cospif(x)); } }
  { bf16_t* d = (bf16_t*)(ws + O_A2D);
    for (long i = gtid; i < (long)T_D * 2 * T_D; i += gn) { int tp = (int)(i / (2 * T_D)), tt = (int)(i % (2 * T_D)); int half = tt >= T_D; int t = half ? tt - T_D : tt; int mm = (int)(((long)tp * t) % T_D); float x = 2.0f * mm / (float)T_D; d[i] = f2bf(half ? -sinpif(x) : cospif(x)); } }
  { float* d = (float*)(ws + O_ROPE);
    for (long i = gtid; i < (long)T_D * 16; i += gn) { int t = (int)(i >> 4), pi = (int)(i & 15); float pos = (pi < 8) ? (float)(t / 64) : (float)(t % 64); float inv = expf(-(float)(pi & 7) * (9.210340371976184f / 8.f)); float a = pos * inv; d[2 * i] = cosf(a); d[2 * i + 1] = sinf(a); } }
  { float4* d = (float4*)p.out; const float4* s0 = (const float4*)p.x_prompt; const float4* s1 = (const float4*)p.x_sample;
    for (long i = gtid; i < (long)M * 256; i += gn) d[i] = (i < (long)M_C * 256) ? s0[i] : s1[i - (long)M_C * 256]; }
  {
    float* red = (float*)smem;
    float* modp = (float*)(ws + O_MOD);
    for (int u = bid; u < NL * 48; u += nb) {
      int ll = u / 48, cg = u % 48; int col = cg * 64 + (tid & 63), kq = tid >> 6;
      float a0 = 0.f, a1 = 0.f, a2 = 0.f;
      const float* w = p.w_ada + (size_t)ll * 1024 * 3072 + col;
      for (int k = kq * 128; k < kq * 128 + 128; ++k) {
        float wv = w[(size_t)k * 3072];
        a0 += siluf_(p.c_ctx[k]) * wv; a1 += siluf_(p.c[k]) * wv; a2 += siluf_(p.c[(NB_D > 1 ? 1024 : 0) + k]) * wv;
      }
      __syncthreads();
      red[(kq * 3 + 0) * 64 + (tid & 63)] = a0; red[(kq * 3 + 1) * 64 + (tid & 63)] = a1; red[(kq * 3 + 2) * 64 + (tid & 63)] = a2;
      __syncthreads();
      if (tid < 192) { int mi = tid >> 6, cc = tid & 63; float s = 0.f;
#pragma unroll
        for (int q8 = 0; q8 < 8; ++q8) s += red[(q8 * 3 + mi) * 64 + cc];
        modp[((size_t)ll * 3 + mi) * 3072 + cg * 64 + cc] = s + p.b_ada[(size_t)ll * 3072 + cg * 64 + cc]; }
    }
  }
}

__device__ __forceinline__ int mod_index(const Grp& g, int lm) { return g.isden ? 1 + lm / T_D : 0; }

__device__ __forceinline__ void stage_h(const Params& p, const Grp& g, int l, int bid, int nb) {
  const int lane = my_tid() & 63, wid = my_tid() >> 6;
  const float* X = p.out + (size_t)g.m0 * 1024;
  bf16_t* H = (bf16_t*)(p.ws + O_H);
  const float* modp = (const float*)(p.ws + O_MOD) + (size_t)l * 3 * 3072;
  const float* gam = p.norm_g + (size_t)l * 1024;
  for (int m = bid * NWAVE + wid; m < g.mg; m += nb * NWAVE) {
    const float* xr = X + (size_t)m * 1024; float v[16]; float ss = 0.f;
#pragma unroll
    for (int i = 0; i < 4; ++i) { float4 q = *(const float4*)(xr + i * 256 + lane * 4); v[4 * i] = q.x; v[4 * i + 1] = q.y; v[4 * i + 2] = q.z; v[4 * i + 3] = q.w; ss += q.x * q.x + q.y * q.y + q.z * q.z + q.w * q.w; }
    ss = wave_sum(ss); float rs = rsqrtf(ss * (1.f / 1024.f) + 1e-6f);
    const float* mo = modp + (size_t)mod_index(g, m) * 3072;
#pragma unroll
    for (int i = 0; i < 4; ++i) {
      int c = i * 256 + lane * 4; bf16_t o[4];
#pragma unroll
      for (int e = 0; e < 4; ++e) o[e] = f2bf(v[4 * i + e] * rs * gam[c + e] * (1.f + mo[1024 + c + e]) + mo[c + e]);
      *(uint2*)(H + (size_t)m * 1024 + c) = make_uint2((unsigned)o[0] | ((unsigned)o[1] << 16), (unsigned)o[2] | ((unsigned)o[3] << 16));
    }
  }
}

__device__ __forceinline__ void stage_g1(const Params& p, const Grp& g, int bid, int nb, char* smem) {
  const bf16_t* H = (const bf16_t*)(p.ws + O_H);
  const bf16_t* W = (const bf16_t*)(p.ws + O_WINT);
  bf16_t* Z = (bf16_t*)(p.ws + O_Z);
  const int TM = (g.mg + 127) / 128; constexpr int TN = (IN_W + 127) / 128;
  const int mg = g.mg;
  for (int t = bid; t < TM * TN; t += nb) {
    int tn = t / TM, tm = t % TM; f4v acc[2][4]; zero_acc<4>(acc);
    gemm_mainloop<4>(H, 1024, tm * 128, mg, W, 1024, tn * 128, IN_W, 1024, smem, acc);
    epi_foreach<4>(acc, tm * 128, tn * 128, [&](int row, int c0, f4v& v) {
      if (c0 < IN_W && row < mg) *(u2v*)(Z + (size_t)row * IN_W + c0) = pack4(v[0], v[1], v[2], v[3]);
    });
  }
}

__device__ __forceinline__ void stage_e1(const Params& p, const Grp& g, int l, int bid, int nb) {
  const int lane = my_tid() & 63, wid = my_tid() >> 6;
  char* ws = p.ws;
  const bf16_t* Z = (const bf16_t*)(ws + O_Z);
  bf16_t* SK = (bf16_t*)(ws + O_SK); bf16_t* SOP = (bf16_t*)(ws + O_SOP);
  bf16_t* LORA = (bf16_t*)(ws + O_LORA); bf16_t* QDN = (bf16_t*)(ws + O_QDN); bf16_t* CKV = (bf16_t*)(ws + O_CKV); bf16_t* KR = (bf16_t*)(ws + O_KR);
  bf16_t* VCNT = (bf16_t*)(ws + O_VCNT);
  const float* rope = (const float*)(ws + O_ROPE);
  const float* mu = p.shift_mu + (size_t)l * SHIFT_W;
  const int isden = g.isden, T = g.T;
  for (int m = bid * NWAVE + wid; m < g.mkv; m += nb * NWAVE) {
    if (m >= g.mg) {
      int r = m - g.mg, b = r / PAST, j = r % PAST;
      const float* s = p.c_ckv + (((size_t)b * NL + l) * PAST + j) * 128;
      CKV[(size_t)m * 128 + lane] = f2bf(s[lane]); CKV[(size_t)m * 128 + 64 + lane] = f2bf(s[64 + lane]);
      if (lane < 32) KR[(size_t)m * 32 + lane] = f2bf(p.c_kr[(((size_t)b * NL + l) * PAST + j) * 32 + lane]);
      continue;
    }
    const int sq = m / T, t = m % T, b = g.b0 + sq;
    const bf16_t* z = Z + (size_t)m * IN_W;
    const bool hp = t > 0, hn = t < T - 1;
#pragma unroll 4
    for (int i = 0; i < 24; ++i) {
      int c = lane + 64 * i; float zc = bf2f(z[c]);
      float pv = hp ? bf2f(z[c - IN_W]) : 0.f, nv = hn ? bf2f(z[c + IN_W]) : 0.f;
      bf16_t s = f2bf(zc + (0.5f * (pv + nv) - zc) * mu[c]);
      if (i < 8) SOP[(((size_t)sq * 8 + i) * T + t) * 576 + lane] = s; else if (i < 16) SK[(size_t)m * 512 + c - 512] = s; else SOP[(((size_t)sq * 8 + (i - 16)) * T + t) * 576 + 128 + lane] = s;
    }
#pragma unroll
    for (int i = 0; i < 3; ++i) {
      int c = ZC_WDF + lane + 64 * i; float zc = bf2f(z[c]);
      float pv = hp ? bf2f(z[c - IN_W]) : 0.f, nv = hn ? bf2f(z[c + IN_W]) : 0.f;
      float s = zc + (0.5f * (pv + nv) - zc) * mu[c];
      LORA[(size_t)m * 192 + lane + 64 * i] = f2bf(i < 2 ? tanhf(s) : s);
    }
    { float v[4]; float ss = 0.f;
#pragma unroll
      for (int i = 0; i < 4; ++i) { v[i] = bf2f(z[ZC_QD + lane + 64 * i]); ss += v[i] * v[i]; }
      ss = wave_sum(ss); float rs = rsqrtf(ss * (1.f / 256.f) + 1e-6f);
#pragma unroll
      for (int i = 0; i < 4; ++i) QDN[(size_t)m * 256 + lane + 64 * i] = f2bf(v[i] * rs * p.q_norm[(size_t)l * 256 + lane + 64 * i]); }
    { float v[2]; float ss = 0.f;
#pragma unroll
      for (int i = 0; i < 2; ++i) { v[i] = bf2f(z[ZC_KVD + lane + 64 * i]); ss += v[i] * v[i]; }
      ss = wave_sum(ss); float rs = rsqrtf(ss * (1.f / 128.f) + 1e-6f);
#pragma unroll
      for (int i = 0; i < 2; ++i) { float o = v[i] * rs * p.kv_norm[(size_t)l * 128 + lane + 64 * i];
        CKV[(size_t)m * 128 + lane + 64 * i] = f2bf(o);
        if (!isden) p.out[OUT_CKV + (((size_t)b * NL + l) * T_C + t) * 128 + lane + 64 * i] = o; } }
    { float v = lane < 32 ? bf2f(z[ZC_KR + (lane & 31)]) : 0.f; float pr = __shfl_xor(v, 1); float o = v;
      if (isden) { int pi = (lane & 31) >> 1; float cs = rope[((size_t)t * 16 + pi) * 2], sn = rope[((size_t)t * 16 + pi) * 2 + 1];
        o = (lane & 1) ? (pr * sn + v * cs) : (v * cs - pr * sn); }
      if (lane < 32) { KR[(size_t)m * 32 + lane] = f2bf(o); if (!isden) p.out[OUT_KR + (((size_t)b * NL + l) * T_C + t) * 32 + lane] = v; } }
    { float v[8]; float s1 = 0.f;
#pragma unroll
      for (int i = 0; i < 8; ++i) { v[i] = geluf_(bf2f(z[ZC_VC + lane + 64 * i])); s1 += v[i]; }
      s1 = wave_sum(s1); float mean = s1 * (1.f / 512.f); float s2 = 0.f;
#pragma unroll
      for (int i = 0; i < 8; ++i) { float d = v[i] - mean; s2 += d * d; }
      s2 = wave_sum(s2); float rs = rsqrtf(s2 * (1.f / 512.f) + 1e-5f);
#pragma unroll
      for (int i = 0; i < 8; ++i) { int ch = lane + 64 * i; float o = (v[i] - mean) * rs * p.g_ln_g[(size_t)l * 512 + ch] + p.g_ln_b[(size_t)l * 512 + ch];
        VCNT[(((size_t)(m >> 7) * 4 + (ch >> 7)) * 128 + (ch & 127)) * 128 + (m & 127)] = f2bf(o); } }
  }
}

__device__ __forceinline__ void stage_g2(const Params& p, const Grp& g, int l, int bid, int nb, char* smem) {
  char* ws = p.ws;
  const bf16_t* Z = (const bf16_t*)(ws + O_Z);
  const float* rope = (const float*)(ws + O_ROPE);
  const int mg = g.mg, mkv = g.mkv, T = g.T, isden = g.isden, nkeys = g.nkeys;
  const int TM_M = (mg + 127) / 128, TM_KV = (mkv + 127) / 128;
  const int NT_Q = TM_M * 6, NT_KV = TM_KV * 8, NT_LORA = TM_M * 16, NT_GM = (mg / 128) * 4, ntt = T / 128, NT_D1 = g.nseq * 8 * ntt;
  const int NT = NT_Q + NT_KV + NT_LORA + NT_GM + NT_D1;
  for (int t0 = bid; t0 < NT; t0 += nb) {
    int t = t0; f4v acc[2][4]; zero_acc<4>(acc);
    if (t < NT_Q) {
      int tn = t / TM_M, tm = t % TM_M;
      gemm_mainloop<4>((const bf16_t*)(ws + O_QDN), 256, tm * 128, mg, (const bf16_t*)(ws + O_WQT), 256, tn * 128, 768, 256, smem, acc);
      bf16_t* Q = (bf16_t*)(ws + O_Q);
      const float scale = 0.10206207261596575f;
      epi_foreach<4>(acc, tm * 128, tn * 128, [&](int row, int c0, f4v& v) {
        if (row >= mg) return;
        int cw = c0 % 96; float o0 = v[0], o1 = v[1], o2 = v[2], o3 = v[3];
        if (cw >= 64 && isden) { int tt = row % T_D; int pi = (cw - 64) >> 1; const float* rp = rope + ((size_t)tt * 16 + pi) * 2;
          float c_a = rp[0], s_a = rp[1], c_b = rp[2], s_b = rp[3];
          o0 = v[0] * c_a - v[1] * s_a; o1 = v[0] * s_a + v[1] * c_a; o2 = v[2] * c_b - v[3] * s_b; o3 = v[2] * s_b + v[3] * c_b; }
        *(u2v*)(Q + (size_t)row * 768 + c0) = pack4(o0 * scale, o1 * scale, o2 * scale, o3 * scale);
      });
      continue;
    }
    t -= NT_Q;
    if (t < NT_KV) {
      int tn = t / TM_KV, tm = t % TM_KV;
      gemm_mainloop<4>((const bf16_t*)(ws + O_CKV), 128, tm * 128, mkv, (const bf16_t*)(ws + O_WKVT), 128, tn * 128, 1024, 128, smem, acc);
      bf16_t* KN = (bf16_t*)(ws + O_KN); bf16_t* VT = (bf16_t*)(ws + O_VT);
      epi_foreach<4>(acc, tm * 128, tn * 128, [&](int row, int c0, f4v& v) {
        if (row >= mkv) return;
        int h = c0 >> 7, w = c0 & 127;
        if (w < 64) *(u2v*)(KN + (size_t)row * 512 + h * 64 + w) = pack4(v[0], v[1], v[2], v[3]);
        else { int sq, key;
          if (row < mg) { sq = row / T; key = row % T; } else { int r = row - mg; sq = r / PAST; key = T + r % PAST; }
#pragma unroll
          for (int e = 0; e < 4; ++e) VT[(((size_t)sq * 8 + h) * 64 + (w - 64 + e)) * nkeys + key] = f2bf(v[e]); }
      });
      continue;
    }
    t -= NT_KV;
    if (t < NT_LORA) {
      int g4 = t / (TM_M * 4), r = t % (TM_M * 4), tn = r / TM_M, tm = r % TM_M;
      int koff = g4 == 0 ? 0 : (g4 == 1 ? 64 : 128);
      gemm_mainloop<4>((const bf16_t*)(ws + O_LORA) + koff, 192, tm * 128, mg, (const bf16_t*)(ws + O_WUPT) + (size_t)g4 * 512 * 64, 64, tn * 128, 512, 64, smem, acc);
      bf16_t* PRE = (bf16_t*)(ws + O_PRE);
      const float* bias = (g4 < 2 ? p.w0 : p.a0) + ((size_t)l * 2 + (g4 & 1)) * 512;
      epi_foreach<4>(acc, tm * 128, tn * 128, [&](int row, int c0, f4v& v) {
        if (row < mg) *(u2v*)(PRE + ((size_t)row * 4 + g4) * 512 + c0) = pack4(v[0] + bias[c0], v[1] + bias[c0 + 1], v[2] + bias[c0 + 2], v[3] + bias[c0 + 3]);
      });
      continue;
    }
    t -= NT_LORA;
    if (t < NT_GM) {
      int ch = t >> 2, gg = t & 3;
      gemm_mainloop<4>((const bf16_t*)(ws + O_WS) + (size_t)gg * 128 * 128, 128, 0, 128, (const bf16_t*)(ws + O_VCNT) + ((size_t)ch * 4 + gg) * 128 * 128, 128, 0, 128, 128, smem, acc);
      bf16_t* O = (bf16_t*)(ws + O_OBR) + (size_t)2 * MG * 512;
      const float* bs = p.g_b_s + ((size_t)l * 4 + gg) * 128;
      epi_foreach<4>(acc, 0, 0, [&](int pp, int c0, f4v& v) {
        int m = ch * 128 + pp; int c = gg * 128 + c0; float bb = bs[pp];
        u2v uu = *(const u2v*)(Z + (size_t)m * IN_W + ZC_U + c), gc = *(const u2v*)(Z + (size_t)m * IN_W + ZC_GC + c);
        *(u2v*)(O + (size_t)m * 512 + c) = pack4(geluf_(bflo(uu.x)) * (v[0] + bb) * siluf_(bflo(gc.x)), geluf_(bfhi(uu.x)) * (v[1] + bb) * siluf_(bfhi(gc.x)),
                                                 geluf_(bflo(uu.y)) * (v[2] + bb) * siluf_(bflo(gc.y)), geluf_(bfhi(uu.y)) * (v[3] + bb) * siluf_(bfhi(gc.y)));
      });
      continue;
    }
    t -= NT_GM;
    {
      int per_seq = 8 * ntt; int sq = t / per_seq; int r = t % per_seq; int gg = r / (2 * ntt); int r2 = r % (2 * ntt); int tj = r2 / ntt, tt = r2 % ntt;
      long mbase = (long)sq * T;
      gemm_mainloop<4>((const bf16_t*)(ws + O_CS128), 128, tj * 128, 256, Z + (size_t)mbase * IN_W + ZC_F + gg * 128, IN_W, tt * 128, T, 128, smem, acc);
      bf16_t* YT = (bf16_t*)(ws + O_YT) + (size_t)mbase * 1024 + (size_t)gg * 128 * 2 * T;
      epi_foreach<4>(acc, tj * 128, tt * 128, [&](int j, int c0, f4v& v) {
        *(u2v*)(YT + (size_t)(j & 127) * 2 * T + (size_t)(j >> 7) * T + c0) = pack4(v[0], v[1], v[2], v[3]);
      });
    }
  }
}

__device__ __forceinline__ void stage_e2(const Params& p, const Grp& g, int l, int bid, int nb) {
  const int lane = my_tid() & 63, wid = my_tid() >> 6;
  char* ws = p.ws;
  const bf16_t* SK = (const bf16_t*)(ws + O_SK); bf16_t* SOP = (bf16_t*)(ws + O_SOP);
  float* BON = (float*)(ws + O_BON); const bf16_t* PRE = (const bf16_t*)(ws + O_PRE);
  const int T = g.T;
  for (int m = bid * NWAVE + wid; m < g.mg; m += nb * NWAVE) {
    const int sq = m / T, t = m % T;
#pragma unroll 2
    for (int i = 0; i < 8; ++i) {
      int c = lane + 64 * i;
      bf16_t* rec = SOP + (((size_t)sq * 8 + i) * T + t) * 576;
      float k = bf2f(SK[(size_t)m * 512 + c]), r = bf2f(rec[lane]);
      float kr = k * p.k_k[(size_t)l * 512 + c];
      float n2 = wave_sum(kr * kr); float kk = kr / fmaxf(sqrtf(n2), 1e-12f);
      rec[64 + lane] = f2bf(kk);
      float bon = 0.f;
#pragma unroll
      for (int d = 0; d < 2; ++d) {
        float pw = bf2f(PRE[((size_t)m * 4 + d) * 512 + c]), pa = bf2f(PRE[((size_t)m * 4 + 2 + d) * 512 + c]);
        float dec = expf(-0.6065306597126334f * sigmoidf_(pw));
        float a = sigmoidf_(pa);
        float kt = k * (1.f + (a - 1.f) * p.k_a[(size_t)l * 512 + c]);
        rec[(3 + 3 * d) * 64 + lane] = f2bf(1.f - dec); rec[(4 + 3 * d) * 64 + lane] = f2bf(kk * a); rec[(5 + 3 * d) * 64 + lane] = f2bf(kt);
        bon += r * kt * p.r_k[(size_t)l * 512 + c];
      }
      bon = wave_sum(bon);
      if (lane == 0) BON[(size_t)m * 8 + i] = bon;
    }
  }
}

__device__ __forceinline__ void attention_task(const Params& p, const Grp& g, int sq, int h, int qb32) {
  char* ws = p.ws;
  const int lane = my_tid() & 63, ql = lane & 31, hh = lane >> 5;
  const int T = g.T, nkeys = g.nkeys;
  const long mbase = (long)sq * T;
  const bf16_t* Q = (const bf16_t*)(ws + O_Q); const bf16_t* KN = (const bf16_t*)(ws + O_KN); const bf16_t* KRp = (const bf16_t*)(ws + O_KR);
  const bf16_t* VT = (const bf16_t*)(ws + O_VT) + ((size_t)sq * 8 + h) * 64 * nkeys;
  const long mq = mbase + qb32 * 32 + ql;
  s8v qf[6];
#pragma unroll
  for (int s = 0; s < 6; ++s) qf[s] = *(const s8v*)(Q + (size_t)mq * 768 + h * 96 + 16 * s + 8 * hh);
  f16v o0, o1;
#pragma unroll
  for (int i = 0; i < 16; ++i) { o0[i] = 0.f; o1[i] = 0.f; }
  float mrun = -1e30f, lrun = 0.f;
  for (int k0 = 0; k0 < nkeys; k0 += 32) {
    long krow = (k0 < T) ? mbase + k0 + ql : (long)g.mg + (long)sq * PAST + (k0 - T) + ql;
    f16v s;
#pragma unroll
    for (int i = 0; i < 16; ++i) s[i] = 0.f;
#pragma unroll
    for (int st = 0; st < 6; ++st) {
      s8v kf = (st < 4) ? *(const s8v*)(KN + (size_t)krow * 512 + h * 64 + 16 * st + 8 * hh) : *(const s8v*)(KRp + (size_t)krow * 32 + 16 * (st - 4) + 8 * hh);
      s = __builtin_amdgcn_mfma_f32_32x32x16_bf16(kf, qf[st], s, 0, 0, 0);
    }
    float mx = s[0];
#pragma unroll
    for (int i = 1; i < 16; ++i) mx = fmaxf(mx, s[i]);
    mx = fmaxf(mx, __shfl_xor(mx, 32));
    float mnew = fmaxf(mrun, mx); float alpha = expf(mrun - mnew); mrun = mnew;
    float ps = 0.f; bf16_t pb[16];
#pragma unroll
    for (int i = 0; i < 16; ++i) { float e = expf(s[i] - mnew); ps += e; pb[i] = f2bf(e); }
    lrun = lrun * alpha + ps;
#pragma unroll
    for (int i = 0; i < 16; ++i) { o0[i] *= alpha; o1[i] *= alpha; }
#pragma unroll
    for (int st = 0; st < 2; ++st) {
      s8v pf;
#pragma unroll
      for (int j = 0; j < 8; ++j) pf[j] = (short)pb[8 * st + j];
#pragma unroll
      for (int db = 0; db < 2; ++db) {
        const bf16_t* vp = VT + (size_t)(db * 32 + ql) * nkeys + k0 + 16 * st + 4 * hh;
        u2v a = *(const u2v*)vp, b2 = *(const u2v*)(vp + 8);
        s8v vf = __builtin_bit_cast(s8v, u4v{a.x, a.y, b2.x, b2.y});
        if (db == 0) o0 = __builtin_amdgcn_mfma_f32_32x32x16_bf16(vf, pf, o0, 0, 0, 0);
        else o1 = __builtin_amdgcn_mfma_f32_32x32x16_bf16(vf, pf, o1, 0, 0, 0);
      }
    }
  }
  float ltot = lrun + __shfl_xor(lrun, 32); float inv = 1.f / ltot;
  const bf16_t* Z = (const bf16_t*)(ws + O_Z);
  bf16_t* O = (bf16_t*)(ws + O_OBR) + (size_t)1 * MG * 512;
#pragma unroll
  for (int db = 0; db < 2; ++db)
#pragma unroll
    for (int i = 0; i < 16; ++i) {
      int dv = db * 32 + (i & 3) + 8 * (i >> 2) + 4 * hh; float ov = (db == 0 ? o0[i] : o1[i]) * inv;
      float gt = siluf_(bf2f(Z[(size_t)mq * IN_W + ZC_GB + h * 64 + dv]));
      O[(size_t)mq * 512 + h * 64 + dv] = f2bf(ov * gt);
    }
}

__device__ __forceinline__ void stage_dft2(const Params& p, const Grp& g, int bid, int nb, char* smem) {
  char* ws = p.ws;
  const bf16_t* Z = (const bf16_t*)(ws + O_Z);
  const int T = g.T, ntt = T / 128;
  const int NT_D2 = g.nseq * 4 * ntt;
  for (int t = bid; t < NT_D2; t += nb) {
    int sq = t / (4 * ntt), r = t % (4 * ntt), gg = r / ntt, tt = r % ntt;
    long mbase = (long)sq * T;
    f4v acc[2][4]; zero_acc<4>(acc);
    gemm_mainloop<4>((const bf16_t*)(ws + (g.isden ? O_A2D : O_A2C)), 2 * T, tt * 128, T, (const bf16_t*)(ws + O_YT) + (size_t)mbase * 1024 + (size_t)gg * 128 * 2 * T, 2 * T, 0, 128, 2 * T, smem, acc);
    bf16_t* O = (bf16_t*)(ws + O_OBR) + (size_t)3 * MG * 512;
    const float sc = rsqrtf(128.f * (float)T);
    epi_foreach<4>(acc, tt * 128, 0, [&](int row, int c0, f4v& v) {
      long m = mbase + row; int c = gg * 128 + c0; u2v gd = *(const u2v*)(Z + (size_t)m * IN_W + ZC_GD + c);
      *(u2v*)(O + (size_t)m * 512 + c) = pack4(v[0] * sc * siluf_(bflo(gd.x)), v[1] * sc * siluf_(bfhi(gd.x)), v[2] * sc * siluf_(bflo(gd.y)), v[3] * sc * siluf_(bfhi(gd.y)));
    });
  }
}

constexpr int SCAN_LDS_PER_WAVE = 8 * 768;
__device__ __forceinline__ void scan_task(const Params& p, const Grp& g, int l, int task, char* wl) {
  char* ws = p.ws;
  const int lane = my_tid() & 63;
  const int T = g.T;
  const int ch = task >> 4, rg = task & 15;
  const int dir = ch & 1, h = (ch >> 1) & 7, sq = ch >> 4;
  const long mbase = (long)sq * T;
  const int row = rg * 4 + (lane >> 4), kl = lane & 15;
  const char* rec0 = (const char*)((const bf16_t*)(ws + O_SOP) + ((size_t)sq * 8 + h) * T * 576);
  float* YS = (float*)(ws + O_YS) + (size_t)dir * MG * 512;
  float s0 = 0.f, s1 = 0.f, s2 = 0.f, s3 = 0.f;
  if (g.isden) { const float* st = (dir ? p.st_b : p.st_f) + ((((size_t)sq * NL + l) * 8 + h) * 64 + row) * 64 + kl * 4; s0 = st[0]; s1 = st[1]; s2 = st[2]; s3 = st[3]; }
  int soff[6], sstep[6];
#pragma unroll
  for (int i = 0; i < 6; ++i) { int c = lane + 64 * i; int st = c / 48, w = c % 48; sstep[i] = st; soff[i] = (w < 24) ? w * 16 : ((dir ? 768 : 384) + (w - 24) * 16); }
  u4v pf[6];
  const int nbt = T >> 3;
#pragma unroll
  for (int i = 0; i < 6; ++i) { int tt = dir ? T - 1 - sstep[i] : sstep[i]; pf[i] = *(const u4v*)(rec0 + (size_t)tt * 1152 + soff[i]); }
  for (int bt = 0; bt < nbt; ++bt) {
    WAVE_SYNC();
#pragma unroll
    for (int i = 0; i < 6; ++i) *(u4v*)(wl + (lane + 64 * i) * 16) = pf[i];
    WAVE_SYNC();
    if (bt + 1 < nbt) {
#pragma unroll
      for (int i = 0; i < 6; ++i) { int st = (bt + 1) * 8 + sstep[i]; int tt = dir ? T - 1 - st : st; pf[i] = *(const u4v*)(rec0 + (size_t)tt * 1152 + soff[i]); }
    }
#pragma unroll
    for (int s = 0; s < 8; ++s) {
      const char* b = wl + s * 768;
      u2v r = *(const u2v*)(b + kl * 8), kk = *(const u2v*)(b + 128 + kl * 8), dd = *(const u2v*)(b + 384 + kl * 8), bb = *(const u2v*)(b + 512 + kl * 8), kt = *(const u2v*)(b + 640 + kl * 8);
      float v = bf2f(*(const bf16_t*)(b + 256 + row * 2));
      float sa = -sum16(s0 * bflo(kk.x) + s1 * bfhi(kk.x) + s2 * bflo(kk.y) + s3 * bfhi(kk.y));
      s0 = s0 - s0 * bflo(dd.x) + sa * bflo(bb.x) + v * bflo(kt.x); s1 = s1 - s1 * bfhi(dd.x) + sa * bfhi(bb.x) + v * bfhi(kt.x);
      s2 = s2 - s2 * bflo(dd.y) + sa * bflo(bb.y) + v * bflo(kt.y); s3 = s3 - s3 * bfhi(dd.y) + sa * bfhi(bb.y) + v * bfhi(kt.y);
      float y = sum16(s0 * bflo(r.x) + s1 * bfhi(r.x) + s2 * bflo(r.y) + s3 * bfhi(r.y));
      int st = bt * 8 + s; int tt = dir ? T - 1 - st : st;
      if (kl == 0) YS[(size_t)(mbase + tt) * 512 + h * 64 + row] = y;
    }
  }
  if (!g.isden) { float* so = p.out + (dir ? OUT_SB : OUT_SF) + ((((size_t)(g.b0 + sq) * NL + l) * 8 + h) * 64 + row) * 64 + kl * 4; *(f4v*)so = f4v{s0, s1, s2, s3}; }
}

__device__ __forceinline__ void stage_mix(const Params& p, const Grp& g, int l, int bid, int nb, char* smem) {
  const int wid = my_tid() >> 6;
  const int NS = g.nseq * 256, q32 = g.T / 32, NA = g.nseq * 8 * q32;
  char* wl = smem + wid * SCAN_LDS_PER_WAVE;
  for (int task = wid * nb + bid; task < NS + NA; task += nb * NWAVE) {
    if (task < NS) scan_task(p, g, l, task, wl);
    else { int t = task - NS; int sq = t / (8 * q32), r = t % (8 * q32); attention_task(p, g, sq, r / q32, r % q32); }
  }
}

__device__ __forceinline__ void stage_e3(const Params& p, const Grp& g, int l, int bid, int nb) {
  const int lane = my_tid() & 63, wid = my_tid() >> 6;
  char* ws = p.ws;
  const float* YS = (const float*)(ws + O_YS); const bf16_t* SOP = (const bf16_t*)(ws + O_SOP); const float* BON = (const float*)(ws + O_BON); const int T = g.T;
  const bf16_t* Z = (const bf16_t*)(ws + O_Z); bf16_t* O = (bf16_t*)(ws + O_OBR);
  for (int m = bid * NWAVE + wid; m < g.mg; m += nb * NWAVE) {
#pragma unroll 2
    for (int i = 0; i < 8; ++i) {
      int c = lane + 64 * i;
      float o = YS[(size_t)m * 512 + c] + YS[((size_t)MG + m) * 512 + c];
      float mean = wave_sum(o) * (1.f / 64.f); float d = o - mean; float var = wave_sum(d * d) * (1.f / 64.f);
      float y = d * rsqrtf(var + 64e-5f) * p.ln_g[(size_t)l * 512 + c] + p.ln_b[(size_t)l * 512 + c] + BON[(size_t)m * 8 + i] * bf2f(SOP[(((size_t)(m / T) * 8 + i) * T + (m % T)) * 576 + 128 + lane]);
      O[(size_t)m * 512 + c] = f2bf(y * siluf_(bf2f(Z[(size_t)m * IN_W + ZC_GA + c])));
    }
  }
}

__device__ __forceinline__ void stage_g8(const Params& p, const Grp& g, int l, int bid, int nb, char* smem) {
  char* ws = p.ws;
  bf16_t* MGD = (bf16_t*)(ws + O_MERGED);
  const bf16_t* H = (const bf16_t*)(ws + O_H);
  const int TM = (g.mg + 127) / 128, mg = g.mg;
  for (int t = bid; t < TM * 16; t += nb) {
    int tn = t / TM, tm = t % TM;
    f4v macc[2][2]; zero_acc<2>(macc);
    for (int n = 0; n < 4; ++n) {
      f4v ag[2][2]; zero_acc<2>(ag);
      gemm_mainloop<2>(H, 1024, tm * 128, mg, (const bf16_t*)(ws + O_WMT) + (size_t)n * 1024 * 1024, 1024, tn * 64, 1024, 1024, smem, ag);
      const float* bm = p.b_merge + (size_t)l * 4096 + n * 1024;
      epi_foreach<2>(ag, 0, tn * 64, [&](int row, int c0, f4v& v) {
#pragma unroll
        for (int e = 0; e < 4; ++e) v[e] = sigmoidf_(v[e] + bm[c0 + e]);
      });
      f4v ap[2][2]; zero_acc<2>(ap);
      gemm_mainloop<2>((const bf16_t*)(ws + O_OBR) + (size_t)n * MG * 512, 512, tm * 128, mg, (const bf16_t*)(ws + O_WBRT) + (size_t)n * 1024 * 512, 512, tn * 64, 1024, 512, smem, ap);
#pragma unroll
      for (int i = 0; i < 2; ++i)
#pragma unroll
        for (int j = 0; j < 2; ++j)
#pragma unroll
          for (int e = 0; e < 4; ++e) macc[i][j][e] += ag[i][j][e] * ap[i][j][e];
    }
    epi_foreach<2>(macc, tm * 128, tn * 64, [&](int row, int c0, f4v& v) {
      if (row < mg) *(u2v*)(MGD + (size_t)row * 1024 + c0) = pack4(v[0], v[1], v[2], v[3]);
    });
  }
}

__device__ __forceinline__ void stage_g9(const Params& p, const Grp& g, int l, int bid, int nb, char* smem) {
  char* ws = p.ws;
  float* X = p.out + (size_t)g.m0 * 1024;
  const float* modp = (const float*)(ws + O_MOD) + (size_t)l * 3 * 3072 + 2048;
  const int TM = (g.mg + 127) / 128, mg = g.mg;
  for (int t = bid; t < TM * 8; t += nb) {
    int tn = t / TM, tm = t % TM;
    f4v acc[2][4]; zero_acc<4>(acc);
    gemm_mainloop<4>((const bf16_t*)(ws + O_MERGED), 1024, tm * 128, mg, (const bf16_t*)(ws + O_WOUTT), 1024, tn * 128, 1024, 1024, smem, acc);
    epi_foreach<4>(acc, tm * 128, tn * 128, [&](int row, int c0, f4v& v) {
      if (row < mg) { const float* gt = modp + (size_t)mod_index(g, row) * 3072 + c0; f4v* xp = (f4v*)(X + (size_t)row * 1024 + c0); f4v x = *xp;
        x[0] += gt[0] * v[0]; x[1] += gt[1] * v[1]; x[2] += gt[2] * v[2]; x[3] += gt[3] * v[3]; *xp = x; }
    });
  }
}

__device__ __forceinline__ void stage_final(const Params& p, int bid, int nb) {
  const int lane = my_tid() & 63, wid = my_tid() >> 6;
  for (int m = bid * NWAVE + wid; m < M; m += nb * NWAVE) {
    float* xr = p.out + (size_t)m * 1024; float4 q[4]; float ss = 0.f;
#pragma unroll
    for (int i = 0; i < 4; ++i) { q[i] = *(const float4*)(xr + i * 256 + lane * 4); ss += q[i].x * q[i].x + q[i].y * q[i].y + q[i].z * q[i].z + q[i].w * q[i].w; }
    ss = wave_sum(ss); float rs = rsqrtf(ss * (1.f / 1024.f) + 1e-6f);
#pragma unroll
    for (int i = 0; i < 4; ++i) { int c = i * 256 + lane * 4; float4 gm = *(const float4*)(p.final_g + c);
      *(float4*)(xr + c) = make_float4(q[i].x * rs * gm.x, q[i].y * rs * gm.y, q[i].z * rs * gm.z, q[i].w * rs * gm.w); }
  }
}

#ifdef EMU
#define DECL_SMEM(name) char* name = emu::smem()
#else
#define DECL_SMEM(name) __shared__ __attribute__((aligned(16))) char name[SMEM_BYTES]
#endif

#ifdef EMU
struct GridBar { __device__ void sync() const { emu::grid_sync(); } };
#else
#define XB_TMO      128
#define XB_XCNT(j)  (256  + 64 * (j))
#define XB_XSUB(j)  (1280 + 64 * (j))
#define XB_XGEN(j)  (2304 + 64 * (j))
#define XB_TOP      3328
#define XB_TOPGEN   3392
#define XB_SPIN_CAP (1u << 20)
#define LAS __attribute__((address_space(3)))
__device__ __forceinline__ unsigned xb_ld(unsigned* p)              { return __hip_atomic_load(p, __ATOMIC_RELAXED, __HIP_MEMORY_SCOPE_AGENT); }
__device__ __forceinline__ unsigned xb_add(unsigned* p, unsigned v) { return __hip_atomic_fetch_add(p, v, __ATOMIC_RELAXED, __HIP_MEMORY_SCOPE_AGENT); }
__device__ __forceinline__ unsigned xb_xcc_id() { return (unsigned)__builtin_amdgcn_s_getreg((3 << 11) | 20) & 0xFu; }
#define XB_SPIN(cond, bar) do { unsigned _sp = 0; while (cond) { __builtin_amdgcn_s_sleep(1); \
    if ((++_sp & 255u) == 0u) { if (xb_ld(&(bar)[XB_TMO])) break; if (_sp > XB_SPIN_CAP) { atomicAdd(&(bar)[XB_TMO], 1u); break; } } } } while (0)
struct GridBar {
  unsigned* bar; unsigned x; volatile LAS unsigned* st;
  __device__ __forceinline__ void post(unsigned* b, volatile LAS unsigned* s_) {
    bar = b; x = xb_xcc_id(); st = s_;
    if (threadIdx.x == 0) (void)xb_add(&bar[XB_XCNT(x)], 1u);
  }
  __device__ __forceinline__ void complete(unsigned& nloc, unsigned& nx) const {
    const unsigned G = gridDim.x;
    unsigned sum, cnt, mine, sp = 0u;
    for (;;) {
      sum = 0u; cnt = 0u; mine = 0u;
#pragma unroll
      for (unsigned j = 0; j < 16; ++j) { const unsigned c = xb_ld(&bar[XB_XCNT(j)]); sum += c; cnt += (c > 0u) ? 1u : 0u; mine = (j == x) ? c : mine; }
      if (sum == G) break;
      __builtin_amdgcn_s_sleep(1);
      if ((++sp & 255u) == 0u) { if (xb_ld(&bar[XB_TMO])) break; if (sp > XB_SPIN_CAP) { atomicAdd(&bar[XB_TMO], 1u); break; } }
    }
    nloc = mine > 0u ? mine : 1u; nx = cnt > 0u ? cnt : 1u;
  }
  __device__ __forceinline__ void sync() const {
    asm volatile("s_waitcnt vmcnt(0)" ::: "memory");
    __syncthreads();
    if (threadIdx.x == 0) {
      __builtin_amdgcn_s_waitcnt(0);
      unsigned nloc = st[0], nx = st[1];
      if (nloc == 0u) { complete(nloc, nx); st[0] = nloc; st[1] = nx; }
      const unsigned old = xb_add(&bar[XB_XSUB(x)], 1u);
      const unsigned gen = old / nloc;
      if (old + 1u == (gen + 1u) * nloc) {
        __builtin_amdgcn_fence(__ATOMIC_RELEASE, "agent");
        asm volatile("s_waitcnt vmcnt(0)" ::: "memory");
        const unsigned og = xb_add(&bar[XB_TOP], 1u);
        const unsigned tg = og / nx;
        if (og + 1u == (tg + 1u) * nx) xb_add(&bar[XB_TOPGEN], 1u);
        else XB_SPIN(xb_ld(&bar[XB_TOPGEN]) == tg, bar);
        __builtin_amdgcn_fence(__ATOMIC_ACQUIRE, "agent");
        xb_add(&bar[XB_XGEN(x)], 1u);
        asm volatile("s_waitcnt vmcnt(0)" ::: "memory");
      } else {
        XB_SPIN(xb_ld(&bar[XB_XGEN(x)]) == gen, bar);
        __builtin_amdgcn_fence(__ATOMIC_ACQUIRE, "agent");
        asm volatile("s_waitcnt vmcnt(0)" ::: "memory");
      }
    }
    __syncthreads();
  }
};
#endif

#ifndef EMU
namespace cg = cooperative_groups;
#else
namespace cg = cooperative_groups;
#endif

__global__ void __launch_bounds__(NTHR) mega_kernel(Params p) {
  DECL_SMEM(smem);
  cg::grid_group grid = cg::this_grid();
  const int bid = blockIdx.x, nb = gridDim.x;
  GridBar gb;
#ifndef EMU
  __shared__ uint4 xb_words;
  if (threadIdx.x == 0) xb_words = make_uint4(0u, 0u, 0u, 0u);
  __syncthreads();
  gb.post((unsigned*)(p.ws + O_BAR), (volatile LAS unsigned*)&xb_words);
#endif
  for (int l = 0; l < NL; ++l) {
    stage_prep(p, l, bid, nb, smem);
    if (l == 0) grid.sync();
    { Grp g0 = get_grp(0); stage_h(p, g0, l, bid, nb); }
    gb.sync();
    for (int gi = 0; gi < NGRP; ++gi) {
      Grp g = get_grp(gi);
      stage_g1(p, g, bid, nb, smem); gb.sync();
      stage_e1(p, g, l, bid, nb); gb.sync();
      stage_g2(p, g, l, bid, nb, smem); gb.sync();
      stage_e2(p, g, l, bid, nb); gb.sync();
      stage_mix(p, g, l, bid, nb, smem); gb.sync();
      stage_dft2(p, g, bid, nb, smem);
      stage_e3(p, g, l, bid, nb); gb.sync();
      stage_g8(p, g, l, bid, nb, smem); gb.sync();
      stage_g9(p, g, l, bid, nb, smem);
      if (gi + 1 < NGRP) { Grp gn = get_grp(gi + 1); stage_h(p, gn, l, bid, nb); }
      gb.sync();
    }
  }
  stage_final(p, bid, nb);
}

extern "C" void kernel_launch(void* const* d_in, const int* in_sizes, int n_in, void* d_out, int out_size, void* d_ws, size_t ws_size,
                              hipStream_t stream) {
  Params p{};
  const float** pp = (const float**)&p;
  for (int i = 0; i < 35; ++i) pp[i] = (const float*)d_in[i];
  p.out = (float*)d_out; p.ws = (char*)d_ws;
#ifdef EMU
  emu::set_coop(true);
  emu_launch(dim3(8), dim3(NTHR), [=]() { mega_kernel(p); });
  emu::set_coop(false);
#else
  static int grid_blocks = 0;
  if (!grid_blocks) {
    int dev = 0, cus = 0, per_cu = 0;
    (void)hipGetDevice(&dev);
    (void)hipDeviceGetAttribute(&cus, hipDeviceAttributeMultiprocessorCount, dev);
    (void)hipOccupancyMaxActiveBlocksPerMultiprocessor(&per_cu, mega_kernel, NTHR, 0);
    if (per_cu > 1) per_cu = 1;
    if (per_cu < 1) per_cu = 1;
    grid_blocks = cus * per_cu;
  }
  (void)hipMemsetAsync((char*)d_ws + O_BAR, 0, BAR_BYTES, stream);
  void* args[] = {&p};
  (void)hipLaunchCooperativeKernel((void*)mega_kernel, dim3(grid_blocks), dim3(NTHR), args, 0, stream);
#endif
  (void)in_sizes; (void)n_in; (void)out_size; (void)ws_size;
}
```

```cpp
#ifdef EMU
#include "hip_emu.h"
#else
#include <hip/hip_runtime.h>
#include <hip/hip_cooperative_groups.h>
#endif
#include <stdint.h>

#ifndef CFG_BATCH
#define CFG_BATCH 32
#define CFG_SEQ 256
#define CFG_DEC_BATCH 2
#define CFG_DEC_SEQ 2048
#define CFG_PAST 512
#define CFG_NGRP_C 2
#endif
constexpr int D = 1024, NL = 2;
constexpr int NB_C = CFG_BATCH, T_C = CFG_SEQ, NB_D = CFG_DEC_BATCH, T_D = CFG_DEC_SEQ, PAST = CFG_PAST;
constexpr int M_C = NB_C * T_C, M_D = NB_D * T_D, M = M_C + M_D;
constexpr int NGRP_C = CFG_NGRP_C, NGRP = 1 + NGRP_C;
constexpr int MGC = M_C / NGRP_C, SEQ_PER_CG = NB_C / NGRP_C;
constexpr int MG = MGC > M_D ? MGC : M_D;
constexpr int MKV = MG + NB_D * PAST;
constexpr int KEYS_D = T_D + PAST;
constexpr int IN_W = 5728;
constexpr int ZC_R = 0, ZC_K = 512, ZC_V = 1024, ZC_WDF = 1536, ZC_GA = 1728, ZC_QD = 2240, ZC_KVD = 2496, ZC_KR = 2624,
              ZC_GB = 2656, ZC_U = 3168, ZC_VC = 3680, ZC_GC = 4192, ZC_F = 4704, ZC_GD = 5216;
constexpr int SHIFT_W = 1728;
static_assert(M_C % NGRP_C == 0 && NB_C % NGRP_C == 0, "ctx groups");
static_assert(T_C % 128 == 0 && T_D % 128 == 0 && PAST % 32 == 0, "seq multiples");

typedef unsigned short bf16_t;
typedef short s8v __attribute__((ext_vector_type(8)));
typedef float f4v __attribute__((ext_vector_type(4)));
typedef float f16v __attribute__((ext_vector_type(16)));
typedef unsigned u4v __attribute__((ext_vector_type(4)));
typedef unsigned u2v __attribute__((ext_vector_type(2)));

struct Params {
  const float *x_prompt, *x_sample, *st_f, *st_b, *c_ckv, *c_kr, *c, *c_ctx, *norm_g, *w_ada, *b_ada, *w_in, *shift_mu, *w0, *w_up,
      *a0, *a_up, *k_k, *k_a, *r_k, *ln_g, *ln_b, *q_norm, *w_q_up, *kv_norm, *w_kv_up, *g_ln_g, *g_ln_b, *g_w_s, *g_b_s, *w_branch,
      *w_merge, *b_merge, *w_out, *final_g;
  float* out;
  char* ws;
};

struct Grp { int isden, m0, mg, nseq, T, b0, nkeys, mkv; };
__host__ __device__ __forceinline__ Grp get_grp(int gi) {
  Grp g;
  if (gi == 0) { g.isden = 1; g.m0 = M_C; g.mg = M_D; g.nseq = NB_D; g.T = T_D; g.b0 = 0; g.nkeys = KEYS_D; g.mkv = M_D + NB_D * PAST; }
  else { g.isden = 0; g.m0 = (gi - 1) * MGC; g.mg = MGC; g.nseq = SEQ_PER_CG; g.T = T_C; g.b0 = (gi - 1) * SEQ_PER_CG; g.nkeys = T_C; g.mkv = MGC; }
  return g;
}

constexpr size_t al256(size_t x) { return (x + 255) & ~(size_t)255; }
constexpr size_t O_WINT = 0;
constexpr int IN_WP = ((IN_W + 255) / 256) * 256;
constexpr size_t O_WMT = O_WINT + al256((size_t)IN_WP * 1024 * 2);
constexpr size_t O_WBRT = O_WMT + al256((size_t)4096 * 1024 * 2);
constexpr size_t O_WOUTT = O_WBRT + al256((size_t)4 * 1024 * 512 * 2);
constexpr size_t O_WQT = O_WOUTT + al256((size_t)1024 * 1024 * 2);
constexpr size_t O_WKVT = O_WQT + al256((size_t)768 * 256 * 2);
constexpr size_t O_WUPT = O_WKVT + al256((size_t)1024 * 128 * 2);
constexpr size_t O_WS = O_WUPT + al256((size_t)4 * 512 * 64 * 2);
constexpr size_t O_CS128 = O_WS + al256((size_t)4 * 128 * 128 * 2);
constexpr size_t O_A2C = O_CS128 + al256((size_t)256 * 128 * 2);
constexpr size_t O_A2D = O_A2C + al256((size_t)T_C * 2 * T_C * 2);
constexpr size_t O_ROPE = O_A2D + al256((size_t)T_D * 2 * T_D * 2);
constexpr size_t O_MOD = O_ROPE + al256((size_t)T_D * 32 * 4);
constexpr size_t O_H = O_MOD + al256((size_t)NL * 3 * 3072 * 4);
constexpr size_t O_Z = O_H + al256((size_t)MG * 1024 * 2);
constexpr size_t O_SK = O_Z + al256((size_t)MG * IN_W * 2);
constexpr size_t O_SOP = O_SK + al256((size_t)MG * 512 * 2);
constexpr size_t O_YS = O_SOP + al256((size_t)MG * 8 * 576 * 2);
constexpr size_t O_BON = O_YS + al256((size_t)2 * MG * 512 * 4);
constexpr size_t O_LORA = O_BON + al256((size_t)MG * 8 * 4);
constexpr size_t O_PRE = O_LORA + al256((size_t)MG * 192 * 2);
constexpr size_t O_QDN = O_PRE + al256((size_t)MG * 2048 * 2);
constexpr size_t O_CKV = O_QDN + al256((size_t)MG * 256 * 2);
constexpr size_t O_KR = O_CKV + al256((size_t)MKV * 128 * 2);
constexpr size_t O_Q = O_KR + al256((size_t)MKV * 32 * 2);
constexpr size_t O_KN = O_Q + al256((size_t)MG * 768 * 2);
constexpr size_t O_VT = O_KN + al256((size_t)MKV * 512 * 2);
constexpr size_t O_VCNT = O_VT + al256((size_t)MKV * 512 * 2);
constexpr size_t O_YT = O_VCNT + al256((size_t)MG * 512 * 2);
constexpr size_t O_OBR = O_YT + al256((size_t)MG * 1024 * 2);
constexpr size_t O_MERGED = O_OBR + al256((size_t)4 * MG * 512 * 2);
constexpr size_t O_END = O_MERGED + al256((size_t)MG * 1024 * 2);
constexpr size_t O_GATES = O_PRE;
static_assert(O_GATES + (size_t)MG * 4096 * 2 <= O_VCNT, "gates alias region too small");
constexpr size_t O_BAR = O_END;
constexpr size_t BAR_BYTES = 3456 * 4;
static_assert(O_BAR + BAR_BYTES <= ((size_t)256 << 20), "workspace must fit 256 MiB");

constexpr size_t OUT_SF = (size_t)M * D, OUT_SB = OUT_SF + (size_t)NB_C * NL * 8 * 64 * 64,
                 OUT_CKV = OUT_SB + (size_t)NB_C * NL * 8 * 64 * 64, OUT_KR = OUT_CKV + (size_t)NB_C * NL * T_C * 128;

#ifdef EMU
template <class T> __device__ __forceinline__ T* opaque(T* p) { return p; }
__device__ __forceinline__ int opaque_i(int v) { return v; }
#else
template <class T> __device__ __forceinline__ T* opaque(T* p) {
  typedef __attribute__((address_space(1))) T* gptr;
  gptr g = (gptr)p; asm volatile("" : "+s"(g)); return (T*)g;
}
__device__ __forceinline__ int opaque_i(int v) { asm volatile("" : "+s"(v)); return v; }
#endif
__device__ __forceinline__ int my_tid() {
#ifdef EMU
  return (int)threadIdx.x;
#else
  int t = (int)threadIdx.x; asm volatile("" : "+v"(t)); return t;
#endif
}
__device__ __forceinline__ unsigned f_as_u(float f) { return __builtin_bit_cast(unsigned, f); }
__device__ __forceinline__ float u_as_f(unsigned u) { return __builtin_bit_cast(float, u); }
__device__ __forceinline__ bf16_t f2bf(float f) { unsigned u = f_as_u(f); u += 0x7FFFu + ((u >> 16) & 1u); return (bf16_t)(u >> 16); }
__device__ __forceinline__ float bf2f(bf16_t h) { return u_as_f(((unsigned)h) << 16); }
__device__ __forceinline__ float bflo(unsigned u) { return u_as_f(u << 16); }
__device__ __forceinline__ float bfhi(unsigned u) { return u_as_f(u & 0xFFFF0000u); }
__device__ __forceinline__ float sigmoidf_(float x) { return 1.f / (1.f + expf(-x)); }
__device__ __forceinline__ float siluf_(float x) { return x / (1.f + expf(-x)); }
__device__ __forceinline__ float geluf_(float x) { return 0.5f * x * (1.f + tanhf(0.7978845608028654f * (x + 0.044715f * x * x * x))); }
__device__ __forceinline__ float wave_sum(float v) {
#pragma unroll
  for (int o = 32; o >= 1; o >>= 1) v += __shfl_xor(v, o);
  return v;
}

#ifdef EMU
#define WAVE_SYNC() emu::wave_barrier()
__device__ __forceinline__ float sum16(float v) { v += __shfl_xor(v, 1); v += __shfl_xor(v, 2); v += __shfl_xor(v, 4); v += __shfl_xor(v, 8); return v; }
#else
#define WAVE_SYNC() __builtin_amdgcn_wave_barrier()
__device__ __forceinline__ float sum16(float v) {
  v += u_as_f(__builtin_amdgcn_update_dpp(0, (int)f_as_u(v), 0xB1, 0xF, 0xF, true));
  v += u_as_f(__builtin_amdgcn_update_dpp(0, (int)f_as_u(v), 0x4E, 0xF, 0xF, true));
  v += u_as_f(__builtin_amdgcn_update_dpp(0, (int)f_as_u(v), 0x141, 0xF, 0xF, true));
  v += u_as_f(__builtin_amdgcn_update_dpp(0, (int)f_as_u(v), 0x140, 0xF, 0xF, true));
  return v;
}
#endif

template <int LPR> __device__ __forceinline__ float sum_lpr(float v) {
#ifdef EMU
  v += __shfl_xor(v, 1); v += __shfl_xor(v, 2); v += __shfl_xor(v, 4);
  if (LPR >= 16) v += __shfl_xor(v, 8);
  if (LPR >= 32) v += __shfl_xor(v, 16);
  return v;
#else
  v += u_as_f(__builtin_amdgcn_update_dpp(0, (int)f_as_u(v), 0xB1, 0xF, 0xF, true));
  v += u_as_f(__builtin_amdgcn_update_dpp(0, (int)f_as_u(v), 0x4E, 0xF, 0xF, true));
  v += u_as_f(__builtin_amdgcn_update_dpp(0, (int)f_as_u(v), 0x141, 0xF, 0xF, true));
  if (LPR >= 16) v += u_as_f(__builtin_amdgcn_update_dpp(0, (int)f_as_u(v), 0x140, 0xF, 0xF, true));
  if (LPR >= 32) { auto r = __builtin_amdgcn_permlane16_swap(f_as_u(v), f_as_u(v), false, false); v = u_as_f(r[0]) + u_as_f(r[1]); }
  return v;
#endif
}

template <int LPR> __device__ __forceinline__ void sum_lpr2(float& a, float& b) {
#ifdef EMU
  a = sum_lpr<LPR>(a); b = sum_lpr<LPR>(b);
#else
#define DPP_ADD2(ctrl) { float ta = u_as_f(__builtin_amdgcn_update_dpp(0, (int)f_as_u(a), ctrl, 0xF, 0xF, true)); float tb = u_as_f(__builtin_amdgcn_update_dpp(0, (int)f_as_u(b), ctrl, 0xF, 0xF, true)); a += ta; b += tb; }
  DPP_ADD2(0xB1) DPP_ADD2(0x4E) DPP_ADD2(0x141)
  if (LPR >= 16) DPP_ADD2(0x140)
  if (LPR >= 32) { auto ra = __builtin_amdgcn_permlane16_swap(f_as_u(a), f_as_u(a), false, false); auto rb = __builtin_amdgcn_permlane16_swap(f_as_u(b), f_as_u(b), false, false);
    a = u_as_f(ra[0]) + u_as_f(ra[1]); b = u_as_f(rb[0]) + u_as_f(rb[1]); }
#undef DPP_ADD2
#endif
}

constexpr int NTHR = 512, NWAVE = 8;
constexpr int LDS_STR = 72;
constexpr int SMEM_STAGE = 131072;
constexpr int SMEM_BYTES = SMEM_STAGE + 16;

template <int NJ>
__device__ __forceinline__ void zero_acc(f4v (&acc)[2][NJ]) {
#pragma unroll
  for (int i = 0; i < 2; ++i)
#pragma unroll
    for (int j = 0; j < NJ; ++j) acc[i][j] = f4v{0.f, 0.f, 0.f, 0.f};
}

template <int NJ>
__device__ __forceinline__ void gemm_mainloop(const bf16_t* __restrict__ A, long lda, int arow0, int arows, const bf16_t* __restrict__ B,
                                              long ldb, int brow0, int brows, int K, char* smem, f4v (&acc)[2][NJ]) {
  constexpr int BROWS = 32 * NJ, NBL = NJ / 2;
  constexpr int BUF = (128 + 128) * LDS_STR;
  bf16_t* s0 = (bf16_t*)smem;
  const int tid = my_tid(), lane = tid & 63, wid = tid >> 6, wm = wid >> 1, wn = wid & 1;
  u4v ra[2], rb[NBL];
  const bf16_t* ap[2]; const bf16_t* bp[NBL];
#pragma unroll
  for (int i = 0; i < 2; ++i) { int c = tid + NTHR * i, r = c >> 3, cc = c & 7; int ar = arow0 + r; ar = ar < arows ? ar : arows - 1; ap[i] = A + (long)ar * lda + cc * 8; }
#pragma unroll
  for (int i = 0; i < NBL; ++i) { int c = tid + NTHR * i, r = c >> 3, cc = c & 7; int br = brow0 + r; br = br < brows ? br : brows - 1; bp[i] = B + (long)br * ldb + cc * 8; }
#pragma unroll
  for (int i = 0; i < 2; ++i) ra[i] = *(const u4v*)(ap[i]);
#pragma unroll
  for (int i = 0; i < NBL; ++i) rb[i] = *(const u4v*)(bp[i]);
  __syncthreads();
#pragma unroll
  for (int i = 0; i < 2; ++i) { int c = tid + NTHR * i, r = c >> 3, cc = c & 7; *(u4v*)(s0 + r * LDS_STR + cc * 8) = ra[i]; }
#pragma unroll
  for (int i = 0; i < NBL; ++i) { int c = tid + NTHR * i, r = c >> 3, cc = c & 7; *(u4v*)(s0 + (128 + r) * LDS_STR + cc * 8) = rb[i]; }
  __syncthreads();
  const int nk = K >> 6;
  for (int kt = 0; kt < nk; ++kt) {
    const bool more = kt + 1 < nk;
    if (more) {
#pragma unroll
      for (int i = 0; i < 2; ++i) ra[i] = *(const u4v*)(ap[i] + (kt + 1) * 64);
#pragma unroll
      for (int i = 0; i < NBL; ++i) rb[i] = *(const u4v*)(bp[i] + (kt + 1) * 64);
    }
    const bf16_t* sA = s0 + (kt & 1) * BUF; const bf16_t* sB = sA + 128 * LDS_STR;
#pragma unroll
    for (int ks = 0; ks < 2; ++ks) {
      s8v af[2], bf[NJ];
#pragma unroll
      for (int i = 0; i < 2; ++i) af[i] = *(const s8v*)(sA + (wm * 32 + i * 16 + (lane & 15)) * LDS_STR + ks * 32 + (lane >> 4) * 8);
#pragma unroll
      for (int j = 0; j < NJ; ++j) bf[j] = *(const s8v*)(sB + (wn * NJ * 16 + j * 16 + (lane & 15)) * LDS_STR + ks * 32 + (lane >> 4) * 8);
#pragma unroll
      for (int i = 0; i < 2; ++i)
#pragma unroll
        for (int j = 0; j < NJ; ++j) acc[i][j] = __builtin_amdgcn_mfma_f32_16x16x32_bf16(bf[j], af[i], acc[i][j], 0, 0, 0);
    }
    if (more) {
      bf16_t* dA = s0 + ((kt + 1) & 1) * BUF;
#pragma unroll
      for (int i = 0; i < 2; ++i) { int c = tid + NTHR * i, r = c >> 3, cc = c & 7; *(u4v*)(dA + r * LDS_STR + cc * 8) = ra[i]; }
#pragma unroll
      for (int i = 0; i < NBL; ++i) { int c = tid + NTHR * i, r = c >> 3, cc = c & 7; *(u4v*)(dA + (128 + r) * LDS_STR + cc * 8) = rb[i]; }
    }
    __syncthreads();
  }
  (void)BROWS;
}

template <int NJ, class F>
__device__ __forceinline__ void epi_foreach(f4v (&acc)[2][NJ], int row0, int col0, F f) {
  const int tid = my_tid(), lane = tid & 63, wid = tid >> 6, wm = wid >> 1, wn = wid & 1;
#pragma unroll
  for (int i = 0; i < 2; ++i)
#pragma unroll
    for (int j = 0; j < NJ; ++j) f(row0 + wm * 32 + i * 16 + (lane & 15), col0 + wn * NJ * 16 + j * 16 + (lane >> 4) * 4, acc[i][j]);
}
__device__ __forceinline__ u2v pack4(float a, float b, float c, float d) {
  return u2v{(unsigned)f2bf(a) | ((unsigned)f2bf(b) << 16), (unsigned)f2bf(c) | ((unsigned)f2bf(d) << 16)};
}

#ifndef EMU
namespace pg8 {
#define PG8_LAS __attribute__((address_space(3)))
typedef unsigned short bf16_t;
typedef short bf16x8 __attribute__((ext_vector_type(8)));
typedef float f32x4 __attribute__((ext_vector_type(4)));
typedef unsigned u32x4 __attribute__((ext_vector_type(4)));
constexpr int BM = 256, BK = 64, HALF = 128, HTB = HALF * BK * 2  , STAGE_BYTES = 8 * HTB, NXCD = 8, WGM = 8;

__host__ __device__ __forceinline__ int lds_byte(int r, int c) { const int st = (r >> 4) * 2 + (c >> 5), rr = r & 15, cc = c & 31, ob = rr * 64 + cc * 2; return st * 1024 + (ob ^ (((ob >> 9) & 1) << 5)); }
__host__ __device__ __forceinline__ void stage_rc(int b, int& R, int& C) { const int st = b / 1024, sb = b % 1024, swz = sb ^ (((sb >> 9) & 1) << 5); R = (st >> 1) * 16 + swz / 64; C = (st & 1) * 32 + (swz % 64) / 2; }
__host__ __device__ __forceinline__ int perm32(int rho) { const int n = rho >> 4, i = rho & 15; return 8 * (i >> 2) + 4 * n + (i & 3); }

struct Unit { int pm, pn; };
struct Gemm { const bf16_t* A; const bf16_t* Bt; int M, N, K; };

struct StaticOrder {
    int nM, nN, nwg, G, c;
    __host__ __device__ void init(int M, int N, int G_, int c_) { nM = M / BM; nN = N / BM; nwg = nM * nN; G = G_; c = c_; }
    __host__ __device__ bool next(int i, Unit& u) const {
        const long L = (long)i * G + c; if (L >= nwg) return false;
        int wgid = (int)L; { const int q = nwg / NXCD, r = nwg % NXCD, xcd = wgid % NXCD, off = wgid / NXCD; wgid = (xcd < r ? xcd * (q + 1) : r * (q + 1) + (xcd - r) * q) + off; }
        const int nig = WGM * nN, gid = wgid / nig, fm = gid * WGM, gsz = (nM - fm) < WGM ? (nM - fm) : WGM;
        u.pm = fm + ((wgid % nig) % gsz); u.pn = (wgid % nig) / gsz; return true;
    }
    __device__ __forceinline__ void a_ready(const Unit&) const {}
    __device__ __forceinline__ void done(const Unit&) const {}
};
template <class Epi, class Sched>
__device__ __forceinline__ void gemm_phase(PG8_LAS unsigned char* lds, const Gemm g, const Sched& S, const Epi& E) {
    const int tid = my_tid(), wid = __builtin_amdgcn_readfirstlane(tid >> 6), lane = tid & 63, wr = wid >> 2, wc = wid & 3, fr = lane & 15, fq = lane >> 4;
    const int K = g.K, nt = K / BK;
    unsigned voffA[2], voffB[2];
#pragma unroll
    for (int i = 0; i < 2; ++i) { int R, C; stage_rc(tid * 16 + i * 8192, R, C); const int Rb = Epi::PERM ? ((R & ~31) + perm32(R & 31)) : R;
        voffA[i] = (unsigned)(R * K + C) * 2u; voffB[i] = (unsigned)(Rb * K + C) * 2u; }
    const size_t kstep = (size_t)(BK * 2);
    const size_t hstep = (size_t)HALF * K * 2;
    const size_t tstep = 2 * hstep;
    const unsigned ldsw = (unsigned)wid * 1024u;
    const int aoff = lds_byte(wr * 64 + fr, fq * 8), boff = lds_byte(wc * 32 + fr, fq * 8);
#define PG8_SA(b, h) (((b) * 2 + (h)) * HTB)
#define PG8_SB(b, h) ((4 + (b) * 2 + (h)) * HTB)
#define PG8_STAGE(bufoff, gbase, voff) do { _Pragma("unroll") for (int _i = 0; _i < 2; ++_i) \
        __builtin_amdgcn_global_load_lds((const unsigned*)((const char*)(gbase) + (voff)[_i]), (PG8_LAS unsigned*)(lds + (bufoff) + ldsw + _i * 8192), 16, 0, 0); } while (0)
#define PG8_LDA(dst, b, h) do { _Pragma("unroll") for (int m = 0; m < 4; ++m) _Pragma("unroll") for (int k = 0; k < 2; ++k) dst[m][k] = *(const PG8_LAS bf16x8*)(lds + PG8_SA(b, h) + aoff + m * 2048 + k * 1024); } while (0)
#define PG8_LDB(dst, b, h) do { _Pragma("unroll") for (int n = 0; n < 2; ++n) _Pragma("unroll") for (int k = 0; k < 2; ++k) dst[n][k] = *(const PG8_LAS bf16x8*)(lds + PG8_SB(b, h) + boff + n * 2048 + k * 1024); } while (0)
#define PG8_MMA(ai, bj, At, Bt) do { __builtin_amdgcn_s_setprio(1); _Pragma("unroll") for (int m = 0; m < 4; ++m) _Pragma("unroll") for (int n = 0; n < 2; ++n) _Pragma("unroll") for (int k = 0; k < 2; ++k) \
        acc[ai][bj][m][n] = __builtin_amdgcn_mfma_f32_16x16x32_bf16(Bt[n][k], At[m][k], acc[ai][bj][m][n], 0, 0, 0); __builtin_amdgcn_s_setprio(0); } while (0)
#define PG8_WAIT_V(n) asm volatile("s_waitcnt vmcnt(" #n ")" ::: "memory")
#define PG8_WAIT_L(n) asm volatile("s_waitcnt lgkmcnt(" #n ")" ::: "memory")
#define PG8_BAR __builtin_amdgcn_s_barrier()
#define PG8_SCHED __builtin_amdgcn_sched_barrier(0)
    Unit cur, nxt; int ui = 0;
    if (!S.next(0, cur)) return;
    f32x4 acc[2][2][4][2];
#pragma unroll
    for (int a = 0; a < 2; ++a)
#pragma unroll
        for (int b = 0; b < 2; ++b)
#pragma unroll
            for (int m = 0; m < 4; ++m)
#pragma unroll
                for (int n = 0; n < 2; ++n) acc[a][b][m][n] = (f32x4){0.f, 0.f, 0.f, 0.f};
    bf16x8 At[4][2], B0[2][2], B1[2][2];
    const char* cA = (const char*)g.A + (size_t)cur.pm * tstep; const char* cB = (const char*)g.Bt + (size_t)cur.pn * tstep;
    S.a_ready(cur);
    PG8_STAGE(PG8_SB(0, 0), cB, voffB); PG8_STAGE(PG8_SA(0, 0), cA, voffA); PG8_STAGE(PG8_SB(0, 1), cB + hstep, voffB); PG8_STAGE(PG8_SA(0, 1), cA + hstep, voffA);
    if (wr == 1) PG8_BAR;
    PG8_WAIT_V(4); PG8_BAR;
    PG8_STAGE(PG8_SB(1, 0), cB + kstep, voffB); PG8_STAGE(PG8_SA(1, 0), cA + kstep, voffA); PG8_STAGE(PG8_SB(1, 1), cB + hstep + kstep, voffB);
    PG8_WAIT_V(6); PG8_BAR;
    for (;;) {
        const bool has_next = S.next(ui + 1, nxt);
        const char* nA = has_next ? (const char*)g.A + (size_t)nxt.pm * tstep : cA; const char* nB = has_next ? (const char*)g.Bt + (size_t)nxt.pn * tstep : cB;
        for (int t = 0; t < nt; t += 2) {
            const bool last = (t == nt - 2);
            const char* a1 = cA + (size_t)(t + 1) * kstep;
            const char* a2 = last ? nA : cA + (size_t)(t + 2) * kstep; const char* b2 = last ? nB : cB + (size_t)(t + 2) * kstep;
            const char* a3 = a2 + kstep; const char* b3 = b2 + kstep;
            if (last && has_next) S.a_ready(nxt);
            PG8_LDB(B0, 0, 0); PG8_SCHED; PG8_LDA(At, 0, 0); PG8_STAGE(PG8_SA(1, 1), a1 + hstep, voffA);
            PG8_WAIT_L(8); PG8_BAR; PG8_WAIT_L(0); PG8_MMA(0, 0, At, B0); PG8_BAR; PG8_SCHED;
            PG8_LDB(B1, 0, 1); PG8_STAGE(PG8_SB(0, 0), b2, voffB);
            PG8_BAR; PG8_WAIT_L(0); PG8_MMA(0, 1, At, B1); PG8_BAR;
            PG8_LDA(At, 0, 1); PG8_STAGE(PG8_SA(0, 0), a2, voffA);
            PG8_BAR; PG8_WAIT_L(0); PG8_MMA(1, 0, At, B0); PG8_BAR; PG8_SCHED;
            PG8_STAGE(PG8_SB(0, 1), b2 + hstep, voffB);
            PG8_WAIT_V(6); PG8_BAR; PG8_MMA(1, 1, At, B1); PG8_BAR;
            PG8_LDB(B0, 1, 0); PG8_SCHED; PG8_LDA(At, 1, 0); PG8_STAGE(PG8_SA(0, 1), a2 + hstep, voffA);
            PG8_WAIT_L(8); PG8_BAR; PG8_WAIT_L(0); PG8_MMA(0, 0, At, B0); PG8_BAR; PG8_SCHED;
            PG8_LDB(B1, 1, 1); PG8_STAGE(PG8_SB(1, 0), b3, voffB);
            PG8_BAR; PG8_WAIT_L(0); PG8_MMA(0, 1, At, B1); PG8_BAR;
            PG8_LDA(At, 1, 1); PG8_STAGE(PG8_SA(1, 0), a3, voffA);
            PG8_BAR; PG8_WAIT_L(0); PG8_MMA(1, 0, At, B0); PG8_BAR; PG8_SCHED;
            PG8_STAGE(PG8_SB(1, 1), b3 + hstep, voffB);
            PG8_WAIT_V(6); PG8_BAR; PG8_MMA(1, 1, At, B1); PG8_BAR;
        }
            if constexpr (!Epi::AFTER_DRAIN) { E(acc, cur, wr, wc, fr, fq); S.done(cur); }
            if (!has_next) break;
#pragma unroll
        for (int a = 0; a < 2; ++a)
#pragma unroll
            for (int b = 0; b < 2; ++b)
#pragma unroll
                for (int m = 0; m < 4; ++m)
#pragma unroll
                    for (int n = 0; n < 2; ++n) acc[a][b][m][n] = (f32x4){0.f, 0.f, 0.f, 0.f};
        cur = nxt; cA = nA; cB = nB; ++ui;
    }
    PG8_WAIT_V(0);
    if (wr == 0) PG8_BAR;
    PG8_BAR;
    if constexpr (Epi::AFTER_DRAIN) { E.fused(acc, cur, wr, wc, fr, fq, lds, wid, lane); S.done(cur); }
#undef PG8_SA
#undef PG8_SB
#undef PG8_STAGE
#undef PG8_LDA
#undef PG8_LDB
#undef PG8_MMA
#undef PG8_WAIT_V
#undef PG8_WAIT_L
#undef PG8_BAR
#undef PG8_SCHED
}

__device__ __forceinline__ unsigned pk2(float lo, float hi) { return (unsigned)f2bf(lo) | ((unsigned)f2bf(hi) << 16); }
struct EpiStore {
  static constexpr bool PERM = true, AFTER_DRAIN = false;
  bf16_t* O; int ldc; int ncols;
  __device__ __forceinline__ void operator()(const f32x4 (&acc)[2][2][4][2], const Unit& u, int wr, int wc, int fr, int fq) const {
    const int row0 = u.pm * BM + wr * 64 + fr, col0 = u.pn * BM + wc * 32 + 8 * fq;
#pragma unroll
    for (int ai = 0; ai < 2; ++ai)
#pragma unroll
      for (int m = 0; m < 4; ++m) { bf16_t* rowp = O + (size_t)(row0 + ai * HALF + m * 16) * ldc + col0;
#pragma unroll
        for (int bj = 0; bj < 2; ++bj) if (col0 + bj * HALF < ncols) { const f32x4 v0 = acc[ai][bj][m][0], v1 = acc[ai][bj][m][1];
          *(u32x4*)(rowp + bj * HALF) = (u32x4){pk2(v0[0], v0[1]), pk2(v0[2], v0[3]), pk2(v1[0], v1[1]), pk2(v1[2], v1[3])}; } }
  }
};
struct EpiSigmoid {
  static constexpr bool PERM = true, AFTER_DRAIN = false;
  bf16_t* O; int ldc; const float* bias;
  __device__ __forceinline__ void operator()(const f32x4 (&acc)[2][2][4][2], const Unit& u, int wr, int wc, int fr, int fq) const {
    const int row0 = u.pm * BM + wr * 64 + fr, col0 = u.pn * BM + wc * 32 + 8 * fq;
    f32x4 bv[2][2];
#pragma unroll
    for (int bj = 0; bj < 2; ++bj)
#pragma unroll
      for (int n = 0; n < 2; ++n) bv[bj][n] = *(const f32x4*)(bias + col0 + bj * HALF + 4 * n);
#pragma unroll
    for (int ai = 0; ai < 2; ++ai)
#pragma unroll
      for (int m = 0; m < 4; ++m) { bf16_t* rowp = O + (size_t)(row0 + ai * HALF + m * 16) * ldc + col0;
#pragma unroll
        for (int bj = 0; bj < 2; ++bj) { const f32x4 v0 = acc[ai][bj][m][0] + bv[bj][0], v1 = acc[ai][bj][m][1] + bv[bj][1];
          *(u32x4*)(rowp + bj * HALF) = (u32x4){pk2(sigmoidf_(v0[0]), sigmoidf_(v0[1])), pk2(sigmoidf_(v0[2]), sigmoidf_(v0[3])), pk2(sigmoidf_(v1[0]), sigmoidf_(v1[1])), pk2(sigmoidf_(v1[2]), sigmoidf_(v1[3]))}; } }
  }
};
}
#endif

struct TJob { const float* src; int K, N; long lds; bf16_t* dst; long ldd; };
__device__ __forceinline__ TJob get_tjob(const Params& p, int l, int j) {
  TJob t; char* ws = p.ws;
  if (j == 0) { t.src = p.w_in + (size_t)l * 1024 * IN_W; t.K = 1024; t.N = IN_W; t.lds = IN_W; t.dst = (bf16_t*)(ws + O_WINT); t.ldd = 1024; }
  else if (j == 1) { t.src = p.w_merge + (size_t)l * 1024 * 4096; t.K = 1024; t.N = 4096; t.lds = 4096; t.dst = (bf16_t*)(ws + O_WMT); t.ldd = 1024; }
  else if (j < 6) { int n = j - 2; t.src = p.w_branch + ((size_t)l * 4 + n) * 512 * 1024; t.K = 512; t.N = 1024; t.lds = 1024; t.dst = (bf16_t*)(ws + O_WBRT) + (size_t)n * 1024 * 512; t.ldd = 512; }
  else if (j == 6) { t.src = p.w_out + (size_t)l * 1024 * 1024; t.K = 1024; t.N = 1024; t.lds = 1024; t.dst = (bf16_t*)(ws + O_WOUTT); t.ldd = 1024; }
  else if (j == 7) { t.src = p.w_q_up + (size_t)l * 256 * 768; t.K = 256; t.N = 768; t.lds = 768; t.dst = (bf16_t*)(ws + O_WQT); t.ldd = 256; }
  else if (j == 8) { t.src = p.w_kv_up + (size_t)l * 128 * 1024; t.K = 128; t.N = 1024; t.lds = 1024; t.dst = (bf16_t*)(ws + O_WKVT); t.ldd = 128; }
  else { int n = j - 9;
    t.src = (n < 2 ? p.w_up : p.a_up) + ((size_t)l * 2 + (n & 1)) * 64 * 512; t.K = 64; t.N = 512; t.lds = 512;
    t.dst = (bf16_t*)(ws + O_WUPT) + (size_t)n * 512 * 64; t.ldd = 64; }
  return t;
}
constexpr int NTJOBS = 13;

__device__ __forceinline__ void stage_prep(const Params& p, int l, int bid, int nb, char* smem) {
  const int tid = my_tid();
  char* ws = p.ws;
  {
    float* tile = (float*)smem;
    int base = 0;
    for (int j = 0; j < NTJOBS; ++j) {
      TJob t = get_tjob(p, l, j);
      int tk = t.K / 32, tn = t.N / 32, nt = tk * tn;
      int first = ((bid - base % nb) % nb + nb) % nb;
      for (int q = first; q < nt; q += nb) {
        int kt = q / tn, nt_ = q % tn;
        __syncthreads();
#pragma unroll
        for (int i = 0; i < 2; ++i) { int e = tid + NTHR * i, r = e >> 5, c = e & 31; tile[r * 33 + c] = t.src[(long)(kt * 32 + r) * t.lds + nt_ * 32 + c]; }
        __syncthreads();
#pragma unroll
        for (int i = 0; i < 2; ++i) { int e = tid + NTHR * i, r = e >> 5, c = e & 31; t.dst[(long)(nt_ * 32 + r) * t.ldd + kt * 32 + c] = f2bf(tile[c * 33 + r]); }
      }
      base += nt;
    }
    __syncthreads();
  }
  const long gtid = (long)bid * NTHR + tid, gn = (long)nb * NTHR;
  { bf16_t* d = (bf16_t*)(ws + O_WINT) + (size_t)IN_W * 1024; for (long i = gtid; i < (long)(IN_WP - IN_W) * 1024; i += gn) d[i] = 0; }
  { bf16_t* d = (bf16_t*)(ws + O_WS); const float* s = p.g_w_s + (size_t)l * 4 * 128 * 128; for (long i = gtid; i < (long)4 * 128 * 128; i += gn) d[i] = f2bf(s[i]); }
  if (l != 0) return;
  { bf16_t* d = (bf16_t*)(ws + O_CS128);
    for (long i = gtid; i < 256 * 128; i += gn) { int j = (int)(i >> 7), c = (int)(i & 127); int mm = ((j & 127) * c) & 127; float x = 2.0f * mm / 128.f; d[i] = f2bf(j < 128 ? cospif(x) : sinpif(x)); } }
  { bf16_t* d = (bf16_t*)(ws + O_A2C);
    for (long i = gtid; i < (long)T_C * 2 * T_C; i += gn) { int tp = (int)(i / (2 * T_C)), tt = (int)(i % (2 * T_C)); int half = tt >= T_C; int t = half ? tt - T_C : tt; int mm = (int)(((long)tp * t) % T_C); float x = 2.0f * mm / (float)T_C; d[i] = f2bf(half ? -sinpif(x) : cospif(x)); } }
  { bf16_t* d = (bf16_t*)(ws + O_A2D);
    for (long i = gtid; i < (long)T_D * 2 * T_D; i += gn) { int tp = (int)(i / (2 * T_D)), tt = (int)(i % (2 * T_D)); int half = tt >= T_D; int t = half ? tt - T_D : tt; int mm = (int)(((long)tp * t) % T_D); float x = 2.0f * mm / (float)T_D; d[i] = f2bf(half ? -sinpif(x) : cospif(x)); } }
  { float* d = (float*)(ws + O_ROPE);
    for (long i = gtid; i < (long)T_D * 16; i += gn) { int t = (int)(i >> 4), pi = (int)(i & 15); float pos = (pi < 8) ? (float)(t / 64) : (float)(t % 64); float inv = expf(-(float)(pi & 7) * (9.210340371976184f / 8.f)); float a = pos * inv; d[2 * i] = cosf(a); d[2 * i + 1] = sinf(a); } }
  { float4* d = (float4*)p.out; const float4* s0 = (const float4*)p.x_prompt; const float4* s1 = (const float4*)p.x_sample;
    for (long i = gtid; i < (long)M * 256; i += gn) d[i] = (i < (long)M_C * 256) ? s0[i] : s1[i - (long)M_C * 256]; }
  {
    float* red = (float*)smem;
    float* modp = (float*)(ws + O_MOD);
    for (int u = bid; u < NL * 48; u += nb) {
      int ll = u / 48, cg = u % 48; int col = cg * 64 + (tid & 63), kq = tid >> 6;
      float a0 = 0.f, a1 = 0.f, a2 = 0.f;
      const float* w = p.w_ada + (size_t)ll * 1024 * 3072 + col;
      for (int k = kq * 128; k < kq * 128 + 128; ++k) {
        float wv = w[(size_t)k * 3072];
        a0 += siluf_(p.c_ctx[k]) * wv; a1 += siluf_(p.c[k]) * wv; a2 += siluf_(p.c[(NB_D > 1 ? 1024 : 0) + k]) * wv;
      }
      __syncthreads();
      red[(kq * 3 + 0) * 64 + (tid & 63)] = a0; red[(kq * 3 + 1) * 64 + (tid & 63)] = a1; red[(kq * 3 + 2) * 64 + (tid & 63)] = a2;
      __syncthreads();
      if (tid < 192) { int mi = tid >> 6, cc = tid & 63; float s = 0.f;
#pragma unroll
        for (int q8 = 0; q8 < 8; ++q8) s += red[(q8 * 3 + mi) * 64 + cc];
        modp[((size_t)ll * 3 + mi) * 3072 + cg * 64 + cc] = s + p.b_ada[(size_t)ll * 3072 + cg * 64 + cc]; }
    }
  }
}

__device__ __forceinline__ int mod_index(const Grp& g, int lm) { return g.isden ? 1 + lm / T_D : 0; }

__device__ __forceinline__ void stage_h(const Params& p, const Grp& g, int l, int bid, int nb) {
  const int lane = my_tid() & 63, wid = my_tid() >> 6;
  const float* X = p.out + (size_t)g.m0 * 1024;
  bf16_t* H = (bf16_t*)(p.ws + O_H);
  const float* modp = (const float*)(p.ws + O_MOD) + (size_t)l * 3 * 3072;
  const float* gam = p.norm_g + (size_t)l * 1024;
  for (int m = bid * NWAVE + wid; m < g.mg; m += nb * NWAVE) {
    const float* xr = X + (size_t)m * 1024; float v[16]; float ss = 0.f;
#pragma unroll
    for (int i = 0; i < 4; ++i) { float4 q = *(const float4*)(xr + i * 256 + lane * 4); v[4 * i] = q.x; v[4 * i + 1] = q.y; v[4 * i + 2] = q.z; v[4 * i + 3] = q.w; ss += q.x * q.x + q.y * q.y + q.z * q.z + q.w * q.w; }
    ss = wave_sum(ss); float rs = rsqrtf(ss * (1.f / 1024.f) + 1e-6f);
    const float* mo = modp + (size_t)mod_index(g, m) * 3072;
#pragma unroll
    for (int i = 0; i < 4; ++i) {
      int c = i * 256 + lane * 4; bf16_t o[4];
#pragma unroll
      for (int e = 0; e < 4; ++e) o[e] = f2bf(v[4 * i + e] * rs * gam[c + e] * (1.f + mo[1024 + c + e]) + mo[c + e]);
      *(uint2*)(H + (size_t)m * 1024 + c) = make_uint2((unsigned)o[0] | ((unsigned)o[1] << 16), (unsigned)o[2] | ((unsigned)o[3] << 16));
    }
  }
}

__device__ __forceinline__ void stage_g1(const Params& p, const Grp& g, int bid, int nb, char* smem) {
  const bf16_t* H = (const bf16_t*)(p.ws + O_H);
  const bf16_t* W = (const bf16_t*)(p.ws + O_WINT);
  bf16_t* Z = (bf16_t*)(p.ws + O_Z);
#ifndef EMU
  if ((g.mg & 255) == 0) {
    pg8::Gemm gm; gm.A = H; gm.Bt = W; gm.M = g.mg; gm.N = IN_WP; gm.K = 1024;
    pg8::StaticOrder S; S.init(gm.M, gm.N, nb, bid);
    pg8::EpiStore E; E.O = Z; E.ldc = IN_W; E.ncols = IN_W;
    pg8::gemm_phase<pg8::EpiStore, pg8::StaticOrder>((PG8_LAS unsigned char*)smem, gm, S, E);
    return;
  }
#endif
  const int TM = (g.mg + 127) / 128; constexpr int TN = (IN_W + 127) / 128;
  const int mg = g.mg;
  for (int t = bid; t < TM * TN; t += nb) {
    int tn = t / TM, tm = t % TM; f4v acc[2][4]; zero_acc<4>(acc);
    gemm_mainloop<4>(H, 1024, tm * 128, mg, W, 1024, tn * 128, IN_W, 1024, smem, acc);
    epi_foreach<4>(acc, tm * 128, tn * 128, [&](int row, int c0, f4v& v) {
      if (c0 < IN_W && row < mg) *(u2v*)(Z + (size_t)row * IN_W + c0) = pack4(v[0], v[1], v[2], v[3]);
    });
  }
}

__device__ __forceinline__ void stage_e1(const Params& p, const Grp& g, int l, int bid, int nb) {
  const int lane = my_tid() & 63, wid = my_tid() >> 6;
  char* ws = p.ws;
  const bf16_t* Z = (const bf16_t*)(ws + O_Z);
  bf16_t* SK = (bf16_t*)(ws + O_SK); bf16_t* SOP = (bf16_t*)(ws + O_SOP);
  bf16_t* LORA = (bf16_t*)(ws + O_LORA); bf16_t* QDN = (bf16_t*)(ws + O_QDN); bf16_t* CKV = (bf16_t*)(ws + O_CKV); bf16_t* KR = (bf16_t*)(ws + O_KR);
  bf16_t* VCNT = (bf16_t*)(ws + O_VCNT);
  const float* rope = (const float*)(ws + O_ROPE);
  const float* mu = p.shift_mu + (size_t)l * SHIFT_W;
  const int isden = g.isden, T = g.T;
  for (int m = bid * NWAVE + wid; m < g.mkv; m += nb * NWAVE) {
    if (m >= g.mg) {
      int r = m - g.mg, b = r / PAST, j = r % PAST;
      const float* s = p.c_ckv + (((size_t)b * NL + l) * PAST + j) * 128;
      CKV[(size_t)m * 128 + lane] = f2bf(s[lane]); CKV[(size_t)m * 128 + 64 + lane] = f2bf(s[64 + lane]);
      if (lane < 32) KR[(size_t)m * 32 + lane] = f2bf(p.c_kr[(((size_t)b * NL + l) * PAST + j) * 32 + lane]);
      continue;
    }
    const int sq = m / T, t = m % T, b = g.b0 + sq;
    const bf16_t* z = Z + (size_t)m * IN_W;
    const bool hp = t > 0, hn = t < T - 1;
#pragma unroll 4
    for (int i = 0; i < 24; ++i) {
      int c = lane + 64 * i; float zc = bf2f(z[c]);
      float pv = hp ? bf2f(z[c - IN_W]) : 0.f, nv = hn ? bf2f(z[c + IN_W]) : 0.f;
      bf16_t s = f2bf(zc + (0.5f * (pv + nv) - zc) * mu[c]);
      if (i < 8) SOP[(((size_t)sq * 8 + i) * T + t) * 576 + lane] = s; else if (i < 16) SK[(size_t)m * 512 + c - 512] = s; else SOP[(((size_t)sq * 8 + (i - 16)) * T + t) * 576 + 128 + lane] = s;
    }
#pragma unroll
    for (int i = 0; i < 3; ++i) {
      int c = ZC_WDF + lane + 64 * i; float zc = bf2f(z[c]);
      float pv = hp ? bf2f(z[c - IN_W]) : 0.f, nv = hn ? bf2f(z[c + IN_W]) : 0.f;
      float s = zc + (0.5f * (pv + nv) - zc) * mu[c];
      LORA[(size_t)m * 192 + lane + 64 * i] = f2bf(i < 2 ? tanhf(s) : s);
    }
    { float v[4]; float ss = 0.f;
#pragma unroll
      for (int i = 0; i < 4; ++i) { v[i] = bf2f(z[ZC_QD + lane + 64 * i]); ss += v[i] * v[i]; }
      ss = wave_sum(ss); float rs = rsqrtf(ss * (1.f / 256.f) + 1e-6f);
#pragma unroll
      for (int i = 0; i < 4; ++i) QDN[(size_t)m * 256 + lane + 64 * i] = f2bf(v[i] * rs * p.q_norm[(size_t)l * 256 + lane + 64 * i]); }
    { float v[2]; float ss = 0.f;
#pragma unroll
      for (int i = 0; i < 2; ++i) { v[i] = bf2f(z[ZC_KVD + lane + 64 * i]); ss += v[i] * v[i]; }
      ss = wave_sum(ss); float rs = rsqrtf(ss * (1.f / 128.f) + 1e-6f);
#pragma unroll
      for (int i = 0; i < 2; ++i) { float o = v[i] * rs * p.kv_norm[(size_t)l * 128 + lane + 64 * i];
        CKV[(size_t)m * 128 + lane + 64 * i] = f2bf(o);
        if (!isden) p.out[OUT_CKV + (((size_t)b * NL + l) * T_C + t) * 128 + lane + 64 * i] = o; } }
    { float v = lane < 32 ? bf2f(z[ZC_KR + (lane & 31)]) : 0.f; float pr = __shfl_xor(v, 1); float o = v;
      if (isden) { int pi = (lane & 31) >> 1; float cs = rope[((size_t)t * 16 + pi) * 2], sn = rope[((size_t)t * 16 + pi) * 2 + 1];
        o = (lane & 1) ? (pr * sn + v * cs) : (v * cs - pr * sn); }
      if (lane < 32) { KR[(size_t)m * 32 + lane] = f2bf(o); if (!isden) p.out[OUT_KR + (((size_t)b * NL + l) * T_C + t) * 32 + lane] = v; } }
    { float v[8]; float s1 = 0.f;
#pragma unroll
      for (int i = 0; i < 8; ++i) { v[i] = geluf_(bf2f(z[ZC_VC + lane + 64 * i])); s1 += v[i]; }
      s1 = wave_sum(s1); float mean = s1 * (1.f / 512.f); float s2 = 0.f;
#pragma unroll
      for (int i = 0; i < 8; ++i) { float d = v[i] - mean; s2 += d * d; }
      s2 = wave_sum(s2); float rs = rsqrtf(s2 * (1.f / 512.f) + 1e-5f);
#pragma unroll
      for (int i = 0; i < 8; ++i) { int ch = lane + 64 * i; float o = (v[i] - mean) * rs * p.g_ln_g[(size_t)l * 512 + ch] + p.g_ln_b[(size_t)l * 512 + ch];
        VCNT[(((size_t)(m >> 7) * 4 + (ch >> 7)) * 128 + (ch & 127)) * 128 + (m & 127)] = f2bf(o); } }
  }
}

__device__ __forceinline__ void stage_g2(const Params& p, const Grp& g, int l, int bid, int nb, char* smem) {
  char* ws = p.ws;
  const bf16_t* Z = (const bf16_t*)(ws + O_Z);
  const float* rope = (const float*)(ws + O_ROPE);
  const int mg = g.mg, mkv = g.mkv, T = g.T, isden = g.isden, nkeys = g.nkeys;
  const int TM_M = (mg + 127) / 128, TM_KV = (mkv + 127) / 128;
  const int NT_Q = TM_M * 6, NT_KV = TM_KV * 8, NT_LORA = TM_M * 16, NT_GM = (mg / 128) * 4, ntt = T / 128, NT_D1 = g.nseq * 8 * ntt;
  const int NT = NT_Q + NT_KV + NT_LORA + NT_GM + NT_D1;
  for (int t0 = bid; t0 < NT; t0 += nb) {
    int t = t0; f4v acc[2][4]; zero_acc<4>(acc);
    if (t < NT_Q) {
      int tn = t / TM_M, tm = t % TM_M;
      gemm_mainloop<4>((const bf16_t*)(ws + O_QDN), 256, tm * 128, mg, (const bf16_t*)(ws + O_WQT), 256, tn * 128, 768, 256, smem, acc);
      bf16_t* Q = (bf16_t*)(ws + O_Q);
      const float scale = 0.10206207261596575f;
      epi_foreach<4>(acc, tm * 128, tn * 128, [&](int row, int c0, f4v& v) {
        if (row >= mg) return;
        int cw = c0 % 96; float o0 = v[0], o1 = v[1], o2 = v[2], o3 = v[3];
        if (cw >= 64 && isden) { int tt = row % T_D; int pi = (cw - 64) >> 1; const float* rp = rope + ((size_t)tt * 16 + pi) * 2;
          float c_a = rp[0], s_a = rp[1], c_b = rp[2], s_b = rp[3];
          o0 = v[0] * c_a - v[1] * s_a; o1 = v[0] * s_a + v[1] * c_a; o2 = v[2] * c_b - v[3] * s_b; o3 = v[2] * s_b + v[3] * c_b; }
        *(u2v*)(Q + (size_t)row * 768 + c0) = pack4(o0 * scale, o1 * scale, o2 * scale, o3 * scale);
      });
      continue;
    }
    t -= NT_Q;
    if (t < NT_KV) {
      int tn = t / TM_KV, tm = t % TM_KV;
      gemm_mainloop<4>((const bf16_t*)(ws + O_CKV), 128, tm * 128, mkv, (const bf16_t*)(ws + O_WKVT), 128, tn * 128, 1024, 128, smem, acc);
      bf16_t* KN = (bf16_t*)(ws + O_KN); bf16_t* VT = (bf16_t*)(ws + O_VT);
      epi_foreach<4>(acc, tm * 128, tn * 128, [&](int row, int c0, f4v& v) {
        if (row >= mkv) return;
        int h = c0 >> 7, w = c0 & 127;
        if (w < 64) *(u2v*)(KN + (size_t)row * 512 + h * 64 + w) = pack4(v[0], v[1], v[2], v[3]);
        else { int sq, key;
          if (row < mg) { sq = row / T; key = row % T; } else { int r = row - mg; sq = r / PAST; key = T + r % PAST; }
#pragma unroll
          for (int e = 0; e < 4; ++e) VT[(((size_t)sq * 8 + h) * 64 + (w - 64 + e)) * nkeys + key] = f2bf(v[e]); }
      });
      continue;
    }
    t -= NT_KV;
    if (t < NT_LORA) {
      int g4 = t / (TM_M * 4), r = t % (TM_M * 4), tn = r / TM_M, tm = r % TM_M;
      int koff = g4 == 0 ? 0 : (g4 == 1 ? 64 : 128);
      gemm_mainloop<4>((const bf16_t*)(ws + O_LORA) + koff, 192, tm * 128, mg, (const bf16_t*)(ws + O_WUPT) + (size_t)g4 * 512 * 64, 64, tn * 128, 512, 64, smem, acc);
      bf16_t* PRE = (bf16_t*)(ws + O_PRE);
      const float* bias = (g4 < 2 ? p.w0 : p.a0) + ((size_t)l * 2 + (g4 & 1)) * 512;
      epi_foreach<4>(acc, tm * 128, tn * 128, [&](int row, int c0, f4v& v) {
        if (row < mg) *(u2v*)(PRE + ((size_t)row * 4 + g4) * 512 + c0) = pack4(v[0] + bias[c0], v[1] + bias[c0 + 1], v[2] + bias[c0 + 2], v[3] + bias[c0 + 3]);
      });
      continue;
    }
    t -= NT_LORA;
    if (t < NT_GM) {
      int ch = t >> 2, gg = t & 3;
      gemm_mainloop<4>((const bf16_t*)(ws + O_WS) + (size_t)gg * 128 * 128, 128, 0, 128, (const bf16_t*)(ws + O_VCNT) + ((size_t)ch * 4 + gg) * 128 * 128, 128, 0, 128, 128, smem, acc);
      bf16_t* O = (bf16_t*)(ws + O_OBR) + (size_t)2 * MG * 512;
      const float* bs = p.g_b_s + ((size_t)l * 4 + gg) * 128;
      epi_foreach<4>(acc, 0, 0, [&](int pp, int c0, f4v& v) {
        int m = ch * 128 + pp; int c = gg * 128 + c0; float bb = bs[pp];
        u2v uu = *(const u2v*)(Z + (size_t)m * IN_W + ZC_U + c), gc = *(const u2v*)(Z + (size_t)m * IN_W + ZC_GC + c);
        *(u2v*)(O + (size_t)m * 512 + c) = pack4(geluf_(bflo(uu.x)) * (v[0] + bb) * siluf_(bflo(gc.x)), geluf_(bfhi(uu.x)) * (v[1] + bb) * siluf_(bfhi(gc.x)),
                                                 geluf_(bflo(uu.y)) * (v[2] + bb) * siluf_(bflo(gc.y)), geluf_(bfhi(uu.y)) * (v[3] + bb) * siluf_(bfhi(gc.y)));
      });
      continue;
    }
    t -= NT_GM;
    {
      int per_seq = 8 * ntt; int sq = t / per_seq; int r = t % per_seq; int gg = r / (2 * ntt); int r2 = r % (2 * ntt); int tj = r2 / ntt, tt = r2 % ntt;
      long mbase = (long)sq * T;
      gemm_mainloop<4>((const bf16_t*)(ws + O_CS128), 128, tj * 128, 256, Z + (size_t)mbase * IN_W + ZC_F + gg * 128, IN_W, tt * 128, T, 128, smem, acc);
      bf16_t* YT = (bf16_t*)(ws + O_YT) + (size_t)mbase * 1024 + (size_t)gg * 128 * 2 * T;
      epi_foreach<4>(acc, tj * 128, tt * 128, [&](int j, int c0, f4v& v) {
        *(u2v*)(YT + (size_t)(j & 127) * 2 * T + (size_t)(j >> 7) * T + c0) = pack4(v[0], v[1], v[2], v[3]);
      });
    }
  }
}

__device__ __forceinline__ void stage_e2(const Params& p, const Grp& g, int l, int bid, int nb) {
  const int lane = my_tid() & 63, wid = my_tid() >> 6;
  char* ws = p.ws;
  const bf16_t* SK = (const bf16_t*)(ws + O_SK); bf16_t* SOP = (bf16_t*)(ws + O_SOP);
  float* BON = (float*)(ws + O_BON); const bf16_t* PRE = (const bf16_t*)(ws + O_PRE);
  const int T = g.T;
  for (int m = bid * NWAVE + wid; m < g.mg; m += nb * NWAVE) {
    const int sq = m / T, t = m % T;
#pragma unroll 2
    for (int i = 0; i < 8; ++i) {
      int c = lane + 64 * i;
      bf16_t* rec = SOP + (((size_t)sq * 8 + i) * T + t) * 576;
      float k = bf2f(SK[(size_t)m * 512 + c]), r = bf2f(rec[lane]);
      float kr = k * p.k_k[(size_t)l * 512 + c];
      float n2 = wave_sum(kr * kr); float kk = kr / fmaxf(sqrtf(n2), 1e-12f);
      rec[64 + lane] = f2bf(kk);
      float bon = 0.f;
#pragma unroll
      for (int d = 0; d < 2; ++d) {
        float pw = bf2f(PRE[((size_t)m * 4 + d) * 512 + c]), pa = bf2f(PRE[((size_t)m * 4 + 2 + d) * 512 + c]);
        float dec = expf(-0.6065306597126334f * sigmoidf_(pw));
        float a = sigmoidf_(pa);
        float kt = k * (1.f + (a - 1.f) * p.k_a[(size_t)l * 512 + c]);
        rec[(3 + 3 * d) * 64 + lane] = f2bf(1.f - dec); rec[(4 + 3 * d) * 64 + lane] = f2bf(kk * a); rec[(5 + 3 * d) * 64 + lane] = f2bf(kt);
        bon += r * kt * p.r_k[(size_t)l * 512 + c];
      }
      bon = wave_sum(bon);
      if (lane == 0) BON[(size_t)m * 8 + i] = bon;
    }
  }
}

__device__ __forceinline__ void attention_task(const Params& p, const Grp& g, int sq, int h, int qb32) {
  char* ws = p.ws;
  const int lane = my_tid() & 63, ql = lane & 31, hh = lane >> 5;
  const int T = g.T, nkeys = g.nkeys;
  const long mbase = (long)sq * T;
  const bf16_t* Q = (const bf16_t*)(ws + O_Q); const bf16_t* KN = (const bf16_t*)(ws + O_KN); const bf16_t* KRp = (const bf16_t*)(ws + O_KR);
  const bf16_t* VT = (const bf16_t*)(ws + O_VT) + ((size_t)sq * 8 + h) * 64 * nkeys;
  const long mq = mbase + qb32 * 32 + ql;
  s8v qf[6];
#pragma unroll
  for (int s = 0; s < 6; ++s) qf[s] = *(const s8v*)(Q + (size_t)mq * 768 + h * 96 + 16 * s + 8 * hh);
  f16v o0, o1;
#pragma unroll
  for (int i = 0; i < 16; ++i) { o0[i] = 0.f; o1[i] = 0.f; }
  float mrun = -1e30f, lrun = 0.f;
  for (int k0 = 0; k0 < nkeys; k0 += 32) {
    long krow = (k0 < T) ? mbase + k0 + ql : (long)g.mg + (long)sq * PAST + (k0 - T) + ql;
    f16v s;
#pragma unroll
    for (int i = 0; i < 16; ++i) s[i] = 0.f;
#pragma unroll
    for (int st = 0; st < 6; ++st) {
      s8v kf = (st < 4) ? *(const s8v*)(KN + (size_t)krow * 512 + h * 64 + 16 * st + 8 * hh) : *(const s8v*)(KRp + (size_t)krow * 32 + 16 * (st - 4) + 8 * hh);
      s = __builtin_amdgcn_mfma_f32_32x32x16_bf16(kf, qf[st], s, 0, 0, 0);
    }
    float mx = s[0];
#pragma unroll
    for (int i = 1; i < 16; ++i) mx = fmaxf(mx, s[i]);
    mx = fmaxf(mx, __shfl_xor(mx, 32));
    float mnew = fmaxf(mrun, mx); float alpha = expf(mrun - mnew); mrun = mnew;
    float ps = 0.f; bf16_t pb[16];
#pragma unroll
    for (int i = 0; i < 16; ++i) { float e = expf(s[i] - mnew); ps += e; pb[i] = f2bf(e); }
    lrun = lrun * alpha + ps;
#pragma unroll
    for (int i = 0; i < 16; ++i) { o0[i] *= alpha; o1[i] *= alpha; }
#pragma unroll
    for (int st = 0; st < 2; ++st) {
      s8v pf;
#pragma unroll
      for (int j = 0; j < 8; ++j) pf[j] = (short)pb[8 * st + j];
#pragma unroll
      for (int db = 0; db < 2; ++db) {
        const bf16_t* vp = VT + (size_t)(db * 32 + ql) * nkeys + k0 + 16 * st + 4 * hh;
        u2v a = *(const u2v*)vp, b2 = *(const u2v*)(vp + 8);
        s8v vf = __builtin_bit_cast(s8v, u4v{a.x, a.y, b2.x, b2.y});
        if (db == 0) o0 = __builtin_amdgcn_mfma_f32_32x32x16_bf16(vf, pf, o0, 0, 0, 0);
        else o1 = __builtin_amdgcn_mfma_f32_32x32x16_bf16(vf, pf, o1, 0, 0, 0);
      }
    }
  }
  float ltot = lrun + __shfl_xor(lrun, 32); float inv = 1.f / ltot;
  const bf16_t* Z = (const bf16_t*)(ws + O_Z);
  bf16_t* O = (bf16_t*)(ws + O_OBR) + (size_t)1 * MG * 512;
#pragma unroll
  for (int db = 0; db < 2; ++db)
#pragma unroll
    for (int i = 0; i < 16; ++i) {
      int dv = db * 32 + (i & 3) + 8 * (i >> 2) + 4 * hh; float ov = (db == 0 ? o0[i] : o1[i]) * inv;
      float gt = siluf_(bf2f(Z[(size_t)mq * IN_W + ZC_GB + h * 64 + dv]));
      O[(size_t)mq * 512 + h * 64 + dv] = f2bf(ov * gt);
    }
}

__device__ __forceinline__ void stage_dft2(const Params& p, const Grp& g, int bid, int nb, char* smem) {
  char* ws = p.ws;
  const bf16_t* Z = (const bf16_t*)(ws + O_Z);
  const int T = g.T, ntt = T / 128;
  const int NT_D2 = g.nseq * 4 * ntt;
  for (int t = bid; t < NT_D2; t += nb) {
    int sq = t / (4 * ntt), r = t % (4 * ntt), gg = r / ntt, tt = r % ntt;
    long mbase = (long)sq * T;
    f4v acc[2][4]; zero_acc<4>(acc);
    gemm_mainloop<4>((const bf16_t*)(ws + (g.isden ? O_A2D : O_A2C)), 2 * T, tt * 128, T, (const bf16_t*)(ws + O_YT) + (size_t)mbase * 1024 + (size_t)gg * 128 * 2 * T, 2 * T, 0, 128, 2 * T, smem, acc);
    bf16_t* O = (bf16_t*)(ws + O_OBR) + (size_t)3 * MG * 512;
    const float sc = rsqrtf(128.f * (float)T);
    epi_foreach<4>(acc, tt * 128, 0, [&](int row, int c0, f4v& v) {
      long m = mbase + row; int c = gg * 128 + c0; u2v gd = *(const u2v*)(Z + (size_t)m * IN_W + ZC_GD + c);
      *(u2v*)(O + (size_t)m * 512 + c) = pack4(v[0] * sc * siluf_(bflo(gd.x)), v[1] * sc * siluf_(bfhi(gd.x)), v[2] * sc * siluf_(bflo(gd.y)), v[3] * sc * siluf_(bfhi(gd.y)));
    });
  }
}

constexpr int SCAN_LDS_PER_WAVE = 8 * 1536;
typedef float f2v __attribute__((ext_vector_type(2)));
template <int CH> __device__ __forceinline__ void lds_ld(const char* q, f2v (&o)[CH / 2]) {
  if constexpr (CH == 2) { o[0] = *(const f2v*)q; }
  else if constexpr (CH == 4) { f4v t = *(const f4v*)q; o[0] = f2v{t[0], t[1]}; o[1] = f2v{t[2], t[3]}; }
  else { f4v t = *(const f4v*)q, u = *(const f4v*)(q + 16); o[0] = f2v{t[0], t[1]}; o[1] = f2v{t[2], t[3]}; o[2] = f2v{u[0], u[1]}; o[3] = f2v{u[2], u[3]}; }
}
template <int LPR>
__device__ __forceinline__ void scan_task(const Params& p, const Grp& g, int l, int task, char* wl) {
  constexpr int CH = 64 / LPR, RW = 64 / LPR, NP = CH / 2;
  char* ws = p.ws;
  const int lane = my_tid() & 63;
  const int T = g.T;
  const int ch = task / LPR, rg = task % LPR;
  const int dir = ch & 1, h = (ch >> 1) & 7, sq = ch >> 4;
  const long mbase = (long)sq * T;
  const int row = rg * RW + lane / LPR, kl = lane % LPR;
  const char* rec0 = (const char*)((const bf16_t*)(ws + O_SOP) + ((size_t)sq * 8 + h) * T * 576);
  float* YS = (float*)(ws + O_YS) + (size_t)dir * MG * 512;
  f2v sv[NP];
#pragma unroll
  for (int i = 0; i < NP; ++i) sv[i] = f2v{0.f, 0.f};
  if (g.isden) { const float* st = (dir ? p.st_b : p.st_f) + ((((size_t)sq * NL + l) * 8 + h) * 64 + row) * 64 + kl * CH;
#pragma unroll
    for (int i = 0; i < NP; ++i) sv[i] = f2v{st[2 * i], st[2 * i + 1]}; }
  int soff[6], sstep[6], doff[6]; bool isd[6];
#pragma unroll
  for (int i = 0; i < 6; ++i) { int c = lane + 64 * i; int st = c / 48, w = c % 48; sstep[i] = st; soff[i] = (w < 24) ? w * 16 : ((dir ? 768 : 384) + (w - 24) * 16);
    doff[i] = st * 1536 + (w >> 3) * 256 + (w & 7) * 32; isd[i] = (w >> 3) == 3; }
  u4v pf[6];
  const int nbt = T >> 3;
#pragma unroll
  for (int i = 0; i < 6; ++i) { int tt = dir ? T - 1 - sstep[i] : sstep[i]; pf[i] = *(const u4v*)(rec0 + (size_t)tt * 1152 + soff[i]); }
  for (int bt = 0; bt < nbt; ++bt) {
    WAVE_SYNC();
#pragma unroll
    for (int i = 0; i < 6; ++i) {
      f4v lo = {bflo(pf[i].x), bfhi(pf[i].x), bflo(pf[i].y), bfhi(pf[i].y)}, hi = {bflo(pf[i].z), bfhi(pf[i].z), bflo(pf[i].w), bfhi(pf[i].w)};
      if (isd[i]) { lo = 1.f - lo; hi = 1.f - hi; }
      *(f4v*)(wl + doff[i]) = lo; *(f4v*)(wl + doff[i] + 16) = hi;
    }
    WAVE_SYNC();
    if (bt + 1 < nbt) {
#pragma unroll
      for (int i = 0; i < 6; ++i) { int st = (bt + 1) * 8 + sstep[i]; int tt = dir ? T - 1 - st : st; pf[i] = *(const u4v*)(rec0 + (size_t)tt * 1152 + soff[i]); }
    }
    float ykeep = 0.f, yprev = 0.f;
    f2v r_[NP], kk_[NP], w_[NP], b_[NP], kt_[NP]; float v;
    lds_ld<CH>(wl + kl * CH * 4, r_); lds_ld<CH>(wl + 256 + kl * CH * 4, kk_); lds_ld<CH>(wl + 768 + kl * CH * 4, w_); lds_ld<CH>(wl + 1024 + kl * CH * 4, b_); lds_ld<CH>(wl + 1280 + kl * CH * 4, kt_);
    v = *(const float*)(wl + 512 + row * 4);
#pragma unroll
    for (int s = 0; s < 8; ++s) {
      f2v nr[NP], nkk[NP], nw[NP], nb_[NP], nkt[NP]; float nv = v;
#pragma unroll
      for (int i = 0; i < NP; ++i) { nr[i] = r_[i]; nkk[i] = kk_[i]; nw[i] = w_[i]; nb_[i] = b_[i]; nkt[i] = kt_[i]; }
      if (s < 7) { const char* q = wl + (s + 1) * 1536;
        lds_ld<CH>(q + kl * CH * 4, nr); lds_ld<CH>(q + 256 + kl * CH * 4, nkk); lds_ld<CH>(q + 768 + kl * CH * 4, nw); lds_ld<CH>(q + 1024 + kl * CH * 4, nb_); lds_ld<CH>(q + 1280 + kl * CH * 4, nkt);
        nv = *(const float*)(q + 512 + row * 4); }
#ifndef EMU
      __builtin_amdgcn_sched_barrier(0);
#endif
      f2v pd = sv[0] * kk_[0];
#pragma unroll
      for (int i = 1; i < NP; ++i) pd += sv[i] * kk_[i];
      const f2v vv = {v, v};
      f2v tmp[NP];
#pragma unroll
      for (int i = 0; i < NP; ++i) tmp[i] = sv[i] * w_[i] + vv * kt_[i];
      float sa = pd.x + pd.y;
      if (s == 0) sa = sum_lpr<LPR>(sa);
      else { sum_lpr2<LPR>(sa, yprev); ykeep = (kl == s - 1) ? yprev : ykeep; }
      const f2v sav = {-sa, -sa};
#pragma unroll
      for (int i = 0; i < NP; ++i) sv[i] = sav * b_[i] + tmp[i];
      f2v py = sv[0] * r_[0];
#pragma unroll
      for (int i = 1; i < NP; ++i) py += sv[i] * r_[i];
      yprev = py.x + py.y;
#pragma unroll
      for (int i = 0; i < NP; ++i) { r_[i] = nr[i]; kk_[i] = nkk[i]; w_[i] = nw[i]; b_[i] = nb_[i]; kt_[i] = nkt[i]; }
      v = nv;
    }
    yprev = sum_lpr<LPR>(yprev); ykeep = (kl == 7) ? yprev : ykeep;
    if (kl < 8) { int st = bt * 8 + kl; int tt = dir ? T - 1 - st : st; YS[(size_t)(mbase + tt) * 512 + h * 64 + row] = ykeep; }
  }
  if (!g.isden) { float* so = p.out + (dir ? OUT_SB : OUT_SF) + ((((size_t)(g.b0 + sq) * NL + l) * 8 + h) * 64 + row) * 64 + kl * CH;
#pragma unroll
    for (int i = 0; i < NP; ++i) *(f2v*)(so + 2 * i) = sv[i]; }
}

__device__ __forceinline__ void stage_mix(const Params& p, const Grp& g, int l, int bid, int nb, char* smem) {
  const int wid = my_tid() >> 6;
  const int NS = g.nseq * 16 * (g.isden ? 32 : 8), q32 = g.T / 32, NA = g.nseq * 8 * q32;
  char* wl = smem + wid * SCAN_LDS_PER_WAVE;
  for (int task = wid * nb + bid; task < NS + NA; task += nb * NWAVE) {
    if (task < NS) { if (g.isden) scan_task<32>(p, g, l, task, wl); else scan_task<8>(p, g, l, task, wl); }
    else { int t = task - NS; int sq = t / (8 * q32), r = t % (8 * q32); attention_task(p, g, sq, r / q32, r % q32); }
  }
}

__device__ __forceinline__ void stage_e3(const Params& p, const Grp& g, int l, int bid, int nb) {
  const int lane = my_tid() & 63, wid = my_tid() >> 6;
  char* ws = p.ws;
  const float* YS = (const float*)(ws + O_YS); const bf16_t* SOP = (const bf16_t*)(ws + O_SOP); const float* BON = (const float*)(ws + O_BON); const int T = g.T;
  const bf16_t* Z = (const bf16_t*)(ws + O_Z); bf16_t* O = (bf16_t*)(ws + O_OBR);
  for (int m = bid * NWAVE + wid; m < g.mg; m += nb * NWAVE) {
#pragma unroll 2
    for (int i = 0; i < 8; ++i) {
      int c = lane + 64 * i;
      float o = YS[(size_t)m * 512 + c] + YS[((size_t)MG + m) * 512 + c];
      float mean = wave_sum(o) * (1.f / 64.f); float d = o - mean; float var = wave_sum(d * d) * (1.f / 64.f);
      float y = d * rsqrtf(var + 64e-5f) * p.ln_g[(size_t)l * 512 + c] + p.ln_b[(size_t)l * 512 + c] + BON[(size_t)m * 8 + i] * bf2f(SOP[(((size_t)(m / T) * 8 + i) * T + (m % T)) * 576 + 128 + lane]);
      O[(size_t)m * 512 + c] = f2bf(y * siluf_(bf2f(Z[(size_t)m * IN_W + ZC_GA + c])));
    }
  }
}

__device__ __forceinline__ void stage_gates(const Params& p, const Grp& g, int l, int bid, int nb, char* smem) {
  const bf16_t* H = (const bf16_t*)(p.ws + O_H);
  const bf16_t* W = (const bf16_t*)(p.ws + O_WMT);
  bf16_t* GT = (bf16_t*)(p.ws + O_GATES);
  const float* bm = p.b_merge + (size_t)l * 4096;
#ifndef EMU
  if ((g.mg & 255) == 0) {
    pg8::Gemm gm; gm.A = H; gm.Bt = W; gm.M = g.mg; gm.N = 4096; gm.K = 1024;
    pg8::StaticOrder S; S.init(gm.M, gm.N, nb, bid);
    pg8::EpiSigmoid E; E.O = GT; E.ldc = 4096; E.bias = bm;
    pg8::gemm_phase<pg8::EpiSigmoid, pg8::StaticOrder>((PG8_LAS unsigned char*)smem, gm, S, E);
    return;
  }
#endif
  const int TM = (g.mg + 127) / 128, mg = g.mg;
  for (int t = bid; t < TM * 32; t += nb) {
    int tn = t / TM, tm = t % TM; f4v acc[2][4]; zero_acc<4>(acc);
    gemm_mainloop<4>(H, 1024, tm * 128, mg, W, 1024, tn * 128, 4096, 1024, smem, acc);
    epi_foreach<4>(acc, tm * 128, tn * 128, [&](int row, int c0, f4v& v) {
      if (row < mg) *(u2v*)(GT + (size_t)row * 4096 + c0) = pack4(sigmoidf_(v[0] + bm[c0]), sigmoidf_(v[1] + bm[c0 + 1]), sigmoidf_(v[2] + bm[c0 + 2]), sigmoidf_(v[3] + bm[c0 + 3]));
    });
  }
}

__device__ __forceinline__ void stage_g8(const Params& p, const Grp& g, int l, int bid, int nb, char* smem) {
  char* ws = p.ws;
  bf16_t* MGD = (bf16_t*)(ws + O_MERGED);
  const bf16_t* GT = (const bf16_t*)(ws + O_GATES);
  const int TM = (g.mg + 127) / 128, mg = g.mg;
  for (int t = bid; t < TM * 8; t += nb) {
    int tn = t / TM, tm = t % TM;
    f4v macc[2][4]; zero_acc<4>(macc);
    for (int n = 0; n < 4; ++n) {
      f4v ap[2][4]; zero_acc<4>(ap);
      gemm_mainloop<4>((const bf16_t*)(ws + O_OBR) + (size_t)n * MG * 512, 512, tm * 128, mg, (const bf16_t*)(ws + O_WBRT) + (size_t)n * 1024 * 512, 512, tn * 128, 1024, 512, smem, ap);
      const int lane = my_tid() & 63, wid = my_tid() >> 6, wm = wid >> 1, wn = wid & 1;
#pragma unroll
      for (int i = 0; i < 2; ++i)
#pragma unroll
        for (int j = 0; j < 4; ++j) {
          int row = tm * 128 + wm * 32 + i * 16 + (lane & 15); row = row < mg ? row : mg - 1;
          int c0 = tn * 128 + wn * 64 + j * 16 + (lane >> 4) * 4;
          u2v gt = *(const u2v*)(GT + (size_t)row * 4096 + n * 1024 + c0);
          macc[i][j][0] += bflo(gt.x) * ap[i][j][0]; macc[i][j][1] += bfhi(gt.x) * ap[i][j][1]; macc[i][j][2] += bflo(gt.y) * ap[i][j][2]; macc[i][j][3] += bfhi(gt.y) * ap[i][j][3];
        }
    }
    epi_foreach<4>(macc, tm * 128, tn * 128, [&](int row, int c0, f4v& v) {
      if (row < mg) *(u2v*)(MGD + (size_t)row * 1024 + c0) = pack4(v[0], v[1], v[2], v[3]);
    });
  }
  (void)l;
}

__device__ __forceinline__ void stage_g9(const Params& p, const Grp& g, int l, int bid, int nb, char* smem) {
  char* ws = p.ws;
  float* X = p.out + (size_t)g.m0 * 1024;
  const float* modp = (const float*)(ws + O_MOD) + (size_t)l * 3 * 3072 + 2048;
  const int TM = (g.mg + 127) / 128, mg = g.mg;
  for (int t = bid; t < TM * 8; t += nb) {
    int tn = t / TM, tm = t % TM;
    f4v acc[2][4]; zero_acc<4>(acc);
    gemm_mainloop<4>((const bf16_t*)(ws + O_MERGED), 1024, tm * 128, mg, (const bf16_t*)(ws + O_WOUTT), 1024, tn * 128, 1024, 1024, smem, acc);
    epi_foreach<4>(acc, tm * 128, tn * 128, [&](int row, int c0, f4v& v) {
      if (row < mg) { const float* gt = modp + (size_t)mod_index(g, row) * 3072 + c0; f4v* xp = (f4v*)(X + (size_t)row * 1024 + c0); f4v x = *xp;
        x[0] += gt[0] * v[0]; x[1] += gt[1] * v[1]; x[2] += gt[2] * v[2]; x[3] += gt[3] * v[3]; *xp = x; }
    });
  }
}

__device__ __forceinline__ void stage_final(const Params& p, int bid, int nb) {
  const int lane = my_tid() & 63, wid = my_tid() >> 6;
  for (int m = bid * NWAVE + wid; m < M; m += nb * NWAVE) {
    float* xr = p.out + (size_t)m * 1024; float4 q[4]; float ss = 0.f;
#pragma unroll
    for (int i = 0; i < 4; ++i) { q[i] = *(const float4*)(xr + i * 256 + lane * 4); ss += q[i].x * q[i].x + q[i].y * q[i].y + q[i].z * q[i].z + q[i].w * q[i].w; }
    ss = wave_sum(ss); float rs = rsqrtf(ss * (1.f / 1024.f) + 1e-6f);
#pragma unroll
    for (int i = 0; i < 4; ++i) { int c = i * 256 + lane * 4; float4 gm = *(const float4*)(p.final_g + c);
      *(float4*)(xr + c) = make_float4(q[i].x * rs * gm.x, q[i].y * rs * gm.y, q[i].z * rs * gm.z, q[i].w * rs * gm.w); }
  }
}

#ifdef EMU
#define DECL_SMEM(name) char* name = emu::smem()
#else
#define DECL_SMEM(name) __shared__ __attribute__((aligned(16))) char name[SMEM_BYTES]
#endif

#ifdef EMU
struct GridBar { __device__ void sync() const { emu::grid_sync(); } };
#else
#define XB_TMO      128
#define XB_XCNT(j)  (256  + 64 * (j))
#define XB_XSUB(j)  (1280 + 64 * (j))
#define XB_XGEN(j)  (2304 + 64 * (j))
#define XB_TOP      3328
#define XB_TOPGEN   3392
#define XB_SPIN_CAP (1u << 20)
#define LAS __attribute__((address_space(3)))
__device__ __forceinline__ unsigned xb_ld(unsigned* p)              { return __hip_atomic_load(p, __ATOMIC_RELAXED, __HIP_MEMORY_SCOPE_AGENT); }
__device__ __forceinline__ unsigned xb_add(unsigned* p, unsigned v) { return __hip_atomic_fetch_add(p, v, __ATOMIC_RELAXED, __HIP_MEMORY_SCOPE_AGENT); }
__device__ __forceinline__ unsigned xb_xcc_id() { return (unsigned)__builtin_amdgcn_s_getreg((3 << 11) | 20) & 0xFu; }
#define XB_SPIN(cond, bar) do { unsigned _sp = 0; while (cond) { __builtin_amdgcn_s_sleep(1); \
    if ((++_sp & 255u) == 0u) { if (xb_ld(&(bar)[XB_TMO])) break; if (_sp > XB_SPIN_CAP) { atomicAdd(&(bar)[XB_TMO], 1u); break; } } } } while (0)
struct GridBar {
  unsigned* bar; unsigned x; volatile LAS unsigned* st;
  __device__ __forceinline__ void post(unsigned* b, volatile LAS unsigned* s_) {
    bar = b; x = xb_xcc_id(); st = s_;
    if (threadIdx.x == 0) (void)xb_add(&bar[XB_XCNT(x)], 1u);
  }
  __device__ __forceinline__ void complete(unsigned& nloc, unsigned& nx) const {
    const unsigned G = gridDim.x;
    unsigned sum, cnt, mine, sp = 0u;
    for (;;) {
      sum = 0u; cnt = 0u; mine = 0u;
#pragma unroll
      for (unsigned j = 0; j < 16; ++j) { const unsigned c = xb_ld(&bar[XB_XCNT(j)]); sum += c; cnt += (c > 0u) ? 1u : 0u; mine = (j == x) ? c : mine; }
      if (sum == G) break;
      __builtin_amdgcn_s_sleep(1);
      if ((++sp & 255u) == 0u) { if (xb_ld(&bar[XB_TMO])) break; if (sp > XB_SPIN_CAP) { atomicAdd(&bar[XB_TMO], 1u); break; } }
    }
    nloc = mine > 0u ? mine : 1u; nx = cnt > 0u ? cnt : 1u;
  }
  __device__ __forceinline__ void sync() const {
    asm volatile("s_waitcnt vmcnt(0)" ::: "memory");
    __syncthreads();
    if (threadIdx.x == 0) {
      __builtin_amdgcn_s_waitcnt(0);
      unsigned nloc = st[0], nx = st[1];
      if (nloc == 0u) { complete(nloc, nx); st[0] = nloc; st[1] = nx; }
      const unsigned old = xb_add(&bar[XB_XSUB(x)], 1u);
      const unsigned gen = old / nloc;
      if (old + 1u == (gen + 1u) * nloc) {
        __builtin_amdgcn_fence(__ATOMIC_RELEASE, "agent");
        asm volatile("s_waitcnt vmcnt(0)" ::: "memory");
        const unsigned og = xb_add(&bar[XB_TOP], 1u);
        const unsigned tg = og / nx;
        if (og + 1u == (tg + 1u) * nx) xb_add(&bar[XB_TOPGEN], 1u);
        else XB_SPIN(xb_ld(&bar[XB_TOPGEN]) == tg, bar);
        __builtin_amdgcn_fence(__ATOMIC_ACQUIRE, "agent");
        xb_add(&bar[XB_XGEN(x)], 1u);
        asm volatile("s_waitcnt vmcnt(0)" ::: "memory");
      } else {
        XB_SPIN(xb_ld(&bar[XB_XGEN(x)]) == gen, bar);
        __builtin_amdgcn_fence(__ATOMIC_ACQUIRE, "agent");
        asm volatile("s_waitcnt vmcnt(0)" ::: "memory");
      }
    }
    __syncthreads();
  }
};
#endif

#ifndef EMU
namespace cg = cooperative_groups;
#else
namespace cg = cooperative_groups;
#endif

__global__ void __launch_bounds__(NTHR) mega_kernel(Params p) {
  DECL_SMEM(smem);
  cg::grid_group grid = cg::this_grid();
  const int bid0 = blockIdx.x, nb0 = gridDim.x;
  GridBar gb;
#ifndef EMU
  if (threadIdx.x == 0) { volatile LAS unsigned* w = (volatile LAS unsigned*)(smem + SMEM_STAGE); w[0] = 0u; w[1] = 0u; w[2] = 0u; w[3] = 0u; }
  __syncthreads();
  gb.post((unsigned*)(p.ws + O_BAR), (volatile LAS unsigned*)(smem + SMEM_STAGE));
#endif
#ifndef PROBE_DUP
#define PROBE_DUP 0
#endif
#define STG(call) do { Params q = p; q.ws = opaque(q.ws); q.out = opaque(q.out); const int bid = opaque_i(bid0); const int nb = opaque_i(nb0); call; } while (0)
#define STP(bit, call) do { STG(call); if (PROBE_DUP & (bit)) { STG(call); } } while (0)
  for (int l = 0; l < NL; ++l) {
    STP(1, stage_prep(q, l, bid, nb, smem));
    if (l == 0) grid.sync();
    { Grp g0 = get_grp(0); STP(2, stage_h(q, g0, l, bid, nb)); }
    gb.sync();
    for (int gi = 0; gi < NGRP; ++gi) {
      Grp g = get_grp(gi);
      STP(4, stage_g1(q, g, bid, nb, smem)); gb.sync();
      STP(8, stage_e1(q, g, l, bid, nb)); gb.sync();
      STP(16, stage_g2(q, g, l, bid, nb, smem)); gb.sync();
      STP(32, stage_e2(q, g, l, bid, nb)); gb.sync();
      STP(64, stage_mix(q, g, l, bid, nb, smem)); gb.sync();
      STP(128, stage_dft2(q, g, bid, nb, smem));
      STP(256, stage_e3(q, g, l, bid, nb));
      STP(512, stage_gates(q, g, l, bid, nb, smem)); gb.sync();
      STP(1024, stage_g8(q, g, l, bid, nb, smem)); gb.sync();
      STG(stage_g9(q, g, l, bid, nb, smem));
      if (gi + 1 < NGRP) { Grp gn = get_grp(gi + 1); STP(2, stage_h(q, gn, l, bid, nb)); }
      gb.sync();
    }
  }
  STG(stage_final(q, bid, nb));
#undef STP
#undef STG
}

extern "C" void kernel_launch(void* const* d_in, const int* in_sizes, int n_in, void* d_out, int out_size, void* d_ws, size_t ws_size,
                              hipStream_t stream) {
  Params p{};
  const float** pp = (const float**)&p;
  for (int i = 0; i < 35; ++i) pp[i] = (const float*)d_in[i];
  p.out = (float*)d_out; p.ws = (char*)d_ws;
#ifdef EMU
  emu::set_coop(true);
  emu_launch(dim3(8), dim3(NTHR), [=]() { mega_kernel(p); });
  emu::set_coop(false);
#else
  static int grid_blocks = 0;
  if (!grid_blocks) {
    int dev = 0, cus = 0, per_cu = 0;
    (void)hipGetDevice(&dev);
    (void)hipDeviceGetAttribute(&cus, hipDeviceAttributeMultiprocessorCount, dev);
    (void)hipOccupancyMaxActiveBlocksPerMultiprocessor(&per_cu, mega_kernel, NTHR, 0);
    if (per_cu > 1) per_cu = 1;
    if (per_cu < 1) per_cu = 1;
    grid_blocks = cus * per_cu;
  }
  (void)hipMemsetAsync((char*)d_ws + O_BAR, 0, BAR_BYTES, stream);
  void* args[] = {&p};
  (void)hipLaunchCooperativeKernel((void*)mega_kernel, dim3(grid_blocks), dim3(NTHR), args, 0, stream);
#endif
  (void)in_sizes; (void)n_in; (void)out_size; (void)ws_size;
}
```

```cpp
#ifdef EMU
#include "hip_emu.h"
#else
#include <hip/hip_runtime.h>
#include <hip/hip_cooperative_groups.h>
#endif
#include <stdint.h>

#ifndef CFG_BATCH
#define CFG_BATCH 32
#define CFG_SEQ 256
#define CFG_DEC_BATCH 2
#define CFG_DEC_SEQ 2048
#define CFG_PAST 512
#define CFG_NGRP_C 2
#endif
constexpr int D = 1024, NL = 2;
constexpr int NB_C = CFG_BATCH, T_C = CFG_SEQ, NB_D = CFG_DEC_BATCH, T_D = CFG_DEC_SEQ, PAST = CFG_PAST;
constexpr int M_C = NB_C * T_C, M_D = NB_D * T_D, M = M_C + M_D;
constexpr int NGRP_C = CFG_NGRP_C, NGRP = 1 + NGRP_C;
constexpr int MGC = M_C / NGRP_C, SEQ_PER_CG = NB_C / NGRP_C;
constexpr int MG = MGC > M_D ? MGC : M_D;
constexpr int MKV = MG + NB_D * PAST;
constexpr int KEYS_D = T_D + PAST;
constexpr int IN_W = 5728;
constexpr int ZC_R = 0, ZC_K = 512, ZC_V = 1024, ZC_WDF = 1536, ZC_GA = 1728, ZC_QD = 2240, ZC_KVD = 2496, ZC_KR = 2624,
              ZC_GB = 2656, ZC_U = 3168, ZC_VC = 3680, ZC_GC = 4192, ZC_F = 4704, ZC_GD = 5216;
constexpr int SHIFT_W = 1728;
static_assert(M_C % NGRP_C == 0 && NB_C % NGRP_C == 0, "ctx groups");
static_assert(T_C % 128 == 0 && T_D % 128 == 0 && PAST % 32 == 0, "seq multiples");

typedef unsigned short bf16_t;
typedef short s8v __attribute__((ext_vector_type(8)));
typedef float f4v __attribute__((ext_vector_type(4)));
typedef float f16v __attribute__((ext_vector_type(16)));
typedef unsigned u4v __attribute__((ext_vector_type(4)));
typedef unsigned u2v __attribute__((ext_vector_type(2)));

struct Params {
  const float *x_prompt, *x_sample, *st_f, *st_b, *c_ckv, *c_kr, *c, *c_ctx, *norm_g, *w_ada, *b_ada, *w_in, *shift_mu, *w0, *w_up,
      *a0, *a_up, *k_k, *k_a, *r_k, *ln_g, *ln_b, *q_norm, *w_q_up, *kv_norm, *w_kv_up, *g_ln_g, *g_ln_b, *g_w_s, *g_b_s, *w_branch,
      *w_merge, *b_merge, *w_out, *final_g;
  float* out;
  char* ws;
};

struct Grp { int isden, m0, mg, nseq, T, b0, nkeys, mkv; };
__host__ __device__ __forceinline__ Grp get_grp(int gi) {
  Grp g;
  if (gi == 0) { g.isden = 1; g.m0 = M_C; g.mg = M_D; g.nseq = NB_D; g.T = T_D; g.b0 = 0; g.nkeys = KEYS_D; g.mkv = M_D + NB_D * PAST; }
  else { g.isden = 0; g.m0 = (gi - 1) * MGC; g.mg = MGC; g.nseq = SEQ_PER_CG; g.T = T_C; g.b0 = (gi - 1) * SEQ_PER_CG; g.nkeys = T_C; g.mkv = MGC; }
  return g;
}

constexpr size_t al256(size_t x) { return (x + 255) & ~(size_t)255; }
constexpr size_t O_WINT = 0;
constexpr int IN_WP = ((IN_W + 255) / 256) * 256;
constexpr size_t O_WMT = O_WINT + al256((size_t)IN_WP * 1024 * 2);
constexpr size_t O_WBRT = O_WMT + al256((size_t)4096 * 1024 * 2);
constexpr size_t O_WOUTT = O_WBRT + al256((size_t)4 * 1024 * 512 * 2);
constexpr size_t O_WQT = O_WOUTT + al256((size_t)1024 * 1024 * 2);
constexpr size_t O_WKVT = O_WQT + al256((size_t)768 * 256 * 2);
constexpr size_t O_WUPT = O_WKVT + al256((size_t)1024 * 128 * 2);
constexpr size_t O_WS = O_WUPT + al256((size_t)4 * 512 * 64 * 2);
constexpr size_t O_CS128 = O_WS + al256((size_t)4 * 128 * 128 * 2);
constexpr size_t O_A2C = O_CS128 + al256((size_t)256 * 128 * 2);
constexpr size_t O_A2D = O_A2C + al256((size_t)T_C * 2 * T_C * 2);
constexpr size_t O_ROPE = O_A2D + al256((size_t)T_D * 2 * T_D * 2);
constexpr size_t O_MOD = O_ROPE + al256((size_t)T_D * 32 * 4);
constexpr size_t O_H = O_MOD + al256((size_t)NL * 3 * 3072 * 4);
constexpr size_t O_Z = O_H + al256((size_t)MG * 1024 * 2);
constexpr size_t O_SK = O_Z + al256((size_t)MG * IN_W * 2);
constexpr size_t O_SOP = O_SK + al256((size_t)MG * 512 * 2);
constexpr size_t O_YS = O_SOP + al256((size_t)MG * 8 * 576 * 2);
constexpr size_t O_BON = O_YS + al256((size_t)2 * MG * 512 * 4);
constexpr size_t O_LORA = O_BON + al256((size_t)MG * 16 * 4);
constexpr size_t O_PRE = O_LORA + al256((size_t)MG * 192 * 2);
constexpr size_t O_QDN = O_PRE + al256((size_t)MG * 2048 * 2);
constexpr size_t O_CKV = O_QDN + al256((size_t)MG * 256 * 2);
constexpr size_t O_KR = O_CKV + al256((size_t)MKV * 128 * 2);
constexpr size_t O_Q = O_KR + al256((size_t)MKV * 32 * 2);
constexpr size_t O_KN = O_Q + al256((size_t)MG * 768 * 2);
constexpr size_t O_VT = O_KN + al256((size_t)MKV * 512 * 2);
constexpr size_t O_VCNT = O_VT + al256((size_t)MKV * 512 * 2);
constexpr size_t O_YT = O_VCNT + al256((size_t)MG * 512 * 2);
constexpr size_t O_OBR = O_YT + al256((size_t)MG * 1024 * 2);
constexpr size_t O_MERGED = O_OBR + al256((size_t)4 * MG * 512 * 2);
constexpr size_t O_END = O_MERGED + al256((size_t)MG * 1024 * 2);
constexpr size_t O_GATES = O_PRE;
static_assert(O_GATES + (size_t)MG * 4096 * 2 <= O_VCNT, "gates alias region too small");
constexpr size_t O_BAR = O_END;
constexpr size_t BAR_BYTES = 3456 * 4;
static_assert(O_BAR + BAR_BYTES <= ((size_t)256 << 20), "workspace must fit 256 MiB");

constexpr size_t OUT_SF = (size_t)M * D, OUT_SB = OUT_SF + (size_t)NB_C * NL * 8 * 64 * 64,
                 OUT_CKV = OUT_SB + (size_t)NB_C * NL * 8 * 64 * 64, OUT_KR = OUT_CKV + (size_t)NB_C * NL * T_C * 128;

#ifdef EMU
template <class T> __device__ __forceinline__ T* opaque(T* p) { return p; }
__device__ __forceinline__ int opaque_i(int v) { return v; }
#else
template <class T> __device__ __forceinline__ T* opaque(T* p) {
  typedef __attribute__((address_space(1))) T* gptr;
  gptr g = (gptr)p; asm volatile("" : "+s"(g)); return (T*)g;
}
__device__ __forceinline__ int opaque_i(int v) { asm volatile("" : "+s"(v)); return v; }
#endif
__device__ __forceinline__ int my_tid() {
#ifdef EMU
  return (int)threadIdx.x;
#else
  int t = (int)threadIdx.x; asm volatile("" : "+v"(t)); return t;
#endif
}
__device__ __forceinline__ unsigned f_as_u(float f) { return __builtin_bit_cast(unsigned, f); }
__device__ __forceinline__ float u_as_f(unsigned u) { return __builtin_bit_cast(float, u); }
__device__ __forceinline__ bf16_t f2bf(float f) { unsigned u = f_as_u(f); u += 0x7FFFu + ((u >> 16) & 1u); return (bf16_t)(u >> 16); }
__device__ __forceinline__ float bf2f(bf16_t h) { return u_as_f(((unsigned)h) << 16); }
__device__ __forceinline__ float bflo(unsigned u) { return u_as_f(u << 16); }
__device__ __forceinline__ float bfhi(unsigned u) { return u_as_f(u & 0xFFFF0000u); }
#ifdef EMU
__device__ __forceinline__ float fexp_(float x) { return expf(x); }
__device__ __forceinline__ float frcp_(float x) { return 1.f / x; }
#else
__device__ __forceinline__ float fexp_(float x) { return __builtin_amdgcn_exp2f(x * 1.4426950408889634f); }
__device__ __forceinline__ float frcp_(float x) { return __builtin_amdgcn_rcpf(x); }
#endif
__device__ __forceinline__ float sigmoidf_(float x) { return frcp_(1.f + fexp_(-x)); }
__device__ __forceinline__ float siluf_(float x) { return x * frcp_(1.f + fexp_(-x)); }
__device__ __forceinline__ float tanhf_(float x) { return 1.f - 2.f * frcp_(1.f + fexp_(2.f * x)); }
__device__ __forceinline__ float geluf_(float x) { return 0.5f * x * (1.f + tanhf_(0.7978845608028654f * (x + 0.044715f * x * x * x))); }
__device__ __forceinline__ float wave_sum(float v) {
#pragma unroll
  for (int o = 32; o >= 1; o >>= 1) v += __shfl_xor(v, o);
  return v;
}

#ifdef EMU
#define WAVE_SYNC() emu::wave_barrier()
__device__ __forceinline__ float sum16(float v) { v += __shfl_xor(v, 1); v += __shfl_xor(v, 2); v += __shfl_xor(v, 4); v += __shfl_xor(v, 8); return v; }
#else
#define WAVE_SYNC() __builtin_amdgcn_wave_barrier()
__device__ __forceinline__ float sum16(float v) {
  v += u_as_f(__builtin_amdgcn_update_dpp(0, (int)f_as_u(v), 0xB1, 0xF, 0xF, true));
  v += u_as_f(__builtin_amdgcn_update_dpp(0, (int)f_as_u(v), 0x4E, 0xF, 0xF, true));
  v += u_as_f(__builtin_amdgcn_update_dpp(0, (int)f_as_u(v), 0x141, 0xF, 0xF, true));
  v += u_as_f(__builtin_amdgcn_update_dpp(0, (int)f_as_u(v), 0x140, 0xF, 0xF, true));
  return v;
}
#endif

template <int LPR> __device__ __forceinline__ float sum_lpr(float v) {
#ifdef EMU
  v += __shfl_xor(v, 1); v += __shfl_xor(v, 2); v += __shfl_xor(v, 4);
  if (LPR >= 16) v += __shfl_xor(v, 8);
  if (LPR >= 32) v += __shfl_xor(v, 16);
  return v;
#else
  v += u_as_f(__builtin_amdgcn_update_dpp(0, (int)f_as_u(v), 0xB1, 0xF, 0xF, true));
  v += u_as_f(__builtin_amdgcn_update_dpp(0, (int)f_as_u(v), 0x4E, 0xF, 0xF, true));
  v += u_as_f(__builtin_amdgcn_update_dpp(0, (int)f_as_u(v), 0x141, 0xF, 0xF, true));
  if (LPR >= 16) v += u_as_f(__builtin_amdgcn_update_dpp(0, (int)f_as_u(v), 0x140, 0xF, 0xF, true));
  if (LPR >= 32) { auto r = __builtin_amdgcn_permlane16_swap(f_as_u(v), f_as_u(v), false, false); v = u_as_f(r[0]) + u_as_f(r[1]); }
  return v;
#endif
}

template <int LPR> __device__ __forceinline__ void sum_lpr2(float& a, float& b) {
#ifdef EMU
  a = sum_lpr<LPR>(a); b = sum_lpr<LPR>(b);
#else
#define DPP_ADD2(ctrl) { float ta = u_as_f(__builtin_amdgcn_update_dpp(0, (int)f_as_u(a), ctrl, 0xF, 0xF, true)); float tb = u_as_f(__builtin_amdgcn_update_dpp(0, (int)f_as_u(b), ctrl, 0xF, 0xF, true)); a += ta; b += tb; }
  DPP_ADD2(0xB1) DPP_ADD2(0x4E) DPP_ADD2(0x141)
  if (LPR >= 16) DPP_ADD2(0x140)
  if (LPR >= 32) { auto ra = __builtin_amdgcn_permlane16_swap(f_as_u(a), f_as_u(a), false, false); auto rb = __builtin_amdgcn_permlane16_swap(f_as_u(b), f_as_u(b), false, false);
    a = u_as_f(ra[0]) + u_as_f(ra[1]); b = u_as_f(rb[0]) + u_as_f(rb[1]); }
#undef DPP_ADD2
#endif
}

constexpr int NTHR = 512, NWAVE = 8;
constexpr int LDS_STR = 72;
constexpr int SMEM_STAGE = 131072;
constexpr int SMEM_BYTES = SMEM_STAGE + 16;

template <int NJ>
__device__ __forceinline__ void zero_acc(f4v (&acc)[2][NJ]) {
#pragma unroll
  for (int i = 0; i < 2; ++i)
#pragma unroll
    for (int j = 0; j < NJ; ++j) acc[i][j] = f4v{0.f, 0.f, 0.f, 0.f};
}

template <int NJ, bool BT = false>
__device__ __forceinline__ void gemm_mainloop(const bf16_t* __restrict__ A, long lda, int arow0, int arows, const bf16_t* __restrict__ B,
                                              long ldb, int brow0, int brows, int K, char* smem, f4v (&acc)[2][NJ]) {
  constexpr int BROWS = 32 * NJ, NBL = NJ / 2;
  constexpr int BUF = (128 + 128) * LDS_STR;
  bf16_t* s0 = (bf16_t*)smem;
  const int tid = my_tid(), lane = tid & 63, wid = tid >> 6, wm = wid >> 1, wn = wid & 1;
  u4v ra[2], rb[NBL];
  const bf16_t* ap[2]; const bf16_t* bp[NBL];
#pragma unroll
  for (int i = 0; i < 2; ++i) { int c = tid + NTHR * i, r = c >> 3, cc = c & 7; int ar = arow0 + r; ar = ar < arows ? ar : arows - 1; ap[i] = A + (long)ar * lda + cc * 8; }
#pragma unroll
  for (int i = 0; i < NBL; ++i) { int c = tid + NTHR * i;
    if (BT) { int q = c >> 4, dc = c & 15; bp[i] = B + (long)q * ldb + brow0 + dc * 8; }
    else { int r = c >> 3, cc = c & 7; int br = brow0 + r; br = br < brows ? br : brows - 1; bp[i] = B + (long)br * ldb + cc * 8; } }
#pragma unroll
  for (int i = 0; i < 2; ++i) ra[i] = *(const u4v*)(ap[i]);
#pragma unroll
  for (int i = 0; i < NBL; ++i) rb[i] = *(const u4v*)(bp[i]);
  __syncthreads();
#pragma unroll
  for (int i = 0; i < 2; ++i) { int c = tid + NTHR * i, r = c >> 3, cc = c & 7; *(u4v*)(s0 + r * LDS_STR + cc * 8) = ra[i]; }
#pragma unroll
  for (int i = 0; i < NBL; ++i) { int c = tid + NTHR * i;
    if (BT) { int q = c >> 4, dc = c & 15;
#pragma unroll
      for (int e = 0; e < 8; ++e) s0[(128 + dc * 8 + e) * LDS_STR + q] = (bf16_t)(rb[i][e >> 1] >> ((e & 1) * 16)); }
    else { int r = c >> 3, cc = c & 7; *(u4v*)(s0 + (128 + r) * LDS_STR + cc * 8) = rb[i]; } }
  __syncthreads();
  const int nk = K >> 6;
  for (int kt = 0; kt < nk; ++kt) {
    const bool more = kt + 1 < nk;
    if (more) {
#pragma unroll
      for (int i = 0; i < 2; ++i) ra[i] = *(const u4v*)(ap[i] + (kt + 1) * 64);
#pragma unroll
      for (int i = 0; i < NBL; ++i) rb[i] = *(const u4v*)(bp[i] + (BT ? (long)(kt + 1) * 64 * ldb : (long)(kt + 1) * 64));
    }
    const bf16_t* sA = s0 + (kt & 1) * BUF; const bf16_t* sB = sA + 128 * LDS_STR;
#pragma unroll
    for (int ks = 0; ks < 2; ++ks) {
      s8v af[2], bf[NJ];
#pragma unroll
      for (int i = 0; i < 2; ++i) af[i] = *(const s8v*)(sA + (wm * 32 + i * 16 + (lane & 15)) * LDS_STR + ks * 32 + (lane >> 4) * 8);
#pragma unroll
      for (int j = 0; j < NJ; ++j) bf[j] = *(const s8v*)(sB + (wn * NJ * 16 + j * 16 + (lane & 15)) * LDS_STR + ks * 32 + (lane >> 4) * 8);
#pragma unroll
      for (int i = 0; i < 2; ++i)
#pragma unroll
        for (int j = 0; j < NJ; ++j) acc[i][j] = __builtin_amdgcn_mfma_f32_16x16x32_bf16(bf[j], af[i], acc[i][j], 0, 0, 0);
    }
    if (more) {
      bf16_t* dA = s0 + ((kt + 1) & 1) * BUF;
#pragma unroll
      for (int i = 0; i < 2; ++i) { int c = tid + NTHR * i, r = c >> 3, cc = c & 7; *(u4v*)(dA + r * LDS_STR + cc * 8) = ra[i]; }
#pragma unroll
      for (int i = 0; i < NBL; ++i) { int c = tid + NTHR * i;
        if (BT) { int q = c >> 4, dc = c & 15;
#pragma unroll
          for (int e = 0; e < 8; ++e) dA[(128 + dc * 8 + e) * LDS_STR + q] = (bf16_t)(rb[i][e >> 1] >> ((e & 1) * 16)); }
        else { int r = c >> 3, cc = c & 7; *(u4v*)(dA + (128 + r) * LDS_STR + cc * 8) = rb[i]; } }
    }
    __syncthreads();
  }
  (void)BROWS;
}

template <int NJ, class F>
__device__ __forceinline__ void epi_foreach(f4v (&acc)[2][NJ], int row0, int col0, F f) {
  const int tid = my_tid(), lane = tid & 63, wid = tid >> 6, wm = wid >> 1, wn = wid & 1;
#pragma unroll
  for (int i = 0; i < 2; ++i)
#pragma unroll
    for (int j = 0; j < NJ; ++j) f(row0 + wm * 32 + i * 16 + (lane & 15), col0 + wn * NJ * 16 + j * 16 + (lane >> 4) * 4, acc[i][j]);
}
__device__ __forceinline__ u4v pack8(const float (&x)[8]) {
  return u4v{(unsigned)f2bf(x[0]) | ((unsigned)f2bf(x[1]) << 16), (unsigned)f2bf(x[2]) | ((unsigned)f2bf(x[3]) << 16),
             (unsigned)f2bf(x[4]) | ((unsigned)f2bf(x[5]) << 16), (unsigned)f2bf(x[6]) | ((unsigned)f2bf(x[7]) << 16)};
}
__device__ __forceinline__ void unpack8(u4v u, float (&x)[8]) {
  x[0] = bflo(u.x); x[1] = bfhi(u.x); x[2] = bflo(u.y); x[3] = bfhi(u.y); x[4] = bflo(u.z); x[5] = bfhi(u.z); x[6] = bflo(u.w); x[7] = bfhi(u.w);
}
__device__ __forceinline__ u2v pack4(float a, float b, float c, float d) {
  return u2v{(unsigned)f2bf(a) | ((unsigned)f2bf(b) << 16), (unsigned)f2bf(c) | ((unsigned)f2bf(d) << 16)};
}

#ifndef EMU
namespace pg8 {
#define PG8_LAS __attribute__((address_space(3)))
typedef unsigned short bf16_t;
typedef short bf16x8 __attribute__((ext_vector_type(8)));
typedef float f32x4 __attribute__((ext_vector_type(4)));
typedef unsigned u32x4 __attribute__((ext_vector_type(4)));
constexpr int BM = 256, BK = 64, HALF = 128, HTB = HALF * BK * 2  , STAGE_BYTES = 8 * HTB, NXCD = 8, WGM = 8;

__host__ __device__ __forceinline__ int lds_byte(int r, int c) { const int st = (r >> 4) * 2 + (c >> 5), rr = r & 15, cc = c & 31, ob = rr * 64 + cc * 2; return st * 1024 + (ob ^ (((ob >> 9) & 1) << 5)); }
__host__ __device__ __forceinline__ void stage_rc(int b, int& R, int& C) { const int st = b / 1024, sb = b % 1024, swz = sb ^ (((sb >> 9) & 1) << 5); R = (st >> 1) * 16 + swz / 64; C = (st & 1) * 32 + (swz % 64) / 2; }
__host__ __device__ __forceinline__ int perm32(int rho) { const int n = rho >> 4, i = rho & 15; return 8 * (i >> 2) + 4 * n + (i & 3); }

struct Unit { int pm, pn; };
struct Gemm { const bf16_t* A; const bf16_t* Bt; int M, N, K; };

struct StaticOrder {
    int nM, nN, nwg, G, c;
    __host__ __device__ void init(int M, int N, int G_, int c_) { nM = M / BM; nN = N / BM; nwg = nM * nN; G = G_; c = c_; }
    __host__ __device__ bool next(int i, Unit& u) const {
        const long L = (long)i * G + c; if (L >= nwg) return false;
        int wgid = (int)L; { const int q = nwg / NXCD, r = nwg % NXCD, xcd = wgid % NXCD, off = wgid / NXCD; wgid = (xcd < r ? xcd * (q + 1) : r * (q + 1) + (xcd - r) * q) + off; }
        const int nig = WGM * nN, gid = wgid / nig, fm = gid * WGM, gsz = (nM - fm) < WGM ? (nM - fm) : WGM;
        u.pm = fm + ((wgid % nig) % gsz); u.pn = (wgid % nig) / gsz; return true;
    }
    __device__ __forceinline__ void a_ready(const Unit&) const {}
    __device__ __forceinline__ void done(const Unit&) const {}
};
template <class Epi, class Sched>
__device__ __forceinline__ void gemm_phase(PG8_LAS unsigned char* lds, const Gemm g, const Sched& S, const Epi& E) {
    const int tid = my_tid(), wid = __builtin_amdgcn_readfirstlane(tid >> 6), lane = tid & 63, wr = wid >> 2, wc = wid & 3, fr = lane & 15, fq = lane >> 4;
    const int K = g.K, nt = K / BK;
    unsigned voffA[2], voffB[2];
#pragma unroll
    for (int i = 0; i < 2; ++i) { int R, C; stage_rc(tid * 16 + i * 8192, R, C); const int Rb = Epi::PERM ? ((R & ~31) + perm32(R & 31)) : R;
        voffA[i] = (unsigned)(R * K + C) * 2u; voffB[i] = (unsigned)(Rb * K + C) * 2u; }
    const size_t kstep = (size_t)(BK * 2);
    const size_t hstep = (size_t)HALF * K * 2;
    const size_t tstep = 2 * hstep;
    const unsigned ldsw = (unsigned)wid * 1024u;
    const int aoff = lds_byte(wr * 64 + fr, fq * 8), boff = lds_byte(wc * 32 + fr, fq * 8);
#define PG8_SA(b, h) (((b) * 2 + (h)) * HTB)
#define PG8_SB(b, h) ((4 + (b) * 2 + (h)) * HTB)
#define PG8_STAGE(bufoff, gbase, voff) do { _Pragma("unroll") for (int _i = 0; _i < 2; ++_i) \
        __builtin_amdgcn_global_load_lds((const unsigned*)((const char*)(gbase) + (voff)[_i]), (PG8_LAS unsigned*)(lds + (bufoff) + ldsw + _i * 8192), 16, 0, 0); } while (0)
#define PG8_LDA(dst, b, h) do { _Pragma("unroll") for (int m = 0; m < 4; ++m) _Pragma("unroll") for (int k = 0; k < 2; ++k) dst[m][k] = *(const PG8_LAS bf16x8*)(lds + PG8_SA(b, h) + aoff + m * 2048 + k * 1024); } while (0)
#define PG8_LDB(dst, b, h) do { _Pragma("unroll") for (int n = 0; n < 2; ++n) _Pragma("unroll") for (int k = 0; k < 2; ++k) dst[n][k] = *(const PG8_LAS bf16x8*)(lds + PG8_SB(b, h) + boff + n * 2048 + k * 1024); } while (0)
#define PG8_MMA(ai, bj, At, Bt) do { __builtin_amdgcn_s_setprio(1); _Pragma("unroll") for (int m = 0; m < 4; ++m) _Pragma("unroll") for (int n = 0; n < 2; ++n) _Pragma("unroll") for (int k = 0; k < 2; ++k) \
        acc[ai][bj][m][n] = __builtin_amdgcn_mfma_f32_16x16x32_bf16(Bt[n][k], At[m][k], acc[ai][bj][m][n], 0, 0, 0); __builtin_amdgcn_s_setprio(0); } while (0)
#define PG8_WAIT_V(n) asm volatile("s_waitcnt vmcnt(" #n ")" ::: "memory")
#define PG8_WAIT_L(n) asm volatile("s_waitcnt lgkmcnt(" #n ")" ::: "memory")
#define PG8_BAR __builtin_amdgcn_s_barrier()
#define PG8_SCHED __builtin_amdgcn_sched_barrier(0)
    Unit cur, nxt; int ui = 0;
    if (!S.next(0, cur)) return;
    f32x4 acc[2][2][4][2];
#pragma unroll
    for (int a = 0; a < 2; ++a)
#pragma unroll
        for (int b = 0; b < 2; ++b)
#pragma unroll
            for (int m = 0; m < 4; ++m)
#pragma unroll
                for (int n = 0; n < 2; ++n) acc[a][b][m][n] = (f32x4){0.f, 0.f, 0.f, 0.f};
    bf16x8 At[4][2], B0[2][2], B1[2][2];
    const char* cA = (const char*)g.A + (size_t)cur.pm * tstep; const char* cB = (const char*)g.Bt + (size_t)cur.pn * tstep;
    S.a_ready(cur);
    PG8_STAGE(PG8_SB(0, 0), cB, voffB); PG8_STAGE(PG8_SA(0, 0), cA, voffA); PG8_STAGE(PG8_SB(0, 1), cB + hstep, voffB); PG8_STAGE(PG8_SA(0, 1), cA + hstep, voffA);
    if (wr == 1) PG8_BAR;
    PG8_WAIT_V(4); PG8_BAR;
    PG8_STAGE(PG8_SB(1, 0), cB + kstep, voffB); PG8_STAGE(PG8_SA(1, 0), cA + kstep, voffA); PG8_STAGE(PG8_SB(1, 1), cB + hstep + kstep, voffB);
    PG8_WAIT_V(6); PG8_BAR;
    for (;;) {
        const bool has_next = S.next(ui + 1, nxt);
        const char* nA = has_next ? (const char*)g.A + (size_t)nxt.pm * tstep : cA; const char* nB = has_next ? (const char*)g.Bt + (size_t)nxt.pn * tstep : cB;
        for (int t = 0; t < nt; t += 2) {
            const bool last = (t == nt - 2);
            const char* a1 = cA + (size_t)(t + 1) * kstep;
            const char* a2 = last ? nA : cA + (size_t)(t + 2) * kstep; const char* b2 = last ? nB : cB + (size_t)(t + 2) * kstep;
            const char* a3 = a2 + kstep; const char* b3 = b2 + kstep;
            if (last && has_next) S.a_ready(nxt);
            PG8_LDB(B0, 0, 0); PG8_SCHED; PG8_LDA(At, 0, 0); PG8_STAGE(PG8_SA(1, 1), a1 + hstep, voffA);
            PG8_WAIT_L(8); PG8_BAR; PG8_WAIT_L(0); PG8_MMA(0, 0, At, B0); PG8_BAR; PG8_SCHED;
            PG8_LDB(B1, 0, 1); PG8_STAGE(PG8_SB(0, 0), b2, voffB);
            PG8_BAR; PG8_WAIT_L(0); PG8_MMA(0, 1, At, B1); PG8_BAR;
            PG8_LDA(At, 0, 1); PG8_STAGE(PG8_SA(0, 0), a2, voffA);
            PG8_BAR; PG8_WAIT_L(0); PG8_MMA(1, 0, At, B0); PG8_BAR; PG8_SCHED;
            PG8_STAGE(PG8_SB(0, 1), b2 + hstep, voffB);
            PG8_WAIT_V(6); PG8_BAR; PG8_MMA(1, 1, At, B1); PG8_BAR;
            PG8_LDB(B0, 1, 0); PG8_SCHED; PG8_LDA(At, 1, 0); PG8_STAGE(PG8_SA(0, 1), a2 + hstep, voffA);
            PG8_WAIT_L(8); PG8_BAR; PG8_WAIT_L(0); PG8_MMA(0, 0, At, B0); PG8_BAR; PG8_SCHED;
            PG8_LDB(B1, 1, 1); PG8_STAGE(PG8_SB(1, 0), b3, voffB);
            PG8_BAR; PG8_WAIT_L(0); PG8_MMA(0, 1, At, B1); PG8_BAR;
            PG8_LDA(At, 1, 1); PG8_STAGE(PG8_SA(1, 0), a3, voffA);
            PG8_BAR; PG8_WAIT_L(0); PG8_MMA(1, 0, At, B0); PG8_BAR; PG8_SCHED;
            PG8_STAGE(PG8_SB(1, 1), b3 + hstep, voffB);
            PG8_WAIT_V(6); PG8_BAR; PG8_MMA(1, 1, At, B1); PG8_BAR;
        }
            if constexpr (!Epi::AFTER_DRAIN) { E(acc, cur, wr, wc, fr, fq); S.done(cur); }
            if (!has_next) break;
#pragma unroll
        for (int a = 0; a < 2; ++a)
#pragma unroll
            for (int b = 0; b < 2; ++b)
#pragma unroll
                for (int m = 0; m < 4; ++m)
#pragma unroll
                    for (int n = 0; n < 2; ++n) acc[a][b][m][n] = (f32x4){0.f, 0.f, 0.f, 0.f};
        cur = nxt; cA = nA; cB = nB; ++ui;
    }
    PG8_WAIT_V(0);
    if (wr == 0) PG8_BAR;
    PG8_BAR;
    if constexpr (Epi::AFTER_DRAIN) { E.fused(acc, cur, wr, wc, fr, fq, lds, wid, lane); S.done(cur); }
#undef PG8_SA
#undef PG8_SB
#undef PG8_STAGE
#undef PG8_LDA
#undef PG8_LDB
#undef PG8_MMA
#undef PG8_WAIT_V
#undef PG8_WAIT_L
#undef PG8_BAR
#undef PG8_SCHED
}

__device__ __forceinline__ unsigned pk2(float lo, float hi) { return (unsigned)f2bf(lo) | ((unsigned)f2bf(hi) << 16); }
struct EpiStore {
  static constexpr bool PERM = true, AFTER_DRAIN = false;
  bf16_t* O; int ldc; int ncols;
  __device__ __forceinline__ void operator()(const f32x4 (&acc)[2][2][4][2], const Unit& u, int wr, int wc, int fr, int fq) const {
    const int row0 = u.pm * BM + wr * 64 + fr, col0 = u.pn * BM + wc * 32 + 8 * fq;
#pragma unroll
    for (int ai = 0; ai < 2; ++ai)
#pragma unroll
      for (int m = 0; m < 4; ++m) { bf16_t* rowp = O + (size_t)(row0 + ai * HALF + m * 16) * ldc + col0;
#pragma unroll
        for (int bj = 0; bj < 2; ++bj) if (col0 + bj * HALF < ncols) { const f32x4 v0 = acc[ai][bj][m][0], v1 = acc[ai][bj][m][1];
          *(u32x4*)(rowp + bj * HALF) = (u32x4){pk2(v0[0], v0[1]), pk2(v0[2], v0[3]), pk2(v1[0], v1[1]), pk2(v1[2], v1[3])}; } }
  }
};
struct EpiSigmoid {
  static constexpr bool PERM = true, AFTER_DRAIN = false;
  bf16_t* O; int ldc; const float* bias;
  __device__ __forceinline__ void operator()(const f32x4 (&acc)[2][2][4][2], const Unit& u, int wr, int wc, int fr, int fq) const {
    const int row0 = u.pm * BM + wr * 64 + fr, col0 = u.pn * BM + wc * 32 + 8 * fq;
    f32x4 bv[2][2];
#pragma unroll
    for (int bj = 0; bj < 2; ++bj)
#pragma unroll
      for (int n = 0; n < 2; ++n) bv[bj][n] = *(const f32x4*)(bias + col0 + bj * HALF + 4 * n);
#pragma unroll
    for (int ai = 0; ai < 2; ++ai)
#pragma unroll
      for (int m = 0; m < 4; ++m) { bf16_t* rowp = O + (size_t)(row0 + ai * HALF + m * 16) * ldc + col0;
#pragma unroll
        for (int bj = 0; bj < 2; ++bj) { const f32x4 v0 = acc[ai][bj][m][0] + bv[bj][0], v1 = acc[ai][bj][m][1] + bv[bj][1];
          *(u32x4*)(rowp + bj * HALF) = (u32x4){pk2(sigmoidf_(v0[0]), sigmoidf_(v0[1])), pk2(sigmoidf_(v0[2]), sigmoidf_(v0[3])), pk2(sigmoidf_(v1[0]), sigmoidf_(v1[1])), pk2(sigmoidf_(v1[2]), sigmoidf_(v1[3]))}; } }
  }
};
}
#endif

struct TJob { const float* src; int K, N; long lds; bf16_t* dst; long ldd; };
__device__ __forceinline__ TJob get_tjob(const Params& p, int l, int j) {
  TJob t; char* ws = p.ws;
  if (j == 0) { t.src = p.w_in + (size_t)l * 1024 * IN_W; t.K = 1024; t.N = IN_W; t.lds = IN_W; t.dst = (bf16_t*)(ws + O_WINT); t.ldd = 1024; }
  else if (j == 1) { t.src = p.w_merge + (size_t)l * 1024 * 4096; t.K = 1024; t.N = 4096; t.lds = 4096; t.dst = (bf16_t*)(ws + O_WMT); t.ldd = 1024; }
  else if (j < 6) { int n = j - 2; t.src = p.w_branch + ((size_t)l * 4 + n) * 512 * 1024; t.K = 512; t.N = 1024; t.lds = 1024; t.dst = (bf16_t*)(ws + O_WBRT) + (size_t)n * 1024 * 512; t.ldd = 512; }
  else if (j == 6) { t.src = p.w_out + (size_t)l * 1024 * 1024; t.K = 1024; t.N = 1024; t.lds = 1024; t.dst = (bf16_t*)(ws + O_WOUTT); t.ldd = 1024; }
  else if (j == 7) { t.src = p.w_q_up + (size_t)l * 256 * 768; t.K = 256; t.N = 768; t.lds = 768; t.dst = (bf16_t*)(ws + O_WQT); t.ldd = 256; }
  else if (j == 8) { t.src = p.w_kv_up + (size_t)l * 128 * 1024; t.K = 128; t.N = 1024; t.lds = 1024; t.dst = (bf16_t*)(ws + O_WKVT); t.ldd = 128; }
  else { int n = j - 9;
    t.src = (n < 2 ? p.w_up : p.a_up) + ((size_t)l * 2 + (n & 1)) * 64 * 512; t.K = 64; t.N = 512; t.lds = 512;
    t.dst = (bf16_t*)(ws + O_WUPT) + (size_t)n * 512 * 64; t.ldd = 64; }
  return t;
}
constexpr int NTJOBS = 13;

__device__ __forceinline__ void stage_prep(const Params& p, int l, int bid, int nb, char* smem) {
  const int tid = my_tid();
  char* ws = p.ws;
  {
    float* tile = (float*)smem;
    int base = 0;
    for (int j = 0; j < NTJOBS; ++j) {
      TJob t = get_tjob(p, l, j);
      int tk = t.K / 64, tn = t.N / 32, nt = tk * tn;
      int first = ((bid - base % nb) % nb + nb) % nb;
      for (int q = first; q < nt; q += nb) {
        int kt = q / tn, nt_ = q % tn;
        __syncthreads();
        { int r = tid >> 3, c4 = tid & 7; f4v x = *(const f4v*)(t.src + (long)(kt * 64 + r) * t.lds + nt_ * 32 + c4 * 4);
          tile[r * 33 + c4 * 4] = x[0]; tile[r * 33 + c4 * 4 + 1] = x[1]; tile[r * 33 + c4 * 4 + 2] = x[2]; tile[r * 33 + c4 * 4 + 3] = x[3]; }
        __syncthreads();
        if (tid < 256) { int n = tid >> 3, kc = tid & 7; float x[8];
#pragma unroll
          for (int e = 0; e < 8; ++e) x[e] = tile[(kc * 8 + e) * 33 + n];
          *(u4v*)(t.dst + (long)(nt_ * 32 + n) * t.ldd + kt * 64 + kc * 8) = pack8(x); }
      }
      base += nt;
    }
    __syncthreads();
  }
  const long gtid = (long)bid * NTHR + tid, gn = (long)nb * NTHR;
  { bf16_t* d = (bf16_t*)(ws + O_WINT) + (size_t)IN_W * 1024; for (long i = gtid; i < (long)(IN_WP - IN_W) * 1024; i += gn) d[i] = 0; }
  { bf16_t* d = (bf16_t*)(ws + O_WS); const float* s = p.g_w_s + (size_t)l * 4 * 128 * 128; for (long i = gtid; i < (long)4 * 128 * 128; i += gn) d[i] = f2bf(s[i]); }
  if (l != 0) return;
  { bf16_t* d = (bf16_t*)(ws + O_CS128);
    for (long i = gtid; i < 256 * 128; i += gn) { int j = (int)(i >> 7), c = (int)(i & 127); int mm = ((j & 127) * c) & 127; float x = 2.0f * mm / 128.f; d[i] = f2bf(j < 128 ? cospif(x) : sinpif(x)); } }
  { bf16_t* d = (bf16_t*)(ws + O_A2C);
    for (long i = gtid; i < (long)T_C * 2 * T_C; i += gn) { int tp = (int)(i / (2 * T_C)), tt = (int)(i % (2 * T_C)); int half = tt >= T_C; int t = half ? tt - T_C : tt; int mm = (int)(((long)tp * t) % T_C); float x = 2.0f * mm / (float)T_C; d[i] = f2bf(half ? -sinpif(x) : cospif(x)); } }
  { bf16_t* d = (bf16_t*)(ws + O_A2D);
    for (long i = gtid; i < (long)T_D * 2 * T_D; i += gn) { int tp = (int)(i / (2 * T_D)), tt = (int)(i % (2 * T_D)); int half = tt >= T_D; int t = half ? tt - T_D : tt; int mm = (int)(((long)tp * t) % T_D); float x = 2.0f * mm / (float)T_D; d[i] = f2bf(half ? -sinpif(x) : cospif(x)); } }
  { float* d = (float*)(ws + O_ROPE);
    for (long i = gtid; i < (long)T_D * 16; i += gn) { int t = (int)(i >> 4), pi = (int)(i & 15); float pos = (pi < 8) ? (float)(t / 64) : (float)(t % 64); float inv = expf(-(float)(pi & 7) * (9.210340371976184f / 8.f)); float a = pos * inv; d[2 * i] = cosf(a); d[2 * i + 1] = sinf(a); } }
  { float4* d = (float4*)p.out; const float4* s0 = (const float4*)p.x_prompt; const float4* s1 = (const float4*)p.x_sample;
    for (long i = gtid; i < (long)M * 256; i += gn) d[i] = (i < (long)M_C * 256) ? s0[i] : s1[i - (long)M_C * 256]; }
  {
    float* red = (float*)smem;
    float* modp = (float*)(ws + O_MOD);
    for (int u = bid; u < NL * 48; u += nb) {
      int ll = u / 48, cg = u % 48; int col = cg * 64 + (tid & 63), kq = tid >> 6;
      float a0 = 0.f, a1 = 0.f, a2 = 0.f;
      const float* w = p.w_ada + (size_t)ll * 1024 * 3072 + col;
      for (int k = kq * 128; k < kq * 128 + 128; ++k) {
        float wv = w[(size_t)k * 3072];
        a0 += siluf_(p.c_ctx[k]) * wv; a1 += siluf_(p.c[k]) * wv; a2 += siluf_(p.c[(NB_D > 1 ? 1024 : 0) + k]) * wv;
      }
      __syncthreads();
      red[(kq * 3 + 0) * 64 + (tid & 63)] = a0; red[(kq * 3 + 1) * 64 + (tid & 63)] = a1; red[(kq * 3 + 2) * 64 + (tid & 63)] = a2;
      __syncthreads();
      if (tid < 192) { int mi = tid >> 6, cc = tid & 63; float s = 0.f;
#pragma unroll
        for (int q8 = 0; q8 < 8; ++q8) s += red[(q8 * 3 + mi) * 64 + cc];
        modp[((size_t)ll * 3 + mi) * 3072 + cg * 64 + cc] = s + p.b_ada[(size_t)ll * 3072 + cg * 64 + cc]; }
    }
  }
}

__device__ __forceinline__ int mod_index(const Grp& g, int lm) { return g.isden ? 1 + lm / T_D : 0; }

__device__ __forceinline__ void stage_h(const Params& p, const Grp& g, int l, int bid, int nb) {
  const int lane = my_tid() & 63, wid = my_tid() >> 6;
  const float* X = p.out + (size_t)g.m0 * 1024;
  bf16_t* H = (bf16_t*)(p.ws + O_H);
  const float* modp = (const float*)(p.ws + O_MOD) + (size_t)l * 3 * 3072;
  const float* gam = p.norm_g + (size_t)l * 1024;
  for (int m = bid * NWAVE + wid; m < g.mg; m += nb * NWAVE) {
    const float* xr = X + (size_t)m * 1024; float v[16]; float ss = 0.f;
#pragma unroll
    for (int i = 0; i < 4; ++i) { float4 q = *(const float4*)(xr + i * 256 + lane * 4); v[4 * i] = q.x; v[4 * i + 1] = q.y; v[4 * i + 2] = q.z; v[4 * i + 3] = q.w; ss += q.x * q.x + q.y * q.y + q.z * q.z + q.w * q.w; }
    ss = wave_sum(ss); float rs = rsqrtf(ss * (1.f / 1024.f) + 1e-6f);
    const float* mo = modp + (size_t)mod_index(g, m) * 3072;
#pragma unroll
    for (int i = 0; i < 4; ++i) {
      int c = i * 256 + lane * 4; bf16_t o[4];
#pragma unroll
      for (int e = 0; e < 4; ++e) o[e] = f2bf(v[4 * i + e] * rs * gam[c + e] * (1.f + mo[1024 + c + e]) + mo[c + e]);
      *(uint2*)(H + (size_t)m * 1024 + c) = make_uint2((unsigned)o[0] | ((unsigned)o[1] << 16), (unsigned)o[2] | ((unsigned)o[3] << 16));
    }
  }
}

__device__ __forceinline__ void stage_g1(const Params& p, const Grp& g, int bid, int nb, char* smem) {
  const bf16_t* H = (const bf16_t*)(p.ws + O_H);
  const bf16_t* W = (const bf16_t*)(p.ws + O_WINT);
  bf16_t* Z = (bf16_t*)(p.ws + O_Z);
#ifndef EMU
  if ((g.mg & 255) == 0) {
    pg8::Gemm gm; gm.A = H; gm.Bt = W; gm.M = g.mg; gm.N = IN_WP; gm.K = 1024;
    pg8::StaticOrder S; S.init(gm.M, gm.N, nb, bid);
    pg8::EpiStore E; E.O = Z; E.ldc = IN_W; E.ncols = IN_W;
    pg8::gemm_phase<pg8::EpiStore, pg8::StaticOrder>((PG8_LAS unsigned char*)smem, gm, S, E);
    return;
  }
#endif
  const int TM = (g.mg + 127) / 128; constexpr int TN = (IN_W + 127) / 128;
  const int mg = g.mg;
  for (int t = bid; t < TM * TN; t += nb) {
    int tn = t / TM, tm = t % TM; f4v acc[2][4]; zero_acc<4>(acc);
    gemm_mainloop<4>(H, 1024, tm * 128, mg, W, 1024, tn * 128, IN_W, 1024, smem, acc);
    epi_foreach<4>(acc, tm * 128, tn * 128, [&](int row, int c0, f4v& v) {
      if (c0 < IN_W && row < mg) *(u2v*)(Z + (size_t)row * IN_W + c0) = pack4(v[0], v[1], v[2], v[3]);
    });
  }
}

__device__ __forceinline__ void stage_e1(const Params& p, const Grp& g, int l, int bid, int nb) {
  const int lane = my_tid() & 63, wid = my_tid() >> 6;
  char* ws = p.ws;
  const bf16_t* Z = (const bf16_t*)(ws + O_Z);
  bf16_t* SK = (bf16_t*)(ws + O_SK); bf16_t* SOP = (bf16_t*)(ws + O_SOP);
  bf16_t* LORA = (bf16_t*)(ws + O_LORA); bf16_t* QDN = (bf16_t*)(ws + O_QDN); bf16_t* CKV = (bf16_t*)(ws + O_CKV); bf16_t* KR = (bf16_t*)(ws + O_KR);
  bf16_t* VCN = (bf16_t*)(ws + O_VCNT);
  const float* rope = (const float*)(ws + O_ROPE);
  const float* mu = p.shift_mu + (size_t)l * SHIFT_W;
  const int isden = g.isden, T = g.T;
  for (int m = bid * NWAVE + wid; m < g.mkv; m += nb * NWAVE) {
    if (m >= g.mg) {
      int r = m - g.mg, b = r / PAST, j = r % PAST;
      if (lane < 20) {
        const float* s = lane < 16 ? p.c_ckv + (((size_t)b * NL + l) * PAST + j) * 128 + lane * 8 : p.c_kr + (((size_t)b * NL + l) * PAST + j) * 32 + (lane - 16) * 8;
        f4v x0 = *(const f4v*)s, x1 = *(const f4v*)(s + 4); float x[8] = {x0[0], x0[1], x0[2], x0[3], x1[0], x1[1], x1[2], x1[3]};
        if (lane < 16) *(u4v*)(CKV + (size_t)m * 128 + lane * 8) = pack8(x); else *(u4v*)(KR + (size_t)m * 32 + (lane - 16) * 8) = pack8(x);
      }
      continue;
    }
    const int sq = m / T, t = m % T, b = g.b0 + sq;
    const bf16_t* z = Z + (size_t)m * IN_W;
    const bool hp = t > 0, hn = t < T - 1;
#pragma unroll
    for (int it = 0; it < 4; ++it) {
      const int ci = it * 64 + lane; const bool valid = ci < 216; const int cc = valid ? ci : 0;
      float zc[8], pv[8], nv[8], sf[8];
      unpack8(*(const u4v*)(z + cc * 8), zc);
      if (hp) unpack8(*(const u4v*)(z - IN_W + cc * 8), pv); else { for (int e = 0; e < 8; ++e) pv[e] = 0.f; }
      if (hn) unpack8(*(const u4v*)(z + IN_W + cc * 8), nv); else { for (int e = 0; e < 8; ++e) nv[e] = 0.f; }
      f4v m0 = *(const f4v*)(mu + cc * 8), m1 = *(const f4v*)(mu + cc * 8 + 4);
#pragma unroll
      for (int e = 0; e < 8; ++e) sf[e] = zc[e] + (0.5f * (pv[e] + nv[e]) - zc[e]) * (e < 4 ? m0[e] : m1[e - 4]);
      bf16_t* rec = SOP + (((size_t)sq * 8 + (lane >> 3)) * T + t) * 576 + (lane & 7) * 8;
      if (it == 0) *(u4v*)rec = pack8(sf);
      else if (it == 1) {
        *(u4v*)(SK + (size_t)m * 512 + lane * 8) = pack8(sf);
        f4v k0 = *(const f4v*)(p.k_k + (size_t)l * 512 + lane * 8), k1 = *(const f4v*)(p.k_k + (size_t)l * 512 + lane * 8 + 4);
        float kr[8]; float n2 = 0.f;
#pragma unroll
        for (int e = 0; e < 8; ++e) { kr[e] = sf[e] * (e < 4 ? k0[e] : k1[e - 4]); n2 += kr[e] * kr[e]; }
        n2 = sum_lpr<8>(n2); const float inv = 1.f / fmaxf(sqrtf(n2), 1e-12f);
#pragma unroll
        for (int e = 0; e < 8; ++e) kr[e] *= inv;
        *(u4v*)(rec + 64) = pack8(kr);
      }
      else if (it == 2) *(u4v*)(rec + 128) = pack8(sf);
      else if (valid) {
        if (lane < 16) { for (int e = 0; e < 8; ++e) sf[e] = tanhf_(sf[e]); }
        *(u4v*)(LORA + (size_t)m * 192 + lane * 8) = pack8(sf);
      }
    }
    {
      const int col = lane < 32 ? ZC_QD + lane * 8 : (lane < 48 ? ZC_KVD + (lane - 32) * 8 : ZC_KR + ((lane - 48) & 3) * 8);
      float x[8]; unpack8(*(const u4v*)(z + col), x);
      float ss = 0.f;
#pragma unroll
      for (int e = 0; e < 8; ++e) ss += x[e] * x[e];
      const float t32 = sum_lpr<32>(ss), t16 = sum_lpr<16>(ss);
      if (lane < 32) {
        const float rs = rsqrtf(t32 * (1.f / 256.f) + 1e-6f); const float* gq = p.q_norm + (size_t)l * 256 + lane * 8; float o[8];
#pragma unroll
        for (int e = 0; e < 8; ++e) o[e] = x[e] * rs * gq[e];
        *(u4v*)(QDN + (size_t)m * 256 + lane * 8) = pack8(o);
      } else if (lane < 48) {
        const float rs = rsqrtf(t16 * (1.f / 128.f) + 1e-6f); const float* gk = p.kv_norm + (size_t)l * 128 + (lane - 32) * 8; float o[8];
#pragma unroll
        for (int e = 0; e < 8; ++e) o[e] = x[e] * rs * gk[e];
        *(u4v*)(CKV + (size_t)m * 128 + (lane - 32) * 8) = pack8(o);
        if (!isden) { float* op = p.out + OUT_CKV + (((size_t)b * NL + l) * T_C + t) * 128 + (lane - 32) * 8; *(f4v*)op = f4v{o[0], o[1], o[2], o[3]}; *(f4v*)(op + 4) = f4v{o[4], o[5], o[6], o[7]}; }
      } else if (lane < 52) {
        float o[8];
        if (isden) {
#pragma unroll
          for (int pq = 0; pq < 4; ++pq) { int pi = (lane - 48) * 4 + pq; float cs = rope[((size_t)t * 16 + pi) * 2], sn = rope[((size_t)t * 16 + pi) * 2 + 1];
            o[2 * pq] = x[2 * pq] * cs - x[2 * pq + 1] * sn; o[2 * pq + 1] = x[2 * pq] * sn + x[2 * pq + 1] * cs; }
        } else {
#pragma unroll
          for (int e = 0; e < 8; ++e) o[e] = x[e];
          float* op = p.out + OUT_KR + (((size_t)b * NL + l) * T_C + t) * 32 + (lane - 48) * 8; *(f4v*)op = f4v{x[0], x[1], x[2], x[3]}; *(f4v*)(op + 4) = f4v{x[4], x[5], x[6], x[7]};
        }
        *(u4v*)(KR + (size_t)m * 32 + (lane - 48) * 8) = pack8(o);
      }
    }
    {
      float v[8]; unpack8(*(const u4v*)(z + ZC_VC + lane * 8), v);
      float s1 = 0.f;
#pragma unroll
      for (int e = 0; e < 8; ++e) { v[e] = geluf_(v[e]); s1 += v[e]; }
      s1 = wave_sum(s1); const float mean = s1 * (1.f / 512.f); float s2 = 0.f;
#pragma unroll
      for (int e = 0; e < 8; ++e) { float d = v[e] - mean; s2 += d * d; }
      s2 = wave_sum(s2); const float rs = rsqrtf(s2 * (1.f / 512.f) + 1e-5f);
      const float* gg = p.g_ln_g + (size_t)l * 512 + lane * 8; const float* gb = p.g_ln_b + (size_t)l * 512 + lane * 8;
#pragma unroll
      for (int e = 0; e < 8; ++e) v[e] = (v[e] - mean) * rs * gg[e] + gb[e];
      *(u4v*)(VCN + (size_t)m * 512 + lane * 8) = pack8(v);
    }
  }
}

__device__ __forceinline__ void stage_g2(const Params& p, const Grp& g, int l, int bid, int nb, char* smem) {
  char* ws = p.ws;
  const bf16_t* Z = (const bf16_t*)(ws + O_Z);
  const float* rope = (const float*)(ws + O_ROPE);
  const int mg = g.mg, mkv = g.mkv, T = g.T, isden = g.isden, nkeys = g.nkeys;
  const int TM_M = (mg + 127) / 128, TM_KV = (mkv + 127) / 128;
  const int NT_Q = TM_M * 6, NT_KV = TM_KV * 8, NT_LORA = TM_M * 8, NT_GM = (mg / 128) * 4, ntt = T / 128, NT_D1 = g.nseq * 8 * ntt;
  const int NT = NT_Q + NT_KV + NT_LORA + NT_GM + NT_D1;
  for (int t0 = bid; t0 < NT; t0 += nb) {
    int t = t0; f4v acc[2][4]; zero_acc<4>(acc);
    if (t < NT_Q) {
      int tn = t / TM_M, tm = t % TM_M;
      gemm_mainloop<4>((const bf16_t*)(ws + O_QDN), 256, tm * 128, mg, (const bf16_t*)(ws + O_WQT), 256, tn * 128, 768, 256, smem, acc);
      bf16_t* Q = (bf16_t*)(ws + O_Q);
      const float scale = 0.10206207261596575f;
      epi_foreach<4>(acc, tm * 128, tn * 128, [&](int row, int c0, f4v& v) {
        if (row >= mg) return;
        int cw = c0 % 96; float o0 = v[0], o1 = v[1], o2 = v[2], o3 = v[3];
        if (cw >= 64 && isden) { int tt = row % T_D; int pi = (cw - 64) >> 1; const float* rp = rope + ((size_t)tt * 16 + pi) * 2;
          float c_a = rp[0], s_a = rp[1], c_b = rp[2], s_b = rp[3];
          o0 = v[0] * c_a - v[1] * s_a; o1 = v[0] * s_a + v[1] * c_a; o2 = v[2] * c_b - v[3] * s_b; o3 = v[2] * s_b + v[3] * c_b; }
        *(u2v*)(Q + (size_t)row * 768 + c0) = pack4(o0 * scale, o1 * scale, o2 * scale, o3 * scale);
      });
      continue;
    }
    t -= NT_Q;
    if (t < NT_KV) {
      int tn = t / TM_KV, tm = t % TM_KV;
      gemm_mainloop<4>((const bf16_t*)(ws + O_CKV), 128, tm * 128, mkv, (const bf16_t*)(ws + O_WKVT), 128, tn * 128, 1024, 128, smem, acc);
      bf16_t* KN = (bf16_t*)(ws + O_KN); bf16_t* VT = (bf16_t*)(ws + O_VT);
      epi_foreach<4>(acc, tm * 128, tn * 128, [&](int row, int c0, f4v& v) {
        if (row >= mkv) return;
        int h = c0 >> 7, w = c0 & 127;
        if (w < 64) *(u2v*)(KN + (size_t)row * 512 + h * 64 + w) = pack4(v[0], v[1], v[2], v[3]);
        else { int sq, key;
          if (row < mg) { sq = row / T; key = row % T; } else { int r = row - mg; sq = r / PAST; key = T + r % PAST; }
#pragma unroll
          for (int e = 0; e < 4; ++e) VT[(((size_t)sq * 8 + h) * 64 + (w - 64 + e)) * nkeys + key] = f2bf(v[e]); }
      });
      continue;
    }
    t -= NT_KV;
    if (t < NT_LORA) {
      int dir = t / (TM_M * 4), r = t % (TM_M * 4), tn = r / TM_M, tm = r % TM_M;
      gemm_mainloop<4>((const bf16_t*)(ws + O_LORA) + dir * 64, 192, tm * 128, mg, (const bf16_t*)(ws + O_WUPT) + (size_t)dir * 512 * 64, 64, tn * 128, 512, 64, smem, acc);
      f4v aa[2][4]; zero_acc<4>(aa);
      gemm_mainloop<4>((const bf16_t*)(ws + O_LORA) + 128, 192, tm * 128, mg, (const bf16_t*)(ws + O_WUPT) + (size_t)(2 + dir) * 512 * 64, 64, tn * 128, 512, 64, smem, aa);
      const float* w0 = p.w0 + ((size_t)l * 2 + dir) * 512; const float* a0 = p.a0 + ((size_t)l * 2 + dir) * 512;
      const float* k_a = p.k_a + (size_t)l * 512; const float* r_k = p.r_k + (size_t)l * 512;
      const bf16_t* SK = (const bf16_t*)(ws + O_SK); bf16_t* SOP = (bf16_t*)(ws + O_SOP); float* BON = (float*)(ws + O_BON);
      const int lane = my_tid() & 63, wid = my_tid() >> 6, wm = wid >> 1, wn = wid & 1;
      const int h = tn * 2 + wn;
#pragma unroll
      for (int i = 0; i < 2; ++i) {
        int row = tm * 128 + wm * 32 + i * 16 + (lane & 15); const bool ok = row < mg; if (!ok) row = mg - 1;
        const int sq = row / T, tt = row % T;
        bf16_t* rec = SOP + (((size_t)sq * 8 + h) * T + tt) * 576;
        float bon = 0.f;
#pragma unroll
        for (int j = 0; j < 4; ++j) {
          const int chn = j * 16 + (lane >> 4) * 4, c = h * 64 + chn;
          u2v k2 = *(const u2v*)(SK + (size_t)row * 512 + c), kk2 = *(const u2v*)(rec + 64 + chn), r2 = *(const u2v*)(rec + chn);
          float kv[4] = {bflo(k2.x), bfhi(k2.x), bflo(k2.y), bfhi(k2.y)}, kkv[4] = {bflo(kk2.x), bfhi(kk2.x), bflo(kk2.y), bfhi(kk2.y)}, rv[4] = {bflo(r2.x), bfhi(r2.x), bflo(r2.y), bfhi(r2.y)};
          float dd[4], bb[4], kt[4];
#pragma unroll
          for (int e = 0; e < 4; ++e) {
            float pw = acc[i][j][e] + w0[c + e], pa = aa[i][j][e] + a0[c + e];
            dd[e] = 1.f - fexp_(-0.6065306597126334f * sigmoidf_(pw));
            float av = sigmoidf_(pa);
            bb[e] = kkv[e] * av; kt[e] = kv[e] * (1.f + (av - 1.f) * k_a[c + e]);
            bon += rv[e] * kt[e] * r_k[c + e];
          }
          if (ok) { *(u2v*)(rec + (3 + 3 * dir) * 64 + chn) = pack4(dd[0], dd[1], dd[2], dd[3]); *(u2v*)(rec + (4 + 3 * dir) * 64 + chn) = pack4(bb[0], bb[1], bb[2], bb[3]);
            *(u2v*)(rec + (5 + 3 * dir) * 64 + chn) = pack4(kt[0], kt[1], kt[2], kt[3]); }
        }
        bon += __shfl_xor(bon, 16); bon += __shfl_xor(bon, 32);
        if (ok && lane < 16) BON[((size_t)row * 8 + h) * 2 + dir] = bon;
      }
      continue;
    }
    t -= NT_LORA;
    if (t < NT_GM) {
      int ch = t >> 2, gg = t & 3;
      gemm_mainloop<4, true>((const bf16_t*)(ws + O_WS) + (size_t)gg * 128 * 128, 128, 0, 128, (const bf16_t*)(ws + O_VCNT) + (size_t)ch * 128 * 512, 512, gg * 128, 512, 128, smem, acc);
      bf16_t* O = (bf16_t*)(ws + O_OBR) + (size_t)2 * MG * 512;
      const float* bs = p.g_b_s + ((size_t)l * 4 + gg) * 128;
      epi_foreach<4>(acc, 0, 0, [&](int pp, int c0, f4v& v) {
        int m = ch * 128 + pp; int c = gg * 128 + c0; float bb = bs[pp];
        u2v uu = *(const u2v*)(Z + (size_t)m * IN_W + ZC_U + c), gc = *(const u2v*)(Z + (size_t)m * IN_W + ZC_GC + c);
        *(u2v*)(O + (size_t)m * 512 + c) = pack4(geluf_(bflo(uu.x)) * (v[0] + bb) * siluf_(bflo(gc.x)), geluf_(bfhi(uu.x)) * (v[1] + bb) * siluf_(bfhi(gc.x)),
                                                 geluf_(bflo(uu.y)) * (v[2] + bb) * siluf_(bflo(gc.y)), geluf_(bfhi(uu.y)) * (v[3] + bb) * siluf_(bfhi(gc.y)));
      });
      continue;
    }
    t -= NT_GM;
    {
      int per_seq = 8 * ntt; int sq = t / per_seq; int r = t % per_seq; int gg = r / (2 * ntt); int r2 = r % (2 * ntt); int tj = r2 / ntt, tt = r2 % ntt;
      long mbase = (long)sq * T;
      gemm_mainloop<4>((const bf16_t*)(ws + O_CS128), 128, tj * 128, 256, Z + (size_t)mbase * IN_W + ZC_F + gg * 128, IN_W, tt * 128, T, 128, smem, acc);
      bf16_t* YT = (bf16_t*)(ws + O_YT) + (size_t)mbase * 1024 + (size_t)gg * 128 * 2 * T;
      epi_foreach<4>(acc, tj * 128, tt * 128, [&](int j, int c0, f4v& v) {
        *(u2v*)(YT + (size_t)(j & 127) * 2 * T + (size_t)(j >> 7) * T + c0) = pack4(v[0], v[1], v[2], v[3]);
      });
    }
  }
}

__device__ __forceinline__ void attention_task(const Params& p, const Grp& g, int sq, int h, int qb32) {
  char* ws = p.ws;
  const int lane = my_tid() & 63, ql = lane & 31, hh = lane >> 5;
  const int T = g.T, nkeys = g.nkeys;
  const long mbase = (long)sq * T;
  const bf16_t* Q = (const bf16_t*)(ws + O_Q); const bf16_t* KN = (const bf16_t*)(ws + O_KN); const bf16_t* KRp = (const bf16_t*)(ws + O_KR);
  const bf16_t* VT = (const bf16_t*)(ws + O_VT) + ((size_t)sq * 8 + h) * 64 * nkeys;
  const long mq = mbase + qb32 * 32 + ql;
  s8v qf[6];
#pragma unroll
  for (int s = 0; s < 6; ++s) qf[s] = *(const s8v*)(Q + (size_t)mq * 768 + h * 96 + 16 * s + 8 * hh);
  f16v o0, o1;
#pragma unroll
  for (int i = 0; i < 16; ++i) { o0[i] = 0.f; o1[i] = 0.f; }
  float mrun = -1e30f, lrun = 0.f;
  for (int k0 = 0; k0 < nkeys; k0 += 32) {
    long krow = (k0 < T) ? mbase + k0 + ql : (long)g.mg + (long)sq * PAST + (k0 - T) + ql;
    f16v s;
#pragma unroll
    for (int i = 0; i < 16; ++i) s[i] = 0.f;
#pragma unroll
    for (int st = 0; st < 6; ++st) {
      s8v kf = (st < 4) ? *(const s8v*)(KN + (size_t)krow * 512 + h * 64 + 16 * st + 8 * hh) : *(const s8v*)(KRp + (size_t)krow * 32 + 16 * (st - 4) + 8 * hh);
      s = __builtin_amdgcn_mfma_f32_32x32x16_bf16(kf, qf[st], s, 0, 0, 0);
    }
    float mx = s[0];
#pragma unroll
    for (int i = 1; i < 16; ++i) mx = fmaxf(mx, s[i]);
    mx = fmaxf(mx, __shfl_xor(mx, 32));
    float mnew = fmaxf(mrun, mx); float alpha = fexp_(mrun - mnew); mrun = mnew;
    float ps = 0.f; bf16_t pb[16];
#pragma unroll
    for (int i = 0; i < 16; ++i) { float e = fexp_(s[i] - mnew); ps += e; pb[i] = f2bf(e); }
    lrun = lrun * alpha + ps;
#pragma unroll
    for (int i = 0; i < 16; ++i) { o0[i] *= alpha; o1[i] *= alpha; }
#pragma unroll
    for (int st = 0; st < 2; ++st) {
      s8v pf;
#pragma unroll
      for (int j = 0; j < 8; ++j) pf[j] = (short)pb[8 * st + j];
#pragma unroll
      for (int db = 0; db < 2; ++db) {
        const bf16_t* vp = VT + (size_t)(db * 32 + ql) * nkeys + k0 + 16 * st + 4 * hh;
        u2v a = *(const u2v*)vp, b2 = *(const u2v*)(vp + 8);
        s8v vf = __builtin_bit_cast(s8v, u4v{a.x, a.y, b2.x, b2.y});
        if (db == 0) o0 = __builtin_amdgcn_mfma_f32_32x32x16_bf16(vf, pf, o0, 0, 0, 0);
        else o1 = __builtin_amdgcn_mfma_f32_32x32x16_bf16(vf, pf, o1, 0, 0, 0);
      }
    }
  }
  float ltot = lrun + __shfl_xor(lrun, 32); float inv = 1.f / ltot;
  const bf16_t* Z = (const bf16_t*)(ws + O_Z);
  bf16_t* O = (bf16_t*)(ws + O_OBR) + (size_t)1 * MG * 512;
#pragma unroll
  for (int db = 0; db < 2; ++db)
#pragma unroll
    for (int i = 0; i < 16; ++i) {
      int dv = db * 32 + (i & 3) + 8 * (i >> 2) + 4 * hh; float ov = (db == 0 ? o0[i] : o1[i]) * inv;
      float gt = siluf_(bf2f(Z[(size_t)mq * IN_W + ZC_GB + h * 64 + dv]));
      O[(size_t)mq * 512 + h * 64 + dv] = f2bf(ov * gt);
    }
}

__device__ __forceinline__ void stage_dft2(const Params& p, const Grp& g, int bid, int nb, char* smem) {
  char* ws = p.ws;
  const bf16_t* Z = (const bf16_t*)(ws + O_Z);
  const int T = g.T, ntt = T / 128;
  const int NT_D2 = g.nseq * 4 * ntt;
  for (int t = bid; t < NT_D2; t += nb) {
    int sq = t / (4 * ntt), r = t % (4 * ntt), gg = r / ntt, tt = r % ntt;
    long mbase = (long)sq * T;
    f4v acc[2][4]; zero_acc<4>(acc);
    gemm_mainloop<4>((const bf16_t*)(ws + (g.isden ? O_A2D : O_A2C)), 2 * T, tt * 128, T, (const bf16_t*)(ws + O_YT) + (size_t)mbase * 1024 + (size_t)gg * 128 * 2 * T, 2 * T, 0, 128, 2 * T, smem, acc);
    bf16_t* O = (bf16_t*)(ws + O_OBR) + (size_t)3 * MG * 512;
    const float sc = rsqrtf(128.f * (float)T);
    epi_foreach<4>(acc, tt * 128, 0, [&](int row, int c0, f4v& v) {
      long m = mbase + row; int c = gg * 128 + c0; u2v gd = *(const u2v*)(Z + (size_t)m * IN_W + ZC_GD + c);
      *(u2v*)(O + (size_t)m * 512 + c) = pack4(v[0] * sc * siluf_(bflo(gd.x)), v[1] * sc * siluf_(bfhi(gd.x)), v[2] * sc * siluf_(bflo(gd.y)), v[3] * sc * siluf_(bfhi(gd.y)));
    });
  }
}

constexpr int SCAN_LDS_PER_WAVE = 8 * 1536;
typedef float f2v __attribute__((ext_vector_type(2)));
template <int CH> __device__ __forceinline__ void lds_ld(const char* q, f2v (&o)[CH / 2]) {
  if constexpr (CH == 2) { o[0] = *(const f2v*)q; }
  else if constexpr (CH == 4) { f4v t = *(const f4v*)q; o[0] = f2v{t[0], t[1]}; o[1] = f2v{t[2], t[3]}; }
  else { f4v t = *(const f4v*)q, u = *(const f4v*)(q + 16); o[0] = f2v{t[0], t[1]}; o[1] = f2v{t[2], t[3]}; o[2] = f2v{u[0], u[1]}; o[3] = f2v{u[2], u[3]}; }
}
template <int LPR>
__device__ __forceinline__ void scan_task(const Params& p, const Grp& g, int l, int task, char* wl) {
  constexpr int CH = 64 / LPR, RW = 64 / LPR, NP = CH / 2;
  char* ws = p.ws;
  const int lane = my_tid() & 63;
  const int T = g.T;
  const int ch = task / LPR, rg = task % LPR;
  const int dir = ch & 1, h = (ch >> 1) & 7, sq = ch >> 4;
  const long mbase = (long)sq * T;
  const int row = rg * RW + lane / LPR, kl = lane % LPR;
  const char* rec0 = (const char*)((const bf16_t*)(ws + O_SOP) + ((size_t)sq * 8 + h) * T * 576);
  float* YS = (float*)(ws + O_YS) + (size_t)dir * MG * 512;
  f2v sv[NP];
#pragma unroll
  for (int i = 0; i < NP; ++i) sv[i] = f2v{0.f, 0.f};
  if (g.isden) { const float* st = (dir ? p.st_b : p.st_f) + ((((size_t)sq * NL + l) * 8 + h) * 64 + row) * 64 + kl * CH;
#pragma unroll
    for (int i = 0; i < NP; ++i) sv[i] = f2v{st[2 * i], st[2 * i + 1]}; }
  int soff[6], sstep[6], doff[6]; bool isd[6];
#pragma unroll
  for (int i = 0; i < 6; ++i) { int c = lane + 64 * i; int st = c / 48, w = c % 48; sstep[i] = st; soff[i] = (w < 24) ? w * 16 : ((dir ? 768 : 384) + (w - 24) * 16);
    doff[i] = st * 1536 + (w >> 3) * 256 + (w & 7) * 32; isd[i] = (w >> 3) == 3; }
  u4v pf[6];
  const int nbt = T >> 3;
#pragma unroll
  for (int i = 0; i < 6; ++i) { int tt = dir ? T - 1 - sstep[i] : sstep[i]; pf[i] = *(const u4v*)(rec0 + (size_t)tt * 1152 + soff[i]); }
  for (int bt = 0; bt < nbt; ++bt) {
    WAVE_SYNC();
#pragma unroll
    for (int i = 0; i < 6; ++i) {
      f4v lo = {bflo(pf[i].x), bfhi(pf[i].x), bflo(pf[i].y), bfhi(pf[i].y)}, hi = {bflo(pf[i].z), bfhi(pf[i].z), bflo(pf[i].w), bfhi(pf[i].w)};
      if (isd[i]) { lo = 1.f - lo; hi = 1.f - hi; }
      *(f4v*)(wl + doff[i]) = lo; *(f4v*)(wl + doff[i] + 16) = hi;
    }
    WAVE_SYNC();
    if (bt + 1 < nbt) {
#pragma unroll
      for (int i = 0; i < 6; ++i) { int st = (bt + 1) * 8 + sstep[i]; int tt = dir ? T - 1 - st : st; pf[i] = *(const u4v*)(rec0 + (size_t)tt * 1152 + soff[i]); }
    }
    float ykeep = 0.f, yprev = 0.f;
    f2v r_[NP], kk_[NP], w_[NP], b_[NP], kt_[NP]; float v;
    lds_ld<CH>(wl + kl * CH * 4, r_); lds_ld<CH>(wl + 256 + kl * CH * 4, kk_); lds_ld<CH>(wl + 768 + kl * CH * 4, w_); lds_ld<CH>(wl + 1024 + kl * CH * 4, b_); lds_ld<CH>(wl + 1280 + kl * CH * 4, kt_);
    v = *(const float*)(wl + 512 + row * 4);
#pragma unroll
    for (int s = 0; s < 8; ++s) {
      f2v nr[NP], nkk[NP], nw[NP], nb_[NP], nkt[NP]; float nv = v;
#pragma unroll
      for (int i = 0; i < NP; ++i) { nr[i] = r_[i]; nkk[i] = kk_[i]; nw[i] = w_[i]; nb_[i] = b_[i]; nkt[i] = kt_[i]; }
      if (s < 7) { const char* q = wl + (s + 1) * 1536;
        lds_ld<CH>(q + kl * CH * 4, nr); lds_ld<CH>(q + 256 + kl * CH * 4, nkk); lds_ld<CH>(q + 768 + kl * CH * 4, nw); lds_ld<CH>(q + 1024 + kl * CH * 4, nb_); lds_ld<CH>(q + 1280 + kl * CH * 4, nkt);
        nv = *(const float*)(q + 512 + row * 4); }
#ifndef EMU
      __builtin_amdgcn_sched_barrier(0);
#endif
      f2v pd = sv[0] * kk_[0];
#pragma unroll
      for (int i = 1; i < NP; ++i) pd += sv[i] * kk_[i];
      const f2v vv = {v, v};
      f2v tmp[NP];
#pragma unroll
      for (int i = 0; i < NP; ++i) tmp[i] = sv[i] * w_[i] + vv * kt_[i];
      float sa = pd.x + pd.y;
      if (s == 0) sa = sum_lpr<LPR>(sa);
      else { sum_lpr2<LPR>(sa, yprev); ykeep = (kl == s - 1) ? yprev : ykeep; }
      const f2v sav = {-sa, -sa};
#pragma unroll
      for (int i = 0; i < NP; ++i) sv[i] = sav * b_[i] + tmp[i];
      f2v py = sv[0] * r_[0];
#pragma unroll
      for (int i = 1; i < NP; ++i) py += sv[i] * r_[i];
      yprev = py.x + py.y;
#pragma unroll
      for (int i = 0; i < NP; ++i) { r_[i] = nr[i]; kk_[i] = nkk[i]; w_[i] = nw[i]; b_[i] = nb_[i]; kt_[i] = nkt[i]; }
      v = nv;
    }
    yprev = sum_lpr<LPR>(yprev); ykeep = (kl == 7) ? yprev : ykeep;
    if (kl < 8) { int st = bt * 8 + kl; int tt = dir ? T - 1 - st : st; YS[(size_t)(mbase + tt) * 512 + h * 64 + row] = ykeep; }
  }
  if (!g.isden) { float* so = p.out + (dir ? OUT_SB : OUT_SF) + ((((size_t)(g.b0 + sq) * NL + l) * 8 + h) * 64 + row) * 64 + kl * CH;
#pragma unroll
    for (int i = 0; i < NP; ++i) *(f2v*)(so + 2 * i) = sv[i]; }
}

__device__ __forceinline__ void stage_mix(const Params& p, const Grp& g, int l, int bid, int nb, char* smem) {
  const int wid = my_tid() >> 6;
  const int NS = g.nseq * 16 * (g.isden ? 32 : 8), q32 = g.T / 32, NA = g.nseq * 8 * q32;
  char* wl = smem + wid * SCAN_LDS_PER_WAVE;
  for (int task = wid * nb + bid; task < NS + NA; task += nb * NWAVE) {
    if (task < NS) { if (g.isden) scan_task<32>(p, g, l, task, wl); else scan_task<8>(p, g, l, task, wl); }
    else { int t = task - NS; int sq = t / (8 * q32), r = t % (8 * q32); attention_task(p, g, sq, r / q32, r % q32); }
  }
}

__device__ __forceinline__ void stage_e3(const Params& p, const Grp& g, int l, int bid, int nb) {
  const int lane = my_tid() & 63, wid = my_tid() >> 6;
  char* ws = p.ws;
  const float* YS = (const float*)(ws + O_YS); const bf16_t* SOP = (const bf16_t*)(ws + O_SOP); const float* BON = (const float*)(ws + O_BON); const int T = g.T;
  const bf16_t* Z = (const bf16_t*)(ws + O_Z); bf16_t* O = (bf16_t*)(ws + O_OBR);
  for (int m = bid * NWAVE + wid; m < g.mg; m += nb * NWAVE) {
#pragma unroll 2
    for (int i = 0; i < 8; ++i) {
      int c = lane + 64 * i;
      float o = YS[(size_t)m * 512 + c] + YS[((size_t)MG + m) * 512 + c];
      float mean = wave_sum(o) * (1.f / 64.f); float d = o - mean; float var = wave_sum(d * d) * (1.f / 64.f);
      float y = d * rsqrtf(var + 64e-5f) * p.ln_g[(size_t)l * 512 + c] + p.ln_b[(size_t)l * 512 + c] + (BON[((size_t)m * 8 + i) * 2] + BON[((size_t)m * 8 + i) * 2 + 1]) * bf2f(SOP[(((size_t)(m / T) * 8 + i) * T + (m % T)) * 576 + 128 + lane]);
      O[(size_t)m * 512 + c] = f2bf(y * siluf_(bf2f(Z[(size_t)m * IN_W + ZC_GA + c])));
    }
  }
}

__device__ __forceinline__ void stage_gates(const Params& p, const Grp& g, int l, int bid, int nb, char* smem) {
  const bf16_t* H = (const bf16_t*)(p.ws + O_H);
  const bf16_t* W = (const bf16_t*)(p.ws + O_WMT);
  bf16_t* GT = (bf16_t*)(p.ws + O_GATES);
  const float* bm = p.b_merge + (size_t)l * 4096;
#ifndef EMU
  if ((g.mg & 255) == 0) {
    pg8::Gemm gm; gm.A = H; gm.Bt = W; gm.M = g.mg; gm.N = 4096; gm.K = 1024;
    pg8::StaticOrder S; S.init(gm.M, gm.N, nb, bid);
    pg8::EpiSigmoid E; E.O = GT; E.ldc = 4096; E.bias = bm;
    pg8::gemm_phase<pg8::EpiSigmoid, pg8::StaticOrder>((PG8_LAS unsigned char*)smem, gm, S, E);
    return;
  }
#endif
  const int TM = (g.mg + 127) / 128, mg = g.mg;
  for (int t = bid; t < TM * 32; t += nb) {
    int tn = t / TM, tm = t % TM; f4v acc[2][4]; zero_acc<4>(acc);
    gemm_mainloop<4>(H, 1024, tm * 128, mg, W, 1024, tn * 128, 4096, 1024, smem, acc);
    epi_foreach<4>(acc, tm * 128, tn * 128, [&](int row, int c0, f4v& v) {
      if (row < mg) *(u2v*)(GT + (size_t)row * 4096 + c0) = pack4(sigmoidf_(v[0] + bm[c0]), sigmoidf_(v[1] + bm[c0 + 1]), sigmoidf_(v[2] + bm[c0 + 2]), sigmoidf_(v[3] + bm[c0 + 3]));
    });
  }
}

__device__ __forceinline__ void stage_g8(const Params& p, const Grp& g, int l, int bid, int nb, char* smem) {
  char* ws = p.ws;
  bf16_t* MGD = (bf16_t*)(ws + O_MERGED);
  const bf16_t* GT = (const bf16_t*)(ws + O_GATES);
  const int TM = (g.mg + 127) / 128, mg = g.mg;
  for (int t = bid; t < TM * 8; t += nb) {
    int tn = t / TM, tm = t % TM;
    f4v macc[2][4]; zero_acc<4>(macc);
    for (int n = 0; n < 4; ++n) {
      f4v ap[2][4]; zero_acc<4>(ap);
      gemm_mainloop<4>((const bf16_t*)(ws + O_OBR) + (size_t)n * MG * 512, 512, tm * 128, mg, (const bf16_t*)(ws + O_WBRT) + (size_t)n * 1024 * 512, 512, tn * 128, 1024, 512, smem, ap);
      const int lane = my_tid() & 63, wid = my_tid() >> 6, wm = wid >> 1, wn = wid & 1;
#pragma unroll
      for (int i = 0; i < 2; ++i)
#pragma unroll
        for (int j = 0; j < 4; ++j) {
          int row = tm * 128 + wm * 32 + i * 16 + (lane & 15); row = row < mg ? row : mg - 1;
          int c0 = tn * 128 + wn * 64 + j * 16 + (lane >> 4) * 4;
          u2v gt = *(const u2v*)(GT + (size_t)row * 4096 + n * 1024 + c0);
          macc[i][j][0] += bflo(gt.x) * ap[i][j][0]; macc[i][j][1] += bfhi(gt.x) * ap[i][j][1]; macc[i][j][2] += bflo(gt.y) * ap[i][j][2]; macc[i][j][3] += bfhi(gt.y) * ap[i][j][3];
        }
    }
    epi_foreach<4>(macc, tm * 128, tn * 128, [&](int row, int c0, f4v& v) {
      if (row < mg) *(u2v*)(MGD + (size_t)row * 1024 + c0) = pack4(v[0], v[1], v[2], v[3]);
    });
  }
  (void)l;
}

__device__ __forceinline__ void stage_g9(const Params& p, const Grp& g, int l, int bid, int nb, char* smem) {
  char* ws = p.ws;
  float* X = p.out + (size_t)g.m0 * 1024;
  const float* modp = (const float*)(ws + O_MOD) + (size_t)l * 3 * 3072 + 2048;
  const int TM = (g.mg + 127) / 128, mg = g.mg;
  for (int t = bid; t < TM * 8; t += nb) {
    int tn = t / TM, tm = t % TM;
    f4v acc[2][4]; zero_acc<4>(acc);
    gemm_mainloop<4>((const bf16_t*)(ws + O_MERGED), 1024, tm * 128, mg, (const bf16_t*)(ws + O_WOUTT), 1024, tn * 128, 1024, 1024, smem, acc);
    epi_foreach<4>(acc, tm * 128, tn * 128, [&](int row, int c0, f4v& v) {
      if (row < mg) { const float* gt = modp + (size_t)mod_index(g, row) * 3072 + c0; f4v* xp = (f4v*)(X + (size_t)row * 1024 + c0); f4v x = *xp;
        x[0] += gt[0] * v[0]; x[1] += gt[1] * v[1]; x[2] += gt[2] * v[2]; x[3] += gt[3] * v[3]; *xp = x; }
    });
  }
}

__device__ __forceinline__ void stage_final(const Params& p, int bid, int nb) {
  const int lane = my_tid() & 63, wid = my_tid() >> 6;
  for (int m = bid * NWAVE + wid; m < M; m += nb * NWAVE) {
    float* xr = p.out + (size_t)m * 1024; float4 q[4]; float ss = 0.f;
#pragma unroll
    for (int i = 0; i < 4; ++i) { q[i] = *(const float4*)(xr + i * 256 + lane * 4); ss += q[i].x * q[i].x + q[i].y * q[i].y + q[i].z * q[i].z + q[i].w * q[i].w; }
    ss = wave_sum(ss); float rs = rsqrtf(ss * (1.f / 1024.f) + 1e-6f);
#pragma unroll
    for (int i = 0; i < 4; ++i) { int c = i * 256 + lane * 4; float4 gm = *(const float4*)(p.final_g + c);
      *(float4*)(xr + c) = make_float4(q[i].x * rs * gm.x, q[i].y * rs * gm.y, q[i].z * rs * gm.z, q[i].w * rs * gm.w); }
  }
}

#ifdef EMU
#define DECL_SMEM(name) char* name = emu::smem()
#else
#define DECL_SMEM(name) __shared__ __attribute__((aligned(16))) char name[SMEM_BYTES]
#endif

#ifdef EMU
struct GridBar { __device__ void sync() const { emu::grid_sync(); } };
#else
#define XB_TMO      128
#define XB_XCNT(j)  (256  + 64 * (j))
#define XB_XSUB(j)  (1280 + 64 * (j))
#define XB_XGEN(j)  (2304 + 64 * (j))
#define XB_TOP      3328
#define XB_TOPGEN   3392
#define XB_SPIN_CAP (1u << 20)
#define LAS __attribute__((address_space(3)))
__device__ __forceinline__ unsigned xb_ld(unsigned* p)              { return __hip_atomic_load(p, __ATOMIC_RELAXED, __HIP_MEMORY_SCOPE_AGENT); }
__device__ __forceinline__ unsigned xb_add(unsigned* p, unsigned v) { return __hip_atomic_fetch_add(p, v, __ATOMIC_RELAXED, __HIP_MEMORY_SCOPE_AGENT); }
__device__ __forceinline__ unsigned xb_xcc_id() { return (unsigned)__builtin_amdgcn_s_getreg((3 << 11) | 20) & 0xFu; }
#define XB_SPIN(cond, bar) do { unsigned _sp = 0; while (cond) { __builtin_amdgcn_s_sleep(1); \
    if ((++_sp & 255u) == 0u) { if (xb_ld(&(bar)[XB_TMO])) break; if (_sp > XB_SPIN_CAP) { atomicAdd(&(bar)[XB_TMO], 1u); break; } } } } while (0)
struct GridBar {
  unsigned* bar; unsigned x; volatile LAS unsigned* st;
  __device__ __forceinline__ void post(unsigned* b, volatile LAS unsigned* s_) {
    bar = b; x = xb_xcc_id(); st = s_;
    if (threadIdx.x == 0) (void)xb_add(&bar[XB_XCNT(x)], 1u);
  }
  __device__ __forceinline__ void complete(unsigned& nloc, unsigned& nx) const {
    const unsigned G = gridDim.x;
    unsigned sum, cnt, mine, sp = 0u;
    for (;;) {
      sum = 0u; cnt = 0u; mine = 0u;
#pragma unroll
      for (unsigned j = 0; j < 16; ++j) { const unsigned c = xb_ld(&bar[XB_XCNT(j)]); sum += c; cnt += (c > 0u) ? 1u : 0u; mine = (j == x) ? c : mine; }
      if (sum == G) break;
      __builtin_amdgcn_s_sleep(1);
      if ((++sp & 255u) == 0u) { if (xb_ld(&bar[XB_TMO])) break; if (sp > XB_SPIN_CAP) { atomicAdd(&bar[XB_TMO], 1u); break; } }
    }
    nloc = mine > 0u ? mine : 1u; nx = cnt > 0u ? cnt : 1u;
  }
  __device__ __forceinline__ void sync() const {
    asm volatile("s_waitcnt vmcnt(0)" ::: "memory");
    __syncthreads();
    if (threadIdx.x == 0) {
      __builtin_amdgcn_s_waitcnt(0);
      unsigned nloc = st[0], nx = st[1];
      if (nloc == 0u) { complete(nloc, nx); st[0] = nloc; st[1] = nx; }
      const unsigned old = xb_add(&bar[XB_XSUB(x)], 1u);
      const unsigned gen = old / nloc;
      if (old + 1u == (gen + 1u) * nloc) {
        __builtin_amdgcn_fence(__ATOMIC_RELEASE, "agent");
        asm volatile("s_waitcnt vmcnt(0)" ::: "memory");
        const unsigned og = xb_add(&bar[XB_TOP], 1u);
        const unsigned tg = og / nx;
        if (og + 1u == (tg + 1u) * nx) xb_add(&bar[XB_TOPGEN], 1u);
        else XB_SPIN(xb_ld(&bar[XB_TOPGEN]) == tg, bar);
        __builtin_amdgcn_fence(__ATOMIC_ACQUIRE, "agent");
        xb_add(&bar[XB_XGEN(x)], 1u);
        asm volatile("s_waitcnt vmcnt(0)" ::: "memory");
      } else {
        XB_SPIN(xb_ld(&bar[XB_XGEN(x)]) == gen, bar);
        __builtin_amdgcn_fence(__ATOMIC_ACQUIRE, "agent");
        asm volatile("s_waitcnt vmcnt(0)" ::: "memory");
      }
    }
    __syncthreads();
  }
};
#endif

#ifndef EMU
namespace cg = cooperative_groups;
#else
namespace cg = cooperative_groups;
#endif

__global__ void __launch_bounds__(NTHR) mega_kernel(Params p) {
  DECL_SMEM(smem);
  cg::grid_group grid = cg::this_grid();
  const int bid0 = blockIdx.x, nb0 = gridDim.x;
  GridBar gb;
#ifndef EMU
  if (threadIdx.x == 0) { volatile LAS unsigned* w = (volatile LAS unsigned*)(smem + SMEM_STAGE); w[0] = 0u; w[1] = 0u; w[2] = 0u; w[3] = 0u; }
  __syncthreads();
  gb.post((unsigned*)(p.ws + O_BAR), (volatile LAS unsigned*)(smem + SMEM_STAGE));
#endif
#ifndef PROBE_DUP
#define PROBE_DUP 0
#endif
#define STG(call) do { Params q = p; q.ws = opaque(q.ws); q.out = opaque(q.out); const int bid = opaque_i(bid0); const int nb = opaque_i(nb0); call; } while (0)
#define STP(bit, call) do { STG(call); if (PROBE_DUP & (bit)) { STG(call); } } while (0)
  for (int l = 0; l < NL; ++l) {
    STP(1, stage_prep(q, l, bid, nb, smem));
    if (l == 0) grid.sync();
    { Grp g0 = get_grp(0); STP(2, stage_h(q, g0, l, bid, nb)); }
    gb.sync();
    for (int gi = 0; gi < NGRP; ++gi) {
      Grp g = get_grp(gi);
      STP(4, stage_g1(q, g, bid, nb, smem)); gb.sync();
      STP(8, stage_e1(q, g, l, bid, nb)); gb.sync();
      STP(16, stage_g2(q, g, l, bid, nb, smem)); gb.sync();
      STP(64, stage_mix(q, g, l, bid, nb, smem)); gb.sync();
      STP(128, stage_dft2(q, g, bid, nb, smem));
      STP(256, stage_e3(q, g, l, bid, nb));
      STP(512, stage_gates(q, g, l, bid, nb, smem)); gb.sync();
      STP(1024, stage_g8(q, g, l, bid, nb, smem)); gb.sync();
      STG(stage_g9(q, g, l, bid, nb, smem));
      if (gi + 1 < NGRP) { Grp gn = get_grp(gi + 1); STP(2, stage_h(q, gn, l, bid, nb)); }
      gb.sync();
    }
  }
  STG(stage_final(q, bid, nb));
#undef STP
#undef STG
}

extern "C" void kernel_launch(void* const* d_in, const int* in_sizes, int n_in, void* d_out, int out_size, void* d_ws, size_t ws_size,
                              hipStream_t stream) {
  Params p{};
  const float** pp = (const float**)&p;
  for (int i = 0; i < 35; ++i) pp[i] = (const float*)d_in[i];
  p.out = (float*)d_out; p.ws = (char*)d_ws;
#ifdef EMU
  emu::set_coop(true);
  emu_launch(dim3(8), dim3(NTHR), [=]() { mega_kernel(p); });
  emu::set_coop(false);
#else
  static int grid_blocks = 0;
  if (!grid_blocks) {
    int dev = 0, cus = 0, per_cu = 0;
    (void)hipGetDevice(&dev);
    (void)hipDeviceGetAttribute(&cus, hipDeviceAttributeMultiprocessorCount, dev);
    (void)hipOccupancyMaxActiveBlocksPerMultiprocessor(&per_cu, mega_kernel, NTHR, 0);
    if (per_cu > 1) per_cu = 1;
    if (per_cu < 1) per_cu = 1;
    grid_blocks = cus * per_cu;
  }
  (void)hipMemsetAsync((char*)d_ws + O_BAR, 0, BAR_BYTES, stream);
  void* args[] = {&p};
  (void)hipLaunchCooperativeKernel((void*)mega_kernel, dim3(grid_blocks), dim3(NTHR), args, 0, stream);
#endif
  (void)in_sizes; (void)n_in; (void)out_size; (void)ws_size;
}
```

```cpp
#ifdef EMU
#include "hip_emu.h"
#else
#include <hip/hip_runtime.h>
#include <hip/hip_cooperative_groups.h>
#endif
#include <stdint.h>

#ifndef CFG_BATCH
#define CFG_BATCH 32
#define CFG_SEQ 256
#define CFG_DEC_BATCH 2
#define CFG_DEC_SEQ 2048
#define CFG_PAST 512
#define CFG_NGRP_C 2
#endif
constexpr int D = 1024, NL = 2;
constexpr int NB_C = CFG_BATCH, T_C = CFG_SEQ, NB_D = CFG_DEC_BATCH, T_D = CFG_DEC_SEQ, PAST = CFG_PAST;
constexpr int M_C = NB_C * T_C, M_D = NB_D * T_D, M = M_C + M_D;
constexpr int NGRP_C = CFG_NGRP_C, NGRP = 1 + NGRP_C;
constexpr int MGC = M_C / NGRP_C, SEQ_PER_CG = NB_C / NGRP_C;
constexpr int MG = MGC > M_D ? MGC : M_D;
constexpr int MKV = MG + NB_D * PAST;
constexpr int KEYS_D = T_D + PAST;
constexpr int IN_W = 5728;
constexpr int ZC_R = 0, ZC_K = 512, ZC_V = 1024, ZC_WDF = 1536, ZC_GA = 1728, ZC_QD = 2240, ZC_KVD = 2496, ZC_KR = 2624,
              ZC_GB = 2656, ZC_U = 3168, ZC_VC = 3680, ZC_GC = 4192, ZC_F = 4704, ZC_GD = 5216;
constexpr int SHIFT_W = 1728;
static_assert(M_C % NGRP_C == 0 && NB_C % NGRP_C == 0, "ctx groups");
static_assert(T_C % 128 == 0 && T_D % 128 == 0 && PAST % 32 == 0, "seq multiples");

typedef unsigned short bf16_t;
typedef short s8v __attribute__((ext_vector_type(8)));
typedef float f4v __attribute__((ext_vector_type(4)));
typedef float f16v __attribute__((ext_vector_type(16)));
typedef unsigned u4v __attribute__((ext_vector_type(4)));
typedef unsigned u2v __attribute__((ext_vector_type(2)));

struct Params {
  const float *x_prompt, *x_sample, *st_f, *st_b, *c_ckv, *c_kr, *c, *c_ctx, *norm_g, *w_ada, *b_ada, *w_in, *shift_mu, *w0, *w_up,
      *a0, *a_up, *k_k, *k_a, *r_k, *ln_g, *ln_b, *q_norm, *w_q_up, *kv_norm, *w_kv_up, *g_ln_g, *g_ln_b, *g_w_s, *g_b_s, *w_branch,
      *w_merge, *b_merge, *w_out, *final_g;
  float* out;
  char* ws;
};

struct Grp { int isden, m0, mg, nseq, T, b0, nkeys, mkv; };
__host__ __device__ __forceinline__ Grp get_grp(int gi) {
  Grp g;
  if (gi == 0) { g.isden = 1; g.m0 = M_C; g.mg = M_D; g.nseq = NB_D; g.T = T_D; g.b0 = 0; g.nkeys = KEYS_D; g.mkv = M_D + NB_D * PAST; }
  else { g.isden = 0; g.m0 = (gi - 1) * MGC; g.mg = MGC; g.nseq = SEQ_PER_CG; g.T = T_C; g.b0 = (gi - 1) * SEQ_PER_CG; g.nkeys = T_C; g.mkv = MGC; }
  return g;
}

constexpr size_t al256(size_t x) { return (x + 255) & ~(size_t)255; }
constexpr size_t O_WINT = 0;
constexpr int IN_WP = ((IN_W + 255) / 256) * 256;
constexpr size_t O_WMT = O_WINT + al256((size_t)IN_WP * 1024 * 2);
constexpr size_t O_WBRT = O_WMT + al256((size_t)4096 * 1024 * 2);
constexpr size_t O_WOUTT = O_WBRT + al256((size_t)4 * 1024 * 512 * 2);
constexpr size_t O_WQT = O_WOUTT + al256((size_t)1024 * 1024 * 2);
constexpr size_t O_WKVT = O_WQT + al256((size_t)768 * 256 * 2);
constexpr size_t O_WUPT = O_WKVT + al256((size_t)1024 * 128 * 2);
constexpr size_t O_WS = O_WUPT + al256((size_t)4 * 512 * 64 * 2);
constexpr size_t O_CS128 = O_WS + al256((size_t)4 * 128 * 128 * 2);
constexpr size_t O_A2C = O_CS128 + al256((size_t)256 * 128 * 2);
constexpr size_t O_A2D = O_A2C + al256((size_t)T_C * 2 * T_C * 2);
constexpr size_t O_ROPE = O_A2D + al256((size_t)T_D * 2 * T_D * 2);
constexpr size_t O_MOD = O_ROPE + al256((size_t)T_D * 32 * 4);
constexpr size_t O_H = O_MOD + al256((size_t)NL * 3 * 3072 * 4);
constexpr size_t O_Z = O_H + al256((size_t)MG * 1024 * 2);
constexpr size_t O_SK = O_Z + al256((size_t)MG * IN_W * 2);
constexpr size_t O_SOP = O_SK + al256((size_t)MG * 512 * 2);
constexpr size_t O_YS = O_SOP + al256((size_t)MG * 8 * 576 * 2);
constexpr size_t O_BON = O_YS + al256((size_t)2 * MG * 512 * 4);
constexpr size_t O_LORA = O_BON + al256((size_t)MG * 16 * 4);
constexpr int CM_GT = 0, CM_BKT = 5120, CM_WL = 9216, CM_REC = 9472;
constexpr size_t CM_BYTES = (size_t)MG * CM_REC;
constexpr size_t O_CM = O_LORA + al256((size_t)MG * 192 * 2);
constexpr size_t O_PRE = O_CM + al256(CM_BYTES - (size_t)MG * 2048 * 2);
constexpr size_t O_QDN = O_PRE + al256((size_t)MG * 2048 * 2);
constexpr size_t O_CKV = O_QDN + al256((size_t)MG * 256 * 2);
constexpr size_t O_KR = O_CKV + al256((size_t)MKV * 128 * 2);
constexpr size_t O_Q = O_KR + al256((size_t)MKV * 32 * 2);
constexpr size_t O_KN = O_Q + al256((size_t)MG * 768 * 2);
constexpr size_t O_VT = O_KN + al256((size_t)MKV * 512 * 2);
constexpr size_t O_VCNT = O_VT + al256((size_t)MKV * 512 * 2);
constexpr size_t O_YT = O_VCNT + al256((size_t)MG * 512 * 2);
constexpr size_t O_OBR = O_YT + al256((size_t)MG * 1024 * 2);
constexpr size_t O_MERGED = O_OBR + al256((size_t)4 * MG * 512 * 2);
constexpr size_t O_END = O_MERGED + al256((size_t)MG * 1024 * 2);
constexpr size_t O_GATES = O_PRE;
static_assert(O_GATES + (size_t)MG * 4096 * 2 <= O_VCNT, "gates alias region too small");
static_assert(O_CM + CM_BYTES <= O_QDN, "chunk-matrix region must end before QDN");
constexpr size_t O_BAR = O_END;
constexpr size_t BAR_BYTES = 3456 * 4;
static_assert(O_BAR + BAR_BYTES <= ((size_t)256 << 20), "workspace must fit 256 MiB");

constexpr size_t OUT_SF = (size_t)M * D, OUT_SB = OUT_SF + (size_t)NB_C * NL * 8 * 64 * 64,
                 OUT_CKV = OUT_SB + (size_t)NB_C * NL * 8 * 64 * 64, OUT_KR = OUT_CKV + (size_t)NB_C * NL * T_C * 128;

#ifdef EMU
template <class T> __device__ __forceinline__ T* opaque(T* p) { return p; }
__device__ __forceinline__ int opaque_i(int v) { return v; }
#else
template <class T> __device__ __forceinline__ T* opaque(T* p) {
  typedef __attribute__((address_space(1))) T* gptr;
  gptr g = (gptr)p; asm volatile("" : "+s"(g)); return (T*)g;
}
__device__ __forceinline__ int opaque_i(int v) { asm volatile("" : "+s"(v)); return v; }
#endif
__device__ __forceinline__ int my_tid() {
#ifdef EMU
  return (int)threadIdx.x;
#else
  int t = (int)threadIdx.x; asm volatile("" : "+v"(t)); return t;
#endif
}
__device__ __forceinline__ unsigned f_as_u(float f) { return __builtin_bit_cast(unsigned, f); }
__device__ __forceinline__ float u_as_f(unsigned u) { return __builtin_bit_cast(float, u); }
#ifdef EMU
__device__ __forceinline__ bf16_t f2bf(float f) { unsigned u = f_as_u(f); u += 0x7FFFu + ((u >> 16) & 1u); return (bf16_t)(u >> 16); }
__device__ __forceinline__ unsigned pk2bf(float lo, float hi) { return (unsigned)f2bf(lo) | ((unsigned)f2bf(hi) << 16); }
#else
typedef __bf16 bf2v_t __attribute__((ext_vector_type(2)));
typedef float f2c_t __attribute__((ext_vector_type(2)));
__device__ __forceinline__ bf16_t f2bf(float f) { return __builtin_bit_cast(unsigned short, (__bf16)f); }
__device__ __forceinline__ unsigned pk2bf(float lo, float hi) { return __builtin_bit_cast(unsigned, __builtin_convertvector(f2c_t{lo, hi}, bf2v_t)); }
#endif
__device__ __forceinline__ float bf2f(bf16_t h) { return u_as_f(((unsigned)h) << 16); }
__device__ __forceinline__ float bflo(unsigned u) { return u_as_f(u << 16); }
__device__ __forceinline__ float bfhi(unsigned u) { return u_as_f(u & 0xFFFF0000u); }
#ifdef EMU
__device__ __forceinline__ float fexp_(float x) { return expf(x); }
__device__ __forceinline__ float frcp_(float x) { return 1.f / x; }
#else
__device__ __forceinline__ float fexp_(float x) { return __builtin_amdgcn_exp2f(x * 1.4426950408889634f); }
__device__ __forceinline__ float frcp_(float x) { return __builtin_amdgcn_rcpf(x); }
#endif
#ifdef EMU
__device__ __forceinline__ float fexp2_(float x) { return exp2f(x); }
#else
__device__ __forceinline__ float fexp2_(float x) { return __builtin_amdgcn_exp2f(x); }
#endif
__device__ __forceinline__ float sigmoidf_(float x) { return frcp_(1.f + fexp_(-x)); }
__device__ __forceinline__ float siluf_(float x) { return x * frcp_(1.f + fexp_(-x)); }
__device__ __forceinline__ float tanhf_(float x) { return 1.f - 2.f * frcp_(1.f + fexp_(2.f * x)); }
__device__ __forceinline__ float geluf_(float x) { return 0.5f * x * (1.f + tanhf_(0.7978845608028654f * (x + 0.044715f * x * x * x))); }
__device__ __forceinline__ float wave_sum(float v) {
#pragma unroll
  for (int o = 32; o >= 1; o >>= 1) v += __shfl_xor(v, o);
  return v;
}

#ifdef EMU
#define WAVE_SYNC() emu::wave_barrier()
__device__ __forceinline__ float sum16(float v) { v += __shfl_xor(v, 1); v += __shfl_xor(v, 2); v += __shfl_xor(v, 4); v += __shfl_xor(v, 8); return v; }
#else
#define WAVE_SYNC() __builtin_amdgcn_wave_barrier()
__device__ __forceinline__ float sum16(float v) {
  v += u_as_f(__builtin_amdgcn_update_dpp(0, (int)f_as_u(v), 0xB1, 0xF, 0xF, true));
  v += u_as_f(__builtin_amdgcn_update_dpp(0, (int)f_as_u(v), 0x4E, 0xF, 0xF, true));
  v += u_as_f(__builtin_amdgcn_update_dpp(0, (int)f_as_u(v), 0x141, 0xF, 0xF, true));
  v += u_as_f(__builtin_amdgcn_update_dpp(0, (int)f_as_u(v), 0x140, 0xF, 0xF, true));
  return v;
}
#endif

template <int LPR> __device__ __forceinline__ float sum_lpr(float v) {
#ifdef EMU
  v += __shfl_xor(v, 1); v += __shfl_xor(v, 2); v += __shfl_xor(v, 4);
  if (LPR >= 16) v += __shfl_xor(v, 8);
  if (LPR >= 32) v += __shfl_xor(v, 16);
  return v;
#else
  v += u_as_f(__builtin_amdgcn_update_dpp(0, (int)f_as_u(v), 0xB1, 0xF, 0xF, true));
  v += u_as_f(__builtin_amdgcn_update_dpp(0, (int)f_as_u(v), 0x4E, 0xF, 0xF, true));
  v += u_as_f(__builtin_amdgcn_update_dpp(0, (int)f_as_u(v), 0x141, 0xF, 0xF, true));
  if (LPR >= 16) v += u_as_f(__builtin_amdgcn_update_dpp(0, (int)f_as_u(v), 0x140, 0xF, 0xF, true));
  if (LPR >= 32) { auto r = __builtin_amdgcn_permlane16_swap(f_as_u(v), f_as_u(v), false, false); v = u_as_f(r[0]) + u_as_f(r[1]); }
  return v;
#endif
}

template <int LPR> __device__ __forceinline__ void sum_lpr2(float& a, float& b) {
#ifdef EMU
  a = sum_lpr<LPR>(a); b = sum_lpr<LPR>(b);
#else
#define DPP_ADD2(ctrl) { float ta = u_as_f(__builtin_amdgcn_update_dpp(0, (int)f_as_u(a), ctrl, 0xF, 0xF, true)); float tb = u_as_f(__builtin_amdgcn_update_dpp(0, (int)f_as_u(b), ctrl, 0xF, 0xF, true)); a += ta; b += tb; }
  DPP_ADD2(0xB1) DPP_ADD2(0x4E) DPP_ADD2(0x141)
  if (LPR >= 16) DPP_ADD2(0x140)
  if (LPR >= 32) { auto ra = __builtin_amdgcn_permlane16_swap(f_as_u(a), f_as_u(a), false, false); auto rb = __builtin_amdgcn_permlane16_swap(f_as_u(b), f_as_u(b), false, false);
    a = u_as_f(ra[0]) + u_as_f(ra[1]); b = u_as_f(rb[0]) + u_as_f(rb[1]); }
#undef DPP_ADD2
#endif
}

constexpr int NTHR = 512, NWAVE = 8;
constexpr int LDS_STR = 72;
constexpr int SMEM_STAGE = 131072;
constexpr int SMEM_BYTES = SMEM_STAGE + 16;

template <int NJ>
__device__ __forceinline__ void zero_acc(f4v (&acc)[2][NJ]) {
#pragma unroll
  for (int i = 0; i < 2; ++i)
#pragma unroll
    for (int j = 0; j < NJ; ++j) acc[i][j] = f4v{0.f, 0.f, 0.f, 0.f};
}

template <int NJ, bool BT = false>
__device__ __forceinline__ void gemm_mainloop(const bf16_t* __restrict__ A, long lda, int arow0, int arows, const bf16_t* __restrict__ B,
                                              long ldb, int brow0, int brows, int K, char* smem, f4v (&acc)[2][NJ]) {
  constexpr int BROWS = 32 * NJ, NBL = NJ / 2;
  constexpr int BUF = (128 + 128) * LDS_STR;
  bf16_t* s0 = (bf16_t*)smem;
  const int tid = my_tid(), lane = tid & 63, wid = tid >> 6, wm = wid >> 1, wn = wid & 1;
  u4v ra[2], rb[NBL];
  const bf16_t* ap[2]; const bf16_t* bp[NBL];
#pragma unroll
  for (int i = 0; i < 2; ++i) { int c = tid + NTHR * i, r = c >> 3, cc = c & 7; int ar = arow0 + r; ar = ar < arows ? ar : arows - 1; ap[i] = A + (long)ar * lda + cc * 8; }
#pragma unroll
  for (int i = 0; i < NBL; ++i) { int c = tid + NTHR * i;
    if (BT) { int q = c >> 4, dc = c & 15; bp[i] = B + (long)q * ldb + brow0 + dc * 8; }
    else { int r = c >> 3, cc = c & 7; int br = brow0 + r; br = br < brows ? br : brows - 1; bp[i] = B + (long)br * ldb + cc * 8; } }
#pragma unroll
  for (int i = 0; i < 2; ++i) ra[i] = *(const u4v*)(ap[i]);
#pragma unroll
  for (int i = 0; i < NBL; ++i) rb[i] = *(const u4v*)(bp[i]);
  __syncthreads();
#pragma unroll
  for (int i = 0; i < 2; ++i) { int c = tid + NTHR * i, r = c >> 3, cc = c & 7; *(u4v*)(s0 + r * LDS_STR + cc * 8) = ra[i]; }
#pragma unroll
  for (int i = 0; i < NBL; ++i) { int c = tid + NTHR * i;
    if (BT) { int q = c >> 4, dc = c & 15;
#pragma unroll
      for (int e = 0; e < 8; ++e) s0[(128 + dc * 8 + e) * LDS_STR + q] = (bf16_t)(rb[i][e >> 1] >> ((e & 1) * 16)); }
    else { int r = c >> 3, cc = c & 7; *(u4v*)(s0 + (128 + r) * LDS_STR + cc * 8) = rb[i]; } }
  __syncthreads();
  const int nk = K >> 6;
  for (int kt = 0; kt < nk; ++kt) {
    const bool more = kt + 1 < nk;
    if (more) {
#pragma unroll
      for (int i = 0; i < 2; ++i) ra[i] = *(const u4v*)(ap[i] + (kt + 1) * 64);
#pragma unroll
      for (int i = 0; i < NBL; ++i) rb[i] = *(const u4v*)(bp[i] + (BT ? (long)(kt + 1) * 64 * ldb : (long)(kt + 1) * 64));
    }
    const bf16_t* sA = s0 + (kt & 1) * BUF; const bf16_t* sB = sA + 128 * LDS_STR;
#pragma unroll
    for (int ks = 0; ks < 2; ++ks) {
      s8v af[2], bf[NJ];
#pragma unroll
      for (int i = 0; i < 2; ++i) af[i] = *(const s8v*)(sA + (wm * 32 + i * 16 + (lane & 15)) * LDS_STR + ks * 32 + (lane >> 4) * 8);
#pragma unroll
      for (int j = 0; j < NJ; ++j) bf[j] = *(const s8v*)(sB + (wn * NJ * 16 + j * 16 + (lane & 15)) * LDS_STR + ks * 32 + (lane >> 4) * 8);
#pragma unroll
      for (int i = 0; i < 2; ++i)
#pragma unroll
        for (int j = 0; j < NJ; ++j) acc[i][j] = __builtin_amdgcn_mfma_f32_16x16x32_bf16(bf[j], af[i], acc[i][j], 0, 0, 0);
    }
    if (more) {
      bf16_t* dA = s0 + ((kt + 1) & 1) * BUF;
#pragma unroll
      for (int i = 0; i < 2; ++i) { int c = tid + NTHR * i, r = c >> 3, cc = c & 7; *(u4v*)(dA + r * LDS_STR + cc * 8) = ra[i]; }
#pragma unroll
      for (int i = 0; i < NBL; ++i) { int c = tid + NTHR * i;
        if (BT) { int q = c >> 4, dc = c & 15;
#pragma unroll
          for (int e = 0; e < 8; ++e) dA[(128 + dc * 8 + e) * LDS_STR + q] = (bf16_t)(rb[i][e >> 1] >> ((e & 1) * 16)); }
        else { int r = c >> 3, cc = c & 7; *(u4v*)(dA + (128 + r) * LDS_STR + cc * 8) = rb[i]; } }
    }
    __syncthreads();
  }
  (void)BROWS;
}

template <int NJ, class F>
__device__ __forceinline__ void epi_foreach(f4v (&acc)[2][NJ], int row0, int col0, F f) {
  const int tid = my_tid(), lane = tid & 63, wid = tid >> 6, wm = wid >> 1, wn = wid & 1;
#pragma unroll
  for (int i = 0; i < 2; ++i)
#pragma unroll
    for (int j = 0; j < NJ; ++j) f(row0 + wm * 32 + i * 16 + (lane & 15), col0 + wn * NJ * 16 + j * 16 + (lane >> 4) * 4, acc[i][j]);
}
__device__ __forceinline__ u4v pack8(const float (&x)[8]) {
  return u4v{pk2bf(x[0], x[1]), pk2bf(x[2], x[3]), pk2bf(x[4], x[5]), pk2bf(x[6], x[7])};
}
__device__ __forceinline__ void unpack8(u4v u, float (&x)[8]) {
  x[0] = bflo(u.x); x[1] = bfhi(u.x); x[2] = bflo(u.y); x[3] = bfhi(u.y); x[4] = bflo(u.z); x[5] = bfhi(u.z); x[6] = bflo(u.w); x[7] = bfhi(u.w);
}
__device__ __forceinline__ u2v pack4(float a, float b, float c, float d) {
  return u2v{pk2bf(a, b), pk2bf(c, d)};
}

#ifndef EMU
namespace pg8 {
#define PG8_LAS __attribute__((address_space(3)))
typedef unsigned short bf16_t;
typedef short bf16x8 __attribute__((ext_vector_type(8)));
typedef float f32x4 __attribute__((ext_vector_type(4)));
typedef unsigned u32x4 __attribute__((ext_vector_type(4)));
constexpr int BM = 256, BK = 64, HALF = 128, HTB = HALF * BK * 2  , STAGE_BYTES = 8 * HTB, NXCD = 8, WGM = 8;

__host__ __device__ __forceinline__ int lds_byte(int r, int c) { const int st = (r >> 4) * 2 + (c >> 5), rr = r & 15, cc = c & 31, ob = rr * 64 + cc * 2; return st * 1024 + (ob ^ (((ob >> 9) & 1) << 5)); }
__host__ __device__ __forceinline__ void stage_rc(int b, int& R, int& C) { const int st = b / 1024, sb = b % 1024, swz = sb ^ (((sb >> 9) & 1) << 5); R = (st >> 1) * 16 + swz / 64; C = (st & 1) * 32 + (swz % 64) / 2; }
__host__ __device__ __forceinline__ int perm32(int rho) { const int n = rho >> 4, i = rho & 15; return 8 * (i >> 2) + 4 * n + (i & 3); }

struct Unit { int pm, pn; };
struct Gemm { const bf16_t* A; const bf16_t* Bt; int M, N, K; };

struct StaticOrder {
    int nM, nN, nwg, G, c;
    __host__ __device__ void init(int M, int N, int G_, int c_) { nM = M / BM; nN = N / BM; nwg = nM * nN; G = G_; c = c_; }
    __host__ __device__ bool next(int i, Unit& u) const {
        const long L = (long)i * G + c; if (L >= nwg) return false;
        int wgid = (int)L; { const int q = nwg / NXCD, r = nwg % NXCD, xcd = wgid % NXCD, off = wgid / NXCD; wgid = (xcd < r ? xcd * (q + 1) : r * (q + 1) + (xcd - r) * q) + off; }
        const int nig = WGM * nN, gid = wgid / nig, fm = gid * WGM, gsz = (nM - fm) < WGM ? (nM - fm) : WGM;
        u.pm = fm + ((wgid % nig) % gsz); u.pn = (wgid % nig) / gsz; return true;
    }
    __device__ __forceinline__ void a_ready(const Unit&) const {}
    __device__ __forceinline__ void done(const Unit&) const {}
};
template <class Epi, class Sched>
__device__ __forceinline__ void gemm_phase(PG8_LAS unsigned char* lds, const Gemm g, const Sched& S, const Epi& E) {
    const int tid = my_tid(), wid = __builtin_amdgcn_readfirstlane(tid >> 6), lane = tid & 63, wr = wid >> 2, wc = wid & 3, fr = lane & 15, fq = lane >> 4;
    const int K = g.K, nt = K / BK;
    unsigned voffA[2], voffB[2];
#pragma unroll
    for (int i = 0; i < 2; ++i) { int R, C; stage_rc(tid * 16 + i * 8192, R, C); const int Rb = Epi::PERM ? ((R & ~31) + perm32(R & 31)) : R;
        voffA[i] = (unsigned)(R * K + C) * 2u; voffB[i] = (unsigned)(Rb * K + C) * 2u; }
    const size_t kstep = (size_t)(BK * 2);
    const size_t hstep = (size_t)HALF * K * 2;
    const size_t tstep = 2 * hstep;
    const unsigned ldsw = (unsigned)wid * 1024u;
    const int aoff = lds_byte(wr * 64 + fr, fq * 8), boff = lds_byte(wc * 32 + fr, fq * 8);
#define PG8_SA(b, h) (((b) * 2 + (h)) * HTB)
#define PG8_SB(b, h) ((4 + (b) * 2 + (h)) * HTB)
#define PG8_STAGE(bufoff, gbase, voff) do { _Pragma("unroll") for (int _i = 0; _i < 2; ++_i) \
        __builtin_amdgcn_global_load_lds((const unsigned*)((const char*)(gbase) + (voff)[_i]), (PG8_LAS unsigned*)(lds + (bufoff) + ldsw + _i * 8192), 16, 0, 0); } while (0)
#define PG8_LDA(dst, b, h) do { _Pragma("unroll") for (int m = 0; m < 4; ++m) _Pragma("unroll") for (int k = 0; k < 2; ++k) dst[m][k] = *(const PG8_LAS bf16x8*)(lds + PG8_SA(b, h) + aoff + m * 2048 + k * 1024); } while (0)
#define PG8_LDB(dst, b, h) do { _Pragma("unroll") for (int n = 0; n < 2; ++n) _Pragma("unroll") for (int k = 0; k < 2; ++k) dst[n][k] = *(const PG8_LAS bf16x8*)(lds + PG8_SB(b, h) + boff + n * 2048 + k * 1024); } while (0)
#define PG8_MMA(ai, bj, At, Bt) do { __builtin_amdgcn_s_setprio(1); _Pragma("unroll") for (int m = 0; m < 4; ++m) _Pragma("unroll") for (int n = 0; n < 2; ++n) _Pragma("unroll") for (int k = 0; k < 2; ++k) \
        acc[ai][bj][m][n] = __builtin_amdgcn_mfma_f32_16x16x32_bf16(Bt[n][k], At[m][k], acc[ai][bj][m][n], 0, 0, 0); __builtin_amdgcn_s_setprio(0); } while (0)
#define PG8_WAIT_V(n) asm volatile("s_waitcnt vmcnt(" #n ")" ::: "memory")
#define PG8_WAIT_L(n) asm volatile("s_waitcnt lgkmcnt(" #n ")" ::: "memory")
#define PG8_BAR __builtin_amdgcn_s_barrier()
#define PG8_SCHED __builtin_amdgcn_sched_barrier(0)
    Unit cur, nxt; int ui = 0;
    if (!S.next(0, cur)) return;
    f32x4 acc[2][2][4][2];
#pragma unroll
    for (int a = 0; a < 2; ++a)
#pragma unroll
        for (int b = 0; b < 2; ++b)
#pragma unroll
            for (int m = 0; m < 4; ++m)
#pragma unroll
                for (int n = 0; n < 2; ++n) acc[a][b][m][n] = (f32x4){0.f, 0.f, 0.f, 0.f};
    bf16x8 At[4][2], B0[2][2], B1[2][2];
    const char* cA = (const char*)g.A + (size_t)cur.pm * tstep; const char* cB = (const char*)g.Bt + (size_t)cur.pn * tstep;
    S.a_ready(cur);
    PG8_STAGE(PG8_SB(0, 0), cB, voffB); PG8_STAGE(PG8_SA(0, 0), cA, voffA); PG8_STAGE(PG8_SB(0, 1), cB + hstep, voffB); PG8_STAGE(PG8_SA(0, 1), cA + hstep, voffA);
    if (wr == 1) PG8_BAR;
    PG8_WAIT_V(4); PG8_BAR;
    PG8_STAGE(PG8_SB(1, 0), cB + kstep, voffB); PG8_STAGE(PG8_SA(1, 0), cA + kstep, voffA); PG8_STAGE(PG8_SB(1, 1), cB + hstep + kstep, voffB);
    PG8_WAIT_V(6); PG8_BAR;
    for (;;) {
        const bool has_next = S.next(ui + 1, nxt);
        const char* nA = has_next ? (const char*)g.A + (size_t)nxt.pm * tstep : cA; const char* nB = has_next ? (const char*)g.Bt + (size_t)nxt.pn * tstep : cB;
        for (int t = 0; t < nt; t += 2) {
            const bool last = (t == nt - 2);
            const char* a1 = cA + (size_t)(t + 1) * kstep;
            const char* a2 = last ? nA : cA + (size_t)(t + 2) * kstep; const char* b2 = last ? nB : cB + (size_t)(t + 2) * kstep;
            const char* a3 = a2 + kstep; const char* b3 = b2 + kstep;
            if (last && has_next) S.a_ready(nxt);
            PG8_LDB(B0, 0, 0); PG8_SCHED; PG8_LDA(At, 0, 0); PG8_STAGE(PG8_SA(1, 1), a1 + hstep, voffA);
            PG8_WAIT_L(8); PG8_BAR; PG8_WAIT_L(0); PG8_MMA(0, 0, At, B0); PG8_BAR; PG8_SCHED;
            PG8_LDB(B1, 0, 1); PG8_STAGE(PG8_SB(0, 0), b2, voffB);
            PG8_BAR; PG8_WAIT_L(0); PG8_MMA(0, 1, At, B1); PG8_BAR;
            PG8_LDA(At, 0, 1); PG8_STAGE(PG8_SA(0, 0), a2, voffA);
            PG8_BAR; PG8_WAIT_L(0); PG8_MMA(1, 0, At, B0); PG8_BAR; PG8_SCHED;
            PG8_STAGE(PG8_SB(0, 1), b2 + hstep, voffB);
            PG8_WAIT_V(6); PG8_BAR; PG8_MMA(1, 1, At, B1); PG8_BAR;
            PG8_LDB(B0, 1, 0); PG8_SCHED; PG8_LDA(At, 1, 0); PG8_STAGE(PG8_SA(0, 1), a2 + hstep, voffA);
            PG8_WAIT_L(8); PG8_BAR; PG8_WAIT_L(0); PG8_MMA(0, 0, At, B0); PG8_BAR; PG8_SCHED;
            PG8_LDB(B1, 1, 1); PG8_STAGE(PG8_SB(1, 0), b3, voffB);
            PG8_BAR; PG8_WAIT_L(0); PG8_MMA(0, 1, At, B1); PG8_BAR;
            PG8_LDA(At, 1, 1); PG8_STAGE(PG8_SA(1, 0), a3, voffA);
            PG8_BAR; PG8_WAIT_L(0); PG8_MMA(1, 0, At, B0); PG8_BAR; PG8_SCHED;
            PG8_STAGE(PG8_SB(1, 1), b3 + hstep, voffB);
            PG8_WAIT_V(6); PG8_BAR; PG8_MMA(1, 1, At, B1); PG8_BAR;
        }
            if constexpr (!Epi::AFTER_DRAIN) { E(acc, cur, wr, wc, fr, fq); S.done(cur); }
            if (!has_next) break;
#pragma unroll
        for (int a = 0; a < 2; ++a)
#pragma unroll
            for (int b = 0; b < 2; ++b)
#pragma unroll
                for (int m = 0; m < 4; ++m)
#pragma unroll
                    for (int n = 0; n < 2; ++n) acc[a][b][m][n] = (f32x4){0.f, 0.f, 0.f, 0.f};
        cur = nxt; cA = nA; cB = nB; ++ui;
    }
    PG8_WAIT_V(0);
    if (wr == 0) PG8_BAR;
    PG8_BAR;
    if constexpr (Epi::AFTER_DRAIN) { E.fused(acc, cur, wr, wc, fr, fq, lds, wid, lane); S.done(cur); }
#undef PG8_SA
#undef PG8_SB
#undef PG8_STAGE
#undef PG8_LDA
#undef PG8_LDB
#undef PG8_MMA
#undef PG8_WAIT_V
#undef PG8_WAIT_L
#undef PG8_BAR
#undef PG8_SCHED
}

__device__ __forceinline__ unsigned pk2(float lo, float hi) { return pk2bf(lo, hi); }
struct EpiStore {
  static constexpr bool PERM = true, AFTER_DRAIN = false;
  bf16_t* O; int ldc; int ncols;
  __device__ __forceinline__ void operator()(const f32x4 (&acc)[2][2][4][2], const Unit& u, int wr, int wc, int fr, int fq) const {
    const int row0 = u.pm * BM + wr * 64 + fr, col0 = u.pn * BM + wc * 32 + 8 * fq;
#pragma unroll
    for (int ai = 0; ai < 2; ++ai)
#pragma unroll
      for (int m = 0; m < 4; ++m) { bf16_t* rowp = O + (size_t)(row0 + ai * HALF + m * 16) * ldc + col0;
#pragma unroll
        for (int bj = 0; bj < 2; ++bj) if (col0 + bj * HALF < ncols) { const f32x4 v0 = acc[ai][bj][m][0], v1 = acc[ai][bj][m][1];
          *(u32x4*)(rowp + bj * HALF) = (u32x4){pk2(v0[0], v0[1]), pk2(v0[2], v0[3]), pk2(v1[0], v1[1]), pk2(v1[2], v1[3])}; } }
  }
};
struct EpiSigmoid {
  static constexpr bool PERM = true, AFTER_DRAIN = false;
  bf16_t* O; int ldc; const float* bias;
  __device__ __forceinline__ void operator()(const f32x4 (&acc)[2][2][4][2], const Unit& u, int wr, int wc, int fr, int fq) const {
    const int row0 = u.pm * BM + wr * 64 + fr, col0 = u.pn * BM + wc * 32 + 8 * fq;
    f32x4 bv[2][2];
#pragma unroll
    for (int bj = 0; bj < 2; ++bj)
#pragma unroll
      for (int n = 0; n < 2; ++n) bv[bj][n] = *(const f32x4*)(bias + col0 + bj * HALF + 4 * n);
#pragma unroll
    for (int ai = 0; ai < 2; ++ai)
#pragma unroll
      for (int m = 0; m < 4; ++m) { bf16_t* rowp = O + (size_t)(row0 + ai * HALF + m * 16) * ldc + col0;
#pragma unroll
        for (int bj = 0; bj < 2; ++bj) { const f32x4 v0 = acc[ai][bj][m][0] + bv[bj][0], v1 = acc[ai][bj][m][1] + bv[bj][1];
          *(u32x4*)(rowp + bj * HALF) = (u32x4){pk2(sigmoidf_(v0[0]), sigmoidf_(v0[1])), pk2(sigmoidf_(v0[2]), sigmoidf_(v0[3])), pk2(sigmoidf_(v1[0]), sigmoidf_(v1[1])), pk2(sigmoidf_(v1[2]), sigmoidf_(v1[3]))}; } }
  }
};
}
#endif

struct TJob { const float* src; int K, N; long lds; bf16_t* dst; long ldd; };
__device__ __forceinline__ TJob get_tjob(const Params& p, int l, int j) {
  TJob t; char* ws = p.ws;
  if (j == 0) { t.src = p.w_in + (size_t)l * 1024 * IN_W; t.K = 1024; t.N = IN_W; t.lds = IN_W; t.dst = (bf16_t*)(ws + O_WINT); t.ldd = 1024; }
  else if (j == 1) { t.src = p.w_merge + (size_t)l * 1024 * 4096; t.K = 1024; t.N = 4096; t.lds = 4096; t.dst = (bf16_t*)(ws + O_WMT); t.ldd = 1024; }
  else if (j < 6) { int n = j - 2; t.src = p.w_branch + ((size_t)l * 4 + n) * 512 * 1024; t.K = 512; t.N = 1024; t.lds = 1024; t.dst = (bf16_t*)(ws + O_WBRT) + (size_t)n * 1024 * 512; t.ldd = 512; }
  else if (j == 6) { t.src = p.w_out + (size_t)l * 1024 * 1024; t.K = 1024; t.N = 1024; t.lds = 1024; t.dst = (bf16_t*)(ws + O_WOUTT); t.ldd = 1024; }
  else if (j == 7) { t.src = p.w_q_up + (size_t)l * 256 * 768; t.K = 256; t.N = 768; t.lds = 768; t.dst = (bf16_t*)(ws + O_WQT); t.ldd = 256; }
  else if (j == 8) { t.src = p.w_kv_up + (size_t)l * 128 * 1024; t.K = 128; t.N = 1024; t.lds = 1024; t.dst = (bf16_t*)(ws + O_WKVT); t.ldd = 128; }
  else { int n = j - 9;
    t.src = (n < 2 ? p.w_up : p.a_up) + ((size_t)l * 2 + (n & 1)) * 64 * 512; t.K = 64; t.N = 512; t.lds = 512;
    t.dst = (bf16_t*)(ws + O_WUPT) + (size_t)n * 512 * 64; t.ldd = 64; }
  return t;
}
constexpr int NTJOBS = 13;

__device__ __forceinline__ void stage_prep(const Params& p, int l, int bid, int nb, char* smem) {
  const int tid = my_tid();
  char* ws = p.ws;
  {
    float* tile = (float*)smem;
    int base = 0;
    for (int j = 0; j < NTJOBS; ++j) {
      TJob t = get_tjob(p, l, j);
      int tk = t.K / 64, tn = t.N / 32, nt = tk * tn;
      int first = ((bid - base % nb) % nb + nb) % nb;
      for (int q = first; q < nt; q += nb) {
        int kt = q / tn, nt_ = q % tn;
        __syncthreads();
        { int r = tid >> 3, c4 = tid & 7; f4v x = *(const f4v*)(t.src + (long)(kt * 64 + r) * t.lds + nt_ * 32 + c4 * 4);
          tile[r * 33 + c4 * 4] = x[0]; tile[r * 33 + c4 * 4 + 1] = x[1]; tile[r * 33 + c4 * 4 + 2] = x[2]; tile[r * 33 + c4 * 4 + 3] = x[3]; }
        __syncthreads();
        if (tid < 256) { int n = tid >> 3, kc = tid & 7; float x[8];
#pragma unroll
          for (int e = 0; e < 8; ++e) x[e] = tile[(kc * 8 + e) * 33 + n];
          *(u4v*)(t.dst + (long)(nt_ * 32 + n) * t.ldd + kt * 64 + kc * 8) = pack8(x); }
      }
      base += nt;
    }
    __syncthreads();
  }
  const long gtid = (long)bid * NTHR + tid, gn = (long)nb * NTHR;
  { bf16_t* d = (bf16_t*)(ws + O_WINT) + (size_t)IN_W * 1024; for (long i = gtid; i < (long)(IN_WP - IN_W) * 1024; i += gn) d[i] = 0; }
  { bf16_t* d = (bf16_t*)(ws + O_WS); const float* s = p.g_w_s + (size_t)l * 4 * 128 * 128; for (long i = gtid; i < (long)4 * 128 * 128; i += gn) d[i] = f2bf(s[i]); }
  if (l != 0) return;
  { bf16_t* d = (bf16_t*)(ws + O_CS128);
    for (long i = gtid; i < 256 * 128; i += gn) { int j = (int)(i >> 7), c = (int)(i & 127); int mm = ((j & 127) * c) & 127; float x = 2.0f * mm / 128.f; d[i] = f2bf(j < 128 ? cospif(x) : sinpif(x)); } }
  { bf16_t* d = (bf16_t*)(ws + O_A2C);
    for (long i = gtid; i < (long)T_C * 2 * T_C; i += gn) { int tp = (int)(i / (2 * T_C)), tt = (int)(i % (2 * T_C)); int half = tt >= T_C; int t = half ? tt - T_C : tt; int mm = (int)(((long)tp * t) % T_C); float x = 2.0f * mm / (float)T_C; d[i] = f2bf(half ? -sinpif(x) : cospif(x)); } }
  { bf16_t* d = (bf16_t*)(ws + O_A2D);
    for (long i = gtid; i < (long)T_D * 2 * T_D; i += gn) { int tp = (int)(i / (2 * T_D)), tt = (int)(i % (2 * T_D)); int half = tt >= T_D; int t = half ? tt - T_D : tt; int mm = (int)(((long)tp * t) % T_D); float x = 2.0f * mm / (float)T_D; d[i] = f2bf(half ? -sinpif(x) : cospif(x)); } }
  { float* d = (float*)(ws + O_ROPE);
    for (long i = gtid; i < (long)T_D * 16; i += gn) { int t = (int)(i >> 4), pi = (int)(i & 15); float pos = (pi < 8) ? (float)(t / 64) : (float)(t % 64); float inv = expf(-(float)(pi & 7) * (9.210340371976184f / 8.f)); float a = pos * inv; d[2 * i] = cosf(a); d[2 * i + 1] = sinf(a); } }
  { float4* d = (float4*)p.out; const float4* s0 = (const float4*)p.x_prompt; const float4* s1 = (const float4*)p.x_sample;
    for (long i = gtid; i < (long)M * 256; i += gn) d[i] = (i < (long)M_C * 256) ? s0[i] : s1[i - (long)M_C * 256]; }
  {
    float* red = (float*)smem;
    float* modp = (float*)(ws + O_MOD);
    for (int u = bid; u < NL * 48; u += nb) {
      int ll = u / 48, cg = u % 48; int col = cg * 64 + (tid & 63), kq = tid >> 6;
      float a0 = 0.f, a1 = 0.f, a2 = 0.f;
      const float* w = p.w_ada + (size_t)ll * 1024 * 3072 + col;
      for (int k = kq * 128; k < kq * 128 + 128; ++k) {
        float wv = w[(size_t)k * 3072];
        a0 += siluf_(p.c_ctx[k]) * wv; a1 += siluf_(p.c[k]) * wv; a2 += siluf_(p.c[(NB_D > 1 ? 1024 : 0) + k]) * wv;
      }
      __syncthreads();
      red[(kq * 3 + 0) * 64 + (tid & 63)] = a0; red[(kq * 3 + 1) * 64 + (tid & 63)] = a1; red[(kq * 3 + 2) * 64 + (tid & 63)] = a2;
      __syncthreads();
      if (tid < 192) { int mi = tid >> 6, cc = tid & 63; float s = 0.f;
#pragma unroll
        for (int q8 = 0; q8 < 8; ++q8) s += red[(q8 * 3 + mi) * 64 + cc];
        modp[((size_t)ll * 3 + mi) * 3072 + cg * 64 + cc] = s + p.b_ada[(size_t)ll * 3072 + cg * 64 + cc]; }
    }
  }
}

__device__ __forceinline__ int mod_index(const Grp& g, int lm) { return g.isden ? 1 + lm / T_D : 0; }

__device__ __forceinline__ void stage_h(const Params& p, const Grp& g, int l, int bid, int nb) {
  const int lane = my_tid() & 63, wid = my_tid() >> 6;
  const float* X = p.out + (size_t)g.m0 * 1024;
  bf16_t* H = (bf16_t*)(p.ws + O_H);
  const float* modp = (const float*)(p.ws + O_MOD) + (size_t)l * 3 * 3072;
  const float* gam = p.norm_g + (size_t)l * 1024;
  for (int m = bid * NWAVE + wid; m < g.mg; m += nb * NWAVE) {
    const float* xr = X + (size_t)m * 1024; float v[16]; float ss = 0.f;
#pragma unroll
    for (int i = 0; i < 4; ++i) { float4 q = *(const float4*)(xr + i * 256 + lane * 4); v[4 * i] = q.x; v[4 * i + 1] = q.y; v[4 * i + 2] = q.z; v[4 * i + 3] = q.w; ss += q.x * q.x + q.y * q.y + q.z * q.z + q.w * q.w; }
    ss = wave_sum(ss); float rs = rsqrtf(ss * (1.f / 1024.f) + 1e-6f);
    const float* mo = modp + (size_t)mod_index(g, m) * 3072;
#pragma unroll
    for (int i = 0; i < 4; ++i) {
      int c = i * 256 + lane * 4; bf16_t o[4];
#pragma unroll
      for (int e = 0; e < 4; ++e) o[e] = f2bf(v[4 * i + e] * rs * gam[c + e] * (1.f + mo[1024 + c + e]) + mo[c + e]);
      *(u2v*)(H + (size_t)m * 1024 + c) = u2v{(unsigned)o[0] | ((unsigned)o[1] << 16), (unsigned)o[2] | ((unsigned)o[3] << 16)};
    }
  }
}

__device__ __forceinline__ void stage_g1(const Params& p, const Grp& g, int bid, int nb, char* smem) {
  const bf16_t* H = (const bf16_t*)(p.ws + O_H);
  const bf16_t* W = (const bf16_t*)(p.ws + O_WINT);
  bf16_t* Z = (bf16_t*)(p.ws + O_Z);
#ifndef EMU
  if ((g.mg & 255) == 0) {
    pg8::Gemm gm; gm.A = H; gm.Bt = W; gm.M = g.mg; gm.N = IN_WP; gm.K = 1024;
    pg8::StaticOrder S; S.init(gm.M, gm.N, nb, bid);
    pg8::EpiStore E; E.O = Z; E.ldc = IN_W; E.ncols = IN_W;
    pg8::gemm_phase<pg8::EpiStore, pg8::StaticOrder>((PG8_LAS unsigned char*)smem, gm, S, E);
    return;
  }
#endif
  const int TM = (g.mg + 127) / 128; constexpr int TN = (IN_W + 127) / 128;
  const int mg = g.mg;
  for (int t = bid; t < TM * TN; t += nb) {
    int tn = t / TM, tm = t % TM; f4v acc[2][4]; zero_acc<4>(acc);
    gemm_mainloop<4>(H, 1024, tm * 128, mg, W, 1024, tn * 128, IN_W, 1024, smem, acc);
    epi_foreach<4>(acc, tm * 128, tn * 128, [&](int row, int c0, f4v& v) {
      if (c0 < IN_W && row < mg) *(u2v*)(Z + (size_t)row * IN_W + c0) = pack4(v[0], v[1], v[2], v[3]);
    });
  }
}

__device__ __forceinline__ void stage_e1(const Params& p, const Grp& g, int l, int bid, int nb) {
  const int lane = my_tid() & 63, wid = my_tid() >> 6;
  char* ws = p.ws;
  const bf16_t* Z = (const bf16_t*)(ws + O_Z);
  bf16_t* SK = (bf16_t*)(ws + O_SK); bf16_t* SOP = (bf16_t*)(ws + O_SOP);
  bf16_t* LORA = (bf16_t*)(ws + O_LORA); bf16_t* QDN = (bf16_t*)(ws + O_QDN); bf16_t* CKV = (bf16_t*)(ws + O_CKV); bf16_t* KR = (bf16_t*)(ws + O_KR);
  bf16_t* VCN = (bf16_t*)(ws + O_VCNT);
  const float* rope = (const float*)(ws + O_ROPE);
  const float* mu = p.shift_mu + (size_t)l * SHIFT_W;
  const int isden = g.isden, T = g.T;
  for (int m = bid * NWAVE + wid; m < g.mkv; m += nb * NWAVE) {
    if (m >= g.mg) {
      int r = m - g.mg, b = r / PAST, j = r % PAST;
      if (lane < 20) {
        const float* s = lane < 16 ? p.c_ckv + (((size_t)b * NL + l) * PAST + j) * 128 + lane * 8 : p.c_kr + (((size_t)b * NL + l) * PAST + j) * 32 + (lane - 16) * 8;
        f4v x0 = *(const f4v*)s, x1 = *(const f4v*)(s + 4); float x[8] = {x0[0], x0[1], x0[2], x0[3], x1[0], x1[1], x1[2], x1[3]};
        if (lane < 16) *(u4v*)(CKV + (size_t)m * 128 + lane * 8) = pack8(x); else *(u4v*)(KR + (size_t)m * 32 + (lane - 16) * 8) = pack8(x);
      }
      continue;
    }
    const int sq = m / T, t = m % T, b = g.b0 + sq;
    const bf16_t* z = Z + (size_t)m * IN_W;
    const bool hp = t > 0, hn = t < T - 1;
#pragma unroll
    for (int it = 0; it < 4; ++it) {
      const int ci = it * 64 + lane; const bool valid = ci < 216; const int cc = valid ? ci : 0;
      float zc[8], pv[8], nv[8], sf[8];
      unpack8(*(const u4v*)(z + cc * 8), zc);
      if (hp) unpack8(*(const u4v*)(z - IN_W + cc * 8), pv); else { for (int e = 0; e < 8; ++e) pv[e] = 0.f; }
      if (hn) unpack8(*(const u4v*)(z + IN_W + cc * 8), nv); else { for (int e = 0; e < 8; ++e) nv[e] = 0.f; }
      f4v m0 = *(const f4v*)(mu + cc * 8), m1 = *(const f4v*)(mu + cc * 8 + 4);
#pragma unroll
      for (int e = 0; e < 8; ++e) sf[e] = zc[e] + (0.5f * (pv[e] + nv[e]) - zc[e]) * (e < 4 ? m0[e] : m1[e - 4]);
      bf16_t* rec = SOP + (((size_t)sq * 8 + (lane >> 3)) * T + t) * 576 + (lane & 7) * 8;
      if (it == 0) *(u4v*)rec = pack8(sf);
      else if (it == 1) {
        *(u4v*)(SK + (size_t)m * 512 + lane * 8) = pack8(sf);
        f4v k0 = *(const f4v*)(p.k_k + (size_t)l * 512 + lane * 8), k1 = *(const f4v*)(p.k_k + (size_t)l * 512 + lane * 8 + 4);
        float kr[8]; float n2 = 0.f;
#pragma unroll
        for (int e = 0; e < 8; ++e) { kr[e] = sf[e] * (e < 4 ? k0[e] : k1[e - 4]); n2 += kr[e] * kr[e]; }
        n2 = sum_lpr<8>(n2); const float inv = 1.f / fmaxf(sqrtf(n2), 1e-12f);
#pragma unroll
        for (int e = 0; e < 8; ++e) kr[e] *= inv;
        *(u4v*)(rec + 64) = pack8(kr);
      }
      else if (it == 2) *(u4v*)(rec + 128) = pack8(sf);
      else if (valid) {
        if (lane < 16) { for (int e = 0; e < 8; ++e) sf[e] = tanhf_(sf[e]); }
        *(u4v*)(LORA + (size_t)m * 192 + lane * 8) = pack8(sf);
      }
    }
    {
      const int col = lane < 32 ? ZC_QD + lane * 8 : (lane < 48 ? ZC_KVD + (lane - 32) * 8 : ZC_KR + ((lane - 48) & 3) * 8);
      float x[8]; unpack8(*(const u4v*)(z + col), x);
      float ss = 0.f;
#pragma unroll
      for (int e = 0; e < 8; ++e) ss += x[e] * x[e];
      const float t32 = sum_lpr<32>(ss), t16 = sum_lpr<16>(ss);
      if (lane < 32) {
        const float rs = rsqrtf(t32 * (1.f / 256.f) + 1e-6f); const float* gq = p.q_norm + (size_t)l * 256 + lane * 8; float o[8];
#pragma unroll
        for (int e = 0; e < 8; ++e) o[e] = x[e] * rs * gq[e];
        *(u4v*)(QDN + (size_t)m * 256 + lane * 8) = pack8(o);
      } else if (lane < 48) {
        const float rs = rsqrtf(t16 * (1.f / 128.f) + 1e-6f); const float* gk = p.kv_norm + (size_t)l * 128 + (lane - 32) * 8; float o[8];
#pragma unroll
        for (int e = 0; e < 8; ++e) o[e] = x[e] * rs * gk[e];
        *(u4v*)(CKV + (size_t)m * 128 + (lane - 32) * 8) = pack8(o);
        if (!isden) { float* op = p.out + OUT_CKV + (((size_t)b * NL + l) * T_C + t) * 128 + (lane - 32) * 8; *(f4v*)op = f4v{o[0], o[1], o[2], o[3]}; *(f4v*)(op + 4) = f4v{o[4], o[5], o[6], o[7]}; }
      } else if (lane < 52) {
        float o[8];
        if (isden) {
#pragma unroll
          for (int pq = 0; pq < 4; ++pq) { int pi = (lane - 48) * 4 + pq; float cs = rope[((size_t)t * 16 + pi) * 2], sn = rope[((size_t)t * 16 + pi) * 2 + 1];
            o[2 * pq] = x[2 * pq] * cs - x[2 * pq + 1] * sn; o[2 * pq + 1] = x[2 * pq] * sn + x[2 * pq + 1] * cs; }
        } else {
#pragma unroll
          for (int e = 0; e < 8; ++e) o[e] = x[e];
          float* op = p.out + OUT_KR + (((size_t)b * NL + l) * T_C + t) * 32 + (lane - 48) * 8; *(f4v*)op = f4v{x[0], x[1], x[2], x[3]}; *(f4v*)(op + 4) = f4v{x[4], x[5], x[6], x[7]};
        }
        *(u4v*)(KR + (size_t)m * 32 + (lane - 48) * 8) = pack8(o);
      }
    }
    {
      float v[8]; unpack8(*(const u4v*)(z + ZC_VC + lane * 8), v);
      float s1 = 0.f;
#pragma unroll
      for (int e = 0; e < 8; ++e) { v[e] = geluf_(v[e]); s1 += v[e]; }
      s1 = wave_sum(s1); const float mean = s1 * (1.f / 512.f); float s2 = 0.f;
#pragma unroll
      for (int e = 0; e < 8; ++e) { float d = v[e] - mean; s2 += d * d; }
      s2 = wave_sum(s2); const float rs = rsqrtf(s2 * (1.f / 512.f) + 1e-5f);
      const float* gg = p.g_ln_g + (size_t)l * 512 + lane * 8; const float* gb = p.g_ln_b + (size_t)l * 512 + lane * 8;
#pragma unroll
      for (int e = 0; e < 8; ++e) v[e] = (v[e] - mean) * rs * gg[e] + gb[e];
      *(u4v*)(VCN + (size_t)m * 512 + lane * 8) = pack8(v);
    }
  }
}

__device__ __forceinline__ void stage_g2(const Params& p, const Grp& g, int l, int bid, int nb, char* smem) {
  char* ws = p.ws;
  const bf16_t* Z = (const bf16_t*)(ws + O_Z);
  const float* rope = (const float*)(ws + O_ROPE);
  const int mg = g.mg, mkv = g.mkv, T = g.T, isden = g.isden, nkeys = g.nkeys;
  const int TM_M = (mg + 127) / 128, TM_KV = (mkv + 127) / 128;
  const int NT_Q = TM_M * 6, NT_KV = TM_KV * 8, NT_LORA = TM_M * 8, NT_GM = (mg / 128) * 4, ntt = T / 128, NT_D1 = g.nseq * 8 * ntt;
  const int NT = NT_Q + NT_KV + NT_LORA + NT_GM + NT_D1;
  for (int t0 = bid; t0 < NT; t0 += nb) {
    int t = t0; f4v acc[2][4]; zero_acc<4>(acc);
    if (t < NT_Q) {
      int tn = t / TM_M, tm = t % TM_M;
      gemm_mainloop<4>((const bf16_t*)(ws + O_QDN), 256, tm * 128, mg, (const bf16_t*)(ws + O_WQT), 256, tn * 128, 768, 256, smem, acc);
      bf16_t* Q = (bf16_t*)(ws + O_Q);
      const float scale = 0.10206207261596575f * 1.4426950408889634f;
      epi_foreach<4>(acc, tm * 128, tn * 128, [&](int row, int c0, f4v& v) {
        if (row >= mg) return;
        int cw = c0 % 96; float o0 = v[0], o1 = v[1], o2 = v[2], o3 = v[3];
        if (cw >= 64 && isden) { int tt = row % T_D; int pi = (cw - 64) >> 1; const float* rp = rope + ((size_t)tt * 16 + pi) * 2;
          float c_a = rp[0], s_a = rp[1], c_b = rp[2], s_b = rp[3];
          o0 = v[0] * c_a - v[1] * s_a; o1 = v[0] * s_a + v[1] * c_a; o2 = v[2] * c_b - v[3] * s_b; o3 = v[2] * s_b + v[3] * c_b; }
        *(u2v*)(Q + (size_t)row * 768 + c0) = pack4(o0 * scale, o1 * scale, o2 * scale, o3 * scale);
      });
      continue;
    }
    t -= NT_Q;
    if (t < NT_KV) {
      int tn = t / TM_KV, tm = t % TM_KV;
      gemm_mainloop<4>((const bf16_t*)(ws + O_CKV), 128, tm * 128, mkv, (const bf16_t*)(ws + O_WKVT), 128, tn * 128, 1024, 128, smem, acc);
      bf16_t* KN = (bf16_t*)(ws + O_KN); bf16_t* VT = (bf16_t*)(ws + O_VT);
      epi_foreach<4>(acc, tm * 128, tn * 128, [&](int row, int c0, f4v& v) {
        if (row >= mkv) return;
        int h = c0 >> 7, w = c0 & 127;
        if (w < 64) *(u2v*)(KN + (size_t)row * 512 + h * 64 + w) = pack4(v[0], v[1], v[2], v[3]);
        else { int sq, key;
          if (row < mg) { sq = row / T; key = row % T; } else { int r = row - mg; sq = r / PAST; key = T + r % PAST; }
#pragma unroll
          for (int e = 0; e < 4; ++e) VT[(((size_t)sq * 8 + h) * 64 + (w - 64 + e)) * nkeys + key] = f2bf(v[e]); }
      });
      continue;
    }
    t -= NT_KV;
    if (t < NT_LORA) {
      int dir = t / (TM_M * 4), r = t % (TM_M * 4), tn = r / TM_M, tm = r % TM_M;
      gemm_mainloop<4>((const bf16_t*)(ws + O_LORA) + dir * 64, 192, tm * 128, mg, (const bf16_t*)(ws + O_WUPT) + (size_t)dir * 512 * 64, 64, tn * 128, 512, 64, smem, acc);
      f4v aa[2][4]; zero_acc<4>(aa);
      gemm_mainloop<4>((const bf16_t*)(ws + O_LORA) + 128, 192, tm * 128, mg, (const bf16_t*)(ws + O_WUPT) + (size_t)(2 + dir) * 512 * 64, 64, tn * 128, 512, 64, smem, aa);
      const float* w0 = p.w0 + ((size_t)l * 2 + dir) * 512; const float* a0 = p.a0 + ((size_t)l * 2 + dir) * 512;
      const float* k_a = p.k_a + (size_t)l * 512; const float* r_k = p.r_k + (size_t)l * 512;
      const bf16_t* SK = (const bf16_t*)(ws + O_SK); bf16_t* SOP = (bf16_t*)(ws + O_SOP); float* BON = (float*)(ws + O_BON);
      const int lane = my_tid() & 63, wid = my_tid() >> 6, wm = wid >> 1, wn = wid & 1;
      const int h = tn * 2 + wn;
#pragma unroll
      for (int i = 0; i < 2; ++i) {
        int row = tm * 128 + wm * 32 + i * 16 + (lane & 15); const bool ok = row < mg; if (!ok) row = mg - 1;
        const int sq = row / T, tt = row % T;
        bf16_t* rec = SOP + (((size_t)sq * 8 + h) * T + tt) * 576;
        float bon = 0.f;
#pragma unroll
        for (int j = 0; j < 4; ++j) {
          const int chn = j * 16 + (lane >> 4) * 4, c = h * 64 + chn;
          u2v k2 = *(const u2v*)(SK + (size_t)row * 512 + c), kk2 = *(const u2v*)(rec + 64 + chn), r2 = *(const u2v*)(rec + chn);
          float kv[4] = {bflo(k2.x), bfhi(k2.x), bflo(k2.y), bfhi(k2.y)}, kkv[4] = {bflo(kk2.x), bfhi(kk2.x), bflo(kk2.y), bfhi(kk2.y)}, rv[4] = {bflo(r2.x), bfhi(r2.x), bflo(r2.y), bfhi(r2.y)};
          float dd[4], bb[4], kt[4];
#pragma unroll
          for (int e = 0; e < 4; ++e) {
            float pw = acc[i][j][e] + w0[c + e], pa = aa[i][j][e] + a0[c + e];
            dd[e] = 1.f - fexp_(-0.6065306597126334f * sigmoidf_(pw));
            float av = sigmoidf_(pa);
            bb[e] = kkv[e] * av; kt[e] = kv[e] * (1.f + (av - 1.f) * k_a[c + e]);
            bon += rv[e] * kt[e] * r_k[c + e];
          }
          if (ok) { *(u2v*)(rec + (3 + 3 * dir) * 64 + chn) = pack4(dd[0], dd[1], dd[2], dd[3]); *(u2v*)(rec + (4 + 3 * dir) * 64 + chn) = pack4(bb[0], bb[1], bb[2], bb[3]);
            *(u2v*)(rec + (5 + 3 * dir) * 64 + chn) = pack4(kt[0], kt[1], kt[2], kt[3]); }
        }
        bon += __shfl_xor(bon, 16); bon += __shfl_xor(bon, 32);
        if (ok && lane < 16) BON[((size_t)row * 8 + h) * 2 + dir] = bon;
      }
      continue;
    }
    t -= NT_LORA;
    if (t < NT_GM) {
      int ch = t >> 2, gg = t & 3;
      gemm_mainloop<4, true>((const bf16_t*)(ws + O_WS) + (size_t)gg * 128 * 128, 128, 0, 128, (const bf16_t*)(ws + O_VCNT) + (size_t)ch * 128 * 512, 512, gg * 128, 512, 128, smem, acc);
      bf16_t* O = (bf16_t*)(ws + O_OBR) + (size_t)2 * MG * 512;
      const float* bs = p.g_b_s + ((size_t)l * 4 + gg) * 128;
      epi_foreach<4>(acc, 0, 0, [&](int pp, int c0, f4v& v) {
        int m = ch * 128 + pp; int c = gg * 128 + c0; float bb = bs[pp];
        u2v uu = *(const u2v*)(Z + (size_t)m * IN_W + ZC_U + c), gc = *(const u2v*)(Z + (size_t)m * IN_W + ZC_GC + c);
        *(u2v*)(O + (size_t)m * 512 + c) = pack4(geluf_(bflo(uu.x)) * (v[0] + bb) * siluf_(bflo(gc.x)), geluf_(bfhi(uu.x)) * (v[1] + bb) * siluf_(bfhi(gc.x)),
                                                 geluf_(bflo(uu.y)) * (v[2] + bb) * siluf_(bflo(gc.y)), geluf_(bfhi(uu.y)) * (v[3] + bb) * siluf_(bfhi(gc.y)));
      });
      continue;
    }
    t -= NT_GM;
    {
      int per_seq = 8 * ntt; int sq = t / per_seq; int r = t % per_seq; int gg = r / (2 * ntt); int r2 = r % (2 * ntt); int tj = r2 / ntt, tt = r2 % ntt;
      long mbase = (long)sq * T;
      gemm_mainloop<4>((const bf16_t*)(ws + O_CS128), 128, tj * 128, 256, Z + (size_t)mbase * IN_W + ZC_F + gg * 128, IN_W, tt * 128, T, 128, smem, acc);
      bf16_t* YT = (bf16_t*)(ws + O_YT) + (size_t)mbase * 1024 + (size_t)gg * 128 * 2 * T;
      epi_foreach<4>(acc, tj * 128, tt * 128, [&](int j, int c0, f4v& v) {
        *(u2v*)(YT + (size_t)(j & 127) * 2 * T + (size_t)(j >> 7) * T + c0) = pack4(v[0], v[1], v[2], v[3]);
      });
    }
  }
}

__device__ __forceinline__ bool wave_any(bool pr) {
#ifdef EMU
  return wave_sum(pr ? 1.f : 0.f) > 0.f;
#else
  return __builtin_amdgcn_ballot_w64(pr) != 0ull;
#endif
}
__device__ __forceinline__ void attention_task(const Params& p, const Grp& g, int sq, int h, int qb32) {
  char* ws = p.ws;
  const int lane = my_tid() & 63, ql = lane & 31, hh = lane >> 5;
  const int T = g.T, nkeys = g.nkeys;
  const long mbase = (long)sq * T;
  const bf16_t* Q = (const bf16_t*)(ws + O_Q); const bf16_t* KN = (const bf16_t*)(ws + O_KN); const bf16_t* KRp = (const bf16_t*)(ws + O_KR);
  const bf16_t* VT = (const bf16_t*)(ws + O_VT) + ((size_t)sq * 8 + h) * 64 * nkeys;
  const long mq = mbase + qb32 * 32 + ql;
  s8v qf[6];
#pragma unroll
  for (int s = 0; s < 6; ++s) qf[s] = *(const s8v*)(Q + (size_t)mq * 768 + h * 96 + 16 * s + 8 * hh);
  f16v o0, o1;
#pragma unroll
  for (int i = 0; i < 16; ++i) { o0[i] = 0.f; o1[i] = 0.f; }
  float mrun = -1e30f, lrun = 0.f;
  s8v kf[6], vf[4];
#define ATT_LOAD(k0_, KF, VF) do { const int kk0 = (k0_); \
    const long krow = (kk0 < T) ? mbase + kk0 + ql : (long)g.mg + (long)sq * PAST + (kk0 - T) + ql; \
    _Pragma("unroll") for (int st = 0; st < 4; ++st) KF[st] = *(const s8v*)(KN + (size_t)krow * 512 + h * 64 + 16 * st + 8 * hh); \
    _Pragma("unroll") for (int st = 0; st < 2; ++st) KF[4 + st] = *(const s8v*)(KRp + (size_t)krow * 32 + 16 * st + 8 * hh); \
    _Pragma("unroll") for (int st = 0; st < 2; ++st) _Pragma("unroll") for (int db = 0; db < 2; ++db) { \
      const bf16_t* vp = VT + (size_t)(db * 32 + ql) * nkeys + kk0 + 16 * st + 4 * hh; \
      u2v a_ = *(const u2v*)vp, b_ = *(const u2v*)(vp + 8); VF[st * 2 + db] = __builtin_bit_cast(s8v, u4v{a_.x, a_.y, b_.x, b_.y}); } } while (0)
  for (int k0 = 0; k0 < nkeys; k0 += 32) {
    ATT_LOAD(k0, kf, vf);
    f16v s;
#pragma unroll
    for (int i = 0; i < 16; ++i) s[i] = 0.f;
#pragma unroll
    for (int st = 0; st < 6; ++st) s = __builtin_amdgcn_mfma_f32_32x32x16_bf16(kf[st], qf[st], s, 0, 0, 0);
    float mx = s[0];
#pragma unroll
    for (int i = 1; i < 16; ++i) mx = fmaxf(mx, s[i]);
    mx = fmaxf(mx, __shfl_xor(mx, 32));
    if (wave_any(mx > mrun)) {
      const float mnew = fmaxf(mrun, mx); const float alpha = fexp2_(mrun - mnew); mrun = mnew;
      lrun *= alpha;
#pragma unroll
      for (int i = 0; i < 16; ++i) { o0[i] *= alpha; o1[i] *= alpha; }
    }
    float ps = 0.f; float pe[16];
#pragma unroll
    for (int i = 0; i < 16; ++i) { pe[i] = fexp2_(s[i] - mrun); ps += pe[i]; }
    lrun += ps;
#pragma unroll
    for (int st = 0; st < 2; ++st) {
      const s8v pf = __builtin_bit_cast(s8v, u4v{pk2bf(pe[8 * st], pe[8 * st + 1]), pk2bf(pe[8 * st + 2], pe[8 * st + 3]), pk2bf(pe[8 * st + 4], pe[8 * st + 5]), pk2bf(pe[8 * st + 6], pe[8 * st + 7])});
      o0 = __builtin_amdgcn_mfma_f32_32x32x16_bf16(vf[st * 2], pf, o0, 0, 0, 0);
      o1 = __builtin_amdgcn_mfma_f32_32x32x16_bf16(vf[st * 2 + 1], pf, o1, 0, 0, 0);
    }
  }
#undef ATT_LOAD
  const float ltot = lrun + __shfl_xor(lrun, 32); const float inv = 1.f / ltot;
  const bf16_t* Z = (const bf16_t*)(ws + O_Z);
  bf16_t* O = (bf16_t*)(ws + O_OBR) + (size_t)1 * MG * 512;
#pragma unroll
  for (int db = 0; db < 2; ++db)
#pragma unroll
    for (int q4 = 0; q4 < 4; ++q4) {
      const int dv = db * 32 + 8 * q4 + 4 * hh;
      u2v gt = *(const u2v*)(Z + (size_t)mq * IN_W + ZC_GB + h * 64 + dv);
      const float x0 = (db == 0 ? o0[4 * q4] : o1[4 * q4]) * inv, x1 = (db == 0 ? o0[4 * q4 + 1] : o1[4 * q4 + 1]) * inv, x2 = (db == 0 ? o0[4 * q4 + 2] : o1[4 * q4 + 2]) * inv, x3 = (db == 0 ? o0[4 * q4 + 3] : o1[4 * q4 + 3]) * inv;
      *(u2v*)(O + (size_t)mq * 512 + h * 64 + dv) = pack4(x0 * siluf_(bflo(gt.x)), x1 * siluf_(bfhi(gt.x)), x2 * siluf_(bflo(gt.y)), x3 * siluf_(bfhi(gt.y)));
    }
}

__device__ __forceinline__ void stage_dft2(const Params& p, const Grp& g, int bid, int nb, char* smem) {
  char* ws = p.ws;
  const bf16_t* Z = (const bf16_t*)(ws + O_Z);
  const int T = g.T, ntt = T / 128;
  const int NT_D2 = g.nseq * 4 * ntt;
  const int soff = (g.nseq * 32) % nb;
  for (int t = (bid - soff + nb) % nb; t < NT_D2; t += nb) {
    int sq = t / (4 * ntt), r = t % (4 * ntt), gg = r / ntt, tt = r % ntt;
    long mbase = (long)sq * T;
    f4v acc[2][4]; zero_acc<4>(acc);
    gemm_mainloop<4>((const bf16_t*)(ws + (g.isden ? O_A2D : O_A2C)), 2 * T, tt * 128, T, (const bf16_t*)(ws + O_YT) + (size_t)mbase * 1024 + (size_t)gg * 128 * 2 * T, 2 * T, 0, 128, 2 * T, smem, acc);
    bf16_t* O = (bf16_t*)(ws + O_OBR) + (size_t)3 * MG * 512;
    const float sc = rsqrtf(128.f * (float)T);
    epi_foreach<4>(acc, tt * 128, 0, [&](int row, int c0, f4v& v) {
      long m = mbase + row; int c = gg * 128 + c0; u2v gd = *(const u2v*)(Z + (size_t)m * IN_W + ZC_GD + c);
      *(u2v*)(O + (size_t)m * 512 + c) = pack4(v[0] * sc * siluf_(bflo(gd.x)), v[1] * sc * siluf_(bfhi(gd.x)), v[2] * sc * siluf_(bflo(gd.y)), v[3] * sc * siluf_(bfhi(gd.y)));
    });
  }
}

constexpr int PL_STR = 72;
constexpr int PCH_MA = 0, PCH_MB = 4608, PCH_TBT = 9216, PCH_MBT = 10240, PCH_TK = 11264, PCH_MK = 12288, PCH_LDS = 13312;
__device__ __forceinline__ void pchunk_task(const Params& p, const Grp& g, int task, char* wl) {
  char* ws = p.ws;
  const int lane = my_tid() & 63, ql = lane & 31, hh = lane >> 5;
  const int T = g.T, nch = T >> 4;
  const int ch = task / nch, ci = task % nch;
  const int dir = ch & 1, h = (ch >> 1) & 7, sq = ch >> 4;
  const bf16_t* rec0 = (const bf16_t*)(ws + O_SOP) + ((size_t)sq * 8 + h) * T * 576;
  char* cm = ws + O_CM + (size_t)task * CM_REC;
  float At[16], Rt[16], Bh[16], Kh[16]; float W = 1.f;
#pragma unroll
  for (int j = 0; j < 16; ++j) {
    const int st = ci * 16 + j, tt = dir ? T - 1 - st : st;
    const bf16_t* rec = rec0 + (size_t)tt * 576;
    const float r = bf2f(rec[lane]), kk = bf2f(rec[64 + lane]), d = bf2f(rec[(3 + 3 * dir) * 64 + lane]), b = bf2f(rec[(4 + 3 * dir) * 64 + lane]), kt = bf2f(rec[(5 + 3 * dir) * 64 + lane]);
    At[j] = -kk * W; W *= (1.f - d); const float iw = 1.f / W; Rt[j] = r * W; Bh[j] = b * iw; Kh[j] = kt * iw;
  }
  {
    float x[8];
#pragma unroll
    for (int q = 0; q < 4; ++q) {
#pragma unroll
      for (int e = 0; e < 8; ++e) x[e] = (q < 2 ? Bh[q * 8 + e] : Kh[(q - 2) * 8 + e]) * W;
      *(u4v*)(cm + CM_BKT + lane * 64 + q * 16) = pack8(x);
    }
    *(float*)(cm + CM_WL + lane * 4) = W;
  }
  bf16_t* MA = (bf16_t*)(wl + PCH_MA); bf16_t* MB = (bf16_t*)(wl + PCH_MB);
  float* TBT = (float*)(wl + PCH_TBT); float* MBT = (float*)(wl + PCH_MBT); float* TK = (float*)(wl + PCH_TK); float* MK = (float*)(wl + PCH_MK);
  WAVE_SYNC();
#pragma unroll
  for (int j = 0; j < 16; ++j) { MA[j * PL_STR + lane] = f2bf(Bh[j]); MA[(16 + j) * PL_STR + lane] = f2bf(Kh[j]); MB[j * PL_STR + lane] = f2bf(At[j]); MB[(16 + j) * PL_STR + lane] = f2bf(Rt[j]); }
  WAVE_SYNC();
  f16v D;
#pragma unroll
  for (int i = 0; i < 16; ++i) D[i] = 0.f;
#pragma unroll
  for (int s4 = 0; s4 < 4; ++s4) {
    const s8v fa = *(const s8v*)(MA + ql * PL_STR + 16 * s4 + 8 * hh), fb = *(const s8v*)(MB + ql * PL_STR + 16 * s4 + 8 * hh);
    D = __builtin_amdgcn_mfma_f32_32x32x16_bf16(fa, fb, D, 0, 0, 0);
  }
#pragma unroll
  for (int r = 0; r < 16; ++r) {
    const int i = (r & 3) + 8 * (r >> 2) + 4 * hh; const float v = D[r];
    if (r < 8) { if (ql < 16) TBT[ql * 16 + i] = (i < ql) ? v : 0.f; else MBT[(ql - 16) * 16 + i] = (i <= ql - 16) ? v : 0.f; }
    else { const int i2 = i - 16; if (ql < 16) TK[i2 * 16 + ql] = (i2 < ql) ? v : 0.f; else MK[i2 * 16 + (ql - 16)] = (i2 <= ql - 16) ? v : 0.f; }
  }
  WAVE_SYNC();
  const int l16 = lane & 15;
  float Z[16], Z2[16];
#pragma unroll
  for (int j = 0; j < 16; ++j) { Z[j] = 0.f; Z2[j] = 0.f; }
#pragma unroll
  for (int j = 0; j < 16; ++j) {
    float a1 = At[j], a2 = TK[l16 * 16 + j];
#pragma unroll
    for (int c4 = 0; c4 * 4 < j; ++c4) { const f4v tv = *(const f4v*)(TBT + j * 16 + c4 * 4);
#pragma unroll
      for (int e = 0; e < 4; ++e) if (c4 * 4 + e < j) { a1 += Z[c4 * 4 + e] * tv[e]; a2 += Z2[c4 * 4 + e] * tv[e]; } }
    Z[j] = a1; Z2[j] = a2;
  }
  bf16_t* GT = (bf16_t*)(cm + CM_GT);
#pragma unroll
  for (int t = 0; t < 16; ++t) {
    float a1 = Rt[t], a2 = MK[l16 * 16 + t];
#pragma unroll
    for (int c4 = 0; c4 * 4 <= t; ++c4) { const f4v mv = *(const f4v*)(MBT + t * 16 + c4 * 4);
#pragma unroll
      for (int e = 0; e < 4; ++e) if (c4 * 4 + e <= t) { a1 += Z[c4 * 4 + e] * mv[e]; a2 += Z2[c4 * 4 + e] * mv[e]; } }
    GT[(16 + t) * 80 + lane] = f2bf(a1);
    if (lane < 16) GT[(16 + t) * 80 + 64 + lane] = f2bf(a2);
  }
#pragma unroll
  for (int j = 0; j < 16; ++j) { GT[j * 80 + lane] = f2bf(Z[j]); if (lane < 16) GT[j * 80 + 64 + lane] = f2bf(Z2[j]); }
}

__device__ __forceinline__ s8v cvt8(const f16v& a, int o) {
  return __builtin_bit_cast(s8v, u4v{pk2bf(a[o], a[o + 1]), pk2bf(a[o + 2], a[o + 3]), pk2bf(a[o + 4], a[o + 5]), pk2bf(a[o + 6], a[o + 7])});
}
struct ScanOps { s8v gA[5], bU[2], bV[2], vf; f4v wl[8]; };
__device__ __forceinline__ void scan2_load(ScanOps& o, const char* cm, const bf16_t* rec0, int ci, int T, int dir, int ql, int hh, int row) {
  const bf16_t* GT = (const bf16_t*)(cm + CM_GT); const bf16_t* BKT = (const bf16_t*)(cm + CM_BKT); const float* WL = (const float*)(cm + CM_WL);
#pragma unroll
  for (int s = 0; s < 4; ++s) { const bf16_t* q = GT + ql * 80 + 16 * s + 4 * hh; u2v lo = *(const u2v*)q, hi = *(const u2v*)(q + 8); o.gA[s] = __builtin_bit_cast(s8v, u4v{lo.x, lo.y, hi.x, hi.y}); }
  o.gA[4] = *(const s8v*)(GT + ql * 80 + 64 + 8 * hh);
#pragma unroll
  for (int k2 = 0; k2 < 2; ++k2) { const bf16_t* q = BKT + (32 * k2 + ql) * 32; u2v lo = *(const u2v*)(q + 4 * hh), hi = *(const u2v*)(q + 8 + 4 * hh);
    o.bU[k2] = __builtin_bit_cast(s8v, u4v{lo.x, lo.y, hi.x, hi.y}); o.bV[k2] = *(const s8v*)(q + 16 + 8 * hh); }
#pragma unroll
  for (int i = 0; i < 8; ++i) o.wl[i] = *(const f4v*)(WL + 32 * (i >> 2) + 8 * (i & 3) + 4 * hh);
#pragma unroll
  for (int j = 0; j < 8; ++j) { const int st = ci * 16 + 8 * hh + j, tt = dir ? T - 1 - st : st; o.vf[j] = (short)rec0[(size_t)tt * 576 + 128 + row]; }
}
__device__ __forceinline__ void scan2_task(const Params& p, const Grp& g, int l, int task) {
  char* ws = p.ws;
  const int lane = my_tid() & 63, ql = lane & 31, hh = lane >> 5;
  const int T = g.T, nch = T >> 4;
  const int ch = task >> 1, rt = task & 1;
  const int dir = ch & 1, h = (ch >> 1) & 7, sq = ch >> 4;
  const int row = rt * 32 + ql;
  const long mbase = (long)sq * T;
  const bf16_t* rec0 = (const bf16_t*)(ws + O_SOP) + ((size_t)sq * 8 + h) * T * 576;
  const char* cm0 = ws + O_CM + (size_t)ch * nch * CM_REC;
  float* YS = (float*)(ws + O_YS) + (size_t)dir * MG * 512;
  f16v a0, a1;
  if (g.isden) { const float* st = (dir ? p.st_b : p.st_f) + ((((size_t)sq * NL + l) * 8 + h) * 64 + row) * 64;
#pragma unroll
    for (int q = 0; q < 4; ++q) { f4v x = *(const f4v*)(st + 8 * q + 4 * hh), y = *(const f4v*)(st + 32 + 8 * q + 4 * hh);
#pragma unroll
      for (int e = 0; e < 4; ++e) { a0[4 * q + e] = x[e]; a1[4 * q + e] = y[e]; } } }
  else {
#pragma unroll
    for (int i = 0; i < 16; ++i) { a0[i] = 0.f; a1[i] = 0.f; } }
  ScanOps cur, nxt;
  scan2_load(cur, cm0, rec0, 0, T, dir, ql, hh, row);
  for (int ci = 0; ci < nch; ++ci) {
    if (ci + 1 < nch) scan2_load(nxt, cm0 + (size_t)(ci + 1) * CM_REC, rec0, ci + 1, T, dir, ql, hh, row);
    f16v D;
#pragma unroll
    for (int i = 0; i < 16; ++i) D[i] = 0.f;
    D = __builtin_amdgcn_mfma_f32_32x32x16_bf16(cur.gA[0], cvt8(a0, 0), D, 0, 0, 0);
    D = __builtin_amdgcn_mfma_f32_32x32x16_bf16(cur.gA[1], cvt8(a0, 8), D, 0, 0, 0);
    D = __builtin_amdgcn_mfma_f32_32x32x16_bf16(cur.gA[2], cvt8(a1, 0), D, 0, 0, 0);
    D = __builtin_amdgcn_mfma_f32_32x32x16_bf16(cur.gA[3], cvt8(a1, 8), D, 0, 0, 0);
    D = __builtin_amdgcn_mfma_f32_32x32x16_bf16(cur.gA[4], cur.vf, D, 0, 0, 0);
#pragma unroll
    for (int i = 0; i < 8; ++i) { const int st = ci * 16 + (i & 3) + 8 * (i >> 2) + 4 * hh, tt = dir ? T - 1 - st : st; YS[(size_t)(mbase + tt) * 512 + h * 64 + row] = D[8 + i]; }
    const s8v uf = cvt8(D, 0);
#pragma unroll
    for (int i = 0; i < 16; ++i) { a0[i] *= cur.wl[i >> 2][i & 3]; a1[i] *= cur.wl[4 + (i >> 2)][i & 3]; }
    a0 = __builtin_amdgcn_mfma_f32_32x32x16_bf16(cur.bU[0], uf, a0, 0, 0, 0);
    a0 = __builtin_amdgcn_mfma_f32_32x32x16_bf16(cur.bV[0], cur.vf, a0, 0, 0, 0);
    a1 = __builtin_amdgcn_mfma_f32_32x32x16_bf16(cur.bU[1], uf, a1, 0, 0, 0);
    a1 = __builtin_amdgcn_mfma_f32_32x32x16_bf16(cur.bV[1], cur.vf, a1, 0, 0, 0);
    cur = nxt;
  }
  if (!g.isden) { float* so = p.out + (dir ? OUT_SB : OUT_SF) + ((((size_t)(g.b0 + sq) * NL + l) * 8 + h) * 64 + row) * 64;
#pragma unroll
    for (int q = 0; q < 4; ++q) { *(f4v*)(so + 8 * q + 4 * hh) = f4v{a0[4 * q], a0[4 * q + 1], a0[4 * q + 2], a0[4 * q + 3]}; *(f4v*)(so + 32 + 8 * q + 4 * hh) = f4v{a1[4 * q], a1[4 * q + 1], a1[4 * q + 2], a1[4 * q + 3]}; } }
}

__device__ __forceinline__ void stage_mixA(const Params& p, const Grp& g, int bid, int nb, char* smem) {
  const int wid = my_tid() >> 6;
  const int NP = g.nseq * 16 * (g.T >> 4), q32 = g.T / 32, NA = g.nseq * 8 * q32;
  char* wl = smem + wid * PCH_LDS;
  for (int task = wid * nb + bid; task < NP + NA; task += nb * NWAVE) {
    if (task < NP) pchunk_task(p, g, task, wl);
    else { int t = task - NP; int sq = t / (8 * q32), r = t % (8 * q32); attention_task(p, g, sq, r / q32, r % q32); }
  }
}
__device__ __forceinline__ void stage_scanS(const Params& p, const Grp& g, int l, int bid, int nb) {
  const int wid = my_tid() >> 6;
  const int NS = g.nseq * 32;
  for (int task = wid * nb + bid; task < NS; task += nb * NWAVE) scan2_task(p, g, l, task);
}

__device__ __forceinline__ void stage_e3(const Params& p, const Grp& g, int l, int bid, int nb) {
  const int lane = my_tid() & 63, wid = my_tid() >> 6;
  char* ws = p.ws;
  const float* YS = (const float*)(ws + O_YS); const bf16_t* SOP = (const bf16_t*)(ws + O_SOP); const float* BON = (const float*)(ws + O_BON); const int T = g.T;
  const bf16_t* Z = (const bf16_t*)(ws + O_Z); bf16_t* O = (bf16_t*)(ws + O_OBR);
  for (int m = bid * NWAVE + wid; m < g.mg; m += nb * NWAVE) {
#pragma unroll 2
    for (int i = 0; i < 8; ++i) {
      int c = lane + 64 * i;
      float o = YS[(size_t)m * 512 + c] + YS[((size_t)MG + m) * 512 + c];
      float mean = wave_sum(o) * (1.f / 64.f); float d = o - mean; float var = wave_sum(d * d) * (1.f / 64.f);
      float y = d * rsqrtf(var + 64e-5f) * p.ln_g[(size_t)l * 512 + c] + p.ln_b[(size_t)l * 512 + c] + (BON[((size_t)m * 8 + i) * 2] + BON[((size_t)m * 8 + i) * 2 + 1]) * bf2f(SOP[(((size_t)(m / T) * 8 + i) * T + (m % T)) * 576 + 128 + lane]);
      O[(size_t)m * 512 + c] = f2bf(y * siluf_(bf2f(Z[(size_t)m * IN_W + ZC_GA + c])));
    }
  }
}

__device__ __forceinline__ void stage_gates(const Params& p, const Grp& g, int l, int bid, int nb, char* smem) {
  const bf16_t* H = (const bf16_t*)(p.ws + O_H);
  const bf16_t* W = (const bf16_t*)(p.ws + O_WMT);
  bf16_t* GT = (bf16_t*)(p.ws + O_GATES);
  const float* bm = p.b_merge + (size_t)l * 4096;
#ifndef EMU
  if ((g.mg & 255) == 0) {
    pg8::Gemm gm; gm.A = H; gm.Bt = W; gm.M = g.mg; gm.N = 4096; gm.K = 1024;
    pg8::StaticOrder S; S.init(gm.M, gm.N, nb, bid);
    pg8::EpiSigmoid E; E.O = GT; E.ldc = 4096; E.bias = bm;
    pg8::gemm_phase<pg8::EpiSigmoid, pg8::StaticOrder>((PG8_LAS unsigned char*)smem, gm, S, E);
    return;
  }
#endif
  const int TM = (g.mg + 127) / 128, mg = g.mg;
  for (int t = bid; t < TM * 32; t += nb) {
    int tn = t / TM, tm = t % TM; f4v acc[2][4]; zero_acc<4>(acc);
    gemm_mainloop<4>(H, 1024, tm * 128, mg, W, 1024, tn * 128, 4096, 1024, smem, acc);
    epi_foreach<4>(acc, tm * 128, tn * 128, [&](int row, int c0, f4v& v) {
      if (row < mg) *(u2v*)(GT + (size_t)row * 4096 + c0) = pack4(sigmoidf_(v[0] + bm[c0]), sigmoidf_(v[1] + bm[c0 + 1]), sigmoidf_(v[2] + bm[c0 + 2]), sigmoidf_(v[3] + bm[c0 + 3]));
    });
  }
}

__device__ __forceinline__ void stage_g8(const Params& p, const Grp& g, int l, int bid, int nb, char* smem) {
  char* ws = p.ws;
  bf16_t* MGD = (bf16_t*)(ws + O_MERGED);
  const bf16_t* GT = (const bf16_t*)(ws + O_GATES);
  const int TM = (g.mg + 127) / 128, mg = g.mg;
  for (int t = bid; t < TM * 8; t += nb) {
    int tn = t / TM, tm = t % TM;
    f4v macc[2][4]; zero_acc<4>(macc);
    for (int n = 0; n < 4; ++n) {
      f4v ap[2][4]; zero_acc<4>(ap);
      gemm_mainloop<4>((const bf16_t*)(ws + O_OBR) + (size_t)n * MG * 512, 512, tm * 128, mg, (const bf16_t*)(ws + O_WBRT) + (size_t)n * 1024 * 512, 512, tn * 128, 1024, 512, smem, ap);
      const int lane = my_tid() & 63, wid = my_tid() >> 6, wm = wid >> 1, wn = wid & 1;
#pragma unroll
      for (int i = 0; i < 2; ++i)
#pragma unroll
        for (int j = 0; j < 4; ++j) {
          int row = tm * 128 + wm * 32 + i * 16 + (lane & 15); row = row < mg ? row : mg - 1;
          int c0 = tn * 128 + wn * 64 + j * 16 + (lane >> 4) * 4;
          u2v gt = *(const u2v*)(GT + (size_t)row * 4096 + n * 1024 + c0);
          macc[i][j][0] += bflo(gt.x) * ap[i][j][0]; macc[i][j][1] += bfhi(gt.x) * ap[i][j][1]; macc[i][j][2] += bflo(gt.y) * ap[i][j][2]; macc[i][j][3] += bfhi(gt.y) * ap[i][j][3];
        }
    }
    epi_foreach<4>(macc, tm * 128, tn * 128, [&](int row, int c0, f4v& v) {
      if (row < mg) *(u2v*)(MGD + (size_t)row * 1024 + c0) = pack4(v[0], v[1], v[2], v[3]);
    });
  }
  (void)l;
}

__device__ __forceinline__ void stage_g9(const Params& p, const Grp& g, int l, int bid, int nb, char* smem) {
  char* ws = p.ws;
  float* X = p.out + (size_t)g.m0 * 1024;
  const float* modp = (const float*)(ws + O_MOD) + (size_t)l * 3 * 3072 + 2048;
  const int TM = (g.mg + 127) / 128, mg = g.mg;
  for (int t = bid; t < TM * 8; t += nb) {
    int tn = t / TM, tm = t % TM;
    f4v acc[2][4]; zero_acc<4>(acc);
    gemm_mainloop<4>((const bf16_t*)(ws + O_MERGED), 1024, tm * 128, mg, (const bf16_t*)(ws + O_WOUTT), 1024, tn * 128, 1024, 1024, smem, acc);
    epi_foreach<4>(acc, tm * 128, tn * 128, [&](int row, int c0, f4v& v) {
      if (row < mg) { const float* gt = modp + (size_t)mod_index(g, row) * 3072 + c0; f4v* xp = (f4v*)(X + (size_t)row * 1024 + c0); f4v x = *xp;
        x[0] += gt[0] * v[0]; x[1] += gt[1] * v[1]; x[2] += gt[2] * v[2]; x[3] += gt[3] * v[3]; *xp = x; }
    });
  }
}

__device__ __forceinline__ void stage_final(const Params& p, int bid, int nb) {
  const int lane = my_tid() & 63, wid = my_tid() >> 6;
  for (int m = bid * NWAVE + wid; m < M; m += nb * NWAVE) {
    float* xr = p.out + (size_t)m * 1024; float4 q[4]; float ss = 0.f;
#pragma unroll
    for (int i = 0; i < 4; ++i) { q[i] = *(const float4*)(xr + i * 256 + lane * 4); ss += q[i].x * q[i].x + q[i].y * q[i].y + q[i].z * q[i].z + q[i].w * q[i].w; }
    ss = wave_sum(ss); float rs = rsqrtf(ss * (1.f / 1024.f) + 1e-6f);
#pragma unroll
    for (int i = 0; i < 4; ++i) { int c = i * 256 + lane * 4; float4 gm = *(const float4*)(p.final_g + c);
      *(float4*)(xr + c) = make_float4(q[i].x * rs * gm.x, q[i].y * rs * gm.y, q[i].z * rs * gm.z, q[i].w * rs * gm.w); }
  }
}

#ifdef EMU
#define DECL_SMEM(name) char* name = emu::smem()
#else
#define DECL_SMEM(name) __shared__ __attribute__((aligned(16))) char name[SMEM_BYTES]
#endif

#ifdef EMU
struct GridBar { __device__ void sync() const { emu::grid_sync(); } };
#else
#define XB_TMO      128
#define XB_XCNT(j)  (256  + 64 * (j))
#define XB_XSUB(j)  (1280 + 64 * (j))
#define XB_XGEN(j)  (2304 + 64 * (j))
#define XB_TOP      3328
#define XB_TOPGEN   3392
#define XB_SPIN_CAP (1u << 20)
#define LAS __attribute__((address_space(3)))
__device__ __forceinline__ unsigned xb_ld(unsigned* p)              { return __hip_atomic_load(p, __ATOMIC_RELAXED, __HIP_MEMORY_SCOPE_AGENT); }
__device__ __forceinline__ unsigned xb_add(unsigned* p, unsigned v) { return __hip_atomic_fetch_add(p, v, __ATOMIC_RELAXED, __HIP_MEMORY_SCOPE_AGENT); }
__device__ __forceinline__ unsigned xb_xcc_id() { return (unsigned)__builtin_amdgcn_s_getreg((3 << 11) | 20) & 0xFu; }
#define XB_SPIN(cond, bar) do { unsigned _sp = 0; while (cond) { __builtin_amdgcn_s_sleep(1); \
    if ((++_sp & 255u) == 0u) { if (xb_ld(&(bar)[XB_TMO])) break; if (_sp > XB_SPIN_CAP) { atomicAdd(&(bar)[XB_TMO], 1u); break; } } } } while (0)
struct GridBar {
  unsigned* bar; unsigned x; volatile LAS unsigned* st;
  __device__ __forceinline__ void post(unsigned* b, volatile LAS unsigned* s_) {
    bar = b; x = xb_xcc_id(); st = s_;
    if (threadIdx.x == 0) (void)xb_add(&bar[XB_XCNT(x)], 1u);
  }
  __device__ __forceinline__ void complete(unsigned& nloc, unsigned& nx) const {
    const unsigned G = gridDim.x;
    unsigned sum, cnt, mine, sp = 0u;
    for (;;) {
      sum = 0u; cnt = 0u; mine = 0u;
#pragma unroll
      for (unsigned j = 0; j < 16; ++j) { const unsigned c = xb_ld(&bar[XB_XCNT(j)]); sum += c; cnt += (c > 0u) ? 1u : 0u; mine = (j == x) ? c : mine; }
      if (sum == G) break;
      __builtin_amdgcn_s_sleep(1);
      if ((++sp & 255u) == 0u) { if (xb_ld(&bar[XB_TMO])) break; if (sp > XB_SPIN_CAP) { atomicAdd(&bar[XB_TMO], 1u); break; } }
    }
    nloc = mine > 0u ? mine : 1u; nx = cnt > 0u ? cnt : 1u;
  }
  __device__ __forceinline__ void sync() const {
    asm volatile("s_waitcnt vmcnt(0)" ::: "memory");
    __syncthreads();
    if (threadIdx.x == 0) {
      __builtin_amdgcn_s_waitcnt(0);
      unsigned nloc = st[0], nx = st[1];
      if (nloc == 0u) { complete(nloc, nx); st[0] = nloc; st[1] = nx; }
      const unsigned old = xb_add(&bar[XB_XSUB(x)], 1u);
      const unsigned gen = old / nloc;
      if (old + 1u == (gen + 1u) * nloc) {
        __builtin_amdgcn_fence(__ATOMIC_RELEASE, "agent");
        asm volatile("s_waitcnt vmcnt(0)" ::: "memory");
        const unsigned og = xb_add(&bar[XB_TOP], 1u);
        const unsigned tg = og / nx;
        if (og + 1u == (tg + 1u) * nx) xb_add(&bar[XB_TOPGEN], 1u);
        else XB_SPIN(xb_ld(&bar[XB_TOPGEN]) == tg, bar);
        __builtin_amdgcn_fence(__ATOMIC_ACQUIRE, "agent");
        xb_add(&bar[XB_XGEN(x)], 1u);
        asm volatile("s_waitcnt vmcnt(0)" ::: "memory");
      } else {
        XB_SPIN(xb_ld(&bar[XB_XGEN(x)]) == gen, bar);
        __builtin_amdgcn_fence(__ATOMIC_ACQUIRE, "agent");
        asm volatile("s_waitcnt vmcnt(0)" ::: "memory");
      }
    }
    __syncthreads();
  }
};
#endif

#ifndef EMU
namespace cg = cooperative_groups;
#else
namespace cg = cooperative_groups;
#endif

__global__ void __launch_bounds__(NTHR) mega_kernel(Params p) {
  DECL_SMEM(smem);
  cg::grid_group grid = cg::this_grid();
  const int bid0 = blockIdx.x, nb0 = gridDim.x;
  GridBar gb;
#ifndef EMU
  if (threadIdx.x == 0) { volatile LAS unsigned* w = (volatile LAS unsigned*)(smem + SMEM_STAGE); w[0] = 0u; w[1] = 0u; w[2] = 0u; w[3] = 0u; }
  __syncthreads();
  gb.post((unsigned*)(p.ws + O_BAR), (volatile LAS unsigned*)(smem + SMEM_STAGE));
#endif
#ifndef PROBE_DUP
#define PROBE_DUP 0
#endif
#define STG(call) do { Params q = p; q.ws = opaque(q.ws); q.out = opaque(q.out); const int bid = opaque_i(bid0); const int nb = opaque_i(nb0); call; } while (0)
#define STP(bit, call) do { STG(call); if (PROBE_DUP & (bit)) { STG(call); } } while (0)
  for (int l = 0; l < NL; ++l) {
    STP(1, stage_prep(q, l, bid, nb, smem));
    if (l == 0) grid.sync();
    { Grp g0 = get_grp(0); STP(2, stage_h(q, g0, l, bid, nb)); }
    gb.sync();
    for (int gi = 0; gi < NGRP; ++gi) {
      Grp g = get_grp(gi);
      STP(4, stage_g1(q, g, bid, nb, smem)); gb.sync();
      STP(8, stage_e1(q, g, l, bid, nb)); gb.sync();
      STP(16, stage_g2(q, g, l, bid, nb, smem)); gb.sync();
      STP(64, stage_mixA(q, g, bid, nb, smem)); gb.sync();
      STP(32, stage_scanS(q, g, l, bid, nb));
      STP(128, stage_dft2(q, g, bid, nb, smem)); gb.sync();
      STP(256, stage_e3(q, g, l, bid, nb));
      STP(512, stage_gates(q, g, l, bid, nb, smem)); gb.sync();
      STP(1024, stage_g8(q, g, l, bid, nb, smem)); gb.sync();
      STG(stage_g9(q, g, l, bid, nb, smem));
      if (gi + 1 < NGRP) { Grp gn = get_grp(gi + 1); STP(2, stage_h(q, gn, l, bid, nb)); }
      gb.sync();
    }
  }
  STG(stage_final(q, bid, nb));
#undef STP
#undef STG
}

extern "C" void kernel_launch(void* const* d_in, const int* in_sizes, int n_in, void* d_out, int out_size, void* d_ws, size_t ws_size,
                              hipStream_t stream) {
  Params p{};
  const float** pp = (const float**)&p;
  for (int i = 0; i < 35; ++i) pp[i] = (const float*)d_in[i];
  p.out = (float*)d_out; p.ws = (char*)d_ws;
#ifdef EMU
  emu::set_coop(true);
  emu_launch(dim3(8), dim3(NTHR), [=]() { mega_kernel(p); });
  emu::set_coop(false);
#else
  static int grid_blocks = 0;
  if (!grid_blocks) {
    int dev = 0, cus = 0, per_cu = 0;
    (void)hipGetDevice(&dev);
    (void)hipDeviceGetAttribute(&cus, hipDeviceAttributeMultiprocessorCount, dev);
    (void)hipOccupancyMaxActiveBlocksPerMultiprocessor(&per_cu, mega_kernel, NTHR, 0);
    if (per_cu > 1) per_cu = 1;
    if (per_cu < 1) per_cu = 1;
    grid_blocks = cus * per_cu;
  }
  (void)hipMemsetAsync((char*)d_ws + O_BAR, 0, BAR_BYTES, stream);
  void* args[] = {&p};
  (void)hipLaunchCooperativeKernel((void*)mega_kernel, dim3(grid_blocks), dim3(NTHR), args, 0, stream);
#endif
  (void)in_sizes; (void)n_in; (void)out_size; (void)ws_size;
}
```

```cpp
#ifdef EMU
#include "hip_emu.h"
#else
#include <hip/hip_runtime.h>
#include <hip/hip_cooperative_groups.h>
#endif
#include <stdint.h>

#ifndef CFG_BATCH
#define CFG_BATCH 32
#define CFG_SEQ 256
#define CFG_DEC_BATCH 2
#define CFG_DEC_SEQ 2048
#define CFG_PAST 512
#define CFG_NGRP_C 2
#endif
constexpr int D = 1024, NL = 2;
constexpr int NB_C = CFG_BATCH, T_C = CFG_SEQ, NB_D = CFG_DEC_BATCH, T_D = CFG_DEC_SEQ, PAST = CFG_PAST;
constexpr int M_C = NB_C * T_C, M_D = NB_D * T_D, M = M_C + M_D;
constexpr int NGRP_C = CFG_NGRP_C, NGRP = 1 + NGRP_C;
constexpr int MGC = M_C / NGRP_C, SEQ_PER_CG = NB_C / NGRP_C;
constexpr int MG = MGC > M_D ? MGC : M_D;
constexpr int MKV = MG + NB_D * PAST;
constexpr int KEYS_D = T_D + PAST;
constexpr int IN_W = 5728;
constexpr int ZC_R = 0, ZC_K = 512, ZC_V = 1024, ZC_WDF = 1536, ZC_GA = 1728, ZC_QD = 2240, ZC_KVD = 2496, ZC_KR = 2624,
              ZC_GB = 2656, ZC_U = 3168, ZC_VC = 3680, ZC_GC = 4192, ZC_F = 4704, ZC_GD = 5216;
constexpr int SHIFT_W = 1728;
static_assert(M_C % NGRP_C == 0 && NB_C % NGRP_C == 0, "ctx groups");
static_assert(T_C % 128 == 0 && T_D % 128 == 0 && PAST % 32 == 0, "seq multiples");

typedef unsigned short bf16_t;
typedef short s8v __attribute__((ext_vector_type(8)));
typedef float f4v __attribute__((ext_vector_type(4)));
typedef float f16v __attribute__((ext_vector_type(16)));
typedef unsigned u4v __attribute__((ext_vector_type(4)));
typedef unsigned u2v __attribute__((ext_vector_type(2)));

struct Params {
  const float *x_prompt, *x_sample, *st_f, *st_b, *c_ckv, *c_kr, *c, *c_ctx, *norm_g, *w_ada, *b_ada, *w_in, *shift_mu, *w0, *w_up,
      *a0, *a_up, *k_k, *k_a, *r_k, *ln_g, *ln_b, *q_norm, *w_q_up, *kv_norm, *w_kv_up, *g_ln_g, *g_ln_b, *g_w_s, *g_b_s, *w_branch,
      *w_merge, *b_merge, *w_out, *final_g;
  float* out;
  char* ws;
};

struct Grp { int isden, m0, mg, nseq, T, b0, nkeys, mkv; };
__host__ __device__ __forceinline__ Grp get_grp(int gi) {
  Grp g;
  if (gi == 0) { g.isden = 1; g.m0 = M_C; g.mg = M_D; g.nseq = NB_D; g.T = T_D; g.b0 = 0; g.nkeys = KEYS_D; g.mkv = M_D + NB_D * PAST; }
  else { g.isden = 0; g.m0 = (gi - 1) * MGC; g.mg = MGC; g.nseq = SEQ_PER_CG; g.T = T_C; g.b0 = (gi - 1) * SEQ_PER_CG; g.nkeys = T_C; g.mkv = MGC; }
  return g;
}

constexpr size_t al256(size_t x) { return (x + 255) & ~(size_t)255; }
constexpr size_t O_WINT = 0;
constexpr int IN_WP = ((IN_W + 255) / 256) * 256;
constexpr size_t O_WMT = O_WINT + al256((size_t)IN_WP * 1024 * 2);
constexpr size_t O_WBRT = O_WMT + al256((size_t)4096 * 1024 * 2);
constexpr size_t O_WOUTT = O_WBRT + al256((size_t)4 * 1024 * 512 * 2);
constexpr size_t O_WQT = O_WOUTT + al256((size_t)1024 * 1024 * 2);
constexpr size_t O_WKVT = O_WQT + al256((size_t)768 * 256 * 2);
constexpr size_t O_WUPT = O_WKVT + al256((size_t)1024 * 128 * 2);
constexpr size_t O_WS = O_WUPT + al256((size_t)4 * 512 * 64 * 2);
constexpr size_t O_CS128 = O_WS + al256((size_t)4 * 128 * 128 * 2);
constexpr size_t O_A2C = O_CS128 + al256((size_t)256 * 128 * 2);
constexpr size_t O_A2D = O_A2C + al256((size_t)T_C * 2 * T_C * 2);
constexpr size_t O_ROPE = O_A2D + al256((size_t)T_D * 2 * T_D * 2);
constexpr size_t O_MOD = O_ROPE + al256((size_t)T_D * 32 * 4);
constexpr size_t O_H = O_MOD + al256((size_t)NL * 3 * 3072 * 4);
constexpr size_t O_Z = O_H + al256((size_t)MG * 1024 * 2);
constexpr size_t O_SK = O_Z + al256((size_t)MG * IN_W * 2);
constexpr size_t O_SOP = O_SK + al256((size_t)MG * 512 * 2);
constexpr size_t O_YS = O_SOP + al256((size_t)MG * 8 * 576 * 2);
constexpr size_t O_BON = O_YS + al256((size_t)2 * MG * 512 * 4);
constexpr size_t O_LORA = O_BON + al256((size_t)MG * 16 * 4);
constexpr int CM_GT = 0, CM_BKT = 5120, CM_WL = 9216, CM_VT = 9472, CM_REC = 11520;
constexpr size_t CM_BYTES = (size_t)MG * CM_REC;
constexpr size_t O_CM = O_LORA + al256((size_t)MG * 192 * 2);
constexpr size_t O_PRE = O_CM + al256(CM_BYTES - (size_t)MG * 2048 * 2);
constexpr size_t O_QDN = O_PRE + al256((size_t)MG * 2048 * 2);
constexpr size_t O_CKV = O_QDN + al256((size_t)MG * 256 * 2);
constexpr size_t O_KR = O_CKV + al256((size_t)MKV * 128 * 2);
constexpr size_t O_Q = O_KR + al256((size_t)MKV * 32 * 2);
constexpr size_t O_KN = O_Q + al256((size_t)MG * 768 * 2);
constexpr size_t O_VT = O_KN + al256((size_t)MKV * 512 * 2);
constexpr size_t O_VCNT = O_VT + al256((size_t)MKV * 512 * 2);
constexpr size_t O_YT = O_VCNT + al256((size_t)MG * 512 * 2);
constexpr size_t O_OBR = O_YT + al256((size_t)MG * 1024 * 2);
constexpr size_t O_MERGED = O_OBR + al256((size_t)4 * MG * 512 * 2);
constexpr size_t O_END = O_MERGED + al256((size_t)MG * 1024 * 2);
constexpr size_t O_GATES = O_PRE;
static_assert(O_GATES + (size_t)MG * 4096 * 2 <= O_VCNT, "gates alias region too small");
static_assert(O_CM + CM_BYTES <= O_QDN, "chunk-matrix region must end before QDN");
constexpr size_t O_BAR = O_END;
constexpr size_t BAR_BYTES = 3456 * 4;
static_assert(O_BAR + BAR_BYTES <= ((size_t)256 << 20), "workspace must fit 256 MiB");

constexpr size_t OUT_SF = (size_t)M * D, OUT_SB = OUT_SF + (size_t)NB_C * NL * 8 * 64 * 64,
                 OUT_CKV = OUT_SB + (size_t)NB_C * NL * 8 * 64 * 64, OUT_KR = OUT_CKV + (size_t)NB_C * NL * T_C * 128;

#ifdef EMU
template <class T> __device__ __forceinline__ T* opaque(T* p) { return p; }
__device__ __forceinline__ int opaque_i(int v) { return v; }
#else
template <class T> __device__ __forceinline__ T* opaque(T* p) {
  typedef __attribute__((address_space(1))) T* gptr;
  gptr g = (gptr)p; asm volatile("" : "+s"(g)); return (T*)g;
}
__device__ __forceinline__ int opaque_i(int v) { asm volatile("" : "+s"(v)); return v; }
#endif
__device__ __forceinline__ int my_tid() {
#ifdef EMU
  return (int)threadIdx.x;
#else
  int t = (int)threadIdx.x; asm volatile("" : "+v"(t)); return t;
#endif
}
__device__ __forceinline__ unsigned f_as_u(float f) { return __builtin_bit_cast(unsigned, f); }
__device__ __forceinline__ float u_as_f(unsigned u) { return __builtin_bit_cast(float, u); }
#ifdef EMU
__device__ __forceinline__ bf16_t f2bf(float f) { unsigned u = f_as_u(f); u += 0x7FFFu + ((u >> 16) & 1u); return (bf16_t)(u >> 16); }
__device__ __forceinline__ unsigned pk2bf(float lo, float hi) { return (unsigned)f2bf(lo) | ((unsigned)f2bf(hi) << 16); }
#else
typedef __bf16 bf2v_t __attribute__((ext_vector_type(2)));
typedef float f2c_t __attribute__((ext_vector_type(2)));
__device__ __forceinline__ bf16_t f2bf(float f) { return __builtin_bit_cast(unsigned short, (__bf16)f); }
__device__ __forceinline__ unsigned pk2bf(float lo, float hi) { return __builtin_bit_cast(unsigned, __builtin_convertvector(f2c_t{lo, hi}, bf2v_t)); }
#endif
__device__ __forceinline__ float bf2f(bf16_t h) { return u_as_f(((unsigned)h) << 16); }
__device__ __forceinline__ float bflo(unsigned u) { return u_as_f(u << 16); }
__device__ __forceinline__ float bfhi(unsigned u) { return u_as_f(u & 0xFFFF0000u); }
#ifdef EMU
__device__ __forceinline__ float fexp_(float x) { return expf(x); }
__device__ __forceinline__ float frcp_(float x) { return 1.f / x; }
#else
__device__ __forceinline__ float fexp_(float x) { return __builtin_amdgcn_exp2f(x * 1.4426950408889634f); }
__device__ __forceinline__ float frcp_(float x) { return __builtin_amdgcn_rcpf(x); }
#endif
#ifdef EMU
__device__ __forceinline__ float fexp2_(float x) { return exp2f(x); }
#else
__device__ __forceinline__ float fexp2_(float x) { return __builtin_amdgcn_exp2f(x); }
#endif
__device__ __forceinline__ float sigmoidf_(float x) { return frcp_(1.f + fexp_(-x)); }
__device__ __forceinline__ float siluf_(float x) { return x * frcp_(1.f + fexp_(-x)); }
__device__ __forceinline__ float tanhf_(float x) { return 1.f - 2.f * frcp_(1.f + fexp_(2.f * x)); }
__device__ __forceinline__ float geluf_(float x) { return 0.5f * x * (1.f + tanhf_(0.7978845608028654f * (x + 0.044715f * x * x * x))); }
__device__ __forceinline__ float wave_sum(float v) {
#pragma unroll
  for (int o = 32; o >= 1; o >>= 1) v += __shfl_xor(v, o);
  return v;
}

#ifdef EMU
#define WAVE_SYNC() emu::wave_barrier()
__device__ __forceinline__ float sum16(float v) { v += __shfl_xor(v, 1); v += __shfl_xor(v, 2); v += __shfl_xor(v, 4); v += __shfl_xor(v, 8); return v; }
#else
#define WAVE_SYNC() __builtin_amdgcn_wave_barrier()
__device__ __forceinline__ float sum16(float v) {
  v += u_as_f(__builtin_amdgcn_update_dpp(0, (int)f_as_u(v), 0xB1, 0xF, 0xF, true));
  v += u_as_f(__builtin_amdgcn_update_dpp(0, (int)f_as_u(v), 0x4E, 0xF, 0xF, true));
  v += u_as_f(__builtin_amdgcn_update_dpp(0, (int)f_as_u(v), 0x141, 0xF, 0xF, true));
  v += u_as_f(__builtin_amdgcn_update_dpp(0, (int)f_as_u(v), 0x140, 0xF, 0xF, true));
  return v;
}
#endif

template <int LPR> __device__ __forceinline__ float sum_lpr(float v) {
#ifdef EMU
  v += __shfl_xor(v, 1); v += __shfl_xor(v, 2); v += __shfl_xor(v, 4);
  if (LPR >= 16) v += __shfl_xor(v, 8);
  if (LPR >= 32) v += __shfl_xor(v, 16);
  return v;
#else
  v += u_as_f(__builtin_amdgcn_update_dpp(0, (int)f_as_u(v), 0xB1, 0xF, 0xF, true));
  v += u_as_f(__builtin_amdgcn_update_dpp(0, (int)f_as_u(v), 0x4E, 0xF, 0xF, true));
  v += u_as_f(__builtin_amdgcn_update_dpp(0, (int)f_as_u(v), 0x141, 0xF, 0xF, true));
  if (LPR >= 16) v += u_as_f(__builtin_amdgcn_update_dpp(0, (int)f_as_u(v), 0x140, 0xF, 0xF, true));
  if (LPR >= 32) { auto r = __builtin_amdgcn_permlane16_swap(f_as_u(v), f_as_u(v), false, false); v = u_as_f(r[0]) + u_as_f(r[1]); }
  return v;
#endif
}

template <int LPR> __device__ __forceinline__ void sum_lpr2(float& a, float& b) {
#ifdef EMU
  a = sum_lpr<LPR>(a); b = sum_lpr<LPR>(b);
#else
#define DPP_ADD2(ctrl) { float ta = u_as_f(__builtin_amdgcn_update_dpp(0, (int)f_as_u(a), ctrl, 0xF, 0xF, true)); float tb = u_as_f(__builtin_amdgcn_update_dpp(0, (int)f_as_u(b), ctrl, 0xF, 0xF, true)); a += ta; b += tb; }
  DPP_ADD2(0xB1) DPP_ADD2(0x4E) DPP_ADD2(0x141)
  if (LPR >= 16) DPP_ADD2(0x140)
  if (LPR >= 32) { auto ra = __builtin_amdgcn_permlane16_swap(f_as_u(a), f_as_u(a), false, false); auto rb = __builtin_amdgcn_permlane16_swap(f_as_u(b), f_as_u(b), false, false);
    a = u_as_f(ra[0]) + u_as_f(ra[1]); b = u_as_f(rb[0]) + u_as_f(rb[1]); }
#undef DPP_ADD2
#endif
}

constexpr int NTHR = 512, NWAVE = 8;
constexpr int LDS_STR = 72;
constexpr int SMEM_STAGE = 131072;
constexpr int SMEM_BYTES = SMEM_STAGE + 16;

template <int NJ>
__device__ __forceinline__ void zero_acc(f4v (&acc)[2][NJ]) {
#pragma unroll
  for (int i = 0; i < 2; ++i)
#pragma unroll
    for (int j = 0; j < NJ; ++j) acc[i][j] = f4v{0.f, 0.f, 0.f, 0.f};
}

template <int NJ, bool BT = false>
__device__ __forceinline__ void gemm_mainloop(const bf16_t* __restrict__ A, long lda, int arow0, int arows, const bf16_t* __restrict__ B,
                                              long ldb, int brow0, int brows, int K, char* smem, f4v (&acc)[2][NJ]) {
  constexpr int BROWS = 32 * NJ, NBL = NJ / 2;
  constexpr int BUF = (128 + 128) * LDS_STR;
  bf16_t* s0 = (bf16_t*)smem;
  const int tid = my_tid(), lane = tid & 63, wid = tid >> 6, wm = wid >> 1, wn = wid & 1;
  u4v ra[2], rb[NBL];
  const bf16_t* ap[2]; const bf16_t* bp[NBL];
#pragma unroll
  for (int i = 0; i < 2; ++i) { int c = tid + NTHR * i, r = c >> 3, cc = c & 7; int ar = arow0 + r; ar = ar < arows ? ar : arows - 1; ap[i] = A + (long)ar * lda + cc * 8; }
#pragma unroll
  for (int i = 0; i < NBL; ++i) { int c = tid + NTHR * i;
    if (BT) { int q = c >> 4, dc = c & 15; bp[i] = B + (long)q * ldb + brow0 + dc * 8; }
    else { int r = c >> 3, cc = c & 7; int br = brow0 + r; br = br < brows ? br : brows - 1; bp[i] = B + (long)br * ldb + cc * 8; } }
#pragma unroll
  for (int i = 0; i < 2; ++i) ra[i] = *(const u4v*)(ap[i]);
#pragma unroll
  for (int i = 0; i < NBL; ++i) rb[i] = *(const u4v*)(bp[i]);
  __syncthreads();
#pragma unroll
  for (int i = 0; i < 2; ++i) { int c = tid + NTHR * i, r = c >> 3, cc = c & 7; *(u4v*)(s0 + r * LDS_STR + cc * 8) = ra[i]; }
#pragma unroll
  for (int i = 0; i < NBL; ++i) { int c = tid + NTHR * i;
    if (BT) { int q = c >> 4, dc = c & 15;
#pragma unroll
      for (int e = 0; e < 8; ++e) s0[(128 + dc * 8 + e) * LDS_STR + q] = (bf16_t)(rb[i][e >> 1] >> ((e & 1) * 16)); }
    else { int r = c >> 3, cc = c & 7; *(u4v*)(s0 + (128 + r) * LDS_STR + cc * 8) = rb[i]; } }
  __syncthreads();
  const int nk = K >> 6;
  for (int kt = 0; kt < nk; ++kt) {
    const bool more = kt + 1 < nk;
    if (more) {
#pragma unroll
      for (int i = 0; i < 2; ++i) ra[i] = *(const u4v*)(ap[i] + (kt + 1) * 64);
#pragma unroll
      for (int i = 0; i < NBL; ++i) rb[i] = *(const u4v*)(bp[i] + (BT ? (long)(kt + 1) * 64 * ldb : (long)(kt + 1) * 64));
    }
    const bf16_t* sA = s0 + (kt & 1) * BUF; const bf16_t* sB = sA + 128 * LDS_STR;
#pragma unroll
    for (int ks = 0; ks < 2; ++ks) {
      s8v af[2], bf[NJ];
#pragma unroll
      for (int i = 0; i < 2; ++i) af[i] = *(const s8v*)(sA + (wm * 32 + i * 16 + (lane & 15)) * LDS_STR + ks * 32 + (lane >> 4) * 8);
#pragma unroll
      for (int j = 0; j < NJ; ++j) bf[j] = *(const s8v*)(sB + (wn * NJ * 16 + j * 16 + (lane & 15)) * LDS_STR + ks * 32 + (lane >> 4) * 8);
#pragma unroll
      for (int i = 0; i < 2; ++i)
#pragma unroll
        for (int j = 0; j < NJ; ++j) acc[i][j] = __builtin_amdgcn_mfma_f32_16x16x32_bf16(bf[j], af[i], acc[i][j], 0, 0, 0);
    }
    if (more) {
      bf16_t* dA = s0 + ((kt + 1) & 1) * BUF;
#pragma unroll
      for (int i = 0; i < 2; ++i) { int c = tid + NTHR * i, r = c >> 3, cc = c & 7; *(u4v*)(dA + r * LDS_STR + cc * 8) = ra[i]; }
#pragma unroll
      for (int i = 0; i < NBL; ++i) { int c = tid + NTHR * i;
        if (BT) { int q = c >> 4, dc = c & 15;
#pragma unroll
          for (int e = 0; e < 8; ++e) dA[(128 + dc * 8 + e) * LDS_STR + q] = (bf16_t)(rb[i][e >> 1] >> ((e & 1) * 16)); }
        else { int r = c >> 3, cc = c & 7; *(u4v*)(dA + (128 + r) * LDS_STR + cc * 8) = rb[i]; } }
    }
    __syncthreads();
  }
  (void)BROWS;
}

template <int NJ, class F>
__device__ __forceinline__ void epi_foreach(f4v (&acc)[2][NJ], int row0, int col0, F f) {
  const int tid = my_tid(), lane = tid & 63, wid = tid >> 6, wm = wid >> 1, wn = wid & 1;
#pragma unroll
  for (int i = 0; i < 2; ++i)
#pragma unroll
    for (int j = 0; j < NJ; ++j) f(row0 + wm * 32 + i * 16 + (lane & 15), col0 + wn * NJ * 16 + j * 16 + (lane >> 4) * 4, acc[i][j]);
}
__device__ __forceinline__ u4v pack8(const float (&x)[8]) {
  return u4v{pk2bf(x[0], x[1]), pk2bf(x[2], x[3]), pk2bf(x[4], x[5]), pk2bf(x[6], x[7])};
}
__device__ __forceinline__ void unpack8(u4v u, float (&x)[8]) {
  x[0] = bflo(u.x); x[1] = bfhi(u.x); x[2] = bflo(u.y); x[3] = bfhi(u.y); x[4] = bflo(u.z); x[5] = bfhi(u.z); x[6] = bflo(u.w); x[7] = bfhi(u.w);
}
__device__ __forceinline__ u2v pack4(float a, float b, float c, float d) {
  return u2v{pk2bf(a, b), pk2bf(c, d)};
}

#ifndef EMU
namespace pg8 {
#define PG8_LAS __attribute__((address_space(3)))
typedef unsigned short bf16_t;
typedef short bf16x8 __attribute__((ext_vector_type(8)));
typedef float f32x4 __attribute__((ext_vector_type(4)));
typedef unsigned u32x4 __attribute__((ext_vector_type(4)));
constexpr int BM = 256, BK = 64, HALF = 128, HTB = HALF * BK * 2  , STAGE_BYTES = 8 * HTB, NXCD = 8, WGM = 8;

__host__ __device__ __forceinline__ int lds_byte(int r, int c) { const int st = (r >> 4) * 2 + (c >> 5), rr = r & 15, cc = c & 31, ob = rr * 64 + cc * 2; return st * 1024 + (ob ^ (((ob >> 9) & 1) << 5)); }
__host__ __device__ __forceinline__ void stage_rc(int b, int& R, int& C) { const int st = b / 1024, sb = b % 1024, swz = sb ^ (((sb >> 9) & 1) << 5); R = (st >> 1) * 16 + swz / 64; C = (st & 1) * 32 + (swz % 64) / 2; }
__host__ __device__ __forceinline__ int perm32(int rho) { const int n = rho >> 4, i = rho & 15; return 8 * (i >> 2) + 4 * n + (i & 3); }

struct Unit { int pm, pn; };
struct Gemm { const bf16_t* A; const bf16_t* Bt; int M, N, K; };

struct StaticOrder {
    int nM, nN, nwg, G, c;
    __host__ __device__ void init(int M, int N, int G_, int c_) { nM = M / BM; nN = N / BM; nwg = nM * nN; G = G_; c = c_; }
    __host__ __device__ bool next(int i, Unit& u) const {
        const long L = (long)i * G + c; if (L >= nwg) return false;
        int wgid = (int)L; { const int q = nwg / NXCD, r = nwg % NXCD, xcd = wgid % NXCD, off = wgid / NXCD; wgid = (xcd < r ? xcd * (q + 1) : r * (q + 1) + (xcd - r) * q) + off; }
        const int nig = WGM * nN, gid = wgid / nig, fm = gid * WGM, gsz = (nM - fm) < WGM ? (nM - fm) : WGM;
        u.pm = fm + ((wgid % nig) % gsz); u.pn = (wgid % nig) / gsz; return true;
    }
    __device__ __forceinline__ void a_ready(const Unit&) const {}
    __device__ __forceinline__ void done(const Unit&) const {}
};
template <class Epi, class Sched>
__device__ __forceinline__ void gemm_phase(PG8_LAS unsigned char* lds, const Gemm g, const Sched& S, const Epi& E) {
    const int tid = my_tid(), wid = __builtin_amdgcn_readfirstlane(tid >> 6), lane = tid & 63, wr = wid >> 2, wc = wid & 3, fr = lane & 15, fq = lane >> 4;
    const int K = g.K, nt = K / BK;
    unsigned voffA[2], voffB[2];
#pragma unroll
    for (int i = 0; i < 2; ++i) { int R, C; stage_rc(tid * 16 + i * 8192, R, C); const int Rb = Epi::PERM ? ((R & ~31) + perm32(R & 31)) : R;
        voffA[i] = (unsigned)(R * K + C) * 2u; voffB[i] = (unsigned)(Rb * K + C) * 2u; }
    const size_t kstep = (size_t)(BK * 2);
    const size_t hstep = (size_t)HALF * K * 2;
    const size_t tstep = 2 * hstep;
    const unsigned ldsw = (unsigned)wid * 1024u;
    const int aoff = lds_byte(wr * 64 + fr, fq * 8), boff = lds_byte(wc * 32 + fr, fq * 8);
#define PG8_SA(b, h) (((b) * 2 + (h)) * HTB)
#define PG8_SB(b, h) ((4 + (b) * 2 + (h)) * HTB)
#define PG8_STAGE(bufoff, gbase, voff) do { _Pragma("unroll") for (int _i = 0; _i < 2; ++_i) \
        __builtin_amdgcn_global_load_lds((const unsigned*)((const char*)(gbase) + (voff)[_i]), (PG8_LAS unsigned*)(lds + (bufoff) + ldsw + _i * 8192), 16, 0, 0); } while (0)
#define PG8_LDA(dst, b, h) do { _Pragma("unroll") for (int m = 0; m < 4; ++m) _Pragma("unroll") for (int k = 0; k < 2; ++k) dst[m][k] = *(const PG8_LAS bf16x8*)(lds + PG8_SA(b, h) + aoff + m * 2048 + k * 1024); } while (0)
#define PG8_LDB(dst, b, h) do { _Pragma("unroll") for (int n = 0; n < 2; ++n) _Pragma("unroll") for (int k = 0; k < 2; ++k) dst[n][k] = *(const PG8_LAS bf16x8*)(lds + PG8_SB(b, h) + boff + n * 2048 + k * 1024); } while (0)
#define PG8_MMA(ai, bj, At, Bt) do { __builtin_amdgcn_s_setprio(1); _Pragma("unroll") for (int m = 0; m < 4; ++m) _Pragma("unroll") for (int n = 0; n < 2; ++n) _Pragma("unroll") for (int k = 0; k < 2; ++k) \
        acc[ai][bj][m][n] = __builtin_amdgcn_mfma_f32_16x16x32_bf16(Bt[n][k], At[m][k], acc[ai][bj][m][n], 0, 0, 0); __builtin_amdgcn_s_setprio(0); } while (0)
#define PG8_WAIT_V(n) asm volatile("s_waitcnt vmcnt(" #n ")" ::: "memory")
#define PG8_WAIT_L(n) asm volatile("s_waitcnt lgkmcnt(" #n ")" ::: "memory")
#define PG8_BAR __builtin_amdgcn_s_barrier()
#define PG8_SCHED __builtin_amdgcn_sched_barrier(0)
    Unit cur, nxt; int ui = 0;
    if (!S.next(0, cur)) return;
    f32x4 acc[2][2][4][2];
#pragma unroll
    for (int a = 0; a < 2; ++a)
#pragma unroll
        for (int b = 0; b < 2; ++b)
#pragma unroll
            for (int m = 0; m < 4; ++m)
#pragma unroll
                for (int n = 0; n < 2; ++n) acc[a][b][m][n] = (f32x4){0.f, 0.f, 0.f, 0.f};
    bf16x8 At[4][2], B0[2][2], B1[2][2];
    const char* cA = (const char*)g.A + (size_t)cur.pm * tstep; const char* cB = (const char*)g.Bt + (size_t)cur.pn * tstep;
    S.a_ready(cur);
    PG8_STAGE(PG8_SB(0, 0), cB, voffB); PG8_STAGE(PG8_SA(0, 0), cA, voffA); PG8_STAGE(PG8_SB(0, 1), cB + hstep, voffB); PG8_STAGE(PG8_SA(0, 1), cA + hstep, voffA);
    if (wr == 1) PG8_BAR;
    PG8_WAIT_V(4); PG8_BAR;
    PG8_STAGE(PG8_SB(1, 0), cB + kstep, voffB); PG8_STAGE(PG8_SA(1, 0), cA + kstep, voffA); PG8_STAGE(PG8_SB(1, 1), cB + hstep + kstep, voffB);
    PG8_WAIT_V(6); PG8_BAR;
    for (;;) {
        const bool has_next = S.next(ui + 1, nxt);
        const char* nA = has_next ? (const char*)g.A + (size_t)nxt.pm * tstep : cA; const char* nB = has_next ? (const char*)g.Bt + (size_t)nxt.pn * tstep : cB;
        for (int t = 0; t < nt; t += 2) {
            const bool last = (t == nt - 2);
            const char* a1 = cA + (size_t)(t + 1) * kstep;
            const char* a2 = last ? nA : cA + (size_t)(t + 2) * kstep; const char* b2 = last ? nB : cB + (size_t)(t + 2) * kstep;
            const char* a3 = a2 + kstep; const char* b3 = b2 + kstep;
            if (last && has_next) S.a_ready(nxt);
            PG8_LDB(B0, 0, 0); PG8_SCHED; PG8_LDA(At, 0, 0); PG8_STAGE(PG8_SA(1, 1), a1 + hstep, voffA);
            PG8_WAIT_L(8); PG8_BAR; PG8_WAIT_L(0); PG8_MMA(0, 0, At, B0); PG8_BAR; PG8_SCHED;
            PG8_LDB(B1, 0, 1); PG8_STAGE(PG8_SB(0, 0), b2, voffB);
            PG8_BAR; PG8_WAIT_L(0); PG8_MMA(0, 1, At, B1); PG8_BAR;
            PG8_LDA(At, 0, 1); PG8_STAGE(PG8_SA(0, 0), a2, voffA);
            PG8_BAR; PG8_WAIT_L(0); PG8_MMA(1, 0, At, B0); PG8_BAR; PG8_SCHED;
            PG8_STAGE(PG8_SB(0, 1), b2 + hstep, voffB);
            PG8_WAIT_V(6); PG8_BAR; PG8_MMA(1, 1, At, B1); PG8_BAR;
            PG8_LDB(B0, 1, 0); PG8_SCHED; PG8_LDA(At, 1, 0); PG8_STAGE(PG8_SA(0, 1), a2 + hstep, voffA);
            PG8_WAIT_L(8); PG8_BAR; PG8_WAIT_L(0); PG8_MMA(0, 0, At, B0); PG8_BAR; PG8_SCHED;
            PG8_LDB(B1, 1, 1); PG8_STAGE(PG8_SB(1, 0), b3, voffB);
            PG8_BAR; PG8_WAIT_L(0); PG8_MMA(0, 1, At, B1); PG8_BAR;
            PG8_LDA(At, 1, 1); PG8_STAGE(PG8_SA(1, 0), a3, voffA);
            PG8_BAR; PG8_WAIT_L(0); PG8_MMA(1, 0, At, B0); PG8_BAR; PG8_SCHED;
            PG8_STAGE(PG8_SB(1, 1), b3 + hstep, voffB);
            PG8_WAIT_V(6); PG8_BAR; PG8_MMA(1, 1, At, B1); PG8_BAR;
        }
            if constexpr (!Epi::AFTER_DRAIN) { E(acc, cur, wr, wc, fr, fq); S.done(cur); }
            if (!has_next) break;
#pragma unroll
        for (int a = 0; a < 2; ++a)
#pragma unroll
            for (int b = 0; b < 2; ++b)
#pragma unroll
                for (int m = 0; m < 4; ++m)
#pragma unroll
                    for (int n = 0; n < 2; ++n) acc[a][b][m][n] = (f32x4){0.f, 0.f, 0.f, 0.f};
        cur = nxt; cA = nA; cB = nB; ++ui;
    }
    PG8_WAIT_V(0);
    if (wr == 0) PG8_BAR;
    PG8_BAR;
    if constexpr (Epi::AFTER_DRAIN) { E.fused(acc, cur, wr, wc, fr, fq, lds, wid, lane); S.done(cur); }
#undef PG8_SA
#undef PG8_SB
#undef PG8_STAGE
#undef PG8_LDA
#undef PG8_LDB
#undef PG8_MMA
#undef PG8_WAIT_V
#undef PG8_WAIT_L
#undef PG8_BAR
#undef PG8_SCHED
}

__device__ __forceinline__ unsigned pk2(float lo, float hi) { return pk2bf(lo, hi); }
struct EpiStore {
  static constexpr bool PERM = true, AFTER_DRAIN = false;
  bf16_t* O; int ldc; int ncols;
  __device__ __forceinline__ void operator()(const f32x4 (&acc)[2][2][4][2], const Unit& u, int wr, int wc, int fr, int fq) const {
    const int row0 = u.pm * BM + wr * 64 + fr, col0 = u.pn * BM + wc * 32 + 8 * fq;
#pragma unroll
    for (int ai = 0; ai < 2; ++ai)
#pragma unroll
      for (int m = 0; m < 4; ++m) { bf16_t* rowp = O + (size_t)(row0 + ai * HALF + m * 16) * ldc + col0;
#pragma unroll
        for (int bj = 0; bj < 2; ++bj) if (col0 + bj * HALF < ncols) { const f32x4 v0 = acc[ai][bj][m][0], v1 = acc[ai][bj][m][1];
          *(u32x4*)(rowp + bj * HALF) = (u32x4){pk2(v0[0], v0[1]), pk2(v0[2], v0[3]), pk2(v1[0], v1[1]), pk2(v1[2], v1[3])}; } }
  }
};
struct EpiSigmoid {
  static constexpr bool PERM = true, AFTER_DRAIN = false;
  bf16_t* O; int ldc; const float* bias;
  __device__ __forceinline__ void operator()(const f32x4 (&acc)[2][2][4][2], const Unit& u, int wr, int wc, int fr, int fq) const {
    const int row0 = u.pm * BM + wr * 64 + fr, col0 = u.pn * BM + wc * 32 + 8 * fq;
    f32x4 bv[2][2];
#pragma unroll
    for (int bj = 0; bj < 2; ++bj)
#pragma unroll
      for (int n = 0; n < 2; ++n) bv[bj][n] = *(const f32x4*)(bias + col0 + bj * HALF + 4 * n);
#pragma unroll
    for (int ai = 0; ai < 2; ++ai)
#pragma unroll
      for (int m = 0; m < 4; ++m) { bf16_t* rowp = O + (size_t)(row0 + ai * HALF + m * 16) * ldc + col0;
#pragma unroll
        for (int bj = 0; bj < 2; ++bj) { const f32x4 v0 = acc[ai][bj][m][0] + bv[bj][0], v1 = acc[ai][bj][m][1] + bv[bj][1];
          *(u32x4*)(rowp + bj * HALF) = (u32x4){pk2(sigmoidf_(v0[0]), sigmoidf_(v0[1])), pk2(sigmoidf_(v0[2]), sigmoidf_(v0[3])), pk2(sigmoidf_(v1[0]), sigmoidf_(v1[1])), pk2(sigmoidf_(v1[2]), sigmoidf_(v1[3]))}; } }
  }
};
}
#endif

struct TJob { const float* src; int K, N; long lds; bf16_t* dst; long ldd; };
__device__ __forceinline__ TJob get_tjob(const Params& p, int l, int j) {
  TJob t; char* ws = p.ws;
  if (j == 0) { t.src = p.w_in + (size_t)l * 1024 * IN_W; t.K = 1024; t.N = IN_W; t.lds = IN_W; t.dst = (bf16_t*)(ws + O_WINT); t.ldd = 1024; }
  else if (j == 1) { t.src = p.w_merge + (size_t)l * 1024 * 4096; t.K = 1024; t.N = 4096; t.lds = 4096; t.dst = (bf16_t*)(ws + O_WMT); t.ldd = 1024; }
  else if (j < 6) { int n = j - 2; t.src = p.w_branch + ((size_t)l * 4 + n) * 512 * 1024; t.K = 512; t.N = 1024; t.lds = 1024; t.dst = (bf16_t*)(ws + O_WBRT) + (size_t)n * 1024 * 512; t.ldd = 512; }
  else if (j == 6) { t.src = p.w_out + (size_t)l * 1024 * 1024; t.K = 1024; t.N = 1024; t.lds = 1024; t.dst = (bf16_t*)(ws + O_WOUTT); t.ldd = 1024; }
  else if (j == 7) { t.src = p.w_q_up + (size_t)l * 256 * 768; t.K = 256; t.N = 768; t.lds = 768; t.dst = (bf16_t*)(ws + O_WQT); t.ldd = 256; }
  else if (j == 8) { t.src = p.w_kv_up + (size_t)l * 128 * 1024; t.K = 128; t.N = 1024; t.lds = 1024; t.dst = (bf16_t*)(ws + O_WKVT); t.ldd = 128; }
  else { int n = j - 9;
    t.src = (n < 2 ? p.w_up : p.a_up) + ((size_t)l * 2 + (n & 1)) * 64 * 512; t.K = 64; t.N = 512; t.lds = 512;
    t.dst = (bf16_t*)(ws + O_WUPT) + (size_t)n * 512 * 64; t.ldd = 64; }
  return t;
}
constexpr int NTJOBS = 13;

__device__ __forceinline__ void stage_prep(const Params& p, int l, int bid, int nb, char* smem) {
  const int tid = my_tid();
  char* ws = p.ws;
  {
    float* tile = (float*)smem;
    int base = 0;
    for (int j = 0; j < NTJOBS; ++j) {
      TJob t = get_tjob(p, l, j);
      int tk = t.K / 64, tn = t.N / 32, nt = tk * tn;
      int first = ((bid - base % nb) % nb + nb) % nb;
      for (int q = first; q < nt; q += nb) {
        int kt = q / tn, nt_ = q % tn;
        __syncthreads();
        { int r = tid >> 3, c4 = tid & 7; f4v x = *(const f4v*)(t.src + (long)(kt * 64 + r) * t.lds + nt_ * 32 + c4 * 4);
          tile[r * 33 + c4 * 4] = x[0]; tile[r * 33 + c4 * 4 + 1] = x[1]; tile[r * 33 + c4 * 4 + 2] = x[2]; tile[r * 33 + c4 * 4 + 3] = x[3]; }
        __syncthreads();
        if (tid < 256) { int n = tid >> 3, kc = tid & 7; float x[8];
#pragma unroll
          for (int e = 0; e < 8; ++e) x[e] = tile[(kc * 8 + e) * 33 + n];
          *(u4v*)(t.dst + (long)(nt_ * 32 + n) * t.ldd + kt * 64 + kc * 8) = pack8(x); }
      }
      base += nt;
    }
    __syncthreads();
  }
  const long gtid = (long)bid * NTHR + tid, gn = (long)nb * NTHR;
  { bf16_t* d = (bf16_t*)(ws + O_WINT) + (size_t)IN_W * 1024; for (long i = gtid; i < (long)(IN_WP - IN_W) * 1024; i += gn) d[i] = 0; }
  { bf16_t* d = (bf16_t*)(ws + O_WS); const float* s = p.g_w_s + (size_t)l * 4 * 128 * 128; for (long i = gtid; i < (long)4 * 128 * 128; i += gn) d[i] = f2bf(s[i]); }
  if (l != 0) return;
  { bf16_t* d = (bf16_t*)(ws + O_CS128);
    for (long i = gtid; i < 256 * 128; i += gn) { int j = (int)(i >> 7), c = (int)(i & 127); int mm = ((j & 127) * c) & 127; float x = 2.0f * mm / 128.f; d[i] = f2bf(j < 128 ? cospif(x) : sinpif(x)); } }
  { bf16_t* d = (bf16_t*)(ws + O_A2C);
    for (long i = gtid; i < (long)T_C * 2 * T_C; i += gn) { int tp = (int)(i / (2 * T_C)), tt = (int)(i % (2 * T_C)); int half = tt >= T_C; int t = half ? tt - T_C : tt; int mm = (int)(((long)tp * t) % T_C); float x = 2.0f * mm / (float)T_C; d[i] = f2bf(half ? -sinpif(x) : cospif(x)); } }
  { bf16_t* d = (bf16_t*)(ws + O_A2D);
    for (long i = gtid; i < (long)T_D * 2 * T_D; i += gn) { int tp = (int)(i / (2 * T_D)), tt = (int)(i % (2 * T_D)); int half = tt >= T_D; int t = half ? tt - T_D : tt; int mm = (int)(((long)tp * t) % T_D); float x = 2.0f * mm / (float)T_D; d[i] = f2bf(half ? -sinpif(x) : cospif(x)); } }
  { float* d = (float*)(ws + O_ROPE);
    for (long i = gtid; i < (long)T_D * 16; i += gn) { int t = (int)(i >> 4), pi = (int)(i & 15); float pos = (pi < 8) ? (float)(t / 64) : (float)(t % 64); float inv = expf(-(float)(pi & 7) * (9.210340371976184f / 8.f)); float a = pos * inv; d[2 * i] = cosf(a); d[2 * i + 1] = sinf(a); } }
  { float4* d = (float4*)p.out; const float4* s0 = (const float4*)p.x_prompt; const float4* s1 = (const float4*)p.x_sample;
    for (long i = gtid; i < (long)M * 256; i += gn) d[i] = (i < (long)M_C * 256) ? s0[i] : s1[i - (long)M_C * 256]; }
  {
    float* red = (float*)smem;
    float* modp = (float*)(ws + O_MOD);
    for (int u = bid; u < NL * 48; u += nb) {
      int ll = u / 48, cg = u % 48; int col = cg * 64 + (tid & 63), kq = tid >> 6;
      float a0 = 0.f, a1 = 0.f, a2 = 0.f;
      const float* w = p.w_ada + (size_t)ll * 1024 * 3072 + col;
      for (int k = kq * 128; k < kq * 128 + 128; ++k) {
        float wv = w[(size_t)k * 3072];
        a0 += siluf_(p.c_ctx[k]) * wv; a1 += siluf_(p.c[k]) * wv; a2 += siluf_(p.c[(NB_D > 1 ? 1024 : 0) + k]) * wv;
      }
      __syncthreads();
      red[(kq * 3 + 0) * 64 + (tid & 63)] = a0; red[(kq * 3 + 1) * 64 + (tid & 63)] = a1; red[(kq * 3 + 2) * 64 + (tid & 63)] = a2;
      __syncthreads();
      if (tid < 192) { int mi = tid >> 6, cc = tid & 63; float s = 0.f;
#pragma unroll
        for (int q8 = 0; q8 < 8; ++q8) s += red[(q8 * 3 + mi) * 64 + cc];
        modp[((size_t)ll * 3 + mi) * 3072 + cg * 64 + cc] = s + p.b_ada[(size_t)ll * 3072 + cg * 64 + cc]; }
    }
  }
}

__device__ __forceinline__ int mod_index(const Grp& g, int lm) { return g.isden ? 1 + lm / T_D : 0; }

__device__ __forceinline__ void stage_h(const Params& p, const Grp& g, int l, int bid, int nb) {
  const int lane = my_tid() & 63, wid = my_tid() >> 6;
  const float* X = p.out + (size_t)g.m0 * 1024;
  bf16_t* H = (bf16_t*)(p.ws + O_H);
  const float* modp = (const float*)(p.ws + O_MOD) + (size_t)l * 3 * 3072;
  const float* gam = p.norm_g + (size_t)l * 1024;
  for (int m = bid * NWAVE + wid; m < g.mg; m += nb * NWAVE) {
    const float* xr = X + (size_t)m * 1024; float v[16]; float ss = 0.f;
#pragma unroll
    for (int i = 0; i < 4; ++i) { float4 q = *(const float4*)(xr + i * 256 + lane * 4); v[4 * i] = q.x; v[4 * i + 1] = q.y; v[4 * i + 2] = q.z; v[4 * i + 3] = q.w; ss += q.x * q.x + q.y * q.y + q.z * q.z + q.w * q.w; }
    ss = wave_sum(ss); float rs = rsqrtf(ss * (1.f / 1024.f) + 1e-6f);
    const float* mo = modp + (size_t)mod_index(g, m) * 3072;
#pragma unroll
    for (int i = 0; i < 4; ++i) {
      int c = i * 256 + lane * 4; bf16_t o[4];
#pragma unroll
      for (int e = 0; e < 4; ++e) o[e] = f2bf(v[4 * i + e] * rs * gam[c + e] * (1.f + mo[1024 + c + e]) + mo[c + e]);
      *(u2v*)(H + (size_t)m * 1024 + c) = u2v{(unsigned)o[0] | ((unsigned)o[1] << 16), (unsigned)o[2] | ((unsigned)o[3] << 16)};
    }
  }
}

__device__ __forceinline__ void stage_g1(const Params& p, const Grp& g, int bid, int nb, char* smem) {
  const bf16_t* H = (const bf16_t*)(p.ws + O_H);
  const bf16_t* W = (const bf16_t*)(p.ws + O_WINT);
  bf16_t* Z = (bf16_t*)(p.ws + O_Z);
#ifndef EMU
  if ((g.mg & 255) == 0) {
    pg8::Gemm gm; gm.A = H; gm.Bt = W; gm.M = g.mg; gm.N = IN_WP; gm.K = 1024;
    pg8::StaticOrder S; S.init(gm.M, gm.N, nb, bid);
    pg8::EpiStore E; E.O = Z; E.ldc = IN_W; E.ncols = IN_W;
    pg8::gemm_phase<pg8::EpiStore, pg8::StaticOrder>((PG8_LAS unsigned char*)smem, gm, S, E);
    return;
  }
#endif
  const int TM = (g.mg + 127) / 128; constexpr int TN = (IN_W + 127) / 128;
  const int mg = g.mg;
  for (int t = bid; t < TM * TN; t += nb) {
    int tn = t / TM, tm = t % TM; f4v acc[2][4]; zero_acc<4>(acc);
    gemm_mainloop<4>(H, 1024, tm * 128, mg, W, 1024, tn * 128, IN_W, 1024, smem, acc);
    epi_foreach<4>(acc, tm * 128, tn * 128, [&](int row, int c0, f4v& v) {
      if (c0 < IN_W && row < mg) *(u2v*)(Z + (size_t)row * IN_W + c0) = pack4(v[0], v[1], v[2], v[3]);
    });
  }
}

__device__ __forceinline__ void stage_e1(const Params& p, const Grp& g, int l, int bid, int nb) {
  const int lane = my_tid() & 63, wid = my_tid() >> 6;
  char* ws = p.ws;
  const bf16_t* Z = (const bf16_t*)(ws + O_Z);
  bf16_t* SK = (bf16_t*)(ws + O_SK); bf16_t* SOP = (bf16_t*)(ws + O_SOP);
  bf16_t* LORA = (bf16_t*)(ws + O_LORA); bf16_t* QDN = (bf16_t*)(ws + O_QDN); bf16_t* CKV = (bf16_t*)(ws + O_CKV); bf16_t* KR = (bf16_t*)(ws + O_KR);
  bf16_t* VCN = (bf16_t*)(ws + O_VCNT);
  const float* rope = (const float*)(ws + O_ROPE);
  const float* mu = p.shift_mu + (size_t)l * SHIFT_W;
  const int isden = g.isden, T = g.T;
  for (int m = bid * NWAVE + wid; m < g.mkv; m += nb * NWAVE) {
    if (m >= g.mg) {
      int r = m - g.mg, b = r / PAST, j = r % PAST;
      if (lane < 20) {
        const float* s = lane < 16 ? p.c_ckv + (((size_t)b * NL + l) * PAST + j) * 128 + lane * 8 : p.c_kr + (((size_t)b * NL + l) * PAST + j) * 32 + (lane - 16) * 8;
        f4v x0 = *(const f4v*)s, x1 = *(const f4v*)(s + 4); float x[8] = {x0[0], x0[1], x0[2], x0[3], x1[0], x1[1], x1[2], x1[3]};
        if (lane < 16) *(u4v*)(CKV + (size_t)m * 128 + lane * 8) = pack8(x); else *(u4v*)(KR + (size_t)m * 32 + (lane - 16) * 8) = pack8(x);
      }
      continue;
    }
    const int sq = m / T, t = m % T, b = g.b0 + sq;
    const bf16_t* z = Z + (size_t)m * IN_W;
    const bool hp = t > 0, hn = t < T - 1;
#pragma unroll
    for (int it = 0; it < 4; ++it) {
      const int ci = it * 64 + lane; const bool valid = ci < 216; const int cc = valid ? ci : 0;
      float zc[8], pv[8], nv[8], sf[8];
      unpack8(*(const u4v*)(z + cc * 8), zc);
      if (hp) unpack8(*(const u4v*)(z - IN_W + cc * 8), pv); else { for (int e = 0; e < 8; ++e) pv[e] = 0.f; }
      if (hn) unpack8(*(const u4v*)(z + IN_W + cc * 8), nv); else { for (int e = 0; e < 8; ++e) nv[e] = 0.f; }
      f4v m0 = *(const f4v*)(mu + cc * 8), m1 = *(const f4v*)(mu + cc * 8 + 4);
#pragma unroll
      for (int e = 0; e < 8; ++e) sf[e] = zc[e] + (0.5f * (pv[e] + nv[e]) - zc[e]) * (e < 4 ? m0[e] : m1[e - 4]);
      bf16_t* rec = SOP + (((size_t)sq * 8 + (lane >> 3)) * T + t) * 576 + (lane & 7) * 8;
      if (it == 0) *(u4v*)rec = pack8(sf);
      else if (it == 1) {
        *(u4v*)(SK + (size_t)m * 512 + lane * 8) = pack8(sf);
        f4v k0 = *(const f4v*)(p.k_k + (size_t)l * 512 + lane * 8), k1 = *(const f4v*)(p.k_k + (size_t)l * 512 + lane * 8 + 4);
        float kr[8]; float n2 = 0.f;
#pragma unroll
        for (int e = 0; e < 8; ++e) { kr[e] = sf[e] * (e < 4 ? k0[e] : k1[e - 4]); n2 += kr[e] * kr[e]; }
        n2 = sum_lpr<8>(n2); const float inv = 1.f / fmaxf(sqrtf(n2), 1e-12f);
#pragma unroll
        for (int e = 0; e < 8; ++e) kr[e] *= inv;
        *(u4v*)(rec + 64) = pack8(kr);
      }
      else if (it == 2) *(u4v*)(rec + 128) = pack8(sf);
      else if (valid) {
        if (lane < 16) { for (int e = 0; e < 8; ++e) sf[e] = tanhf_(sf[e]); }
        *(u4v*)(LORA + (size_t)m * 192 + lane * 8) = pack8(sf);
      }
    }
    {
      const int col = lane < 32 ? ZC_QD + lane * 8 : (lane < 48 ? ZC_KVD + (lane - 32) * 8 : ZC_KR + ((lane - 48) & 3) * 8);
      float x[8]; unpack8(*(const u4v*)(z + col), x);
      float ss = 0.f;
#pragma unroll
      for (int e = 0; e < 8; ++e) ss += x[e] * x[e];
      const float t32 = sum_lpr<32>(ss), t16 = sum_lpr<16>(ss);
      if (lane < 32) {
        const float rs = rsqrtf(t32 * (1.f / 256.f) + 1e-6f); const float* gq = p.q_norm + (size_t)l * 256 + lane * 8; float o[8];
#pragma unroll
        for (int e = 0; e < 8; ++e) o[e] = x[e] * rs * gq[e];
        *(u4v*)(QDN + (size_t)m * 256 + lane * 8) = pack8(o);
      } else if (lane < 48) {
        const float rs = rsqrtf(t16 * (1.f / 128.f) + 1e-6f); const float* gk = p.kv_norm + (size_t)l * 128 + (lane - 32) * 8; float o[8];
#pragma unroll
        for (int e = 0; e < 8; ++e) o[e] = x[e] * rs * gk[e];
        *(u4v*)(CKV + (size_t)m * 128 + (lane - 32) * 8) = pack8(o);
        if (!isden) { float* op = p.out + OUT_CKV + (((size_t)b * NL + l) * T_C + t) * 128 + (lane - 32) * 8; *(f4v*)op = f4v{o[0], o[1], o[2], o[3]}; *(f4v*)(op + 4) = f4v{o[4], o[5], o[6], o[7]}; }
      } else if (lane < 52) {
        float o[8];
        if (isden) {
#pragma unroll
          for (int pq = 0; pq < 4; ++pq) { int pi = (lane - 48) * 4 + pq; float cs = rope[((size_t)t * 16 + pi) * 2], sn = rope[((size_t)t * 16 + pi) * 2 + 1];
            o[2 * pq] = x[2 * pq] * cs - x[2 * pq + 1] * sn; o[2 * pq + 1] = x[2 * pq] * sn + x[2 * pq + 1] * cs; }
        } else {
#pragma unroll
          for (int e = 0; e < 8; ++e) o[e] = x[e];
          float* op = p.out + OUT_KR + (((size_t)b * NL + l) * T_C + t) * 32 + (lane - 48) * 8; *(f4v*)op = f4v{x[0], x[1], x[2], x[3]}; *(f4v*)(op + 4) = f4v{x[4], x[5], x[6], x[7]};
        }
        *(u4v*)(KR + (size_t)m * 32 + (lane - 48) * 8) = pack8(o);
      }
    }
    {
      float v[8]; unpack8(*(const u4v*)(z + ZC_VC + lane * 8), v);
      float s1 = 0.f;
#pragma unroll
      for (int e = 0; e < 8; ++e) { v[e] = geluf_(v[e]); s1 += v[e]; }
      s1 = wave_sum(s1); const float mean = s1 * (1.f / 512.f); float s2 = 0.f;
#pragma unroll
      for (int e = 0; e < 8; ++e) { float d = v[e] - mean; s2 += d * d; }
      s2 = wave_sum(s2); const float rs = rsqrtf(s2 * (1.f / 512.f) + 1e-5f);
      const float* gg = p.g_ln_g + (size_t)l * 512 + lane * 8; const float* gb = p.g_ln_b + (size_t)l * 512 + lane * 8;
#pragma unroll
      for (int e = 0; e < 8; ++e) v[e] = (v[e] - mean) * rs * gg[e] + gb[e];
      *(u4v*)(VCN + (size_t)m * 512 + lane * 8) = pack8(v);
    }
  }
}

__device__ __forceinline__ void stage_g2(const Params& p, const Grp& g, int l, int bid, int nb, char* smem) {
  char* ws = p.ws;
  const bf16_t* Z = (const bf16_t*)(ws + O_Z);
  const float* rope = (const float*)(ws + O_ROPE);
  const int mg = g.mg, mkv = g.mkv, T = g.T, isden = g.isden, nkeys = g.nkeys;
  const int TM_M = (mg + 127) / 128, TM_KV = (mkv + 127) / 128;
  const int NT_Q = TM_M * 6, NT_KV = TM_KV * 8, NT_LORA = TM_M * 8, NT_GM = (mg / 128) * 4, ntt = T / 128, NT_D1 = g.nseq * 8 * ntt;
  const int NT = NT_Q + NT_KV + NT_LORA + NT_GM + NT_D1;
  for (int t0 = bid; t0 < NT; t0 += nb) {
    int t = t0; f4v acc[2][4]; zero_acc<4>(acc);
    if (t < NT_Q) {
      int tn = t / TM_M, tm = t % TM_M;
      gemm_mainloop<4>((const bf16_t*)(ws + O_QDN), 256, tm * 128, mg, (const bf16_t*)(ws + O_WQT), 256, tn * 128, 768, 256, smem, acc);
      bf16_t* Q = (bf16_t*)(ws + O_Q);
      const float scale = 0.10206207261596575f * 1.4426950408889634f;
      epi_foreach<4>(acc, tm * 128, tn * 128, [&](int row, int c0, f4v& v) {
        if (row >= mg) return;
        int cw = c0 % 96; float o0 = v[0], o1 = v[1], o2 = v[2], o3 = v[3];
        if (cw >= 64 && isden) { int tt = row % T_D; int pi = (cw - 64) >> 1; const float* rp = rope + ((size_t)tt * 16 + pi) * 2;
          float c_a = rp[0], s_a = rp[1], c_b = rp[2], s_b = rp[3];
          o0 = v[0] * c_a - v[1] * s_a; o1 = v[0] * s_a + v[1] * c_a; o2 = v[2] * c_b - v[3] * s_b; o3 = v[2] * s_b + v[3] * c_b; }
        *(u2v*)(Q + (size_t)row * 768 + c0) = pack4(o0 * scale, o1 * scale, o2 * scale, o3 * scale);
      });
      continue;
    }
    t -= NT_Q;
    if (t < NT_KV) {
      int tn = t / TM_KV, tm = t % TM_KV;
      gemm_mainloop<4>((const bf16_t*)(ws + O_CKV), 128, tm * 128, mkv, (const bf16_t*)(ws + O_WKVT), 128, tn * 128, 1024, 128, smem, acc);
      bf16_t* KN = (bf16_t*)(ws + O_KN); bf16_t* VT = (bf16_t*)(ws + O_VT);
      epi_foreach<4>(acc, tm * 128, tn * 128, [&](int row, int c0, f4v& v) {
        if (row >= mkv) return;
        int h = c0 >> 7, w = c0 & 127;
        if (w < 64) *(u2v*)(KN + (size_t)row * 512 + h * 64 + w) = pack4(v[0], v[1], v[2], v[3]);
        else { int sq, key;
          if (row < mg) { sq = row / T; key = row % T; } else { int r = row - mg; sq = r / PAST; key = T + r % PAST; }
#pragma unroll
          for (int e = 0; e < 4; ++e) VT[(((size_t)sq * 8 + h) * 64 + (w - 64 + e)) * nkeys + key] = f2bf(v[e]); }
      });
      continue;
    }
    t -= NT_KV;
    if (t < NT_LORA) {
      int dir = t / (TM_M * 4), r = t % (TM_M * 4), tn = r / TM_M, tm = r % TM_M;
      gemm_mainloop<4>((const bf16_t*)(ws + O_LORA) + dir * 64, 192, tm * 128, mg, (const bf16_t*)(ws + O_WUPT) + (size_t)dir * 512 * 64, 64, tn * 128, 512, 64, smem, acc);
      f4v aa[2][4]; zero_acc<4>(aa);
      gemm_mainloop<4>((const bf16_t*)(ws + O_LORA) + 128, 192, tm * 128, mg, (const bf16_t*)(ws + O_WUPT) + (size_t)(2 + dir) * 512 * 64, 64, tn * 128, 512, 64, smem, aa);
      const float* w0 = p.w0 + ((size_t)l * 2 + dir) * 512; const float* a0 = p.a0 + ((size_t)l * 2 + dir) * 512;
      const float* k_a = p.k_a + (size_t)l * 512; const float* r_k = p.r_k + (size_t)l * 512;
      const bf16_t* SK = (const bf16_t*)(ws + O_SK); bf16_t* SOP = (bf16_t*)(ws + O_SOP); float* BON = (float*)(ws + O_BON);
      const int lane = my_tid() & 63, wid = my_tid() >> 6, wm = wid >> 1, wn = wid & 1;
      const int h = tn * 2 + wn;
#pragma unroll
      for (int i = 0; i < 2; ++i) {
        int row = tm * 128 + wm * 32 + i * 16 + (lane & 15); const bool ok = row < mg; if (!ok) row = mg - 1;
        const int sq = row / T, tt = row % T;
        bf16_t* rec = SOP + (((size_t)sq * 8 + h) * T + tt) * 576;
        float bon = 0.f;
#pragma unroll
        for (int j = 0; j < 4; ++j) {
          const int chn = j * 16 + (lane >> 4) * 4, c = h * 64 + chn;
          u2v k2 = *(const u2v*)(SK + (size_t)row * 512 + c), kk2 = *(const u2v*)(rec + 64 + chn), r2 = *(const u2v*)(rec + chn);
          float kv[4] = {bflo(k2.x), bfhi(k2.x), bflo(k2.y), bfhi(k2.y)}, kkv[4] = {bflo(kk2.x), bfhi(kk2.x), bflo(kk2.y), bfhi(kk2.y)}, rv[4] = {bflo(r2.x), bfhi(r2.x), bflo(r2.y), bfhi(r2.y)};
          float dd[4], bb[4], kt[4];
#pragma unroll
          for (int e = 0; e < 4; ++e) {
            float pw = acc[i][j][e] + w0[c + e], pa = aa[i][j][e] + a0[c + e];
            dd[e] = 1.f - fexp_(-0.6065306597126334f * sigmoidf_(pw));
            float av = sigmoidf_(pa);
            bb[e] = kkv[e] * av; kt[e] = kv[e] * (1.f + (av - 1.f) * k_a[c + e]);
            bon += rv[e] * kt[e] * r_k[c + e];
          }
          if (ok) { *(u2v*)(rec + (3 + 3 * dir) * 64 + chn) = pack4(dd[0], dd[1], dd[2], dd[3]); *(u2v*)(rec + (4 + 3 * dir) * 64 + chn) = pack4(bb[0], bb[1], bb[2], bb[3]);
            *(u2v*)(rec + (5 + 3 * dir) * 64 + chn) = pack4(kt[0], kt[1], kt[2], kt[3]); }
        }
        bon += __shfl_xor(bon, 16); bon += __shfl_xor(bon, 32);
        if (ok && lane < 16) BON[((size_t)row * 8 + h) * 2 + dir] = bon;
      }
      continue;
    }
    t -= NT_LORA;
    if (t < NT_GM) {
      int ch = t >> 2, gg = t & 3;
      gemm_mainloop<4, true>((const bf16_t*)(ws + O_WS) + (size_t)gg * 128 * 128, 128, 0, 128, (const bf16_t*)(ws + O_VCNT) + (size_t)ch * 128 * 512, 512, gg * 128, 512, 128, smem, acc);
      bf16_t* O = (bf16_t*)(ws + O_OBR) + (size_t)2 * MG * 512;
      const float* bs = p.g_b_s + ((size_t)l * 4 + gg) * 128;
      epi_foreach<4>(acc, 0, 0, [&](int pp, int c0, f4v& v) {
        int m = ch * 128 + pp; int c = gg * 128 + c0; float bb = bs[pp];
        u2v uu = *(const u2v*)(Z + (size_t)m * IN_W + ZC_U + c), gc = *(const u2v*)(Z + (size_t)m * IN_W + ZC_GC + c);
        *(u2v*)(O + (size_t)m * 512 + c) = pack4(geluf_(bflo(uu.x)) * (v[0] + bb) * siluf_(bflo(gc.x)), geluf_(bfhi(uu.x)) * (v[1] + bb) * siluf_(bfhi(gc.x)),
                                                 geluf_(bflo(uu.y)) * (v[2] + bb) * siluf_(bflo(gc.y)), geluf_(bfhi(uu.y)) * (v[3] + bb) * siluf_(bfhi(gc.y)));
      });
      continue;
    }
    t -= NT_GM;
    {
      int per_seq = 8 * ntt; int sq = t / per_seq; int r = t % per_seq; int gg = r / (2 * ntt); int r2 = r % (2 * ntt); int tj = r2 / ntt, tt = r2 % ntt;
      long mbase = (long)sq * T;
      gemm_mainloop<4>((const bf16_t*)(ws + O_CS128), 128, tj * 128, 256, Z + (size_t)mbase * IN_W + ZC_F + gg * 128, IN_W, tt * 128, T, 128, smem, acc);
      bf16_t* YT = (bf16_t*)(ws + O_YT) + (size_t)mbase * 1024 + (size_t)gg * 128 * 2 * T;
      epi_foreach<4>(acc, tj * 128, tt * 128, [&](int j, int c0, f4v& v) {
        *(u2v*)(YT + (size_t)(j & 127) * 2 * T + (size_t)(j >> 7) * T + c0) = pack4(v[0], v[1], v[2], v[3]);
      });
    }
  }
}

__device__ __forceinline__ bool wave_any(bool pr) {
#ifdef EMU
  return wave_sum(pr ? 1.f : 0.f) > 0.f;
#else
  return __builtin_amdgcn_ballot_w64(pr) != 0ull;
#endif
}
__device__ __forceinline__ void attention_task(const Params& p, const Grp& g, int sq, int h, int qb32) {
  char* ws = p.ws;
  const int lane = my_tid() & 63, ql = lane & 31, hh = lane >> 5;
  const int T = g.T, nkeys = g.nkeys;
  const long mbase = (long)sq * T;
  const bf16_t* Q = (const bf16_t*)(ws + O_Q); const bf16_t* KN = (const bf16_t*)(ws + O_KN); const bf16_t* KRp = (const bf16_t*)(ws + O_KR);
  const bf16_t* VT = (const bf16_t*)(ws + O_VT) + ((size_t)sq * 8 + h) * 64 * nkeys;
  const long mq = mbase + qb32 * 32 + ql;
  s8v qf[6];
#pragma unroll
  for (int s = 0; s < 6; ++s) qf[s] = *(const s8v*)(Q + (size_t)mq * 768 + h * 96 + 16 * s + 8 * hh);
  f16v o0, o1;
#pragma unroll
  for (int i = 0; i < 16; ++i) { o0[i] = 0.f; o1[i] = 0.f; }
  float mrun = -1e30f, lrun = 0.f;
  s8v kf[6], vf[4];
#define ATT_LOAD(k0_, KF, VF) do { const int kk0 = (k0_); \
    const long krow = (kk0 < T) ? mbase + kk0 + ql : (long)g.mg + (long)sq * PAST + (kk0 - T) + ql; \
    _Pragma("unroll") for (int st = 0; st < 4; ++st) KF[st] = *(const s8v*)(KN + (size_t)krow * 512 + h * 64 + 16 * st + 8 * hh); \
    _Pragma("unroll") for (int st = 0; st < 2; ++st) KF[4 + st] = *(const s8v*)(KRp + (size_t)krow * 32 + 16 * st + 8 * hh); \
    _Pragma("unroll") for (int st = 0; st < 2; ++st) _Pragma("unroll") for (int db = 0; db < 2; ++db) { \
      const bf16_t* vp = VT + (size_t)(db * 32 + ql) * nkeys + kk0 + 16 * st + 4 * hh; \
      u2v a_ = *(const u2v*)vp, b_ = *(const u2v*)(vp + 8); VF[st * 2 + db] = __builtin_bit_cast(s8v, u4v{a_.x, a_.y, b_.x, b_.y}); } } while (0)
  for (int k0 = 0; k0 < nkeys; k0 += 32) {
    ATT_LOAD(k0, kf, vf);
    f16v s;
#pragma unroll
    for (int i = 0; i < 16; ++i) s[i] = 0.f;
#pragma unroll
    for (int st = 0; st < 6; ++st) s = __builtin_amdgcn_mfma_f32_32x32x16_bf16(kf[st], qf[st], s, 0, 0, 0);
    float mx = s[0];
#pragma unroll
    for (int i = 1; i < 16; ++i) mx = fmaxf(mx, s[i]);
    mx = fmaxf(mx, __shfl_xor(mx, 32));
    if (wave_any(mx > mrun)) {
      const float mnew = fmaxf(mrun, mx); const float alpha = fexp2_(mrun - mnew); mrun = mnew;
      lrun *= alpha;
#pragma unroll
      for (int i = 0; i < 16; ++i) { o0[i] *= alpha; o1[i] *= alpha; }
    }
    float ps = 0.f; float pe[16];
#pragma unroll
    for (int i = 0; i < 16; ++i) { pe[i] = fexp2_(s[i] - mrun); ps += pe[i]; }
    lrun += ps;
#pragma unroll
    for (int st = 0; st < 2; ++st) {
      const s8v pf = __builtin_bit_cast(s8v, u4v{pk2bf(pe[8 * st], pe[8 * st + 1]), pk2bf(pe[8 * st + 2], pe[8 * st + 3]), pk2bf(pe[8 * st + 4], pe[8 * st + 5]), pk2bf(pe[8 * st + 6], pe[8 * st + 7])});
      o0 = __builtin_amdgcn_mfma_f32_32x32x16_bf16(vf[st * 2], pf, o0, 0, 0, 0);
      o1 = __builtin_amdgcn_mfma_f32_32x32x16_bf16(vf[st * 2 + 1], pf, o1, 0, 0, 0);
    }
  }
#undef ATT_LOAD
  const float ltot = lrun + __shfl_xor(lrun, 32); const float inv = 1.f / ltot;
  const bf16_t* Z = (const bf16_t*)(ws + O_Z);
  bf16_t* O = (bf16_t*)(ws + O_OBR) + (size_t)1 * MG * 512;
#pragma unroll
  for (int db = 0; db < 2; ++db)
#pragma unroll
    for (int q4 = 0; q4 < 4; ++q4) {
      const int dv = db * 32 + 8 * q4 + 4 * hh;
      u2v gt = *(const u2v*)(Z + (size_t)mq * IN_W + ZC_GB + h * 64 + dv);
      const float x0 = (db == 0 ? o0[4 * q4] : o1[4 * q4]) * inv, x1 = (db == 0 ? o0[4 * q4 + 1] : o1[4 * q4 + 1]) * inv, x2 = (db == 0 ? o0[4 * q4 + 2] : o1[4 * q4 + 2]) * inv, x3 = (db == 0 ? o0[4 * q4 + 3] : o1[4 * q4 + 3]) * inv;
      *(u2v*)(O + (size_t)mq * 512 + h * 64 + dv) = pack4(x0 * siluf_(bflo(gt.x)), x1 * siluf_(bfhi(gt.x)), x2 * siluf_(bflo(gt.y)), x3 * siluf_(bfhi(gt.y)));
    }
}

__device__ __forceinline__ void stage_dft2(const Params& p, const Grp& g, int bid, int nb, char* smem) {
  char* ws = p.ws;
  const bf16_t* Z = (const bf16_t*)(ws + O_Z);
  const int T = g.T, ntt = T / 128;
  const int NT_D2 = g.nseq * 4 * ntt;
  const int soff = (g.nseq * 32) % nb;
  for (int t = (bid - soff + nb) % nb; t < NT_D2; t += nb) {
    int sq = t / (4 * ntt), r = t % (4 * ntt), gg = r / ntt, tt = r % ntt;
    long mbase = (long)sq * T;
    f4v acc[2][4]; zero_acc<4>(acc);
    gemm_mainloop<4>((const bf16_t*)(ws + (g.isden ? O_A2D : O_A2C)), 2 * T, tt * 128, T, (const bf16_t*)(ws + O_YT) + (size_t)mbase * 1024 + (size_t)gg * 128 * 2 * T, 2 * T, 0, 128, 2 * T, smem, acc);
    bf16_t* O = (bf16_t*)(ws + O_OBR) + (size_t)3 * MG * 512;
    const float sc = rsqrtf(128.f * (float)T);
    epi_foreach<4>(acc, tt * 128, 0, [&](int row, int c0, f4v& v) {
      long m = mbase + row; int c = gg * 128 + c0; u2v gd = *(const u2v*)(Z + (size_t)m * IN_W + ZC_GD + c);
      *(u2v*)(O + (size_t)m * 512 + c) = pack4(v[0] * sc * siluf_(bflo(gd.x)), v[1] * sc * siluf_(bfhi(gd.x)), v[2] * sc * siluf_(bflo(gd.y)), v[3] * sc * siluf_(bfhi(gd.y)));
    });
  }
}

constexpr int PL_STR = 72;
constexpr int PCH_MA = 0, PCH_MB = 4608, PCH_TBT = 9216, PCH_MBT = 10240, PCH_TK = 11264, PCH_MK = 12288, PCH_LDS = 13312;
__device__ __forceinline__ void pchunk_task(const Params& p, const Grp& g, int task, char* wl) {
  char* ws = p.ws;
  const int lane = my_tid() & 63, ql = lane & 31, hh = lane >> 5;
  const int T = g.T, nch = T >> 4;
  const int ch = task / nch, ci = task % nch;
  const int dir = ch & 1, h = (ch >> 1) & 7, sq = ch >> 4;
  const bf16_t* rec0 = (const bf16_t*)(ws + O_SOP) + ((size_t)sq * 8 + h) * T * 576;
  char* cm = ws + O_CM + (size_t)task * CM_REC;
  float At[16], Rt[16], Bh[16], Kh[16]; float W = 1.f;
#pragma unroll
  for (int j = 0; j < 16; ++j) {
    const int st = ci * 16 + j, tt = dir ? T - 1 - st : st;
    const bf16_t* rec = rec0 + (size_t)tt * 576;
    const float r = bf2f(rec[lane]), kk = bf2f(rec[64 + lane]), d = bf2f(rec[(3 + 3 * dir) * 64 + lane]), b = bf2f(rec[(4 + 3 * dir) * 64 + lane]), kt = bf2f(rec[(5 + 3 * dir) * 64 + lane]);
    At[j] = -kk * W; W *= (1.f - d); const float iw = 1.f / W; Rt[j] = r * W; Bh[j] = b * iw; Kh[j] = kt * iw;
  }
  {
    float x[8];
#pragma unroll
    for (int q = 0; q < 2; ++q) {
#pragma unroll
      for (int e = 0; e < 8; ++e) { const int st = ci * 16 + q * 8 + e, tt = dir ? T - 1 - st : st; x[e] = bf2f(rec0[(size_t)tt * 576 + 128 + lane]); }
      *(u4v*)(cm + CM_VT + lane * 32 + q * 16) = pack8(x);
    }
  }
  {
    float x[8];
#pragma unroll
    for (int q = 0; q < 4; ++q) {
#pragma unroll
      for (int e = 0; e < 8; ++e) x[e] = (q < 2 ? Bh[q * 8 + e] : Kh[(q - 2) * 8 + e]) * W;
      *(u4v*)(cm + CM_BKT + lane * 64 + q * 16) = pack8(x);
    }
    *(float*)(cm + CM_WL + lane * 4) = W;
  }
  bf16_t* MA = (bf16_t*)(wl + PCH_MA); bf16_t* MB = (bf16_t*)(wl + PCH_MB);
  float* TBT = (float*)(wl + PCH_TBT); float* MBT = (float*)(wl + PCH_MBT); float* TK = (float*)(wl + PCH_TK); float* MK = (float*)(wl + PCH_MK);
  WAVE_SYNC();
#pragma unroll
  for (int j = 0; j < 16; ++j) { MA[j * PL_STR + lane] = f2bf(Bh[j]); MA[(16 + j) * PL_STR + lane] = f2bf(Kh[j]); MB[j * PL_STR + lane] = f2bf(At[j]); MB[(16 + j) * PL_STR + lane] = f2bf(Rt[j]); }
  WAVE_SYNC();
  f16v D;
#pragma unroll
  for (int i = 0; i < 16; ++i) D[i] = 0.f;
#pragma unroll
  for (int s4 = 0; s4 < 4; ++s4) {
    const s8v fa = *(const s8v*)(MA + ql * PL_STR + 16 * s4 + 8 * hh), fb = *(const s8v*)(MB + ql * PL_STR + 16 * s4 + 8 * hh);
    D = __builtin_amdgcn_mfma_f32_32x32x16_bf16(fa, fb, D, 0, 0, 0);
  }
#pragma unroll
  for (int r = 0; r < 16; ++r) {
    const int i = (r & 3) + 8 * (r >> 2) + 4 * hh; const float v = D[r];
    if (r < 8) { if (ql < 16) TBT[ql * 16 + i] = (i < ql) ? v : 0.f; else MBT[(ql - 16) * 16 + i] = (i <= ql - 16) ? v : 0.f; }
    else { const int i2 = i - 16; if (ql < 16) TK[i2 * 16 + ql] = (i2 < ql) ? v : 0.f; else MK[i2 * 16 + (ql - 16)] = (i2 <= ql - 16) ? v : 0.f; }
  }
  WAVE_SYNC();
  const int l16 = lane & 15;
  float Z[16], Z2[16];
#pragma unroll
  for (int j = 0; j < 16; ++j) { Z[j] = 0.f; Z2[j] = 0.f; }
#pragma unroll
  for (int j = 0; j < 16; ++j) {
    float a1 = At[j], a2 = TK[l16 * 16 + j];
#pragma unroll
    for (int c4 = 0; c4 * 4 < j; ++c4) { const f4v tv = *(const f4v*)(TBT + j * 16 + c4 * 4);
#pragma unroll
      for (int e = 0; e < 4; ++e) if (c4 * 4 + e < j) { a1 += Z[c4 * 4 + e] * tv[e]; a2 += Z2[c4 * 4 + e] * tv[e]; } }
    Z[j] = a1; Z2[j] = a2;
  }
  bf16_t* GT = (bf16_t*)(cm + CM_GT);
#pragma unroll
  for (int t = 0; t < 16; ++t) {
    float a1 = Rt[t], a2 = MK[l16 * 16 + t];
#pragma unroll
    for (int c4 = 0; c4 * 4 <= t; ++c4) { const f4v mv = *(const f4v*)(MBT + t * 16 + c4 * 4);
#pragma unroll
      for (int e = 0; e < 4; ++e) if (c4 * 4 + e <= t) { a1 += Z[c4 * 4 + e] * mv[e]; a2 += Z2[c4 * 4 + e] * mv[e]; } }
    GT[(16 + t) * 80 + lane] = f2bf(a1);
    if (lane < 16) GT[(16 + t) * 80 + 64 + lane] = f2bf(a2);
  }
#pragma unroll
  for (int j = 0; j < 16; ++j) { GT[j * 80 + lane] = f2bf(Z[j]); if (lane < 16) GT[j * 80 + 64 + lane] = f2bf(Z2[j]); }
}

__device__ __forceinline__ s8v cvt8(const f16v& a, int o) {
  return __builtin_bit_cast(s8v, u4v{pk2bf(a[o], a[o + 1]), pk2bf(a[o + 2], a[o + 3]), pk2bf(a[o + 4], a[o + 5]), pk2bf(a[o + 6], a[o + 7])});
}
struct ScanOps { s8v gA[5], bU[2], bV[2], vf; float wreg; };
__device__ __forceinline__ void scan2_load(ScanOps& o, const char* cm, const bf16_t* rec0, int ci, int T, int dir, int ql, int hh, int row) {
  const bf16_t* GT = (const bf16_t*)(cm + CM_GT); const bf16_t* BKT = (const bf16_t*)(cm + CM_BKT);
  o.wreg = *(const float*)(cm + CM_WL + (ql + 32 * hh) * 4);
#pragma unroll
  for (int s = 0; s < 4; ++s) { const bf16_t* q = GT + ql * 80 + 16 * s + 4 * hh; u2v lo = *(const u2v*)q, hi = *(const u2v*)(q + 8); o.gA[s] = __builtin_bit_cast(s8v, u4v{lo.x, lo.y, hi.x, hi.y}); }
  o.gA[4] = *(const s8v*)(GT + ql * 80 + 64 + 8 * hh);
#pragma unroll
  for (int k2 = 0; k2 < 2; ++k2) { const bf16_t* q = BKT + (32 * k2 + ql) * 32; u2v lo = *(const u2v*)(q + 4 * hh), hi = *(const u2v*)(q + 8 + 4 * hh);
    o.bU[k2] = __builtin_bit_cast(s8v, u4v{lo.x, lo.y, hi.x, hi.y}); o.bV[k2] = *(const s8v*)(q + 16 + 8 * hh); }
  o.vf = *(const s8v*)(cm + CM_VT + row * 32 + hh * 16);
}
__device__ __forceinline__ void scan2_task(const Params& p, const Grp& g, int l, int task, char* wl) {
  char* ws = p.ws;
  const int lane = my_tid() & 63, ql = lane & 31, hh = lane >> 5;
  const int T = g.T, nch = T >> 4;
  const int ch = task >> 1, rt = task & 1;
  const int dir = ch & 1, h = (ch >> 1) & 7, sq = ch >> 4;
  const int row = rt * 32 + ql;
  const long mbase = (long)sq * T;
  const bf16_t* rec0 = (const bf16_t*)(ws + O_SOP) + ((size_t)sq * 8 + h) * T * 576;
  const char* cm0 = ws + O_CM + (size_t)ch * nch * CM_REC;
  float* YS = (float*)(ws + O_YS) + (size_t)dir * MG * 512;
  float* wlf = (float*)wl;
  f16v a0, a1;
  if (g.isden) { const float* st = (dir ? p.st_b : p.st_f) + ((((size_t)sq * NL + l) * 8 + h) * 64 + row) * 64;
#pragma unroll
    for (int q = 0; q < 4; ++q) { f4v x = *(const f4v*)(st + 8 * q + 4 * hh), y = *(const f4v*)(st + 32 + 8 * q + 4 * hh);
#pragma unroll
      for (int e = 0; e < 4; ++e) { a0[4 * q + e] = x[e]; a1[4 * q + e] = y[e]; } } }
  else {
#pragma unroll
    for (int i = 0; i < 16; ++i) { a0[i] = 0.f; a1[i] = 0.f; } }
  ScanOps s0, s1, s2;
  scan2_load(s0, cm0, rec0, 0, T, dir, ql, hh, row);
  scan2_load(s1, cm0 + CM_REC, rec0, 1, T, dir, ql, hh, row);
#define SCAN2_STEP(CUR, ci_) do { const int ci = (ci_); \
    WAVE_SYNC(); wlf[lane] = CUR.wreg; WAVE_SYNC(); \
    const s8v vfrag = CUR.vf; \
    f16v D; _Pragma("unroll") for (int i = 0; i < 16; ++i) D[i] = 0.f; \
    D = __builtin_amdgcn_mfma_f32_32x32x16_bf16(CUR.gA[0], cvt8(a0, 0), D, 0, 0, 0); \
    D = __builtin_amdgcn_mfma_f32_32x32x16_bf16(CUR.gA[1], cvt8(a0, 8), D, 0, 0, 0); \
    D = __builtin_amdgcn_mfma_f32_32x32x16_bf16(CUR.gA[2], cvt8(a1, 0), D, 0, 0, 0); \
    D = __builtin_amdgcn_mfma_f32_32x32x16_bf16(CUR.gA[3], cvt8(a1, 8), D, 0, 0, 0); \
    D = __builtin_amdgcn_mfma_f32_32x32x16_bf16(CUR.gA[4], vfrag, D, 0, 0, 0); \
    _Pragma("unroll") for (int i = 0; i < 8; ++i) { const int st = ci * 16 + (i & 3) + 8 * (i >> 2) + 4 * hh, tt = dir ? T - 1 - st : st; YS[(size_t)(mbase + tt) * 512 + h * 64 + row] = D[8 + i]; } \
    const s8v uf = cvt8(D, 0); \
    const float* wq = wlf + 4 * hh; \
    _Pragma("unroll") for (int q = 0; q < 4; ++q) { const f4v w0 = *(const f4v*)(wq + 8 * q), w1 = *(const f4v*)(wq + 32 + 8 * q); \
      _Pragma("unroll") for (int e = 0; e < 4; ++e) { a0[4 * q + e] *= w0[e]; a1[4 * q + e] *= w1[e]; } } \
    a0 = __builtin_amdgcn_mfma_f32_32x32x16_bf16(CUR.bU[0], uf, a0, 0, 0, 0); \
    a0 = __builtin_amdgcn_mfma_f32_32x32x16_bf16(CUR.bV[0], vfrag, a0, 0, 0, 0); \
    a1 = __builtin_amdgcn_mfma_f32_32x32x16_bf16(CUR.bU[1], uf, a1, 0, 0, 0); \
    a1 = __builtin_amdgcn_mfma_f32_32x32x16_bf16(CUR.bV[1], vfrag, a1, 0, 0, 0); } while (0)
  int c = 0;
  for (; c + 3 <= nch; c += 3) {
    if (c + 2 < nch) scan2_load(s2, cm0 + (size_t)(c + 2) * CM_REC, rec0, c + 2, T, dir, ql, hh, row);
    SCAN2_STEP(s0, c);
    if (c + 3 < nch) scan2_load(s0, cm0 + (size_t)(c + 3) * CM_REC, rec0, c + 3, T, dir, ql, hh, row);
    SCAN2_STEP(s1, c + 1);
    if (c + 4 < nch) scan2_load(s1, cm0 + (size_t)(c + 4) * CM_REC, rec0, c + 4, T, dir, ql, hh, row);
    SCAN2_STEP(s2, c + 2);
  }
  if (c < nch) SCAN2_STEP(s0, c);
  if (c + 1 < nch) SCAN2_STEP(s1, c + 1);
#undef SCAN2_STEP
  if (!g.isden) { float* so = p.out + (dir ? OUT_SB : OUT_SF) + ((((size_t)(g.b0 + sq) * NL + l) * 8 + h) * 64 + row) * 64;
#pragma unroll
    for (int q = 0; q < 4; ++q) { *(f4v*)(so + 8 * q + 4 * hh) = f4v{a0[4 * q], a0[4 * q + 1], a0[4 * q + 2], a0[4 * q + 3]}; *(f4v*)(so + 32 + 8 * q + 4 * hh) = f4v{a1[4 * q], a1[4 * q + 1], a1[4 * q + 2], a1[4 * q + 3]}; } }
}

__device__ __forceinline__ void stage_mixA(const Params& p, const Grp& g, int bid, int nb, char* smem) {
  const int wid = my_tid() >> 6;
  const int NP = g.nseq * 16 * (g.T >> 4), q32 = g.T / 32, NA = g.nseq * 8 * q32;
  char* wl = smem + wid * PCH_LDS;
  for (int task = wid * nb + bid; task < NP + NA; task += nb * NWAVE) {
    if (task < NP) pchunk_task(p, g, task, wl);
    else { int t = task - NP; int sq = t / (8 * q32), r = t % (8 * q32); attention_task(p, g, sq, r / q32, r % q32); }
  }
}
__device__ __forceinline__ void stage_scanS(const Params& p, const Grp& g, int l, int bid, int nb, char* smem) {
  const int wid = my_tid() >> 6;
  const int NS = g.nseq * 32;
  for (int task = wid * nb + bid; task < NS; task += nb * NWAVE) scan2_task(p, g, l, task, smem + wid * 768);
  __syncthreads();
}

__device__ __forceinline__ void stage_e3(const Params& p, const Grp& g, int l, int bid, int nb) {
  const int lane = my_tid() & 63, wid = my_tid() >> 6;
  char* ws = p.ws;
  const float* YS = (const float*)(ws + O_YS); const bf16_t* SOP = (const bf16_t*)(ws + O_SOP); const float* BON = (const float*)(ws + O_BON); const int T = g.T;
  const bf16_t* Z = (const bf16_t*)(ws + O_Z); bf16_t* O = (bf16_t*)(ws + O_OBR);
  for (int m = bid * NWAVE + wid; m < g.mg; m += nb * NWAVE) {
#pragma unroll 2
    for (int i = 0; i < 8; ++i) {
      int c = lane + 64 * i;
      float o = YS[(size_t)m * 512 + c] + YS[((size_t)MG + m) * 512 + c];
      float mean = wave_sum(o) * (1.f / 64.f); float d = o - mean; float var = wave_sum(d * d) * (1.f / 64.f);
      float y = d * rsqrtf(var + 64e-5f) * p.ln_g[(size_t)l * 512 + c] + p.ln_b[(size_t)l * 512 + c] + (BON[((size_t)m * 8 + i) * 2] + BON[((size_t)m * 8 + i) * 2 + 1]) * bf2f(SOP[(((size_t)(m / T) * 8 + i) * T + (m % T)) * 576 + 128 + lane]);
      O[(size_t)m * 512 + c] = f2bf(y * siluf_(bf2f(Z[(size_t)m * IN_W + ZC_GA + c])));
    }
  }
}

__device__ __forceinline__ void stage_gates(const Params& p, const Grp& g, int l, int bid, int nb, char* smem) {
  const bf16_t* H = (const bf16_t*)(p.ws + O_H);
  const bf16_t* W = (const bf16_t*)(p.ws + O_WMT);
  bf16_t* GT = (bf16_t*)(p.ws + O_GATES);
  const float* bm = p.b_merge + (size_t)l * 4096;
#ifndef EMU
  if ((g.mg & 255) == 0) {
    pg8::Gemm gm; gm.A = H; gm.Bt = W; gm.M = g.mg; gm.N = 4096; gm.K = 1024;
    pg8::StaticOrder S; S.init(gm.M, gm.N, nb, bid);
    pg8::EpiSigmoid E; E.O = GT; E.ldc = 4096; E.bias = bm;
    pg8::gemm_phase<pg8::EpiSigmoid, pg8::StaticOrder>((PG8_LAS unsigned char*)smem, gm, S, E);
    return;
  }
#endif
  const int TM = (g.mg + 127) / 128, mg = g.mg;
  for (int t = bid; t < TM * 32; t += nb) {
    int tn = t / TM, tm = t % TM; f4v acc[2][4]; zero_acc<4>(acc);
    gemm_mainloop<4>(H, 1024, tm * 128, mg, W, 1024, tn * 128, 4096, 1024, smem, acc);
    epi_foreach<4>(acc, tm * 128, tn * 128, [&](int row, int c0, f4v& v) {
      if (row < mg) *(u2v*)(GT + (size_t)row * 4096 + c0) = pack4(sigmoidf_(v[0] + bm[c0]), sigmoidf_(v[1] + bm[c0 + 1]), sigmoidf_(v[2] + bm[c0 + 2]), sigmoidf_(v[3] + bm[c0 + 3]));
    });
  }
}

__device__ __forceinline__ void stage_g8(const Params& p, const Grp& g, int l, int bid, int nb, char* smem) {
  char* ws = p.ws;
  bf16_t* MGD = (bf16_t*)(ws + O_MERGED);
  const bf16_t* GT = (const bf16_t*)(ws + O_GATES);
  const int TM = (g.mg + 127) / 128, mg = g.mg;
  for (int t = bid; t < TM * 8; t += nb) {
    int tn = t / TM, tm = t % TM;
    f4v macc[2][4]; zero_acc<4>(macc);
    for (int n = 0; n < 4; ++n) {
      f4v ap[2][4]; zero_acc<4>(ap);
      gemm_mainloop<4>((const bf16_t*)(ws + O_OBR) + (size_t)n * MG * 512, 512, tm * 128, mg, (const bf16_t*)(ws + O_WBRT) + (size_t)n * 1024 * 512, 512, tn * 128, 1024, 512, smem, ap);
      const int lane = my_tid() & 63, wid = my_tid() >> 6, wm = wid >> 1, wn = wid & 1;
#pragma unroll
      for (int i = 0; i < 2; ++i)
#pragma unroll
        for (int j = 0; j < 4; ++j) {
          int row = tm * 128 + wm * 32 + i * 16 + (lane & 15); row = row < mg ? row : mg - 1;
          int c0 = tn * 128 + wn * 64 + j * 16 + (lane >> 4) * 4;
          u2v gt = *(const u2v*)(GT + (size_t)row * 4096 + n * 1024 + c0);
          macc[i][j][0] += bflo(gt.x) * ap[i][j][0]; macc[i][j][1] += bfhi(gt.x) * ap[i][j][1]; macc[i][j][2] += bflo(gt.y) * ap[i][j][2]; macc[i][j][3] += bfhi(gt.y) * ap[i][j][3];
        }
    }
    epi_foreach<4>(macc, tm * 128, tn * 128, [&](int row, int c0, f4v& v) {
      if (row < mg) *(u2v*)(MGD + (size_t)row * 1024 + c0) = pack4(v[0], v[1], v[2], v[3]);
    });
  }
  (void)l;
}

__device__ __forceinline__ void stage_g9(const Params& p, const Grp& g, int l, int bid, int nb, char* smem) {
  char* ws = p.ws;
  float* X = p.out + (size_t)g.m0 * 1024;
  const float* modp = (const float*)(ws + O_MOD) + (size_t)l * 3 * 3072 + 2048;
  const int TM = (g.mg + 127) / 128, mg = g.mg;
  for (int t = bid; t < TM * 8; t += nb) {
    int tn = t / TM, tm = t % TM;
    f4v acc[2][4]; zero_acc<4>(acc);
    gemm_mainloop<4>((const bf16_t*)(ws + O_MERGED), 1024, tm * 128, mg, (const bf16_t*)(ws + O_WOUTT), 1024, tn * 128, 1024, 1024, smem, acc);
    epi_foreach<4>(acc, tm * 128, tn * 128, [&](int row, int c0, f4v& v) {
      if (row < mg) { const float* gt = modp + (size_t)mod_index(g, row) * 3072 + c0; f4v* xp = (f4v*)(X + (size_t)row * 1024 + c0); f4v x = *xp;
        x[0] += gt[0] * v[0]; x[1] += gt[1] * v[1]; x[2] += gt[2] * v[2]; x[3] += gt[3] * v[3]; *xp = x; }
    });
  }
}

__device__ __forceinline__ void stage_final(const Params& p, int bid, int nb) {
  const int lane = my_tid() & 63, wid = my_tid() >> 6;
  for (int m = bid * NWAVE + wid; m < M; m += nb * NWAVE) {
    float* xr = p.out + (size_t)m * 1024; float4 q[4]; float ss = 0.f;
#pragma unroll
    for (int i = 0; i < 4; ++i) { q[i] = *(const float4*)(xr + i * 256 + lane * 4); ss += q[i].x * q[i].x + q[i].y * q[i].y + q[i].z * q[i].z + q[i].w * q[i].w; }
    ss = wave_sum(ss); float rs = rsqrtf(ss * (1.f / 1024.f) + 1e-6f);
#pragma unroll
    for (int i = 0; i < 4; ++i) { int c = i * 256 + lane * 4; float4 gm = *(const float4*)(p.final_g + c);
      *(float4*)(xr + c) = make_float4(q[i].x * rs * gm.x, q[i].y * rs * gm.y, q[i].z * rs * gm.z, q[i].w * rs * gm.w); }
  }
}

#ifdef EMU
#define DECL_SMEM(name) char* name = emu::smem()
#else
#define DECL_SMEM(name) __shared__ __attribute__((aligned(16))) char name[SMEM_BYTES]
#endif

#ifdef EMU
struct GridBar { __device__ void sync() const { emu::grid_sync(); } };
#else
#define XB_TMO      128
#define XB_XCNT(j)  (256  + 64 * (j))
#define XB_XSUB(j)  (1280 + 64 * (j))
#define XB_XGEN(j)  (2304 + 64 * (j))
#define XB_TOP      3328
#define XB_TOPGEN   3392
#define XB_SPIN_CAP (1u << 20)
#define LAS __attribute__((address_space(3)))
__device__ __forceinline__ unsigned xb_ld(unsigned* p)              { return __hip_atomic_load(p, __ATOMIC_RELAXED, __HIP_MEMORY_SCOPE_AGENT); }
__device__ __forceinline__ unsigned xb_add(unsigned* p, unsigned v) { return __hip_atomic_fetch_add(p, v, __ATOMIC_RELAXED, __HIP_MEMORY_SCOPE_AGENT); }
__device__ __forceinline__ unsigned xb_xcc_id() { return (unsigned)__builtin_amdgcn_s_getreg((3 << 11) | 20) & 0xFu; }
#define XB_SPIN(cond, bar) do { unsigned _sp = 0; while (cond) { __builtin_amdgcn_s_sleep(1); \
    if ((++_sp & 255u) == 0u) { if (xb_ld(&(bar)[XB_TMO])) break; if (_sp > XB_SPIN_CAP) { atomicAdd(&(bar)[XB_TMO], 1u); break; } } } } while (0)
struct GridBar {
  unsigned* bar; unsigned x; volatile LAS unsigned* st;
  __device__ __forceinline__ void post(unsigned* b, volatile LAS unsigned* s_) {
    bar = b; x = xb_xcc_id(); st = s_;
    if (threadIdx.x == 0) (void)xb_add(&bar[XB_XCNT(x)], 1u);
  }
  __device__ __forceinline__ void complete(unsigned& nloc, unsigned& nx) const {
    const unsigned G = gridDim.x;
    unsigned sum, cnt, mine, sp = 0u;
    for (;;) {
      sum = 0u; cnt = 0u; mine = 0u;
#pragma unroll
      for (unsigned j = 0; j < 16; ++j) { const unsigned c = xb_ld(&bar[XB_XCNT(j)]); sum += c; cnt += (c > 0u) ? 1u : 0u; mine = (j == x) ? c : mine; }
      if (sum == G) break;
      __builtin_amdgcn_s_sleep(1);
      if ((++sp & 255u) == 0u) { if (xb_ld(&bar[XB_TMO])) break; if (sp > XB_SPIN_CAP) { atomicAdd(&bar[XB_TMO], 1u); break; } }
    }
    nloc = mine > 0u ? mine : 1u; nx = cnt > 0u ? cnt : 1u;
  }
  __device__ __forceinline__ void sync() const {
    asm volatile("s_waitcnt vmcnt(0)" ::: "memory");
    __syncthreads();
    if (threadIdx.x == 0) {
      __builtin_amdgcn_s_waitcnt(0);
      unsigned nloc = st[0], nx = st[1];
      if (nloc == 0u) { complete(nloc, nx); st[0] = nloc; st[1] = nx; }
      const unsigned old = xb_add(&bar[XB_XSUB(x)], 1u);
      const unsigned gen = old / nloc;
      if (old + 1u == (gen + 1u) * nloc) {
        __builtin_amdgcn_fence(__ATOMIC_RELEASE, "agent");
        asm volatile("s_waitcnt vmcnt(0)" ::: "memory");
        const unsigned og = xb_add(&bar[XB_TOP], 1u);
        const unsigned tg = og / nx;
        if (og + 1u == (tg + 1u) * nx) xb_add(&bar[XB_TOPGEN], 1u);
        else XB_SPIN(xb_ld(&bar[XB_TOPGEN]) == tg, bar);
        __builtin_amdgcn_fence(__ATOMIC_ACQUIRE, "agent");
        xb_add(&bar[XB_XGEN(x)], 1u);
        asm volatile("s_waitcnt vmcnt(0)" ::: "memory");
      } else {
        XB_SPIN(xb_ld(&bar[XB_XGEN(x)]) == gen, bar);
        __builtin_amdgcn_fence(__ATOMIC_ACQUIRE, "agent");
        asm volatile("s_waitcnt vmcnt(0)" ::: "memory");
      }
    }
    __syncthreads();
  }
};
#endif

#ifndef EMU
namespace cg = cooperative_groups;
#else
namespace cg = cooperative_groups;
#endif

__global__ void __launch_bounds__(NTHR) mega_kernel(Params p) {
  DECL_SMEM(smem);
  cg::grid_group grid = cg::this_grid();
  const int bid0 = blockIdx.x, nb0 = gridDim.x;
  GridBar gb;
#ifndef EMU
  if (threadIdx.x == 0) { volatile LAS unsigned* w = (volatile LAS unsigned*)(smem + SMEM_STAGE); w[0] = 0u; w[1] = 0u; w[2] = 0u; w[3] = 0u; }
  __syncthreads();
  gb.post((unsigned*)(p.ws + O_BAR), (volatile LAS unsigned*)(smem + SMEM_STAGE));
#endif
#ifndef PROBE_DUP
#define PROBE_DUP 0
#endif
#define STG(gi_, call) do { Params q = p; q.ws = opaque(q.ws); q.out = opaque(q.out); const int bid = opaque_i(bid0); const int nb = opaque_i(nb0); const Grp g = get_grp(opaque_i(gi_)); (void)g; call; } while (0)
#define STP(bit, gi_, call) do { STG(gi_, call); if (PROBE_DUP & (bit)) { STG(gi_, call); } } while (0)
  for (int l = 0; l < NL; ++l) {
    STP(1, 0, stage_prep(q, l, bid, nb, smem));
    if (l == 0) grid.sync();
    STP(2, 0, stage_h(q, g, l, bid, nb));
    gb.sync();
    for (int gi = 0; gi < NGRP; ++gi) {
      STP(4, gi, stage_g1(q, g, bid, nb, smem)); gb.sync();
      STP(8, gi, stage_e1(q, g, l, bid, nb)); gb.sync();
      STP(16, gi, stage_g2(q, g, l, bid, nb, smem)); gb.sync();
      STP(64, gi, stage_mixA(q, g, bid, nb, smem)); gb.sync();
      STP(32, gi, stage_scanS(q, g, l, bid, nb, smem));
      STP(128, gi, stage_dft2(q, g, bid, nb, smem)); gb.sync();
      STP(256, gi, stage_e3(q, g, l, bid, nb));
      STP(512, gi, stage_gates(q, g, l, bid, nb, smem)); gb.sync();
      STP(1024, gi, stage_g8(q, g, l, bid, nb, smem)); gb.sync();
      STG(gi, stage_g9(q, g, l, bid, nb, smem));
      if (gi + 1 < NGRP) { STP(2, gi + 1, stage_h(q, g, l, bid, nb)); }
      gb.sync();
    }
  }
  STG(0, stage_final(q, bid, nb));
#undef STP
#undef STG
}

extern "C" void kernel_launch(void* const* d_in, const int* in_sizes, int n_in, void* d_out, int out_size, void* d_ws, size_t ws_size,
                              hipStream_t stream) {
  Params p{};
  const float** pp = (const float**)&p;
  for (int i = 0; i < 35; ++i) pp[i] = (const float*)d_in[i];
  p.out = (float*)d_out; p.ws = (char*)d_ws;
#ifdef EMU
  emu::set_coop(true);
  emu_launch(dim3(8), dim3(NTHR), [=]() { mega_kernel(p); });
  emu::set_coop(false);
#else
  static int grid_blocks = 0;
  if (!grid_blocks) {
    int dev = 0, cus = 0, per_cu = 0;
    (void)hipGetDevice(&dev);
    (void)hipDeviceGetAttribute(&cus, hipDeviceAttributeMultiprocessorCount, dev);
    (void)hipOccupancyMaxActiveBlocksPerMultiprocessor(&per_cu, mega_kernel, NTHR, 0);
    if (per_cu > 1) per_cu = 1;
    if (per_cu < 1) per_cu = 1;
    grid_blocks = cus * per_cu;
  }
  (void)hipMemsetAsync((char*)d_ws + O_BAR, 0, BAR_BYTES, stream);
  void* args[] = {&p};
  (void)hipLaunchCooperativeKernel((void*)mega_kernel, dim3(grid_blocks), dim3(NTHR), args, 0, stream);
#endif
  (void)in_sizes; (void)n_in; (void)out_size; (void)ws_size;
}
```

```cpp
#ifdef EMU
#include "hip_emu.h"
#else
#include <hip/hip_runtime.h>
#include <hip/hip_cooperative_groups.h>
#endif
#include <stdint.h>

#ifndef CFG_BATCH
#define CFG_BATCH 32
#define CFG_SEQ 256
#define CFG_DEC_BATCH 2
#define CFG_DEC_SEQ 2048
#define CFG_PAST 512
#define CFG_NGRP_C 2
#endif
constexpr int D = 1024, NL = 2;
constexpr int NB_C = CFG_BATCH, T_C = CFG_SEQ, NB_D = CFG_DEC_BATCH, T_D = CFG_DEC_SEQ, PAST = CFG_PAST;
constexpr int M_C = NB_C * T_C, M_D = NB_D * T_D, M = M_C + M_D;
constexpr int NGRP_C = CFG_NGRP_C, NGRP = 1 + NGRP_C;
constexpr int MGC = M_C / NGRP_C, SEQ_PER_CG = NB_C / NGRP_C;
constexpr int MG = MGC > M_D ? MGC : M_D;
constexpr int MKV = MG + NB_D * PAST;
constexpr int KEYS_D = T_D + PAST;
constexpr int IN_W = 5728;
constexpr int ZC_R = 0, ZC_K = 512, ZC_V = 1024, ZC_WDF = 1536, ZC_GA = 1728, ZC_QD = 2240, ZC_KVD = 2496, ZC_KR = 2624,
              ZC_GB = 2656, ZC_U = 3168, ZC_VC = 3680, ZC_GC = 4192, ZC_F = 4704, ZC_GD = 5216;
constexpr int SHIFT_W = 1728;
static_assert(M_C % NGRP_C == 0 && NB_C % NGRP_C == 0, "ctx groups");
static_assert(T_C % 128 == 0 && T_D % 128 == 0 && PAST % 32 == 0, "seq multiples");

typedef unsigned short bf16_t;
typedef short s8v __attribute__((ext_vector_type(8)));
typedef float f4v __attribute__((ext_vector_type(4)));
typedef float f16v __attribute__((ext_vector_type(16)));
typedef unsigned u4v __attribute__((ext_vector_type(4)));
typedef unsigned u2v __attribute__((ext_vector_type(2)));

struct Params {
  const float *x_prompt, *x_sample, *st_f, *st_b, *c_ckv, *c_kr, *c, *c_ctx, *norm_g, *w_ada, *b_ada, *w_in, *shift_mu, *w0, *w_up,
      *a0, *a_up, *k_k, *k_a, *r_k, *ln_g, *ln_b, *q_norm, *w_q_up, *kv_norm, *w_kv_up, *g_ln_g, *g_ln_b, *g_w_s, *g_b_s, *w_branch,
      *w_merge, *b_merge, *w_out, *final_g;
  float* out;
  char* ws;
};

struct Grp { int isden, m0, mg, nseq, T, b0, nkeys, mkv; };
__host__ __device__ __forceinline__ Grp get_grp(int gi) {
  Grp g;
  if (gi == 0) { g.isden = 1; g.m0 = M_C; g.mg = M_D; g.nseq = NB_D; g.T = T_D; g.b0 = 0; g.nkeys = KEYS_D; g.mkv = M_D + NB_D * PAST; }
  else { g.isden = 0; g.m0 = (gi - 1) * MGC; g.mg = MGC; g.nseq = SEQ_PER_CG; g.T = T_C; g.b0 = (gi - 1) * SEQ_PER_CG; g.nkeys = T_C; g.mkv = MGC; }
  return g;
}

constexpr size_t al256(size_t x) { return (x + 255) & ~(size_t)255; }
constexpr size_t O_WINT = 0;
constexpr int IN_WP = ((IN_W + 255) / 256) * 256;
constexpr size_t O_WMT = O_WINT + al256((size_t)IN_WP * 1024 * 2);
constexpr size_t O_WBRT = O_WMT + al256((size_t)4096 * 1024 * 2);
constexpr size_t O_WOUTT = O_WBRT + al256((size_t)4 * 1024 * 512 * 2);
constexpr size_t O_WQT = O_WOUTT + al256((size_t)1024 * 1024 * 2);
constexpr size_t O_WKVT = O_WQT + al256((size_t)768 * 256 * 2);
constexpr size_t O_WUPT = O_WKVT + al256((size_t)1024 * 128 * 2);
constexpr size_t O_WS = O_WUPT + al256((size_t)4 * 512 * 64 * 2);
constexpr size_t O_CS128 = O_WS + al256((size_t)4 * 128 * 128 * 2);
constexpr size_t O_A2C = O_CS128 + al256((size_t)256 * 128 * 2);
constexpr size_t O_A2D = O_A2C + al256((size_t)T_C * 2 * T_C * 2);
constexpr size_t O_ROPE = O_A2D + al256((size_t)T_D * 2 * T_D * 2);
constexpr size_t O_MOD = O_ROPE + al256((size_t)T_D * 32 * 4);
constexpr size_t O_H = O_MOD + al256((size_t)NL * 3 * 3072 * 4);
constexpr size_t O_Z = O_H + al256((size_t)MG * 1024 * 2);
constexpr size_t O_SK = O_Z + al256((size_t)MG * IN_W * 2);
constexpr size_t O_SOP = O_SK + al256((size_t)MG * 512 * 2);
constexpr size_t O_YS = O_SOP + al256((size_t)MG * 8 * 576 * 2);
constexpr size_t O_BON = O_YS + al256((size_t)2 * MG * 512 * 4);
constexpr size_t O_LORA = O_BON + al256((size_t)MG * 16 * 4);
constexpr int CM_GT = 0, CM_BKT = 5120, CM_WL = 9216, CM_VT = 9472, CM_REC = 11520;
constexpr size_t CM_BYTES = (size_t)MG * CM_REC;
constexpr size_t O_CM = O_LORA + al256((size_t)MG * 192 * 2);
constexpr size_t O_PRE = O_CM + al256(CM_BYTES - (size_t)MG * 2048 * 2);
constexpr size_t O_QDN = O_PRE + al256((size_t)MG * 2048 * 2);
constexpr size_t O_CKV = O_QDN + al256((size_t)MG * 256 * 2);
constexpr size_t O_KR = O_CKV + al256((size_t)MKV * 128 * 2);
constexpr size_t O_Q = O_KR + al256((size_t)MKV * 32 * 2);
constexpr size_t O_KN = O_Q + al256((size_t)MG * 768 * 2);
constexpr size_t O_VT = O_KN + al256((size_t)MKV * 512 * 2);
constexpr size_t O_VCNT = O_VT + al256((size_t)MKV * 512 * 2);
constexpr size_t O_YT = O_VCNT + al256((size_t)MG * 512 * 2);
constexpr size_t O_OBR = O_YT + al256((size_t)MG * 1024 * 2);
constexpr size_t O_MERGED = O_OBR + al256((size_t)4 * MG * 512 * 2);
constexpr size_t O_END = O_MERGED + al256((size_t)MG * 1024 * 2);
constexpr size_t O_GATES = O_PRE;
static_assert(O_GATES + (size_t)MG * 4096 * 2 <= O_VCNT, "gates alias region too small");
static_assert(O_CM + CM_BYTES <= O_QDN, "chunk-matrix region must end before QDN");
constexpr size_t O_BAR = O_END;
constexpr size_t BAR_BYTES = 3456 * 4;
static_assert(O_BAR + BAR_BYTES <= ((size_t)256 << 20), "workspace must fit 256 MiB");

constexpr size_t OUT_SF = (size_t)M * D, OUT_SB = OUT_SF + (size_t)NB_C * NL * 8 * 64 * 64,
                 OUT_CKV = OUT_SB + (size_t)NB_C * NL * 8 * 64 * 64, OUT_KR = OUT_CKV + (size_t)NB_C * NL * T_C * 128;

#ifdef EMU
template <class T> __device__ __forceinline__ T* opaque(T* p) { return p; }
__device__ __forceinline__ int opaque_i(int v) { return v; }
#else
template <class T> __device__ __forceinline__ T* opaque(T* p) {
  typedef __attribute__((address_space(1))) T* gptr;
  gptr g = (gptr)p; asm volatile("" : "+s"(g)); return (T*)g;
}
__device__ __forceinline__ int opaque_i(int v) { asm volatile("" : "+s"(v)); return v; }
#endif
#ifdef EMU
#define SCHED_FENCE() do {} while (0)
#else
#define SCHED_FENCE() do { asm volatile("" ::: "memory"); __builtin_amdgcn_sched_barrier(0); } while (0)
#endif
__device__ __forceinline__ int my_tid() {
#ifdef EMU
  return (int)threadIdx.x;
#else
  int t = (int)threadIdx.x; asm volatile("" : "+v"(t)); return t;
#endif
}
__device__ __forceinline__ unsigned f_as_u(float f) { return __builtin_bit_cast(unsigned, f); }
__device__ __forceinline__ float u_as_f(unsigned u) { return __builtin_bit_cast(float, u); }
#ifdef EMU
__device__ __forceinline__ bf16_t f2bf(float f) { unsigned u = f_as_u(f); u += 0x7FFFu + ((u >> 16) & 1u); return (bf16_t)(u >> 16); }
__device__ __forceinline__ unsigned pk2bf(float lo, float hi) { return (unsigned)f2bf(lo) | ((unsigned)f2bf(hi) << 16); }
#else
typedef __bf16 bf2v_t __attribute__((ext_vector_type(2)));
typedef float f2c_t __attribute__((ext_vector_type(2)));
__device__ __forceinline__ bf16_t f2bf(float f) { return __builtin_bit_cast(unsigned short, (__bf16)f); }
__device__ __forceinline__ unsigned pk2bf(float lo, float hi) { return __builtin_bit_cast(unsigned, __builtin_convertvector(f2c_t{lo, hi}, bf2v_t)); }
#endif
__device__ __forceinline__ float bf2f(bf16_t h) { return u_as_f(((unsigned)h) << 16); }
__device__ __forceinline__ float bflo(unsigned u) { return u_as_f(u << 16); }
__device__ __forceinline__ float bfhi(unsigned u) { return u_as_f(u & 0xFFFF0000u); }
#ifdef EMU
__device__ __forceinline__ float fexp_(float x) { return expf(x); }
__device__ __forceinline__ float frcp_(float x) { return 1.f / x; }
#else
__device__ __forceinline__ float fexp_(float x) { return __builtin_amdgcn_exp2f(x * 1.4426950408889634f); }
__device__ __forceinline__ float frcp_(float x) { return __builtin_amdgcn_rcpf(x); }
#endif
#ifdef EMU
__device__ __forceinline__ float fexp2_(float x) { return exp2f(x); }
#else
__device__ __forceinline__ float fexp2_(float x) { return __builtin_amdgcn_exp2f(x); }
#endif
__device__ __forceinline__ float sigmoidf_(float x) { return frcp_(1.f + fexp_(-x)); }
__device__ __forceinline__ float siluf_(float x) { return x * frcp_(1.f + fexp_(-x)); }
__device__ __forceinline__ float tanhf_(float x) { return 1.f - 2.f * frcp_(1.f + fexp_(2.f * x)); }
__device__ __forceinline__ float geluf_(float x) { return 0.5f * x * (1.f + tanhf_(0.7978845608028654f * (x + 0.044715f * x * x * x))); }
#ifdef EMU
__device__ __forceinline__ float wave_sum(float v) {
#pragma unroll
  for (int o = 32; o >= 1; o >>= 1) v += __shfl_xor(v, o);
  return v;
}
#else
__device__ __forceinline__ float wave_sum(float v) {
  v += u_as_f(__builtin_amdgcn_update_dpp(0, (int)f_as_u(v), 0xB1, 0xF, 0xF, true));
  v += u_as_f(__builtin_amdgcn_update_dpp(0, (int)f_as_u(v), 0x4E, 0xF, 0xF, true));
  v += u_as_f(__builtin_amdgcn_update_dpp(0, (int)f_as_u(v), 0x141, 0xF, 0xF, true));
  v += u_as_f(__builtin_amdgcn_update_dpp(0, (int)f_as_u(v), 0x140, 0xF, 0xF, true));
  { auto r = __builtin_amdgcn_permlane16_swap(f_as_u(v), f_as_u(v), false, false); v = u_as_f(r[0]) + u_as_f(r[1]); }
  { auto r = __builtin_amdgcn_permlane32_swap(f_as_u(v), f_as_u(v), false, false); v = u_as_f(r[0]) + u_as_f(r[1]); }
  return v;
}
#endif

#ifdef EMU
#define WAVE_SYNC() emu::wave_barrier()
__device__ __forceinline__ float sum16(float v) { v += __shfl_xor(v, 1); v += __shfl_xor(v, 2); v += __shfl_xor(v, 4); v += __shfl_xor(v, 8); return v; }
#else
#define WAVE_SYNC() __builtin_amdgcn_wave_barrier()
__device__ __forceinline__ float sum16(float v) {
  v += u_as_f(__builtin_amdgcn_update_dpp(0, (int)f_as_u(v), 0xB1, 0xF, 0xF, true));
  v += u_as_f(__builtin_amdgcn_update_dpp(0, (int)f_as_u(v), 0x4E, 0xF, 0xF, true));
  v += u_as_f(__builtin_amdgcn_update_dpp(0, (int)f_as_u(v), 0x141, 0xF, 0xF, true));
  v += u_as_f(__builtin_amdgcn_update_dpp(0, (int)f_as_u(v), 0x140, 0xF, 0xF, true));
  return v;
}
#endif

template <int LPR> __device__ __forceinline__ float sum_lpr(float v) {
#ifdef EMU
  v += __shfl_xor(v, 1); v += __shfl_xor(v, 2); v += __shfl_xor(v, 4);
  if (LPR >= 16) v += __shfl_xor(v, 8);
  if (LPR >= 32) v += __shfl_xor(v, 16);
  return v;
#else
  v += u_as_f(__builtin_amdgcn_update_dpp(0, (int)f_as_u(v), 0xB1, 0xF, 0xF, true));
  v += u_as_f(__builtin_amdgcn_update_dpp(0, (int)f_as_u(v), 0x4E, 0xF, 0xF, true));
  v += u_as_f(__builtin_amdgcn_update_dpp(0, (int)f_as_u(v), 0x141, 0xF, 0xF, true));
  if (LPR >= 16) v += u_as_f(__builtin_amdgcn_update_dpp(0, (int)f_as_u(v), 0x140, 0xF, 0xF, true));
  if (LPR >= 32) { auto r = __builtin_amdgcn_permlane16_swap(f_as_u(v), f_as_u(v), false, false); v = u_as_f(r[0]) + u_as_f(r[1]); }
  return v;
#endif
}

template <int LPR> __device__ __forceinline__ void sum_lpr2(float& a, float& b) {
#ifdef EMU
  a = sum_lpr<LPR>(a); b = sum_lpr<LPR>(b);
#else
#define DPP_ADD2(ctrl) { float ta = u_as_f(__builtin_amdgcn_update_dpp(0, (int)f_as_u(a), ctrl, 0xF, 0xF, true)); float tb = u_as_f(__builtin_amdgcn_update_dpp(0, (int)f_as_u(b), ctrl, 0xF, 0xF, true)); a += ta; b += tb; }
  DPP_ADD2(0xB1) DPP_ADD2(0x4E) DPP_ADD2(0x141)
  if (LPR >= 16) DPP_ADD2(0x140)
  if (LPR >= 32) { auto ra = __builtin_amdgcn_permlane16_swap(f_as_u(a), f_as_u(a), false, false); auto rb = __builtin_amdgcn_permlane16_swap(f_as_u(b), f_as_u(b), false, false);
    a = u_as_f(ra[0]) + u_as_f(ra[1]); b = u_as_f(rb[0]) + u_as_f(rb[1]); }
#undef DPP_ADD2
#endif
}

constexpr int NTHR = 512, NWAVE = 8;
constexpr int LDS_STR = 72;
constexpr int SMEM_STAGE = 131072;
constexpr int SMEM_BYTES = SMEM_STAGE + 16;

template <int NJ>
__device__ __forceinline__ void zero_acc(f4v (&acc)[2][NJ]) {
#pragma unroll
  for (int i = 0; i < 2; ++i)
#pragma unroll
    for (int j = 0; j < NJ; ++j) acc[i][j] = f4v{0.f, 0.f, 0.f, 0.f};
}

template <int NJ, bool BT = false>
__device__ __forceinline__ void gemm_mainloop(const bf16_t* __restrict__ A, long lda, int arow0, int arows, const bf16_t* __restrict__ B,
                                              long ldb, int brow0, int brows, int K, char* smem, f4v (&acc)[2][NJ]) {
  constexpr int BROWS = 32 * NJ, NBL = NJ / 2;
  constexpr int BUF = (128 + 128) * LDS_STR;
  bf16_t* s0 = (bf16_t*)smem;
  const int tid = my_tid(), lane = tid & 63, wid = tid >> 6, wm = wid >> 1, wn = wid & 1;
  u4v ra[2], rb[NBL];
  const bf16_t* ap[2]; const bf16_t* bp[NBL];
#pragma unroll
  for (int i = 0; i < 2; ++i) { int c = tid + NTHR * i, r = c >> 3, cc = c & 7; int ar = arow0 + r; ar = ar < arows ? ar : arows - 1; ap[i] = A + (long)ar * lda + cc * 8; }
#pragma unroll
  for (int i = 0; i < NBL; ++i) { int c = tid + NTHR * i;
    if (BT) { int q = c >> 4, dc = c & 15; bp[i] = B + (long)q * ldb + brow0 + dc * 8; }
    else { int r = c >> 3, cc = c & 7; int br = brow0 + r; br = br < brows ? br : brows - 1; bp[i] = B + (long)br * ldb + cc * 8; } }
#pragma unroll
  for (int i = 0; i < 2; ++i) ra[i] = *(const u4v*)(ap[i]);
#pragma unroll
  for (int i = 0; i < NBL; ++i) rb[i] = *(const u4v*)(bp[i]);
  __syncthreads();
#pragma unroll
  for (int i = 0; i < 2; ++i) { int c = tid + NTHR * i, r = c >> 3, cc = c & 7; *(u4v*)(s0 + r * LDS_STR + cc * 8) = ra[i]; }
#pragma unroll
  for (int i = 0; i < NBL; ++i) { int c = tid + NTHR * i;
    if (BT) { int q = c >> 4, dc = c & 15;
#pragma unroll
      for (int e = 0; e < 8; ++e) s0[(128 + dc * 8 + e) * LDS_STR + q] = (bf16_t)(rb[i][e >> 1] >> ((e & 1) * 16)); }
    else { int r = c >> 3, cc = c & 7; *(u4v*)(s0 + (128 + r) * LDS_STR + cc * 8) = rb[i]; } }
  __syncthreads();
  const int nk = K >> 6;
  for (int kt = 0; kt < nk; ++kt) {
    const bool more = kt + 1 < nk;
    if (more) {
#pragma unroll
      for (int i = 0; i < 2; ++i) ra[i] = *(const u4v*)(ap[i] + (kt + 1) * 64);
#pragma unroll
      for (int i = 0; i < NBL; ++i) rb[i] = *(const u4v*)(bp[i] + (BT ? (long)(kt + 1) * 64 * ldb : (long)(kt + 1) * 64));
    }
    const bf16_t* sA = s0 + (kt & 1) * BUF; const bf16_t* sB = sA + 128 * LDS_STR;
#pragma unroll
    for (int ks = 0; ks < 2; ++ks) {
      s8v af[2], bf[NJ];
#pragma unroll
      for (int i = 0; i < 2; ++i) af[i] = *(const s8v*)(sA + (wm * 32 + i * 16 + (lane & 15)) * LDS_STR + ks * 32 + (lane >> 4) * 8);
#pragma unroll
      for (int j = 0; j < NJ; ++j) bf[j] = *(const s8v*)(sB + (wn * NJ * 16 + j * 16 + (lane & 15)) * LDS_STR + ks * 32 + (lane >> 4) * 8);
#pragma unroll
      for (int i = 0; i < 2; ++i)
#pragma unroll
        for (int j = 0; j < NJ; ++j) acc[i][j] = __builtin_amdgcn_mfma_f32_16x16x32_bf16(bf[j], af[i], acc[i][j], 0, 0, 0);
    }
    if (more) {
      bf16_t* dA = s0 + ((kt + 1) & 1) * BUF;
#pragma unroll
      for (int i = 0; i < 2; ++i) { int c = tid + NTHR * i, r = c >> 3, cc = c & 7; *(u4v*)(dA + r * LDS_STR + cc * 8) = ra[i]; }
#pragma unroll
      for (int i = 0; i < NBL; ++i) { int c = tid + NTHR * i;
        if (BT) { int q = c >> 4, dc = c & 15;
#pragma unroll
          for (int e = 0; e < 8; ++e) dA[(128 + dc * 8 + e) * LDS_STR + q] = (bf16_t)(rb[i][e >> 1] >> ((e & 1) * 16)); }
        else { int r = c >> 3, cc = c & 7; *(u4v*)(dA + (128 + r) * LDS_STR + cc * 8) = rb[i]; } }
    }
    __syncthreads();
  }
  (void)BROWS;
}

template <int NJ, class F>
__device__ __forceinline__ void epi_foreach(f4v (&acc)[2][NJ], int row0, int col0, F f) {
  const int tid = my_tid(), lane = tid & 63, wid = tid >> 6, wm = wid >> 1, wn = wid & 1;
#pragma unroll
  for (int i = 0; i < 2; ++i)
#pragma unroll
    for (int j = 0; j < NJ; ++j) f(row0 + wm * 32 + i * 16 + (lane & 15), col0 + wn * NJ * 16 + j * 16 + (lane >> 4) * 4, acc[i][j]);
}
__device__ __forceinline__ u4v pack8(const float (&x)[8]) {
  return u4v{pk2bf(x[0], x[1]), pk2bf(x[2], x[3]), pk2bf(x[4], x[5]), pk2bf(x[6], x[7])};
}
__device__ __forceinline__ void unpack8(u4v u, float (&x)[8]) {
  x[0] = bflo(u.x); x[1] = bfhi(u.x); x[2] = bflo(u.y); x[3] = bfhi(u.y); x[4] = bflo(u.z); x[5] = bfhi(u.z); x[6] = bflo(u.w); x[7] = bfhi(u.w);
}
__device__ __forceinline__ u2v pack4(float a, float b, float c, float d) {
  return u2v{pk2bf(a, b), pk2bf(c, d)};
}

#ifndef EMU
namespace pg8 {
#define PG8_LAS __attribute__((address_space(3)))
typedef unsigned short bf16_t;
typedef short bf16x8 __attribute__((ext_vector_type(8)));
typedef float f32x4 __attribute__((ext_vector_type(4)));
typedef unsigned u32x4 __attribute__((ext_vector_type(4)));
constexpr int BM = 256, BK = 64, HALF = 128, HTB = HALF * BK * 2  , STAGE_BYTES = 8 * HTB, NXCD = 8, WGM = 8;

__host__ __device__ __forceinline__ int lds_byte(int r, int c) { const int st = (r >> 4) * 2 + (c >> 5), rr = r & 15, cc = c & 31, ob = rr * 64 + cc * 2; return st * 1024 + (ob ^ (((ob >> 9) & 1) << 5)); }
__host__ __device__ __forceinline__ void stage_rc(int b, int& R, int& C) { const int st = b / 1024, sb = b % 1024, swz = sb ^ (((sb >> 9) & 1) << 5); R = (st >> 1) * 16 + swz / 64; C = (st & 1) * 32 + (swz % 64) / 2; }
__host__ __device__ __forceinline__ int perm32(int rho) { const int n = rho >> 4, i = rho & 15; return 8 * (i >> 2) + 4 * n + (i & 3); }

struct Unit { int pm, pn; };
struct Gemm { const bf16_t* A; const bf16_t* Bt; int M, N, K; };

struct StaticOrder {
    int nM, nN, nwg, G, c;
    __host__ __device__ void init(int M, int N, int G_, int c_) { nM = M / BM; nN = N / BM; nwg = nM * nN; G = G_; c = c_; }
    __host__ __device__ bool next(int i, Unit& u) const {
        const long L = (long)i * G + c; if (L >= nwg) return false;
        int wgid = (int)L; { const int q = nwg / NXCD, r = nwg % NXCD, xcd = wgid % NXCD, off = wgid / NXCD; wgid = (xcd < r ? xcd * (q + 1) : r * (q + 1) + (xcd - r) * q) + off; }
        const int nig = WGM * nN, gid = wgid / nig, fm = gid * WGM, gsz = (nM - fm) < WGM ? (nM - fm) : WGM;
        u.pm = fm + ((wgid % nig) % gsz); u.pn = (wgid % nig) / gsz; return true;
    }
    __device__ __forceinline__ void a_ready(const Unit&) const {}
    __device__ __forceinline__ void done(const Unit&) const {}
};
template <class Epi, class Sched>
__device__ __forceinline__ void gemm_phase(PG8_LAS unsigned char* lds, const Gemm g, const Sched& S, const Epi& E) {
    const int tid = my_tid(), wid = __builtin_amdgcn_readfirstlane(tid >> 6), lane = tid & 63, wr = wid >> 2, wc = wid & 3, fr = lane & 15, fq = lane >> 4;
    const int K = g.K, nt = K / BK;
    unsigned voffA[2], voffB[2];
#pragma unroll
    for (int i = 0; i < 2; ++i) { int R, C; stage_rc(tid * 16 + i * 8192, R, C); const int Rb = Epi::PERM ? ((R & ~31) + perm32(R & 31)) : R;
        voffA[i] = (unsigned)(R * K + C) * 2u; voffB[i] = (unsigned)(Rb * K + C) * 2u; }
    const size_t kstep = (size_t)(BK * 2);
    const size_t hstep = (size_t)HALF * K * 2;
    const size_t tstep = 2 * hstep;
    const unsigned ldsw = (unsigned)wid * 1024u;
    const int aoff = lds_byte(wr * 64 + fr, fq * 8), boff = lds_byte(wc * 32 + fr, fq * 8);
#define PG8_SA(b, h) (((b) * 2 + (h)) * HTB)
#define PG8_SB(b, h) ((4 + (b) * 2 + (h)) * HTB)
#define PG8_STAGE(bufoff, gbase, voff) do { _Pragma("unroll") for (int _i = 0; _i < 2; ++_i) \
        __builtin_amdgcn_global_load_lds((const unsigned*)((const char*)(gbase) + (voff)[_i]), (PG8_LAS unsigned*)(lds + (bufoff) + ldsw + _i * 8192), 16, 0, 0); } while (0)
#define PG8_LDA(dst, b, h) do { _Pragma("unroll") for (int m = 0; m < 4; ++m) _Pragma("unroll") for (int k = 0; k < 2; ++k) dst[m][k] = *(const PG8_LAS bf16x8*)(lds + PG8_SA(b, h) + aoff + m * 2048 + k * 1024); } while (0)
#define PG8_LDB(dst, b, h) do { _Pragma("unroll") for (int n = 0; n < 2; ++n) _Pragma("unroll") for (int k = 0; k < 2; ++k) dst[n][k] = *(const PG8_LAS bf16x8*)(lds + PG8_SB(b, h) + boff + n * 2048 + k * 1024); } while (0)
#define PG8_MMA(ai, bj, At, Bt) do { __builtin_amdgcn_s_setprio(1); _Pragma("unroll") for (int m = 0; m < 4; ++m) _Pragma("unroll") for (int n = 0; n < 2; ++n) _Pragma("unroll") for (int k = 0; k < 2; ++k) \
        acc[ai][bj][m][n] = __builtin_amdgcn_mfma_f32_16x16x32_bf16(Bt[n][k], At[m][k], acc[ai][bj][m][n], 0, 0, 0); __builtin_amdgcn_s_setprio(0); } while (0)
#define PG8_WAIT_V(n) asm volatile("s_waitcnt vmcnt(" #n ")" ::: "memory")
#define PG8_WAIT_L(n) asm volatile("s_waitcnt lgkmcnt(" #n ")" ::: "memory")
#define PG8_BAR __builtin_amdgcn_s_barrier()
#define PG8_SCHED __builtin_amdgcn_sched_barrier(0)
    Unit cur, nxt; int ui = 0;
    if (!S.next(0, cur)) return;
    f32x4 acc[2][2][4][2];
#pragma unroll
    for (int a = 0; a < 2; ++a)
#pragma unroll
        for (int b = 0; b < 2; ++b)
#pragma unroll
            for (int m = 0; m < 4; ++m)
#pragma unroll
                for (int n = 0; n < 2; ++n) acc[a][b][m][n] = (f32x4){0.f, 0.f, 0.f, 0.f};
    bf16x8 At[4][2], B0[2][2], B1[2][2];
    const char* cA = (const char*)g.A + (size_t)cur.pm * tstep; const char* cB = (const char*)g.Bt + (size_t)cur.pn * tstep;
    S.a_ready(cur);
    PG8_STAGE(PG8_SB(0, 0), cB, voffB); PG8_STAGE(PG8_SA(0, 0), cA, voffA); PG8_STAGE(PG8_SB(0, 1), cB + hstep, voffB); PG8_STAGE(PG8_SA(0, 1), cA + hstep, voffA);
    if (wr == 1) PG8_BAR;
    PG8_WAIT_V(4); PG8_BAR;
    PG8_STAGE(PG8_SB(1, 0), cB + kstep, voffB); PG8_STAGE(PG8_SA(1, 0), cA + kstep, voffA); PG8_STAGE(PG8_SB(1, 1), cB + hstep + kstep, voffB);
    PG8_WAIT_V(6); PG8_BAR;
    for (;;) {
        const bool has_next = S.next(ui + 1, nxt);
        const char* nA = has_next ? (const char*)g.A + (size_t)nxt.pm * tstep : cA; const char* nB = has_next ? (const char*)g.Bt + (size_t)nxt.pn * tstep : cB;
        for (int t = 0; t < nt; t += 2) {
            const bool last = (t == nt - 2);
            const char* a1 = cA + (size_t)(t + 1) * kstep;
            const char* a2 = last ? nA : cA + (size_t)(t + 2) * kstep; const char* b2 = last ? nB : cB + (size_t)(t + 2) * kstep;
            const char* a3 = a2 + kstep; const char* b3 = b2 + kstep;
            if (last && has_next) S.a_ready(nxt);
            PG8_LDB(B0, 0, 0); PG8_SCHED; PG8_LDA(At, 0, 0); PG8_STAGE(PG8_SA(1, 1), a1 + hstep, voffA);
            PG8_WAIT_L(8); PG8_BAR; PG8_WAIT_L(0); PG8_MMA(0, 0, At, B0); PG8_BAR; PG8_SCHED;
            PG8_LDB(B1, 0, 1); PG8_STAGE(PG8_SB(0, 0), b2, voffB);
            PG8_BAR; PG8_WAIT_L(0); PG8_MMA(0, 1, At, B1); PG8_BAR;
            PG8_LDA(At, 0, 1); PG8_STAGE(PG8_SA(0, 0), a2, voffA);
            PG8_BAR; PG8_WAIT_L(0); PG8_MMA(1, 0, At, B0); PG8_BAR; PG8_SCHED;
            PG8_STAGE(PG8_SB(0, 1), b2 + hstep, voffB);
            PG8_WAIT_V(6); PG8_BAR; PG8_MMA(1, 1, At, B1); PG8_BAR;
            PG8_LDB(B0, 1, 0); PG8_SCHED; PG8_LDA(At, 1, 0); PG8_STAGE(PG8_SA(0, 1), a2 + hstep, voffA);
            PG8_WAIT_L(8); PG8_BAR; PG8_WAIT_L(0); PG8_MMA(0, 0, At, B0); PG8_BAR; PG8_SCHED;
            PG8_LDB(B1, 1, 1); PG8_STAGE(PG8_SB(1, 0), b3, voffB);
            PG8_BAR; PG8_WAIT_L(0); PG8_MMA(0, 1, At, B1); PG8_BAR;
            PG8_LDA(At, 1, 1); PG8_STAGE(PG8_SA(1, 0), a3, voffA);
            PG8_BAR; PG8_WAIT_L(0); PG8_MMA(1, 0, At, B0); PG8_BAR; PG8_SCHED;
            PG8_STAGE(PG8_SB(1, 1), b3 + hstep, voffB);
            PG8_WAIT_V(6); PG8_BAR; PG8_MMA(1, 1, At, B1); PG8_BAR;
        }
            if constexpr (!Epi::AFTER_DRAIN) { E(acc, cur, wr, wc, fr, fq); S.done(cur); }
            if (!has_next) break;
#pragma unroll
        for (int a = 0; a < 2; ++a)
#pragma unroll
            for (int b = 0; b < 2; ++b)
#pragma unroll
                for (int m = 0; m < 4; ++m)
#pragma unroll
                    for (int n = 0; n < 2; ++n) acc[a][b][m][n] = (f32x4){0.f, 0.f, 0.f, 0.f};
        cur = nxt; cA = nA; cB = nB; ++ui;
    }
    PG8_WAIT_V(0);
    if (wr == 0) PG8_BAR;
    PG8_BAR;
    if constexpr (Epi::AFTER_DRAIN) { E.fused(acc, cur, wr, wc, fr, fq, lds, wid, lane); S.done(cur); }
#undef PG8_SA
#undef PG8_SB
#undef PG8_STAGE
#undef PG8_LDA
#undef PG8_LDB
#undef PG8_MMA
#undef PG8_WAIT_V
#undef PG8_WAIT_L
#undef PG8_BAR
#undef PG8_SCHED
}

__device__ __forceinline__ unsigned pk2(float lo, float hi) { return pk2bf(lo, hi); }
struct EpiStore {
  static constexpr bool PERM = true, AFTER_DRAIN = false;
  bf16_t* O; int ldc; int ncols;
  __device__ __forceinline__ void operator()(const f32x4 (&acc)[2][2][4][2], const Unit& u, int wr, int wc, int fr, int fq) const {
    const int row0 = u.pm * BM + wr * 64 + fr, col0 = u.pn * BM + wc * 32 + 8 * fq;
#pragma unroll
    for (int ai = 0; ai < 2; ++ai)
#pragma unroll
      for (int m = 0; m < 4; ++m) { bf16_t* rowp = O + (size_t)(row0 + ai * HALF + m * 16) * ldc + col0;
#pragma unroll
        for (int bj = 0; bj < 2; ++bj) if (col0 + bj * HALF < ncols) { const f32x4 v0 = acc[ai][bj][m][0], v1 = acc[ai][bj][m][1];
          *(u32x4*)(rowp + bj * HALF) = (u32x4){pk2(v0[0], v0[1]), pk2(v0[2], v0[3]), pk2(v1[0], v1[1]), pk2(v1[2], v1[3])}; } }
  }
};
struct EpiSigmoid {
  static constexpr bool PERM = true, AFTER_DRAIN = false;
  bf16_t* O; int ldc; const float* bias;
  __device__ __forceinline__ void operator()(const f32x4 (&acc)[2][2][4][2], const Unit& u, int wr, int wc, int fr, int fq) const {
    const int row0 = u.pm * BM + wr * 64 + fr, col0 = u.pn * BM + wc * 32 + 8 * fq;
    f32x4 bv[2][2];
#pragma unroll
    for (int bj = 0; bj < 2; ++bj)
#pragma unroll
      for (int n = 0; n < 2; ++n) bv[bj][n] = *(const f32x4*)(bias + col0 + bj * HALF + 4 * n);
#pragma unroll
    for (int ai = 0; ai < 2; ++ai)
#pragma unroll
      for (int m = 0; m < 4; ++m) { bf16_t* rowp = O + (size_t)(row0 + ai * HALF + m * 16) * ldc + col0;
#pragma unroll
        for (int bj = 0; bj < 2; ++bj) { const f32x4 v0 = acc[ai][bj][m][0] + bv[bj][0], v1 = acc[ai][bj][m][1] + bv[bj][1];
          *(u32x4*)(rowp + bj * HALF) = (u32x4){pk2(sigmoidf_(v0[0]), sigmoidf_(v0[1])), pk2(sigmoidf_(v0[2]), sigmoidf_(v0[3])), pk2(sigmoidf_(v1[0]), sigmoidf_(v1[1])), pk2(sigmoidf_(v1[2]), sigmoidf_(v1[3]))}; } }
  }
};
}
#endif

struct TJob { const float* src; int K, N; long lds; bf16_t* dst; long ldd; };
__device__ __forceinline__ TJob get_tjob(const Params& p, int l, int j) {
  TJob t; char* ws = p.ws;
  if (j == 0) { t.src = p.w_in + (size_t)l * 1024 * IN_W; t.K = 1024; t.N = IN_W; t.lds = IN_W; t.dst = (bf16_t*)(ws + O_WINT); t.ldd = 1024; }
  else if (j == 1) { t.src = p.w_merge + (size_t)l * 1024 * 4096; t.K = 1024; t.N = 4096; t.lds = 4096; t.dst = (bf16_t*)(ws + O_WMT); t.ldd = 1024; }
  else if (j < 6) { int n = j - 2; t.src = p.w_branch + ((size_t)l * 4 + n) * 512 * 1024; t.K = 512; t.N = 1024; t.lds = 1024; t.dst = (bf16_t*)(ws + O_WBRT) + (size_t)n * 1024 * 512; t.ldd = 512; }
  else if (j == 6) { t.src = p.w_out + (size_t)l * 1024 * 1024; t.K = 1024; t.N = 1024; t.lds = 1024; t.dst = (bf16_t*)(ws + O_WOUTT); t.ldd = 1024; }
  else if (j == 7) { t.src = p.w_q_up + (size_t)l * 256 * 768; t.K = 256; t.N = 768; t.lds = 768; t.dst = (bf16_t*)(ws + O_WQT); t.ldd = 256; }
  else if (j == 8) { t.src = p.w_kv_up + (size_t)l * 128 * 1024; t.K = 128; t.N = 1024; t.lds = 1024; t.dst = (bf16_t*)(ws + O_WKVT); t.ldd = 128; }
  else { int n = j - 9;
    t.src = (n < 2 ? p.w_up : p.a_up) + ((size_t)l * 2 + (n & 1)) * 64 * 512; t.K = 64; t.N = 512; t.lds = 512;
    t.dst = (bf16_t*)(ws + O_WUPT) + (size_t)n * 512 * 64; t.ldd = 64; }
  return t;
}
constexpr int NTJOBS = 13;

__device__ __forceinline__ void stage_prep(const Params& p, int l, int bid, int nb, char* smem) {
  const int tid = my_tid();
  char* ws = p.ws;
  {
    float* tile = (float*)smem;
    int base = 0;
    for (int j = 0; j < NTJOBS; ++j) {
      TJob t = get_tjob(p, l, j);
      int tk = t.K / 64, tn = t.N / 32, nt = tk * tn;
      int first = ((bid - base % nb) % nb + nb) % nb;
      for (int q = first; q < nt; q += nb) {
        int kt = q / tn, nt_ = q % tn;
        __syncthreads();
        { int r = tid >> 3, c4 = tid & 7; f4v x = *(const f4v*)(t.src + (long)(kt * 64 + r) * t.lds + nt_ * 32 + c4 * 4);
          tile[r * 33 + c4 * 4] = x[0]; tile[r * 33 + c4 * 4 + 1] = x[1]; tile[r * 33 + c4 * 4 + 2] = x[2]; tile[r * 33 + c4 * 4 + 3] = x[3]; }
        __syncthreads();
        if (tid < 256) { int n = tid >> 3, kc = tid & 7; float x[8];
#pragma unroll
          for (int e = 0; e < 8; ++e) x[e] = tile[(kc * 8 + e) * 33 + n];
          *(u4v*)(t.dst + (long)(nt_ * 32 + n) * t.ldd + kt * 64 + kc * 8) = pack8(x); }
      }
      base += nt;
    }
    __syncthreads();
  }
  const long gtid = (long)bid * NTHR + tid, gn = (long)nb * NTHR;
  { bf16_t* d = (bf16_t*)(ws + O_WINT) + (size_t)IN_W * 1024; for (long i = gtid; i < (long)(IN_WP - IN_W) * 1024; i += gn) d[i] = 0; }
  { bf16_t* d = (bf16_t*)(ws + O_WS); const float* s = p.g_w_s + (size_t)l * 4 * 128 * 128; for (long i = gtid; i < (long)4 * 128 * 128; i += gn) d[i] = f2bf(s[i]); }
  if (l != 0) return;
  { bf16_t* d = (bf16_t*)(ws + O_CS128);
    for (long i = gtid; i < 256 * 128; i += gn) { int j = (int)(i >> 7), c = (int)(i & 127); int mm = ((j & 127) * c) & 127; float x = 2.0f * mm / 128.f; d[i] = f2bf(j < 128 ? cospif(x) : sinpif(x)); } }
  { bf16_t* d = (bf16_t*)(ws + O_A2C);
    for (long i = gtid; i < (long)T_C * 2 * T_C; i += gn) { int tp = (int)(i / (2 * T_C)), tt = (int)(i % (2 * T_C)); int half = tt >= T_C; int t = half ? tt - T_C : tt; int mm = (int)(((long)tp * t) % T_C); float x = 2.0f * mm / (float)T_C; d[i] = f2bf(half ? -sinpif(x) : cospif(x)); } }
  { bf16_t* d = (bf16_t*)(ws + O_A2D);
    for (long i = gtid; i < (long)T_D * 2 * T_D; i += gn) { int tp = (int)(i / (2 * T_D)), tt = (int)(i % (2 * T_D)); int half = tt >= T_D; int t = half ? tt - T_D : tt; int mm = (int)(((long)tp * t) % T_D); float x = 2.0f * mm / (float)T_D; d[i] = f2bf(half ? -sinpif(x) : cospif(x)); } }
  { float* d = (float*)(ws + O_ROPE);
    for (long i = gtid; i < (long)T_D * 16; i += gn) { int t = (int)(i >> 4), pi = (int)(i & 15); float pos = (pi < 8) ? (float)(t / 64) : (float)(t % 64); float inv = expf(-(float)(pi & 7) * (9.210340371976184f / 8.f)); float a = pos * inv; d[2 * i] = cosf(a); d[2 * i + 1] = sinf(a); } }
  { float4* d = (float4*)p.out; const float4* s0 = (const float4*)p.x_prompt; const float4* s1 = (const float4*)p.x_sample;
    for (long i = gtid; i < (long)M * 256; i += gn) d[i] = (i < (long)M_C * 256) ? s0[i] : s1[i - (long)M_C * 256]; }
  {
    float* red = (float*)smem;
    float* modp = (float*)(ws + O_MOD);
    for (int u = bid; u < NL * 48; u += nb) {
      int ll = u / 48, cg = u % 48; int col = cg * 64 + (tid & 63), kq = tid >> 6;
      float a0 = 0.f, a1 = 0.f, a2 = 0.f;
      const float* w = p.w_ada + (size_t)ll * 1024 * 3072 + col;
      for (int k = kq * 128; k < kq * 128 + 128; ++k) {
        float wv = w[(size_t)k * 3072];
        a0 += siluf_(p.c_ctx[k]) * wv; a1 += siluf_(p.c[k]) * wv; a2 += siluf_(p.c[(NB_D > 1 ? 1024 : 0) + k]) * wv;
      }
      __syncthreads();
      red[(kq * 3 + 0) * 64 + (tid & 63)] = a0; red[(kq * 3 + 1) * 64 + (tid & 63)] = a1; red[(kq * 3 + 2) * 64 + (tid & 63)] = a2;
      __syncthreads();
      if (tid < 192) { int mi = tid >> 6, cc = tid & 63; float s = 0.f;
#pragma unroll
        for (int q8 = 0; q8 < 8; ++q8) s += red[(q8 * 3 + mi) * 64 + cc];
        modp[((size_t)ll * 3 + mi) * 3072 + cg * 64 + cc] = s + p.b_ada[(size_t)ll * 3072 + cg * 64 + cc]; }
    }
  }
}

__device__ __forceinline__ int mod_index(const Grp& g, int lm) { return g.isden ? 1 + lm / T_D : 0; }

__device__ __forceinline__ void stage_h(const Params& p, const Grp& g, int l, int bid, int nb) {
  const int lane = my_tid() & 63, wid = my_tid() >> 6;
  const float* X = p.out + (size_t)g.m0 * 1024;
  bf16_t* H = (bf16_t*)(p.ws + O_H);
  const float* modp = (const float*)(p.ws + O_MOD) + (size_t)l * 3 * 3072;
  const float* gam = p.norm_g + (size_t)l * 1024;
  for (int m = bid * NWAVE + wid; m < g.mg; m += nb * NWAVE) {
    const float* xr = X + (size_t)m * 1024; float v[16]; float ss = 0.f;
#pragma unroll
    for (int i = 0; i < 4; ++i) { float4 q = *(const float4*)(xr + i * 256 + lane * 4); v[4 * i] = q.x; v[4 * i + 1] = q.y; v[4 * i + 2] = q.z; v[4 * i + 3] = q.w; ss += q.x * q.x + q.y * q.y + q.z * q.z + q.w * q.w; }
    ss = wave_sum(ss); float rs = rsqrtf(ss * (1.f / 1024.f) + 1e-6f);
    const float* mo = modp + (size_t)mod_index(g, m) * 3072;
#pragma unroll
    for (int i = 0; i < 4; ++i) {
      int c = i * 256 + lane * 4; bf16_t o[4];
#pragma unroll
      for (int e = 0; e < 4; ++e) o[e] = f2bf(v[4 * i + e] * rs * gam[c + e] * (1.f + mo[1024 + c + e]) + mo[c + e]);
      *(u2v*)(H + (size_t)m * 1024 + c) = u2v{(unsigned)o[0] | ((unsigned)o[1] << 16), (unsigned)o[2] | ((unsigned)o[3] << 16)};
    }
  }
}

__device__ __forceinline__ void stage_g1(const Params& p, const Grp& g, int bid, int nb, char* smem) {
  const bf16_t* H = (const bf16_t*)(p.ws + O_H);
  const bf16_t* W = (const bf16_t*)(p.ws + O_WINT);
  bf16_t* Z = (bf16_t*)(p.ws + O_Z);
#ifndef EMU
  if ((g.mg & 255) == 0) {
    pg8::Gemm gm; gm.A = H; gm.Bt = W; gm.M = g.mg; gm.N = IN_WP; gm.K = 1024;
    pg8::StaticOrder S; S.init(gm.M, gm.N, nb, bid);
    pg8::EpiStore E; E.O = Z; E.ldc = IN_W; E.ncols = IN_W;
    pg8::gemm_phase<pg8::EpiStore, pg8::StaticOrder>((PG8_LAS unsigned char*)smem, gm, S, E);
    return;
  }
#endif
  const int TM = (g.mg + 127) / 128; constexpr int TN = (IN_W + 127) / 128;
  const int mg = g.mg;
  for (int t = bid; t < TM * TN; t += nb) {
    int tn = t / TM, tm = t % TM; f4v acc[2][4]; zero_acc<4>(acc);
    gemm_mainloop<4>(H, 1024, tm * 128, mg, W, 1024, tn * 128, IN_W, 1024, smem, acc);
    epi_foreach<4>(acc, tm * 128, tn * 128, [&](int row, int c0, f4v& v) {
      if (c0 < IN_W && row < mg) *(u2v*)(Z + (size_t)row * IN_W + c0) = pack4(v[0], v[1], v[2], v[3]);
    });
  }
}

__device__ __forceinline__ void stage_e1(const Params& p, const Grp& g, int l, int bid, int nb) {
  const int lane = my_tid() & 63, wid = my_tid() >> 6;
  char* ws = p.ws;
  const bf16_t* Z = (const bf16_t*)(ws + O_Z);
  bf16_t* SK = (bf16_t*)(ws + O_SK); bf16_t* SOP = (bf16_t*)(ws + O_SOP);
  bf16_t* LORA = (bf16_t*)(ws + O_LORA); bf16_t* QDN = (bf16_t*)(ws + O_QDN); bf16_t* CKV = (bf16_t*)(ws + O_CKV); bf16_t* KR = (bf16_t*)(ws + O_KR);
  bf16_t* VCN = (bf16_t*)(ws + O_VCNT);
  const float* rope = (const float*)(ws + O_ROPE);
  const float* mu = p.shift_mu + (size_t)l * SHIFT_W;
  const int isden = g.isden, T = g.T;
  for (int m = bid * NWAVE + wid; m < g.mkv; m += nb * NWAVE) {
    if (m >= g.mg) {
      int r = m - g.mg, b = r / PAST, j = r % PAST;
      if (lane < 20) {
        const float* s = lane < 16 ? p.c_ckv + (((size_t)b * NL + l) * PAST + j) * 128 + lane * 8 : p.c_kr + (((size_t)b * NL + l) * PAST + j) * 32 + (lane - 16) * 8;
        f4v x0 = *(const f4v*)s, x1 = *(const f4v*)(s + 4); float x[8] = {x0[0], x0[1], x0[2], x0[3], x1[0], x1[1], x1[2], x1[3]};
        if (lane < 16) *(u4v*)(CKV + (size_t)m * 128 + lane * 8) = pack8(x);
        else { const int key = T + j, d8 = lane - 16;
          *(u4v*)(KR + ((((size_t)b * (g.nkeys >> 5) + (key >> 5)) * 2 + (d8 >> 1)) * 64 + (d8 & 1) * 32 + (key & 31)) * 8) = pack8(x); }
      }
      continue;
    }
    const int sq = m / T, t = m % T, b = g.b0 + sq;
    const bf16_t* z = Z + (size_t)m * IN_W;
    const bool hp = t > 0, hn = t < T - 1;
#pragma unroll
    for (int it = 0; it < 4; ++it) {
      const int ci = it * 64 + lane; const bool valid = ci < 216; const int cc = valid ? ci : 0;
      float zc[8], pv[8], nv[8], sf[8];
      unpack8(*(const u4v*)(z + cc * 8), zc);
      if (hp) unpack8(*(const u4v*)(z - IN_W + cc * 8), pv); else { for (int e = 0; e < 8; ++e) pv[e] = 0.f; }
      if (hn) unpack8(*(const u4v*)(z + IN_W + cc * 8), nv); else { for (int e = 0; e < 8; ++e) nv[e] = 0.f; }
      f4v m0 = *(const f4v*)(mu + cc * 8), m1 = *(const f4v*)(mu + cc * 8 + 4);
#pragma unroll
      for (int e = 0; e < 8; ++e) sf[e] = zc[e] + (0.5f * (pv[e] + nv[e]) - zc[e]) * (e < 4 ? m0[e] : m1[e - 4]);
      bf16_t* rec = SOP + (((size_t)sq * 8 + (lane >> 3)) * T + t) * 576 + (lane & 7) * 8;
      if (it == 0) *(u4v*)rec = pack8(sf);
      else if (it == 1) {
        *(u4v*)(SK + (size_t)m * 512 + lane * 8) = pack8(sf);
        f4v k0 = *(const f4v*)(p.k_k + (size_t)l * 512 + lane * 8), k1 = *(const f4v*)(p.k_k + (size_t)l * 512 + lane * 8 + 4);
        float kr[8]; float n2 = 0.f;
#pragma unroll
        for (int e = 0; e < 8; ++e) { kr[e] = sf[e] * (e < 4 ? k0[e] : k1[e - 4]); n2 += kr[e] * kr[e]; }
        n2 = sum_lpr<8>(n2); const float inv = 1.f / fmaxf(sqrtf(n2), 1e-12f);
#pragma unroll
        for (int e = 0; e < 8; ++e) kr[e] *= inv;
        *(u4v*)(rec + 64) = pack8(kr);
      }
      else if (it == 2) *(u4v*)(rec + 128) = pack8(sf);
      else if (valid) {
        if (lane < 16) { for (int e = 0; e < 8; ++e) sf[e] = tanhf_(sf[e]); }
        *(u4v*)(LORA + (size_t)m * 192 + lane * 8) = pack8(sf);
      }
    }
    {
      const int col = lane < 32 ? ZC_QD + lane * 8 : (lane < 48 ? ZC_KVD + (lane - 32) * 8 : ZC_KR + ((lane - 48) & 3) * 8);
      float x[8]; unpack8(*(const u4v*)(z + col), x);
      float ss = 0.f;
#pragma unroll
      for (int e = 0; e < 8; ++e) ss += x[e] * x[e];
      const float t32 = sum_lpr<32>(ss), t16 = sum_lpr<16>(ss);
      if (lane < 32) {
        const float rs = rsqrtf(t32 * (1.f / 256.f) + 1e-6f); const float* gq = p.q_norm + (size_t)l * 256 + lane * 8; float o[8];
#pragma unroll
        for (int e = 0; e < 8; ++e) o[e] = x[e] * rs * gq[e];
        *(u4v*)(QDN + (size_t)m * 256 + lane * 8) = pack8(o);
      } else if (lane < 48) {
        const float rs = rsqrtf(t16 * (1.f / 128.f) + 1e-6f); const float* gk = p.kv_norm + (size_t)l * 128 + (lane - 32) * 8; float o[8];
#pragma unroll
        for (int e = 0; e < 8; ++e) o[e] = x[e] * rs * gk[e];
        *(u4v*)(CKV + (size_t)m * 128 + (lane - 32) * 8) = pack8(o);
        if (!isden) { float* op = p.out + OUT_CKV + (((size_t)b * NL + l) * T_C + t) * 128 + (lane - 32) * 8; *(f4v*)op = f4v{o[0], o[1], o[2], o[3]}; *(f4v*)(op + 4) = f4v{o[4], o[5], o[6], o[7]}; }
      } else if (lane < 52) {
        float o[8];
        if (isden) {
#pragma unroll
          for (int pq = 0; pq < 4; ++pq) { int pi = (lane - 48) * 4 + pq; float cs = rope[((size_t)t * 16 + pi) * 2], sn = rope[((size_t)t * 16 + pi) * 2 + 1];
            o[2 * pq] = x[2 * pq] * cs - x[2 * pq + 1] * sn; o[2 * pq + 1] = x[2 * pq] * sn + x[2 * pq + 1] * cs; }
        } else {
#pragma unroll
          for (int e = 0; e < 8; ++e) o[e] = x[e];
          float* op = p.out + OUT_KR + (((size_t)b * NL + l) * T_C + t) * 32 + (lane - 48) * 8; *(f4v*)op = f4v{x[0], x[1], x[2], x[3]}; *(f4v*)(op + 4) = f4v{x[4], x[5], x[6], x[7]};
        }
        { const int d8 = lane - 48; *(u4v*)(KR + ((((size_t)sq * (g.nkeys >> 5) + (t >> 5)) * 2 + (d8 >> 1)) * 64 + (d8 & 1) * 32 + (t & 31)) * 8) = pack8(o); }
      }
    }
    {
      float v[8]; unpack8(*(const u4v*)(z + ZC_VC + lane * 8), v);
      float s1 = 0.f;
#pragma unroll
      for (int e = 0; e < 8; ++e) { v[e] = geluf_(v[e]); s1 += v[e]; }
      s1 = wave_sum(s1); const float mean = s1 * (1.f / 512.f); float s2 = 0.f;
#pragma unroll
      for (int e = 0; e < 8; ++e) { float d = v[e] - mean; s2 += d * d; }
      s2 = wave_sum(s2); const float rs = rsqrtf(s2 * (1.f / 512.f) + 1e-5f);
      const float* gg = p.g_ln_g + (size_t)l * 512 + lane * 8; const float* gb = p.g_ln_b + (size_t)l * 512 + lane * 8;
#pragma unroll
      for (int e = 0; e < 8; ++e) v[e] = (v[e] - mean) * rs * gg[e] + gb[e];
      *(u4v*)(VCN + (size_t)m * 512 + lane * 8) = pack8(v);
    }
  }
}

__device__ __forceinline__ void stage_g2(const Params& p, const Grp& g, int l, int bid, int nb, char* smem) {
  char* ws = p.ws;
  const bf16_t* Z = (const bf16_t*)(ws + O_Z);
  const float* rope = (const float*)(ws + O_ROPE);
  const int mg = g.mg, mkv = g.mkv, T = g.T, isden = g.isden, nkeys = g.nkeys;
  const int TM_M = (mg + 127) / 128, TM_KV = (mkv + 127) / 128;
  const int NT_Q = TM_M * 6, NT_KV = TM_KV * 8, NT_LORA = TM_M * 8, NT_GM = (mg / 128) * 4, ntt = T / 128, NT_D1 = g.nseq * 8 * ntt;
  const int NT = NT_Q + NT_KV + NT_LORA + NT_GM + NT_D1;
  for (int t0 = bid; t0 < NT; t0 += nb) {
    int t = t0; f4v acc[2][4]; zero_acc<4>(acc);
    if (t < NT_Q) {
      int tn = t / TM_M, tm = t % TM_M;
      gemm_mainloop<4>((const bf16_t*)(ws + O_QDN), 256, tm * 128, mg, (const bf16_t*)(ws + O_WQT), 256, tn * 128, 768, 256, smem, acc);
      bf16_t* Q = (bf16_t*)(ws + O_Q);
      const float scale = 0.10206207261596575f * 1.4426950408889634f;
      epi_foreach<4>(acc, tm * 128, tn * 128, [&](int row, int c0, f4v& v) {
        if (row >= mg) return;
        int cw = c0 % 96; float o0 = v[0], o1 = v[1], o2 = v[2], o3 = v[3];
        if (cw >= 64 && isden) { int tt = row % T_D; int pi = (cw - 64) >> 1; const float* rp = rope + ((size_t)tt * 16 + pi) * 2;
          float c_a = rp[0], s_a = rp[1], c_b = rp[2], s_b = rp[3];
          o0 = v[0] * c_a - v[1] * s_a; o1 = v[0] * s_a + v[1] * c_a; o2 = v[2] * c_b - v[3] * s_b; o3 = v[2] * s_b + v[3] * c_b; }
        *(u2v*)(Q + (size_t)row * 768 + c0) = pack4(o0 * scale, o1 * scale, o2 * scale, o3 * scale);
      });
      continue;
    }
    t -= NT_Q;
    if (t < NT_KV) {
      int tn = t / TM_KV, tm = t % TM_KV;
      gemm_mainloop<4>((const bf16_t*)(ws + O_CKV), 128, tm * 128, mkv, (const bf16_t*)(ws + O_WKVT), 128, tn * 128, 1024, 128, smem, acc);
      bf16_t* KN = (bf16_t*)(ws + O_KN); bf16_t* VT = (bf16_t*)(ws + O_VT);
      epi_foreach<4>(acc, tm * 128, tn * 128, [&](int row, int c0, f4v& v) {
        if (row >= mkv) return;
        int h = c0 >> 7, w = c0 & 127;
        int sq, key;
        if (row < mg) { sq = row / T; key = row % T; } else { int r = row - mg; sq = r / PAST; key = T + r % PAST; }
        const int ntile = nkeys >> 5, tile = key >> 5, kq = key & 31;
        if (w < 64)
          *(u2v*)(KN + (((((size_t)sq * 8 + h) * ntile + tile) * 4 + (w >> 4)) * 64 + ((w >> 3) & 1) * 32 + kq) * 8 + (w & 7)) = pack4(v[0], v[1], v[2], v[3]);
        else {
          const int o16 = kq & 15, st = kq >> 4, hh2 = (o16 & 7) >> 2, jj = ((o16 >> 3) << 2) | (o16 & 3);
#pragma unroll
          for (int e = 0; e < 4; ++e) { const int dv = w - 64 + e;
            VT[((((((size_t)sq * 8 + h) * ntile + tile) * 2 + st) * 2 + (dv >> 5)) * 64 + hh2 * 32 + (dv & 31)) * 8 + jj] = f2bf(v[e]); } }
      });
      continue;
    }
    t -= NT_KV;
    if (t < NT_LORA) {
      int dir = t / (TM_M * 4), r = t % (TM_M * 4), tn = r / TM_M, tm = r % TM_M;
      gemm_mainloop<4>((const bf16_t*)(ws + O_LORA) + dir * 64, 192, tm * 128, mg, (const bf16_t*)(ws + O_WUPT) + (size_t)dir * 512 * 64, 64, tn * 128, 512, 64, smem, acc);
      f4v aa[2][4]; zero_acc<4>(aa);
      gemm_mainloop<4>((const bf16_t*)(ws + O_LORA) + 128, 192, tm * 128, mg, (const bf16_t*)(ws + O_WUPT) + (size_t)(2 + dir) * 512 * 64, 64, tn * 128, 512, 64, smem, aa);
      const float* w0 = p.w0 + ((size_t)l * 2 + dir) * 512; const float* a0 = p.a0 + ((size_t)l * 2 + dir) * 512;
      const float* k_a = p.k_a + (size_t)l * 512; const float* r_k = p.r_k + (size_t)l * 512;
      const bf16_t* SK = (const bf16_t*)(ws + O_SK); bf16_t* SOP = (bf16_t*)(ws + O_SOP); float* BON = (float*)(ws + O_BON);
      const int lane = my_tid() & 63, wid = my_tid() >> 6, wm = wid >> 1, wn = wid & 1;
      const int h = tn * 2 + wn;
#pragma unroll
      for (int i = 0; i < 2; ++i) {
        int row = tm * 128 + wm * 32 + i * 16 + (lane & 15); const bool ok = row < mg; if (!ok) row = mg - 1;
        const int sq = row / T, tt = row % T;
        bf16_t* rec = SOP + (((size_t)sq * 8 + h) * T + tt) * 576;
        float bon = 0.f;
#pragma unroll
        for (int j = 0; j < 4; ++j) {
          const int chn = j * 16 + (lane >> 4) * 4, c = h * 64 + chn;
          u2v k2 = *(const u2v*)(SK + (size_t)row * 512 + c), kk2 = *(const u2v*)(rec + 64 + chn), r2 = *(const u2v*)(rec + chn);
          float kv[4] = {bflo(k2.x), bfhi(k2.x), bflo(k2.y), bfhi(k2.y)}, kkv[4] = {bflo(kk2.x), bfhi(kk2.x), bflo(kk2.y), bfhi(kk2.y)}, rv[4] = {bflo(r2.x), bfhi(r2.x), bflo(r2.y), bfhi(r2.y)};
          float dd[4], bb[4], kt[4];
#pragma unroll
          for (int e = 0; e < 4; ++e) {
            float pw = acc[i][j][e] + w0[c + e], pa = aa[i][j][e] + a0[c + e];
            dd[e] = 1.f - fexp_(-0.6065306597126334f * sigmoidf_(pw));
            float av = sigmoidf_(pa);
            bb[e] = kkv[e] * av; kt[e] = kv[e] * (1.f + (av - 1.f) * k_a[c + e]);
            bon += rv[e] * kt[e] * r_k[c + e];
          }
          if (ok) { *(u2v*)(rec + (3 + 3 * dir) * 64 + chn) = pack4(dd[0], dd[1], dd[2], dd[3]); *(u2v*)(rec + (4 + 3 * dir) * 64 + chn) = pack4(bb[0], bb[1], bb[2], bb[3]);
            *(u2v*)(rec + (5 + 3 * dir) * 64 + chn) = pack4(kt[0], kt[1], kt[2], kt[3]); }
        }
        bon += __shfl_xor(bon, 16); bon += __shfl_xor(bon, 32);
        if (ok && lane < 16) BON[((size_t)row * 8 + h) * 2 + dir] = bon;
      }
      continue;
    }
    t -= NT_LORA;
    if (t < NT_GM) {
      int ch = t >> 2, gg = t & 3;
      gemm_mainloop<4, true>((const bf16_t*)(ws + O_WS) + (size_t)gg * 128 * 128, 128, 0, 128, (const bf16_t*)(ws + O_VCNT) + (size_t)ch * 128 * 512, 512, gg * 128, 512, 128, smem, acc);
      bf16_t* O = (bf16_t*)(ws + O_OBR) + (size_t)2 * MG * 512;
      const float* bs = p.g_b_s + ((size_t)l * 4 + gg) * 128;
      epi_foreach<4>(acc, 0, 0, [&](int pp, int c0, f4v& v) {
        int m = ch * 128 + pp; int c = gg * 128 + c0; float bb = bs[pp];
        u2v uu = *(const u2v*)(Z + (size_t)m * IN_W + ZC_U + c), gc = *(const u2v*)(Z + (size_t)m * IN_W + ZC_GC + c);
        *(u2v*)(O + (size_t)m * 512 + c) = pack4(geluf_(bflo(uu.x)) * (v[0] + bb) * siluf_(bflo(gc.x)), geluf_(bfhi(uu.x)) * (v[1] + bb) * siluf_(bfhi(gc.x)),
                                                 geluf_(bflo(uu.y)) * (v[2] + bb) * siluf_(bflo(gc.y)), geluf_(bfhi(uu.y)) * (v[3] + bb) * siluf_(bfhi(gc.y)));
      });
      continue;
    }
    t -= NT_GM;
    {
      int per_seq = 8 * ntt; int sq = t / per_seq; int r = t % per_seq; int gg = r / (2 * ntt); int r2 = r % (2 * ntt); int tj = r2 / ntt, tt = r2 % ntt;
      long mbase = (long)sq * T;
      gemm_mainloop<4>((const bf16_t*)(ws + O_CS128), 128, tj * 128, 256, Z + (size_t)mbase * IN_W + ZC_F + gg * 128, IN_W, tt * 128, T, 128, smem, acc);
      bf16_t* YT = (bf16_t*)(ws + O_YT) + (size_t)mbase * 1024 + (size_t)gg * 128 * 2 * T;
      epi_foreach<4>(acc, tj * 128, tt * 128, [&](int j, int c0, f4v& v) {
        *(u2v*)(YT + (size_t)(j & 127) * 2 * T + (size_t)(j >> 7) * T + c0) = pack4(v[0], v[1], v[2], v[3]);
      });
    }
  }
}

__device__ __forceinline__ bool wave_any(bool pr) {
#ifdef EMU
  return wave_sum(pr ? 1.f : 0.f) > 0.f;
#else
  return __builtin_amdgcn_ballot_w64(pr) != 0ull;
#endif
}
__device__ __forceinline__ void attention_task(const Params& p, const Grp& g, int sq, int h, int qb32) {
  char* ws = p.ws;
  const int lane = my_tid() & 63, ql = lane & 31, hh = lane >> 5;
  const int T = g.T, nkeys = g.nkeys;
  const long mbase = (long)sq * T;
  const bf16_t* Q = (const bf16_t*)(ws + O_Q); const bf16_t* KN = (const bf16_t*)(ws + O_KN); const bf16_t* KRp = (const bf16_t*)(ws + O_KR);
  const int ntile = nkeys >> 5;
  const bf16_t* KFb = KN + ((size_t)sq * 8 + h) * ntile * 4 * 512 + lane * 8;
  const bf16_t* KRb = KRp + (size_t)sq * ntile * 2 * 512 + lane * 8;
  const bf16_t* VFb = (const bf16_t*)(ws + O_VT) + ((size_t)sq * 8 + h) * ntile * 4 * 512 + lane * 8;
  const long mq = mbase + qb32 * 32 + ql;
  s8v qf[6];
#pragma unroll
  for (int s = 0; s < 6; ++s) qf[s] = *(const s8v*)(Q + (size_t)mq * 768 + h * 96 + 16 * s + 8 * hh);
  f16v o0, o1;
#pragma unroll
  for (int i = 0; i < 16; ++i) { o0[i] = 0.f; o1[i] = 0.f; }
  float mrun = -1e30f, lrun = 0.f;
  s8v kfA[6], vfA[4], kfB[6], vfB[4];
#define ATT_LOAD(k0_, KF, VF) do { const int tl = (k0_) >> 5; \
    _Pragma("unroll") for (int st = 0; st < 4; ++st) KF[st] = *(const s8v*)(KFb + (size_t)(tl * 4 + st) * 512); \
    _Pragma("unroll") for (int st = 0; st < 2; ++st) KF[4 + st] = *(const s8v*)(KRb + (size_t)(tl * 2 + st) * 512); \
    _Pragma("unroll") for (int q = 0; q < 4; ++q) VF[q] = *(const s8v*)(VFb + (size_t)(tl * 4 + q) * 512); } while (0)
#define ATT_TILE(KF, VF) do { \
    f16v s; _Pragma("unroll") for (int i = 0; i < 16; ++i) s[i] = 0.f; \
    _Pragma("unroll") for (int st = 0; st < 6; ++st) s = __builtin_amdgcn_mfma_f32_32x32x16_bf16(KF[st], qf[st], s, 0, 0, 0); \
    float mx = s[0]; _Pragma("unroll") for (int i = 1; i < 16; ++i) mx = fmaxf(mx, s[i]); \
    mx = fmaxf(mx, __shfl_xor(mx, 32)); \
    if (wave_any(mx > mrun)) { const float mnew = fmaxf(mrun, mx); const float alpha = fexp2_(mrun - mnew); mrun = mnew; lrun *= alpha; \
      _Pragma("unroll") for (int i = 0; i < 16; ++i) { o0[i] *= alpha; o1[i] *= alpha; } } \
    float ps = 0.f; float pe[16]; \
    _Pragma("unroll") for (int i = 0; i < 16; ++i) { pe[i] = fexp2_(s[i] - mrun); ps += pe[i]; } \
    lrun += ps; \
    _Pragma("unroll") for (int st = 0; st < 2; ++st) { \
      const s8v pf = __builtin_bit_cast(s8v, u4v{pk2bf(pe[8 * st], pe[8 * st + 1]), pk2bf(pe[8 * st + 2], pe[8 * st + 3]), pk2bf(pe[8 * st + 4], pe[8 * st + 5]), pk2bf(pe[8 * st + 6], pe[8 * st + 7])}); \
      o0 = __builtin_amdgcn_mfma_f32_32x32x16_bf16(VF[st * 2], pf, o0, 0, 0, 0); \
      o1 = __builtin_amdgcn_mfma_f32_32x32x16_bf16(VF[st * 2 + 1], pf, o1, 0, 0, 0); } } while (0)
  ATT_LOAD(0, kfA, vfA);
  int k0 = 0;
  for (; k0 + 64 <= nkeys; k0 += 64) {
    ATT_LOAD(k0 + 32, kfB, vfB); SCHED_FENCE();
    ATT_TILE(kfA, vfA); SCHED_FENCE();
    ATT_LOAD((k0 + 64 < nkeys) ? k0 + 64 : nkeys - 32, kfA, vfA); SCHED_FENCE();
    ATT_TILE(kfB, vfB); SCHED_FENCE();
  }
  if (k0 < nkeys) ATT_TILE(kfA, vfA);
#undef ATT_LOAD
#undef ATT_TILE
  const float ltot = lrun + __shfl_xor(lrun, 32); const float inv = 1.f / ltot;
  const bf16_t* Z = (const bf16_t*)(ws + O_Z);
  bf16_t* O = (bf16_t*)(ws + O_OBR) + (size_t)1 * MG * 512;
#pragma unroll
  for (int db = 0; db < 2; ++db)
#pragma unroll
    for (int q4 = 0; q4 < 4; ++q4) {
      const int dv = db * 32 + 8 * q4 + 4 * hh;
      u2v gt = *(const u2v*)(Z + (size_t)mq * IN_W + ZC_GB + h * 64 + dv);
      const float x0 = (db == 0 ? o0[4 * q4] : o1[4 * q4]) * inv, x1 = (db == 0 ? o0[4 * q4 + 1] : o1[4 * q4 + 1]) * inv, x2 = (db == 0 ? o0[4 * q4 + 2] : o1[4 * q4 + 2]) * inv, x3 = (db == 0 ? o0[4 * q4 + 3] : o1[4 * q4 + 3]) * inv;
      *(u2v*)(O + (size_t)mq * 512 + h * 64 + dv) = pack4(x0 * siluf_(bflo(gt.x)), x1 * siluf_(bfhi(gt.x)), x2 * siluf_(bflo(gt.y)), x3 * siluf_(bfhi(gt.y)));
    }
}

__device__ __forceinline__ void stage_dft2(const Params& p, const Grp& g, int bid, int nb, char* smem) {
  char* ws = p.ws;
  const bf16_t* Z = (const bf16_t*)(ws + O_Z);
  const int T = g.T, ntt = T / 128;
  const int NT_D2 = g.nseq * 4 * ntt;
  const int soff = (g.nseq * 32) % nb;
  for (int t = (bid - soff + nb) % nb; t < NT_D2; t += nb) {
    int sq = t / (4 * ntt), r = t % (4 * ntt), gg = r / ntt, tt = r % ntt;
    long mbase = (long)sq * T;
    f4v acc[2][4]; zero_acc<4>(acc);
    gemm_mainloop<4>((const bf16_t*)(ws + (g.isden ? O_A2D : O_A2C)), 2 * T, tt * 128, T, (const bf16_t*)(ws + O_YT) + (size_t)mbase * 1024 + (size_t)gg * 128 * 2 * T, 2 * T, 0, 128, 2 * T, smem, acc);
    bf16_t* O = (bf16_t*)(ws + O_OBR) + (size_t)3 * MG * 512;
    const float sc = rsqrtf(128.f * (float)T);
    epi_foreach<4>(acc, tt * 128, 0, [&](int row, int c0, f4v& v) {
      long m = mbase + row; int c = gg * 128 + c0; u2v gd = *(const u2v*)(Z + (size_t)m * IN_W + ZC_GD + c);
      *(u2v*)(O + (size_t)m * 512 + c) = pack4(v[0] * sc * siluf_(bflo(gd.x)), v[1] * sc * siluf_(bfhi(gd.x)), v[2] * sc * siluf_(bflo(gd.y)), v[3] * sc * siluf_(bfhi(gd.y)));
    });
  }
}

constexpr int PL_STR = 72;
constexpr int PCH_MA = 0, PCH_MB = 4608, PCH_TBT = 9216, PCH_MBT = 10240, PCH_TK = 11264, PCH_MK = 12288, PCH_LDS = 13312;
__device__ __forceinline__ void pchunk_task(const Params& p, const Grp& g, int task, char* wl) {
  char* ws = p.ws;
  const int lane = my_tid() & 63, ql = lane & 31, hh = lane >> 5;
  const int T = g.T, nch = T >> 4;
  const int ch = task / nch, ci = task % nch;
  const int dir = ch & 1, h = (ch >> 1) & 7, sq = ch >> 4;
  const bf16_t* rec0 = (const bf16_t*)(ws + O_SOP) + ((size_t)sq * 8 + h) * T * 576;
  char* cm = ws + O_CM + (size_t)task * CM_REC;
  float At[16], Rt[16], Bh[16], Kh[16]; float W = 1.f;
#pragma unroll
  for (int j = 0; j < 16; ++j) {
    const int st = ci * 16 + j, tt = dir ? T - 1 - st : st;
    const bf16_t* rec = rec0 + (size_t)tt * 576;
    const float r = bf2f(rec[lane]), kk = bf2f(rec[64 + lane]), d = bf2f(rec[(3 + 3 * dir) * 64 + lane]), b = bf2f(rec[(4 + 3 * dir) * 64 + lane]), kt = bf2f(rec[(5 + 3 * dir) * 64 + lane]);
    At[j] = -kk * W; W *= (1.f - d); const float iw = 1.f / W; Rt[j] = r * W; Bh[j] = b * iw; Kh[j] = kt * iw;
  }
  {
    float x[8];
#pragma unroll
    for (int q = 0; q < 2; ++q) {
#pragma unroll
      for (int e = 0; e < 8; ++e) { const int st = ci * 16 + q * 8 + e, tt = dir ? T - 1 - st : st; x[e] = bf2f(rec0[(size_t)tt * 576 + 128 + lane]); }
      *(u4v*)(cm + CM_VT + lane * 32 + q * 16) = pack8(x);
    }
  }
  {
    float x[8];
#pragma unroll
    for (int q = 0; q < 4; ++q) {
#pragma unroll
      for (int e = 0; e < 8; ++e) x[e] = (q < 2 ? Bh[q * 8 + e] : Kh[(q - 2) * 8 + e]) * W;
      *(u4v*)(cm + CM_BKT + lane * 64 + q * 16) = pack8(x);
    }
    *(float*)(cm + CM_WL + lane * 4) = W;
  }
  bf16_t* MA = (bf16_t*)(wl + PCH_MA); bf16_t* MB = (bf16_t*)(wl + PCH_MB);
  float* TBT = (float*)(wl + PCH_TBT); float* MBT = (float*)(wl + PCH_MBT); float* TK = (float*)(wl + PCH_TK); float* MK = (float*)(wl + PCH_MK);
  WAVE_SYNC();
#pragma unroll
  for (int j = 0; j < 16; ++j) { MA[j * PL_STR + lane] = f2bf(Bh[j]); MA[(16 + j) * PL_STR + lane] = f2bf(Kh[j]); MB[j * PL_STR + lane] = f2bf(At[j]); MB[(16 + j) * PL_STR + lane] = f2bf(Rt[j]); }
  WAVE_SYNC();
  f16v D;
#pragma unroll
  for (int i = 0; i < 16; ++i) D[i] = 0.f;
#pragma unroll
  for (int s4 = 0; s4 < 4; ++s4) {
    const s8v fa = *(const s8v*)(MA + ql * PL_STR + 16 * s4 + 8 * hh), fb = *(const s8v*)(MB + ql * PL_STR + 16 * s4 + 8 * hh);
    D = __builtin_amdgcn_mfma_f32_32x32x16_bf16(fa, fb, D, 0, 0, 0);
  }
#pragma unroll
  for (int r = 0; r < 16; ++r) {
    const int i = (r & 3) + 8 * (r >> 2) + 4 * hh; const float v = D[r];
    if (r < 8) { if (ql < 16) TBT[ql * 16 + i] = (i < ql) ? v : 0.f; else MBT[(ql - 16) * 16 + i] = (i <= ql - 16) ? v : 0.f; }
    else { const int i2 = i - 16; if (ql < 16) TK[i2 * 16 + ql] = (i2 < ql) ? v : 0.f; else MK[i2 * 16 + (ql - 16)] = (i2 <= ql - 16) ? v : 0.f; }
  }
  WAVE_SYNC();
  const int l16 = lane & 15;
  float Z[16], Z2[16];
#pragma unroll
  for (int j = 0; j < 16; ++j) { Z[j] = 0.f; Z2[j] = 0.f; }
#pragma unroll
  for (int j = 0; j < 16; ++j) {
    float a1 = At[j], a2 = TK[l16 * 16 + j];
#pragma unroll
    for (int c4 = 0; c4 * 4 < j; ++c4) { const f4v tv = *(const f4v*)(TBT + j * 16 + c4 * 4);
#pragma unroll
      for (int e = 0; e < 4; ++e) if (c4 * 4 + e < j) { a1 += Z[c4 * 4 + e] * tv[e]; a2 += Z2[c4 * 4 + e] * tv[e]; } }
    Z[j] = a1; Z2[j] = a2;
  }
  bf16_t* GT = (bf16_t*)(cm + CM_GT);
#pragma unroll
  for (int t = 0; t < 16; ++t) {
    float a1 = Rt[t], a2 = MK[l16 * 16 + t];
#pragma unroll
    for (int c4 = 0; c4 * 4 <= t; ++c4) { const f4v mv = *(const f4v*)(MBT + t * 16 + c4 * 4);
#pragma unroll
      for (int e = 0; e < 4; ++e) if (c4 * 4 + e <= t) { a1 += Z[c4 * 4 + e] * mv[e]; a2 += Z2[c4 * 4 + e] * mv[e]; } }
    GT[(16 + t) * 80 + lane] = f2bf(a1);
    if (lane < 16) GT[(16 + t) * 80 + 64 + lane] = f2bf(a2);
  }
#pragma unroll
  for (int j = 0; j < 16; ++j) { GT[j * 80 + lane] = f2bf(Z[j]); if (lane < 16) GT[j * 80 + 64 + lane] = f2bf(Z2[j]); }
}

__device__ __forceinline__ s8v cvt8(const f16v& a, int o) {
  return __builtin_bit_cast(s8v, u4v{pk2bf(a[o], a[o + 1]), pk2bf(a[o + 2], a[o + 3]), pk2bf(a[o + 4], a[o + 5]), pk2bf(a[o + 6], a[o + 7])});
}
struct ScanOps { s8v gA[5], bU[2], bV[2], vf; float wreg; };
__device__ __forceinline__ void scan2_load(ScanOps& o, const char* cm, const bf16_t* rec0, int ci, int T, int dir, int ql, int hh, int row) {
  const bf16_t* GT = (const bf16_t*)(cm + CM_GT); const bf16_t* BKT = (const bf16_t*)(cm + CM_BKT);
  o.wreg = *(const float*)(cm + CM_WL + (ql + 32 * hh) * 4);
#pragma unroll
  for (int s = 0; s < 4; ++s) { const bf16_t* q = GT + ql * 80 + 16 * s + 4 * hh; u2v lo = *(const u2v*)q, hi = *(const u2v*)(q + 8); o.gA[s] = __builtin_bit_cast(s8v, u4v{lo.x, lo.y, hi.x, hi.y}); }
  o.gA[4] = *(const s8v*)(GT + ql * 80 + 64 + 8 * hh);
#pragma unroll
  for (int k2 = 0; k2 < 2; ++k2) { const bf16_t* q = BKT + (32 * k2 + ql) * 32; u2v lo = *(const u2v*)(q + 4 * hh), hi = *(const u2v*)(q + 8 + 4 * hh);
    o.bU[k2] = __builtin_bit_cast(s8v, u4v{lo.x, lo.y, hi.x, hi.y}); o.bV[k2] = *(const s8v*)(q + 16 + 8 * hh); }
  o.vf = *(const s8v*)(cm + CM_VT + row * 32 + hh * 16);
}
__device__ __forceinline__ void scan2_task(const Params& p, const Grp& g, int l, int task, char* wl) {
  char* ws = p.ws;
  const int lane = my_tid() & 63, ql = lane & 31, hh = lane >> 5;
  const int T = g.T, nch = T >> 4;
  const int ch = task >> 1, rt = task & 1;
  const int dir = ch & 1, h = (ch >> 1) & 7, sq = ch >> 4;
  const int row = rt * 32 + ql;
  const long mbase = (long)sq * T;
  const bf16_t* rec0 = (const bf16_t*)(ws + O_SOP) + ((size_t)sq * 8 + h) * T * 576;
  const char* cm0 = ws + O_CM + (size_t)ch * nch * CM_REC;
  float* YS = (float*)(ws + O_YS) + (size_t)dir * MG * 512;
  float* wlf = (float*)wl;
  f16v a0, a1;
  if (g.isden) { const float* st = (dir ? p.st_b : p.st_f) + ((((size_t)sq * NL + l) * 8 + h) * 64 + row) * 64;
#pragma unroll
    for (int q = 0; q < 4; ++q) { f4v x = *(const f4v*)(st + 8 * q + 4 * hh), y = *(const f4v*)(st + 32 + 8 * q + 4 * hh);
#pragma unroll
      for (int e = 0; e < 4; ++e) { a0[4 * q + e] = x[e]; a1[4 * q + e] = y[e]; } } }
  else {
#pragma unroll
    for (int i = 0; i < 16; ++i) { a0[i] = 0.f; a1[i] = 0.f; } }
  ScanOps s0, s1, s2;
  scan2_load(s0, cm0, rec0, 0, T, dir, ql, hh, row);
  scan2_load(s1, cm0 + CM_REC, rec0, 1, T, dir, ql, hh, row);
#define SCAN2_STEP(CUR, ci_) do { const int ci = (ci_); \
    WAVE_SYNC(); wlf[lane] = CUR.wreg; WAVE_SYNC(); \
    const s8v vfrag = CUR.vf; \
    f16v D; _Pragma("unroll") for (int i = 0; i < 16; ++i) D[i] = 0.f; \
    D = __builtin_amdgcn_mfma_f32_32x32x16_bf16(CUR.gA[0], cvt8(a0, 0), D, 0, 0, 0); \
    D = __builtin_amdgcn_mfma_f32_32x32x16_bf16(CUR.gA[1], cvt8(a0, 8), D, 0, 0, 0); \
    D = __builtin_amdgcn_mfma_f32_32x32x16_bf16(CUR.gA[2], cvt8(a1, 0), D, 0, 0, 0); \
    D = __builtin_amdgcn_mfma_f32_32x32x16_bf16(CUR.gA[3], cvt8(a1, 8), D, 0, 0, 0); \
    D = __builtin_amdgcn_mfma_f32_32x32x16_bf16(CUR.gA[4], vfrag, D, 0, 0, 0); \
    _Pragma("unroll") for (int i = 0; i < 8; ++i) { const int st = ci * 16 + (i & 3) + 8 * (i >> 2) + 4 * hh, tt = dir ? T - 1 - st : st; YS[(size_t)(mbase + tt) * 512 + h * 64 + row] = D[8 + i]; } \
    const s8v uf = cvt8(D, 0); \
    const float* wq = wlf + 4 * hh; \
    _Pragma("unroll") for (int q = 0; q < 4; ++q) { const f4v w0 = *(const f4v*)(wq + 8 * q), w1 = *(const f4v*)(wq + 32 + 8 * q); \
      _Pragma("unroll") for (int e = 0; e < 4; ++e) { a0[4 * q + e] *= w0[e]; a1[4 * q + e] *= w1[e]; } } \
    a0 = __builtin_amdgcn_mfma_f32_32x32x16_bf16(CUR.bU[0], uf, a0, 0, 0, 0); \
    a0 = __builtin_amdgcn_mfma_f32_32x32x16_bf16(CUR.bV[0], vfrag, a0, 0, 0, 0); \
    a1 = __builtin_amdgcn_mfma_f32_32x32x16_bf16(CUR.bU[1], uf, a1, 0, 0, 0); \
    a1 = __builtin_amdgcn_mfma_f32_32x32x16_bf16(CUR.bV[1], vfrag, a1, 0, 0, 0); } while (0)
  int c = 0;
  for (; c + 3 <= nch; c += 3) {
    { const int cc = (c + 2 < nch) ? c + 2 : nch - 1; scan2_load(s2, cm0 + (size_t)cc * CM_REC, rec0, cc, T, dir, ql, hh, row); }
    SCHED_FENCE(); SCAN2_STEP(s0, c); SCHED_FENCE();
    { const int cc = (c + 3 < nch) ? c + 3 : nch - 1; scan2_load(s0, cm0 + (size_t)cc * CM_REC, rec0, cc, T, dir, ql, hh, row); }
    SCHED_FENCE(); SCAN2_STEP(s1, c + 1); SCHED_FENCE();
    { const int cc = (c + 4 < nch) ? c + 4 : nch - 1; scan2_load(s1, cm0 + (size_t)cc * CM_REC, rec0, cc, T, dir, ql, hh, row); }
    SCHED_FENCE(); SCAN2_STEP(s2, c + 2); SCHED_FENCE();
  }
  if (c < nch) SCAN2_STEP(s0, c);
  if (c + 1 < nch) SCAN2_STEP(s1, c + 1);
#undef SCAN2_STEP
  if (!g.isden) { float* so = p.out + (dir ? OUT_SB : OUT_SF) + ((((size_t)(g.b0 + sq) * NL + l) * 8 + h) * 64 + row) * 64;
#pragma unroll
    for (int q = 0; q < 4; ++q) { *(f4v*)(so + 8 * q + 4 * hh) = f4v{a0[4 * q], a0[4 * q + 1], a0[4 * q + 2], a0[4 * q + 3]}; *(f4v*)(so + 32 + 8 * q + 4 * hh) = f4v{a1[4 * q], a1[4 * q + 1], a1[4 * q + 2], a1[4 * q + 3]}; } }
}

__device__ __forceinline__ void stage_mixA(const Params& p, const Grp& g, int bid, int nb, char* smem) {
  const int wid = my_tid() >> 6;
  const int NP = g.nseq * 16 * (g.T >> 4), q32 = g.T / 32, NA = g.nseq * 8 * q32;
  char* wl = smem + wid * PCH_LDS;
  for (int task = wid * nb + bid; task < NP + NA; task += nb * NWAVE) {
    if (task < NP) pchunk_task(p, g, task, wl);
    else { int t = task - NP; int sq = t / (8 * q32), r = t % (8 * q32); attention_task(p, g, sq, r / q32, r % q32); }
  }
}
__device__ __forceinline__ void stage_scanS(const Params& p, const Grp& g, int l, int bid, int nb, char* smem) {
  const int wid = my_tid() >> 6;
  const int NS = g.nseq * 32;
  for (int task = wid * nb + bid; task < NS; task += nb * NWAVE) scan2_task(p, g, l, task, smem + wid * 768);
  __syncthreads();
}

__device__ __forceinline__ void stage_e3(const Params& p, const Grp& g, int l, int bid, int nb) {
  const int lane = my_tid() & 63, wid = my_tid() >> 6;
  char* ws = p.ws;
  const float* YS = (const float*)(ws + O_YS); const bf16_t* SOP = (const bf16_t*)(ws + O_SOP); const float* BON = (const float*)(ws + O_BON); const int T = g.T;
  const bf16_t* Z = (const bf16_t*)(ws + O_Z); bf16_t* O = (bf16_t*)(ws + O_OBR);
  const int hd = lane >> 3, c0 = lane * 8;
  const float* lg = p.ln_g + (size_t)l * 512 + c0; const float* lb = p.ln_b + (size_t)l * 512 + c0;
  for (int m = bid * NWAVE + wid; m < g.mg; m += nb * NWAVE) {
    const f4v y0 = *(const f4v*)(YS + (size_t)m * 512 + c0), y1 = *(const f4v*)(YS + (size_t)m * 512 + c0 + 4);
    const f4v z0 = *(const f4v*)(YS + ((size_t)MG + m) * 512 + c0), z1 = *(const f4v*)(YS + ((size_t)MG + m) * 512 + c0 + 4);
    float o[8]; float s1 = 0.f;
#pragma unroll
    for (int e = 0; e < 4; ++e) { o[e] = y0[e] + z0[e]; o[4 + e] = y1[e] + z1[e]; }
#pragma unroll
    for (int e = 0; e < 8; ++e) s1 += o[e];
    const float mean = sum_lpr<8>(s1) * (1.f / 64.f); float s2 = 0.f;
#pragma unroll
    for (int e = 0; e < 8; ++e) { o[e] -= mean; s2 += o[e] * o[e]; }
    const float rs = rsqrtf(sum_lpr<8>(s2) * (1.f / 64.f) + 64e-5f);
    const float bon = BON[((size_t)m * 8 + hd) * 2] + BON[((size_t)m * 8 + hd) * 2 + 1];
    float v[8], ga[8];
    unpack8(*(const u4v*)(SOP + (((size_t)(m / T) * 8 + hd) * T + (m % T)) * 576 + 128 + (lane & 7) * 8), v);
    unpack8(*(const u4v*)(Z + (size_t)m * IN_W + ZC_GA + c0), ga);
    float r[8];
#pragma unroll
    for (int e = 0; e < 8; ++e) r[e] = (o[e] * rs * lg[e] + lb[e] + bon * v[e]) * siluf_(ga[e]);
    *(u4v*)(O + (size_t)m * 512 + c0) = pack8(r);
  }
}

__device__ __forceinline__ void stage_gates(const Params& p, const Grp& g, int l, int bid, int nb, char* smem) {
  const bf16_t* H = (const bf16_t*)(p.ws + O_H);
  const bf16_t* W = (const bf16_t*)(p.ws + O_WMT);
  bf16_t* GT = (bf16_t*)(p.ws + O_GATES);
  const float* bm = p.b_merge + (size_t)l * 4096;
#ifndef EMU
  if ((g.mg & 255) == 0) {
    pg8::Gemm gm; gm.A = H; gm.Bt = W; gm.M = g.mg; gm.N = 4096; gm.K = 1024;
    pg8::StaticOrder S; S.init(gm.M, gm.N, nb, bid);
    pg8::EpiSigmoid E; E.O = GT; E.ldc = 4096; E.bias = bm;
    pg8::gemm_phase<pg8::EpiSigmoid, pg8::StaticOrder>((PG8_LAS unsigned char*)smem, gm, S, E);
    return;
  }
#endif
  const int TM = (g.mg + 127) / 128, mg = g.mg;
  for (int t = bid; t < TM * 32; t += nb) {
    int tn = t / TM, tm = t % TM; f4v acc[2][4]; zero_acc<4>(acc);
    gemm_mainloop<4>(H, 1024, tm * 128, mg, W, 1024, tn * 128, 4096, 1024, smem, acc);
    epi_foreach<4>(acc, tm * 128, tn * 128, [&](int row, int c0, f4v& v) {
      if (row < mg) *(u2v*)(GT + (size_t)row * 4096 + c0) = pack4(sigmoidf_(v[0] + bm[c0]), sigmoidf_(v[1] + bm[c0 + 1]), sigmoidf_(v[2] + bm[c0 + 2]), sigmoidf_(v[3] + bm[c0 + 3]));
    });
  }
}

__device__ __forceinline__ void stage_g8(const Params& p, const Grp& g, int l, int bid, int nb, char* smem) {
  char* ws = p.ws;
  bf16_t* MGD = (bf16_t*)(ws + O_MERGED);
  const bf16_t* GT = (const bf16_t*)(ws + O_GATES);
  const int TM = (g.mg + 127) / 128, mg = g.mg;
  for (int t = bid; t < TM * 8; t += nb) {
    int tn = t / TM, tm = t % TM;
    f4v macc[2][4]; zero_acc<4>(macc);
    for (int n = 0; n < 4; ++n) {
      f4v ap[2][4]; zero_acc<4>(ap);
      gemm_mainloop<4>((const bf16_t*)(ws + O_OBR) + (size_t)n * MG * 512, 512, tm * 128, mg, (const bf16_t*)(ws + O_WBRT) + (size_t)n * 1024 * 512, 512, tn * 128, 1024, 512, smem, ap);
      const int lane = my_tid() & 63, wid = my_tid() >> 6, wm = wid >> 1, wn = wid & 1;
#pragma unroll
      for (int i = 0; i < 2; ++i)
#pragma unroll
        for (int j = 0; j < 4; ++j) {
          int row = tm * 128 + wm * 32 + i * 16 + (lane & 15); row = row < mg ? row : mg - 1;
          int c0 = tn * 128 + wn * 64 + j * 16 + (lane >> 4) * 4;
          u2v gt = *(const u2v*)(GT + (size_t)row * 4096 + n * 1024 + c0);
          macc[i][j][0] += bflo(gt.x) * ap[i][j][0]; macc[i][j][1] += bfhi(gt.x) * ap[i][j][1]; macc[i][j][2] += bflo(gt.y) * ap[i][j][2]; macc[i][j][3] += bfhi(gt.y) * ap[i][j][3];
        }
    }
    epi_foreach<4>(macc, tm * 128, tn * 128, [&](int row, int c0, f4v& v) {
      if (row < mg) *(u2v*)(MGD + (size_t)row * 1024 + c0) = pack4(v[0], v[1], v[2], v[3]);
    });
  }
  (void)l;
}

__device__ __forceinline__ void stage_g9(const Params& p, const Grp& g, int l, int bid, int nb, char* smem) {
  char* ws = p.ws;
  float* X = p.out + (size_t)g.m0 * 1024;
  const float* modp = (const float*)(ws + O_MOD) + (size_t)l * 3 * 3072 + 2048;
  const int TM = (g.mg + 127) / 128, mg = g.mg;
  for (int t = bid; t < TM * 8; t += nb) {
    int tn = t / TM, tm = t % TM;
    f4v acc[2][4]; zero_acc<4>(acc);
    gemm_mainloop<4>((const bf16_t*)(ws + O_MERGED), 1024, tm * 128, mg, (const bf16_t*)(ws + O_WOUTT), 1024, tn * 128, 1024, 1024, smem, acc);
    epi_foreach<4>(acc, tm * 128, tn * 128, [&](int row, int c0, f4v& v) {
      if (row < mg) { const float* gt = modp + (size_t)mod_index(g, row) * 3072 + c0; f4v* xp = (f4v*)(X + (size_t)row * 1024 + c0); f4v x = *xp;
        x[0] += gt[0] * v[0]; x[1] += gt[1] * v[1]; x[2] += gt[2] * v[2]; x[3] += gt[3] * v[3]; *xp = x; }
    });
  }
}

__device__ __forceinline__ void stage_final(const Params& p, int bid, int nb) {
  const int lane = my_tid() & 63, wid = my_tid() >> 6;
  for (int m = bid * NWAVE + wid; m < M; m += nb * NWAVE) {
    float* xr = p.out + (size_t)m * 1024; float4 q[4]; float ss = 0.f;
#pragma unroll
    for (int i = 0; i < 4; ++i) { q[i] = *(const float4*)(xr + i * 256 + lane * 4); ss += q[i].x * q[i].x + q[i].y * q[i].y + q[i].z * q[i].z + q[i].w * q[i].w; }
    ss = wave_sum(ss); float rs = rsqrtf(ss * (1.f / 1024.f) + 1e-6f);
#pragma unroll
    for (int i = 0; i < 4; ++i) { int c = i * 256 + lane * 4; float4 gm = *(const float4*)(p.final_g + c);
      *(float4*)(xr + c) = make_float4(q[i].x * rs * gm.x, q[i].y * rs * gm.y, q[i].z * rs * gm.z, q[i].w * rs * gm.w); }
  }
}

#ifdef EMU
#define DECL_SMEM(name) char* name = emu::smem()
#else
#define DECL_SMEM(name) __shared__ __attribute__((aligned(16))) char name[SMEM_BYTES]
#endif

#ifdef EMU
struct GridBar { __device__ void sync() const { emu::grid_sync(); } };
#else
#define XB_TMO      128
#define XB_XCNT(j)  (256  + 64 * (j))
#define XB_XSUB(j)  (1280 + 64 * (j))
#define XB_XGEN(j)  (2304 + 64 * (j))
#define XB_TOP      3328
#define XB_TOPGEN   3392
#define XB_SPIN_CAP (1u << 20)
#define LAS __attribute__((address_space(3)))
__device__ __forceinline__ unsigned xb_ld(unsigned* p)              { return __hip_atomic_load(p, __ATOMIC_RELAXED, __HIP_MEMORY_SCOPE_AGENT); }
__device__ __forceinline__ unsigned xb_add(unsigned* p, unsigned v) { return __hip_atomic_fetch_add(p, v, __ATOMIC_RELAXED, __HIP_MEMORY_SCOPE_AGENT); }
__device__ __forceinline__ unsigned xb_xcc_id() { return (unsigned)__builtin_amdgcn_s_getreg((3 << 11) | 20) & 0xFu; }
#define XB_SPIN(cond, bar) do { unsigned _sp = 0; while (cond) { __builtin_amdgcn_s_sleep(1); \
    if ((++_sp & 255u) == 0u) { if (xb_ld(&(bar)[XB_TMO])) break; if (_sp > XB_SPIN_CAP) { atomicAdd(&(bar)[XB_TMO], 1u); break; } } } } while (0)
struct GridBar {
  unsigned* bar; unsigned x; volatile LAS unsigned* st;
  __device__ __forceinline__ void post(unsigned* b, volatile LAS unsigned* s_) {
    bar = b; x = xb_xcc_id(); st = s_;
    if (threadIdx.x == 0) (void)xb_add(&bar[XB_XCNT(x)], 1u);
  }
  __device__ __forceinline__ void complete(unsigned& nloc, unsigned& nx) const {
    const unsigned G = gridDim.x;
    unsigned sum, cnt, mine, sp = 0u;
    for (;;) {
      sum = 0u; cnt = 0u; mine = 0u;
#pragma unroll
      for (unsigned j = 0; j < 16; ++j) { const unsigned c = xb_ld(&bar[XB_XCNT(j)]); sum += c; cnt += (c > 0u) ? 1u : 0u; mine = (j == x) ? c : mine; }
      if (sum == G) break;
      __builtin_amdgcn_s_sleep(1);
      if ((++sp & 255u) == 0u) { if (xb_ld(&bar[XB_TMO])) break; if (sp > XB_SPIN_CAP) { atomicAdd(&bar[XB_TMO], 1u); break; } }
    }
    nloc = mine > 0u ? mine : 1u; nx = cnt > 0u ? cnt : 1u;
  }
  __device__ __forceinline__ void sync() const {
    asm volatile("s_waitcnt vmcnt(0)" ::: "memory");
    __syncthreads();
    if (threadIdx.x == 0) {
      __builtin_amdgcn_s_waitcnt(0);
      unsigned nloc = st[0], nx = st[1];
      if (nloc == 0u) { complete(nloc, nx); st[0] = nloc; st[1] = nx; }
      const unsigned old = xb_add(&bar[XB_XSUB(x)], 1u);
      const unsigned gen = old / nloc;
      if (old + 1u == (gen + 1u) * nloc) {
        __builtin_amdgcn_fence(__ATOMIC_RELEASE, "agent");
        asm volatile("s_waitcnt vmcnt(0)" ::: "memory");
        const unsigned og = xb_add(&bar[XB_TOP], 1u);
        const unsigned tg = og / nx;
        if (og + 1u == (tg + 1u) * nx) xb_add(&bar[XB_TOPGEN], 1u);
        else XB_SPIN(xb_ld(&bar[XB_TOPGEN]) == tg, bar);
        __builtin_amdgcn_fence(__ATOMIC_ACQUIRE, "agent");
        xb_add(&bar[XB_XGEN(x)], 1u);
        asm volatile("s_waitcnt vmcnt(0)" ::: "memory");
      } else {
        XB_SPIN(xb_ld(&bar[XB_XGEN(x)]) == gen, bar);
        __builtin_amdgcn_fence(__ATOMIC_ACQUIRE, "agent");
        asm volatile("s_waitcnt vmcnt(0)" ::: "memory");
      }
    }
    __syncthreads();
  }
};
#endif

#ifndef EMU
namespace cg = cooperative_groups;
#else
namespace cg = cooperative_groups;
#endif

__global__ void __launch_bounds__(NTHR) mega_kernel(Params p) {
  DECL_SMEM(smem);
  cg::grid_group grid = cg::this_grid();
  const int bid0 = blockIdx.x, nb0 = gridDim.x;
  GridBar gb;
#ifndef EMU
  if (threadIdx.x == 0) { volatile LAS unsigned* w = (volatile LAS unsigned*)(smem + SMEM_STAGE); w[0] = 0u; w[1] = 0u; w[2] = 0u; w[3] = 0u; }
  __syncthreads();
  gb.post((unsigned*)(p.ws + O_BAR), (volatile LAS unsigned*)(smem + SMEM_STAGE));
#endif
#ifndef PROBE_DUP
#define PROBE_DUP 0
#endif
#define STG(gi_, call) do { Params q = p; q.ws = opaque(q.ws); q.out = opaque(q.out); const int bid = opaque_i(bid0); const int nb = opaque_i(nb0); const Grp g = get_grp(opaque_i(gi_)); (void)g; call; } while (0)
#define STP(bit, gi_, call) do { STG(gi_, call); if (PROBE_DUP & (bit)) { STG(gi_, call); } } while (0)
  for (int l = 0; l < NL; ++l) {
    STP(1, 0, stage_prep(q, l, bid, nb, smem));
    if (l == 0) grid.sync();
    STP(2, 0, stage_h(q, g, l, bid, nb));
    gb.sync();
    for (int gi = 0; gi < NGRP; ++gi) {
      STP(4, gi, stage_g1(q, g, bid, nb, smem)); gb.sync();
      STP(8, gi, stage_e1(q, g, l, bid, nb)); gb.sync();
      STP(16, gi, stage_g2(q, g, l, bid, nb, smem)); gb.sync();
      STP(64, gi, stage_mixA(q, g, bid, nb, smem)); gb.sync();
      STP(32, gi, stage_scanS(q, g, l, bid, nb, smem));
      STP(128, gi, stage_dft2(q, g, bid, nb, smem)); gb.sync();
      STP(256, gi, stage_e3(q, g, l, bid, nb));
      STP(512, gi, stage_gates(q, g, l, bid, nb, smem)); gb.sync();
      STP(1024, gi, stage_g8(q, g, l, bid, nb, smem)); gb.sync();
      STG(gi, stage_g9(q, g, l, bid, nb, smem));
      if (gi + 1 < NGRP) { STP(2, gi + 1, stage_h(q, g, l, bid, nb)); }
      gb.sync();
    }
  }
  STG(0, stage_final(q, bid, nb));
#undef STP
#undef STG
}

extern "C" void kernel_launch(void* const* d_in, const int* in_sizes, int n_in, void* d_out, int out_size, void* d_ws, size_t ws_size,
                              hipStream_t stream) {
  Params p{};
  const float** pp = (const float**)&p;
  for (int i = 0; i < 35; ++i) pp[i] = (const float*)d_in[i];
  p.out = (float*)d_out; p.ws = (char*)d_ws;
#ifdef EMU
  emu::set_coop(true);
  emu_launch(dim3(8), dim3(NTHR), [=]() { mega_kernel(p); });
  emu::set_coop(false);
#else
  static int grid_blocks = 0;
  if (!grid_blocks) {
    int dev = 0, cus = 0, per_cu = 0;
    (void)hipGetDevice(&dev);
    (void)hipDeviceGetAttribute(&cus, hipDeviceAttributeMultiprocessorCount, dev);
    (void)hipOccupancyMaxActiveBlocksPerMultiprocessor(&per_cu, mega_kernel, NTHR, 0);
    if (per_cu > 1) per_cu = 1;
    if (per_cu < 1) per_cu = 1;
    grid_blocks = cus * per_cu;
  }
  (void)hipMemsetAsync((char*)d_ws + O_BAR, 0, BAR_BYTES, stream);
  void* args[] = {&p};
  (void)hipLaunchCooperativeKernel((void*)mega_kernel, dim3(grid_blocks), dim3(NTHR), args, 0, stream);
#endif
  (void)in_sizes; (void)n_in; (void)out_size; (void)ws_size;
}
```

```cpp
#ifdef EMU
#include "hip_emu.h"
#else
#include <hip/hip_runtime.h>
#include <hip/hip_cooperative_groups.h>
#endif
#include <stdint.h>

#ifndef CFG_BATCH
#define CFG_BATCH 32
#define CFG_SEQ 256
#define CFG_DEC_BATCH 2
#define CFG_DEC_SEQ 2048
#define CFG_PAST 512
#define CFG_NGRP_C 2
#endif
constexpr int D = 1024, NL = 2;
constexpr int NB_C = CFG_BATCH, T_C = CFG_SEQ, NB_D = CFG_DEC_BATCH, T_D = CFG_DEC_SEQ, PAST = CFG_PAST;
constexpr int M_C = NB_C * T_C, M_D = NB_D * T_D, M = M_C + M_D;
constexpr int NGRP_C = CFG_NGRP_C, NGRP = 1 + NGRP_C;
constexpr int MGC = M_C / NGRP_C, SEQ_PER_CG = NB_C / NGRP_C;
constexpr int MG = MGC > M_D ? MGC : M_D;
constexpr int MKV = MG + NB_D * PAST;
constexpr int KEYS_D = T_D + PAST;
constexpr int IN_W = 5728;
constexpr int ZC_R = 0, ZC_K = 512, ZC_V = 1024, ZC_WDF = 1536, ZC_GA = 1728, ZC_QD = 2240, ZC_KVD = 2496, ZC_KR = 2624,
              ZC_GB = 2656, ZC_U = 3168, ZC_VC = 3680, ZC_GC = 4192, ZC_F = 4704, ZC_GD = 5216;
constexpr int SHIFT_W = 1728;
static_assert(M_C % NGRP_C == 0 && NB_C % NGRP_C == 0, "ctx groups");
static_assert(T_C % 128 == 0 && T_D % 128 == 0 && PAST % 32 == 0, "seq multiples");

typedef unsigned short bf16_t;
typedef short s8v __attribute__((ext_vector_type(8)));
typedef float f4v __attribute__((ext_vector_type(4)));
typedef float f16v __attribute__((ext_vector_type(16)));
typedef unsigned u4v __attribute__((ext_vector_type(4)));
typedef unsigned u2v __attribute__((ext_vector_type(2)));

struct Params {
  const float *x_prompt, *x_sample, *st_f, *st_b, *c_ckv, *c_kr, *c, *c_ctx, *norm_g, *w_ada, *b_ada, *w_in, *shift_mu, *w0, *w_up,
      *a0, *a_up, *k_k, *k_a, *r_k, *ln_g, *ln_b, *q_norm, *w_q_up, *kv_norm, *w_kv_up, *g_ln_g, *g_ln_b, *g_w_s, *g_b_s, *w_branch,
      *w_merge, *b_merge, *w_out, *final_g;
  float* out;
  char* ws;
};

struct Grp { int isden, m0, mg, nseq, T, b0, nkeys, mkv; };
__host__ __device__ __forceinline__ Grp get_grp(int gi) {
  Grp g;
  if (gi == 0) { g.isden = 1; g.m0 = M_C; g.mg = M_D; g.nseq = NB_D; g.T = T_D; g.b0 = 0; g.nkeys = KEYS_D; g.mkv = M_D + NB_D * PAST; }
  else { g.isden = 0; g.m0 = (gi - 1) * MGC; g.mg = MGC; g.nseq = SEQ_PER_CG; g.T = T_C; g.b0 = (gi - 1) * SEQ_PER_CG; g.nkeys = T_C; g.mkv = MGC; }
  return g;
}

constexpr size_t al256(size_t x) { return (x + 255) & ~(size_t)255; }
constexpr size_t O_WINT = 0;
constexpr int IN_WP = ((IN_W + 255) / 256) * 256;
constexpr size_t O_WMT = O_WINT + al256((size_t)IN_WP * 1024 * 2);
constexpr size_t O_WBRT = O_WMT + al256((size_t)4096 * 1024 * 2);
constexpr size_t O_WOUTT = O_WBRT + al256((size_t)4 * 1024 * 512 * 2);
constexpr size_t O_WQT = O_WOUTT + al256((size_t)1024 * 1024 * 2);
constexpr size_t O_WKVT = O_WQT + al256((size_t)768 * 256 * 2);
constexpr size_t O_WUPT = O_WKVT + al256((size_t)1024 * 128 * 2);
constexpr size_t O_WS = O_WUPT + al256((size_t)4 * 512 * 64 * 2);
constexpr size_t O_CS128 = O_WS + al256((size_t)4 * 128 * 128 * 2);
constexpr size_t O_A2C = O_CS128 + al256((size_t)256 * 128 * 2);
constexpr size_t O_A2D = O_A2C + al256((size_t)T_C * 2 * T_C * 2);
constexpr size_t O_ROPE = O_A2D + al256((size_t)T_D * 2 * T_D * 2);
constexpr size_t O_MOD = O_ROPE + al256((size_t)T_D * 32 * 4);
constexpr size_t O_H = O_MOD + al256((size_t)NL * 3 * 3072 * 4);
constexpr size_t O_Z = O_H + al256((size_t)MG * 1024 * 2);
constexpr size_t O_SK = O_Z + al256((size_t)MG * IN_W * 2);
constexpr size_t O_SOP = O_SK + al256((size_t)MG * 512 * 2);
constexpr size_t O_YS = O_SOP + al256((size_t)MG * 8 * 576 * 2);
constexpr size_t O_BON = O_YS + al256((size_t)2 * MG * 512 * 4);
constexpr size_t O_LORA = O_BON + al256((size_t)MG * 16 * 4);
constexpr int CM_GT = 0, CM_BKT = 5120, CM_WL = 9216, CM_VT = 9472, CM_REC = 11520;
constexpr size_t CM_BYTES = (size_t)MG * CM_REC;
constexpr size_t O_CM = O_LORA + al256((size_t)MG * 192 * 2);
constexpr size_t O_PRE = O_CM + al256(CM_BYTES - (size_t)MG * 2048 * 2);
constexpr size_t O_QDN = O_PRE + al256((size_t)MG * 2048 * 2);
constexpr size_t O_CKV = O_QDN + al256((size_t)MG * 256 * 2);
constexpr size_t O_KR = O_CKV + al256((size_t)MKV * 128 * 2);
constexpr size_t O_Q = O_KR + al256((size_t)MKV * 32 * 2);
constexpr size_t O_KN = O_Q + al256((size_t)MG * 768 * 2);
constexpr size_t O_VT = O_KN + al256((size_t)MKV * 512 * 2);
constexpr size_t O_VCNT = O_VT + al256((size_t)MKV * 512 * 2);
constexpr size_t O_YT = O_VCNT + al256((size_t)MG * 512 * 2);
constexpr size_t O_OBR = O_YT + al256((size_t)MG * 1024 * 2);
constexpr size_t O_MERGED = O_OBR + al256((size_t)4 * MG * 512 * 2);
constexpr size_t O_END = O_MERGED + al256((size_t)MG * 1024 * 2);
constexpr size_t O_GATES = O_PRE;
static_assert(O_GATES + (size_t)MG * 4096 * 2 <= O_VCNT, "gates alias region too small");
static_assert(O_CM + CM_BYTES <= O_QDN, "chunk-matrix region must end before QDN");
constexpr size_t O_BAR = O_END;
constexpr size_t BAR_BYTES = 3456 * 4;
static_assert(O_BAR + BAR_BYTES <= ((size_t)256 << 20), "workspace must fit 256 MiB");

constexpr size_t OUT_SF = (size_t)M * D, OUT_SB = OUT_SF + (size_t)NB_C * NL * 8 * 64 * 64,
                 OUT_CKV = OUT_SB + (size_t)NB_C * NL * 8 * 64 * 64, OUT_KR = OUT_CKV + (size_t)NB_C * NL * T_C * 128;

#ifdef EMU
template <class T> __device__ __forceinline__ T* opaque(T* p) { return p; }
__device__ __forceinline__ int opaque_i(int v) { return v; }
#else
template <class T> __device__ __forceinline__ T* opaque(T* p) {
  typedef __attribute__((address_space(1))) T* gptr;
  gptr g = (gptr)p; asm volatile("" : "+s"(g)); return (T*)g;
}
__device__ __forceinline__ int opaque_i(int v) { asm volatile("" : "+s"(v)); return v; }
#endif
#ifdef EMU
#define SCHED_FENCE() do {} while (0)
#else
#define SCHED_FENCE() do { asm volatile("" ::: "memory"); __builtin_amdgcn_sched_barrier(0); } while (0)
#endif
__device__ __forceinline__ int my_tid() {
#ifdef EMU
  return (int)threadIdx.x;
#else
  int t = (int)threadIdx.x; asm volatile("" : "+v"(t)); return t;
#endif
}
__device__ __forceinline__ unsigned f_as_u(float f) { return __builtin_bit_cast(unsigned, f); }
__device__ __forceinline__ float u_as_f(unsigned u) { return __builtin_bit_cast(float, u); }
#ifdef EMU
__device__ __forceinline__ bf16_t f2bf(float f) { unsigned u = f_as_u(f); u += 0x7FFFu + ((u >> 16) & 1u); return (bf16_t)(u >> 16); }
__device__ __forceinline__ unsigned pk2bf(float lo, float hi) { return (unsigned)f2bf(lo) | ((unsigned)f2bf(hi) << 16); }
#else
typedef __bf16 bf2v_t __attribute__((ext_vector_type(2)));
typedef float f2c_t __attribute__((ext_vector_type(2)));
__device__ __forceinline__ bf16_t f2bf(float f) { return __builtin_bit_cast(unsigned short, (__bf16)f); }
__device__ __forceinline__ unsigned pk2bf(float lo, float hi) { return __builtin_bit_cast(unsigned, __builtin_convertvector(f2c_t{lo, hi}, bf2v_t)); }
#endif
__device__ __forceinline__ float bf2f(bf16_t h) { return u_as_f(((unsigned)h) << 16); }
__device__ __forceinline__ float bflo(unsigned u) { return u_as_f(u << 16); }
__device__ __forceinline__ float bfhi(unsigned u) { return u_as_f(u & 0xFFFF0000u); }
#ifdef EMU
__device__ __forceinline__ float fexp_(float x) { return expf(x); }
__device__ __forceinline__ float frcp_(float x) { return 1.f / x; }
#else
__device__ __forceinline__ float fexp_(float x) { return __builtin_amdgcn_exp2f(x * 1.4426950408889634f); }
__device__ __forceinline__ float frcp_(float x) { return __builtin_amdgcn_rcpf(x); }
#endif
#ifdef EMU
__device__ __forceinline__ float fexp2_(float x) { return exp2f(x); }
#else
__device__ __forceinline__ float fexp2_(float x) { return __builtin_amdgcn_exp2f(x); }
#endif
__device__ __forceinline__ float sigmoidf_(float x) { return frcp_(1.f + fexp_(-x)); }
__device__ __forceinline__ float siluf_(float x) { return x * frcp_(1.f + fexp_(-x)); }
__device__ __forceinline__ float tanhf_(float x) { return 1.f - 2.f * frcp_(1.f + fexp_(2.f * x)); }
__device__ __forceinline__ float geluf_(float x) { return 0.5f * x * (1.f + tanhf_(0.7978845608028654f * (x + 0.044715f * x * x * x))); }
#ifdef EMU
__device__ __forceinline__ float wave_sum(float v) {
#pragma unroll
  for (int o = 32; o >= 1; o >>= 1) v += __shfl_xor(v, o);
  return v;
}
#else
__device__ __forceinline__ float wave_sum(float v) {
  v += u_as_f(__builtin_amdgcn_update_dpp(0, (int)f_as_u(v), 0xB1, 0xF, 0xF, true));
  v += u_as_f(__builtin_amdgcn_update_dpp(0, (int)f_as_u(v), 0x4E, 0xF, 0xF, true));
  v += u_as_f(__builtin_amdgcn_update_dpp(0, (int)f_as_u(v), 0x141, 0xF, 0xF, true));
  v += u_as_f(__builtin_amdgcn_update_dpp(0, (int)f_as_u(v), 0x140, 0xF, 0xF, true));
  { auto r = __builtin_amdgcn_permlane16_swap(f_as_u(v), f_as_u(v), false, false); v = u_as_f(r[0]) + u_as_f(r[1]); }
  { auto r = __builtin_amdgcn_permlane32_swap(f_as_u(v), f_as_u(v), false, false); v = u_as_f(r[0]) + u_as_f(r[1]); }
  return v;
}
#endif

#ifdef EMU
#define WAVE_SYNC() emu::wave_barrier()
__device__ __forceinline__ float sum16(float v) { v += __shfl_xor(v, 1); v += __shfl_xor(v, 2); v += __shfl_xor(v, 4); v += __shfl_xor(v, 8); return v; }
#else
#define WAVE_SYNC() __builtin_amdgcn_wave_barrier()
__device__ __forceinline__ float sum16(float v) {
  v += u_as_f(__builtin_amdgcn_update_dpp(0, (int)f_as_u(v), 0xB1, 0xF, 0xF, true));
  v += u_as_f(__builtin_amdgcn_update_dpp(0, (int)f_as_u(v), 0x4E, 0xF, 0xF, true));
  v += u_as_f(__builtin_amdgcn_update_dpp(0, (int)f_as_u(v), 0x141, 0xF, 0xF, true));
  v += u_as_f(__builtin_amdgcn_update_dpp(0, (int)f_as_u(v), 0x140, 0xF, 0xF, true));
  return v;
}
#endif

template <int LPR> __device__ __forceinline__ float sum_lpr(float v) {
#ifdef EMU
  v += __shfl_xor(v, 1); v += __shfl_xor(v, 2); v += __shfl_xor(v, 4);
  if (LPR >= 16) v += __shfl_xor(v, 8);
  if (LPR >= 32) v += __shfl_xor(v, 16);
  return v;
#else
  v += u_as_f(__builtin_amdgcn_update_dpp(0, (int)f_as_u(v), 0xB1, 0xF, 0xF, true));
  v += u_as_f(__builtin_amdgcn_update_dpp(0, (int)f_as_u(v), 0x4E, 0xF, 0xF, true));
  v += u_as_f(__builtin_amdgcn_update_dpp(0, (int)f_as_u(v), 0x141, 0xF, 0xF, true));
  if (LPR >= 16) v += u_as_f(__builtin_amdgcn_update_dpp(0, (int)f_as_u(v), 0x140, 0xF, 0xF, true));
  if (LPR >= 32) { auto r = __builtin_amdgcn_permlane16_swap(f_as_u(v), f_as_u(v), false, false); v = u_as_f(r[0]) + u_as_f(r[1]); }
  return v;
#endif
}

template <int LPR> __device__ __forceinline__ void sum_lpr2(float& a, float& b) {
#ifdef EMU
  a = sum_lpr<LPR>(a); b = sum_lpr<LPR>(b);
#else
#define DPP_ADD2(ctrl) { float ta = u_as_f(__builtin_amdgcn_update_dpp(0, (int)f_as_u(a), ctrl, 0xF, 0xF, true)); float tb = u_as_f(__builtin_amdgcn_update_dpp(0, (int)f_as_u(b), ctrl, 0xF, 0xF, true)); a += ta; b += tb; }
  DPP_ADD2(0xB1) DPP_ADD2(0x4E) DPP_ADD2(0x141)
  if (LPR >= 16) DPP_ADD2(0x140)
  if (LPR >= 32) { auto ra = __builtin_amdgcn_permlane16_swap(f_as_u(a), f_as_u(a), false, false); auto rb = __builtin_amdgcn_permlane16_swap(f_as_u(b), f_as_u(b), false, false);
    a = u_as_f(ra[0]) + u_as_f(ra[1]); b = u_as_f(rb[0]) + u_as_f(rb[1]); }
#undef DPP_ADD2
#endif
}

constexpr int NTHR = 512, NWAVE = 8;
constexpr int LDS_STR = 72;
constexpr int SMEM_STAGE = 131072;
constexpr int SMEM_BYTES = SMEM_STAGE + 16;

template <int NJ>
__device__ __forceinline__ void zero_acc(f4v (&acc)[2][NJ]) {
#pragma unroll
  for (int i = 0; i < 2; ++i)
#pragma unroll
    for (int j = 0; j < NJ; ++j) acc[i][j] = f4v{0.f, 0.f, 0.f, 0.f};
}

struct GT { const bf16_t* A; long lda; int arow0, arows; const bf16_t* B; long ldb; int brow0, brows; int K; int bt; };
__device__ __forceinline__ GT mk_gt(const bf16_t* A, long lda, int arow0, int arows, const bf16_t* B, long ldb, int brow0, int brows, int K, int bt = 0) {
  GT t; t.A = A; t.lda = lda; t.arow0 = arow0; t.arows = arows; t.B = B; t.ldb = ldb; t.brow0 = brow0; t.brows = brows; t.K = K; t.bt = bt; return t;
}
template <int NJ>
__device__ __forceinline__ void gemm_ptrs(const GT& t, int tid, const bf16_t* (&ap)[2], const bf16_t* (&bp)[NJ / 2]) {
#pragma unroll
  for (int i = 0; i < 2; ++i) { int c = tid + NTHR * i, r = c >> 3, cc = c & 7; int ar = t.arow0 + r; ar = ar < t.arows ? ar : t.arows - 1; ap[i] = t.A + (long)ar * t.lda + cc * 8; }
#pragma unroll
  for (int i = 0; i < NJ / 2; ++i) { int c = tid + NTHR * i;
    if (t.bt) { int q = c >> 4, dc = c & 15; bp[i] = t.B + (long)q * t.ldb + t.brow0 + dc * 8; }
    else { int r = c >> 3, cc = c & 7; int br = t.brow0 + r; br = br < t.brows ? br : t.brows - 1; bp[i] = t.B + (long)br * t.ldb + cc * 8; } }
}
template <int NJ>
__device__ __forceinline__ void gemm_prefetch(const GT& t, u4v (&ra)[2], u4v (&rb)[NJ / 2]) {
  const bf16_t* ap[2]; const bf16_t* bp[NJ / 2];
  gemm_ptrs<NJ>(t, my_tid(), ap, bp);
#pragma unroll
  for (int i = 0; i < 2; ++i) ra[i] = *(const u4v*)(ap[i]);
#pragma unroll
  for (int i = 0; i < NJ / 2; ++i) rb[i] = *(const u4v*)(bp[i]);
}
template <int NJ, bool BT>
__device__ __forceinline__ void gemm_run(const GT& t, const GT* nxt, u4v (&ra)[2], u4v (&rb)[NJ / 2], char* smem, f4v (&acc)[2][NJ]) {
  constexpr int NBL = NJ / 2;
  constexpr int BUF = (128 + 128) * LDS_STR;
  bf16_t* s0 = (bf16_t*)smem;
  const int tid = my_tid(), lane = tid & 63, wid = tid >> 6, wm = wid >> 1, wn = wid & 1;
  const bf16_t* ap[2]; const bf16_t* bp[NBL];
  gemm_ptrs<NJ>(t, tid, ap, bp);
  const long ldb = t.ldb;
  __syncthreads();
#pragma unroll
  for (int i = 0; i < 2; ++i) { int c = tid + NTHR * i, r = c >> 3, cc = c & 7; *(u4v*)(s0 + r * LDS_STR + cc * 8) = ra[i]; }
#pragma unroll
  for (int i = 0; i < NBL; ++i) { int c = tid + NTHR * i;
    if (BT) { int q = c >> 4, dc = c & 15;
#pragma unroll
      for (int e = 0; e < 8; ++e) s0[(128 + dc * 8 + e) * LDS_STR + q] = (bf16_t)(rb[i][e >> 1] >> ((e & 1) * 16)); }
    else { int r = c >> 3, cc = c & 7; *(u4v*)(s0 + (128 + r) * LDS_STR + cc * 8) = rb[i]; } }
  __syncthreads();
  const int nk = t.K >> 6;
  for (int kt = 0; kt < nk; ++kt) {
    const bool more = kt + 1 < nk;
    if (more) {
#pragma unroll
      for (int i = 0; i < 2; ++i) ra[i] = *(const u4v*)(ap[i] + (kt + 1) * 64);
#pragma unroll
      for (int i = 0; i < NBL; ++i) rb[i] = *(const u4v*)(bp[i] + (BT ? (long)(kt + 1) * 64 * ldb : (long)(kt + 1) * 64));
    } else if (nxt) gemm_prefetch<NJ>(*nxt, ra, rb);
    const bf16_t* sA = s0 + (kt & 1) * BUF; const bf16_t* sB = sA + 128 * LDS_STR;
#pragma unroll
    for (int ks = 0; ks < 2; ++ks) {
      s8v af[2], bf[NJ];
#pragma unroll
      for (int i = 0; i < 2; ++i) af[i] = *(const s8v*)(sA + (wm * 32 + i * 16 + (lane & 15)) * LDS_STR + ks * 32 + (lane >> 4) * 8);
#pragma unroll
      for (int j = 0; j < NJ; ++j) bf[j] = *(const s8v*)(sB + (wn * NJ * 16 + j * 16 + (lane & 15)) * LDS_STR + ks * 32 + (lane >> 4) * 8);
#pragma unroll
      for (int i = 0; i < 2; ++i)
#pragma unroll
        for (int j = 0; j < NJ; ++j) acc[i][j] = __builtin_amdgcn_mfma_f32_16x16x32_bf16(bf[j], af[i], acc[i][j], 0, 0, 0);
    }
    if (more) {
      bf16_t* dA = s0 + ((kt + 1) & 1) * BUF;
#pragma unroll
      for (int i = 0; i < 2; ++i) { int c = tid + NTHR * i, r = c >> 3, cc = c & 7; *(u4v*)(dA + r * LDS_STR + cc * 8) = ra[i]; }
#pragma unroll
      for (int i = 0; i < NBL; ++i) { int c = tid + NTHR * i;
        if (BT) { int q = c >> 4, dc = c & 15;
#pragma unroll
          for (int e = 0; e < 8; ++e) dA[(128 + dc * 8 + e) * LDS_STR + q] = (bf16_t)(rb[i][e >> 1] >> ((e & 1) * 16)); }
        else { int r = c >> 3, cc = c & 7; *(u4v*)(dA + (128 + r) * LDS_STR + cc * 8) = rb[i]; } }
      __syncthreads();
    }
  }
}
template <int NJ>
__device__ __forceinline__ void gemm_deep(const GT& t, char* smem, f4v (&acc)[2][NJ]) {
  constexpr int NBL = NJ / 2;
  constexpr int BUF = (128 + 128) * LDS_STR;
  bf16_t* s0 = (bf16_t*)smem;
  const int tid = my_tid(), lane = tid & 63, wid = tid >> 6, wm = wid >> 1, wn = wid & 1;
  const bf16_t* ap[2]; const bf16_t* bp[NBL];
  gemm_ptrs<NJ>(t, tid, ap, bp);
  const int nk = t.K >> 6;
  u4v pa0[2], pb0[NBL], pa1[2], pb1[NBL];
#define GD_LOAD(PA, PB, kt_) do { const int kq = (kt_) < nk ? (kt_) : nk - 1; \
    _Pragma("unroll") for (int i = 0; i < 2; ++i) PA[i] = *(const u4v*)(ap[i] + kq * 64); \
    _Pragma("unroll") for (int i = 0; i < NBL; ++i) PB[i] = *(const u4v*)(bp[i] + kq * 64); } while (0)
#define GD_STORE(PA, PB, buf_) do { bf16_t* dA = s0 + (buf_) * BUF; \
    _Pragma("unroll") for (int i = 0; i < 2; ++i) { int c = tid + NTHR * i, r = c >> 3, cc = c & 7; *(u4v*)(dA + r * LDS_STR + cc * 8) = PA[i]; } \
    _Pragma("unroll") for (int i = 0; i < NBL; ++i) { int c = tid + NTHR * i, r = c >> 3, cc = c & 7; *(u4v*)(dA + (128 + r) * LDS_STR + cc * 8) = PB[i]; } } while (0)
#define GD_COMPUTE(buf_) do { const bf16_t* sA = s0 + (buf_) * BUF; const bf16_t* sB = sA + 128 * LDS_STR; \
    _Pragma("unroll") for (int ks = 0; ks < 2; ++ks) { s8v af[2], bf[NJ]; \
      _Pragma("unroll") for (int i = 0; i < 2; ++i) af[i] = *(const s8v*)(sA + (wm * 32 + i * 16 + (lane & 15)) * LDS_STR + ks * 32 + (lane >> 4) * 8); \
      _Pragma("unroll") for (int j = 0; j < NJ; ++j) bf[j] = *(const s8v*)(sB + (wn * NJ * 16 + j * 16 + (lane & 15)) * LDS_STR + ks * 32 + (lane >> 4) * 8); \
      _Pragma("unroll") for (int i = 0; i < 2; ++i) _Pragma("unroll") for (int j = 0; j < NJ; ++j) acc[i][j] = __builtin_amdgcn_mfma_f32_16x16x32_bf16(bf[j], af[i], acc[i][j], 0, 0, 0); } } while (0)
  GD_LOAD(pa0, pb0, 0); SCHED_FENCE();
  GD_LOAD(pa1, pb1, 1); SCHED_FENCE();
  __syncthreads();
  GD_STORE(pa0, pb0, 0);
  __syncthreads();
  for (int kt = 0; kt < nk; kt += 2) {
    GD_LOAD(pa0, pb0, kt + 2); SCHED_FENCE();
    GD_COMPUTE(0);
    if (kt + 1 < nk) { GD_STORE(pa1, pb1, 1); }
    __syncthreads();
    if (kt + 1 >= nk) break;
    GD_LOAD(pa1, pb1, kt + 3); SCHED_FENCE();
    GD_COMPUTE(1);
    if (kt + 2 < nk) { GD_STORE(pa0, pb0, 0); }
    __syncthreads();
  }
#undef GD_LOAD
#undef GD_STORE
#undef GD_COMPUTE
}

template <int NJ, bool BT = false>
__device__ __forceinline__ void gemm_mainloop(const bf16_t* __restrict__ A, long lda, int arow0, int arows, const bf16_t* __restrict__ B,
                                              long ldb, int brow0, int brows, int K, char* smem, f4v (&acc)[2][NJ]) {
  GT t = mk_gt(A, lda, arow0, arows, B, ldb, brow0, brows, K, BT ? 1 : 0);
  u4v ra[2], rb[NJ / 2];
  gemm_prefetch<NJ>(t, ra, rb);
  gemm_run<NJ, BT>(t, nullptr, ra, rb, smem, acc);
}

template <int NJ, class F>
__device__ __forceinline__ void epi_foreach(f4v (&acc)[2][NJ], int row0, int col0, F f) {
  const int tid = my_tid(), lane = tid & 63, wid = tid >> 6, wm = wid >> 1, wn = wid & 1;
#pragma unroll
  for (int i = 0; i < 2; ++i)
#pragma unroll
    for (int j = 0; j < NJ; ++j) f(row0 + wm * 32 + i * 16 + (lane & 15), col0 + wn * NJ * 16 + j * 16 + (lane >> 4) * 4, acc[i][j]);
}
__device__ __forceinline__ u4v pack8(const float (&x)[8]) {
  return u4v{pk2bf(x[0], x[1]), pk2bf(x[2], x[3]), pk2bf(x[4], x[5]), pk2bf(x[6], x[7])};
}
__device__ __forceinline__ void unpack8(u4v u, float (&x)[8]) {
  x[0] = bflo(u.x); x[1] = bfhi(u.x); x[2] = bflo(u.y); x[3] = bfhi(u.y); x[4] = bflo(u.z); x[5] = bfhi(u.z); x[6] = bflo(u.w); x[7] = bfhi(u.w);
}
__device__ __forceinline__ u2v pack4(float a, float b, float c, float d) {
  return u2v{pk2bf(a, b), pk2bf(c, d)};
}

#ifndef EMU
namespace pg8 {
#define PG8_LAS __attribute__((address_space(3)))
typedef unsigned short bf16_t;
typedef short bf16x8 __attribute__((ext_vector_type(8)));
typedef float f32x4 __attribute__((ext_vector_type(4)));
typedef unsigned u32x4 __attribute__((ext_vector_type(4)));
constexpr int BM = 256, BK = 64, HALF = 128, HTB = HALF * BK * 2  , STAGE_BYTES = 8 * HTB, NXCD = 8, WGM = 8;

__host__ __device__ __forceinline__ int lds_byte(int r, int c) { const int st = (r >> 4) * 2 + (c >> 5), rr = r & 15, cc = c & 31, ob = rr * 64 + cc * 2; return st * 1024 + (ob ^ (((ob >> 9) & 1) << 5)); }
__host__ __device__ __forceinline__ void stage_rc(int b, int& R, int& C) { const int st = b / 1024, sb = b % 1024, swz = sb ^ (((sb >> 9) & 1) << 5); R = (st >> 1) * 16 + swz / 64; C = (st & 1) * 32 + (swz % 64) / 2; }
__host__ __device__ __forceinline__ int perm32(int rho) { const int n = rho >> 4, i = rho & 15; return 8 * (i >> 2) + 4 * n + (i & 3); }

struct Unit { int pm, pn; };
struct Gemm { const bf16_t* A; const bf16_t* Bt; int M, N, K; };

struct StaticOrder {
    int nM, nN, nwg, G, c;
    __host__ __device__ void init(int M, int N, int G_, int c_) { nM = M / BM; nN = N / BM; nwg = nM * nN; G = G_; c = c_; }
    __host__ __device__ bool next(int i, Unit& u) const {
        const long L = (long)i * G + c; if (L >= nwg) return false;
        int wgid = (int)L; { const int q = nwg / NXCD, r = nwg % NXCD, xcd = wgid % NXCD, off = wgid / NXCD; wgid = (xcd < r ? xcd * (q + 1) : r * (q + 1) + (xcd - r) * q) + off; }
        const int nig = WGM * nN, gid = wgid / nig, fm = gid * WGM, gsz = (nM - fm) < WGM ? (nM - fm) : WGM;
        u.pm = fm + ((wgid % nig) % gsz); u.pn = (wgid % nig) / gsz; return true;
    }
    __device__ __forceinline__ void a_ready(const Unit&) const {}
    __device__ __forceinline__ void done(const Unit&) const {}
};
template <class Epi, class Sched>
__device__ __forceinline__ void gemm_phase(PG8_LAS unsigned char* lds, const Gemm g, const Sched& S, const Epi& E) {
    const int tid = my_tid(), wid = __builtin_amdgcn_readfirstlane(tid >> 6), lane = tid & 63, wr = wid >> 2, wc = wid & 3, fr = lane & 15, fq = lane >> 4;
    const int K = g.K, nt = K / BK;
    unsigned voffA[2], voffB[2];
#pragma unroll
    for (int i = 0; i < 2; ++i) { int R, C; stage_rc(tid * 16 + i * 8192, R, C); const int Rb = Epi::PERM ? ((R & ~31) + perm32(R & 31)) : R;
        voffA[i] = (unsigned)(R * K + C) * 2u; voffB[i] = (unsigned)(Rb * K + C) * 2u; }
    const size_t kstep = (size_t)(BK * 2);
    const size_t hstep = (size_t)HALF * K * 2;
    const size_t tstep = 2 * hstep;
    const unsigned ldsw = (unsigned)wid * 1024u;
    const int aoff = lds_byte(wr * 64 + fr, fq * 8), boff = lds_byte(wc * 32 + fr, fq * 8);
#define PG8_SA(b, h) (((b) * 2 + (h)) * HTB)
#define PG8_SB(b, h) ((4 + (b) * 2 + (h)) * HTB)
#define PG8_STAGE(bufoff, gbase, voff) do { _Pragma("unroll") for (int _i = 0; _i < 2; ++_i) \
        __builtin_amdgcn_global_load_lds((const unsigned*)((const char*)(gbase) + (voff)[_i]), (PG8_LAS unsigned*)(lds + (bufoff) + ldsw + _i * 8192), 16, 0, 0); } while (0)
#define PG8_LDA(dst, b, h) do { _Pragma("unroll") for (int m = 0; m < 4; ++m) _Pragma("unroll") for (int k = 0; k < 2; ++k) dst[m][k] = *(const PG8_LAS bf16x8*)(lds + PG8_SA(b, h) + aoff + m * 2048 + k * 1024); } while (0)
#define PG8_LDB(dst, b, h) do { _Pragma("unroll") for (int n = 0; n < 2; ++n) _Pragma("unroll") for (int k = 0; k < 2; ++k) dst[n][k] = *(const PG8_LAS bf16x8*)(lds + PG8_SB(b, h) + boff + n * 2048 + k * 1024); } while (0)
#define PG8_MMA(ai, bj, At, Bt) do { __builtin_amdgcn_s_setprio(1); _Pragma("unroll") for (int m = 0; m < 4; ++m) _Pragma("unroll") for (int n = 0; n < 2; ++n) _Pragma("unroll") for (int k = 0; k < 2; ++k) \
        acc[ai][bj][m][n] = __builtin_amdgcn_mfma_f32_16x16x32_bf16(Bt[n][k], At[m][k], acc[ai][bj][m][n], 0, 0, 0); __builtin_amdgcn_s_setprio(0); } while (0)
#define PG8_WAIT_V(n) asm volatile("s_waitcnt vmcnt(" #n ")" ::: "memory")
#define PG8_WAIT_L(n) asm volatile("s_waitcnt lgkmcnt(" #n ")" ::: "memory")
#define PG8_BAR __builtin_amdgcn_s_barrier()
#define PG8_SCHED __builtin_amdgcn_sched_barrier(0)
    Unit cur, nxt; int ui = 0;
    if (!S.next(0, cur)) return;
    f32x4 acc[2][2][4][2];
#pragma unroll
    for (int a = 0; a < 2; ++a)
#pragma unroll
        for (int b = 0; b < 2; ++b)
#pragma unroll
            for (int m = 0; m < 4; ++m)
#pragma unroll
                for (int n = 0; n < 2; ++n) acc[a][b][m][n] = (f32x4){0.f, 0.f, 0.f, 0.f};
    bf16x8 At[4][2], B0[2][2], B1[2][2];
    const char* cA = (const char*)g.A + (size_t)cur.pm * tstep; const char* cB = (const char*)g.Bt + (size_t)cur.pn * tstep;
    S.a_ready(cur);
    PG8_STAGE(PG8_SB(0, 0), cB, voffB); PG8_STAGE(PG8_SA(0, 0), cA, voffA); PG8_STAGE(PG8_SB(0, 1), cB + hstep, voffB); PG8_STAGE(PG8_SA(0, 1), cA + hstep, voffA);
    if (wr == 1) PG8_BAR;
    PG8_WAIT_V(4); PG8_BAR;
    PG8_STAGE(PG8_SB(1, 0), cB + kstep, voffB); PG8_STAGE(PG8_SA(1, 0), cA + kstep, voffA); PG8_STAGE(PG8_SB(1, 1), cB + hstep + kstep, voffB);
    PG8_WAIT_V(6); PG8_BAR;
    for (;;) {
        const bool has_next = S.next(ui + 1, nxt);
        const char* nA = has_next ? (const char*)g.A + (size_t)nxt.pm * tstep : cA; const char* nB = has_next ? (const char*)g.Bt + (size_t)nxt.pn * tstep : cB;
        for (int t = 0; t < nt; t += 2) {
            const bool last = (t == nt - 2);
            const char* a1 = cA + (size_t)(t + 1) * kstep;
            const char* a2 = last ? nA : cA + (size_t)(t + 2) * kstep; const char* b2 = last ? nB : cB + (size_t)(t + 2) * kstep;
            const char* a3 = a2 + kstep; const char* b3 = b2 + kstep;
            if (last && has_next) S.a_ready(nxt);
            PG8_LDB(B0, 0, 0); PG8_SCHED; PG8_LDA(At, 0, 0); PG8_STAGE(PG8_SA(1, 1), a1 + hstep, voffA);
            PG8_WAIT_L(8); PG8_BAR; PG8_WAIT_L(0); PG8_MMA(0, 0, At, B0); PG8_BAR; PG8_SCHED;
            PG8_LDB(B1, 0, 1); PG8_STAGE(PG8_SB(0, 0), b2, voffB);
            PG8_BAR; PG8_WAIT_L(0); PG8_MMA(0, 1, At, B1); PG8_BAR;
            PG8_LDA(At, 0, 1); PG8_STAGE(PG8_SA(0, 0), a2, voffA);
            PG8_BAR; PG8_WAIT_L(0); PG8_MMA(1, 0, At, B0); PG8_BAR; PG8_SCHED;
            PG8_STAGE(PG8_SB(0, 1), b2 + hstep, voffB);
            PG8_WAIT_V(6); PG8_BAR; PG8_MMA(1, 1, At, B1); PG8_BAR;
            PG8_LDB(B0, 1, 0); PG8_SCHED; PG8_LDA(At, 1, 0); PG8_STAGE(PG8_SA(0, 1), a2 + hstep, voffA);
            PG8_WAIT_L(8); PG8_BAR; PG8_WAIT_L(0); PG8_MMA(0, 0, At, B0); PG8_BAR; PG8_SCHED;
            PG8_LDB(B1, 1, 1); PG8_STAGE(PG8_SB(1, 0), b3, voffB);
            PG8_BAR; PG8_WAIT_L(0); PG8_MMA(0, 1, At, B1); PG8_BAR;
            PG8_LDA(At, 1, 1); PG8_STAGE(PG8_SA(1, 0), a3, voffA);
            PG8_BAR; PG8_WAIT_L(0); PG8_MMA(1, 0, At, B0); PG8_BAR; PG8_SCHED;
            PG8_STAGE(PG8_SB(1, 1), b3 + hstep, voffB);
            PG8_WAIT_V(6); PG8_BAR; PG8_MMA(1, 1, At, B1); PG8_BAR;
        }
            if constexpr (!Epi::AFTER_DRAIN) { E(acc, cur, wr, wc, fr, fq); S.done(cur); }
            if (!has_next) break;
#pragma unroll
        for (int a = 0; a < 2; ++a)
#pragma unroll
            for (int b = 0; b < 2; ++b)
#pragma unroll
                for (int m = 0; m < 4; ++m)
#pragma unroll
                    for (int n = 0; n < 2; ++n) acc[a][b][m][n] = (f32x4){0.f, 0.f, 0.f, 0.f};
        cur = nxt; cA = nA; cB = nB; ++ui;
    }
    PG8_WAIT_V(0);
    if (wr == 0) PG8_BAR;
    PG8_BAR;
    if constexpr (Epi::AFTER_DRAIN) { E.fused(acc, cur, wr, wc, fr, fq, lds, wid, lane); S.done(cur); }
#undef PG8_SA
#undef PG8_SB
#undef PG8_STAGE
#undef PG8_LDA
#undef PG8_LDB
#undef PG8_MMA
#undef PG8_WAIT_V
#undef PG8_WAIT_L
#undef PG8_BAR
#undef PG8_SCHED
}

__device__ __forceinline__ unsigned pk2(float lo, float hi) { return pk2bf(lo, hi); }
struct EpiStore {
  static constexpr bool PERM = true, AFTER_DRAIN = false;
  bf16_t* O; int ldc; int ncols;
  __device__ __forceinline__ void operator()(const f32x4 (&acc)[2][2][4][2], const Unit& u, int wr, int wc, int fr, int fq) const {
    const int row0 = u.pm * BM + wr * 64 + fr, col0 = u.pn * BM + wc * 32 + 8 * fq;
#pragma unroll
    for (int ai = 0; ai < 2; ++ai)
#pragma unroll
      for (int m = 0; m < 4; ++m) { bf16_t* rowp = O + (size_t)(row0 + ai * HALF + m * 16) * ldc + col0;
#pragma unroll
        for (int bj = 0; bj < 2; ++bj) if (col0 + bj * HALF < ncols) { const f32x4 v0 = acc[ai][bj][m][0], v1 = acc[ai][bj][m][1];
          *(u32x4*)(rowp + bj * HALF) = (u32x4){pk2(v0[0], v0[1]), pk2(v0[2], v0[3]), pk2(v1[0], v1[1]), pk2(v1[2], v1[3])}; } }
  }
};
struct EpiSigmoid {
  static constexpr bool PERM = true, AFTER_DRAIN = false;
  bf16_t* O; int ldc; const float* bias;
  __device__ __forceinline__ void operator()(const f32x4 (&acc)[2][2][4][2], const Unit& u, int wr, int wc, int fr, int fq) const {
    const int row0 = u.pm * BM + wr * 64 + fr, col0 = u.pn * BM + wc * 32 + 8 * fq;
    f32x4 bv[2][2];
#pragma unroll
    for (int bj = 0; bj < 2; ++bj)
#pragma unroll
      for (int n = 0; n < 2; ++n) bv[bj][n] = *(const f32x4*)(bias + col0 + bj * HALF + 4 * n);
#pragma unroll
    for (int ai = 0; ai < 2; ++ai)
#pragma unroll
      for (int m = 0; m < 4; ++m) { bf16_t* rowp = O + (size_t)(row0 + ai * HALF + m * 16) * ldc + col0;
#pragma unroll
        for (int bj = 0; bj < 2; ++bj) { const f32x4 v0 = acc[ai][bj][m][0] + bv[bj][0], v1 = acc[ai][bj][m][1] + bv[bj][1];
          *(u32x4*)(rowp + bj * HALF) = (u32x4){pk2(sigmoidf_(v0[0]), sigmoidf_(v0[1])), pk2(sigmoidf_(v0[2]), sigmoidf_(v0[3])), pk2(sigmoidf_(v1[0]), sigmoidf_(v1[1])), pk2(sigmoidf_(v1[2]), sigmoidf_(v1[3]))}; } }
  }
};
}
#endif

struct TJob { const float* src; int K, N; long lds; bf16_t* dst; long ldd; };
__device__ __forceinline__ TJob get_tjob(const Params& p, int l, int j) {
  TJob t; char* ws = p.ws;
  if (j == 0) { t.src = p.w_in + (size_t)l * 1024 * IN_W; t.K = 1024; t.N = IN_W; t.lds = IN_W; t.dst = (bf16_t*)(ws + O_WINT); t.ldd = 1024; }
  else if (j == 1) { t.src = p.w_merge + (size_t)l * 1024 * 4096; t.K = 1024; t.N = 4096; t.lds = 4096; t.dst = (bf16_t*)(ws + O_WMT); t.ldd = 1024; }
  else if (j < 6) { int n = j - 2; t.src = p.w_branch + ((size_t)l * 4 + n) * 512 * 1024; t.K = 512; t.N = 1024; t.lds = 1024; t.dst = (bf16_t*)(ws + O_WBRT) + (size_t)n * 1024 * 512; t.ldd = 512; }
  else if (j == 6) { t.src = p.w_out + (size_t)l * 1024 * 1024; t.K = 1024; t.N = 1024; t.lds = 1024; t.dst = (bf16_t*)(ws + O_WOUTT); t.ldd = 1024; }
  else if (j == 7) { t.src = p.w_q_up + (size_t)l * 256 * 768; t.K = 256; t.N = 768; t.lds = 768; t.dst = (bf16_t*)(ws + O_WQT); t.ldd = 256; }
  else if (j == 8) { t.src = p.w_kv_up + (size_t)l * 128 * 1024; t.K = 128; t.N = 1024; t.lds = 1024; t.dst = (bf16_t*)(ws + O_WKVT); t.ldd = 128; }
  else { int n = j - 9;
    t.src = (n < 2 ? p.w_up : p.a_up) + ((size_t)l * 2 + (n & 1)) * 64 * 512; t.K = 64; t.N = 512; t.lds = 512;
    t.dst = (bf16_t*)(ws + O_WUPT) + (size_t)n * 512 * 64; t.ldd = 64; }
  return t;
}
constexpr int NTJOBS = 13;

__device__ __forceinline__ void stage_prep(const Params& p, int l, int bid, int nb, char* smem) {
  const int tid = my_tid();
  char* ws = p.ws;
  {
    float* tile = (float*)smem;
    int base = 0;
    for (int j = 0; j < NTJOBS; ++j) {
      TJob t = get_tjob(p, l, j);
      int tk = t.K / 64, tn = t.N / 32, nt = tk * tn;
      int first = ((bid - base % nb) % nb + nb) % nb;
      for (int q = first; q < nt; q += nb) {
        int kt = q / tn, nt_ = q % tn;
        __syncthreads();
        { int r = tid >> 3, c4 = tid & 7; f4v x = *(const f4v*)(t.src + (long)(kt * 64 + r) * t.lds + nt_ * 32 + c4 * 4);
          tile[r * 33 + c4 * 4] = x[0]; tile[r * 33 + c4 * 4 + 1] = x[1]; tile[r * 33 + c4 * 4 + 2] = x[2]; tile[r * 33 + c4 * 4 + 3] = x[3]; }
        __syncthreads();
        if (tid < 256) { int n = tid >> 3, kc = tid & 7; float x[8];
#pragma unroll
          for (int e = 0; e < 8; ++e) x[e] = tile[(kc * 8 + e) * 33 + n];
          *(u4v*)(t.dst + (long)(nt_ * 32 + n) * t.ldd + kt * 64 + kc * 8) = pack8(x); }
      }
      base += nt;
    }
    __syncthreads();
  }
  const long gtid = (long)bid * NTHR + tid, gn = (long)nb * NTHR;
  { bf16_t* d = (bf16_t*)(ws + O_WINT) + (size_t)IN_W * 1024; for (long i = gtid; i < (long)(IN_WP - IN_W) * 1024; i += gn) d[i] = 0; }
  { bf16_t* d = (bf16_t*)(ws + O_WS); const float* s = p.g_w_s + (size_t)l * 4 * 128 * 128; for (long i = gtid; i < (long)4 * 128 * 128; i += gn) d[i] = f2bf(s[i]); }
  if (l != 0) return;
  { bf16_t* d = (bf16_t*)(ws + O_CS128);
    for (long i = gtid; i < 256 * 128; i += gn) { int j = (int)(i >> 7), c = (int)(i & 127); int mm = ((j & 127) * c) & 127; float x = 2.0f * mm / 128.f; d[i] = f2bf(j < 128 ? cospif(x) : sinpif(x)); } }
  { bf16_t* d = (bf16_t*)(ws + O_A2C);
    for (long i = gtid; i < (long)T_C * 2 * T_C; i += gn) { int tp = (int)(i / (2 * T_C)), tt = (int)(i % (2 * T_C)); int half = tt >= T_C; int t = half ? tt - T_C : tt; int mm = (int)(((long)tp * t) % T_C); float x = 2.0f * mm / (float)T_C; d[i] = f2bf(half ? -sinpif(x) : cospif(x)); } }
  { bf16_t* d = (bf16_t*)(ws + O_A2D);
    for (long i = gtid; i < (long)T_D * 2 * T_D; i += gn) { int tp = (int)(i / (2 * T_D)), tt = (int)(i % (2 * T_D)); int half = tt >= T_D; int t = half ? tt - T_D : tt; int mm = (int)(((long)tp * t) % T_D); float x = 2.0f * mm / (float)T_D; d[i] = f2bf(half ? -sinpif(x) : cospif(x)); } }
  { float* d = (float*)(ws + O_ROPE);
    for (long i = gtid; i < (long)T_D * 16; i += gn) { int t = (int)(i >> 4), pi = (int)(i & 15); float pos = (pi < 8) ? (float)(t / 64) : (float)(t % 64); float inv = expf(-(float)(pi & 7) * (9.210340371976184f / 8.f)); float a = pos * inv; d[2 * i] = cosf(a); d[2 * i + 1] = sinf(a); } }
  { float4* d = (float4*)p.out; const float4* s0 = (const float4*)p.x_prompt; const float4* s1 = (const float4*)p.x_sample;
    for (long i = gtid; i < (long)M * 256; i += gn) d[i] = (i < (long)M_C * 256) ? s0[i] : s1[i - (long)M_C * 256]; }
  {
    float* red = (float*)smem;
    float* modp = (float*)(ws + O_MOD);
    for (int u = bid; u < NL * 48; u += nb) {
      int ll = u / 48, cg = u % 48; int col = cg * 64 + (tid & 63), kq = tid >> 6;
      float a0 = 0.f, a1 = 0.f, a2 = 0.f;
      const float* w = p.w_ada + (size_t)ll * 1024 * 3072 + col;
      for (int k = kq * 128; k < kq * 128 + 128; ++k) {
        float wv = w[(size_t)k * 3072];
        a0 += siluf_(p.c_ctx[k]) * wv; a1 += siluf_(p.c[k]) * wv; a2 += siluf_(p.c[(NB_D > 1 ? 1024 : 0) + k]) * wv;
      }
      __syncthreads();
      red[(kq * 3 + 0) * 64 + (tid & 63)] = a0; red[(kq * 3 + 1) * 64 + (tid & 63)] = a1; red[(kq * 3 + 2) * 64 + (tid & 63)] = a2;
      __syncthreads();
      if (tid < 192) { int mi = tid >> 6, cc = tid & 63; float s = 0.f;
#pragma unroll
        for (int q8 = 0; q8 < 8; ++q8) s += red[(q8 * 3 + mi) * 64 + cc];
        modp[((size_t)ll * 3 + mi) * 3072 + cg * 64 + cc] = s + p.b_ada[(size_t)ll * 3072 + cg * 64 + cc]; }
    }
  }
}

__device__ __forceinline__ int mod_index(const Grp& g, int lm) { return g.isden ? 1 + lm / T_D : 0; }

__device__ __forceinline__ void stage_h(const Params& p, const Grp& g, int l, int bid, int nb) {
  const int lane = my_tid() & 63, wid = my_tid() >> 6;
  const float* X = p.out + (size_t)g.m0 * 1024;
  bf16_t* H = (bf16_t*)(p.ws + O_H);
  const float* modp = (const float*)(p.ws + O_MOD) + (size_t)l * 3 * 3072;
  const float* gam = p.norm_g + (size_t)l * 1024;
  for (int m = bid * NWAVE + wid; m < g.mg; m += nb * NWAVE) {
    const float* xr = X + (size_t)m * 1024; float v[16]; float ss = 0.f;
#pragma unroll
    for (int i = 0; i < 4; ++i) { float4 q = *(const float4*)(xr + i * 256 + lane * 4); v[4 * i] = q.x; v[4 * i + 1] = q.y; v[4 * i + 2] = q.z; v[4 * i + 3] = q.w; ss += q.x * q.x + q.y * q.y + q.z * q.z + q.w * q.w; }
    ss = wave_sum(ss); float rs = rsqrtf(ss * (1.f / 1024.f) + 1e-6f);
    const float* mo = modp + (size_t)mod_index(g, m) * 3072;
#pragma unroll
    for (int i = 0; i < 4; ++i) {
      int c = i * 256 + lane * 4; bf16_t o[4];
#pragma unroll
      for (int e = 0; e < 4; ++e) o[e] = f2bf(v[4 * i + e] * rs * gam[c + e] * (1.f + mo[1024 + c + e]) + mo[c + e]);
      *(u2v*)(H + (size_t)m * 1024 + c) = u2v{(unsigned)o[0] | ((unsigned)o[1] << 16), (unsigned)o[2] | ((unsigned)o[3] << 16)};
    }
  }
}

__device__ __forceinline__ void stage_g1(const Params& p, const Grp& g, int bid, int nb, char* smem) {
  const bf16_t* H = (const bf16_t*)(p.ws + O_H);
  const bf16_t* W = (const bf16_t*)(p.ws + O_WINT);
  bf16_t* Z = (bf16_t*)(p.ws + O_Z);
#ifndef EMU
  if ((g.mg & 255) == 0) {
    pg8::Gemm gm; gm.A = H; gm.Bt = W; gm.M = g.mg; gm.N = IN_WP; gm.K = 1024;
    pg8::StaticOrder S; S.init(gm.M, gm.N, nb, bid);
    pg8::EpiStore E; E.O = Z; E.ldc = IN_W; E.ncols = IN_W;
    pg8::gemm_phase<pg8::EpiStore, pg8::StaticOrder>((PG8_LAS unsigned char*)smem, gm, S, E);
    return;
  }
#endif
  const int TM = (g.mg + 127) / 128; constexpr int TN = (IN_W + 127) / 128;
  const int mg = g.mg;
  for (int t = bid; t < TM * TN; t += nb) {
    int tn = t / TM, tm = t % TM; f4v acc[2][4]; zero_acc<4>(acc);
    gemm_mainloop<4>(H, 1024, tm * 128, mg, W, 1024, tn * 128, IN_W, 1024, smem, acc);
    epi_foreach<4>(acc, tm * 128, tn * 128, [&](int row, int c0, f4v& v) {
      if (c0 < IN_W && row < mg) *(u2v*)(Z + (size_t)row * IN_W + c0) = pack4(v[0], v[1], v[2], v[3]);
    });
  }
}

__device__ __forceinline__ void stage_e1(const Params& p, const Grp& g, int l, int bid, int nb) {
  const int lane = my_tid() & 63, wid = my_tid() >> 6;
  char* ws = p.ws;
  const bf16_t* Z = (const bf16_t*)(ws + O_Z);
  bf16_t* SK = (bf16_t*)(ws + O_SK); bf16_t* SOP = (bf16_t*)(ws + O_SOP);
  bf16_t* LORA = (bf16_t*)(ws + O_LORA); bf16_t* QDN = (bf16_t*)(ws + O_QDN); bf16_t* CKV = (bf16_t*)(ws + O_CKV); bf16_t* KR = (bf16_t*)(ws + O_KR);
  bf16_t* VCN = (bf16_t*)(ws + O_VCNT);
  const float* rope = (const float*)(ws + O_ROPE);
  const float* mu = p.shift_mu + (size_t)l * SHIFT_W;
  const int isden = g.isden, T = g.T;
  for (int m = bid * NWAVE + wid; m < g.mkv; m += nb * NWAVE) {
    if (m >= g.mg) {
      int r = m - g.mg, b = r / PAST, j = r % PAST;
      if (lane < 20) {
        const float* s = lane < 16 ? p.c_ckv + (((size_t)b * NL + l) * PAST + j) * 128 + lane * 8 : p.c_kr + (((size_t)b * NL + l) * PAST + j) * 32 + (lane - 16) * 8;
        f4v x0 = *(const f4v*)s, x1 = *(const f4v*)(s + 4); float x[8] = {x0[0], x0[1], x0[2], x0[3], x1[0], x1[1], x1[2], x1[3]};
        if (lane < 16) *(u4v*)(CKV + (size_t)m * 128 + lane * 8) = pack8(x);
        else { const int key = T + j, d8 = lane - 16;
          *(u4v*)(KR + ((((size_t)b * (g.nkeys >> 5) + (key >> 5)) * 2 + (d8 >> 1)) * 64 + (d8 & 1) * 32 + (key & 31)) * 8) = pack8(x); }
      }
      continue;
    }
    const int sq = m / T, t = m % T, b = g.b0 + sq;
    const bf16_t* z = Z + (size_t)m * IN_W;
    const bool hp = t > 0, hn = t < T - 1;
#pragma unroll
    for (int it = 0; it < 4; ++it) {
      const int ci = it * 64 + lane; const bool valid = ci < 216; const int cc = valid ? ci : 0;
      float zc[8], pv[8], nv[8], sf[8];
      unpack8(*(const u4v*)(z + cc * 8), zc);
      if (hp) unpack8(*(const u4v*)(z - IN_W + cc * 8), pv); else { for (int e = 0; e < 8; ++e) pv[e] = 0.f; }
      if (hn) unpack8(*(const u4v*)(z + IN_W + cc * 8), nv); else { for (int e = 0; e < 8; ++e) nv[e] = 0.f; }
      f4v m0 = *(const f4v*)(mu + cc * 8), m1 = *(const f4v*)(mu + cc * 8 + 4);
#pragma unroll
      for (int e = 0; e < 8; ++e) sf[e] = zc[e] + (0.5f * (pv[e] + nv[e]) - zc[e]) * (e < 4 ? m0[e] : m1[e - 4]);
      bf16_t* rec = SOP + (((size_t)sq * 8 + (lane >> 3)) * T + t) * 576 + (lane & 7) * 8;
      if (it == 0) *(u4v*)rec = pack8(sf);
      else if (it == 1) {
        *(u4v*)(SK + (size_t)m * 512 + lane * 8) = pack8(sf);
        f4v k0 = *(const f4v*)(p.k_k + (size_t)l * 512 + lane * 8), k1 = *(const f4v*)(p.k_k + (size_t)l * 512 + lane * 8 + 4);
        float kr[8]; float n2 = 0.f;
#pragma unroll
        for (int e = 0; e < 8; ++e) { kr[e] = sf[e] * (e < 4 ? k0[e] : k1[e - 4]); n2 += kr[e] * kr[e]; }
        n2 = sum_lpr<8>(n2); const float inv = 1.f / fmaxf(sqrtf(n2), 1e-12f);
#pragma unroll
        for (int e = 0; e < 8; ++e) kr[e] *= inv;
        *(u4v*)(rec + 64) = pack8(kr);
      }
      else if (it == 2) *(u4v*)(rec + 128) = pack8(sf);
      else if (valid) {
        if (lane < 16) { for (int e = 0; e < 8; ++e) sf[e] = tanhf_(sf[e]); }
        *(u4v*)(LORA + (size_t)m * 192 + lane * 8) = pack8(sf);
      }
    }
    {
      const int col = lane < 32 ? ZC_QD + lane * 8 : (lane < 48 ? ZC_KVD + (lane - 32) * 8 : ZC_KR + ((lane - 48) & 3) * 8);
      float x[8]; unpack8(*(const u4v*)(z + col), x);
      float ss = 0.f;
#pragma unroll
      for (int e = 0; e < 8; ++e) ss += x[e] * x[e];
      const float t32 = sum_lpr<32>(ss), t16 = sum_lpr<16>(ss);
      if (lane < 32) {
        const float rs = rsqrtf(t32 * (1.f / 256.f) + 1e-6f); const float* gq = p.q_norm + (size_t)l * 256 + lane * 8; float o[8];
#pragma unroll
        for (int e = 0; e < 8; ++e) o[e] = x[e] * rs * gq[e];
        *(u4v*)(QDN + (size_t)m * 256 + lane * 8) = pack8(o);
      } else if (lane < 48) {
        const float rs = rsqrtf(t16 * (1.f / 128.f) + 1e-6f); const float* gk = p.kv_norm + (size_t)l * 128 + (lane - 32) * 8; float o[8];
#pragma unroll
        for (int e = 0; e < 8; ++e) o[e] = x[e] * rs * gk[e];
        *(u4v*)(CKV + (size_t)m * 128 + (lane - 32) * 8) = pack8(o);
        if (!isden) { float* op = p.out + OUT_CKV + (((size_t)b * NL + l) * T_C + t) * 128 + (lane - 32) * 8; *(f4v*)op = f4v{o[0], o[1], o[2], o[3]}; *(f4v*)(op + 4) = f4v{o[4], o[5], o[6], o[7]}; }
      } else if (lane < 52) {
        float o[8];
        if (isden) {
#pragma unroll
          for (int pq = 0; pq < 4; ++pq) { int pi = (lane - 48) * 4 + pq; float cs = rope[((size_t)t * 16 + pi) * 2], sn = rope[((size_t)t * 16 + pi) * 2 + 1];
            o[2 * pq] = x[2 * pq] * cs - x[2 * pq + 1] * sn; o[2 * pq + 1] = x[2 * pq] * sn + x[2 * pq + 1] * cs; }
        } else {
#pragma unroll
          for (int e = 0; e < 8; ++e) o[e] = x[e];
          float* op = p.out + OUT_KR + (((size_t)b * NL + l) * T_C + t) * 32 + (lane - 48) * 8; *(f4v*)op = f4v{x[0], x[1], x[2], x[3]}; *(f4v*)(op + 4) = f4v{x[4], x[5], x[6], x[7]};
        }
        { const int d8 = lane - 48; *(u4v*)(KR + ((((size_t)sq * (g.nkeys >> 5) + (t >> 5)) * 2 + (d8 >> 1)) * 64 + (d8 & 1) * 32 + (t & 31)) * 8) = pack8(o); }
      }
    }
    {
      float v[8]; unpack8(*(const u4v*)(z + ZC_VC + lane * 8), v);
      float s1 = 0.f;
#pragma unroll
      for (int e = 0; e < 8; ++e) { v[e] = geluf_(v[e]); s1 += v[e]; }
      s1 = wave_sum(s1); const float mean = s1 * (1.f / 512.f); float s2 = 0.f;
#pragma unroll
      for (int e = 0; e < 8; ++e) { float d = v[e] - mean; s2 += d * d; }
      s2 = wave_sum(s2); const float rs = rsqrtf(s2 * (1.f / 512.f) + 1e-5f);
      const float* gg = p.g_ln_g + (size_t)l * 512 + lane * 8; const float* gb = p.g_ln_b + (size_t)l * 512 + lane * 8;
#pragma unroll
      for (int e = 0; e < 8; ++e) v[e] = (v[e] - mean) * rs * gg[e] + gb[e];
      *(u4v*)(VCN + (size_t)m * 512 + lane * 8) = pack8(v);
    }
  }
}

__device__ __forceinline__ void stage_g2(const Params& p, const Grp& g, int l, int bid, int nb, char* smem) {
  char* ws = p.ws;
  const bf16_t* Z = (const bf16_t*)(ws + O_Z);
  const float* rope = (const float*)(ws + O_ROPE);
  const int mg = g.mg, mkv = g.mkv, T = g.T, isden = g.isden, nkeys = g.nkeys;
  const int TM_M = (mg + 127) / 128, TM_KV = (mkv + 127) / 128;
  const int NT_Q = TM_M * 6, NT_KV = TM_KV * 8, NT_LORA = TM_M * 8, NT_GM = (mg / 128) * 4, ntt = T / 128, NT_D1 = g.nseq * 8 * ntt;
  const int NT = NT_Q + NT_KV + NT_LORA + NT_GM + NT_D1;
  for (int t0 = bid; t0 < NT; t0 += nb) {
    int t = t0; f4v acc[2][4]; zero_acc<4>(acc);
    if (t < NT_Q) {
      int tn = t / TM_M, tm = t % TM_M;
      gemm_mainloop<4>((const bf16_t*)(ws + O_QDN), 256, tm * 128, mg, (const bf16_t*)(ws + O_WQT), 256, tn * 128, 768, 256, smem, acc);
      bf16_t* Q = (bf16_t*)(ws + O_Q);
      const float scale = 0.10206207261596575f * 1.4426950408889634f;
      epi_foreach<4>(acc, tm * 128, tn * 128, [&](int row, int c0, f4v& v) {
        if (row >= mg) return;
        int cw = c0 % 96; float o0 = v[0], o1 = v[1], o2 = v[2], o3 = v[3];
        if (cw >= 64 && isden) { int tt = row % T_D; int pi = (cw - 64) >> 1; const float* rp = rope + ((size_t)tt * 16 + pi) * 2;
          float c_a = rp[0], s_a = rp[1], c_b = rp[2], s_b = rp[3];
          o0 = v[0] * c_a - v[1] * s_a; o1 = v[0] * s_a + v[1] * c_a; o2 = v[2] * c_b - v[3] * s_b; o3 = v[2] * s_b + v[3] * c_b; }
        *(u2v*)(Q + (size_t)row * 768 + c0) = pack4(o0 * scale, o1 * scale, o2 * scale, o3 * scale);
      });
      continue;
    }
    t -= NT_Q;
    if (t < NT_KV) {
      int tn = t / TM_KV, tm = t % TM_KV;
      gemm_mainloop<4>((const bf16_t*)(ws + O_CKV), 128, tm * 128, mkv, (const bf16_t*)(ws + O_WKVT), 128, tn * 128, 1024, 128, smem, acc);
      bf16_t* KN = (bf16_t*)(ws + O_KN); bf16_t* VT = (bf16_t*)(ws + O_VT);
      epi_foreach<4>(acc, tm * 128, tn * 128, [&](int row, int c0, f4v& v) {
        if (row >= mkv) return;
        int h = c0 >> 7, w = c0 & 127;
        int sq, key;
        if (row < mg) { sq = row / T; key = row % T; } else { int r = row - mg; sq = r / PAST; key = T + r % PAST; }
        const int ntile = nkeys >> 5, tile = key >> 5, kq = key & 31;
        if (w < 64)
          *(u2v*)(KN + (((((size_t)sq * 8 + h) * ntile + tile) * 4 + (w >> 4)) * 64 + ((w >> 3) & 1) * 32 + kq) * 8 + (w & 7)) = pack4(v[0], v[1], v[2], v[3]);
        else {
          const int o16 = kq & 15, st = kq >> 4, hh2 = (o16 & 7) >> 2, jj = ((o16 >> 3) << 2) | (o16 & 3);
#pragma unroll
          for (int e = 0; e < 4; ++e) { const int dv = w - 64 + e;
            VT[((((((size_t)sq * 8 + h) * ntile + tile) * 2 + st) * 2 + (dv >> 5)) * 64 + hh2 * 32 + (dv & 31)) * 8 + jj] = f2bf(v[e]); } }
      });
      continue;
    }
    t -= NT_KV;
    if (t < NT_LORA) {
      int dir = t / (TM_M * 4), r = t % (TM_M * 4), tn = r / TM_M, tm = r % TM_M;
      gemm_mainloop<4>((const bf16_t*)(ws + O_LORA) + dir * 64, 192, tm * 128, mg, (const bf16_t*)(ws + O_WUPT) + (size_t)dir * 512 * 64, 64, tn * 128, 512, 64, smem, acc);
      f4v aa[2][4]; zero_acc<4>(aa);
      gemm_mainloop<4>((const bf16_t*)(ws + O_LORA) + 128, 192, tm * 128, mg, (const bf16_t*)(ws + O_WUPT) + (size_t)(2 + dir) * 512 * 64, 64, tn * 128, 512, 64, smem, aa);
      const float* w0 = p.w0 + ((size_t)l * 2 + dir) * 512; const float* a0 = p.a0 + ((size_t)l * 2 + dir) * 512;
      const float* k_a = p.k_a + (size_t)l * 512; const float* r_k = p.r_k + (size_t)l * 512;
      const bf16_t* SK = (const bf16_t*)(ws + O_SK); bf16_t* SOP = (bf16_t*)(ws + O_SOP); float* BON = (float*)(ws + O_BON);
      const int lane = my_tid() & 63, wid = my_tid() >> 6, wm = wid >> 1, wn = wid & 1;
      const int h = tn * 2 + wn;
#pragma unroll
      for (int i = 0; i < 2; ++i) {
        int row = tm * 128 + wm * 32 + i * 16 + (lane & 15); const bool ok = row < mg; if (!ok) row = mg - 1;
        const int sq = row / T, tt = row % T;
        bf16_t* rec = SOP + (((size_t)sq * 8 + h) * T + tt) * 576;
        float bon = 0.f;
#pragma unroll
        for (int j = 0; j < 4; ++j) {
          const int chn = j * 16 + (lane >> 4) * 4, c = h * 64 + chn;
          u2v k2 = *(const u2v*)(SK + (size_t)row * 512 + c), kk2 = *(const u2v*)(rec + 64 + chn), r2 = *(const u2v*)(rec + chn);
          float kv[4] = {bflo(k2.x), bfhi(k2.x), bflo(k2.y), bfhi(k2.y)}, kkv[4] = {bflo(kk2.x), bfhi(kk2.x), bflo(kk2.y), bfhi(kk2.y)}, rv[4] = {bflo(r2.x), bfhi(r2.x), bflo(r2.y), bfhi(r2.y)};
          float dd[4], bb[4], kt[4];
#pragma unroll
          for (int e = 0; e < 4; ++e) {
            float pw = acc[i][j][e] + w0[c + e], pa = aa[i][j][e] + a0[c + e];
            dd[e] = 1.f - fexp_(-0.6065306597126334f * sigmoidf_(pw));
            float av = sigmoidf_(pa);
            bb[e] = kkv[e] * av; kt[e] = kv[e] * (1.f + (av - 1.f) * k_a[c + e]);
            bon += rv[e] * kt[e] * r_k[c + e];
          }
          if (ok) { *(u2v*)(rec + (3 + 3 * dir) * 64 + chn) = pack4(dd[0], dd[1], dd[2], dd[3]); *(u2v*)(rec + (4 + 3 * dir) * 64 + chn) = pack4(bb[0], bb[1], bb[2], bb[3]);
            *(u2v*)(rec + (5 + 3 * dir) * 64 + chn) = pack4(kt[0], kt[1], kt[2], kt[3]); }
        }
        bon += __shfl_xor(bon, 16); bon += __shfl_xor(bon, 32);
        if (ok && lane < 16) BON[((size_t)row * 8 + h) * 2 + dir] = bon;
      }
      continue;
    }
    t -= NT_LORA;
    if (t < NT_GM) {
      int ch = t >> 2, gg = t & 3;
      gemm_mainloop<4, true>((const bf16_t*)(ws + O_WS) + (size_t)gg * 128 * 128, 128, 0, 128, (const bf16_t*)(ws + O_VCNT) + (size_t)ch * 128 * 512, 512, gg * 128, 512, 128, smem, acc);
      bf16_t* O = (bf16_t*)(ws + O_OBR) + (size_t)2 * MG * 512;
      const float* bs = p.g_b_s + ((size_t)l * 4 + gg) * 128;
      epi_foreach<4>(acc, 0, 0, [&](int pp, int c0, f4v& v) {
        int m = ch * 128 + pp; int c = gg * 128 + c0; float bb = bs[pp];
        u2v uu = *(const u2v*)(Z + (size_t)m * IN_W + ZC_U + c), gc = *(const u2v*)(Z + (size_t)m * IN_W + ZC_GC + c);
        *(u2v*)(O + (size_t)m * 512 + c) = pack4(geluf_(bflo(uu.x)) * (v[0] + bb) * siluf_(bflo(gc.x)), geluf_(bfhi(uu.x)) * (v[1] + bb) * siluf_(bfhi(gc.x)),
                                                 geluf_(bflo(uu.y)) * (v[2] + bb) * siluf_(bflo(gc.y)), geluf_(bfhi(uu.y)) * (v[3] + bb) * siluf_(bfhi(gc.y)));
      });
      continue;
    }
    t -= NT_GM;
    {
      int per_seq = 8 * ntt; int sq = t / per_seq; int r = t % per_seq; int gg = r / (2 * ntt); int r2 = r % (2 * ntt); int tj = r2 / ntt, tt = r2 % ntt;
      long mbase = (long)sq * T;
      gemm_mainloop<4>((const bf16_t*)(ws + O_CS128), 128, tj * 128, 256, Z + (size_t)mbase * IN_W + ZC_F + gg * 128, IN_W, tt * 128, T, 128, smem, acc);
      bf16_t* YT = (bf16_t*)(ws + O_YT) + (size_t)mbase * 1024 + (size_t)gg * 128 * 2 * T;
      epi_foreach<4>(acc, tj * 128, tt * 128, [&](int j, int c0, f4v& v) {
        *(u2v*)(YT + (size_t)(j & 127) * 2 * T + (size_t)(j >> 7) * T + c0) = pack4(v[0], v[1], v[2], v[3]);
      });
    }
  }
}

__device__ __forceinline__ bool wave_any(bool pr) {
#ifdef EMU
  return wave_sum(pr ? 1.f : 0.f) > 0.f;
#else
  return __builtin_amdgcn_ballot_w64(pr) != 0ull;
#endif
}
__device__ __forceinline__ void attention_task(const Params& p, const Grp& g, int sq, int h, int qb32) {
  char* ws = p.ws;
  const int lane = my_tid() & 63, ql = lane & 31, hh = lane >> 5;
  const int T = g.T, nkeys = g.nkeys;
  const long mbase = (long)sq * T;
  const bf16_t* Q = (const bf16_t*)(ws + O_Q); const bf16_t* KN = (const bf16_t*)(ws + O_KN); const bf16_t* KRp = (const bf16_t*)(ws + O_KR);
  const int ntile = nkeys >> 5;
  const bf16_t* KFb = KN + ((size_t)sq * 8 + h) * ntile * 4 * 512 + lane * 8;
  const bf16_t* KRb = KRp + (size_t)sq * ntile * 2 * 512 + lane * 8;
  const bf16_t* VFb = (const bf16_t*)(ws + O_VT) + ((size_t)sq * 8 + h) * ntile * 4 * 512 + lane * 8;
  const long mq = mbase + qb32 * 32 + ql;
  s8v qf[6];
#pragma unroll
  for (int s = 0; s < 6; ++s) qf[s] = *(const s8v*)(Q + (size_t)mq * 768 + h * 96 + 16 * s + 8 * hh);
  f16v o0, o1;
#pragma unroll
  for (int i = 0; i < 16; ++i) { o0[i] = 0.f; o1[i] = 0.f; }
  float mrun = -1e30f, lrun = 0.f;
  s8v kfA[6], vfA[4], kfB[6], vfB[4];
#define ATT_LOAD(k0_, KF, VF) do { const int tl = (k0_) >> 5; \
    _Pragma("unroll") for (int st = 0; st < 4; ++st) KF[st] = *(const s8v*)(KFb + (size_t)(tl * 4 + st) * 512); \
    _Pragma("unroll") for (int st = 0; st < 2; ++st) KF[4 + st] = *(const s8v*)(KRb + (size_t)(tl * 2 + st) * 512); \
    _Pragma("unroll") for (int q = 0; q < 4; ++q) VF[q] = *(const s8v*)(VFb + (size_t)(tl * 4 + q) * 512); } while (0)
#define ATT_TILE(KF, VF) do { \
    f16v s; _Pragma("unroll") for (int i = 0; i < 16; ++i) s[i] = 0.f; \
    _Pragma("unroll") for (int st = 0; st < 6; ++st) s = __builtin_amdgcn_mfma_f32_32x32x16_bf16(KF[st], qf[st], s, 0, 0, 0); \
    float mx = s[0]; _Pragma("unroll") for (int i = 1; i < 16; ++i) mx = fmaxf(mx, s[i]); \
    mx = fmaxf(mx, __shfl_xor(mx, 32)); \
    if (wave_any(mx > mrun)) { const float mnew = fmaxf(mrun, mx); const float alpha = fexp2_(mrun - mnew); mrun = mnew; lrun *= alpha; \
      _Pragma("unroll") for (int i = 0; i < 16; ++i) { o0[i] *= alpha; o1[i] *= alpha; } } \
    float ps = 0.f; float pe[16]; \
    _Pragma("unroll") for (int i = 0; i < 16; ++i) { pe[i] = fexp2_(s[i] - mrun); ps += pe[i]; } \
    lrun += ps; \
    _Pragma("unroll") for (int st = 0; st < 2; ++st) { \
      const s8v pf = __builtin_bit_cast(s8v, u4v{pk2bf(pe[8 * st], pe[8 * st + 1]), pk2bf(pe[8 * st + 2], pe[8 * st + 3]), pk2bf(pe[8 * st + 4], pe[8 * st + 5]), pk2bf(pe[8 * st + 6], pe[8 * st + 7])}); \
      o0 = __builtin_amdgcn_mfma_f32_32x32x16_bf16(VF[st * 2], pf, o0, 0, 0, 0); \
      o1 = __builtin_amdgcn_mfma_f32_32x32x16_bf16(VF[st * 2 + 1], pf, o1, 0, 0, 0); } } while (0)
  ATT_LOAD(0, kfA, vfA);
  int k0 = 0;
  for (; k0 + 64 <= nkeys; k0 += 64) {
    ATT_LOAD(k0 + 32, kfB, vfB); SCHED_FENCE();
    ATT_TILE(kfA, vfA); SCHED_FENCE();
    ATT_LOAD((k0 + 64 < nkeys) ? k0 + 64 : nkeys - 32, kfA, vfA); SCHED_FENCE();
    ATT_TILE(kfB, vfB); SCHED_FENCE();
  }
  if (k0 < nkeys) ATT_TILE(kfA, vfA);
#undef ATT_LOAD
#undef ATT_TILE
  const float ltot = lrun + __shfl_xor(lrun, 32); const float inv = 1.f / ltot;
  const bf16_t* Z = (const bf16_t*)(ws + O_Z);
  bf16_t* O = (bf16_t*)(ws + O_OBR) + (size_t)1 * MG * 512;
#pragma unroll
  for (int db = 0; db < 2; ++db)
#pragma unroll
    for (int q4 = 0; q4 < 4; ++q4) {
      const int dv = db * 32 + 8 * q4 + 4 * hh;
      u2v gt = *(const u2v*)(Z + (size_t)mq * IN_W + ZC_GB + h * 64 + dv);
      const float x0 = (db == 0 ? o0[4 * q4] : o1[4 * q4]) * inv, x1 = (db == 0 ? o0[4 * q4 + 1] : o1[4 * q4 + 1]) * inv, x2 = (db == 0 ? o0[4 * q4 + 2] : o1[4 * q4 + 2]) * inv, x3 = (db == 0 ? o0[4 * q4 + 3] : o1[4 * q4 + 3]) * inv;
      *(u2v*)(O + (size_t)mq * 512 + h * 64 + dv) = pack4(x0 * siluf_(bflo(gt.x)), x1 * siluf_(bfhi(gt.x)), x2 * siluf_(bflo(gt.y)), x3 * siluf_(bfhi(gt.y)));
    }
}

__device__ __forceinline__ void stage_dft2(const Params& p, const Grp& g, int bid, int nb, char* smem) {
  char* ws = p.ws;
  const bf16_t* Z = (const bf16_t*)(ws + O_Z);
  const int T = g.T, ntt = T / 128;
  const int NT_D2 = g.nseq * 4 * ntt;
  const int soff = (g.nseq * 32) % nb;
  for (int t = (bid - soff + nb) % nb; t < NT_D2; t += nb) {
    int sq = t / (4 * ntt), r = t % (4 * ntt), gg = r / ntt, tt = r % ntt;
    long mbase = (long)sq * T;
    f4v acc[2][4]; zero_acc<4>(acc);
    { GT d = mk_gt((const bf16_t*)(ws + (g.isden ? O_A2D : O_A2C)), 2 * T, tt * 128, T, (const bf16_t*)(ws + O_YT) + (size_t)mbase * 1024 + (size_t)gg * 128 * 2 * T, 2 * T, 0, 128, 2 * T); gemm_deep<4>(d, smem, acc); }
    bf16_t* O = (bf16_t*)(ws + O_OBR) + (size_t)3 * MG * 512;
    const float sc = rsqrtf(128.f * (float)T);
    epi_foreach<4>(acc, tt * 128, 0, [&](int row, int c0, f4v& v) {
      long m = mbase + row; int c = gg * 128 + c0; u2v gd = *(const u2v*)(Z + (size_t)m * IN_W + ZC_GD + c);
      *(u2v*)(O + (size_t)m * 512 + c) = pack4(v[0] * sc * siluf_(bflo(gd.x)), v[1] * sc * siluf_(bfhi(gd.x)), v[2] * sc * siluf_(bflo(gd.y)), v[3] * sc * siluf_(bfhi(gd.y)));
    });
  }
}

constexpr int PL_STR = 72;
constexpr int PCH_MA = 0, PCH_MB = 4608, PCH_TBT = 9216, PCH_MBT = 10240, PCH_TK = 11264, PCH_MK = 12288, PCH_LDS = 13312;
__device__ __forceinline__ void pchunk_task(const Params& p, const Grp& g, int task, char* wl) {
  char* ws = p.ws;
  const int lane = my_tid() & 63, ql = lane & 31, hh = lane >> 5;
  const int T = g.T, nch = T >> 4;
  const int ch = task / nch, ci = task % nch;
  const int dir = ch & 1, h = (ch >> 1) & 7, sq = ch >> 4;
  const bf16_t* rec0 = (const bf16_t*)(ws + O_SOP) + ((size_t)sq * 8 + h) * T * 576;
  char* cm = ws + O_CM + (size_t)task * CM_REC;
  float At[16], Rt[16], Bh[16], Kh[16]; float W = 1.f;
#pragma unroll
  for (int j = 0; j < 16; ++j) {
    const int st = ci * 16 + j, tt = dir ? T - 1 - st : st;
    const bf16_t* rec = rec0 + (size_t)tt * 576;
    const float r = bf2f(rec[lane]), kk = bf2f(rec[64 + lane]), d = bf2f(rec[(3 + 3 * dir) * 64 + lane]), b = bf2f(rec[(4 + 3 * dir) * 64 + lane]), kt = bf2f(rec[(5 + 3 * dir) * 64 + lane]);
    At[j] = -kk * W; W *= (1.f - d); const float iw = 1.f / W; Rt[j] = r * W; Bh[j] = b * iw; Kh[j] = kt * iw;
  }
  {
    float x[8];
#pragma unroll
    for (int q = 0; q < 2; ++q) {
#pragma unroll
      for (int e = 0; e < 8; ++e) { const int st = ci * 16 + q * 8 + e, tt = dir ? T - 1 - st : st; x[e] = bf2f(rec0[(size_t)tt * 576 + 128 + lane]); }
      *(u4v*)(cm + CM_VT + (((lane >> 5) * 64 + q * 32 + (lane & 31)) * 16)) = pack8(x);
    }
  }
  {
    float x[8];
    const int k2 = lane >> 5, kq = lane & 31;
#pragma unroll
    for (int hq = 0; hq < 2; ++hq) {
#pragma unroll
      for (int e = 0; e < 8; ++e) x[e] = Bh[8 * (e >> 2) + 4 * hq + (e & 3)] * W;
      *(u4v*)(cm + CM_BKT + (((k2 * 2 + 0) * 64 + hq * 32 + kq) * 16)) = pack8(x);
#pragma unroll
      for (int e = 0; e < 8; ++e) x[e] = Kh[8 * hq + e] * W;
      *(u4v*)(cm + CM_BKT + (((k2 * 2 + 1) * 64 + hq * 32 + kq) * 16)) = pack8(x);
    }
    *(float*)(cm + CM_WL + lane * 4) = W;
  }
  bf16_t* MA = (bf16_t*)(wl + PCH_MA); bf16_t* MB = (bf16_t*)(wl + PCH_MB);
  float* TBT = (float*)(wl + PCH_TBT); float* MBT = (float*)(wl + PCH_MBT); float* TK = (float*)(wl + PCH_TK); float* MK = (float*)(wl + PCH_MK);
  WAVE_SYNC();
#pragma unroll
  for (int j = 0; j < 16; ++j) { MA[j * PL_STR + lane] = f2bf(Bh[j]); MA[(16 + j) * PL_STR + lane] = f2bf(Kh[j]); MB[j * PL_STR + lane] = f2bf(At[j]); MB[(16 + j) * PL_STR + lane] = f2bf(Rt[j]); }
  WAVE_SYNC();
  f16v D;
#pragma unroll
  for (int i = 0; i < 16; ++i) D[i] = 0.f;
#pragma unroll
  for (int s4 = 0; s4 < 4; ++s4) {
    const s8v fa = *(const s8v*)(MA + ql * PL_STR + 16 * s4 + 8 * hh), fb = *(const s8v*)(MB + ql * PL_STR + 16 * s4 + 8 * hh);
    D = __builtin_amdgcn_mfma_f32_32x32x16_bf16(fa, fb, D, 0, 0, 0);
  }
#pragma unroll
  for (int r = 0; r < 16; ++r) {
    const int i = (r & 3) + 8 * (r >> 2) + 4 * hh; const float v = D[r];
    if (r < 8) { if (ql < 16) TBT[ql * 16 + i] = (i < ql) ? v : 0.f; else MBT[(ql - 16) * 16 + i] = (i <= ql - 16) ? v : 0.f; }
    else { const int i2 = i - 16; if (ql < 16) TK[i2 * 16 + ql] = (i2 < ql) ? v : 0.f; else MK[i2 * 16 + (ql - 16)] = (i2 <= ql - 16) ? v : 0.f; }
  }
  WAVE_SYNC();
  const int l16 = lane & 15;
  float Z[16], Z2[16];
#pragma unroll
  for (int j = 0; j < 16; ++j) { Z[j] = 0.f; Z2[j] = 0.f; }
#pragma unroll
  for (int j = 0; j < 16; ++j) {
    float a1 = At[j], a2 = TK[l16 * 16 + j];
#pragma unroll
    for (int c4 = 0; c4 * 4 < j; ++c4) { const f4v tv = *(const f4v*)(TBT + j * 16 + c4 * 4);
#pragma unroll
      for (int e = 0; e < 4; ++e) if (c4 * 4 + e < j) { a1 += Z[c4 * 4 + e] * tv[e]; a2 += Z2[c4 * 4 + e] * tv[e]; } }
    Z[j] = a1; Z2[j] = a2;
  }
  bf16_t* GT = (bf16_t*)(cm + CM_GT);
  const int o16 = lane & 15, gt1 = (((lane >> 4) * 64 + ((o16 & 7) >> 2) * 32) * 8) + (((o16 >> 3) << 2) | (o16 & 3)), gt2 = ((4 * 64 + (o16 >> 3) * 32) * 8) + (o16 & 7);
#pragma unroll
  for (int t = 0; t < 16; ++t) {
    float a1 = Rt[t], a2 = MK[l16 * 16 + t];
#pragma unroll
    for (int c4 = 0; c4 * 4 <= t; ++c4) { const f4v mv = *(const f4v*)(MBT + t * 16 + c4 * 4);
#pragma unroll
      for (int e = 0; e < 4; ++e) if (c4 * 4 + e <= t) { a1 += Z[c4 * 4 + e] * mv[e]; a2 += Z2[c4 * 4 + e] * mv[e]; } }
    GT[gt1 + (16 + t) * 8] = f2bf(a1);
    if (lane < 16) GT[gt2 + (16 + t) * 8] = f2bf(a2);
  }
#pragma unroll
  for (int j = 0; j < 16; ++j) { GT[gt1 + j * 8] = f2bf(Z[j]); if (lane < 16) GT[gt2 + j * 8] = f2bf(Z2[j]); }
}

__device__ __forceinline__ s8v cvt8(const f16v& a, int o) {
  return __builtin_bit_cast(s8v, u4v{pk2bf(a[o], a[o + 1]), pk2bf(a[o + 2], a[o + 3]), pk2bf(a[o + 4], a[o + 5]), pk2bf(a[o + 6], a[o + 7])});
}
struct ScanOps { s8v gA[5], bU[2], bV[2], vf; float wreg; };
__device__ __forceinline__ void scan2_load(ScanOps& o, const char* cm, const bf16_t* rec0, int ci, int T, int dir, int ql, int hh, int row) {
  const int lane = hh * 32 + ql, rt = row >> 5;
  o.wreg = *(const float*)(cm + CM_WL + lane * 4);
#pragma unroll
  for (int s = 0; s < 5; ++s) o.gA[s] = *(const s8v*)(cm + CM_GT + (s * 64 + lane) * 16);
#pragma unroll
  for (int k2 = 0; k2 < 2; ++k2) { o.bU[k2] = *(const s8v*)(cm + CM_BKT + ((k2 * 2) * 64 + lane) * 16); o.bV[k2] = *(const s8v*)(cm + CM_BKT + ((k2 * 2 + 1) * 64 + lane) * 16); }
  o.vf = *(const s8v*)(cm + CM_VT + (rt * 64 + lane) * 16);
  (void)rec0; (void)ci; (void)T; (void)dir;
}
__device__ __forceinline__ void scan2_task(const Params& p, const Grp& g, int l, int task, char* wl) {
  char* ws = p.ws;
  const int lane = my_tid() & 63, ql = lane & 31, hh = lane >> 5;
  const int T = g.T, nch = T >> 4;
  const int ch = task >> 1, rt = task & 1;
  const int dir = ch & 1, h = (ch >> 1) & 7, sq = ch >> 4;
  const int row = rt * 32 + ql;
  const long mbase = (long)sq * T;
  const bf16_t* rec0 = (const bf16_t*)(ws + O_SOP) + ((size_t)sq * 8 + h) * T * 576;
  const char* cm0 = ws + O_CM + (size_t)ch * nch * CM_REC;
  float* YS = (float*)(ws + O_YS) + (size_t)dir * MG * 512;
  float* wlf = (float*)wl;
  f16v a0, a1;
  if (g.isden) { const float* st = (dir ? p.st_b : p.st_f) + ((((size_t)sq * NL + l) * 8 + h) * 64 + row) * 64;
#pragma unroll
    for (int q = 0; q < 4; ++q) { f4v x = *(const f4v*)(st + 8 * q + 4 * hh), y = *(const f4v*)(st + 32 + 8 * q + 4 * hh);
#pragma unroll
      for (int e = 0; e < 4; ++e) { a0[4 * q + e] = x[e]; a1[4 * q + e] = y[e]; } } }
  else {
#pragma unroll
    for (int i = 0; i < 16; ++i) { a0[i] = 0.f; a1[i] = 0.f; } }
  ScanOps s0, s1, s2;
  scan2_load(s0, cm0, rec0, 0, T, dir, ql, hh, row);
  scan2_load(s1, cm0 + CM_REC, rec0, 1, T, dir, ql, hh, row);
#define SCAN2_STEP(CUR, ci_) do { const int ci = (ci_); \
    WAVE_SYNC(); wlf[lane] = CUR.wreg; WAVE_SYNC(); \
    const s8v vfrag = CUR.vf; \
    f16v D; _Pragma("unroll") for (int i = 0; i < 16; ++i) D[i] = 0.f; \
    D = __builtin_amdgcn_mfma_f32_32x32x16_bf16(CUR.gA[0], cvt8(a0, 0), D, 0, 0, 0); \
    D = __builtin_amdgcn_mfma_f32_32x32x16_bf16(CUR.gA[1], cvt8(a0, 8), D, 0, 0, 0); \
    D = __builtin_amdgcn_mfma_f32_32x32x16_bf16(CUR.gA[2], cvt8(a1, 0), D, 0, 0, 0); \
    D = __builtin_amdgcn_mfma_f32_32x32x16_bf16(CUR.gA[3], cvt8(a1, 8), D, 0, 0, 0); \
    D = __builtin_amdgcn_mfma_f32_32x32x16_bf16(CUR.gA[4], vfrag, D, 0, 0, 0); \
    _Pragma("unroll") for (int i = 0; i < 8; ++i) { const int st = ci * 16 + (i & 3) + 8 * (i >> 2) + 4 * hh, tt = dir ? T - 1 - st : st; YS[(size_t)(mbase + tt) * 512 + h * 64 + row] = D[8 + i]; } \
    const s8v uf = cvt8(D, 0); \
    const float* wq = wlf + 4 * hh; \
    _Pragma("unroll") for (int q = 0; q < 4; ++q) { const f4v w0 = *(const f4v*)(wq + 8 * q), w1 = *(const f4v*)(wq + 32 + 8 * q); \
      _Pragma("unroll") for (int e = 0; e < 4; ++e) { a0[4 * q + e] *= w0[e]; a1[4 * q + e] *= w1[e]; } } \
    a0 = __builtin_amdgcn_mfma_f32_32x32x16_bf16(CUR.bU[0], uf, a0, 0, 0, 0); \
    a0 = __builtin_amdgcn_mfma_f32_32x32x16_bf16(CUR.bV[0], vfrag, a0, 0, 0, 0); \
    a1 = __builtin_amdgcn_mfma_f32_32x32x16_bf16(CUR.bU[1], uf, a1, 0, 0, 0); \
    a1 = __builtin_amdgcn_mfma_f32_32x32x16_bf16(CUR.bV[1], vfrag, a1, 0, 0, 0); } while (0)
  int c = 0;
  for (; c + 3 <= nch; c += 3) {
    { const int cc = (c + 2 < nch) ? c + 2 : nch - 1; scan2_load(s2, cm0 + (size_t)cc * CM_REC, rec0, cc, T, dir, ql, hh, row); }
    SCHED_FENCE(); SCAN2_STEP(s0, c); SCHED_FENCE();
    { const int cc = (c + 3 < nch) ? c + 3 : nch - 1; scan2_load(s0, cm0 + (size_t)cc * CM_REC, rec0, cc, T, dir, ql, hh, row); }
    SCHED_FENCE(); SCAN2_STEP(s1, c + 1); SCHED_FENCE();
    { const int cc = (c + 4 < nch) ? c + 4 : nch - 1; scan2_load(s1, cm0 + (size_t)cc * CM_REC, rec0, cc, T, dir, ql, hh, row); }
    SCHED_FENCE(); SCAN2_STEP(s2, c + 2); SCHED_FENCE();
  }
  if (c < nch) SCAN2_STEP(s0, c);
  if (c + 1 < nch) SCAN2_STEP(s1, c + 1);
#undef SCAN2_STEP
  if (!g.isden) { float* so = p.out + (dir ? OUT_SB : OUT_SF) + ((((size_t)(g.b0 + sq) * NL + l) * 8 + h) * 64 + row) * 64;
#pragma unroll
    for (int q = 0; q < 4; ++q) { *(f4v*)(so + 8 * q + 4 * hh) = f4v{a0[4 * q], a0[4 * q + 1], a0[4 * q + 2], a0[4 * q + 3]}; *(f4v*)(so + 32 + 8 * q + 4 * hh) = f4v{a1[4 * q], a1[4 * q + 1], a1[4 * q + 2], a1[4 * q + 3]}; } }
}

__device__ __forceinline__ void stage_mixA(const Params& p, const Grp& g, int bid, int nb, char* smem) {
  const int wid = my_tid() >> 6;
  const int NP = g.nseq * 16 * (g.T >> 4), q32 = g.T / 32, NA = g.nseq * 8 * q32;
  char* wl = smem + wid * PCH_LDS;
  for (int task = wid * nb + bid; task < NP + NA; task += nb * NWAVE) {
    if (task < NP) pchunk_task(p, g, task, wl);
    else { int t = task - NP; int sq = t / (8 * q32), r = t % (8 * q32); attention_task(p, g, sq, r / q32, r % q32); }
  }
}
__device__ __forceinline__ void stage_scanS(const Params& p, const Grp& g, int l, int bid, int nb, char* smem) {
  const int wid = my_tid() >> 6;
  const int NS = g.nseq * 32;
  for (int task = wid * nb + bid; task < NS; task += nb * NWAVE) scan2_task(p, g, l, task, smem + wid * 768);
  __syncthreads();
}

__device__ __forceinline__ void stage_e3(const Params& p, const Grp& g, int l, int bid, int nb) {
  const int lane = my_tid() & 63, wid = my_tid() >> 6;
  char* ws = p.ws;
  const float* YS = (const float*)(ws + O_YS); const bf16_t* SOP = (const bf16_t*)(ws + O_SOP); const float* BON = (const float*)(ws + O_BON); const int T = g.T;
  const bf16_t* Z = (const bf16_t*)(ws + O_Z); bf16_t* O = (bf16_t*)(ws + O_OBR);
  const int hd = lane >> 3, c0 = lane * 8;
  const float* lg = p.ln_g + (size_t)l * 512 + c0; const float* lb = p.ln_b + (size_t)l * 512 + c0;
  for (int m = bid * NWAVE + wid; m < g.mg; m += nb * NWAVE) {
    const f4v y0 = *(const f4v*)(YS + (size_t)m * 512 + c0), y1 = *(const f4v*)(YS + (size_t)m * 512 + c0 + 4);
    const f4v z0 = *(const f4v*)(YS + ((size_t)MG + m) * 512 + c0), z1 = *(const f4v*)(YS + ((size_t)MG + m) * 512 + c0 + 4);
    float o[8]; float s1 = 0.f;
#pragma unroll
    for (int e = 0; e < 4; ++e) { o[e] = y0[e] + z0[e]; o[4 + e] = y1[e] + z1[e]; }
#pragma unroll
    for (int e = 0; e < 8; ++e) s1 += o[e];
    const float mean = sum_lpr<8>(s1) * (1.f / 64.f); float s2 = 0.f;
#pragma unroll
    for (int e = 0; e < 8; ++e) { o[e] -= mean; s2 += o[e] * o[e]; }
    const float rs = rsqrtf(sum_lpr<8>(s2) * (1.f / 64.f) + 64e-5f);
    const float bon = BON[((size_t)m * 8 + hd) * 2] + BON[((size_t)m * 8 + hd) * 2 + 1];
    float v[8], ga[8];
    unpack8(*(const u4v*)(SOP + (((size_t)(m / T) * 8 + hd) * T + (m % T)) * 576 + 128 + (lane & 7) * 8), v);
    unpack8(*(const u4v*)(Z + (size_t)m * IN_W + ZC_GA + c0), ga);
    float r[8];
#pragma unroll
    for (int e = 0; e < 8; ++e) r[e] = (o[e] * rs * lg[e] + lb[e] + bon * v[e]) * siluf_(ga[e]);
    *(u4v*)(O + (size_t)m * 512 + c0) = pack8(r);
  }
}

__device__ __forceinline__ void stage_gates(const Params& p, const Grp& g, int l, int bid, int nb, char* smem) {
  const bf16_t* H = (const bf16_t*)(p.ws + O_H);
  const bf16_t* W = (const bf16_t*)(p.ws + O_WMT);
  bf16_t* GT = (bf16_t*)(p.ws + O_GATES);
  const float* bm = p.b_merge + (size_t)l * 4096;
#ifndef EMU
  if ((g.mg & 255) == 0) {
    pg8::Gemm gm; gm.A = H; gm.Bt = W; gm.M = g.mg; gm.N = 4096; gm.K = 1024;
    pg8::StaticOrder S; S.init(gm.M, gm.N, nb, bid);
    pg8::EpiSigmoid E; E.O = GT; E.ldc = 4096; E.bias = bm;
    pg8::gemm_phase<pg8::EpiSigmoid, pg8::StaticOrder>((PG8_LAS unsigned char*)smem, gm, S, E);
    return;
  }
#endif
  const int TM = (g.mg + 127) / 128, mg = g.mg;
  for (int t = bid; t < TM * 32; t += nb) {
    int tn = t / TM, tm = t % TM; f4v acc[2][4]; zero_acc<4>(acc);
    gemm_mainloop<4>(H, 1024, tm * 128, mg, W, 1024, tn * 128, 4096, 1024, smem, acc);
    epi_foreach<4>(acc, tm * 128, tn * 128, [&](int row, int c0, f4v& v) {
      if (row < mg) *(u2v*)(GT + (size_t)row * 4096 + c0) = pack4(sigmoidf_(v[0] + bm[c0]), sigmoidf_(v[1] + bm[c0 + 1]), sigmoidf_(v[2] + bm[c0 + 2]), sigmoidf_(v[3] + bm[c0 + 3]));
    });
  }
}

__device__ __forceinline__ void stage_g8(const Params& p, const Grp& g, int l, int bid, int nb, char* smem) {
  char* ws = p.ws;
  bf16_t* MGD = (bf16_t*)(ws + O_MERGED);
  const bf16_t* GTp = (const bf16_t*)(ws + O_GATES);
  const int TM = (g.mg + 127) / 128, mg = g.mg, NT = TM * 8;
  auto desc = [&](int t, int n) { int tn = t / TM, tm = t % TM;
    return mk_gt((const bf16_t*)(ws + O_OBR) + (size_t)n * MG * 512, 512, tm * 128, mg, (const bf16_t*)(ws + O_WBRT) + (size_t)n * 1024 * 512, 512, tn * 128, 1024, 512); };
  for (int t = bid; t < NT; t += nb) {
    int tn = t / TM, tm = t % TM;
    f4v macc[2][4]; zero_acc<4>(macc);
#pragma unroll 1
    for (int n = 0; n < 4; ++n) {
      f4v ap[2][4]; zero_acc<4>(ap);
      GT cur = desc(t, n);
      gemm_deep<4>(cur, smem, ap);
      const int lane = my_tid() & 63, wid = my_tid() >> 6, wm = wid >> 1, wn = wid & 1;
#pragma unroll
      for (int i = 0; i < 2; ++i)
#pragma unroll
        for (int j = 0; j < 4; ++j) {
          int row = tm * 128 + wm * 32 + i * 16 + (lane & 15); row = row < mg ? row : mg - 1;
          int c0 = tn * 128 + wn * 64 + j * 16 + (lane >> 4) * 4;
          u2v gt = *(const u2v*)(GTp + (size_t)row * 4096 + n * 1024 + c0);
          macc[i][j][0] += bflo(gt.x) * ap[i][j][0]; macc[i][j][1] += bfhi(gt.x) * ap[i][j][1]; macc[i][j][2] += bflo(gt.y) * ap[i][j][2]; macc[i][j][3] += bfhi(gt.y) * ap[i][j][3];
        }
    }
    epi_foreach<4>(macc, tm * 128, tn * 128, [&](int row, int c0, f4v& v) {
      if (row < mg) *(u2v*)(MGD + (size_t)row * 1024 + c0) = pack4(v[0], v[1], v[2], v[3]);
    });
  }
  (void)l;
}

__device__ __forceinline__ void stage_g9(const Params& p, const Grp& g, int l, int bid, int nb, char* smem) {
  char* ws = p.ws;
  float* X = p.out + (size_t)g.m0 * 1024;
  const float* modp = (const float*)(ws + O_MOD) + (size_t)l * 3 * 3072 + 2048;
  const int TM = (g.mg + 127) / 128, mg = g.mg, NT = TM * 8;
  auto desc = [&](int t) { int tn = t / TM, tm = t % TM; return mk_gt((const bf16_t*)(ws + O_MERGED), 1024, tm * 128, mg, (const bf16_t*)(ws + O_WOUTT), 1024, tn * 128, 1024, 1024); };
  for (int t = bid; t < NT; t += nb) {
    int tn = t / TM, tm = t % TM;
    f4v acc[2][4]; zero_acc<4>(acc);
    GT cur = desc(t);
    gemm_deep<4>(cur, smem, acc);
    epi_foreach<4>(acc, tm * 128, tn * 128, [&](int row, int c0, f4v& v) {
      if (row < mg) { const float* gt = modp + (size_t)mod_index(g, row) * 3072 + c0; f4v* xp = (f4v*)(X + (size_t)row * 1024 + c0); f4v x = *xp;
        x[0] += gt[0] * v[0]; x[1] += gt[1] * v[1]; x[2] += gt[2] * v[2]; x[3] += gt[3] * v[3]; *xp = x; }
    });
  }
}

__device__ __forceinline__ void stage_final(const Params& p, int bid, int nb) {
  const int lane = my_tid() & 63, wid = my_tid() >> 6;
  for (int m = bid * NWAVE + wid; m < M; m += nb * NWAVE) {
    float* xr = p.out + (size_t)m * 1024; float4 q[4]; float ss = 0.f;
#pragma unroll
    for (int i = 0; i < 4; ++i) { q[i] = *(const float4*)(xr + i * 256 + lane * 4); ss += q[i].x * q[i].x + q[i].y * q[i].y + q[i].z * q[i].z + q[i].w * q[i].w; }
    ss = wave_sum(ss); float rs = rsqrtf(ss * (1.f / 1024.f) + 1e-6f);
#pragma unroll
    for (int i = 0; i < 4; ++i) { int c = i * 256 + lane * 4; float4 gm = *(const float4*)(p.final_g + c);
      *(float4*)(xr + c) = make_float4(q[i].x * rs * gm.x, q[i].y * rs * gm.y, q[i].z * rs * gm.z, q[i].w * rs * gm.w); }
  }
}

#ifdef EMU
#define DECL_SMEM(name) char* name = emu::smem()
#else
#define DECL_SMEM(name) __shared__ __attribute__((aligned(16))) char name[SMEM_BYTES]
#endif

#ifdef EMU
struct GridBar { __device__ void sync() const { emu::grid_sync(); } };
#else
#define XB_TMO      128
#define XB_XCNT(j)  (256  + 64 * (j))
#define XB_XSUB(j)  (1280 + 64 * (j))
#define XB_XGEN(j)  (2304 + 64 * (j))
#define XB_TOP      3328
#define XB_TOPGEN   3392
#define XB_SPIN_CAP (1u << 20)
#define LAS __attribute__((address_space(3)))
__device__ __forceinline__ unsigned xb_ld(unsigned* p)              { return __hip_atomic_load(p, __ATOMIC_RELAXED, __HIP_MEMORY_SCOPE_AGENT); }
__device__ __forceinline__ unsigned xb_add(unsigned* p, unsigned v) { return __hip_atomic_fetch_add(p, v, __ATOMIC_RELAXED, __HIP_MEMORY_SCOPE_AGENT); }
__device__ __forceinline__ unsigned xb_xcc_id() { return (unsigned)__builtin_amdgcn_s_getreg((3 << 11) | 20) & 0xFu; }
#define XB_SPIN(cond, bar) do { unsigned _sp = 0; while (cond) { __builtin_amdgcn_s_sleep(1); \
    if ((++_sp & 255u) == 0u) { if (xb_ld(&(bar)[XB_TMO])) break; if (_sp > XB_SPIN_CAP) { atomicAdd(&(bar)[XB_TMO], 1u); break; } } } } while (0)
struct GridBar {
  unsigned* bar; unsigned x; volatile LAS unsigned* st;
  __device__ __forceinline__ void post(unsigned* b, volatile LAS unsigned* s_) {
    bar = b; x = xb_xcc_id(); st = s_;
    if (threadIdx.x == 0) (void)xb_add(&bar[XB_XCNT(x)], 1u);
  }
  __device__ __forceinline__ void complete(unsigned& nloc, unsigned& nx) const {
    const unsigned G = gridDim.x;
    unsigned sum, cnt, mine, sp = 0u;
    for (;;) {
      sum = 0u; cnt = 0u; mine = 0u;
#pragma unroll
      for (unsigned j = 0; j < 16; ++j) { const unsigned c = xb_ld(&bar[XB_XCNT(j)]); sum += c; cnt += (c > 0u) ? 1u : 0u; mine = (j == x) ? c : mine; }
      if (sum == G) break;
      __builtin_amdgcn_s_sleep(1);
      if ((++sp & 255u) == 0u) { if (xb_ld(&bar[XB_TMO])) break; if (sp > XB_SPIN_CAP) { atomicAdd(&bar[XB_TMO], 1u); break; } }
    }
    nloc = mine > 0u ? mine : 1u; nx = cnt > 0u ? cnt : 1u;
  }
  __device__ __forceinline__ void sync() const {
    asm volatile("s_waitcnt vmcnt(0)" ::: "memory");
    __syncthreads();
    if (threadIdx.x == 0) {
      __builtin_amdgcn_s_waitcnt(0);
      unsigned nloc = st[0], nx = st[1];
      if (nloc == 0u) { complete(nloc, nx); st[0] = nloc; st[1] = nx; }
      const unsigned old = xb_add(&bar[XB_XSUB(x)], 1u);
      const unsigned gen = old / nloc;
      if (old + 1u == (gen + 1u) * nloc) {
        __builtin_amdgcn_fence(__ATOMIC_RELEASE, "agent");
        asm volatile("s_waitcnt vmcnt(0)" ::: "memory");
        const unsigned og = xb_add(&bar[XB_TOP], 1u);
        const unsigned tg = og / nx;
        if (og + 1u == (tg + 1u) * nx) xb_add(&bar[XB_TOPGEN], 1u);
        else XB_SPIN(xb_ld(&bar[XB_TOPGEN]) == tg, bar);
        __builtin_amdgcn_fence(__ATOMIC_ACQUIRE, "agent");
        xb_add(&bar[XB_XGEN(x)], 1u);
        asm volatile("s_waitcnt vmcnt(0)" ::: "memory");
      } else {
        XB_SPIN(xb_ld(&bar[XB_XGEN(x)]) == gen, bar);
        __builtin_amdgcn_fence(__ATOMIC_ACQUIRE, "agent");
        asm volatile("s_waitcnt vmcnt(0)" ::: "memory");
      }
    }
    __syncthreads();
  }
};
#endif

#ifndef EMU
namespace cg = cooperative_groups;
#else
namespace cg = cooperative_groups;
#endif

__global__ void __launch_bounds__(NTHR) mega_kernel(Params p) {
  DECL_SMEM(smem);
  cg::grid_group grid = cg::this_grid();
  const int bid0 = blockIdx.x, nb0 = gridDim.x;
  GridBar gb;
#ifndef EMU
  if (threadIdx.x == 0) { volatile LAS unsigned* w = (volatile LAS unsigned*)(smem + SMEM_STAGE); w[0] = 0u; w[1] = 0u; w[2] = 0u; w[3] = 0u; }
  __syncthreads();
  gb.post((unsigned*)(p.ws + O_BAR), (volatile LAS unsigned*)(smem + SMEM_STAGE));
#endif
#ifndef PROBE_DUP
#define PROBE_DUP 0
#endif
#define STG(gi_, call) do { Params q = p; q.ws = opaque(q.ws); q.out = opaque(q.out); const int bid = opaque_i(bid0); const int nb = opaque_i(nb0); const Grp g = get_grp(opaque_i(gi_)); (void)g; call; } while (0)
#define STP(bit, gi_, call) do { STG(gi_, call); if (PROBE_DUP & (bit)) { STG(gi_, call); } } while (0)
  for (int l = 0; l < NL; ++l) {
    STP(1, 0, stage_prep(q, l, bid, nb, smem));
    if (l == 0) grid.sync();
    STP(2, 0, stage_h(q, g, l, bid, nb));
    gb.sync();
    for (int gi = 0; gi < NGRP; ++gi) {
      STP(4, gi, stage_g1(q, g, bid, nb, smem)); gb.sync();
      STP(8, gi, stage_e1(q, g, l, bid, nb)); gb.sync();
      STP(16, gi, stage_g2(q, g, l, bid, nb, smem)); gb.sync();
      STP(64, gi, stage_mixA(q, g, bid, nb, smem)); gb.sync();
      STP(32, gi, stage_scanS(q, g, l, bid, nb, smem));
      STP(128, gi, stage_dft2(q, g, bid, nb, smem)); gb.sync();
      STP(256, gi, stage_e3(q, g, l, bid, nb));
      STP(512, gi, stage_gates(q, g, l, bid, nb, smem)); gb.sync();
      STP(1024, gi, stage_g8(q, g, l, bid, nb, smem)); gb.sync();
      STG(gi, stage_g9(q, g, l, bid, nb, smem));
      if (gi + 1 < NGRP) { STP(2, gi + 1, stage_h(q, g, l, bid, nb)); }
      gb.sync();
    }
  }
  STG(0, stage_final(q, bid, nb));
#undef STP
#undef STG
}

extern "C" void kernel_launch(void* const* d_in, const int* in_sizes, int n_in, void* d_out, int out_size, void* d_ws, size_t ws_size,
                              hipStream_t stream) {
  Params p{};
  const float** pp = (const float**)&p;
  for (int i = 0; i < 35; ++i) pp[i] = (const float*)d_in[i];
  p.out = (float*)d_out; p.ws = (char*)d_ws;
#ifdef EMU
  emu::set_coop(true);
  emu_launch(dim3(8), dim3(NTHR), [=]() { mega_kernel(p); });
  emu::set_coop(false);
#else
  static int grid_blocks = 0;
  if (!grid_blocks) {
    int dev = 0, cus = 0, per_cu = 0;
    (void)hipGetDevice(&dev);
    (void)hipDeviceGetAttribute(&cus, hipDeviceAttributeMultiprocessorCount, dev);
    (void)hipOccupancyMaxActiveBlocksPerMultiprocessor(&per_cu, mega_kernel, NTHR, 0);
    if (per_cu > 1) per_cu = 1;
    if (per_cu < 1) per_cu = 1;
    grid_blocks = cus * per_cu;
  }
  (void)hipMemsetAsync((char*)d_ws + O_BAR, 0, BAR_BYTES, stream);
  void* args[] = {&p};
  (void)hipLaunchCooperativeKernel((void*)mega_kernel, dim3(grid_blocks), dim3(NTHR), args, 0, stream);
#endif
  (void)in_sizes; (void)n_in; (void)out_size; (void)ws_size;
}
```

```cpp
#ifdef EMU
#include "hip_emu.h"
#else
#include <hip/hip_runtime.h>
#include <hip/hip_cooperative_groups.h>
#endif
#include <stdint.h>

#ifndef CFG_BATCH
#define CFG_BATCH 32
#define CFG_SEQ 256
#define CFG_DEC_BATCH 2
#define CFG_DEC_SEQ 2048
#define CFG_PAST 512
#define CFG_NGRP_C 2
#endif
constexpr int D = 1024, NL = 2;
constexpr int NB_C = CFG_BATCH, T_C = CFG_SEQ, NB_D = CFG_DEC_BATCH, T_D = CFG_DEC_SEQ, PAST = CFG_PAST;
constexpr int M_C = NB_C * T_C, M_D = NB_D * T_D, M = M_C + M_D;
constexpr int NGRP_C = CFG_NGRP_C, NGRP = 1 + NGRP_C;
constexpr int MGC = M_C / NGRP_C, SEQ_PER_CG = NB_C / NGRP_C;
constexpr int MG = MGC > M_D ? MGC : M_D;
constexpr int MKV = MG + NB_D * PAST;
constexpr int KEYS_D = T_D + PAST;
constexpr int IN_W = 5728;
constexpr int ZC_R = 0, ZC_K = 512, ZC_V = 1024, ZC_WDF = 1536, ZC_GA = 1728, ZC_QD = 2240, ZC_KVD = 2496, ZC_KR = 2624,
              ZC_GB = 2656, ZC_U = 3168, ZC_VC = 3680, ZC_GC = 4192, ZC_F = 4704, ZC_GD = 5216;
constexpr int SHIFT_W = 1728;
static_assert(M_C % NGRP_C == 0 && NB_C % NGRP_C == 0, "ctx groups");
static_assert(T_C % 128 == 0 && T_D % 128 == 0 && PAST % 32 == 0, "seq multiples");

typedef unsigned short bf16_t;
typedef short s8v __attribute__((ext_vector_type(8)));
typedef float f4v __attribute__((ext_vector_type(4)));
typedef float f16v __attribute__((ext_vector_type(16)));
typedef unsigned u4v __attribute__((ext_vector_type(4)));
typedef unsigned u2v __attribute__((ext_vector_type(2)));

struct Params {
  const float *x_prompt, *x_sample, *st_f, *st_b, *c_ckv, *c_kr, *c, *c_ctx, *norm_g, *w_ada, *b_ada, *w_in, *shift_mu, *w0, *w_up,
      *a0, *a_up, *k_k, *k_a, *r_k, *ln_g, *ln_b, *q_norm, *w_q_up, *kv_norm, *w_kv_up, *g_ln_g, *g_ln_b, *g_w_s, *g_b_s, *w_branch,
      *w_merge, *b_merge, *w_out, *final_g;
  float* out;
  char* ws;
};

struct Grp { int isden, m0, mg, nseq, T, b0, nkeys, mkv; };
__host__ __device__ __forceinline__ Grp get_grp(int gi) {
  Grp g;
  if (gi == 0) { g.isden = 1; g.m0 = M_C; g.mg = M_D; g.nseq = NB_D; g.T = T_D; g.b0 = 0; g.nkeys = KEYS_D; g.mkv = M_D + NB_D * PAST; }
  else { g.isden = 0; g.m0 = (gi - 1) * MGC; g.mg = MGC; g.nseq = SEQ_PER_CG; g.T = T_C; g.b0 = (gi - 1) * SEQ_PER_CG; g.nkeys = T_C; g.mkv = MGC; }
  return g;
}

constexpr size_t al256(size_t x) { return (x + 255) & ~(size_t)255; }
constexpr size_t O_WINT = 0;
constexpr int IN_WP = ((IN_W + 255) / 256) * 256;
constexpr size_t O_WMT = O_WINT + al256((size_t)IN_WP * 1024 * 2);
constexpr size_t O_WBRT = O_WMT + al256((size_t)4096 * 1024 * 2);
constexpr size_t O_WOUTT = O_WBRT + al256((size_t)4 * 1024 * 512 * 2);
constexpr size_t O_WQT = O_WOUTT + al256((size_t)1024 * 1024 * 2);
constexpr size_t O_WKVT = O_WQT + al256((size_t)768 * 256 * 2);
constexpr size_t O_WUPT = O_WKVT + al256((size_t)1024 * 128 * 2);
constexpr size_t O_WS = O_WUPT + al256((size_t)4 * 512 * 64 * 2);
constexpr size_t O_CS128 = O_WS + al256((size_t)4 * 128 * 128 * 2);
constexpr size_t O_A2C = O_CS128 + al256((size_t)256 * 128 * 2);
constexpr size_t O_A2D = O_A2C + al256((size_t)T_C * 2 * T_C * 2);
constexpr size_t O_ROPE = O_A2D + al256((size_t)T_D * 2 * T_D * 2);
constexpr size_t O_MOD = O_ROPE + al256((size_t)T_D * 32 * 4);
constexpr size_t O_H = O_MOD + al256((size_t)NL * 3 * 3072 * 4);
constexpr size_t O_Z = O_H + al256((size_t)MG * 1024 * 2);
constexpr size_t O_SK = O_Z + al256((size_t)MG * IN_W * 2);
constexpr size_t O_SOP = O_SK + al256((size_t)MG * 512 * 2);
constexpr size_t O_YS = O_SOP + al256((size_t)MG * 8 * 576 * 2);
constexpr size_t O_BON = O_YS + al256((size_t)2 * MG * 512 * 4);
constexpr size_t O_LORA = O_BON + al256((size_t)MG * 16 * 4);
constexpr int CM_GT = 0, CM_BKT = 5120, CM_WL = 9216, CM_VT = 9472, CM_REC = 11520;
constexpr size_t CM_BYTES = (size_t)MG * CM_REC;
constexpr size_t O_CM = O_LORA + al256((size_t)MG * 192 * 2);
constexpr size_t O_PRE = O_CM + al256(CM_BYTES - (size_t)MG * 2048 * 2);
constexpr size_t O_QDN = O_PRE + al256((size_t)MG * 2048 * 2);
constexpr size_t O_CKV = O_QDN + al256((size_t)MG * 256 * 2);
constexpr size_t O_KR = O_CKV + al256((size_t)MKV * 128 * 2);
constexpr size_t O_Q = O_KR + al256((size_t)MKV * 32 * 2);
constexpr size_t O_KN = O_Q + al256((size_t)MG * 768 * 2);
constexpr size_t O_VT = O_KN + al256((size_t)MKV * 512 * 2);
constexpr size_t O_VCNT = O_VT + al256((size_t)MKV * 512 * 2);
constexpr size_t O_YT = O_VCNT + al256((size_t)MG * 512 * 2);
constexpr size_t O_OBR = O_YT + al256((size_t)MG * 1024 * 2);
constexpr size_t O_MERGED = O_OBR + al256((size_t)4 * MG * 512 * 2);
constexpr size_t O_END = O_MERGED + al256((size_t)MG * 1024 * 2);
constexpr size_t O_GATES = O_PRE;
static_assert(O_GATES + (size_t)MG * 4096 * 2 <= O_VCNT, "gates alias region too small");
static_assert(O_CM + CM_BYTES <= O_QDN, "chunk-matrix region must end before QDN");
constexpr size_t O_BAR = O_END;
constexpr size_t BAR_BYTES = 3456 * 4;
static_assert(O_BAR + BAR_BYTES <= ((size_t)256 << 20), "workspace must fit 256 MiB");

constexpr size_t OUT_SF = (size_t)M * D, OUT_SB = OUT_SF + (size_t)NB_C * NL * 8 * 64 * 64,
                 OUT_CKV = OUT_SB + (size_t)NB_C * NL * 8 * 64 * 64, OUT_KR = OUT_CKV + (size_t)NB_C * NL * T_C * 128;

#ifdef EMU
template <class T> __device__ __forceinline__ T* opaque(T* p) { return p; }
__device__ __forceinline__ int opaque_i(int v) { return v; }
#else
template <class T> __device__ __forceinline__ T* opaque(T* p) {
  typedef __attribute__((address_space(1))) T* gptr;
  gptr g = (gptr)p; asm volatile("" : "+s"(g)); return (T*)g;
}
__device__ __forceinline__ int opaque_i(int v) { asm volatile("" : "+s"(v)); return v; }
#endif
#ifdef EMU
#define SCHED_FENCE() do {} while (0)
#else
#define SCHED_FENCE() do { asm volatile("" ::: "memory"); __builtin_amdgcn_sched_barrier(0); } while (0)
#endif
__device__ __forceinline__ int my_tid() {
#ifdef EMU
  return (int)threadIdx.x;
#else
  int t = (int)threadIdx.x; asm volatile("" : "+v"(t)); return t;
#endif
}
__device__ __forceinline__ unsigned f_as_u(float f) { return __builtin_bit_cast(unsigned, f); }
__device__ __forceinline__ float u_as_f(unsigned u) { return __builtin_bit_cast(float, u); }
#ifdef EMU
__device__ __forceinline__ bf16_t f2bf(float f) { unsigned u = f_as_u(f); u += 0x7FFFu + ((u >> 16) & 1u); return (bf16_t)(u >> 16); }
__device__ __forceinline__ unsigned pk2bf(float lo, float hi) { return (unsigned)f2bf(lo) | ((unsigned)f2bf(hi) << 16); }
#else
typedef __bf16 bf2v_t __attribute__((ext_vector_type(2)));
typedef float f2c_t __attribute__((ext_vector_type(2)));
__device__ __forceinline__ bf16_t f2bf(float f) { return __builtin_bit_cast(unsigned short, (__bf16)f); }
__device__ __forceinline__ unsigned pk2bf(float lo, float hi) { return __builtin_bit_cast(unsigned, __builtin_convertvector(f2c_t{lo, hi}, bf2v_t)); }
#endif
__device__ __forceinline__ float bf2f(bf16_t h) { return u_as_f(((unsigned)h) << 16); }
__device__ __forceinline__ float bflo(unsigned u) { return u_as_f(u << 16); }
__device__ __forceinline__ float bfhi(unsigned u) { return u_as_f(u & 0xFFFF0000u); }
#ifdef EMU
__device__ __forceinline__ float fexp_(float x) { return expf(x); }
__device__ __forceinline__ float frcp_(float x) { return 1.f / x; }
#else
__device__ __forceinline__ float fexp_(float x) { return __builtin_amdgcn_exp2f(x * 1.4426950408889634f); }
__device__ __forceinline__ float frcp_(float x) { return __builtin_amdgcn_rcpf(x); }
#endif
#ifdef EMU
__device__ __forceinline__ float fexp2_(float x) { return exp2f(x); }
#else
__device__ __forceinline__ float fexp2_(float x) { return __builtin_amdgcn_exp2f(x); }
#endif
__device__ __forceinline__ float sigmoidf_(float x) { return frcp_(1.f + fexp_(-x)); }
__device__ __forceinline__ float siluf_(float x) { return x * frcp_(1.f + fexp_(-x)); }
__device__ __forceinline__ float tanhf_(float x) { return 1.f - 2.f * frcp_(1.f + fexp_(2.f * x)); }
__device__ __forceinline__ float geluf_(float x) { return 0.5f * x * (1.f + tanhf_(0.7978845608028654f * (x + 0.044715f * x * x * x))); }
#ifdef EMU
__device__ __forceinline__ float wave_sum(float v) {
#pragma unroll
  for (int o = 32; o >= 1; o >>= 1) v += __shfl_xor(v, o);
  return v;
}
#else
__device__ __forceinline__ float wave_sum(float v) {
  v += u_as_f(__builtin_amdgcn_update_dpp(0, (int)f_as_u(v), 0xB1, 0xF, 0xF, true));
  v += u_as_f(__builtin_amdgcn_update_dpp(0, (int)f_as_u(v), 0x4E, 0xF, 0xF, true));
  v += u_as_f(__builtin_amdgcn_update_dpp(0, (int)f_as_u(v), 0x141, 0xF, 0xF, true));
  v += u_as_f(__builtin_amdgcn_update_dpp(0, (int)f_as_u(v), 0x140, 0xF, 0xF, true));
  { auto r = __builtin_amdgcn_permlane16_swap(f_as_u(v), f_as_u(v), false, false); v = u_as_f(r[0]) + u_as_f(r[1]); }
  { auto r = __builtin_amdgcn_permlane32_swap(f_as_u(v), f_as_u(v), false, false); v = u_as_f(r[0]) + u_as_f(r[1]); }
  return v;
}
#endif

#ifdef EMU
#define WAVE_SYNC() emu::wave_barrier()
__device__ __forceinline__ float sum16(float v) { v += __shfl_xor(v, 1); v += __shfl_xor(v, 2); v += __shfl_xor(v, 4); v += __shfl_xor(v, 8); return v; }
#else
#define WAVE_SYNC() __builtin_amdgcn_wave_barrier()
__device__ __forceinline__ float sum16(float v) {
  v += u_as_f(__builtin_amdgcn_update_dpp(0, (int)f_as_u(v), 0xB1, 0xF, 0xF, true));
  v += u_as_f(__builtin_amdgcn_update_dpp(0, (int)f_as_u(v), 0x4E, 0xF, 0xF, true));
  v += u_as_f(__builtin_amdgcn_update_dpp(0, (int)f_as_u(v), 0x141, 0xF, 0xF, true));
  v += u_as_f(__builtin_amdgcn_update_dpp(0, (int)f_as_u(v), 0x140, 0xF, 0xF, true));
  return v;
}
#endif

template <int LPR> __device__ __forceinline__ float sum_lpr(float v) {
#ifdef EMU
  v += __shfl_xor(v, 1); v += __shfl_xor(v, 2); v += __shfl_xor(v, 4);
  if (LPR >= 16) v += __shfl_xor(v, 8);
  if (LPR >= 32) v += __shfl_xor(v, 16);
  return v;
#else
  v += u_as_f(__builtin_amdgcn_update_dpp(0, (int)f_as_u(v), 0xB1, 0xF, 0xF, true));
  v += u_as_f(__builtin_amdgcn_update_dpp(0, (int)f_as_u(v), 0x4E, 0xF, 0xF, true));
  v += u_as_f(__builtin_amdgcn_update_dpp(0, (int)f_as_u(v), 0x141, 0xF, 0xF, true));
  if (LPR >= 16) v += u_as_f(__builtin_amdgcn_update_dpp(0, (int)f_as_u(v), 0x140, 0xF, 0xF, true));
  if (LPR >= 32) { auto r = __builtin_amdgcn_permlane16_swap(f_as_u(v), f_as_u(v), false, false); v = u_as_f(r[0]) + u_as_f(r[1]); }
  return v;
#endif
}

template <int LPR> __device__ __forceinline__ void sum_lpr2(float& a, float& b) {
#ifdef EMU
  a = sum_lpr<LPR>(a); b = sum_lpr<LPR>(b);
#else
#define DPP_ADD2(ctrl) { float ta = u_as_f(__builtin_amdgcn_update_dpp(0, (int)f_as_u(a), ctrl, 0xF, 0xF, true)); float tb = u_as_f(__builtin_amdgcn_update_dpp(0, (int)f_as_u(b), ctrl, 0xF, 0xF, true)); a += ta; b += tb; }
  DPP_ADD2(0xB1) DPP_ADD2(0x4E) DPP_ADD2(0x141)
  if (LPR >= 16) DPP_ADD2(0x140)
  if (LPR >= 32) { auto ra = __builtin_amdgcn_permlane16_swap(f_as_u(a), f_as_u(a), false, false); auto rb = __builtin_amdgcn_permlane16_swap(f_as_u(b), f_as_u(b), false, false);
    a = u_as_f(ra[0]) + u_as_f(ra[1]); b = u_as_f(rb[0]) + u_as_f(rb[1]); }
#undef DPP_ADD2
#endif
}

constexpr int NTHR = 512, NWAVE = 8;
constexpr int LDS_STR = 72;
constexpr int SMEM_STAGE = 131072;
constexpr int SMEM_BYTES = SMEM_STAGE + 16;

template <int NJ>
__device__ __forceinline__ void zero_acc(f4v (&acc)[2][NJ]) {
#pragma unroll
  for (int i = 0; i < 2; ++i)
#pragma unroll
    for (int j = 0; j < NJ; ++j) acc[i][j] = f4v{0.f, 0.f, 0.f, 0.f};
}

struct GT { const bf16_t* A; long lda; int arow0, arows; const bf16_t* B; long ldb; int brow0, brows; int K; int bt; };
__device__ __forceinline__ GT mk_gt(const bf16_t* A, long lda, int arow0, int arows, const bf16_t* B, long ldb, int brow0, int brows, int K, int bt = 0) {
  GT t; t.A = A; t.lda = lda; t.arow0 = arow0; t.arows = arows; t.B = B; t.ldb = ldb; t.brow0 = brow0; t.brows = brows; t.K = K; t.bt = bt; return t;
}
template <int NJ>
__device__ __forceinline__ void gemm_ptrs(const GT& t, int tid, const bf16_t* (&ap)[2], const bf16_t* (&bp)[NJ / 2]) {
#pragma unroll
  for (int i = 0; i < 2; ++i) { int c = tid + NTHR * i, r = c >> 3, cc = c & 7; int ar = t.arow0 + r; ar = ar < t.arows ? ar : t.arows - 1; ap[i] = t.A + (long)ar * t.lda + cc * 8; }
#pragma unroll
  for (int i = 0; i < NJ / 2; ++i) { int c = tid + NTHR * i;
    if (t.bt) { int q = c & 63, dc = c >> 6; bp[i] = t.B + (long)q * t.ldb + t.brow0 + dc * 8; }
    else { int r = c >> 3, cc = c & 7; int br = t.brow0 + r; br = br < t.brows ? br : t.brows - 1; bp[i] = t.B + (long)br * t.ldb + cc * 8; } }
}
template <int NJ>
__device__ __forceinline__ void gemm_prefetch(const GT& t, u4v (&ra)[2], u4v (&rb)[NJ / 2]) {
  const bf16_t* ap[2]; const bf16_t* bp[NJ / 2];
  gemm_ptrs<NJ>(t, my_tid(), ap, bp);
#pragma unroll
  for (int i = 0; i < 2; ++i) ra[i] = *(const u4v*)(ap[i]);
#pragma unroll
  for (int i = 0; i < NJ / 2; ++i) rb[i] = *(const u4v*)(bp[i]);
}
template <int NJ, bool BT>
__device__ __forceinline__ void gemm_run(const GT& t, const GT* nxt, u4v (&ra)[2], u4v (&rb)[NJ / 2], char* smem, f4v (&acc)[2][NJ]) {
  constexpr int NBL = NJ / 2;
  constexpr int BUF = (128 + 128) * LDS_STR;
  bf16_t* s0 = (bf16_t*)smem;
  const int tid = my_tid(), lane = tid & 63, wid = tid >> 6, wm = wid >> 1, wn = wid & 1;
  const bf16_t* ap[2]; const bf16_t* bp[NBL];
  gemm_ptrs<NJ>(t, tid, ap, bp);
  const long ldb = t.ldb;
  __syncthreads();
#pragma unroll
  for (int i = 0; i < 2; ++i) { int c = tid + NTHR * i, r = c >> 3, cc = c & 7; *(u4v*)(s0 + r * LDS_STR + cc * 8) = ra[i]; }
#pragma unroll
  for (int i = 0; i < NBL; ++i) { int c = tid + NTHR * i;
    if (BT) { int q = c & 63, dc = c >> 6;
#pragma unroll
      for (int e = 0; e < 8; ++e) s0[(128 + dc * 8 + e) * LDS_STR + q] = (bf16_t)(rb[i][e >> 1] >> ((e & 1) * 16)); }
    else { int r = c >> 3, cc = c & 7; *(u4v*)(s0 + (128 + r) * LDS_STR + cc * 8) = rb[i]; } }
  __syncthreads();
  const int nk = t.K >> 6;
  for (int kt = 0; kt < nk; ++kt) {
    const bool more = kt + 1 < nk;
    if (more) {
#pragma unroll
      for (int i = 0; i < 2; ++i) ra[i] = *(const u4v*)(ap[i] + (kt + 1) * 64);
#pragma unroll
      for (int i = 0; i < NBL; ++i) rb[i] = *(const u4v*)(bp[i] + (BT ? (long)(kt + 1) * 64 * ldb : (long)(kt + 1) * 64));
    } else if (nxt) gemm_prefetch<NJ>(*nxt, ra, rb);
    const bf16_t* sA = s0 + (kt & 1) * BUF; const bf16_t* sB = sA + 128 * LDS_STR;
#pragma unroll
    for (int ks = 0; ks < 2; ++ks) {
      s8v af[2], bf[NJ];
#pragma unroll
      for (int i = 0; i < 2; ++i) af[i] = *(const s8v*)(sA + (wm * 32 + i * 16 + (lane & 15)) * LDS_STR + ks * 32 + (lane >> 4) * 8);
#pragma unroll
      for (int j = 0; j < NJ; ++j) bf[j] = *(const s8v*)(sB + (wn * NJ * 16 + j * 16 + (lane & 15)) * LDS_STR + ks * 32 + (lane >> 4) * 8);
#pragma unroll
      for (int i = 0; i < 2; ++i)
#pragma unroll
        for (int j = 0; j < NJ; ++j) acc[i][j] = __builtin_amdgcn_mfma_f32_16x16x32_bf16(bf[j], af[i], acc[i][j], 0, 0, 0);
    }
    if (more) {
      bf16_t* dA = s0 + ((kt + 1) & 1) * BUF;
#pragma unroll
      for (int i = 0; i < 2; ++i) { int c = tid + NTHR * i, r = c >> 3, cc = c & 7; *(u4v*)(dA + r * LDS_STR + cc * 8) = ra[i]; }
#pragma unroll
      for (int i = 0; i < NBL; ++i) { int c = tid + NTHR * i;
        if (BT) { int q = c & 63, dc = c >> 6;
#pragma unroll
          for (int e = 0; e < 8; ++e) dA[(128 + dc * 8 + e) * LDS_STR + q] = (bf16_t)(rb[i][e >> 1] >> ((e & 1) * 16)); }
        else { int r = c >> 3, cc = c & 7; *(u4v*)(dA + (128 + r) * LDS_STR + cc * 8) = rb[i]; } }
      __syncthreads();
    }
  }
}
template <int NJ>
__device__ __forceinline__ void gemm_deep(const GT& t, char* smem, f4v (&acc)[2][NJ]) {
  constexpr int NBL = NJ / 2;
  constexpr int BUF = (128 + 128) * LDS_STR;
  bf16_t* s0 = (bf16_t*)smem;
  const int tid = my_tid(), lane = tid & 63, wid = tid >> 6, wm = wid >> 1, wn = wid & 1;
  const bf16_t* ap[2]; const bf16_t* bp[NBL];
  gemm_ptrs<NJ>(t, tid, ap, bp);
  const int nk = t.K >> 6;
  u4v pa0[2], pb0[NBL], pa1[2], pb1[NBL];
#define GD_LOAD(PA, PB, kt_) do { const int kq = (kt_) < nk ? (kt_) : nk - 1; \
    _Pragma("unroll") for (int i = 0; i < 2; ++i) PA[i] = *(const u4v*)(ap[i] + kq * 64); \
    _Pragma("unroll") for (int i = 0; i < NBL; ++i) PB[i] = *(const u4v*)(bp[i] + kq * 64); } while (0)
#define GD_STORE(PA, PB, buf_) do { bf16_t* dA = s0 + (buf_) * BUF; \
    _Pragma("unroll") for (int i = 0; i < 2; ++i) { int c = tid + NTHR * i, r = c >> 3, cc = c & 7; *(u4v*)(dA + r * LDS_STR + cc * 8) = PA[i]; } \
    _Pragma("unroll") for (int i = 0; i < NBL; ++i) { int c = tid + NTHR * i, r = c >> 3, cc = c & 7; *(u4v*)(dA + (128 + r) * LDS_STR + cc * 8) = PB[i]; } } while (0)
#define GD_COMPUTE(buf_) do { const bf16_t* sA = s0 + (buf_) * BUF; const bf16_t* sB = sA + 128 * LDS_STR; \
    _Pragma("unroll") for (int ks = 0; ks < 2; ++ks) { s8v af[2], bf[NJ]; \
      _Pragma("unroll") for (int i = 0; i < 2; ++i) af[i] = *(const s8v*)(sA + (wm * 32 + i * 16 + (lane & 15)) * LDS_STR + ks * 32 + (lane >> 4) * 8); \
      _Pragma("unroll") for (int j = 0; j < NJ; ++j) bf[j] = *(const s8v*)(sB + (wn * NJ * 16 + j * 16 + (lane & 15)) * LDS_STR + ks * 32 + (lane >> 4) * 8); \
      _Pragma("unroll") for (int i = 0; i < 2; ++i) _Pragma("unroll") for (int j = 0; j < NJ; ++j) acc[i][j] = __builtin_amdgcn_mfma_f32_16x16x32_bf16(bf[j], af[i], acc[i][j], 0, 0, 0); } } while (0)
  GD_LOAD(pa0, pb0, 0); SCHED_FENCE();
  GD_LOAD(pa1, pb1, 1); SCHED_FENCE();
  __syncthreads();
  GD_STORE(pa0, pb0, 0);
  __syncthreads();
  for (int kt = 0; kt < nk; kt += 2) {
    GD_LOAD(pa0, pb0, kt + 2); SCHED_FENCE();
    GD_COMPUTE(0);
    if (kt + 1 < nk) { GD_STORE(pa1, pb1, 1); }
    __syncthreads();
    if (kt + 1 >= nk) break;
    GD_LOAD(pa1, pb1, kt + 3); SCHED_FENCE();
    GD_COMPUTE(1);
    if (kt + 2 < nk) { GD_STORE(pa0, pb0, 0); }
    __syncthreads();
  }
#undef GD_LOAD
#undef GD_STORE
#undef GD_COMPUTE
}

template <int NJ, bool BT = false>
__device__ __forceinline__ void gemm_mainloop(const bf16_t* __restrict__ A, long lda, int arow0, int arows, const bf16_t* __restrict__ B,
                                              long ldb, int brow0, int brows, int K, char* smem, f4v (&acc)[2][NJ]) {
  GT t = mk_gt(A, lda, arow0, arows, B, ldb, brow0, brows, K, BT ? 1 : 0);
  u4v ra[2], rb[NJ / 2];
  gemm_prefetch<NJ>(t, ra, rb);
  gemm_run<NJ, BT>(t, nullptr, ra, rb, smem, acc);
}

template <int NJ, class F>
__device__ __forceinline__ void epi_foreach(f4v (&acc)[2][NJ], int row0, int col0, F f) {
  const int tid = my_tid(), lane = tid & 63, wid = tid >> 6, wm = wid >> 1, wn = wid & 1;
#pragma unroll
  for (int i = 0; i < 2; ++i)
#pragma unroll
    for (int j = 0; j < NJ; ++j) f(row0 + wm * 32 + i * 16 + (lane & 15), col0 + wn * NJ * 16 + j * 16 + (lane >> 4) * 4, acc[i][j]);
}
__device__ __forceinline__ u4v pack8(const float (&x)[8]) {
  return u4v{pk2bf(x[0], x[1]), pk2bf(x[2], x[3]), pk2bf(x[4], x[5]), pk2bf(x[6], x[7])};
}
__device__ __forceinline__ void unpack8(u4v u, float (&x)[8]) {
  x[0] = bflo(u.x); x[1] = bfhi(u.x); x[2] = bflo(u.y); x[3] = bfhi(u.y); x[4] = bflo(u.z); x[5] = bfhi(u.z); x[6] = bflo(u.w); x[7] = bfhi(u.w);
}
__device__ __forceinline__ u2v pack4(float a, float b, float c, float d) {
  return u2v{pk2bf(a, b), pk2bf(c, d)};
}

#ifndef EMU
namespace pg8 {
#define PG8_LAS __attribute__((address_space(3)))
typedef unsigned short bf16_t;
typedef short bf16x8 __attribute__((ext_vector_type(8)));
typedef float f32x4 __attribute__((ext_vector_type(4)));
typedef unsigned u32x4 __attribute__((ext_vector_type(4)));
constexpr int BM = 256, BK = 64, HALF = 128, HTB = HALF * BK * 2  , STAGE_BYTES = 8 * HTB, NXCD = 8, WGM = 8;

__host__ __device__ __forceinline__ int lds_byte(int r, int c) { const int st = (r >> 4) * 2 + (c >> 5), rr = r & 15, cc = c & 31, ob = rr * 64 + cc * 2; return st * 1024 + (ob ^ (((ob >> 9) & 1) << 5)); }
__host__ __device__ __forceinline__ void stage_rc(int b, int& R, int& C) { const int st = b / 1024, sb = b % 1024, swz = sb ^ (((sb >> 9) & 1) << 5); R = (st >> 1) * 16 + swz / 64; C = (st & 1) * 32 + (swz % 64) / 2; }
__host__ __device__ __forceinline__ int perm32(int rho) { const int n = rho >> 4, i = rho & 15; return 8 * (i >> 2) + 4 * n + (i & 3); }

struct Unit { int pm, pn; };
struct Gemm { const bf16_t* A; const bf16_t* Bt; int M, N, K; };

struct StaticOrder {
    int nM, nN, nwg, G, c;
    __host__ __device__ void init(int M, int N, int G_, int c_) { nM = M / BM; nN = N / BM; nwg = nM * nN; G = G_; c = c_; }
    __host__ __device__ bool next(int i, Unit& u) const {
        const long L = (long)i * G + c; if (L >= nwg) return false;
        int wgid = (int)L; { const int q = nwg / NXCD, r = nwg % NXCD, xcd = wgid % NXCD, off = wgid / NXCD; wgid = (xcd < r ? xcd * (q + 1) : r * (q + 1) + (xcd - r) * q) + off; }
        const int nig = WGM * nN, gid = wgid / nig, fm = gid * WGM, gsz = (nM - fm) < WGM ? (nM - fm) : WGM;
        u.pm = fm + ((wgid % nig) % gsz); u.pn = (wgid % nig) / gsz; return true;
    }
    __device__ __forceinline__ void a_ready(const Unit&) const {}
    __device__ __forceinline__ void done(const Unit&) const {}
};
template <class Epi, class Sched>
__device__ __forceinline__ void gemm_phase(PG8_LAS unsigned char* lds, const Gemm g, const Sched& S, const Epi& E) {
    const int tid = my_tid(), wid = __builtin_amdgcn_readfirstlane(tid >> 6), lane = tid & 63, wr = wid >> 2, wc = wid & 3, fr = lane & 15, fq = lane >> 4;
    const int K = g.K, nt = K / BK;
    unsigned voffA[2], voffB[2];
#pragma unroll
    for (int i = 0; i < 2; ++i) { int R, C; stage_rc(tid * 16 + i * 8192, R, C); const int Rb = Epi::PERM ? ((R & ~31) + perm32(R & 31)) : R;
        voffA[i] = (unsigned)(R * K + C) * 2u; voffB[i] = (unsigned)(Rb * K + C) * 2u; }
    const size_t kstep = (size_t)(BK * 2);
    const size_t hstep = (size_t)HALF * K * 2;
    const size_t tstep = 2 * hstep;
    const unsigned ldsw = (unsigned)wid * 1024u;
    const int aoff = lds_byte(wr * 64 + fr, fq * 8), boff = lds_byte(wc * 32 + fr, fq * 8);
#define PG8_SA(b, h) (((b) * 2 + (h)) * HTB)
#define PG8_SB(b, h) ((4 + (b) * 2 + (h)) * HTB)
#define PG8_STAGE(bufoff, gbase, voff) do { _Pragma("unroll") for (int _i = 0; _i < 2; ++_i) \
        __builtin_amdgcn_global_load_lds((const unsigned*)((const char*)(gbase) + (voff)[_i]), (PG8_LAS unsigned*)(lds + (bufoff) + ldsw + _i * 8192), 16, 0, 0); } while (0)
#define PG8_LDA(dst, b, h) do { _Pragma("unroll") for (int m = 0; m < 4; ++m) _Pragma("unroll") for (int k = 0; k < 2; ++k) dst[m][k] = *(const PG8_LAS bf16x8*)(lds + PG8_SA(b, h) + aoff + m * 2048 + k * 1024); } while (0)
#define PG8_LDB(dst, b, h) do { _Pragma("unroll") for (int n = 0; n < 2; ++n) _Pragma("unroll") for (int k = 0; k < 2; ++k) dst[n][k] = *(const PG8_LAS bf16x8*)(lds + PG8_SB(b, h) + boff + n * 2048 + k * 1024); } while (0)
#define PG8_MMA(ai, bj, At, Bt) do { __builtin_amdgcn_s_setprio(1); _Pragma("unroll") for (int m = 0; m < 4; ++m) _Pragma("unroll") for (int n = 0; n < 2; ++n) _Pragma("unroll") for (int k = 0; k < 2; ++k) \
        acc[ai][bj][m][n] = __builtin_amdgcn_mfma_f32_16x16x32_bf16(Bt[n][k], At[m][k], acc[ai][bj][m][n], 0, 0, 0); __builtin_amdgcn_s_setprio(0); } while (0)
#define PG8_WAIT_V(n) asm volatile("s_waitcnt vmcnt(" #n ")" ::: "memory")
#define PG8_WAIT_L(n) asm volatile("s_waitcnt lgkmcnt(" #n ")" ::: "memory")
#define PG8_BAR __builtin_amdgcn_s_barrier()
#define PG8_SCHED __builtin_amdgcn_sched_barrier(0)
    Unit cur, nxt; int ui = 0;
    if (!S.next(0, cur)) return;
    f32x4 acc[2][2][4][2];
#pragma unroll
    for (int a = 0; a < 2; ++a)
#pragma unroll
        for (int b = 0; b < 2; ++b)
#pragma unroll
            for (int m = 0; m < 4; ++m)
#pragma unroll
                for (int n = 0; n < 2; ++n) acc[a][b][m][n] = (f32x4){0.f, 0.f, 0.f, 0.f};
    bf16x8 At[4][2], B0[2][2], B1[2][2];
    const char* cA = (const char*)g.A + (size_t)cur.pm * tstep; const char* cB = (const char*)g.Bt + (size_t)cur.pn * tstep;
    S.a_ready(cur);
    PG8_STAGE(PG8_SB(0, 0), cB, voffB); PG8_STAGE(PG8_SA(0, 0), cA, voffA); PG8_STAGE(PG8_SB(0, 1), cB + hstep, voffB); PG8_STAGE(PG8_SA(0, 1), cA + hstep, voffA);
    if (wr == 1) PG8_BAR;
    PG8_WAIT_V(4); PG8_BAR;
    PG8_STAGE(PG8_SB(1, 0), cB + kstep, voffB); PG8_STAGE(PG8_SA(1, 0), cA + kstep, voffA); PG8_STAGE(PG8_SB(1, 1), cB + hstep + kstep, voffB);
    PG8_WAIT_V(6); PG8_BAR;
    for (;;) {
        const bool has_next = S.next(ui + 1, nxt);
        const char* nA = has_next ? (const char*)g.A + (size_t)nxt.pm * tstep : cA; const char* nB = has_next ? (const char*)g.Bt + (size_t)nxt.pn * tstep : cB;
        for (int t = 0; t < nt; t += 2) {
            const bool last = (t == nt - 2);
            const char* a1 = cA + (size_t)(t + 1) * kstep;
            const char* a2 = last ? nA : cA + (size_t)(t + 2) * kstep; const char* b2 = last ? nB : cB + (size_t)(t + 2) * kstep;
            const char* a3 = a2 + kstep; const char* b3 = b2 + kstep;
            if (last && has_next) S.a_ready(nxt);
            PG8_LDB(B0, 0, 0); PG8_SCHED; PG8_LDA(At, 0, 0); PG8_STAGE(PG8_SA(1, 1), a1 + hstep, voffA);
            PG8_WAIT_L(8); PG8_BAR; PG8_WAIT_L(0); PG8_MMA(0, 0, At, B0); PG8_BAR; PG8_SCHED;
            PG8_LDB(B1, 0, 1); PG8_STAGE(PG8_SB(0, 0), b2, voffB);
            PG8_BAR; PG8_WAIT_L(0); PG8_MMA(0, 1, At, B1); PG8_BAR;
            PG8_LDA(At, 0, 1); PG8_STAGE(PG8_SA(0, 0), a2, voffA);
            PG8_BAR; PG8_WAIT_L(0); PG8_MMA(1, 0, At, B0); PG8_BAR; PG8_SCHED;
            PG8_STAGE(PG8_SB(0, 1), b2 + hstep, voffB);
            PG8_WAIT_V(6); PG8_BAR; PG8_MMA(1, 1, At, B1); PG8_BAR;
            PG8_LDB(B0, 1, 0); PG8_SCHED; PG8_LDA(At, 1, 0); PG8_STAGE(PG8_SA(0, 1), a2 + hstep, voffA);
            PG8_WAIT_L(8); PG8_BAR; PG8_WAIT_L(0); PG8_MMA(0, 0, At, B0); PG8_BAR; PG8_SCHED;
            PG8_LDB(B1, 1, 1); PG8_STAGE(PG8_SB(1, 0), b3, voffB);
            PG8_BAR; PG8_WAIT_L(0); PG8_MMA(0, 1, At, B1); PG8_BAR;
            PG8_LDA(At, 1, 1); PG8_STAGE(PG8_SA(1, 0), a3, voffA);
            PG8_BAR; PG8_WAIT_L(0); PG8_MMA(1, 0, At, B0); PG8_BAR; PG8_SCHED;
            PG8_STAGE(PG8_SB(1, 1), b3 + hstep, voffB);
            PG8_WAIT_V(6); PG8_BAR; PG8_MMA(1, 1, At, B1); PG8_BAR;
        }
            if constexpr (!Epi::AFTER_DRAIN) { E(acc, cur, wr, wc, fr, fq); S.done(cur); }
            if (!has_next) break;
#pragma unroll
        for (int a = 0; a < 2; ++a)
#pragma unroll
            for (int b = 0; b < 2; ++b)
#pragma unroll
                for (int m = 0; m < 4; ++m)
#pragma unroll
                    for (int n = 0; n < 2; ++n) acc[a][b][m][n] = (f32x4){0.f, 0.f, 0.f, 0.f};
        cur = nxt; cA = nA; cB = nB; ++ui;
    }
    PG8_WAIT_V(0);
    if (wr == 0) PG8_BAR;
    PG8_BAR;
    if constexpr (Epi::AFTER_DRAIN) { E.fused(acc, cur, wr, wc, fr, fq, lds, wid, lane); S.done(cur); }
#undef PG8_SA
#undef PG8_SB
#undef PG8_STAGE
#undef PG8_LDA
#undef PG8_LDB
#undef PG8_MMA
#undef PG8_WAIT_V
#undef PG8_WAIT_L
#undef PG8_BAR
#undef PG8_SCHED
}

__device__ __forceinline__ unsigned pk2(float lo, float hi) { return pk2bf(lo, hi); }
struct EpiStore {
  static constexpr bool PERM = true, AFTER_DRAIN = false;
  bf16_t* O; int ldc; int ncols;
  __device__ __forceinline__ void operator()(const f32x4 (&acc)[2][2][4][2], const Unit& u, int wr, int wc, int fr, int fq) const {
    const int row0 = u.pm * BM + wr * 64 + fr, col0 = u.pn * BM + wc * 32 + 8 * fq;
#pragma unroll
    for (int ai = 0; ai < 2; ++ai)
#pragma unroll
      for (int m = 0; m < 4; ++m) { bf16_t* rowp = O + (size_t)(row0 + ai * HALF + m * 16) * ldc + col0;
#pragma unroll
        for (int bj = 0; bj < 2; ++bj) if (col0 + bj * HALF < ncols) { const f32x4 v0 = acc[ai][bj][m][0], v1 = acc[ai][bj][m][1];
          *(u32x4*)(rowp + bj * HALF) = (u32x4){pk2(v0[0], v0[1]), pk2(v0[2], v0[3]), pk2(v1[0], v1[1]), pk2(v1[2], v1[3])}; } }
  }
};
struct EpiSigmoid {
  static constexpr bool PERM = true, AFTER_DRAIN = false;
  bf16_t* O; int ldc; const float* bias;
  __device__ __forceinline__ void operator()(const f32x4 (&acc)[2][2][4][2], const Unit& u, int wr, int wc, int fr, int fq) const {
    const int row0 = u.pm * BM + wr * 64 + fr, col0 = u.pn * BM + wc * 32 + 8 * fq;
    f32x4 bv[2][2];
#pragma unroll
    for (int bj = 0; bj < 2; ++bj)
#pragma unroll
      for (int n = 0; n < 2; ++n) bv[bj][n] = *(const f32x4*)(bias + col0 + bj * HALF + 4 * n);
#pragma unroll
    for (int ai = 0; ai < 2; ++ai)
#pragma unroll
      for (int m = 0; m < 4; ++m) { bf16_t* rowp = O + (size_t)(row0 + ai * HALF + m * 16) * ldc + col0;
#pragma unroll
        for (int bj = 0; bj < 2; ++bj) { const f32x4 v0 = acc[ai][bj][m][0] + bv[bj][0], v1 = acc[ai][bj][m][1] + bv[bj][1];
          *(u32x4*)(rowp + bj * HALF) = (u32x4){pk2(sigmoidf_(v0[0]), sigmoidf_(v0[1])), pk2(sigmoidf_(v0[2]), sigmoidf_(v0[3])), pk2(sigmoidf_(v1[0]), sigmoidf_(v1[1])), pk2(sigmoidf_(v1[2]), sigmoidf_(v1[3]))}; } }
  }
};
}
#endif

struct TJob { const float* src; int K, N; long lds; bf16_t* dst; long ldd; };
__device__ __forceinline__ TJob get_tjob(const Params& p, int l, int j) {
  TJob t; char* ws = p.ws;
  if (j == 0) { t.src = p.w_in + (size_t)l * 1024 * IN_W; t.K = 1024; t.N = IN_W; t.lds = IN_W; t.dst = (bf16_t*)(ws + O_WINT); t.ldd = 1024; }
  else if (j == 1) { t.src = p.w_merge + (size_t)l * 1024 * 4096; t.K = 1024; t.N = 4096; t.lds = 4096; t.dst = (bf16_t*)(ws + O_WMT); t.ldd = 1024; }
  else if (j < 6) { int n = j - 2; t.src = p.w_branch + ((size_t)l * 4 + n) * 512 * 1024; t.K = 512; t.N = 1024; t.lds = 1024; t.dst = (bf16_t*)(ws + O_WBRT) + (size_t)n * 1024 * 512; t.ldd = 512; }
  else if (j == 6) { t.src = p.w_out + (size_t)l * 1024 * 1024; t.K = 1024; t.N = 1024; t.lds = 1024; t.dst = (bf16_t*)(ws + O_WOUTT); t.ldd = 1024; }
  else if (j == 7) { t.src = p.w_q_up + (size_t)l * 256 * 768; t.K = 256; t.N = 768; t.lds = 768; t.dst = (bf16_t*)(ws + O_WQT); t.ldd = 256; }
  else if (j == 8) { t.src = p.w_kv_up + (size_t)l * 128 * 1024; t.K = 128; t.N = 1024; t.lds = 1024; t.dst = (bf16_t*)(ws + O_WKVT); t.ldd = 128; }
  else { int n = j - 9;
    t.src = (n < 2 ? p.w_up : p.a_up) + ((size_t)l * 2 + (n & 1)) * 64 * 512; t.K = 64; t.N = 512; t.lds = 512;
    t.dst = (bf16_t*)(ws + O_WUPT) + (size_t)n * 512 * 64; t.ldd = 64; }
  return t;
}
constexpr int NTJOBS = 13;

__device__ __forceinline__ void stage_prep(const Params& p, int l, int bid, int nb, char* smem) {
  const int tid = my_tid();
  char* ws = p.ws;
  {
    float* tile = (float*)smem;
    int base = 0;
    for (int j = 0; j < NTJOBS; ++j) {
      TJob t = get_tjob(p, l, j);
      int tk = t.K / 64, tn = (t.N + 63) / 64, nt = tk * tn;
      int first = ((bid - base % nb) % nb + nb) % nb;
      for (int q = first; q < nt; q += nb) {
        int kt = q / tn, nt_ = q % tn;
        __syncthreads();
#pragma unroll
        for (int i = 0; i < 2; ++i) { int e = tid + NTHR * i, r = e >> 4, c4 = e & 15; int n0 = nt_ * 64 + c4 * 4;
          if (n0 < t.N) { f4v x = *(const f4v*)(t.src + (long)(kt * 64 + r) * t.lds + n0);
            tile[r * 65 + c4 * 4] = x[0]; tile[r * 65 + c4 * 4 + 1] = x[1]; tile[r * 65 + c4 * 4 + 2] = x[2]; tile[r * 65 + c4 * 4 + 3] = x[3]; } }
        __syncthreads();
        { int n = tid >> 3, kc = tid & 7; float x[8];
          if (nt_ * 64 + n < t.N) {
#pragma unroll
            for (int e = 0; e < 8; ++e) x[e] = tile[(kc * 8 + e) * 65 + n];
            *(u4v*)(t.dst + (long)(nt_ * 64 + n) * t.ldd + kt * 64 + kc * 8) = pack8(x); } }
      }
      base += nt;
    }
    __syncthreads();
  }
  const long gtid = (long)bid * NTHR + tid, gn = (long)nb * NTHR;
  { bf16_t* d = (bf16_t*)(ws + O_WINT) + (size_t)IN_W * 1024; for (long i = gtid; i < (long)(IN_WP - IN_W) * 1024; i += gn) d[i] = 0; }
  { bf16_t* d = (bf16_t*)(ws + O_WS); const float* s = p.g_w_s + (size_t)l * 4 * 128 * 128; for (long i = gtid; i < (long)4 * 128 * 128; i += gn) d[i] = f2bf(s[i]); }
  if (l != 0) return;
  { bf16_t* d = (bf16_t*)(ws + O_CS128);
    for (long i = gtid; i < 256 * 128; i += gn) { int j = (int)(i >> 7), c = (int)(i & 127); int mm = ((j & 127) * c) & 127; float x = 2.0f * mm / 128.f; d[i] = f2bf(j < 128 ? cospif(x) : sinpif(x)); } }
  { bf16_t* d = (bf16_t*)(ws + O_A2C);
    for (long i = gtid; i < (long)T_C * 2 * T_C; i += gn) { int tp = (int)(i / (2 * T_C)), tt = (int)(i % (2 * T_C)); int half = tt >= T_C; int t = half ? tt - T_C : tt; int mm = (int)(((long)tp * t) % T_C); float x = 2.0f * mm / (float)T_C; d[i] = f2bf(half ? -sinpif(x) : cospif(x)); } }
  { bf16_t* d = (bf16_t*)(ws + O_A2D);
    for (long i = gtid; i < (long)T_D * 2 * T_D; i += gn) { int tp = (int)(i / (2 * T_D)), tt = (int)(i % (2 * T_D)); int half = tt >= T_D; int t = half ? tt - T_D : tt; int mm = (int)(((long)tp * t) % T_D); float x = 2.0f * mm / (float)T_D; d[i] = f2bf(half ? -sinpif(x) : cospif(x)); } }
  { float* d = (float*)(ws + O_ROPE);
    for (long i = gtid; i < (long)T_D * 16; i += gn) { int t = (int)(i >> 4), pi = (int)(i & 15); float pos = (pi < 8) ? (float)(t / 64) : (float)(t % 64); float inv = expf(-(float)(pi & 7) * (9.210340371976184f / 8.f)); float a = pos * inv; d[2 * i] = cosf(a); d[2 * i + 1] = sinf(a); } }
  { float4* d = (float4*)p.out; const float4* s0 = (const float4*)p.x_prompt; const float4* s1 = (const float4*)p.x_sample;
    for (long i = gtid; i < (long)M * 256; i += gn) d[i] = (i < (long)M_C * 256) ? s0[i] : s1[i - (long)M_C * 256]; }
  {
    float* sc = (float*)smem;
    float* red = sc + 3 * 1024;
    float* modp = (float*)(ws + O_MOD);
    if (bid < NL * 96) {
      __syncthreads();
      for (int i = tid; i < 3 * 1024; i += NTHR) { int mi = i >> 10, k = i & 1023; sc[i] = siluf_(mi == 0 ? p.c_ctx[k] : p.c[(mi == 2 && NB_D > 1 ? 1024 : 0) + k]); }
      __syncthreads();
    }
    for (int u = bid; u < NL * 96; u += nb) {
      int ll = u / 96, cg = u % 96; int cl = tid & 31, kq = tid >> 5, col = cg * 32 + cl;
      float a0 = 0.f, a1 = 0.f, a2 = 0.f;
      const float* w = p.w_ada + (size_t)ll * 1024 * 3072 + col;
#pragma unroll 16
      for (int k = kq * 64; k < kq * 64 + 64; ++k) {
        float wv = w[(size_t)k * 3072];
        a0 += sc[k] * wv; a1 += sc[1024 + k] * wv; a2 += sc[2048 + k] * wv;
      }
      __syncthreads();
      red[(kq * 3 + 0) * 32 + cl] = a0; red[(kq * 3 + 1) * 32 + cl] = a1; red[(kq * 3 + 2) * 32 + cl] = a2;
      __syncthreads();
      if (tid < 96) { int mi = tid >> 5, cc = tid & 31; float s2 = 0.f;
#pragma unroll
        for (int q8 = 0; q8 < 16; ++q8) s2 += red[(q8 * 3 + mi) * 32 + cc];
        modp[((size_t)ll * 3 + mi) * 3072 + cg * 32 + cc] = s2 + p.b_ada[(size_t)ll * 3072 + cg * 32 + cc]; }
    }
  }
}

__device__ __forceinline__ int mod_index(const Grp& g, int lm) { return g.isden ? 1 + lm / T_D : 0; }

__device__ __forceinline__ void stage_h(const Params& p, const Grp& g, int l, int bid, int nb) {
  const int lane = my_tid() & 63, wid = my_tid() >> 6;
  const float* X = p.out + (size_t)g.m0 * 1024;
  bf16_t* H = (bf16_t*)(p.ws + O_H);
  const float* modp = (const float*)(p.ws + O_MOD) + (size_t)l * 3 * 3072;
  const float* gam = p.norm_g + (size_t)l * 1024;
  for (int m = bid * NWAVE + wid; m < g.mg; m += nb * NWAVE) {
    const float* xr = X + (size_t)m * 1024; float v[16]; float ss = 0.f;
#pragma unroll
    for (int i = 0; i < 4; ++i) { float4 q = *(const float4*)(xr + i * 256 + lane * 4); v[4 * i] = q.x; v[4 * i + 1] = q.y; v[4 * i + 2] = q.z; v[4 * i + 3] = q.w; ss += q.x * q.x + q.y * q.y + q.z * q.z + q.w * q.w; }
    ss = wave_sum(ss); float rs = rsqrtf(ss * (1.f / 1024.f) + 1e-6f);
    const float* mo = modp + (size_t)mod_index(g, m) * 3072;
#pragma unroll
    for (int i = 0; i < 4; ++i) {
      int c = i * 256 + lane * 4; bf16_t o[4];
#pragma unroll
      for (int e = 0; e < 4; ++e) o[e] = f2bf(v[4 * i + e] * rs * gam[c + e] * (1.f + mo[1024 + c + e]) + mo[c + e]);
      *(u2v*)(H + (size_t)m * 1024 + c) = u2v{(unsigned)o[0] | ((unsigned)o[1] << 16), (unsigned)o[2] | ((unsigned)o[3] << 16)};
    }
  }
}

__device__ __forceinline__ void stage_g1(const Params& p, const Grp& g, int bid, int nb, char* smem) {
  const bf16_t* H = (const bf16_t*)(p.ws + O_H);
  const bf16_t* W = (const bf16_t*)(p.ws + O_WINT);
  bf16_t* Z = (bf16_t*)(p.ws + O_Z);
#ifndef EMU
  if ((g.mg & 255) == 0) {
    pg8::Gemm gm; gm.A = H; gm.Bt = W; gm.M = g.mg; gm.N = IN_WP; gm.K = 1024;
    pg8::StaticOrder S; S.init(gm.M, gm.N, nb, bid);
    pg8::EpiStore E; E.O = Z; E.ldc = IN_W; E.ncols = IN_W;
    pg8::gemm_phase<pg8::EpiStore, pg8::StaticOrder>((PG8_LAS unsigned char*)smem, gm, S, E);
    return;
  }
#endif
  const int TM = (g.mg + 127) / 128; constexpr int TN = (IN_W + 127) / 128;
  const int mg = g.mg;
  for (int t = bid; t < TM * TN; t += nb) {
    int tn = t / TM, tm = t % TM; f4v acc[2][4]; zero_acc<4>(acc);
    gemm_mainloop<4>(H, 1024, tm * 128, mg, W, 1024, tn * 128, IN_W, 1024, smem, acc);
    epi_foreach<4>(acc, tm * 128, tn * 128, [&](int row, int c0, f4v& v) {
      if (c0 < IN_W && row < mg) *(u2v*)(Z + (size_t)row * IN_W + c0) = pack4(v[0], v[1], v[2], v[3]);
    });
  }
}

__device__ __forceinline__ void stage_e1(const Params& p, const Grp& g, int l, int bid, int nb) {
  const int lane = my_tid() & 63, wid = my_tid() >> 6;
  char* ws = p.ws;
  const bf16_t* Z = (const bf16_t*)(ws + O_Z);
  bf16_t* SK = (bf16_t*)(ws + O_SK); bf16_t* SOP = (bf16_t*)(ws + O_SOP);
  bf16_t* LORA = (bf16_t*)(ws + O_LORA); bf16_t* QDN = (bf16_t*)(ws + O_QDN); bf16_t* CKV = (bf16_t*)(ws + O_CKV); bf16_t* KR = (bf16_t*)(ws + O_KR);
  bf16_t* VCN = (bf16_t*)(ws + O_VCNT);
  const float* rope = (const float*)(ws + O_ROPE);
  const float* mu = p.shift_mu + (size_t)l * SHIFT_W;
  const int isden = g.isden, T = g.T;
  for (int m = bid * NWAVE + wid; m < g.mkv; m += nb * NWAVE) {
    if (m >= g.mg) {
      int r = m - g.mg, b = r / PAST, j = r % PAST;
      if (lane < 20) {
        const float* s = lane < 16 ? p.c_ckv + (((size_t)b * NL + l) * PAST + j) * 128 + lane * 8 : p.c_kr + (((size_t)b * NL + l) * PAST + j) * 32 + (lane - 16) * 8;
        f4v x0 = *(const f4v*)s, x1 = *(const f4v*)(s + 4); float x[8] = {x0[0], x0[1], x0[2], x0[3], x1[0], x1[1], x1[2], x1[3]};
        if (lane < 16) *(u4v*)(CKV + (size_t)m * 128 + lane * 8) = pack8(x);
        else { const int key = T + j, d8 = lane - 16;
          *(u4v*)(KR + ((((size_t)b * (g.nkeys >> 5) + (key >> 5)) * 2 + (d8 >> 1)) * 64 + (d8 & 1) * 32 + (key & 31)) * 8) = pack8(x); }
      }
      continue;
    }
    const int sq = m / T, t = m % T, b = g.b0 + sq;
    const bf16_t* z = Z + (size_t)m * IN_W;
    const bool hp = t > 0, hn = t < T - 1;
#pragma unroll
    for (int it = 0; it < 4; ++it) {
      const int ci = it * 64 + lane; const bool valid = ci < 216; const int cc = valid ? ci : 0;
      float zc[8], pv[8], nv[8], sf[8];
      unpack8(*(const u4v*)(z + cc * 8), zc);
      if (hp) unpack8(*(const u4v*)(z - IN_W + cc * 8), pv); else { for (int e = 0; e < 8; ++e) pv[e] = 0.f; }
      if (hn) unpack8(*(const u4v*)(z + IN_W + cc * 8), nv); else { for (int e = 0; e < 8; ++e) nv[e] = 0.f; }
      f4v m0 = *(const f4v*)(mu + cc * 8), m1 = *(const f4v*)(mu + cc * 8 + 4);
#pragma unroll
      for (int e = 0; e < 8; ++e) sf[e] = zc[e] + (0.5f * (pv[e] + nv[e]) - zc[e]) * (e < 4 ? m0[e] : m1[e - 4]);
      bf16_t* rec = SOP + (((size_t)sq * 8 + (lane >> 3)) * T + t) * 576 + (lane & 7) * 8;
      if (it == 0) *(u4v*)rec = pack8(sf);
      else if (it == 1) {
        *(u4v*)(SK + (size_t)m * 512 + lane * 8) = pack8(sf);
        f4v k0 = *(const f4v*)(p.k_k + (size_t)l * 512 + lane * 8), k1 = *(const f4v*)(p.k_k + (size_t)l * 512 + lane * 8 + 4);
        float kr[8]; float n2 = 0.f;
#pragma unroll
        for (int e = 0; e < 8; ++e) { kr[e] = sf[e] * (e < 4 ? k0[e] : k1[e - 4]); n2 += kr[e] * kr[e]; }
        n2 = sum_lpr<8>(n2); const float inv = 1.f / fmaxf(sqrtf(n2), 1e-12f);
#pragma unroll
        for (int e = 0; e < 8; ++e) kr[e] *= inv;
        *(u4v*)(rec + 64) = pack8(kr);
      }
      else if (it == 2) *(u4v*)(rec + 128) = pack8(sf);
      else if (valid) {
        if (lane < 16) { for (int e = 0; e < 8; ++e) sf[e] = tanhf_(sf[e]); }
        *(u4v*)(LORA + (size_t)m * 192 + lane * 8) = pack8(sf);
      }
    }
    {
      const int col = lane < 32 ? ZC_QD + lane * 8 : (lane < 48 ? ZC_KVD + (lane - 32) * 8 : ZC_KR + ((lane - 48) & 3) * 8);
      float x[8]; unpack8(*(const u4v*)(z + col), x);
      float ss = 0.f;
#pragma unroll
      for (int e = 0; e < 8; ++e) ss += x[e] * x[e];
      const float t32 = sum_lpr<32>(ss), t16 = sum_lpr<16>(ss);
      if (lane < 32) {
        const float rs = rsqrtf(t32 * (1.f / 256.f) + 1e-6f); const float* gq = p.q_norm + (size_t)l * 256 + lane * 8; float o[8];
#pragma unroll
        for (int e = 0; e < 8; ++e) o[e] = x[e] * rs * gq[e];
        *(u4v*)(QDN + (size_t)m * 256 + lane * 8) = pack8(o);
      } else if (lane < 48) {
        const float rs = rsqrtf(t16 * (1.f / 128.f) + 1e-6f); const float* gk = p.kv_norm + (size_t)l * 128 + (lane - 32) * 8; float o[8];
#pragma unroll
        for (int e = 0; e < 8; ++e) o[e] = x[e] * rs * gk[e];
        *(u4v*)(CKV + (size_t)m * 128 + (lane - 32) * 8) = pack8(o);
        if (!isden) { float* op = p.out + OUT_CKV + (((size_t)b * NL + l) * T_C + t) * 128 + (lane - 32) * 8; *(f4v*)op = f4v{o[0], o[1], o[2], o[3]}; *(f4v*)(op + 4) = f4v{o[4], o[5], o[6], o[7]}; }
      } else if (lane < 52) {
        float o[8];
        if (isden) {
#pragma unroll
          for (int pq = 0; pq < 4; ++pq) { int pi = (lane - 48) * 4 + pq; float cs = rope[((size_t)t * 16 + pi) * 2], sn = rope[((size_t)t * 16 + pi) * 2 + 1];
            o[2 * pq] = x[2 * pq] * cs - x[2 * pq + 1] * sn; o[2 * pq + 1] = x[2 * pq] * sn + x[2 * pq + 1] * cs; }
        } else {
#pragma unroll
          for (int e = 0; e < 8; ++e) o[e] = x[e];
          float* op = p.out + OUT_KR + (((size_t)b * NL + l) * T_C + t) * 32 + (lane - 48) * 8; *(f4v*)op = f4v{x[0], x[1], x[2], x[3]}; *(f4v*)(op + 4) = f4v{x[4], x[5], x[6], x[7]};
        }
        { const int d8 = lane - 48; *(u4v*)(KR + ((((size_t)sq * (g.nkeys >> 5) + (t >> 5)) * 2 + (d8 >> 1)) * 64 + (d8 & 1) * 32 + (t & 31)) * 8) = pack8(o); }
      }
    }
    {
      float v[8]; unpack8(*(const u4v*)(z + ZC_VC + lane * 8), v);
      float s1 = 0.f;
#pragma unroll
      for (int e = 0; e < 8; ++e) { v[e] = geluf_(v[e]); s1 += v[e]; }
      s1 = wave_sum(s1); const float mean = s1 * (1.f / 512.f); float s2 = 0.f;
#pragma unroll
      for (int e = 0; e < 8; ++e) { float d = v[e] - mean; s2 += d * d; }
      s2 = wave_sum(s2); const float rs = rsqrtf(s2 * (1.f / 512.f) + 1e-5f);
      const float* gg = p.g_ln_g + (size_t)l * 512 + lane * 8; const float* gb = p.g_ln_b + (size_t)l * 512 + lane * 8;
#pragma unroll
      for (int e = 0; e < 8; ++e) v[e] = (v[e] - mean) * rs * gg[e] + gb[e];
      *(u4v*)(VCN + (size_t)m * 512 + lane * 8) = pack8(v);
    }
  }
}

__device__ __forceinline__ void stage_g2(const Params& p, const Grp& g, int l, int bid, int nb, char* smem) {
  char* ws = p.ws;
  const bf16_t* Z = (const bf16_t*)(ws + O_Z);
  const float* rope = (const float*)(ws + O_ROPE);
  const int mg = g.mg, mkv = g.mkv, T = g.T, isden = g.isden, nkeys = g.nkeys;
  const int TM_M = (mg + 127) / 128, TM_KV = (mkv + 127) / 128;
  const int NT_Q = TM_M * 6, NT_KV = TM_KV * 8, NT_LORA = TM_M * 8, NT_GM = (mg / 128) * 8, ntt = T / 128, NT_D1 = g.nseq * 8 * ntt;
  const int NT = NT_Q + NT_KV + NT_LORA + NT_GM + NT_D1;
  for (int t0 = bid; t0 < NT; t0 += nb) {
    int t = t0; f4v acc[2][4]; zero_acc<4>(acc);
    if (t < NT_Q) {
      int tn = t / TM_M, tm = t % TM_M;
      gemm_mainloop<4>((const bf16_t*)(ws + O_QDN), 256, tm * 128, mg, (const bf16_t*)(ws + O_WQT), 256, tn * 128, 768, 256, smem, acc);
      bf16_t* Q = (bf16_t*)(ws + O_Q);
      const float scale = 0.10206207261596575f * 1.4426950408889634f;
      epi_foreach<4>(acc, tm * 128, tn * 128, [&](int row, int c0, f4v& v) {
        if (row >= mg) return;
        int cw = c0 % 96; float o0 = v[0], o1 = v[1], o2 = v[2], o3 = v[3];
        if (cw >= 64 && isden) { int tt = row % T_D; int pi = (cw - 64) >> 1; const float* rp = rope + ((size_t)tt * 16 + pi) * 2;
          float c_a = rp[0], s_a = rp[1], c_b = rp[2], s_b = rp[3];
          o0 = v[0] * c_a - v[1] * s_a; o1 = v[0] * s_a + v[1] * c_a; o2 = v[2] * c_b - v[3] * s_b; o3 = v[2] * s_b + v[3] * c_b; }
        *(u2v*)(Q + (size_t)row * 768 + c0) = pack4(o0 * scale, o1 * scale, o2 * scale, o3 * scale);
      });
      continue;
    }
    t -= NT_Q;
    if (t < NT_KV) {
      int tn = t / TM_KV, tm = t % TM_KV;
      gemm_mainloop<4>((const bf16_t*)(ws + O_CKV), 128, tm * 128, mkv, (const bf16_t*)(ws + O_WKVT), 128, tn * 128, 1024, 128, smem, acc);
      bf16_t* KN = (bf16_t*)(ws + O_KN); bf16_t* VT = (bf16_t*)(ws + O_VT);
      epi_foreach<4>(acc, tm * 128, tn * 128, [&](int row, int c0, f4v& v) {
        if (row >= mkv) return;
        int h = c0 >> 7, w = c0 & 127;
        int sq, key;
        if (row < mg) { sq = row / T; key = row % T; } else { int r = row - mg; sq = r / PAST; key = T + r % PAST; }
        const int ntile = nkeys >> 5, tile = key >> 5, kq = key & 31;
        if (w < 64)
          *(u2v*)(KN + (((((size_t)sq * 8 + h) * ntile + tile) * 4 + (w >> 4)) * 64 + ((w >> 3) & 1) * 32 + kq) * 8 + (w & 7)) = pack4(v[0], v[1], v[2], v[3]);
        else {
          const int o16 = kq & 15, st = kq >> 4, hh2 = (o16 & 7) >> 2, jj = ((o16 >> 3) << 2) | (o16 & 3);
#pragma unroll
          for (int e = 0; e < 4; ++e) { const int dv = w - 64 + e;
            VT[((((((size_t)sq * 8 + h) * ntile + tile) * 2 + st) * 2 + (dv >> 5)) * 64 + hh2 * 32 + (dv & 31)) * 8 + jj] = f2bf(v[e]); } }
      });
      continue;
    }
    t -= NT_KV;
    if (t < NT_LORA) {
      int dir = t / (TM_M * 4), r = t % (TM_M * 4), tn = r / TM_M, tm = r % TM_M;
      f4v aa[2][4]; zero_acc<4>(aa);
      { GT d1 = mk_gt((const bf16_t*)(ws + O_LORA) + dir * 64, 192, tm * 128, mg, (const bf16_t*)(ws + O_WUPT) + (size_t)dir * 512 * 64, 64, tn * 128, 512, 64);
        GT d2 = mk_gt((const bf16_t*)(ws + O_LORA) + 128, 192, tm * 128, mg, (const bf16_t*)(ws + O_WUPT) + (size_t)(2 + dir) * 512 * 64, 64, tn * 128, 512, 64);
        u4v ra[2], rb[2]; gemm_prefetch<4>(d1, ra, rb);
        gemm_run<4, false>(d1, &d2, ra, rb, smem, acc);
        gemm_run<4, false>(d2, nullptr, ra, rb, smem, aa); }
      bf16_t* sW = (bf16_t*)smem; bf16_t* sA2 = sW + 128 * 136;
      __syncthreads();
      epi_foreach<4>(acc, 0, 0, [&](int row, int c0, f4v& v) { *(u2v*)(sW + row * 136 + c0) = pack4(v[0], v[1], v[2], v[3]); });
      epi_foreach<4>(aa, 0, 0, [&](int row, int c0, f4v& v) { *(u2v*)(sA2 + row * 136 + c0) = pack4(v[0], v[1], v[2], v[3]); });
      __syncthreads();
      const bf16_t* SK = (const bf16_t*)(ws + O_SK); bf16_t* SOP = (bf16_t*)(ws + O_SOP); float* BON = (float*)(ws + O_BON);
      const int tid = my_tid();
#pragma unroll 1
      for (int q4 = 0; q4 < 4; ++q4) {
        const int item = tid + NTHR * q4, rowl = item >> 4, ch8 = item & 15;
        int row = tm * 128 + rowl; const bool ok = row < mg; if (!ok) row = mg - 1;
        const int h = tn * 2 + (ch8 >> 3), chn = (ch8 & 7) * 8, c = h * 64 + chn;
        const int sq = row / T, tt = row % T;
        bf16_t* rec = SOP + (((size_t)sq * 8 + h) * T + tt) * 576;
        float pw[8], pa[8], kv[8], kkv[8], rv[8];
        unpack8(*(const u4v*)(sW + rowl * 136 + ch8 * 8), pw); unpack8(*(const u4v*)(sA2 + rowl * 136 + ch8 * 8), pa);
        unpack8(*(const u4v*)(SK + (size_t)row * 512 + c), kv); unpack8(*(const u4v*)(rec + 64 + chn), kkv); unpack8(*(const u4v*)(rec + chn), rv);
        const float* w0 = p.w0 + ((size_t)l * 2 + dir) * 512 + c; const float* a0 = p.a0 + ((size_t)l * 2 + dir) * 512 + c;
        const float* k_a = p.k_a + (size_t)l * 512 + c; const float* r_k = p.r_k + (size_t)l * 512 + c;
        float dd[8], bb[8], kt[8]; float bon = 0.f;
#pragma unroll
        for (int e = 0; e < 8; ++e) {
          dd[e] = 1.f - fexp_(-0.6065306597126334f * sigmoidf_(pw[e] + w0[e]));
          const float av = sigmoidf_(pa[e] + a0[e]);
          bb[e] = kkv[e] * av; kt[e] = kv[e] * (1.f + (av - 1.f) * k_a[e]);
          bon += rv[e] * kt[e] * r_k[e];
        }
        if (ok) { *(u4v*)(rec + (3 + 3 * dir) * 64 + chn) = pack8(dd); *(u4v*)(rec + (4 + 3 * dir) * 64 + chn) = pack8(bb); *(u4v*)(rec + (5 + 3 * dir) * 64 + chn) = pack8(kt); }
        bon = sum_lpr<8>(bon);
        if (ok && (ch8 & 7) == 0) BON[((size_t)row * 8 + h) * 2 + dir] = bon;
      }
      continue;
    }
    t -= NT_LORA;
    if (t < NT_GM) {
      int ch = t >> 3, gg = (t >> 1) & 3, dh = t & 1;
      f4v ac2[2][2]; zero_acc<2>(ac2);
      gemm_mainloop<2, true>((const bf16_t*)(ws + O_WS) + (size_t)gg * 128 * 128, 128, 0, 128, (const bf16_t*)(ws + O_VCNT) + (size_t)ch * 128 * 512, 512, gg * 128 + dh * 64, 512, 128, smem, ac2);
      bf16_t* O = (bf16_t*)(ws + O_OBR) + (size_t)2 * MG * 512;
      const float* bs = p.g_b_s + ((size_t)l * 4 + gg) * 128;
      epi_foreach<2>(ac2, 0, dh * 64, [&](int pp, int c0, f4v& v) {
        int m = ch * 128 + pp; int c = gg * 128 + c0; float bb = bs[pp];
        u2v uu = *(const u2v*)(Z + (size_t)m * IN_W + ZC_U + c), gc = *(const u2v*)(Z + (size_t)m * IN_W + ZC_GC + c);
        *(u2v*)(O + (size_t)m * 512 + c) = pack4(geluf_(bflo(uu.x)) * (v[0] + bb) * siluf_(bflo(gc.x)), geluf_(bfhi(uu.x)) * (v[1] + bb) * siluf_(bfhi(gc.x)),
                                                 geluf_(bflo(uu.y)) * (v[2] + bb) * siluf_(bflo(gc.y)), geluf_(bfhi(uu.y)) * (v[3] + bb) * siluf_(bfhi(gc.y)));
      });
      continue;
    }
    t -= NT_GM;
    {
      int per_seq = 8 * ntt; int sq = t / per_seq; int r = t % per_seq; int gg = r / (2 * ntt); int r2 = r % (2 * ntt); int tj = r2 / ntt, tt = r2 % ntt;
      long mbase = (long)sq * T;
      gemm_mainloop<4>((const bf16_t*)(ws + O_CS128), 128, tj * 128, 256, Z + (size_t)mbase * IN_W + ZC_F + gg * 128, IN_W, tt * 128, T, 128, smem, acc);
      bf16_t* YT = (bf16_t*)(ws + O_YT) + (size_t)mbase * 1024 + (size_t)gg * 128 * 2 * T;
      epi_foreach<4>(acc, tj * 128, tt * 128, [&](int j, int c0, f4v& v) {
        *(u2v*)(YT + (size_t)(j & 127) * 2 * T + (size_t)(j >> 7) * T + c0) = pack4(v[0], v[1], v[2], v[3]);
      });
    }
  }
}

__device__ __forceinline__ bool wave_any(bool pr) {
#ifdef EMU
  return wave_sum(pr ? 1.f : 0.f) > 0.f;
#else
  return __builtin_amdgcn_ballot_w64(pr) != 0ull;
#endif
}
__device__ __forceinline__ void attention_task(const Params& p, const Grp& g, int sq, int h, int qb32) {
  char* ws = p.ws;
  const int lane = my_tid() & 63, ql = lane & 31, hh = lane >> 5;
  const int T = g.T, nkeys = g.nkeys;
  const long mbase = (long)sq * T;
  const bf16_t* Q = (const bf16_t*)(ws + O_Q); const bf16_t* KN = (const bf16_t*)(ws + O_KN); const bf16_t* KRp = (const bf16_t*)(ws + O_KR);
  const int ntile = nkeys >> 5;
  const bf16_t* KFb = KN + ((size_t)sq * 8 + h) * ntile * 4 * 512 + lane * 8;
  const bf16_t* KRb = KRp + (size_t)sq * ntile * 2 * 512 + lane * 8;
  const bf16_t* VFb = (const bf16_t*)(ws + O_VT) + ((size_t)sq * 8 + h) * ntile * 4 * 512 + lane * 8;
  const long mq = mbase + qb32 * 32 + ql;
  s8v qf[6];
#pragma unroll
  for (int s = 0; s < 6; ++s) qf[s] = *(const s8v*)(Q + (size_t)mq * 768 + h * 96 + 16 * s + 8 * hh);
  f16v o0, o1;
#pragma unroll
  for (int i = 0; i < 16; ++i) { o0[i] = 0.f; o1[i] = 0.f; }
  float mrun = -1e30f, lrun = 0.f;
  s8v kfA[6], vfA[4], kfB[6], vfB[4];
#define ATT_LOAD(k0_, KF, VF) do { const int tl = (k0_) >> 5; \
    _Pragma("unroll") for (int st = 0; st < 4; ++st) KF[st] = *(const s8v*)(KFb + (size_t)(tl * 4 + st) * 512); \
    _Pragma("unroll") for (int st = 0; st < 2; ++st) KF[4 + st] = *(const s8v*)(KRb + (size_t)(tl * 2 + st) * 512); \
    _Pragma("unroll") for (int q = 0; q < 4; ++q) VF[q] = *(const s8v*)(VFb + (size_t)(tl * 4 + q) * 512); } while (0)
#define ATT_TILE(KF, VF) do { \
    f16v s; _Pragma("unroll") for (int i = 0; i < 16; ++i) s[i] = 0.f; \
    _Pragma("unroll") for (int st = 0; st < 6; ++st) s = __builtin_amdgcn_mfma_f32_32x32x16_bf16(KF[st], qf[st], s, 0, 0, 0); \
    float mx = s[0]; _Pragma("unroll") for (int i = 1; i < 16; ++i) mx = fmaxf(mx, s[i]); \
    mx = fmaxf(mx, __shfl_xor(mx, 32)); \
    if (wave_any(mx > mrun)) { const float mnew = fmaxf(mrun, mx); const float alpha = fexp2_(mrun - mnew); mrun = mnew; lrun *= alpha; \
      _Pragma("unroll") for (int i = 0; i < 16; ++i) { o0[i] *= alpha; o1[i] *= alpha; } } \
    float ps = 0.f; float pe[16]; \
    _Pragma("unroll") for (int i = 0; i < 16; ++i) { pe[i] = fexp2_(s[i] - mrun); ps += pe[i]; } \
    lrun += ps; \
    _Pragma("unroll") for (int st = 0; st < 2; ++st) { \
      const s8v pf = __builtin_bit_cast(s8v, u4v{pk2bf(pe[8 * st], pe[8 * st + 1]), pk2bf(pe[8 * st + 2], pe[8 * st + 3]), pk2bf(pe[8 * st + 4], pe[8 * st + 5]), pk2bf(pe[8 * st + 6], pe[8 * st + 7])}); \
      o0 = __builtin_amdgcn_mfma_f32_32x32x16_bf16(VF[st * 2], pf, o0, 0, 0, 0); \
      o1 = __builtin_amdgcn_mfma_f32_32x32x16_bf16(VF[st * 2 + 1], pf, o1, 0, 0, 0); } } while (0)
  ATT_LOAD(0, kfA, vfA);
  int k0 = 0;
  for (; k0 + 64 <= nkeys; k0 += 64) {
    ATT_LOAD(k0 + 32, kfB, vfB); SCHED_FENCE();
    ATT_TILE(kfA, vfA); SCHED_FENCE();
    ATT_LOAD((k0 + 64 < nkeys) ? k0 + 64 : nkeys - 32, kfA, vfA); SCHED_FENCE();
    ATT_TILE(kfB, vfB); SCHED_FENCE();
  }
  if (k0 < nkeys) ATT_TILE(kfA, vfA);
#undef ATT_LOAD
#undef ATT_TILE
  const float ltot = lrun + __shfl_xor(lrun, 32); const float inv = 1.f / ltot;
  const bf16_t* Z = (const bf16_t*)(ws + O_Z);
  bf16_t* O = (bf16_t*)(ws + O_OBR) + (size_t)1 * MG * 512;
#pragma unroll
  for (int db = 0; db < 2; ++db)
#pragma unroll
    for (int q4 = 0; q4 < 4; ++q4) {
      const int dv = db * 32 + 8 * q4 + 4 * hh;
      u2v gt = *(const u2v*)(Z + (size_t)mq * IN_W + ZC_GB + h * 64 + dv);
      const float x0 = (db == 0 ? o0[4 * q4] : o1[4 * q4]) * inv, x1 = (db == 0 ? o0[4 * q4 + 1] : o1[4 * q4 + 1]) * inv, x2 = (db == 0 ? o0[4 * q4 + 2] : o1[4 * q4 + 2]) * inv, x3 = (db == 0 ? o0[4 * q4 + 3] : o1[4 * q4 + 3]) * inv;
      *(u2v*)(O + (size_t)mq * 512 + h * 64 + dv) = pack4(x0 * siluf_(bflo(gt.x)), x1 * siluf_(bfhi(gt.x)), x2 * siluf_(bflo(gt.y)), x3 * siluf_(bfhi(gt.y)));
    }
}

__device__ __forceinline__ void stage_dft2(const Params& p, const Grp& g, int bid, int nb, char* smem) {
  char* ws = p.ws;
  const bf16_t* Z = (const bf16_t*)(ws + O_Z);
  const int T = g.T, ntt = T / 128;
  const int NT_D2 = g.nseq * 4 * ntt;
  const int soff = (g.nseq * 32) % nb;
  for (int t = (bid - soff + nb) % nb; t < NT_D2; t += nb) {
    int sq = t / (4 * ntt), r = t % (4 * ntt), gg = r / ntt, tt = r % ntt;
    long mbase = (long)sq * T;
    f4v acc[2][4]; zero_acc<4>(acc);
    { GT d = mk_gt((const bf16_t*)(ws + (g.isden ? O_A2D : O_A2C)), 2 * T, tt * 128, T, (const bf16_t*)(ws + O_YT) + (size_t)mbase * 1024 + (size_t)gg * 128 * 2 * T, 2 * T, 0, 128, 2 * T); gemm_deep<4>(d, smem, acc); }
    bf16_t* O = (bf16_t*)(ws + O_OBR) + (size_t)3 * MG * 512;
    const float sc = rsqrtf(128.f * (float)T);
    epi_foreach<4>(acc, tt * 128, 0, [&](int row, int c0, f4v& v) {
      long m = mbase + row; int c = gg * 128 + c0; u2v gd = *(const u2v*)(Z + (size_t)m * IN_W + ZC_GD + c);
      *(u2v*)(O + (size_t)m * 512 + c) = pack4(v[0] * sc * siluf_(bflo(gd.x)), v[1] * sc * siluf_(bfhi(gd.x)), v[2] * sc * siluf_(bflo(gd.y)), v[3] * sc * siluf_(bfhi(gd.y)));
    });
  }
}

constexpr int PL_STR = 72;
constexpr int PCH_MA = 0, PCH_MB = 4608, PCH_TBT = 9216, PCH_MBT = 10240, PCH_TK = 11264, PCH_MK = 12288, PCH_LDS = 13312;
__device__ __forceinline__ void pchunk_task(const Params& p, const Grp& g, int task, char* wl) {
  char* ws = p.ws;
  const int lane = my_tid() & 63, ql = lane & 31, hh = lane >> 5;
  const int T = g.T, nch = T >> 4;
  const int ch = task / nch, ci = task % nch;
  const int dir = ch & 1, h = (ch >> 1) & 7, sq = ch >> 4;
  const bf16_t* rec0 = (const bf16_t*)(ws + O_SOP) + ((size_t)sq * 8 + h) * T * 576;
  char* cm = ws + O_CM + (size_t)task * CM_REC;
  float At[16], Rt[16], Bh[16], Kh[16]; float W = 1.f;
#pragma unroll
  for (int j = 0; j < 16; ++j) {
    const int st = ci * 16 + j, tt = dir ? T - 1 - st : st;
    const bf16_t* rec = rec0 + (size_t)tt * 576;
    const float r = bf2f(rec[lane]), kk = bf2f(rec[64 + lane]), d = bf2f(rec[(3 + 3 * dir) * 64 + lane]), b = bf2f(rec[(4 + 3 * dir) * 64 + lane]), kt = bf2f(rec[(5 + 3 * dir) * 64 + lane]);
    At[j] = -kk * W; W *= (1.f - d); const float iw = 1.f / W; Rt[j] = r * W; Bh[j] = b * iw; Kh[j] = kt * iw;
  }
  {
    float x[8];
#pragma unroll
    for (int q = 0; q < 2; ++q) {
#pragma unroll
      for (int e = 0; e < 8; ++e) { const int st = ci * 16 + q * 8 + e, tt = dir ? T - 1 - st : st; x[e] = bf2f(rec0[(size_t)tt * 576 + 128 + lane]); }
      *(u4v*)(cm + CM_VT + (((lane >> 5) * 64 + q * 32 + (lane & 31)) * 16)) = pack8(x);
    }
  }
  {
    float x[8];
    const int k2 = lane >> 5, kq = lane & 31;
#pragma unroll
    for (int hq = 0; hq < 2; ++hq) {
#pragma unroll
      for (int e = 0; e < 8; ++e) x[e] = Bh[8 * (e >> 2) + 4 * hq + (e & 3)] * W;
      *(u4v*)(cm + CM_BKT + (((k2 * 2 + 0) * 64 + hq * 32 + kq) * 16)) = pack8(x);
#pragma unroll
      for (int e = 0; e < 8; ++e) x[e] = Kh[8 * hq + e] * W;
      *(u4v*)(cm + CM_BKT + (((k2 * 2 + 1) * 64 + hq * 32 + kq) * 16)) = pack8(x);
    }
    *(float*)(cm + CM_WL + lane * 4) = W;
  }
  bf16_t* MA = (bf16_t*)(wl + PCH_MA); bf16_t* MB = (bf16_t*)(wl + PCH_MB);
  float* TBT = (float*)(wl + PCH_TBT); float* MBT = (float*)(wl + PCH_MBT); float* TK = (float*)(wl + PCH_TK); float* MK = (float*)(wl + PCH_MK);
  WAVE_SYNC();
#pragma unroll
  for (int j = 0; j < 16; ++j) { MA[j * PL_STR + lane] = f2bf(Bh[j]); MA[(16 + j) * PL_STR + lane] = f2bf(Kh[j]); MB[j * PL_STR + lane] = f2bf(At[j]); MB[(16 + j) * PL_STR + lane] = f2bf(Rt[j]); }
  WAVE_SYNC();
  f16v D;
#pragma unroll
  for (int i = 0; i < 16; ++i) D[i] = 0.f;
#pragma unroll
  for (int s4 = 0; s4 < 4; ++s4) {
    const s8v fa = *(const s8v*)(MA + ql * PL_STR + 16 * s4 + 8 * hh), fb = *(const s8v*)(MB + ql * PL_STR + 16 * s4 + 8 * hh);
    D = __builtin_amdgcn_mfma_f32_32x32x16_bf16(fa, fb, D, 0, 0, 0);
  }
#pragma unroll
  for (int r = 0; r < 16; ++r) {
    const int i = (r & 3) + 8 * (r >> 2) + 4 * hh; const float v = D[r];
    if (r < 8) { if (ql < 16) TBT[ql * 16 + i] = (i < ql) ? v : 0.f; else MBT[(ql - 16) * 16 + i] = (i <= ql - 16) ? v : 0.f; }
    else { const int i2 = i - 16; if (ql < 16) TK[i2 * 16 + ql] = (i2 < ql) ? v : 0.f; else MK[i2 * 16 + (ql - 16)] = (i2 <= ql - 16) ? v : 0.f; }
  }
  WAVE_SYNC();
  const int l16 = lane & 15;
  float Z[16], Z2[16];
#pragma unroll
  for (int j = 0; j < 16; ++j) { Z[j] = 0.f; Z2[j] = 0.f; }
#pragma unroll
  for (int j = 0; j < 16; ++j) {
    float a1 = At[j], a2 = TK[l16 * 16 + j];
#pragma unroll
    for (int c4 = 0; c4 * 4 < j; ++c4) { const f4v tv = *(const f4v*)(TBT + j * 16 + c4 * 4);
#pragma unroll
      for (int e = 0; e < 4; ++e) if (c4 * 4 + e < j) { a1 += Z[c4 * 4 + e] * tv[e]; a2 += Z2[c4 * 4 + e] * tv[e]; } }
    Z[j] = a1; Z2[j] = a2;
  }
  bf16_t* GT = (bf16_t*)(cm + CM_GT);
  const int o16 = lane & 15, gt1 = (((lane >> 4) * 64 + ((o16 & 7) >> 2) * 32) * 8) + (((o16 >> 3) << 2) | (o16 & 3)), gt2 = ((4 * 64 + (o16 >> 3) * 32) * 8) + (o16 & 7);
#pragma unroll
  for (int t = 0; t < 16; ++t) {
    float a1 = Rt[t], a2 = MK[l16 * 16 + t];
#pragma unroll
    for (int c4 = 0; c4 * 4 <= t; ++c4) { const f4v mv = *(const f4v*)(MBT + t * 16 + c4 * 4);
#pragma unroll
      for (int e = 0; e < 4; ++e) if (c4 * 4 + e <= t) { a1 += Z[c4 * 4 + e] * mv[e]; a2 += Z2[c4 * 4 + e] * mv[e]; } }
    GT[gt1 + (16 + t) * 8] = f2bf(a1);
    if (lane < 16) GT[gt2 + (16 + t) * 8] = f2bf(a2);
  }
#pragma unroll
  for (int j = 0; j < 16; ++j) { GT[gt1 + j * 8] = f2bf(Z[j]); if (lane < 16) GT[gt2 + j * 8] = f2bf(Z2[j]); }
}

__device__ __forceinline__ s8v cvt8(const f16v& a, int o) {
  return __builtin_bit_cast(s8v, u4v{pk2bf(a[o], a[o + 1]), pk2bf(a[o + 2], a[o + 3]), pk2bf(a[o + 4], a[o + 5]), pk2bf(a[o + 6], a[o + 7])});
}
struct ScanOps { s8v gA[5], bU[2], bV[2], vf; float wreg; };
__device__ __forceinline__ void scan2_load(ScanOps& o, const char* cm, const bf16_t* rec0, int ci, int T, int dir, int ql, int hh, int row) {
  const int lane = hh * 32 + ql, rt = row >> 5;
  o.wreg = *(const float*)(cm + CM_WL + lane * 4);
#pragma unroll
  for (int s = 0; s < 5; ++s) o.gA[s] = *(const s8v*)(cm + CM_GT + (s * 64 + lane) * 16);
#pragma unroll
  for (int k2 = 0; k2 < 2; ++k2) { o.bU[k2] = *(const s8v*)(cm + CM_BKT + ((k2 * 2) * 64 + lane) * 16); o.bV[k2] = *(const s8v*)(cm + CM_BKT + ((k2 * 2 + 1) * 64 + lane) * 16); }
  o.vf = *(const s8v*)(cm + CM_VT + (rt * 64 + lane) * 16);
  (void)rec0; (void)ci; (void)T; (void)dir;
}
__device__ __forceinline__ void scan2_task(const Params& p, const Grp& g, int l, int task, char* wl) {
  char* ws = p.ws;
  const int lane = my_tid() & 63, ql = lane & 31, hh = lane >> 5;
  const int T = g.T, nch = T >> 4;
  const int ch = task >> 1, rt = task & 1;
  const int dir = ch & 1, h = (ch >> 1) & 7, sq = ch >> 4;
  const int row = rt * 32 + ql;
  const long mbase = (long)sq * T;
  const bf16_t* rec0 = (const bf16_t*)(ws + O_SOP) + ((size_t)sq * 8 + h) * T * 576;
  const char* cm0 = ws + O_CM + (size_t)ch * nch * CM_REC;
  float* YS = (float*)(ws + O_YS) + (size_t)dir * MG * 512;
  float* wlf = (float*)wl;
  f16v a0, a1;
  if (g.isden) { const float* st = (dir ? p.st_b : p.st_f) + ((((size_t)sq * NL + l) * 8 + h) * 64 + row) * 64;
#pragma unroll
    for (int q = 0; q < 4; ++q) { f4v x = *(const f4v*)(st + 8 * q + 4 * hh), y = *(const f4v*)(st + 32 + 8 * q + 4 * hh);
#pragma unroll
      for (int e = 0; e < 4; ++e) { a0[4 * q + e] = x[e]; a1[4 * q + e] = y[e]; } } }
  else {
#pragma unroll
    for (int i = 0; i < 16; ++i) { a0[i] = 0.f; a1[i] = 0.f; } }
  ScanOps s0, s1, s2;
  scan2_load(s0, cm0, rec0, 0, T, dir, ql, hh, row);
  scan2_load(s1, cm0 + CM_REC, rec0, 1, T, dir, ql, hh, row);
#define SCAN2_STEP(CUR, ci_) do { const int ci = (ci_); \
    WAVE_SYNC(); wlf[lane] = CUR.wreg; WAVE_SYNC(); \
    const s8v vfrag = CUR.vf; \
    f16v D; _Pragma("unroll") for (int i = 0; i < 16; ++i) D[i] = 0.f; \
    D = __builtin_amdgcn_mfma_f32_32x32x16_bf16(CUR.gA[0], cvt8(a0, 0), D, 0, 0, 0); \
    D = __builtin_amdgcn_mfma_f32_32x32x16_bf16(CUR.gA[1], cvt8(a0, 8), D, 0, 0, 0); \
    D = __builtin_amdgcn_mfma_f32_32x32x16_bf16(CUR.gA[2], cvt8(a1, 0), D, 0, 0, 0); \
    D = __builtin_amdgcn_mfma_f32_32x32x16_bf16(CUR.gA[3], cvt8(a1, 8), D, 0, 0, 0); \
    D = __builtin_amdgcn_mfma_f32_32x32x16_bf16(CUR.gA[4], vfrag, D, 0, 0, 0); \
    _Pragma("unroll") for (int i = 0; i < 8; ++i) { const int st = ci * 16 + (i & 3) + 8 * (i >> 2) + 4 * hh, tt = dir ? T - 1 - st : st; YS[(size_t)(mbase + tt) * 512 + h * 64 + row] = D[8 + i]; } \
    const s8v uf = cvt8(D, 0); \
    const float* wq = wlf + 4 * hh; \
    _Pragma("unroll") for (int q = 0; q < 4; ++q) { const f4v w0 = *(const f4v*)(wq + 8 * q), w1 = *(const f4v*)(wq + 32 + 8 * q); \
      _Pragma("unroll") for (int e = 0; e < 4; ++e) { a0[4 * q + e] *= w0[e]; a1[4 * q + e] *= w1[e]; } } \
    a0 = __builtin_amdgcn_mfma_f32_32x32x16_bf16(CUR.bU[0], uf, a0, 0, 0, 0); \
    a0 = __builtin_amdgcn_mfma_f32_32x32x16_bf16(CUR.bV[0], vfrag, a0, 0, 0, 0); \
    a1 = __builtin_amdgcn_mfma_f32_32x32x16_bf16(CUR.bU[1], uf, a1, 0, 0, 0); \
    a1 = __builtin_amdgcn_mfma_f32_32x32x16_bf16(CUR.bV[1], vfrag, a1, 0, 0, 0); } while (0)
  int c = 0;
  for (; c + 3 <= nch; c += 3) {
    { const int cc = (c + 2 < nch) ? c + 2 : nch - 1; scan2_load(s2, cm0 + (size_t)cc * CM_REC, rec0, cc, T, dir, ql, hh, row); }
    SCHED_FENCE(); SCAN2_STEP(s0, c); SCHED_FENCE();
    { const int cc = (c + 3 < nch) ? c + 3 : nch - 1; scan2_load(s0, cm0 + (size_t)cc * CM_REC, rec0, cc, T, dir, ql, hh, row); }
    SCHED_FENCE(); SCAN2_STEP(s1, c + 1); SCHED_FENCE();
    { const int cc = (c + 4 < nch) ? c + 4 : nch - 1; scan2_load(s1, cm0 + (size_t)cc * CM_REC, rec0, cc, T, dir, ql, hh, row); }
    SCHED_FENCE(); SCAN2_STEP(s2, c + 2); SCHED_FENCE();
  }
  if (c < nch) SCAN2_STEP(s0, c);
  if (c + 1 < nch) SCAN2_STEP(s1, c + 1);
#undef SCAN2_STEP
  if (!g.isden) { float* so = p.out + (dir ? OUT_SB : OUT_SF) + ((((size_t)(g.b0 + sq) * NL + l) * 8 + h) * 64 + row) * 64;
#pragma unroll
    for (int q = 0; q < 4; ++q) { *(f4v*)(so + 8 * q + 4 * hh) = f4v{a0[4 * q], a0[4 * q + 1], a0[4 * q + 2], a0[4 * q + 3]}; *(f4v*)(so + 32 + 8 * q + 4 * hh) = f4v{a1[4 * q], a1[4 * q + 1], a1[4 * q + 2], a1[4 * q + 3]}; } }
}

__device__ __forceinline__ void stage_mixA(const Params& p, const Grp& g, int bid, int nb, char* smem) {
  const int wid = my_tid() >> 6;
  const int NP = g.nseq * 16 * (g.T >> 4), q32 = g.T / 32, NA = g.nseq * 8 * q32;
  char* wl = smem + wid * PCH_LDS;
  for (int task = wid * nb + bid; task < NP + NA; task += nb * NWAVE) {
    if (task < NP) pchunk_task(p, g, task, wl);
    else { int t = task - NP; int sq = t / (8 * q32), r = t % (8 * q32); attention_task(p, g, sq, r / q32, r % q32); }
  }
}
__device__ __forceinline__ void stage_scanS(const Params& p, const Grp& g, int l, int bid, int nb, char* smem) {
  const int wid = my_tid() >> 6;
  const int NS = g.nseq * 32;
  for (int task = wid * nb + bid; task < NS; task += nb * NWAVE) scan2_task(p, g, l, task, smem + wid * 768);
  __syncthreads();
}

__device__ __forceinline__ void stage_e3(const Params& p, const Grp& g, int l, int bid, int nb) {
  const int lane = my_tid() & 63, wid = my_tid() >> 6;
  char* ws = p.ws;
  const float* YS = (const float*)(ws + O_YS); const bf16_t* SOP = (const bf16_t*)(ws + O_SOP); const float* BON = (const float*)(ws + O_BON); const int T = g.T;
  const bf16_t* Z = (const bf16_t*)(ws + O_Z); bf16_t* O = (bf16_t*)(ws + O_OBR);
  const int hd = lane >> 3, c0 = lane * 8;
  const float* lg = p.ln_g + (size_t)l * 512 + c0; const float* lb = p.ln_b + (size_t)l * 512 + c0;
  for (int m = bid * NWAVE + wid; m < g.mg; m += nb * NWAVE) {
    const f4v y0 = *(const f4v*)(YS + (size_t)m * 512 + c0), y1 = *(const f4v*)(YS + (size_t)m * 512 + c0 + 4);
    const f4v z0 = *(const f4v*)(YS + ((size_t)MG + m) * 512 + c0), z1 = *(const f4v*)(YS + ((size_t)MG + m) * 512 + c0 + 4);
    float o[8]; float s1 = 0.f;
#pragma unroll
    for (int e = 0; e < 4; ++e) { o[e] = y0[e] + z0[e]; o[4 + e] = y1[e] + z1[e]; }
#pragma unroll
    for (int e = 0; e < 8; ++e) s1 += o[e];
    const float mean = sum_lpr<8>(s1) * (1.f / 64.f); float s2 = 0.f;
#pragma unroll
    for (int e = 0; e < 8; ++e) { o[e] -= mean; s2 += o[e] * o[e]; }
    const float rs = rsqrtf(sum_lpr<8>(s2) * (1.f / 64.f) + 64e-5f);
    const float bon = BON[((size_t)m * 8 + hd) * 2] + BON[((size_t)m * 8 + hd) * 2 + 1];
    float v[8], ga[8];
    unpack8(*(const u4v*)(SOP + (((size_t)(m / T) * 8 + hd) * T + (m % T)) * 576 + 128 + (lane & 7) * 8), v);
    unpack8(*(const u4v*)(Z + (size_t)m * IN_W + ZC_GA + c0), ga);
    float r[8];
#pragma unroll
    for (int e = 0; e < 8; ++e) r[e] = (o[e] * rs * lg[e] + lb[e] + bon * v[e]) * siluf_(ga[e]);
    *(u4v*)(O + (size_t)m * 512 + c0) = pack8(r);
  }
}

__device__ __forceinline__ void stage_gates(const Params& p, const Grp& g, int l, int bid, int nb, char* smem) {
  const bf16_t* H = (const bf16_t*)(p.ws + O_H);
  const bf16_t* W = (const bf16_t*)(p.ws + O_WMT);
  bf16_t* GT = (bf16_t*)(p.ws + O_GATES);
  const float* bm = p.b_merge + (size_t)l * 4096;
#ifndef EMU
  if ((g.mg & 255) == 0) {
    pg8::Gemm gm; gm.A = H; gm.Bt = W; gm.M = g.mg; gm.N = 4096; gm.K = 1024;
    pg8::StaticOrder S; S.init(gm.M, gm.N, nb, bid);
    pg8::EpiSigmoid E; E.O = GT; E.ldc = 4096; E.bias = bm;
    pg8::gemm_phase<pg8::EpiSigmoid, pg8::StaticOrder>((PG8_LAS unsigned char*)smem, gm, S, E);
    return;
  }
#endif
  const int TM = (g.mg + 127) / 128, mg = g.mg;
  for (int t = bid; t < TM * 32; t += nb) {
    int tn = t / TM, tm = t % TM; f4v acc[2][4]; zero_acc<4>(acc);
    gemm_mainloop<4>(H, 1024, tm * 128, mg, W, 1024, tn * 128, 4096, 1024, smem, acc);
    epi_foreach<4>(acc, tm * 128, tn * 128, [&](int row, int c0, f4v& v) {
      if (row < mg) *(u2v*)(GT + (size_t)row * 4096 + c0) = pack4(sigmoidf_(v[0] + bm[c0]), sigmoidf_(v[1] + bm[c0 + 1]), sigmoidf_(v[2] + bm[c0 + 2]), sigmoidf_(v[3] + bm[c0 + 3]));
    });
  }
}

__device__ __forceinline__ void stage_g8(const Params& p, const Grp& g, int l, int bid, int nb, char* smem) {
  char* ws = p.ws;
  bf16_t* MGD = (bf16_t*)(ws + O_MERGED);
  const bf16_t* GTp = (const bf16_t*)(ws + O_GATES);
  const int TM = (g.mg + 127) / 128, mg = g.mg, NT = TM * 8;
  auto desc = [&](int t, int n) { int tn = t / TM, tm = t % TM;
    return mk_gt((const bf16_t*)(ws + O_OBR) + (size_t)n * MG * 512, 512, tm * 128, mg, (const bf16_t*)(ws + O_WBRT) + (size_t)n * 1024 * 512, 512, tn * 128, 1024, 512); };
  for (int t = bid; t < NT; t += nb) {
    int tn = t / TM, tm = t % TM;
    f4v macc[2][4]; zero_acc<4>(macc);
#pragma unroll 1
    for (int n = 0; n < 4; ++n) {
      f4v ap[2][4]; zero_acc<4>(ap);
      GT cur = desc(t, n);
      gemm_deep<4>(cur, smem, ap);
      const int lane = my_tid() & 63, wid = my_tid() >> 6, wm = wid >> 1, wn = wid & 1;
#pragma unroll
      for (int i = 0; i < 2; ++i)
#pragma unroll
        for (int j = 0; j < 4; ++j) {
          int row = tm * 128 + wm * 32 + i * 16 + (lane & 15); row = row < mg ? row : mg - 1;
          int c0 = tn * 128 + wn * 64 + j * 16 + (lane >> 4) * 4;
          u2v gt = *(const u2v*)(GTp + (size_t)row * 4096 + n * 1024 + c0);
          macc[i][j][0] += bflo(gt.x) * ap[i][j][0]; macc[i][j][1] += bfhi(gt.x) * ap[i][j][1]; macc[i][j][2] += bflo(gt.y) * ap[i][j][2]; macc[i][j][3] += bfhi(gt.y) * ap[i][j][3];
        }
    }
    epi_foreach<4>(macc, tm * 128, tn * 128, [&](int row, int c0, f4v& v) {
      if (row < mg) *(u2v*)(MGD + (size_t)row * 1024 + c0) = pack4(v[0], v[1], v[2], v[3]);
    });
  }
  (void)l;
}

__device__ __forceinline__ void stage_g9(const Params& p, const Grp& g, int l, int bid, int nb, char* smem) {
  char* ws = p.ws;
  float* X = p.out + (size_t)g.m0 * 1024;
  const float* modp = (const float*)(ws + O_MOD) + (size_t)l * 3 * 3072 + 2048;
  const int TM = (g.mg + 127) / 128, mg = g.mg, NT = TM * 8;
  auto desc = [&](int t) { int tn = t / TM, tm = t % TM; return mk_gt((const bf16_t*)(ws + O_MERGED), 1024, tm * 128, mg, (const bf16_t*)(ws + O_WOUTT), 1024, tn * 128, 1024, 1024); };
  for (int t = bid; t < NT; t += nb) {
    int tn = t / TM, tm = t % TM;
    f4v acc[2][4]; zero_acc<4>(acc);
    GT cur = desc(t);
    gemm_deep<4>(cur, smem, acc);
    epi_foreach<4>(acc, tm * 128, tn * 128, [&](int row, int c0, f4v& v) {
      if (row < mg) { const float* gt = modp + (size_t)mod_index(g, row) * 3072 + c0; f4v* xp = (f4v*)(X + (size_t)row * 1024 + c0); f4v x = *xp;
        x[0] += gt[0] * v[0]; x[1] += gt[1] * v[1]; x[2] += gt[2] * v[2]; x[3] += gt[3] * v[3]; *xp = x; }
    });
  }
}

__device__ __forceinline__ void stage_final(const Params& p, int bid, int nb) {
  const int lane = my_tid() & 63, wid = my_tid() >> 6;
  for (int m = bid * NWAVE + wid; m < M; m += nb * NWAVE) {
    float* xr = p.out + (size_t)m * 1024; float4 q[4]; float ss = 0.f;
#pragma unroll
    for (int i = 0; i < 4; ++i) { q[i] = *(const float4*)(xr + i * 256 + lane * 4); ss += q[i].x * q[i].x + q[i].y * q[i].y + q[i].z * q[i].z + q[i].w * q[i].w; }
    ss = wave_sum(ss); float rs = rsqrtf(ss * (1.f / 1024.f) + 1e-6f);
#pragma unroll
    for (int i = 0; i < 4; ++i) { int c = i * 256 + lane * 4; float4 gm = *(const float4*)(p.final_g + c);
      *(float4*)(xr + c) = make_float4(q[i].x * rs * gm.x, q[i].y * rs * gm.y, q[i].z * rs * gm.z, q[i].w * rs * gm.w); }
  }
}

#ifdef EMU
#define DECL_SMEM(name) char* name = emu::smem()
#else
#define DECL_SMEM(name) __shared__ __attribute__((aligned(16))) char name[SMEM_BYTES]
#endif

#ifdef EMU
struct GridBar { __device__ void sync() const { emu::grid_sync(); } };
#else
#define XB_TMO      128
#define XB_XCNT(j)  (256  + 64 * (j))
#define XB_XSUB(j)  (1280 + 64 * (j))
#define XB_XGEN(j)  (2304 + 64 * (j))
#define XB_TOP      3328
#define XB_TOPGEN   3392
#define XB_SPIN_CAP (1u << 20)
#define LAS __attribute__((address_space(3)))
__device__ __forceinline__ unsigned xb_ld(unsigned* p)              { return __hip_atomic_load(p, __ATOMIC_RELAXED, __HIP_MEMORY_SCOPE_AGENT); }
__device__ __forceinline__ unsigned xb_add(unsigned* p, unsigned v) { return __hip_atomic_fetch_add(p, v, __ATOMIC_RELAXED, __HIP_MEMORY_SCOPE_AGENT); }
__device__ __forceinline__ unsigned xb_xcc_id() { return (unsigned)__builtin_amdgcn_s_getreg((3 << 11) | 20) & 0xFu; }
#define XB_SPIN(cond, bar) do { unsigned _sp = 0; while (cond) { __builtin_amdgcn_s_sleep(1); \
    if ((++_sp & 255u) == 0u) { if (xb_ld(&(bar)[XB_TMO])) break; if (_sp > XB_SPIN_CAP) { atomicAdd(&(bar)[XB_TMO], 1u); break; } } } } while (0)
struct GridBar {
  unsigned* bar; unsigned x; volatile LAS unsigned* st;
  __device__ __forceinline__ void post(unsigned* b, volatile LAS unsigned* s_) {
    bar = b; x = xb_xcc_id(); st = s_;
    if (threadIdx.x == 0) (void)xb_add(&bar[XB_XCNT(x)], 1u);
  }
  __device__ __forceinline__ void complete(unsigned& nloc, unsigned& nx) const {
    const unsigned G = gridDim.x;
    unsigned sum, cnt, mine, sp = 0u;
    for (;;) {
      sum = 0u; cnt = 0u; mine = 0u;
#pragma unroll
      for (unsigned j = 0; j < 16; ++j) { const unsigned c = xb_ld(&bar[XB_XCNT(j)]); sum += c; cnt += (c > 0u) ? 1u : 0u; mine = (j == x) ? c : mine; }
      if (sum == G) break;
      __builtin_amdgcn_s_sleep(1);
      if ((++sp & 255u) == 0u) { if (xb_ld(&bar[XB_TMO])) break; if (sp > XB_SPIN_CAP) { atomicAdd(&bar[XB_TMO], 1u); break; } }
    }
    nloc = mine > 0u ? mine : 1u; nx = cnt > 0u ? cnt : 1u;
  }
  __device__ __forceinline__ void sync() const {
    asm volatile("s_waitcnt vmcnt(0)" ::: "memory");
    __syncthreads();
    if (threadIdx.x == 0) {
      __builtin_amdgcn_s_waitcnt(0);
      unsigned nloc = st[0], nx = st[1];
      if (nloc == 0u) { complete(nloc, nx); st[0] = nloc; st[1] = nx; }
      const unsigned old = xb_add(&bar[XB_XSUB(x)], 1u);
      const unsigned gen = old / nloc;
      if (old + 1u == (gen + 1u) * nloc) {
        __builtin_amdgcn_fence(__ATOMIC_RELEASE, "agent");
        asm volatile("s_waitcnt vmcnt(0)" ::: "memory");
        const unsigned og = xb_add(&bar[XB_TOP], 1u);
        const unsigned tg = og / nx;
        if (og + 1u == (tg + 1u) * nx) xb_add(&bar[XB_TOPGEN], 1u);
        else XB_SPIN(xb_ld(&bar[XB_TOPGEN]) == tg, bar);
        __builtin_amdgcn_fence(__ATOMIC_ACQUIRE, "agent");
        xb_add(&bar[XB_XGEN(x)], 1u);
        asm volatile("s_waitcnt vmcnt(0)" ::: "memory");
      } else {
        XB_SPIN(xb_ld(&bar[XB_XGEN(x)]) == gen, bar);
        __builtin_amdgcn_fence(__ATOMIC_ACQUIRE, "agent");
        asm volatile("s_waitcnt vmcnt(0)" ::: "memory");
      }
    }
    __syncthreads();
  }
};
#endif

#ifndef EMU
namespace cg = cooperative_groups;
#else
namespace cg = cooperative_groups;
#endif

__global__ void __launch_bounds__(NTHR) mega_kernel(Params p) {
  DECL_SMEM(smem);
  cg::grid_group grid = cg::this_grid();
  const int bid0 = blockIdx.x, nb0 = gridDim.x;
  GridBar gb;
#ifndef EMU
  if (threadIdx.x == 0) { volatile LAS unsigned* w = (volatile LAS unsigned*)(smem + SMEM_STAGE); w[0] = 0u; w[1] = 0u; w[2] = 0u; w[3] = 0u; }
  __syncthreads();
  gb.post((unsigned*)(p.ws + O_BAR), (volatile LAS unsigned*)(smem + SMEM_STAGE));
#endif
#ifndef PROBE_DUP
#define PROBE_DUP 0
#endif
#define STG(gi_, call) do { Params q = p; q.ws = opaque(q.ws); q.out = opaque(q.out); const int bid = opaque_i(bid0); const int nb = opaque_i(nb0); const Grp g = get_grp(opaque_i(gi_)); (void)g; call; } while (0)
#define STP(bit, gi_, call) do { STG(gi_, call); if (PROBE_DUP & (bit)) { STG(gi_, call); } } while (0)
  for (int l = 0; l < NL; ++l) {
    STP(1, 0, stage_prep(q, l, bid, nb, smem));
    if (l == 0) grid.sync();
    STP(2, 0, stage_h(q, g, l, bid, nb));
    gb.sync();
    for (int gi = 0; gi < NGRP; ++gi) {
      STP(4, gi, stage_g1(q, g, bid, nb, smem)); gb.sync();
      STP(8, gi, stage_e1(q, g, l, bid, nb)); gb.sync();
      STP(16, gi, stage_g2(q, g, l, bid, nb, smem)); gb.sync();
      STP(64, gi, stage_mixA(q, g, bid, nb, smem)); gb.sync();
      STP(32, gi, stage_scanS(q, g, l, bid, nb, smem));
      STP(128, gi, stage_dft2(q, g, bid, nb, smem)); gb.sync();
      STP(256, gi, stage_e3(q, g, l, bid, nb));
      STP(512, gi, stage_gates(q, g, l, bid, nb, smem)); gb.sync();
      STP(1024, gi, stage_g8(q, g, l, bid, nb, smem)); gb.sync();
      STG(gi, stage_g9(q, g, l, bid, nb, smem));
      if (gi + 1 < NGRP) { STP(2, gi + 1, stage_h(q, g, l, bid, nb)); }
      gb.sync();
    }
  }
  STG(0, stage_final(q, bid, nb));
#undef STP
#undef STG
}

extern "C" void kernel_launch(void* const* d_in, const int* in_sizes, int n_in, void* d_out, int out_size, void* d_ws, size_t ws_size,
                              hipStream_t stream) {
  Params p{};
  const float** pp = (const float**)&p;
  for (int i = 0; i < 35; ++i) pp[i] = (const float*)d_in[i];
  p.out = (float*)d_out; p.ws = (char*)d_ws;
#ifdef EMU
  emu::set_coop(true);
  emu_launch(dim3(8), dim3(NTHR), [=]() { mega_kernel(p); });
  emu::set_coop(false);
#else
  static int grid_blocks = 0;
  if (!grid_blocks) {
    int dev = 0, cus = 0, per_cu = 0;
    (void)hipGetDevice(&dev);
    (void)hipDeviceGetAttribute(&cus, hipDeviceAttributeMultiprocessorCount, dev);
    (void)hipOccupancyMaxActiveBlocksPerMultiprocessor(&per_cu, mega_kernel, NTHR, 0);
    if (per_cu > 1) per_cu = 1;
    if (per_cu < 1) per_cu = 1;
    grid_blocks = cus * per_cu;
  }
  (void)hipMemsetAsync((char*)d_ws + O_BAR, 0, BAR_BYTES, stream);
  void* args[] = {&p};
  (void)hipLaunchCooperativeKernel((void*)mega_kernel, dim3(grid_blocks), dim3(NTHR), args, 0, stream);
#endif
  (void)in_sizes; (void)n_in; (void)out_size; (void)ws_size;
}
```

```cpp
#ifdef EMU
#include "hip_emu.h"
#else
#include <hip/hip_runtime.h>
#include <hip/hip_cooperative_groups.h>
#endif
#include <stdint.h>

#ifndef CFG_BATCH
#define CFG_BATCH 32
#define CFG_SEQ 256
#define CFG_DEC_BATCH 2
#define CFG_DEC_SEQ 2048
#define CFG_PAST 512
#define CFG_NGRP_C 2
#endif
constexpr int D = 1024, NL = 2;
constexpr int NB_C = CFG_BATCH, T_C = CFG_SEQ, NB_D = CFG_DEC_BATCH, T_D = CFG_DEC_SEQ, PAST = CFG_PAST;
constexpr int M_C = NB_C * T_C, M_D = NB_D * T_D, M = M_C + M_D;
constexpr int NGRP_C = CFG_NGRP_C, NGRP = 1 + NGRP_C;
constexpr int MGC = M_C / NGRP_C, SEQ_PER_CG = NB_C / NGRP_C;
constexpr int MG = MGC > M_D ? MGC : M_D;
constexpr int MKV = MG + NB_D * PAST;
constexpr int KEYS_D = T_D + PAST;
constexpr int IN_W = 5728;
constexpr int ZC_R = 0, ZC_K = 512, ZC_V = 1024, ZC_WDF = 1536, ZC_QD = 1728, ZC_KVD = 1984, ZC_KR = 2112, ZC_VC = 2144, ZC_U = 2656, ZC_GC = 3168,
              ZC_GA = 3680, ZC_GB = 4192, ZC_F = 4704, ZC_GD = 5216;
constexpr int Z1_W = 3680, Z1_WP = 3840, Z2_W = 2048;
constexpr int SHIFT_W = 1728;
static_assert(M_C % NGRP_C == 0 && NB_C % NGRP_C == 0, "ctx groups");
static_assert(T_C % 128 == 0 && T_D % 128 == 0 && PAST % 32 == 0, "seq multiples");

typedef unsigned short bf16_t;
typedef short s8v __attribute__((ext_vector_type(8)));
typedef float f4v __attribute__((ext_vector_type(4)));
typedef float f16v __attribute__((ext_vector_type(16)));
typedef unsigned u4v __attribute__((ext_vector_type(4)));
typedef unsigned u2v __attribute__((ext_vector_type(2)));

struct Params {
  const float *x_prompt, *x_sample, *st_f, *st_b, *c_ckv, *c_kr, *c, *c_ctx, *norm_g, *w_ada, *b_ada, *w_in, *shift_mu, *w0, *w_up,
      *a0, *a_up, *k_k, *k_a, *r_k, *ln_g, *ln_b, *q_norm, *w_q_up, *kv_norm, *w_kv_up, *g_ln_g, *g_ln_b, *g_w_s, *g_b_s, *w_branch,
      *w_merge, *b_merge, *w_out, *final_g;
  float* out;
  char* ws;
};

struct Grp { int isden, m0, mg, nseq, T, b0, nkeys, mkv; };
__host__ __device__ __forceinline__ Grp get_grp(int gi) {
  Grp g;
  if (gi == 0) { g.isden = 1; g.m0 = M_C; g.mg = M_D; g.nseq = NB_D; g.T = T_D; g.b0 = 0; g.nkeys = KEYS_D; g.mkv = M_D + NB_D * PAST; }
  else { g.isden = 0; g.m0 = (gi - 1) * MGC; g.mg = MGC; g.nseq = SEQ_PER_CG; g.T = T_C; g.b0 = (gi - 1) * SEQ_PER_CG; g.nkeys = T_C; g.mkv = MGC; }
  return g;
}

constexpr size_t al256(size_t x) { return (x + 255) & ~(size_t)255; }
constexpr size_t O_WINT = 0;
constexpr int IN_WP = Z1_WP + Z2_W;
constexpr size_t O_WMT = O_WINT + al256((size_t)IN_WP * 1024 * 2);
constexpr size_t O_WBRT = O_WMT + al256((size_t)4096 * 1024 * 2);
constexpr size_t O_WOUTT = O_WBRT + al256((size_t)4 * 1024 * 512 * 2);
constexpr size_t O_WQT = O_WOUTT + al256((size_t)1024 * 1024 * 2);
constexpr size_t O_WKVT = O_WQT + al256((size_t)768 * 256 * 2);
constexpr size_t O_WUPT = O_WKVT + al256((size_t)1024 * 128 * 2);
constexpr size_t O_WS = O_WUPT + al256((size_t)4 * 512 * 64 * 2);
constexpr size_t O_CS128 = O_WS + al256((size_t)4 * 128 * 128 * 2);
constexpr size_t O_A2C = O_CS128 + al256((size_t)256 * 128 * 2);
constexpr size_t O_A2D = O_A2C + al256((size_t)T_C * 2 * T_C * 2);
constexpr size_t O_ROPE = O_A2D + al256((size_t)T_D * 2 * T_D * 2);
constexpr size_t O_MOD = O_ROPE + al256((size_t)T_D * 32 * 4);
constexpr size_t O_H = O_MOD + al256((size_t)NL * 3 * 3072 * 4);
constexpr size_t O_Z = O_H + al256((size_t)MG * 1024 * 2);
constexpr size_t O_SK = O_Z + al256((size_t)MG * IN_W * 2);
constexpr size_t O_SOP = O_SK + al256((size_t)MG * 512 * 2);
constexpr size_t O_YS = O_SOP + al256((size_t)MG * 8 * 576 * 2);
constexpr size_t O_BON = O_YS + al256((size_t)2 * MG * 512 * 4);
constexpr size_t O_LORA = O_BON + al256((size_t)MG * 16 * 4);
constexpr int CM_GT = 0, CM_BKT = 5120, CM_WL = 9216, CM_VT = 9472, CM_REC = 11520;
constexpr size_t CM_BYTES = (size_t)MG * CM_REC;
constexpr size_t O_CM = O_LORA + al256((size_t)MG * 192 * 2);
constexpr size_t O_PRE = O_CM + al256(CM_BYTES - (size_t)MG * 2048 * 2);
constexpr size_t O_QDN = O_PRE + al256((size_t)MG * 2048 * 2);
constexpr size_t O_CKV = O_QDN + al256((size_t)MG * 256 * 2);
constexpr size_t O_KR = O_CKV + al256((size_t)MKV * 128 * 2);
constexpr size_t O_Q = O_KR + al256((size_t)MKV * 32 * 2);
constexpr size_t O_KN = O_Q + al256((size_t)MG * 768 * 2);
constexpr size_t O_VT = O_KN + al256((size_t)MKV * 512 * 2);
constexpr size_t O_VCNT = O_VT + al256((size_t)MKV * 512 * 2);
constexpr size_t O_YT = O_VCNT + al256((size_t)MG * 512 * 2);
constexpr size_t O_OBR = O_YT + al256((size_t)MG * 1024 * 2);
constexpr size_t O_MERGED = O_OBR + al256((size_t)4 * MG * 512 * 2);
constexpr size_t O_END = O_MERGED + al256((size_t)MG * 1024 * 2);
constexpr size_t O_GATES = O_PRE;
static_assert(O_GATES + (size_t)MG * 4096 * 2 <= O_VCNT, "gates alias region too small");
static_assert(O_CM + CM_BYTES <= O_QDN, "chunk-matrix region must end before QDN");
constexpr size_t O_BAR = O_END;
constexpr size_t BAR_BYTES = 3456 * 4;
static_assert(O_BAR + BAR_BYTES <= ((size_t)256 << 20), "workspace must fit 256 MiB");

constexpr size_t OUT_SF = (size_t)M * D, OUT_SB = OUT_SF + (size_t)NB_C * NL * 8 * 64 * 64,
                 OUT_CKV = OUT_SB + (size_t)NB_C * NL * 8 * 64 * 64, OUT_KR = OUT_CKV + (size_t)NB_C * NL * T_C * 128;

#ifdef EMU
template <class T> __device__ __forceinline__ T* opaque(T* p) { return p; }
__device__ __forceinline__ int opaque_i(int v) { return v; }
#else
template <class T> __device__ __forceinline__ T* opaque(T* p) {
  typedef __attribute__((address_space(1))) T* gptr;
  gptr g = (gptr)p; asm volatile("" : "+s"(g)); return (T*)g;
}
__device__ __forceinline__ int opaque_i(int v) { asm volatile("" : "+s"(v)); return v; }
#endif
#ifdef EMU
#define SCHED_FENCE() do {} while (0)
#else
#define SCHED_FENCE() do { asm volatile("" ::: "memory"); __builtin_amdgcn_sched_barrier(0); } while (0)
#endif
__device__ __forceinline__ int my_tid() {
#ifdef EMU
  return (int)threadIdx.x;
#else
  int t = (int)threadIdx.x; asm volatile("" : "+v"(t)); return t;
#endif
}
__device__ __forceinline__ unsigned f_as_u(float f) { return __builtin_bit_cast(unsigned, f); }
__device__ __forceinline__ float u_as_f(unsigned u) { return __builtin_bit_cast(float, u); }
#ifdef EMU
__device__ __forceinline__ bf16_t f2bf(float f) { unsigned u = f_as_u(f); u += 0x7FFFu + ((u >> 16) & 1u); return (bf16_t)(u >> 16); }
__device__ __forceinline__ unsigned pk2bf(float lo, float hi) { return (unsigned)f2bf(lo) | ((unsigned)f2bf(hi) << 16); }
#else
typedef __bf16 bf2v_t __attribute__((ext_vector_type(2)));
typedef float f2c_t __attribute__((ext_vector_type(2)));
__device__ __forceinline__ bf16_t f2bf(float f) { return __builtin_bit_cast(unsigned short, (__bf16)f); }
__device__ __forceinline__ unsigned pk2bf(float lo, float hi) { return __builtin_bit_cast(unsigned, __builtin_convertvector(f2c_t{lo, hi}, bf2v_t)); }
#endif
__device__ __forceinline__ float bf2f(bf16_t h) { return u_as_f(((unsigned)h) << 16); }
__device__ __forceinline__ float bflo(unsigned u) { return u_as_f(u << 16); }
__device__ __forceinline__ float bfhi(unsigned u) { return u_as_f(u & 0xFFFF0000u); }
#ifdef EMU
__device__ __forceinline__ float fexp_(float x) { return expf(x); }
__device__ __forceinline__ float frcp_(float x) { return 1.f / x; }
#else
__device__ __forceinline__ float fexp_(float x) { return __builtin_amdgcn_exp2f(x * 1.4426950408889634f); }
__device__ __forceinline__ float frcp_(float x) { return __builtin_amdgcn_rcpf(x); }
#endif
#ifdef EMU
__device__ __forceinline__ float fexp2_(float x) { return exp2f(x); }
#else
__device__ __forceinline__ float fexp2_(float x) { return __builtin_amdgcn_exp2f(x); }
#endif
__device__ __forceinline__ float sigmoidf_(float x) { return frcp_(1.f + fexp_(-x)); }
__device__ __forceinline__ float siluf_(float x) { return x * frcp_(1.f + fexp_(-x)); }
__device__ __forceinline__ float tanhf_(float x) { return 1.f - 2.f * frcp_(1.f + fexp_(2.f * x)); }
__device__ __forceinline__ float geluf_(float x) { return 0.5f * x * (1.f + tanhf_(0.7978845608028654f * (x + 0.044715f * x * x * x))); }
#ifdef EMU
__device__ __forceinline__ float wave_sum(float v) {
#pragma unroll
  for (int o = 32; o >= 1; o >>= 1) v += __shfl_xor(v, o);
  return v;
}
#else
__device__ __forceinline__ float wave_sum(float v) {
  v += u_as_f(__builtin_amdgcn_update_dpp(0, (int)f_as_u(v), 0xB1, 0xF, 0xF, true));
  v += u_as_f(__builtin_amdgcn_update_dpp(0, (int)f_as_u(v), 0x4E, 0xF, 0xF, true));
  v += u_as_f(__builtin_amdgcn_update_dpp(0, (int)f_as_u(v), 0x141, 0xF, 0xF, true));
  v += u_as_f(__builtin_amdgcn_update_dpp(0, (int)f_as_u(v), 0x140, 0xF, 0xF, true));
  { auto r = __builtin_amdgcn_permlane16_swap(f_as_u(v), f_as_u(v), false, false); v = u_as_f(r[0]) + u_as_f(r[1]); }
  { auto r = __builtin_amdgcn_permlane32_swap(f_as_u(v), f_as_u(v), false, false); v = u_as_f(r[0]) + u_as_f(r[1]); }
  return v;
}
#endif

#ifdef EMU
#define WAVE_SYNC() emu::wave_barrier()
__device__ __forceinline__ float sum16(float v) { v += __shfl_xor(v, 1); v += __shfl_xor(v, 2); v += __shfl_xor(v, 4); v += __shfl_xor(v, 8); return v; }
#else
#define WAVE_SYNC() __builtin_amdgcn_wave_barrier()
__device__ __forceinline__ float sum16(float v) {
  v += u_as_f(__builtin_amdgcn_update_dpp(0, (int)f_as_u(v), 0xB1, 0xF, 0xF, true));
  v += u_as_f(__builtin_amdgcn_update_dpp(0, (int)f_as_u(v), 0x4E, 0xF, 0xF, true));
  v += u_as_f(__builtin_amdgcn_update_dpp(0, (int)f_as_u(v), 0x141, 0xF, 0xF, true));
  v += u_as_f(__builtin_amdgcn_update_dpp(0, (int)f_as_u(v), 0x140, 0xF, 0xF, true));
  return v;
}
#endif

template <int LPR> __device__ __forceinline__ float sum_lpr(float v) {
#ifdef EMU
  v += __shfl_xor(v, 1); v += __shfl_xor(v, 2); v += __shfl_xor(v, 4);
  if (LPR >= 16) v += __shfl_xor(v, 8);
  if (LPR >= 32) v += __shfl_xor(v, 16);
  return v;
#else
  v += u_as_f(__builtin_amdgcn_update_dpp(0, (int)f_as_u(v), 0xB1, 0xF, 0xF, true));
  v += u_as_f(__builtin_amdgcn_update_dpp(0, (int)f_as_u(v), 0x4E, 0xF, 0xF, true));
  v += u_as_f(__builtin_amdgcn_update_dpp(0, (int)f_as_u(v), 0x141, 0xF, 0xF, true));
  if (LPR >= 16) v += u_as_f(__builtin_amdgcn_update_dpp(0, (int)f_as_u(v), 0x140, 0xF, 0xF, true));
  if (LPR >= 32) { auto r = __builtin_amdgcn_permlane16_swap(f_as_u(v), f_as_u(v), false, false); v = u_as_f(r[0]) + u_as_f(r[1]); }
  return v;
#endif
}

template <int LPR> __device__ __forceinline__ void sum_lpr2(float& a, float& b) {
#ifdef EMU
  a = sum_lpr<LPR>(a); b = sum_lpr<LPR>(b);
#else
#define DPP_ADD2(ctrl) { float ta = u_as_f(__builtin_amdgcn_update_dpp(0, (int)f_as_u(a), ctrl, 0xF, 0xF, true)); float tb = u_as_f(__builtin_amdgcn_update_dpp(0, (int)f_as_u(b), ctrl, 0xF, 0xF, true)); a += ta; b += tb; }
  DPP_ADD2(0xB1) DPP_ADD2(0x4E) DPP_ADD2(0x141)
  if (LPR >= 16) DPP_ADD2(0x140)
  if (LPR >= 32) { auto ra = __builtin_amdgcn_permlane16_swap(f_as_u(a), f_as_u(a), false, false); auto rb = __builtin_amdgcn_permlane16_swap(f_as_u(b), f_as_u(b), false, false);
    a = u_as_f(ra[0]) + u_as_f(ra[1]); b = u_as_f(rb[0]) + u_as_f(rb[1]); }
#undef DPP_ADD2
#endif
}

constexpr int NTHR = 512, NWAVE = 8;
constexpr int LDS_STR = 72;
constexpr int SMEM_STAGE = 131072;
constexpr int SMEM_BYTES = SMEM_STAGE + 16;

template <int NJ>
__device__ __forceinline__ void zero_acc(f4v (&acc)[2][NJ]) {
#pragma unroll
  for (int i = 0; i < 2; ++i)
#pragma unroll
    for (int j = 0; j < NJ; ++j) acc[i][j] = f4v{0.f, 0.f, 0.f, 0.f};
}

struct GT { const bf16_t* A; long lda; int arow0, arows; const bf16_t* B; long ldb; int brow0, brows; int K; int bt; };
__device__ __forceinline__ GT mk_gt(const bf16_t* A, long lda, int arow0, int arows, const bf16_t* B, long ldb, int brow0, int brows, int K, int bt = 0) {
  GT t; t.A = A; t.lda = lda; t.arow0 = arow0; t.arows = arows; t.B = B; t.ldb = ldb; t.brow0 = brow0; t.brows = brows; t.K = K; t.bt = bt; return t;
}
template <int NJ>
__device__ __forceinline__ void gemm_ptrs(const GT& t, int tid, const bf16_t* (&ap)[2], const bf16_t* (&bp)[NJ / 2]) {
#pragma unroll
  for (int i = 0; i < 2; ++i) { int c = tid + NTHR * i, r = c >> 3, cc = c & 7; int ar = t.arow0 + r; ar = ar < t.arows ? ar : t.arows - 1; ap[i] = t.A + (long)ar * t.lda + cc * 8; }
#pragma unroll
  for (int i = 0; i < NJ / 2; ++i) { int c = tid + NTHR * i;
    if (t.bt) { int q = c & 63, dc = c >> 6; bp[i] = t.B + (long)q * t.ldb + t.brow0 + dc * 8; }
    else { int r = c >> 3, cc = c & 7; int br = t.brow0 + r; br = br < t.brows ? br : t.brows - 1; bp[i] = t.B + (long)br * t.ldb + cc * 8; } }
}
template <int NJ>
__device__ __forceinline__ void gemm_prefetch(const GT& t, u4v (&ra)[2], u4v (&rb)[NJ / 2]) {
  const bf16_t* ap[2]; const bf16_t* bp[NJ / 2];
  gemm_ptrs<NJ>(t, my_tid(), ap, bp);
#pragma unroll
  for (int i = 0; i < 2; ++i) ra[i] = *(const u4v*)(ap[i]);
#pragma unroll
  for (int i = 0; i < NJ / 2; ++i) rb[i] = *(const u4v*)(bp[i]);
}
template <int NJ, bool BT>
__device__ __forceinline__ void gemm_run(const GT& t, const GT* nxt, u4v (&ra)[2], u4v (&rb)[NJ / 2], char* smem, f4v (&acc)[2][NJ]) {
  constexpr int NBL = NJ / 2;
  constexpr int BUF = (128 + 128) * LDS_STR;
  bf16_t* s0 = (bf16_t*)smem;
  const int tid = my_tid(), lane = tid & 63, wid = tid >> 6, wm = wid >> 1, wn = wid & 1;
  const bf16_t* ap[2]; const bf16_t* bp[NBL];
  gemm_ptrs<NJ>(t, tid, ap, bp);
  const long ldb = t.ldb;
  __syncthreads();
#pragma unroll
  for (int i = 0; i < 2; ++i) { int c = tid + NTHR * i, r = c >> 3, cc = c & 7; *(u4v*)(s0 + r * LDS_STR + cc * 8) = ra[i]; }
#pragma unroll
  for (int i = 0; i < NBL; ++i) { int c = tid + NTHR * i;
    if (BT) { int q = c & 63, dc = c >> 6;
#pragma unroll
      for (int e = 0; e < 8; ++e) s0[(128 + dc * 8 + e) * LDS_STR + q] = (bf16_t)(rb[i][e >> 1] >> ((e & 1) * 16)); }
    else { int r = c >> 3, cc = c & 7; *(u4v*)(s0 + (128 + r) * LDS_STR + cc * 8) = rb[i]; } }
  __syncthreads();
  const int nk = t.K >> 6;
  for (int kt = 0; kt < nk; ++kt) {
    const bool more = kt + 1 < nk;
    if (more) {
#pragma unroll
      for (int i = 0; i < 2; ++i) ra[i] = *(const u4v*)(ap[i] + (kt + 1) * 64);
#pragma unroll
      for (int i = 0; i < NBL; ++i) rb[i] = *(const u4v*)(bp[i] + (BT ? (long)(kt + 1) * 64 * ldb : (long)(kt + 1) * 64));
    } else if (nxt) gemm_prefetch<NJ>(*nxt, ra, rb);
    SCHED_FENCE();
    const bf16_t* sA = s0 + (kt & 1) * BUF; const bf16_t* sB = sA + 128 * LDS_STR;
#pragma unroll
    for (int ks = 0; ks < 2; ++ks) {
      s8v af[2], bf[NJ];
#pragma unroll
      for (int i = 0; i < 2; ++i) af[i] = *(const s8v*)(sA + (wm * 32 + i * 16 + (lane & 15)) * LDS_STR + ks * 32 + (lane >> 4) * 8);
#pragma unroll
      for (int j = 0; j < NJ; ++j) bf[j] = *(const s8v*)(sB + (wn * NJ * 16 + j * 16 + (lane & 15)) * LDS_STR + ks * 32 + (lane >> 4) * 8);
#pragma unroll
      for (int i = 0; i < 2; ++i)
#pragma unroll
        for (int j = 0; j < NJ; ++j) acc[i][j] = __builtin_amdgcn_mfma_f32_16x16x32_bf16(bf[j], af[i], acc[i][j], 0, 0, 0);
    }
    if (more) {
      bf16_t* dA = s0 + ((kt + 1) & 1) * BUF;
#pragma unroll
      for (int i = 0; i < 2; ++i) { int c = tid + NTHR * i, r = c >> 3, cc = c & 7; *(u4v*)(dA + r * LDS_STR + cc * 8) = ra[i]; }
#pragma unroll
      for (int i = 0; i < NBL; ++i) { int c = tid + NTHR * i;
        if (BT) { int q = c & 63, dc = c >> 6;
#pragma unroll
          for (int e = 0; e < 8; ++e) dA[(128 + dc * 8 + e) * LDS_STR + q] = (bf16_t)(rb[i][e >> 1] >> ((e & 1) * 16)); }
        else { int r = c >> 3, cc = c & 7; *(u4v*)(dA + (128 + r) * LDS_STR + cc * 8) = rb[i]; } }
      __syncthreads();
    }
  }
}
template <int NJ>
__device__ __forceinline__ void gemm_deep(const GT& t, char* smem, f4v (&acc)[2][NJ]) {
  constexpr int NBL = NJ / 2;
  constexpr int BUF = (128 + 128) * LDS_STR;
  bf16_t* s0 = (bf16_t*)smem;
  const int tid = my_tid(), lane = tid & 63, wid = tid >> 6, wm = wid >> 1, wn = wid & 1;
  const bf16_t* ap[2]; const bf16_t* bp[NBL];
  gemm_ptrs<NJ>(t, tid, ap, bp);
  const int nk = t.K >> 6;
  u4v pa0[2], pb0[NBL], pa1[2], pb1[NBL];
#define GD_LOAD(PA, PB, kt_) do { const int kq = (kt_) < nk ? (kt_) : nk - 1; \
    _Pragma("unroll") for (int i = 0; i < 2; ++i) PA[i] = *(const u4v*)(ap[i] + kq * 64); \
    _Pragma("unroll") for (int i = 0; i < NBL; ++i) PB[i] = *(const u4v*)(bp[i] + kq * 64); } while (0)
#define GD_STORE(PA, PB, buf_) do { bf16_t* dA = s0 + (buf_) * BUF; \
    _Pragma("unroll") for (int i = 0; i < 2; ++i) { int c = tid + NTHR * i, r = c >> 3, cc = c & 7; *(u4v*)(dA + r * LDS_STR + cc * 8) = PA[i]; } \
    _Pragma("unroll") for (int i = 0; i < NBL; ++i) { int c = tid + NTHR * i, r = c >> 3, cc = c & 7; *(u4v*)(dA + (128 + r) * LDS_STR + cc * 8) = PB[i]; } } while (0)
#define GD_COMPUTE(buf_) do { const bf16_t* sA = s0 + (buf_) * BUF; const bf16_t* sB = sA + 128 * LDS_STR; \
    _Pragma("unroll") for (int ks = 0; ks < 2; ++ks) { s8v af[2], bf[NJ]; \
      _Pragma("unroll") for (int i = 0; i < 2; ++i) af[i] = *(const s8v*)(sA + (wm * 32 + i * 16 + (lane & 15)) * LDS_STR + ks * 32 + (lane >> 4) * 8); \
      _Pragma("unroll") for (int j = 0; j < NJ; ++j) bf[j] = *(const s8v*)(sB + (wn * NJ * 16 + j * 16 + (lane & 15)) * LDS_STR + ks * 32 + (lane >> 4) * 8); \
      _Pragma("unroll") for (int i = 0; i < 2; ++i) _Pragma("unroll") for (int j = 0; j < NJ; ++j) acc[i][j] = __builtin_amdgcn_mfma_f32_16x16x32_bf16(bf[j], af[i], acc[i][j], 0, 0, 0); } } while (0)
  GD_LOAD(pa0, pb0, 0); SCHED_FENCE();
  GD_LOAD(pa1, pb1, 1); SCHED_FENCE();
  __syncthreads();
  GD_STORE(pa0, pb0, 0);
  __syncthreads();
  for (int kt = 0; kt < nk; kt += 2) {
    GD_LOAD(pa0, pb0, kt + 2); SCHED_FENCE();
    GD_COMPUTE(0);
    if (kt + 1 < nk) { GD_STORE(pa1, pb1, 1); }
    __syncthreads();
    if (kt + 1 >= nk) break;
    GD_LOAD(pa1, pb1, kt + 3); SCHED_FENCE();
    GD_COMPUTE(1);
    if (kt + 2 < nk) { GD_STORE(pa0, pb0, 0); }
    __syncthreads();
  }
#undef GD_LOAD
#undef GD_STORE
#undef GD_COMPUTE
}

template <int NJ, bool BT = false>
__device__ __forceinline__ void gemm_mainloop(const bf16_t* __restrict__ A, long lda, int arow0, int arows, const bf16_t* __restrict__ B,
                                              long ldb, int brow0, int brows, int K, char* smem, f4v (&acc)[2][NJ]) {
  GT t = mk_gt(A, lda, arow0, arows, B, ldb, brow0, brows, K, BT ? 1 : 0);
  u4v ra[2], rb[NJ / 2];
  gemm_prefetch<NJ>(t, ra, rb);
  gemm_run<NJ, BT>(t, nullptr, ra, rb, smem, acc);
}

template <int NJ, class F>
__device__ __forceinline__ void epi_foreach(f4v (&acc)[2][NJ], int row0, int col0, F f) {
  const int tid = my_tid(), lane = tid & 63, wid = tid >> 6, wm = wid >> 1, wn = wid & 1;
#pragma unroll
  for (int i = 0; i < 2; ++i)
#pragma unroll
    for (int j = 0; j < NJ; ++j) f(row0 + wm * 32 + i * 16 + (lane & 15), col0 + wn * NJ * 16 + j * 16 + (lane >> 4) * 4, acc[i][j]);
}
__device__ __forceinline__ u4v pack8(const float (&x)[8]) {
  return u4v{pk2bf(x[0], x[1]), pk2bf(x[2], x[3]), pk2bf(x[4], x[5]), pk2bf(x[6], x[7])};
}
__device__ __forceinline__ void unpack8(u4v u, float (&x)[8]) {
  x[0] = bflo(u.x); x[1] = bfhi(u.x); x[2] = bflo(u.y); x[3] = bfhi(u.y); x[4] = bflo(u.z); x[5] = bfhi(u.z); x[6] = bflo(u.w); x[7] = bfhi(u.w);
}
__device__ __forceinline__ u2v pack4(float a, float b, float c, float d) {
  return u2v{pk2bf(a, b), pk2bf(c, d)};
}

#ifndef EMU
namespace pg8 {
#define PG8_LAS __attribute__((address_space(3)))
typedef unsigned short bf16_t;
typedef short bf16x8 __attribute__((ext_vector_type(8)));
typedef float f32x4 __attribute__((ext_vector_type(4)));
typedef unsigned u32x4 __attribute__((ext_vector_type(4)));
constexpr int BM = 256, BK = 64, HALF = 128, HTB = HALF * BK * 2  , STAGE_BYTES = 8 * HTB, NXCD = 8, WGM = 8;

__host__ __device__ __forceinline__ int lds_byte(int r, int c) { const int st = (r >> 4) * 2 + (c >> 5), rr = r & 15, cc = c & 31, ob = rr * 64 + cc * 2; return st * 1024 + (ob ^ (((ob >> 9) & 1) << 5)); }
__host__ __device__ __forceinline__ void stage_rc(int b, int& R, int& C) { const int st = b / 1024, sb = b % 1024, swz = sb ^ (((sb >> 9) & 1) << 5); R = (st >> 1) * 16 + swz / 64; C = (st & 1) * 32 + (swz % 64) / 2; }
__host__ __device__ __forceinline__ int perm32(int rho) { const int n = rho >> 4, i = rho & 15; return 8 * (i >> 2) + 4 * n + (i & 3); }

struct Unit { int pm, pn; };
struct Gemm { const bf16_t* A; const bf16_t* Bt; int M, N, K; };

struct StaticOrder {
    int nM, nN, nwg, G, c;
    __host__ __device__ void init(int M, int N, int G_, int c_) { nM = M / BM; nN = N / BM; nwg = nM * nN; G = G_; c = c_; }
    __host__ __device__ bool next(int i, Unit& u) const {
        const long L = (long)i * G + c; if (L >= nwg) return false;
        int wgid = (int)L; { const int q = nwg / NXCD, r = nwg % NXCD, xcd = wgid % NXCD, off = wgid / NXCD; wgid = (xcd < r ? xcd * (q + 1) : r * (q + 1) + (xcd - r) * q) + off; }
        const int nig = WGM * nN, gid = wgid / nig, fm = gid * WGM, gsz = (nM - fm) < WGM ? (nM - fm) : WGM;
        u.pm = fm + ((wgid % nig) % gsz); u.pn = (wgid % nig) / gsz; return true;
    }
    __device__ __forceinline__ void a_ready(const Unit&) const {}
    __device__ __forceinline__ void done(const Unit&) const {}
};
template <class Epi, class Sched>
__device__ __forceinline__ void gemm_phase(PG8_LAS unsigned char* lds, const Gemm g, const Sched& S, const Epi& E) {
    const int tid = my_tid(), wid = __builtin_amdgcn_readfirstlane(tid >> 6), lane = tid & 63, wr = wid >> 2, wc = wid & 3, fr = lane & 15, fq = lane >> 4;
    const int K = g.K, nt = K / BK;
    unsigned voffA[2], voffB[2];
#pragma unroll
    for (int i = 0; i < 2; ++i) { int R, C; stage_rc(tid * 16 + i * 8192, R, C); const int Rb = Epi::PERM ? ((R & ~31) + perm32(R & 31)) : R;
        voffA[i] = (unsigned)(R * K + C) * 2u; voffB[i] = (unsigned)(Rb * K + C) * 2u; }
    const size_t kstep = (size_t)(BK * 2);
    const size_t hstep = (size_t)HALF * K * 2;
    const size_t tstep = 2 * hstep;
    const unsigned ldsw = (unsigned)wid * 1024u;
    const int aoff = lds_byte(wr * 64 + fr, fq * 8), boff = lds_byte(wc * 32 + fr, fq * 8);
#define PG8_SA(b, h) (((b) * 2 + (h)) * HTB)
#define PG8_SB(b, h) ((4 + (b) * 2 + (h)) * HTB)
#define PG8_STAGE(bufoff, gbase, voff) do { _Pragma("unroll") for (int _i = 0; _i < 2; ++_i) \
        __builtin_amdgcn_global_load_lds((const unsigned*)((const char*)(gbase) + (voff)[_i]), (PG8_LAS unsigned*)(lds + (bufoff) + ldsw + _i * 8192), 16, 0, 0); } while (0)
#define PG8_LDA(dst, b, h) do { _Pragma("unroll") for (int m = 0; m < 4; ++m) _Pragma("unroll") for (int k = 0; k < 2; ++k) dst[m][k] = *(const PG8_LAS bf16x8*)(lds + PG8_SA(b, h) + aoff + m * 2048 + k * 1024); } while (0)
#define PG8_LDB(dst, b, h) do { _Pragma("unroll") for (int n = 0; n < 2; ++n) _Pragma("unroll") for (int k = 0; k < 2; ++k) dst[n][k] = *(const PG8_LAS bf16x8*)(lds + PG8_SB(b, h) + boff + n * 2048 + k * 1024); } while (0)
#define PG8_MMA(ai, bj, At, Bt) do { __builtin_amdgcn_s_setprio(1); _Pragma("unroll") for (int m = 0; m < 4; ++m) _Pragma("unroll") for (int n = 0; n < 2; ++n) _Pragma("unroll") for (int k = 0; k < 2; ++k) \
        acc[ai][bj][m][n] = __builtin_amdgcn_mfma_f32_16x16x32_bf16(Bt[n][k], At[m][k], acc[ai][bj][m][n], 0, 0, 0); __builtin_amdgcn_s_setprio(0); } while (0)
#define PG8_WAIT_V(n) asm volatile("s_waitcnt vmcnt(" #n ")" ::: "memory")
#define PG8_WAIT_L(n) asm volatile("s_waitcnt lgkmcnt(" #n ")" ::: "memory")
#define PG8_BAR __builtin_amdgcn_s_barrier()
#define PG8_SCHED __builtin_amdgcn_sched_barrier(0)
    Unit cur, nxt; int ui = 0;
    if (!S.next(0, cur)) return;
    f32x4 acc[2][2][4][2];
#pragma unroll
    for (int a = 0; a < 2; ++a)
#pragma unroll
        for (int b = 0; b < 2; ++b)
#pragma unroll
            for (int m = 0; m < 4; ++m)
#pragma unroll
                for (int n = 0; n < 2; ++n) acc[a][b][m][n] = (f32x4){0.f, 0.f, 0.f, 0.f};
    bf16x8 At[4][2], B0[2][2], B1[2][2];
    const char* cA = (const char*)g.A + (size_t)cur.pm * tstep; const char* cB = (const char*)g.Bt + (size_t)cur.pn * tstep;
    S.a_ready(cur);
    PG8_STAGE(PG8_SB(0, 0), cB, voffB); PG8_STAGE(PG8_SA(0, 0), cA, voffA); PG8_STAGE(PG8_SB(0, 1), cB + hstep, voffB); PG8_STAGE(PG8_SA(0, 1), cA + hstep, voffA);
    if (wr == 1) PG8_BAR;
    PG8_WAIT_V(4); PG8_BAR;
    PG8_STAGE(PG8_SB(1, 0), cB + kstep, voffB); PG8_STAGE(PG8_SA(1, 0), cA + kstep, voffA); PG8_STAGE(PG8_SB(1, 1), cB + hstep + kstep, voffB);
    PG8_WAIT_V(6); PG8_BAR;
    for (;;) {
        const bool has_next = S.next(ui + 1, nxt);
        const char* nA = has_next ? (const char*)g.A + (size_t)nxt.pm * tstep : cA; const char* nB = has_next ? (const char*)g.Bt + (size_t)nxt.pn * tstep : cB;
        for (int t = 0; t < nt; t += 2) {
            const bool last = (t == nt - 2);
            const char* a1 = cA + (size_t)(t + 1) * kstep;
            const char* a2 = last ? nA : cA + (size_t)(t + 2) * kstep; const char* b2 = last ? nB : cB + (size_t)(t + 2) * kstep;
            const char* a3 = a2 + kstep; const char* b3 = b2 + kstep;
            if (last && has_next) S.a_ready(nxt);
            PG8_LDB(B0, 0, 0); PG8_SCHED; PG8_LDA(At, 0, 0); PG8_STAGE(PG8_SA(1, 1), a1 + hstep, voffA);
            PG8_WAIT_L(8); PG8_BAR; PG8_WAIT_L(0); PG8_MMA(0, 0, At, B0); PG8_BAR; PG8_SCHED;
            PG8_LDB(B1, 0, 1); PG8_STAGE(PG8_SB(0, 0), b2, voffB);
            PG8_BAR; PG8_WAIT_L(0); PG8_MMA(0, 1, At, B1); PG8_BAR;
            PG8_LDA(At, 0, 1); PG8_STAGE(PG8_SA(0, 0), a2, voffA);
            PG8_BAR; PG8_WAIT_L(0); PG8_MMA(1, 0, At, B0); PG8_BAR; PG8_SCHED;
            PG8_STAGE(PG8_SB(0, 1), b2 + hstep, voffB);
            PG8_WAIT_V(6); PG8_BAR; PG8_MMA(1, 1, At, B1); PG8_BAR;
            PG8_LDB(B0, 1, 0); PG8_SCHED; PG8_LDA(At, 1, 0); PG8_STAGE(PG8_SA(0, 1), a2 + hstep, voffA);
            PG8_WAIT_L(8); PG8_BAR; PG8_WAIT_L(0); PG8_MMA(0, 0, At, B0); PG8_BAR; PG8_SCHED;
            PG8_LDB(B1, 1, 1); PG8_STAGE(PG8_SB(1, 0), b3, voffB);
            PG8_BAR; PG8_WAIT_L(0); PG8_MMA(0, 1, At, B1); PG8_BAR;
            PG8_LDA(At, 1, 1); PG8_STAGE(PG8_SA(1, 0), a3, voffA);
            PG8_BAR; PG8_WAIT_L(0); PG8_MMA(1, 0, At, B0); PG8_BAR; PG8_SCHED;
            PG8_STAGE(PG8_SB(1, 1), b3 + hstep, voffB);
            PG8_WAIT_V(6); PG8_BAR; PG8_MMA(1, 1, At, B1); PG8_BAR;
        }
            if constexpr (!Epi::AFTER_DRAIN) { E(acc, cur, wr, wc, fr, fq); S.done(cur); }
            if (!has_next) break;
#pragma unroll
        for (int a = 0; a < 2; ++a)
#pragma unroll
            for (int b = 0; b < 2; ++b)
#pragma unroll
                for (int m = 0; m < 4; ++m)
#pragma unroll
                    for (int n = 0; n < 2; ++n) acc[a][b][m][n] = (f32x4){0.f, 0.f, 0.f, 0.f};
        cur = nxt; cA = nA; cB = nB; ++ui;
    }
    PG8_WAIT_V(0);
    if (wr == 0) PG8_BAR;
    PG8_BAR;
    if constexpr (Epi::AFTER_DRAIN) { E.fused(acc, cur, wr, wc, fr, fq, lds, wid, lane); S.done(cur); }
#undef PG8_SA
#undef PG8_SB
#undef PG8_STAGE
#undef PG8_LDA
#undef PG8_LDB
#undef PG8_MMA
#undef PG8_WAIT_V
#undef PG8_WAIT_L
#undef PG8_BAR
#undef PG8_SCHED
}

__device__ __forceinline__ unsigned pk2(float lo, float hi) { return pk2bf(lo, hi); }
struct EpiStore {
  static constexpr bool PERM = true, AFTER_DRAIN = false;
  bf16_t* O; int ldc; int ncols; int coff;
  __device__ __forceinline__ void operator()(const f32x4 (&acc)[2][2][4][2], const Unit& u, int wr, int wc, int fr, int fq) const {
    const int row0 = u.pm * BM + wr * 64 + fr, col0 = u.pn * BM + wc * 32 + 8 * fq;
#pragma unroll
    for (int ai = 0; ai < 2; ++ai)
#pragma unroll
      for (int m = 0; m < 4; ++m) { bf16_t* rowp = O + (size_t)(row0 + ai * HALF + m * 16) * ldc + coff + col0;
#pragma unroll
        for (int bj = 0; bj < 2; ++bj) if (col0 + bj * HALF < ncols) { const f32x4 v0 = acc[ai][bj][m][0], v1 = acc[ai][bj][m][1];
          *(u32x4*)(rowp + bj * HALF) = (u32x4){pk2(v0[0], v0[1]), pk2(v0[2], v0[3]), pk2(v1[0], v1[1]), pk2(v1[2], v1[3])}; } }
  }
};
struct EpiSigmoid {
  static constexpr bool PERM = true, AFTER_DRAIN = false;
  bf16_t* O; int ldc; const float* bias;
  __device__ __forceinline__ void operator()(const f32x4 (&acc)[2][2][4][2], const Unit& u, int wr, int wc, int fr, int fq) const {
    const int row0 = u.pm * BM + wr * 64 + fr, col0 = u.pn * BM + wc * 32 + 8 * fq;
    f32x4 bv[2][2];
#pragma unroll
    for (int bj = 0; bj < 2; ++bj)
#pragma unroll
      for (int n = 0; n < 2; ++n) bv[bj][n] = *(const f32x4*)(bias + col0 + bj * HALF + 4 * n);
#pragma unroll
    for (int ai = 0; ai < 2; ++ai)
#pragma unroll
      for (int m = 0; m < 4; ++m) { bf16_t* rowp = O + (size_t)(row0 + ai * HALF + m * 16) * ldc + col0;
#pragma unroll
        for (int bj = 0; bj < 2; ++bj) { const f32x4 v0 = acc[ai][bj][m][0] + bv[bj][0], v1 = acc[ai][bj][m][1] + bv[bj][1];
          *(u32x4*)(rowp + bj * HALF) = (u32x4){pk2(sigmoidf_(v0[0]), sigmoidf_(v0[1])), pk2(sigmoidf_(v0[2]), sigmoidf_(v0[3])), pk2(sigmoidf_(v1[0]), sigmoidf_(v1[1])), pk2(sigmoidf_(v1[2]), sigmoidf_(v1[3]))}; } }
  }
};
}
#endif

struct TJob { const float* src; int K, N; long lds; bf16_t* dst; long ldd; };
__device__ __forceinline__ TJob get_tjob(const Params& p, int l, int j) {
  TJob t; char* ws = p.ws;
  if (j < 10) {
    const int seg[10][3] = {{0, 1728, 0}, {1728, 512, ZC_GA}, {2240, 256, ZC_QD}, {2496, 128, ZC_KVD}, {2624, 32, ZC_KR}, {2656, 512, ZC_GB}, {3168, 512, ZC_U}, {3680, 512, ZC_VC}, {4192, 512, ZC_GC}, {4704, 1024, ZC_F}};
    int sc = 0, wd = 0, zc = 0;
#pragma unroll
    for (int q = 0; q < 10; ++q) if (q == j) { sc = seg[q][0]; wd = seg[q][1]; zc = seg[q][2]; }
    const int wrow = zc < Z1_W ? zc : zc + (Z1_WP - Z1_W);
    t.src = p.w_in + (size_t)l * 1024 * IN_W + sc; t.K = 1024; t.N = wd; t.lds = IN_W; t.dst = (bf16_t*)(ws + O_WINT) + (size_t)wrow * 1024; t.ldd = 1024; return t; }
  j -= 9;
  if (j == 1) { t.src = p.w_merge + (size_t)l * 1024 * 4096; t.K = 1024; t.N = 4096; t.lds = 4096; t.dst = (bf16_t*)(ws + O_WMT); t.ldd = 1024; }
  else if (j < 6) { int n = j - 2; t.src = p.w_branch + ((size_t)l * 4 + n) * 512 * 1024; t.K = 512; t.N = 1024; t.lds = 1024; t.dst = (bf16_t*)(ws + O_WBRT) + (size_t)n * 1024 * 512; t.ldd = 512; }
  else if (j == 6) { t.src = p.w_out + (size_t)l * 1024 * 1024; t.K = 1024; t.N = 1024; t.lds = 1024; t.dst = (bf16_t*)(ws + O_WOUTT); t.ldd = 1024; }
  else if (j == 7) { t.src = p.w_q_up + (size_t)l * 256 * 768; t.K = 256; t.N = 768; t.lds = 768; t.dst = (bf16_t*)(ws + O_WQT); t.ldd = 256; }
  else if (j == 8) { t.src = p.w_kv_up + (size_t)l * 128 * 1024; t.K = 128; t.N = 1024; t.lds = 1024; t.dst = (bf16_t*)(ws + O_WKVT); t.ldd = 128; }
  else { int n = j - 9;
    t.src = (n < 2 ? p.w_up : p.a_up) + ((size_t)l * 2 + (n & 1)) * 64 * 512; t.K = 64; t.N = 512; t.lds = 512;
    t.dst = (bf16_t*)(ws + O_WUPT) + (size_t)n * 512 * 64; t.ldd = 64; }
  return t;
}
constexpr int NTJOBS = 22;

__device__ __forceinline__ void stage_prep(const Params& p, int l, int bid, int nb, char* smem) {
  const int tid = my_tid();
  char* ws = p.ws;
  {
    float* tile = (float*)smem;
    int total = 0;
    for (int j = 0; j < NTJOBS; ++j) { TJob t = get_tjob(p, l, j); total += (t.K / 64) * ((t.N + 63) / 64); }
    f4v pre[2]; bool pv[2];
    auto locate = [&](int q, TJob& t, int& kt, int& nt_) { int base = 0;
      for (int j = 0; j < NTJOBS; ++j) { t = get_tjob(p, l, j); int tn = (t.N + 63) / 64, nt = (t.K / 64) * tn; if (q < base + nt) { int r = q - base; kt = r / tn; nt_ = r % tn; return; } base += nt; } };
    auto issue = [&](int q) { TJob t; int kt = 0, nt_ = 0; locate(q, t, kt, nt_);
#pragma unroll
      for (int i = 0; i < 2; ++i) { int e = tid + NTHR * i, r = e >> 4, c4 = e & 15; int n0 = nt_ * 64 + c4 * 4; pv[i] = n0 < t.N;
        pre[i] = pv[i] ? *(const f4v*)(t.src + (long)(kt * 64 + r) * t.lds + n0) : f4v{0.f, 0.f, 0.f, 0.f}; } };
    if (bid < total) issue(bid);
    for (int q = bid; q < total; q += nb) {
      TJob t; int kt = 0, nt_ = 0; locate(q, t, kt, nt_);
      __syncthreads();
#pragma unroll
      for (int i = 0; i < 2; ++i) { int e = tid + NTHR * i, r = e >> 4, c4 = e & 15;
        tile[r * 65 + c4 * 4] = pre[i][0]; tile[r * 65 + c4 * 4 + 1] = pre[i][1]; tile[r * 65 + c4 * 4 + 2] = pre[i][2]; tile[r * 65 + c4 * 4 + 3] = pre[i][3]; }
      __syncthreads();
      if (q + nb < total) issue(q + nb);
      { int n = tid >> 3, kc = tid & 7; float x[8];
        if (nt_ * 64 + n < t.N) {
#pragma unroll
          for (int e = 0; e < 8; ++e) x[e] = tile[(kc * 8 + e) * 65 + n];
          *(u4v*)(t.dst + (long)(nt_ * 64 + n) * t.ldd + kt * 64 + kc * 8) = pack8(x); } }
    }
    __syncthreads();
  }
  const long gtid = (long)bid * NTHR + tid, gn = (long)nb * NTHR;
  { bf16_t* d = (bf16_t*)(ws + O_WINT) + (size_t)Z1_W * 1024; for (long i = gtid; i < (long)(Z1_WP - Z1_W) * 1024; i += gn) d[i] = 0; }
  { bf16_t* d = (bf16_t*)(ws + O_WS); const float* s = p.g_w_s + (size_t)l * 4 * 128 * 128; for (long i = gtid; i < (long)4 * 128 * 128; i += gn) d[i] = f2bf(s[i]); }
  if (l != 0) return;
  { bf16_t* d = (bf16_t*)(ws + O_CS128);
    for (long i = gtid; i < 256 * 128; i += gn) { int j = (int)(i >> 7), c = (int)(i & 127); int mm = ((j & 127) * c) & 127; float x = 2.0f * mm / 128.f; d[i] = f2bf(j < 128 ? cospif(x) : sinpif(x)); } }
  { bf16_t* d = (bf16_t*)(ws + O_A2C);
    for (long i = gtid; i < (long)T_C * 2 * T_C; i += gn) { int tp = (int)(i / (2 * T_C)), tt = (int)(i % (2 * T_C)); int half = tt >= T_C; int t = half ? tt - T_C : tt; int mm = (int)(((long)tp * t) % T_C); float x = 2.0f * mm / (float)T_C; d[i] = f2bf(half ? -sinpif(x) : cospif(x)); } }
  { bf16_t* d = (bf16_t*)(ws + O_A2D);
    for (long i = gtid; i < (long)T_D * 2 * T_D; i += gn) { int tp = (int)(i / (2 * T_D)), tt = (int)(i % (2 * T_D)); int half = tt >= T_D; int t = half ? tt - T_D : tt; int mm = (int)(((long)tp * t) % T_D); float x = 2.0f * mm / (float)T_D; d[i] = f2bf(half ? -sinpif(x) : cospif(x)); } }
  { float* d = (float*)(ws + O_ROPE);
    for (long i = gtid; i < (long)T_D * 16; i += gn) { int t = (int)(i >> 4), pi = (int)(i & 15); float pos = (pi < 8) ? (float)(t / 64) : (float)(t % 64); float inv = expf(-(float)(pi & 7) * (9.210340371976184f / 8.f)); float a = pos * inv; d[2 * i] = cosf(a); d[2 * i + 1] = sinf(a); } }
  { float4* d = (float4*)p.out; const float4* s0 = (const float4*)p.x_prompt; const float4* s1 = (const float4*)p.x_sample;
    for (long i = gtid; i < (long)M * 256; i += gn) d[i] = (i < (long)M_C * 256) ? s0[i] : s1[i - (long)M_C * 256]; }
  {
    float* sc = (float*)smem;
    float* red = sc + 3 * 1024;
    float* modp = (float*)(ws + O_MOD);
    if (bid < NL * 96) {
      __syncthreads();
      for (int i = tid; i < 3 * 1024; i += NTHR) { int mi = i >> 10, k = i & 1023; sc[i] = siluf_(mi == 0 ? p.c_ctx[k] : p.c[(mi == 2 && NB_D > 1 ? 1024 : 0) + k]); }
      __syncthreads();
    }
    for (int u = bid; u < NL * 96; u += nb) {
      int ll = u / 96, cg = u % 96; int cl = tid & 31, kq = tid >> 5, col = cg * 32 + cl;
      float a0 = 0.f, a1 = 0.f, a2 = 0.f;
      const float* w = p.w_ada + (size_t)ll * 1024 * 3072 + col;
#pragma unroll 16
      for (int k = kq * 64; k < kq * 64 + 64; ++k) {
        float wv = w[(size_t)k * 3072];
        a0 += sc[k] * wv; a1 += sc[1024 + k] * wv; a2 += sc[2048 + k] * wv;
      }
      __syncthreads();
      red[(kq * 3 + 0) * 32 + cl] = a0; red[(kq * 3 + 1) * 32 + cl] = a1; red[(kq * 3 + 2) * 32 + cl] = a2;
      __syncthreads();
      if (tid < 96) { int mi = tid >> 5, cc = tid & 31; float s2 = 0.f;
#pragma unroll
        for (int q8 = 0; q8 < 16; ++q8) s2 += red[(q8 * 3 + mi) * 32 + cc];
        modp[((size_t)ll * 3 + mi) * 3072 + cg * 32 + cc] = s2 + p.b_ada[(size_t)ll * 3072 + cg * 32 + cc]; }
    }
  }
}

__device__ __forceinline__ int mod_index(const Grp& g, int lm) { return g.isden ? 1 + lm / T_D : 0; }

__device__ __forceinline__ void stage_h(const Params& p, const Grp& g, int l, int bid, int nb) {
  const int lane = my_tid() & 63, wid = my_tid() >> 6;
  const float* X = p.out + (size_t)g.m0 * 1024;
  bf16_t* H = (bf16_t*)(p.ws + O_H);
  const float* modp = (const float*)(p.ws + O_MOD) + (size_t)l * 3 * 3072;
  const float* gam = p.norm_g + (size_t)l * 1024;
  for (int m = bid * NWAVE + wid; m < g.mg; m += nb * NWAVE) {
    const float* xr = X + (size_t)m * 1024; float v[16]; float ss = 0.f;
#pragma unroll
    for (int i = 0; i < 4; ++i) { float4 q = *(const float4*)(xr + i * 256 + lane * 4); v[4 * i] = q.x; v[4 * i + 1] = q.y; v[4 * i + 2] = q.z; v[4 * i + 3] = q.w; ss += q.x * q.x + q.y * q.y + q.z * q.z + q.w * q.w; }
    ss = wave_sum(ss); float rs = rsqrtf(ss * (1.f / 1024.f) + 1e-6f);
    const float* mo = modp + (size_t)mod_index(g, m) * 3072;
#pragma unroll
    for (int i = 0; i < 4; ++i) {
      int c = i * 256 + lane * 4; bf16_t o[4];
#pragma unroll
      for (int e = 0; e < 4; ++e) o[e] = f2bf(v[4 * i + e] * rs * gam[c + e] * (1.f + mo[1024 + c + e]) + mo[c + e]);
      *(u2v*)(H + (size_t)m * 1024 + c) = u2v{(unsigned)o[0] | ((unsigned)o[1] << 16), (unsigned)o[2] | ((unsigned)o[3] << 16)};
    }
  }
}

__device__ __forceinline__ int g1b_blocks(const Grp& g, int nb) { int u = ((g.mg + 255) / 256) * (Z2_W / 256); int h = nb / 2; return u < h ? u : h; }
__device__ __forceinline__ void stage_g1(const Params& p, const Grp& g, int part, int bid, int nb, char* smem) {
  const bf16_t* H = (const bf16_t*)(p.ws + O_H);
  const bf16_t* W = (const bf16_t*)(p.ws + O_WINT) + (part ? (size_t)Z1_WP * 1024 : 0);
  bf16_t* Z = (bf16_t*)(p.ws + O_Z);
  const int NW = part ? Z2_W : Z1_W, NWP = part ? Z2_W : Z1_WP, coff = part ? Z1_W : 0;
  if (part) { nb = g1b_blocks(g, nb); if (bid >= nb) return; }
#ifndef EMU
  if ((g.mg & 255) == 0) {
    pg8::Gemm gm; gm.A = H; gm.Bt = W; gm.M = g.mg; gm.N = NWP; gm.K = 1024;
    pg8::StaticOrder S; S.init(gm.M, gm.N, nb, bid);
    pg8::EpiStore E; E.O = Z; E.ldc = IN_W; E.ncols = NW; E.coff = coff;
    pg8::gemm_phase<pg8::EpiStore, pg8::StaticOrder>((PG8_LAS unsigned char*)smem, gm, S, E);
    return;
  }
#endif
  const int TM = (g.mg + 127) / 128, TN = (NW + 127) / 128;
  const int mg = g.mg;
  for (int t = bid; t < TM * TN; t += nb) {
    int tn = t / TM, tm = t % TM; f4v acc[2][4]; zero_acc<4>(acc);
    gemm_mainloop<4>(H, 1024, tm * 128, mg, W, 1024, tn * 128, NWP, 1024, smem, acc);
    epi_foreach<4>(acc, tm * 128, tn * 128, [&](int row, int c0, f4v& v) {
      if (c0 < NW && row < mg) *(u2v*)(Z + (size_t)row * IN_W + coff + c0) = pack4(v[0], v[1], v[2], v[3]);
    });
  }
}

__device__ __forceinline__ void stage_e1(const Params& p, const Grp& g, int l, int bid, int nb) {
  { const int nbA = g1b_blocks(g, nb); if (bid < nbA) return; bid -= nbA; nb -= nbA; }
  const int lane = my_tid() & 63, wid = my_tid() >> 6;
  char* ws = p.ws;
  const bf16_t* Z = (const bf16_t*)(ws + O_Z);
  bf16_t* SK = (bf16_t*)(ws + O_SK); bf16_t* SOP = (bf16_t*)(ws + O_SOP);
  bf16_t* LORA = (bf16_t*)(ws + O_LORA); bf16_t* QDN = (bf16_t*)(ws + O_QDN); bf16_t* CKV = (bf16_t*)(ws + O_CKV); bf16_t* KR = (bf16_t*)(ws + O_KR);
  bf16_t* VCN = (bf16_t*)(ws + O_VCNT);
  const float* rope = (const float*)(ws + O_ROPE);
  const float* mu = p.shift_mu + (size_t)l * SHIFT_W;
  const int isden = g.isden, T = g.T;
  for (int m = bid * NWAVE + wid; m < g.mkv; m += nb * NWAVE) {
    if (m >= g.mg) {
      int r = m - g.mg, b = r / PAST, j = r % PAST;
      if (lane < 20) {
        const float* s = lane < 16 ? p.c_ckv + (((size_t)b * NL + l) * PAST + j) * 128 + lane * 8 : p.c_kr + (((size_t)b * NL + l) * PAST + j) * 32 + (lane - 16) * 8;
        f4v x0 = *(const f4v*)s, x1 = *(const f4v*)(s + 4); float x[8] = {x0[0], x0[1], x0[2], x0[3], x1[0], x1[1], x1[2], x1[3]};
        if (lane < 16) *(u4v*)(CKV + (size_t)m * 128 + lane * 8) = pack8(x);
        else { const int key = T + j, d8 = lane - 16;
          *(u4v*)(KR + ((((size_t)b * (g.nkeys >> 5) + (key >> 5)) * 2 + (d8 >> 1)) * 64 + (d8 & 1) * 32 + (key & 31)) * 8) = pack8(x); }
      }
      continue;
    }
    const int sq = m / T, t = m % T, b = g.b0 + sq;
    const bf16_t* z = Z + (size_t)m * IN_W;
    const bool hp = t > 0, hn = t < T - 1;
#pragma unroll
    for (int it = 0; it < 4; ++it) {
      const int ci = it * 64 + lane; const bool valid = ci < 216; const int cc = valid ? ci : 0;
      float zc[8], pv[8], nv[8], sf[8];
      unpack8(*(const u4v*)(z + cc * 8), zc);
      if (hp) unpack8(*(const u4v*)(z - IN_W + cc * 8), pv); else { for (int e = 0; e < 8; ++e) pv[e] = 0.f; }
      if (hn) unpack8(*(const u4v*)(z + IN_W + cc * 8), nv); else { for (int e = 0; e < 8; ++e) nv[e] = 0.f; }
      f4v m0 = *(const f4v*)(mu + cc * 8), m1 = *(const f4v*)(mu + cc * 8 + 4);
#pragma unroll
      for (int e = 0; e < 8; ++e) sf[e] = zc[e] + (0.5f * (pv[e] + nv[e]) - zc[e]) * (e < 4 ? m0[e] : m1[e - 4]);
      bf16_t* rec = SOP + (((size_t)sq * 8 + (lane >> 3)) * T + t) * 576 + (lane & 7) * 8;
      if (it == 0) *(u4v*)rec = pack8(sf);
      else if (it == 1) {
        *(u4v*)(SK + (size_t)m * 512 + lane * 8) = pack8(sf);
        f4v k0 = *(const f4v*)(p.k_k + (size_t)l * 512 + lane * 8), k1 = *(const f4v*)(p.k_k + (size_t)l * 512 + lane * 8 + 4);
        float kr[8]; float n2 = 0.f;
#pragma unroll
        for (int e = 0; e < 8; ++e) { kr[e] = sf[e] * (e < 4 ? k0[e] : k1[e - 4]); n2 += kr[e] * kr[e]; }
        n2 = sum_lpr<8>(n2); const float inv = 1.f / fmaxf(sqrtf(n2), 1e-12f);
#pragma unroll
        for (int e = 0; e < 8; ++e) kr[e] *= inv;
        *(u4v*)(rec + 64) = pack8(kr);
      }
      else if (it == 2) *(u4v*)(rec + 128) = pack8(sf);
      else if (valid) {
        if (lane < 16) { for (int e = 0; e < 8; ++e) sf[e] = tanhf_(sf[e]); }
        *(u4v*)(LORA + (size_t)m * 192 + lane * 8) = pack8(sf);
      }
    }
    {
      const int col = lane < 32 ? ZC_QD + lane * 8 : (lane < 48 ? ZC_KVD + (lane - 32) * 8 : ZC_KR + ((lane - 48) & 3) * 8);
      float x[8]; unpack8(*(const u4v*)(z + col), x);
      float ss = 0.f;
#pragma unroll
      for (int e = 0; e < 8; ++e) ss += x[e] * x[e];
      const float t32 = sum_lpr<32>(ss), t16 = sum_lpr<16>(ss);
      if (lane < 32) {
        const float rs = rsqrtf(t32 * (1.f / 256.f) + 1e-6f); const float* gq = p.q_norm + (size_t)l * 256 + lane * 8; float o[8];
#pragma unroll
        for (int e = 0; e < 8; ++e) o[e] = x[e] * rs * gq[e];
        *(u4v*)(QDN + (size_t)m * 256 + lane * 8) = pack8(o);
      } else if (lane < 48) {
        const float rs = rsqrtf(t16 * (1.f / 128.f) + 1e-6f); const float* gk = p.kv_norm + (size_t)l * 128 + (lane - 32) * 8; float o[8];
#pragma unroll
        for (int e = 0; e < 8; ++e) o[e] = x[e] * rs * gk[e];
        *(u4v*)(CKV + (size_t)m * 128 + (lane - 32) * 8) = pack8(o);
        if (!isden) { float* op = p.out + OUT_CKV + (((size_t)b * NL + l) * T_C + t) * 128 + (lane - 32) * 8; *(f4v*)op = f4v{o[0], o[1], o[2], o[3]}; *(f4v*)(op + 4) = f4v{o[4], o[5], o[6], o[7]}; }
      } else if (lane < 52) {
        float o[8];
        if (isden) {
#pragma unroll
          for (int pq = 0; pq < 4; ++pq) { int pi = (lane - 48) * 4 + pq; float cs = rope[((size_t)t * 16 + pi) * 2], sn = rope[((size_t)t * 16 + pi) * 2 + 1];
            o[2 * pq] = x[2 * pq] * cs - x[2 * pq + 1] * sn; o[2 * pq + 1] = x[2 * pq] * sn + x[2 * pq + 1] * cs; }
        } else {
#pragma unroll
          for (int e = 0; e < 8; ++e) o[e] = x[e];
          float* op = p.out + OUT_KR + (((size_t)b * NL + l) * T_C + t) * 32 + (lane - 48) * 8; *(f4v*)op = f4v{x[0], x[1], x[2], x[3]}; *(f4v*)(op + 4) = f4v{x[4], x[5], x[6], x[7]};
        }
        { const int d8 = lane - 48; *(u4v*)(KR + ((((size_t)sq * (g.nkeys >> 5) + (t >> 5)) * 2 + (d8 >> 1)) * 64 + (d8 & 1) * 32 + (t & 31)) * 8) = pack8(o); }
      }
    }
    {
      float v[8]; unpack8(*(const u4v*)(z + ZC_VC + lane * 8), v);
      float s1 = 0.f;
#pragma unroll
      for (int e = 0; e < 8; ++e) { v[e] = geluf_(v[e]); s1 += v[e]; }
      s1 = wave_sum(s1); const float mean = s1 * (1.f / 512.f); float s2 = 0.f;
#pragma unroll
      for (int e = 0; e < 8; ++e) { float d = v[e] - mean; s2 += d * d; }
      s2 = wave_sum(s2); const float rs = rsqrtf(s2 * (1.f / 512.f) + 1e-5f);
      const float* gg = p.g_ln_g + (size_t)l * 512 + lane * 8; const float* gb = p.g_ln_b + (size_t)l * 512 + lane * 8;
#pragma unroll
      for (int e = 0; e < 8; ++e) v[e] = (v[e] - mean) * rs * gg[e] + gb[e];
      *(u4v*)(VCN + (size_t)m * 512 + lane * 8) = pack8(v);
    }
  }
}

__device__ __forceinline__ void stage_g2(const Params& p, const Grp& g, int l, int bid, int nb, char* smem) {
  char* ws = p.ws;
  const bf16_t* Z = (const bf16_t*)(ws + O_Z);
  const float* rope = (const float*)(ws + O_ROPE);
  const int mg = g.mg, mkv = g.mkv, T = g.T, isden = g.isden, nkeys = g.nkeys;
  const int TM_M = (mg + 127) / 128, TM_KV = (mkv + 127) / 128;
  const int NT_Q = TM_M * 6, NT_KV = TM_KV * 8, NT_LORA = TM_M * 8, NT_GM = (mg / 128) * 8, ntt = T / 128, NT_D1 = g.nseq * 8 * ntt;
  const int NT = NT_Q + NT_KV + NT_LORA + NT_GM + NT_D1;
  for (int t0 = bid; t0 < NT; t0 += nb) {
    int t = t0; f4v acc[2][4]; zero_acc<4>(acc);
    if (t < NT_Q) {
      int tn = t / TM_M, tm = t % TM_M;
      gemm_mainloop<4>((const bf16_t*)(ws + O_QDN), 256, tm * 128, mg, (const bf16_t*)(ws + O_WQT), 256, tn * 128, 768, 256, smem, acc);
      bf16_t* Q = (bf16_t*)(ws + O_Q);
      const float scale = 0.10206207261596575f * 1.4426950408889634f;
      epi_foreach<4>(acc, tm * 128, tn * 128, [&](int row, int c0, f4v& v) {
        if (row >= mg) return;
        int cw = c0 % 96; float o0 = v[0], o1 = v[1], o2 = v[2], o3 = v[3];
        if (cw >= 64 && isden) { int tt = row % T_D; int pi = (cw - 64) >> 1; const float* rp = rope + ((size_t)tt * 16 + pi) * 2;
          float c_a = rp[0], s_a = rp[1], c_b = rp[2], s_b = rp[3];
          o0 = v[0] * c_a - v[1] * s_a; o1 = v[0] * s_a + v[1] * c_a; o2 = v[2] * c_b - v[3] * s_b; o3 = v[2] * s_b + v[3] * c_b; }
        *(u2v*)(Q + (size_t)row * 768 + c0) = pack4(o0 * scale, o1 * scale, o2 * scale, o3 * scale);
      });
      continue;
    }
    t -= NT_Q;
    if (t < NT_KV) {
      int tn = t / TM_KV, tm = t % TM_KV;
      gemm_mainloop<4>((const bf16_t*)(ws + O_CKV), 128, tm * 128, mkv, (const bf16_t*)(ws + O_WKVT), 128, tn * 128, 1024, 128, smem, acc);
      bf16_t* KN = (bf16_t*)(ws + O_KN); bf16_t* VT = (bf16_t*)(ws + O_VT);
      epi_foreach<4>(acc, tm * 128, tn * 128, [&](int row, int c0, f4v& v) {
        if (row >= mkv) return;
        int h = c0 >> 7, w = c0 & 127;
        int sq, key;
        if (row < mg) { sq = row / T; key = row % T; } else { int r = row - mg; sq = r / PAST; key = T + r % PAST; }
        const int ntile = nkeys >> 5, tile = key >> 5, kq = key & 31;
        if (w < 64)
          *(u2v*)(KN + (((((size_t)sq * 8 + h) * ntile + tile) * 4 + (w >> 4)) * 64 + ((w >> 3) & 1) * 32 + kq) * 8 + (w & 7)) = pack4(v[0], v[1], v[2], v[3]);
        else {
          const int o16 = kq & 15, st = kq >> 4, hh2 = (o16 & 7) >> 2, jj = ((o16 >> 3) << 2) | (o16 & 3);
#pragma unroll
          for (int e = 0; e < 4; ++e) { const int dv = w - 64 + e;
            VT[((((((size_t)sq * 8 + h) * ntile + tile) * 2 + st) * 2 + (dv >> 5)) * 64 + hh2 * 32 + (dv & 31)) * 8 + jj] = f2bf(v[e]); } }
      });
      continue;
    }
    t -= NT_KV;
    if (t < NT_LORA) {
      int dir = t / (TM_M * 4), r = t % (TM_M * 4), tn = r / TM_M, tm = r % TM_M;
      f4v aa[2][4]; zero_acc<4>(aa);
      { GT d1 = mk_gt((const bf16_t*)(ws + O_LORA) + dir * 64, 192, tm * 128, mg, (const bf16_t*)(ws + O_WUPT) + (size_t)dir * 512 * 64, 64, tn * 128, 512, 64);
        GT d2 = mk_gt((const bf16_t*)(ws + O_LORA) + 128, 192, tm * 128, mg, (const bf16_t*)(ws + O_WUPT) + (size_t)(2 + dir) * 512 * 64, 64, tn * 128, 512, 64);
        u4v ra[2], rb[2]; gemm_prefetch<4>(d1, ra, rb);
        gemm_run<4, false>(d1, &d2, ra, rb, smem, acc);
        gemm_run<4, false>(d2, nullptr, ra, rb, smem, aa); }
      bf16_t* sW = (bf16_t*)smem; bf16_t* sA2 = sW + 128 * 136;
      __syncthreads();
      epi_foreach<4>(acc, 0, 0, [&](int row, int c0, f4v& v) { *(u2v*)(sW + row * 136 + c0) = pack4(v[0], v[1], v[2], v[3]); });
      epi_foreach<4>(aa, 0, 0, [&](int row, int c0, f4v& v) { *(u2v*)(sA2 + row * 136 + c0) = pack4(v[0], v[1], v[2], v[3]); });
      __syncthreads();
      const bf16_t* SK = (const bf16_t*)(ws + O_SK); bf16_t* SOP = (bf16_t*)(ws + O_SOP); float* BON = (float*)(ws + O_BON);
      const int tid = my_tid();
#pragma unroll 1
      for (int q4 = 0; q4 < 4; ++q4) {
        const int item = tid + NTHR * q4, rowl = item >> 4, ch8 = item & 15;
        int row = tm * 128 + rowl; const bool ok = row < mg; if (!ok) row = mg - 1;
        const int h = tn * 2 + (ch8 >> 3), chn = (ch8 & 7) * 8, c = h * 64 + chn;
        const int sq = row / T, tt = row % T;
        bf16_t* rec = SOP + (((size_t)sq * 8 + h) * T + tt) * 576;
        float pw[8], pa[8], kv[8], kkv[8], rv[8];
        unpack8(*(const u4v*)(sW + rowl * 136 + ch8 * 8), pw); unpack8(*(const u4v*)(sA2 + rowl * 136 + ch8 * 8), pa);
        unpack8(*(const u4v*)(SK + (size_t)row * 512 + c), kv); unpack8(*(const u4v*)(rec + 64 + chn), kkv); unpack8(*(const u4v*)(rec + chn), rv);
        const float* w0 = p.w0 + ((size_t)l * 2 + dir) * 512 + c; const float* a0 = p.a0 + ((size_t)l * 2 + dir) * 512 + c;
        const float* k_a = p.k_a + (size_t)l * 512 + c; const float* r_k = p.r_k + (size_t)l * 512 + c;
        float dd[8], bb[8], kt[8]; float bon = 0.f;
#pragma unroll
        for (int e = 0; e < 8; ++e) {
          dd[e] = 1.f - fexp_(-0.6065306597126334f * sigmoidf_(pw[e] + w0[e]));
          const float av = sigmoidf_(pa[e] + a0[e]);
          bb[e] = kkv[e] * av; kt[e] = kv[e] * (1.f + (av - 1.f) * k_a[e]);
          bon += rv[e] * kt[e] * r_k[e];
        }
        if (ok) { *(u4v*)(rec + (3 + 3 * dir) * 64 + chn) = pack8(dd); *(u4v*)(rec + (4 + 3 * dir) * 64 + chn) = pack8(bb); *(u4v*)(rec + (5 + 3 * dir) * 64 + chn) = pack8(kt); }
        bon = sum_lpr<8>(bon);
        if (ok && (ch8 & 7) == 0) BON[((size_t)row * 8 + h) * 2 + dir] = bon;
      }
      continue;
    }
    t -= NT_LORA;
    if (t < NT_GM) {
      int ch = t >> 3, gg = (t >> 1) & 3, dh = t & 1;
      f4v ac2[2][2]; zero_acc<2>(ac2);
      gemm_mainloop<2, true>((const bf16_t*)(ws + O_WS) + (size_t)gg * 128 * 128, 128, 0, 128, (const bf16_t*)(ws + O_VCNT) + (size_t)ch * 128 * 512, 512, gg * 128 + dh * 64, 512, 128, smem, ac2);
      bf16_t* O = (bf16_t*)(ws + O_OBR) + (size_t)2 * MG * 512;
      const float* bs = p.g_b_s + ((size_t)l * 4 + gg) * 128;
      epi_foreach<2>(ac2, 0, dh * 64, [&](int pp, int c0, f4v& v) {
        int m = ch * 128 + pp; int c = gg * 128 + c0; float bb = bs[pp];
        u2v uu = *(const u2v*)(Z + (size_t)m * IN_W + ZC_U + c), gc = *(const u2v*)(Z + (size_t)m * IN_W + ZC_GC + c);
        *(u2v*)(O + (size_t)m * 512 + c) = pack4(geluf_(bflo(uu.x)) * (v[0] + bb) * siluf_(bflo(gc.x)), geluf_(bfhi(uu.x)) * (v[1] + bb) * siluf_(bfhi(gc.x)),
                                                 geluf_(bflo(uu.y)) * (v[2] + bb) * siluf_(bflo(gc.y)), geluf_(bfhi(uu.y)) * (v[3] + bb) * siluf_(bfhi(gc.y)));
      });
      continue;
    }
    t -= NT_GM;
    {
      int per_seq = 8 * ntt; int sq = t / per_seq; int r = t % per_seq; int gg = r / (2 * ntt); int r2 = r % (2 * ntt); int tj = r2 / ntt, tt = r2 % ntt;
      long mbase = (long)sq * T;
      gemm_mainloop<4>((const bf16_t*)(ws + O_CS128), 128, tj * 128, 256, Z + (size_t)mbase * IN_W + ZC_F + gg * 128, IN_W, tt * 128, T, 128, smem, acc);
      bf16_t* YT = (bf16_t*)(ws + O_YT) + (size_t)mbase * 1024 + (size_t)gg * 128 * 2 * T;
      epi_foreach<4>(acc, tj * 128, tt * 128, [&](int j, int c0, f4v& v) {
        *(u2v*)(YT + (size_t)(j & 127) * 2 * T + (size_t)(j >> 7) * T + c0) = pack4(v[0], v[1], v[2], v[3]);
      });
    }
  }
}

__device__ __forceinline__ bool wave_any(bool pr) {
#ifdef EMU
  return wave_sum(pr ? 1.f : 0.f) > 0.f;
#else
  return __builtin_amdgcn_ballot_w64(pr) != 0ull;
#endif
}
__device__ __forceinline__ void attention_task(const Params& p, const Grp& g, int sq, int h, int qb32) {
  char* ws = p.ws;
  const int lane = my_tid() & 63, ql = lane & 31, hh = lane >> 5;
  const int T = g.T, nkeys = g.nkeys;
  const long mbase = (long)sq * T;
  const bf16_t* Q = (const bf16_t*)(ws + O_Q); const bf16_t* KN = (const bf16_t*)(ws + O_KN); const bf16_t* KRp = (const bf16_t*)(ws + O_KR);
  const int ntile = nkeys >> 5;
  const bf16_t* KFb = KN + ((size_t)sq * 8 + h) * ntile * 4 * 512 + lane * 8;
  const bf16_t* KRb = KRp + (size_t)sq * ntile * 2 * 512 + lane * 8;
  const bf16_t* VFb = (const bf16_t*)(ws + O_VT) + ((size_t)sq * 8 + h) * ntile * 4 * 512 + lane * 8;
  const long mq = mbase + qb32 * 32 + ql;
  s8v qf[6];
#pragma unroll
  for (int s = 0; s < 6; ++s) qf[s] = *(const s8v*)(Q + (size_t)mq * 768 + h * 96 + 16 * s + 8 * hh);
  f16v o0, o1;
#pragma unroll
  for (int i = 0; i < 16; ++i) { o0[i] = 0.f; o1[i] = 0.f; }
  float mrun = -1e30f, lrun = 0.f;
  s8v kfA[6], vfA[4], kfB[6], vfB[4];
#define ATT_LOAD(k0_, KF, VF) do { const int tl = (k0_) >> 5; \
    _Pragma("unroll") for (int st = 0; st < 4; ++st) KF[st] = *(const s8v*)(KFb + (size_t)(tl * 4 + st) * 512); \
    _Pragma("unroll") for (int st = 0; st < 2; ++st) KF[4 + st] = *(const s8v*)(KRb + (size_t)(tl * 2 + st) * 512); \
    _Pragma("unroll") for (int q = 0; q < 4; ++q) VF[q] = *(const s8v*)(VFb + (size_t)(tl * 4 + q) * 512); } while (0)
#define ATT_TILE(KF, VF) do { \
    f16v s; _Pragma("unroll") for (int i = 0; i < 16; ++i) s[i] = 0.f; \
    _Pragma("unroll") for (int st = 0; st < 6; ++st) s = __builtin_amdgcn_mfma_f32_32x32x16_bf16(KF[st], qf[st], s, 0, 0, 0); \
    float mx = s[0]; _Pragma("unroll") for (int i = 1; i < 16; ++i) mx = fmaxf(mx, s[i]); \
    mx = fmaxf(mx, __shfl_xor(mx, 32)); \
    if (wave_any(mx > mrun)) { const float mnew = fmaxf(mrun, mx); const float alpha = fexp2_(mrun - mnew); mrun = mnew; lrun *= alpha; \
      _Pragma("unroll") for (int i = 0; i < 16; ++i) { o0[i] *= alpha; o1[i] *= alpha; } } \
    float ps = 0.f; float pe[16]; \
    _Pragma("unroll") for (int i = 0; i < 16; ++i) { pe[i] = fexp2_(s[i] - mrun); ps += pe[i]; } \
    lrun += ps; \
    _Pragma("unroll") for (int st = 0; st < 2; ++st) { \
      const s8v pf = __builtin_bit_cast(s8v, u4v{pk2bf(pe[8 * st], pe[8 * st + 1]), pk2bf(pe[8 * st + 2], pe[8 * st + 3]), pk2bf(pe[8 * st + 4], pe[8 * st + 5]), pk2bf(pe[8 * st + 6], pe[8 * st + 7])}); \
      o0 = __builtin_amdgcn_mfma_f32_32x32x16_bf16(VF[st * 2], pf, o0, 0, 0, 0); \
      o1 = __builtin_amdgcn_mfma_f32_32x32x16_bf16(VF[st * 2 + 1], pf, o1, 0, 0, 0); } } while (0)
  ATT_LOAD(0, kfA, vfA);
  int k0 = 0;
  for (; k0 + 64 <= nkeys; k0 += 64) {
    ATT_LOAD(k0 + 32, kfB, vfB); SCHED_FENCE();
    ATT_TILE(kfA, vfA); SCHED_FENCE();
    ATT_LOAD((k0 + 64 < nkeys) ? k0 + 64 : nkeys - 32, kfA, vfA); SCHED_FENCE();
    ATT_TILE(kfB, vfB); SCHED_FENCE();
  }
  if (k0 < nkeys) ATT_TILE(kfA, vfA);
#undef ATT_LOAD
#undef ATT_TILE
  const float ltot = lrun + __shfl_xor(lrun, 32); const float inv = 1.f / ltot;
  const bf16_t* Z = (const bf16_t*)(ws + O_Z);
  bf16_t* O = (bf16_t*)(ws + O_OBR) + (size_t)1 * MG * 512;
#pragma unroll
  for (int db = 0; db < 2; ++db)
#pragma unroll
    for (int q4 = 0; q4 < 4; ++q4) {
      const int dv = db * 32 + 8 * q4 + 4 * hh;
      u2v gt = *(const u2v*)(Z + (size_t)mq * IN_W + ZC_GB + h * 64 + dv);
      const float x0 = (db == 0 ? o0[4 * q4] : o1[4 * q4]) * inv, x1 = (db == 0 ? o0[4 * q4 + 1] : o1[4 * q4 + 1]) * inv, x2 = (db == 0 ? o0[4 * q4 + 2] : o1[4 * q4 + 2]) * inv, x3 = (db == 0 ? o0[4 * q4 + 3] : o1[4 * q4 + 3]) * inv;
      *(u2v*)(O + (size_t)mq * 512 + h * 64 + dv) = pack4(x0 * siluf_(bflo(gt.x)), x1 * siluf_(bfhi(gt.x)), x2 * siluf_(bflo(gt.y)), x3 * siluf_(bfhi(gt.y)));
    }
}

__device__ __forceinline__ void stage_dft2(const Params& p, const Grp& g, int bid, int nb, char* smem) {
  char* ws = p.ws;
  const bf16_t* Z = (const bf16_t*)(ws + O_Z);
  const int T = g.T, ntt = T / 128;
  const int NT_D2 = g.nseq * 4 * ntt;
  const int soff = (g.nseq * 32) % nb;
  for (int t = (bid - soff + nb) % nb; t < NT_D2; t += nb) {
    int sq = t / (4 * ntt), r = t % (4 * ntt), gg = r / ntt, tt = r % ntt;
    long mbase = (long)sq * T;
    f4v acc[2][4]; zero_acc<4>(acc);
    { GT d = mk_gt((const bf16_t*)(ws + (g.isden ? O_A2D : O_A2C)), 2 * T, tt * 128, T, (const bf16_t*)(ws + O_YT) + (size_t)mbase * 1024 + (size_t)gg * 128 * 2 * T, 2 * T, 0, 128, 2 * T); gemm_deep<4>(d, smem, acc); }
    bf16_t* O = (bf16_t*)(ws + O_OBR) + (size_t)3 * MG * 512;
    const float sc = rsqrtf(128.f * (float)T);
    epi_foreach<4>(acc, tt * 128, 0, [&](int row, int c0, f4v& v) {
      long m = mbase + row; int c = gg * 128 + c0; u2v gd = *(const u2v*)(Z + (size_t)m * IN_W + ZC_GD + c);
      *(u2v*)(O + (size_t)m * 512 + c) = pack4(v[0] * sc * siluf_(bflo(gd.x)), v[1] * sc * siluf_(bfhi(gd.x)), v[2] * sc * siluf_(bflo(gd.y)), v[3] * sc * siluf_(bfhi(gd.y)));
    });
  }
}

constexpr int PL_STR = 72;
constexpr int PCH_MA = 0, PCH_MB = 4608, PCH_TBT = 9216, PCH_MBT = 10240, PCH_TK = 11264, PCH_MK = 12288, PCH_LDS = 13312;
__device__ __forceinline__ void pchunk_task(const Params& p, const Grp& g, int task, char* wl) {
  char* ws = p.ws;
  const int lane = my_tid() & 63, ql = lane & 31, hh = lane >> 5;
  const int T = g.T, nch = T >> 4;
  const int ch = task / nch, ci = task % nch;
  const int dir = ch & 1, h = (ch >> 1) & 7, sq = ch >> 4;
  const bf16_t* rec0 = (const bf16_t*)(ws + O_SOP) + ((size_t)sq * 8 + h) * T * 576;
  char* cm = ws + O_CM + (size_t)task * CM_REC;
  float At[16], Rt[16], Bh[16], Kh[16]; float W = 1.f;
#pragma unroll
  for (int j = 0; j < 16; ++j) {
    const int st = ci * 16 + j, tt = dir ? T - 1 - st : st;
    const bf16_t* rec = rec0 + (size_t)tt * 576;
    const float r = bf2f(rec[lane]), kk = bf2f(rec[64 + lane]), d = bf2f(rec[(3 + 3 * dir) * 64 + lane]), b = bf2f(rec[(4 + 3 * dir) * 64 + lane]), kt = bf2f(rec[(5 + 3 * dir) * 64 + lane]);
    At[j] = -kk * W; W *= (1.f - d); const float iw = frcp_(W); Rt[j] = r * W; Bh[j] = b * iw; Kh[j] = kt * iw;
  }
  {
    float x[8];
#pragma unroll
    for (int q = 0; q < 2; ++q) {
#pragma unroll
      for (int e = 0; e < 8; ++e) { const int st = ci * 16 + q * 8 + e, tt = dir ? T - 1 - st : st; x[e] = bf2f(rec0[(size_t)tt * 576 + 128 + lane]); }
      *(u4v*)(cm + CM_VT + (((lane >> 5) * 64 + q * 32 + (lane & 31)) * 16)) = pack8(x);
    }
  }
  {
    float x[8];
    const int k2 = lane >> 5, kq = lane & 31;
#pragma unroll
    for (int hq = 0; hq < 2; ++hq) {
#pragma unroll
      for (int e = 0; e < 8; ++e) x[e] = Bh[8 * (e >> 2) + 4 * hq + (e & 3)] * W;
      *(u4v*)(cm + CM_BKT + (((k2 * 2 + 0) * 64 + hq * 32 + kq) * 16)) = pack8(x);
#pragma unroll
      for (int e = 0; e < 8; ++e) x[e] = Kh[8 * hq + e] * W;
      *(u4v*)(cm + CM_BKT + (((k2 * 2 + 1) * 64 + hq * 32 + kq) * 16)) = pack8(x);
    }
    *(float*)(cm + CM_WL + lane * 4) = W;
  }
  bf16_t* MA = (bf16_t*)(wl + PCH_MA); bf16_t* MB = (bf16_t*)(wl + PCH_MB);
  float* TBT = (float*)(wl + PCH_TBT); float* MBT = (float*)(wl + PCH_MBT); float* TK = (float*)(wl + PCH_TK); float* MK = (float*)(wl + PCH_MK);
  WAVE_SYNC();
#pragma unroll
  for (int j = 0; j < 16; ++j) { MA[j * PL_STR + lane] = f2bf(Bh[j]); MA[(16 + j) * PL_STR + lane] = f2bf(Kh[j]); MB[j * PL_STR + lane] = f2bf(At[j]); MB[(16 + j) * PL_STR + lane] = f2bf(Rt[j]); }
  WAVE_SYNC();
  f16v D;
#pragma unroll
  for (int i = 0; i < 16; ++i) D[i] = 0.f;
#pragma unroll
  for (int s4 = 0; s4 < 4; ++s4) {
    const s8v fa = *(const s8v*)(MA + ql * PL_STR + 16 * s4 + 8 * hh), fb = *(const s8v*)(MB + ql * PL_STR + 16 * s4 + 8 * hh);
    D = __builtin_amdgcn_mfma_f32_32x32x16_bf16(fa, fb, D, 0, 0, 0);
  }
#pragma unroll
  for (int r = 0; r < 16; ++r) {
    const int i = (r & 3) + 8 * (r >> 2) + 4 * hh; const float v = D[r];
    if (r < 8) { if (ql < 16) TBT[ql * 16 + i] = (i < ql) ? v : 0.f; else MBT[(ql - 16) * 16 + i] = (i <= ql - 16) ? v : 0.f; }
    else { const int i2 = i - 16; if (ql < 16) TK[i2 * 16 + ql] = (i2 < ql) ? v : 0.f; else MK[i2 * 16 + (ql - 16)] = (i2 <= ql - 16) ? v : 0.f; }
  }
  WAVE_SYNC();
  const int l16 = lane & 15;
  float Z[16], Z2[16];
#pragma unroll
  for (int j = 0; j < 16; ++j) { Z[j] = 0.f; Z2[j] = 0.f; }
#pragma unroll
  for (int j = 0; j < 16; ++j) {
    float a1 = At[j], a2 = TK[l16 * 16 + j];
#pragma unroll
    for (int c4 = 0; c4 * 4 < j; ++c4) { const f4v tv = *(const f4v*)(TBT + j * 16 + c4 * 4);
#pragma unroll
      for (int e = 0; e < 4; ++e) if (c4 * 4 + e < j) { a1 += Z[c4 * 4 + e] * tv[e]; a2 += Z2[c4 * 4 + e] * tv[e]; } }
    Z[j] = a1; Z2[j] = a2;
  }
  bf16_t* GL = (bf16_t*)(wl + PCH_MA);
#pragma unroll
  for (int t = 0; t < 16; ++t) {
    float a1 = Rt[t], a2 = MK[l16 * 16 + t];
#pragma unroll
    for (int c4 = 0; c4 * 4 <= t; ++c4) { const f4v mv = *(const f4v*)(MBT + t * 16 + c4 * 4);
#pragma unroll
      for (int e = 0; e < 4; ++e) if (c4 * 4 + e <= t) { a1 += Z[c4 * 4 + e] * mv[e]; a2 += Z2[c4 * 4 + e] * mv[e]; } }
    GL[(16 + t) * 88 + lane] = f2bf(a1);
    if (lane < 16) GL[(16 + t) * 88 + 64 + lane] = f2bf(a2);
  }
#pragma unroll
  for (int j = 0; j < 16; ++j) { GL[j * 88 + lane] = f2bf(Z[j]); if (lane < 16) GL[j * 88 + 64 + lane] = f2bf(Z2[j]); }
  WAVE_SYNC();
  { const bf16_t* gr = GL + ql * 88;
#pragma unroll
    for (int s4 = 0; s4 < 4; ++s4) { const u2v lo = *(const u2v*)(gr + 16 * s4 + 4 * hh), hi = *(const u2v*)(gr + 16 * s4 + 8 + 4 * hh);
      *(u4v*)(cm + CM_GT + (s4 * 64 + lane) * 16) = u4v{lo.x, lo.y, hi.x, hi.y}; }
    *(u4v*)(cm + CM_GT + (4 * 64 + lane) * 16) = *(const u4v*)(gr + 64 + 8 * hh);
  }
  WAVE_SYNC();
}

__device__ __forceinline__ s8v cvt8(const f16v& a, int o) {
  return __builtin_bit_cast(s8v, u4v{pk2bf(a[o], a[o + 1]), pk2bf(a[o + 2], a[o + 3]), pk2bf(a[o + 4], a[o + 5]), pk2bf(a[o + 6], a[o + 7])});
}
struct ScanOps { s8v gA[5], bU[2], bV[2], vf; float wreg; };
__device__ __forceinline__ void scan2_load(ScanOps& o, const char* cm, const bf16_t* rec0, int ci, int T, int dir, int ql, int hh, int row) {
  const int lane = hh * 32 + ql, rt = row >> 5;
  o.wreg = *(const float*)(cm + CM_WL + lane * 4);
#pragma unroll
  for (int s = 0; s < 5; ++s) o.gA[s] = *(const s8v*)(cm + CM_GT + (s * 64 + lane) * 16);
#pragma unroll
  for (int k2 = 0; k2 < 2; ++k2) { o.bU[k2] = *(const s8v*)(cm + CM_BKT + ((k2 * 2) * 64 + lane) * 16); o.bV[k2] = *(const s8v*)(cm + CM_BKT + ((k2 * 2 + 1) * 64 + lane) * 16); }
  o.vf = *(const s8v*)(cm + CM_VT + (rt * 64 + lane) * 16);
  (void)rec0; (void)ci; (void)T; (void)dir;
}
__device__ __forceinline__ void scan2_task(const Params& p, const Grp& g, int l, int task, char* wl) {
  char* ws = p.ws;
  const int lane = my_tid() & 63, ql = lane & 31, hh = lane >> 5;
  const int T = g.T, nch = T >> 4;
  const int ch = task >> 1, rt = task & 1;
  const int dir = ch & 1, h = (ch >> 1) & 7, sq = ch >> 4;
  const int row = rt * 32 + ql;
  const long mbase = (long)sq * T;
  const bf16_t* rec0 = (const bf16_t*)(ws + O_SOP) + ((size_t)sq * 8 + h) * T * 576;
  const char* cm0 = ws + O_CM + (size_t)ch * nch * CM_REC;
  float* YS = (float*)(ws + O_YS) + (size_t)dir * MG * 512;
  float* wlf = (float*)wl;
  f16v a0, a1;
  if (g.isden) { const float* st = (dir ? p.st_b : p.st_f) + ((((size_t)sq * NL + l) * 8 + h) * 64 + row) * 64;
#pragma unroll
    for (int q = 0; q < 4; ++q) { f4v x = *(const f4v*)(st + 8 * q + 4 * hh), y = *(const f4v*)(st + 32 + 8 * q + 4 * hh);
#pragma unroll
      for (int e = 0; e < 4; ++e) { a0[4 * q + e] = x[e]; a1[4 * q + e] = y[e]; } } }
  else {
#pragma unroll
    for (int i = 0; i < 16; ++i) { a0[i] = 0.f; a1[i] = 0.f; } }
  ScanOps s0, s1, s2;
  scan2_load(s0, cm0, rec0, 0, T, dir, ql, hh, row);
  scan2_load(s1, cm0 + CM_REC, rec0, 1, T, dir, ql, hh, row);
#define SCAN2_STEP(CUR, ci_) do { const int ci = (ci_); \
    WAVE_SYNC(); wlf[lane] = CUR.wreg; WAVE_SYNC(); \
    const s8v vfrag = CUR.vf; \
    f16v D; _Pragma("unroll") for (int i = 0; i < 16; ++i) D[i] = 0.f; \
    D = __builtin_amdgcn_mfma_f32_32x32x16_bf16(CUR.gA[0], cvt8(a0, 0), D, 0, 0, 0); \
    D = __builtin_amdgcn_mfma_f32_32x32x16_bf16(CUR.gA[1], cvt8(a0, 8), D, 0, 0, 0); \
    D = __builtin_amdgcn_mfma_f32_32x32x16_bf16(CUR.gA[2], cvt8(a1, 0), D, 0, 0, 0); \
    D = __builtin_amdgcn_mfma_f32_32x32x16_bf16(CUR.gA[3], cvt8(a1, 8), D, 0, 0, 0); \
    D = __builtin_amdgcn_mfma_f32_32x32x16_bf16(CUR.gA[4], vfrag, D, 0, 0, 0); \
    _Pragma("unroll") for (int i = 0; i < 8; ++i) { const int st = ci * 16 + (i & 3) + 8 * (i >> 2) + 4 * hh, tt = dir ? T - 1 - st : st; YS[(size_t)(mbase + tt) * 512 + h * 64 + row] = D[8 + i]; } \
    const s8v uf = cvt8(D, 0); \
    const float* wq = wlf + 4 * hh; \
    _Pragma("unroll") for (int q = 0; q < 4; ++q) { const f4v w0 = *(const f4v*)(wq + 8 * q), w1 = *(const f4v*)(wq + 32 + 8 * q); \
      _Pragma("unroll") for (int e = 0; e < 4; ++e) { a0[4 * q + e] *= w0[e]; a1[4 * q + e] *= w1[e]; } } \
    a0 = __builtin_amdgcn_mfma_f32_32x32x16_bf16(CUR.bU[0], uf, a0, 0, 0, 0); \
    a0 = __builtin_amdgcn_mfma_f32_32x32x16_bf16(CUR.bV[0], vfrag, a0, 0, 0, 0); \
    a1 = __builtin_amdgcn_mfma_f32_32x32x16_bf16(CUR.bU[1], uf, a1, 0, 0, 0); \
    a1 = __builtin_amdgcn_mfma_f32_32x32x16_bf16(CUR.bV[1], vfrag, a1, 0, 0, 0); } while (0)
  int c = 0;
  for (; c + 3 <= nch; c += 3) {
    { const int cc = (c + 2 < nch) ? c + 2 : nch - 1; scan2_load(s2, cm0 + (size_t)cc * CM_REC, rec0, cc, T, dir, ql, hh, row); }
    SCHED_FENCE(); SCAN2_STEP(s0, c); SCHED_FENCE();
    { const int cc = (c + 3 < nch) ? c + 3 : nch - 1; scan2_load(s0, cm0 + (size_t)cc * CM_REC, rec0, cc, T, dir, ql, hh, row); }
    SCHED_FENCE(); SCAN2_STEP(s1, c + 1); SCHED_FENCE();
    { const int cc = (c + 4 < nch) ? c + 4 : nch - 1; scan2_load(s1, cm0 + (size_t)cc * CM_REC, rec0, cc, T, dir, ql, hh, row); }
    SCHED_FENCE(); SCAN2_STEP(s2, c + 2); SCHED_FENCE();
  }
  if (c < nch) SCAN2_STEP(s0, c);
  if (c + 1 < nch) SCAN2_STEP(s1, c + 1);
#undef SCAN2_STEP
  if (!g.isden) { float* so = p.out + (dir ? OUT_SB : OUT_SF) + ((((size_t)(g.b0 + sq) * NL + l) * 8 + h) * 64 + row) * 64;
#pragma unroll
    for (int q = 0; q < 4; ++q) { *(f4v*)(so + 8 * q + 4 * hh) = f4v{a0[4 * q], a0[4 * q + 1], a0[4 * q + 2], a0[4 * q + 3]}; *(f4v*)(so + 32 + 8 * q + 4 * hh) = f4v{a1[4 * q], a1[4 * q + 1], a1[4 * q + 2], a1[4 * q + 3]}; } }
}

__device__ __forceinline__ void stage_mixA(const Params& p, const Grp& g, int bid, int nb, char* smem) {
  const int wid = my_tid() >> 6;
  const int NP = g.nseq * 16 * (g.T >> 4), q32 = g.T / 32, NA = g.nseq * 8 * q32;
  char* wl = smem + wid * PCH_LDS;
  for (int task = wid * nb + bid; task < NP + NA; task += nb * NWAVE) {
    if (task < NP) pchunk_task(p, g, task, wl);
    else { int t = task - NP; int sq = t / (8 * q32), r = t % (8 * q32); attention_task(p, g, sq, r / q32, r % q32); }
  }
}
__device__ __forceinline__ void stage_scanS(const Params& p, const Grp& g, int l, int bid, int nb, char* smem) {
  const int wid = my_tid() >> 6;
  const int NS = g.nseq * 32;
  for (int task = wid * nb + bid; task < NS; task += nb * NWAVE) scan2_task(p, g, l, task, smem + wid * 768);
  __syncthreads();
}

__device__ __forceinline__ void stage_e3(const Params& p, const Grp& g, int l, int bid, int nb) {
  const int lane = my_tid() & 63, wid = my_tid() >> 6;
  char* ws = p.ws;
  const float* YS = (const float*)(ws + O_YS); const bf16_t* SOP = (const bf16_t*)(ws + O_SOP); const float* BON = (const float*)(ws + O_BON); const int T = g.T;
  const bf16_t* Z = (const bf16_t*)(ws + O_Z); bf16_t* O = (bf16_t*)(ws + O_OBR);
  const int hd = lane >> 3, c0 = lane * 8;
  const float* lg = p.ln_g + (size_t)l * 512 + c0; const float* lb = p.ln_b + (size_t)l * 512 + c0;
  for (int m = bid * NWAVE + wid; m < g.mg; m += nb * NWAVE) {
    const f4v y0 = *(const f4v*)(YS + (size_t)m * 512 + c0), y1 = *(const f4v*)(YS + (size_t)m * 512 + c0 + 4);
    const f4v z0 = *(const f4v*)(YS + ((size_t)MG + m) * 512 + c0), z1 = *(const f4v*)(YS + ((size_t)MG + m) * 512 + c0 + 4);
    float o[8]; float s1 = 0.f;
#pragma unroll
    for (int e = 0; e < 4; ++e) { o[e] = y0[e] + z0[e]; o[4 + e] = y1[e] + z1[e]; }
#pragma unroll
    for (int e = 0; e < 8; ++e) s1 += o[e];
    const float mean = sum_lpr<8>(s1) * (1.f / 64.f); float s2 = 0.f;
#pragma unroll
    for (int e = 0; e < 8; ++e) { o[e] -= mean; s2 += o[e] * o[e]; }
    const float rs = rsqrtf(sum_lpr<8>(s2) * (1.f / 64.f) + 64e-5f);
    const float bon = BON[((size_t)m * 8 + hd) * 2] + BON[((size_t)m * 8 + hd) * 2 + 1];
    float v[8], ga[8];
    unpack8(*(const u4v*)(SOP + (((size_t)(m / T) * 8 + hd) * T + (m % T)) * 576 + 128 + (lane & 7) * 8), v);
    unpack8(*(const u4v*)(Z + (size_t)m * IN_W + ZC_GA + c0), ga);
    float r[8];
#pragma unroll
    for (int e = 0; e < 8; ++e) r[e] = (o[e] * rs * lg[e] + lb[e] + bon * v[e]) * siluf_(ga[e]);
    *(u4v*)(O + (size_t)m * 512 + c0) = pack8(r);
  }
}

__device__ __forceinline__ void stage_gates(const Params& p, const Grp& g, int l, int bid, int nb, char* smem) {
  const bf16_t* H = (const bf16_t*)(p.ws + O_H);
  const bf16_t* W = (const bf16_t*)(p.ws + O_WMT);
  bf16_t* GT = (bf16_t*)(p.ws + O_GATES);
  const float* bm = p.b_merge + (size_t)l * 4096;
#ifndef EMU
  if ((g.mg & 255) == 0) {
    pg8::Gemm gm; gm.A = H; gm.Bt = W; gm.M = g.mg; gm.N = 4096; gm.K = 1024;
    pg8::StaticOrder S; S.init(gm.M, gm.N, nb, bid);
    pg8::EpiSigmoid E; E.O = GT; E.ldc = 4096; E.bias = bm;
    pg8::gemm_phase<pg8::EpiSigmoid, pg8::StaticOrder>((PG8_LAS unsigned char*)smem, gm, S, E);
    return;
  }
#endif
  const int TM = (g.mg + 127) / 128, mg = g.mg;
  for (int t = bid; t < TM * 32; t += nb) {
    int tn = t / TM, tm = t % TM; f4v acc[2][4]; zero_acc<4>(acc);
    gemm_mainloop<4>(H, 1024, tm * 128, mg, W, 1024, tn * 128, 4096, 1024, smem, acc);
    epi_foreach<4>(acc, tm * 128, tn * 128, [&](int row, int c0, f4v& v) {
      if (row < mg) *(u2v*)(GT + (size_t)row * 4096 + c0) = pack4(sigmoidf_(v[0] + bm[c0]), sigmoidf_(v[1] + bm[c0 + 1]), sigmoidf_(v[2] + bm[c0 + 2]), sigmoidf_(v[3] + bm[c0 + 3]));
    });
  }
}

__device__ __forceinline__ void stage_g8(const Params& p, const Grp& g, int l, int bid, int nb, char* smem) {
  char* ws = p.ws;
  bf16_t* MGD = (bf16_t*)(ws + O_MERGED);
  const bf16_t* GTp = (const bf16_t*)(ws + O_GATES);
  const int TM = (g.mg + 127) / 128, mg = g.mg, NT = TM * 8;
  auto desc = [&](int t, int n) { int tn = t / TM, tm = t % TM;
    return mk_gt((const bf16_t*)(ws + O_OBR) + (size_t)n * MG * 512, 512, tm * 128, mg, (const bf16_t*)(ws + O_WBRT) + (size_t)n * 1024 * 512, 512, tn * 128, 1024, 512); };
  for (int t = bid; t < NT; t += nb) {
    int tn = t / TM, tm = t % TM;
    f4v macc[2][4]; zero_acc<4>(macc);
#pragma unroll 1
    for (int n = 0; n < 4; ++n) {
      f4v ap[2][4]; zero_acc<4>(ap);
      GT cur = desc(t, n);
      gemm_deep<4>(cur, smem, ap);
      const int lane = my_tid() & 63, wid = my_tid() >> 6, wm = wid >> 1, wn = wid & 1;
#pragma unroll
      for (int i = 0; i < 2; ++i)
#pragma unroll
        for (int j = 0; j < 4; ++j) {
          int row = tm * 128 + wm * 32 + i * 16 + (lane & 15); row = row < mg ? row : mg - 1;
          int c0 = tn * 128 + wn * 64 + j * 16 + (lane >> 4) * 4;
          u2v gt = *(const u2v*)(GTp + (size_t)row * 4096 + n * 1024 + c0);
          macc[i][j][0] += bflo(gt.x) * ap[i][j][0]; macc[i][j][1] += bfhi(gt.x) * ap[i][j][1]; macc[i][j][2] += bflo(gt.y) * ap[i][j][2]; macc[i][j][3] += bfhi(gt.y) * ap[i][j][3];
        }
    }
    epi_foreach<4>(macc, tm * 128, tn * 128, [&](int row, int c0, f4v& v) {
      if (row < mg) *(u2v*)(MGD + (size_t)row * 1024 + c0) = pack4(v[0], v[1], v[2], v[3]);
    });
  }
  (void)l;
}

__device__ __forceinline__ void stage_g9(const Params& p, const Grp& g, int l, int bid, int nb, char* smem) {
  char* ws = p.ws;
  float* X = p.out + (size_t)g.m0 * 1024;
  const float* modp = (const float*)(ws + O_MOD) + (size_t)l * 3 * 3072 + 2048;
  const int TM = (g.mg + 127) / 128, mg = g.mg, NT = TM * 8;
  auto desc = [&](int t) { int tn = t / TM, tm = t % TM; return mk_gt((const bf16_t*)(ws + O_MERGED), 1024, tm * 128, mg, (const bf16_t*)(ws + O_WOUTT), 1024, tn * 128, 1024, 1024); };
  for (int t = bid; t < NT; t += nb) {
    int tn = t / TM, tm = t % TM;
    f4v acc[2][4]; zero_acc<4>(acc);
    GT cur = desc(t);
    gemm_deep<4>(cur, smem, acc);
    epi_foreach<4>(acc, tm * 128, tn * 128, [&](int row, int c0, f4v& v) {
      if (row < mg) { const float* gt = modp + (size_t)mod_index(g, row) * 3072 + c0; f4v* xp = (f4v*)(X + (size_t)row * 1024 + c0); f4v x = *xp;
        x[0] += gt[0] * v[0]; x[1] += gt[1] * v[1]; x[2] += gt[2] * v[2]; x[3] += gt[3] * v[3]; *xp = x; }
    });
  }
}

__device__ __forceinline__ void stage_final(const Params& p, int bid, int nb) {
  const int lane = my_tid() & 63, wid = my_tid() >> 6;
  for (int m = bid * NWAVE + wid; m < M; m += nb * NWAVE) {
    float* xr = p.out + (size_t)m * 1024; float4 q[4]; float ss = 0.f;
#pragma unroll
    for (int i = 0; i < 4; ++i) { q[i] = *(const float4*)(xr + i * 256 + lane * 4); ss += q[i].x * q[i].x + q[i].y * q[i].y + q[i].z * q[i].z + q[i].w * q[i].w; }
    ss = wave_sum(ss); float rs = rsqrtf(ss * (1.f / 1024.f) + 1e-6f);
#pragma unroll
    for (int i = 0; i < 4; ++i) { int c = i * 256 + lane * 4; float4 gm = *(const float4*)(p.final_g + c);
      *(float4*)(xr + c) = make_float4(q[i].x * rs * gm.x, q[i].y * rs * gm.y, q[i].z * rs * gm.z, q[i].w * rs * gm.w); }
  }
}

#ifdef EMU
#define DECL_SMEM(name) char* name = emu::smem()
#else
#define DECL_SMEM(name) __shared__ __attribute__((aligned(16))) char name[SMEM_BYTES]
#endif

#ifdef EMU
struct GridBar { __device__ void sync() const { emu::grid_sync(); } };
#else
#define XB_TMO      128
#define XB_XCNT(j)  (256  + 64 * (j))
#define XB_XSUB(j)  (1280 + 64 * (j))
#define XB_XGEN(j)  (2304 + 64 * (j))
#define XB_TOP      3328
#define XB_TOPGEN   3392
#define XB_SPIN_CAP (1u << 20)
#define LAS __attribute__((address_space(3)))
__device__ __forceinline__ unsigned xb_ld(unsigned* p)              { return __hip_atomic_load(p, __ATOMIC_RELAXED, __HIP_MEMORY_SCOPE_AGENT); }
__device__ __forceinline__ unsigned xb_add(unsigned* p, unsigned v) { return __hip_atomic_fetch_add(p, v, __ATOMIC_RELAXED, __HIP_MEMORY_SCOPE_AGENT); }
__device__ __forceinline__ unsigned xb_xcc_id() { return (unsigned)__builtin_amdgcn_s_getreg((3 << 11) | 20) & 0xFu; }
#define XB_SPIN(cond, bar) do { unsigned _sp = 0; while (cond) { __builtin_amdgcn_s_sleep(1); \
    if ((++_sp & 255u) == 0u) { if (xb_ld(&(bar)[XB_TMO])) break; if (_sp > XB_SPIN_CAP) { atomicAdd(&(bar)[XB_TMO], 1u); break; } } } } while (0)
struct GridBar {
  unsigned* bar; unsigned x; volatile LAS unsigned* st;
  __device__ __forceinline__ void post(unsigned* b, volatile LAS unsigned* s_) {
    bar = b; x = xb_xcc_id(); st = s_;
    if (threadIdx.x == 0) (void)xb_add(&bar[XB_XCNT(x)], 1u);
  }
  __device__ __forceinline__ void complete(unsigned& nloc, unsigned& nx) const {
    const unsigned G = gridDim.x;
    unsigned sum, cnt, mine, sp = 0u;
    for (;;) {
      sum = 0u; cnt = 0u; mine = 0u;
#pragma unroll
      for (unsigned j = 0; j < 16; ++j) { const unsigned c = xb_ld(&bar[XB_XCNT(j)]); sum += c; cnt += (c > 0u) ? 1u : 0u; mine = (j == x) ? c : mine; }
      if (sum == G) break;
      __builtin_amdgcn_s_sleep(1);
      if ((++sp & 255u) == 0u) { if (xb_ld(&bar[XB_TMO])) break; if (sp > XB_SPIN_CAP) { atomicAdd(&bar[XB_TMO], 1u); break; } }
    }
    nloc = mine > 0u ? mine : 1u; nx = cnt > 0u ? cnt : 1u;
  }
  __device__ __forceinline__ void sync() const {
    asm volatile("s_waitcnt vmcnt(0)" ::: "memory");
    __syncthreads();
    if (threadIdx.x == 0) {
      __builtin_amdgcn_s_waitcnt(0);
      unsigned nloc = st[0], nx = st[1];
      if (nloc == 0u) { complete(nloc, nx); st[0] = nloc; st[1] = nx; }
      const unsigned old = xb_add(&bar[XB_XSUB(x)], 1u);
      const unsigned gen = old / nloc;
      if (old + 1u == (gen + 1u) * nloc) {
        __builtin_amdgcn_fence(__ATOMIC_RELEASE, "agent");
        asm volatile("s_waitcnt vmcnt(0)" ::: "memory");
        const unsigned og = xb_add(&bar[XB_TOP], 1u);
        const unsigned tg = og / nx;
        if (og + 1u == (tg + 1u) * nx) xb_add(&bar[XB_TOPGEN], 1u);
        else XB_SPIN(xb_ld(&bar[XB_TOPGEN]) == tg, bar);
        __builtin_amdgcn_fence(__ATOMIC_ACQUIRE, "agent");
        xb_add(&bar[XB_XGEN(x)], 1u);
        asm volatile("s_waitcnt vmcnt(0)" ::: "memory");
      } else {
        XB_SPIN(xb_ld(&bar[XB_XGEN(x)]) == gen, bar);
        __builtin_amdgcn_fence(__ATOMIC_ACQUIRE, "agent");
        asm volatile("s_waitcnt vmcnt(0)" ::: "memory");
      }
    }
    __syncthreads();
  }
};
#endif

#ifndef EMU
namespace cg = cooperative_groups;
#else
namespace cg = cooperative_groups;
#endif

__global__ void __launch_bounds__(NTHR) mega_kernel(Params p) {
  DECL_SMEM(smem);
  cg::grid_group grid = cg::this_grid();
  const int bid0 = blockIdx.x, nb0 = gridDim.x;
  GridBar gb;
#ifndef EMU
  if (threadIdx.x == 0) { volatile LAS unsigned* w = (volatile LAS unsigned*)(smem + SMEM_STAGE); w[0] = 0u; w[1] = 0u; w[2] = 0u; w[3] = 0u; }
  __syncthreads();
  gb.post((unsigned*)(p.ws + O_BAR), (volatile LAS unsigned*)(smem + SMEM_STAGE));
#endif
#ifndef PROBE_DUP
#define PROBE_DUP 0
#endif
#define STG(gi_, call) do { Params q = p; q.ws = opaque(q.ws); q.out = opaque(q.out); const int bid = opaque_i(bid0); const int nb = opaque_i(nb0); const Grp g = get_grp(opaque_i(gi_)); (void)g; call; } while (0)
#define STP(bit, gi_, call) do { STG(gi_, call); if (PROBE_DUP & (bit)) { STG(gi_, call); } } while (0)
  for (int l = 0; l < NL; ++l) {
    STP(1, 0, stage_prep(q, l, bid, nb, smem));
    if (l == 0) grid.sync();
    STP(2, 0, stage_h(q, g, l, bid, nb));
    gb.sync();
    for (int gi = 0; gi < NGRP; ++gi) {
      STP(4, gi, stage_g1(q, g, 0, bid, nb, smem)); gb.sync();
      STP(4, gi, stage_g1(q, g, 1, bid, nb, smem));
      STP(8, gi, stage_e1(q, g, l, bid, nb)); gb.sync();
      STP(16, gi, stage_g2(q, g, l, bid, nb, smem)); gb.sync();
      STP(64, gi, stage_mixA(q, g, bid, nb, smem)); gb.sync();
      STP(32, gi, stage_scanS(q, g, l, bid, nb, smem));
      STP(128, gi, stage_dft2(q, g, bid, nb, smem)); gb.sync();
      STP(256, gi, stage_e3(q, g, l, bid, nb));
      STP(512, gi, stage_gates(q, g, l, bid, nb, smem)); gb.sync();
      STP(1024, gi, stage_g8(q, g, l, bid, nb, smem)); gb.sync();
      STG(gi, stage_g9(q, g, l, bid, nb, smem));
      if (gi + 1 < NGRP) { STP(2, gi + 1, stage_h(q, g, l, bid, nb)); }
      gb.sync();
    }
  }
  STG(0, stage_final(q, bid, nb));
#undef STP
#undef STG
}

extern "C" void kernel_launch(void* const* d_in, const int* in_sizes, int n_in, void* d_out, int out_size, void* d_ws, size_t ws_size,
                              hipStream_t stream) {
  Params p{};
  const float** pp = (const float**)&p;
  for (int i = 0; i < 35; ++i) pp[i] = (const float*)d_in[i];
  p.out = (float*)d_out; p.ws = (char*)d_ws;
#ifdef EMU
  emu::set_coop(true);
  emu_launch(dim3(8), dim3(NTHR), [=]() { mega_kernel(p); });
  emu::set_coop(false);
#else
  static int grid_blocks = 0;
  if (!grid_blocks) {
    int dev = 0, cus = 0, per_cu = 0;
    (void)hipGetDevice(&dev);
    (void)hipDeviceGetAttribute(&cus, hipDeviceAttributeMultiprocessorCount, dev);
    (void)hipOccupancyMaxActiveBlocksPerMultiprocessor(&per_cu, mega_kernel, NTHR, 0);
    if (per_cu > 1) per_cu = 1;
    if (per_cu < 1) per_cu = 1;
    grid_blocks = cus * per_cu;
  }
  (void)hipMemsetAsync((char*)d_ws + O_BAR, 0, BAR_BYTES, stream);
  void* args[] = {&p};
  (void)hipLaunchCooperativeKernel((void*)mega_kernel, dim3(grid_blocks), dim3(NTHR), args, 0, stream);
#endif
  (void)in_sizes; (void)n_in; (void)out_size; (void)ws_size;
}
```

```cpp
#ifdef EMU
#include "hip_emu.h"
#else
#include <hip/hip_runtime.h>
#include <hip/hip_cooperative_groups.h>
#endif
#include <stdint.h>

#ifndef CFG_BATCH
#define CFG_BATCH 32
#define CFG_SEQ 256
#define CFG_DEC_BATCH 2
#define CFG_DEC_SEQ 2048
#define CFG_PAST 512
#define CFG_NGRP_C 2
#endif
constexpr int D = 1024, NL = 2;
constexpr int NB_C = CFG_BATCH, T_C = CFG_SEQ, NB_D = CFG_DEC_BATCH, T_D = CFG_DEC_SEQ, PAST = CFG_PAST;
constexpr int M_C = NB_C * T_C, M_D = NB_D * T_D, M = M_C + M_D;
constexpr int NGRP_C = CFG_NGRP_C, NGRP = 1 + NGRP_C;
constexpr int MGC = M_C / NGRP_C, SEQ_PER_CG = NB_C / NGRP_C;
constexpr int MG = MGC > M_D ? MGC : M_D;
constexpr int MKV = MG + NB_D * PAST;
constexpr int KEYS_D = T_D + PAST;
constexpr int IN_W = 5728;
constexpr int ZC_R = 0, ZC_K = 512, ZC_V = 1024, ZC_WDF = 1536, ZC_QD = 1728, ZC_KVD = 1984, ZC_KR = 2112, ZC_VC = 2144, ZC_U = 2656, ZC_GC = 3168,
              ZC_GA = 3680, ZC_GB = 4192, ZC_F = 4704, ZC_GD = 5216;
constexpr int Z1_W = 3680, Z1_WP = 3840, Z2_W = 2048;
constexpr int SHIFT_W = 1728;
static_assert(M_C % NGRP_C == 0 && NB_C % NGRP_C == 0, "ctx groups");
static_assert(T_C % 128 == 0 && T_D % 128 == 0 && PAST % 32 == 0, "seq multiples");

typedef unsigned short bf16_t;
typedef short s8v __attribute__((ext_vector_type(8)));
typedef float f4v __attribute__((ext_vector_type(4)));
typedef float f16v __attribute__((ext_vector_type(16)));
typedef unsigned u4v __attribute__((ext_vector_type(4)));
typedef unsigned u2v __attribute__((ext_vector_type(2)));

struct Params {
  const float *x_prompt, *x_sample, *st_f, *st_b, *c_ckv, *c_kr, *c, *c_ctx, *norm_g, *w_ada, *b_ada, *w_in, *shift_mu, *w0, *w_up,
      *a0, *a_up, *k_k, *k_a, *r_k, *ln_g, *ln_b, *q_norm, *w_q_up, *kv_norm, *w_kv_up, *g_ln_g, *g_ln_b, *g_w_s, *g_b_s, *w_branch,
      *w_merge, *b_merge, *w_out, *final_g;
  float* out;
  char* ws;
};

struct Grp { int isden, m0, mg, nseq, T, b0, nkeys, mkv; };
__host__ __device__ __forceinline__ Grp get_grp(int gi) {
  Grp g;
  if (gi == 0) { g.isden = 1; g.m0 = M_C; g.mg = M_D; g.nseq = NB_D; g.T = T_D; g.b0 = 0; g.nkeys = KEYS_D; g.mkv = M_D + NB_D * PAST; }
  else { g.isden = 0; g.m0 = (gi - 1) * MGC; g.mg = MGC; g.nseq = SEQ_PER_CG; g.T = T_C; g.b0 = (gi - 1) * SEQ_PER_CG; g.nkeys = T_C; g.mkv = MGC; }
  return g;
}

constexpr size_t al256(size_t x) { return (x + 255) & ~(size_t)255; }
constexpr size_t O_WINT = 0;
constexpr int IN_WP = Z1_WP + Z2_W;
constexpr size_t O_WMT = O_WINT + al256((size_t)IN_WP * 1024 * 2);
constexpr size_t O_WBRT = O_WMT + al256((size_t)4096 * 1024 * 2);
constexpr size_t O_WOUTT = O_WBRT + al256((size_t)4 * 1024 * 512 * 2);
constexpr size_t O_WQT = O_WOUTT + al256((size_t)1024 * 1024 * 2);
constexpr size_t O_WKVT = O_WQT + al256((size_t)768 * 256 * 2);
constexpr size_t O_WUPT = O_WKVT + al256((size_t)1024 * 128 * 2);
constexpr size_t O_WS = O_WUPT + al256((size_t)4 * 512 * 64 * 2);
constexpr size_t O_CS128 = O_WS + al256((size_t)4 * 128 * 128 * 2);
constexpr size_t O_A2C = O_CS128 + al256((size_t)256 * 128 * 2);
constexpr size_t O_A2D = O_A2C + al256((size_t)T_C * 2 * T_C * 2);
constexpr size_t O_ROPE = O_A2D + al256((size_t)T_D * 2 * T_D * 2);
constexpr size_t O_MOD = O_ROPE + al256((size_t)T_D * 32 * 4);
constexpr size_t O_H = O_MOD + al256((size_t)NL * 3 * 3072 * 4);
constexpr size_t O_Z = O_H + al256((size_t)MG * 1024 * 2);
constexpr size_t O_SK = O_Z + al256((size_t)MG * IN_W * 2);
constexpr size_t O_SOP = O_SK + al256((size_t)MG * 512 * 2);
constexpr size_t O_YS = O_SOP + al256((size_t)MG * 8 * 576 * 2);
constexpr size_t O_BON = O_YS + al256((size_t)2 * MG * 512 * 4);
constexpr size_t O_LORA = O_BON + al256((size_t)MG * 16 * 4);
constexpr int CM_GT = 0, CM_BKT = 5120, CM_WL = 9216, CM_VT = 9472, CM_REC = 11520;
constexpr size_t CM_BYTES = (size_t)MG * CM_REC;
constexpr size_t O_CM = O_LORA + al256((size_t)MG * 192 * 2);
constexpr size_t O_PRE = O_CM + al256(CM_BYTES - (size_t)MG * 2048 * 2);
constexpr size_t O_QDN = O_PRE + al256((size_t)MG * 2048 * 2);
constexpr size_t O_CKV = O_QDN + al256((size_t)MG * 256 * 2);
constexpr size_t O_KR = O_CKV + al256((size_t)MKV * 128 * 2);
constexpr size_t O_Q = O_KR + al256((size_t)MKV * 32 * 2);
constexpr size_t O_KN = O_Q + al256((size_t)MG * 768 * 2);
constexpr size_t O_VT = O_KN + al256((size_t)MKV * 512 * 2);
constexpr size_t O_VCNT = O_VT + al256((size_t)MKV * 512 * 2);
constexpr size_t O_YT = O_VCNT + al256((size_t)MG * 512 * 2);
constexpr size_t O_OBR = O_YT + al256((size_t)MG * 1024 * 2);
constexpr size_t O_MERGED = O_OBR + al256((size_t)4 * MG * 512 * 2);
constexpr size_t O_END = O_MERGED + al256((size_t)MG * 1024 * 2);
constexpr size_t O_GATES = O_PRE;
static_assert(O_GATES + (size_t)MG * 4096 * 2 <= O_VCNT, "gates alias region too small");
static_assert(O_CM + CM_BYTES <= O_QDN, "chunk-matrix region must end before QDN");
constexpr size_t O_BAR = O_END;
constexpr size_t BAR_BYTES = 3456 * 4;
static_assert(O_BAR + BAR_BYTES <= ((size_t)256 << 20), "workspace must fit 256 MiB");

constexpr size_t OUT_SF = (size_t)M * D, OUT_SB = OUT_SF + (size_t)NB_C * NL * 8 * 64 * 64,
                 OUT_CKV = OUT_SB + (size_t)NB_C * NL * 8 * 64 * 64, OUT_KR = OUT_CKV + (size_t)NB_C * NL * T_C * 128;

#ifdef EMU
template <class T> __device__ __forceinline__ T* opaque(T* p) { return p; }
__device__ __forceinline__ int opaque_i(int v) { return v; }
#else
template <class T> __device__ __forceinline__ T* opaque(T* p) {
  typedef __attribute__((address_space(1))) T* gptr;
  gptr g = (gptr)p; asm volatile("" : "+s"(g)); return (T*)g;
}
__device__ __forceinline__ int opaque_i(int v) { asm volatile("" : "+s"(v)); return v; }
#endif
#ifdef EMU
#define SCHED_FENCE() do {} while (0)
#else
#define SCHED_FENCE() do { asm volatile("" ::: "memory"); __builtin_amdgcn_sched_barrier(0); } while (0)
#endif
__device__ __forceinline__ int my_tid() {
#ifdef EMU
  return (int)threadIdx.x;
#else
  int t = (int)threadIdx.x; asm volatile("" : "+v"(t)); return t;
#endif
}
__device__ __forceinline__ unsigned f_as_u(float f) { return __builtin_bit_cast(unsigned, f); }
__device__ __forceinline__ float u_as_f(unsigned u) { return __builtin_bit_cast(float, u); }
#ifdef EMU
__device__ __forceinline__ bf16_t f2bf(float f) { unsigned u = f_as_u(f); u += 0x7FFFu + ((u >> 16) & 1u); return (bf16_t)(u >> 16); }
__device__ __forceinline__ unsigned pk2bf(float lo, float hi) { return (unsigned)f2bf(lo) | ((unsigned)f2bf(hi) << 16); }
#else
typedef __bf16 bf2v_t __attribute__((ext_vector_type(2)));
typedef float f2c_t __attribute__((ext_vector_type(2)));
__device__ __forceinline__ bf16_t f2bf(float f) { return __builtin_bit_cast(unsigned short, (__bf16)f); }
__device__ __forceinline__ unsigned pk2bf(float lo, float hi) { return __builtin_bit_cast(unsigned, __builtin_convertvector(f2c_t{lo, hi}, bf2v_t)); }
#endif
__device__ __forceinline__ float bf2f(bf16_t h) { return u_as_f(((unsigned)h) << 16); }
__device__ __forceinline__ float bflo(unsigned u) { return u_as_f(u << 16); }
__device__ __forceinline__ float bfhi(unsigned u) { return u_as_f(u & 0xFFFF0000u); }
#ifdef EMU
__device__ __forceinline__ float fexp_(float x) { return expf(x); }
__device__ __forceinline__ float frcp_(float x) { return 1.f / x; }
#else
__device__ __forceinline__ float fexp_(float x) { return __builtin_amdgcn_exp2f(x * 1.4426950408889634f); }
__device__ __forceinline__ float frcp_(float x) { return __builtin_amdgcn_rcpf(x); }
#endif
#ifdef EMU
__device__ __forceinline__ float fexp2_(float x) { return exp2f(x); }
#else
__device__ __forceinline__ float fexp2_(float x) { return __builtin_amdgcn_exp2f(x); }
#endif
__device__ __forceinline__ float sigmoidf_(float x) { return frcp_(1.f + fexp_(-x)); }
__device__ __forceinline__ float siluf_(float x) { return x * frcp_(1.f + fexp_(-x)); }
__device__ __forceinline__ float tanhf_(float x) { return 1.f - 2.f * frcp_(1.f + fexp_(2.f * x)); }
__device__ __forceinline__ float geluf_(float x) { return 0.5f * x * (1.f + tanhf_(0.7978845608028654f * (x + 0.044715f * x * x * x))); }
#ifdef EMU
__device__ __forceinline__ float wave_sum(float v) {
#pragma unroll
  for (int o = 32; o >= 1; o >>= 1) v += __shfl_xor(v, o);
  return v;
}
#else
__device__ __forceinline__ float wave_sum(float v) {
  v += u_as_f(__builtin_amdgcn_update_dpp(0, (int)f_as_u(v), 0xB1, 0xF, 0xF, true));
  v += u_as_f(__builtin_amdgcn_update_dpp(0, (int)f_as_u(v), 0x4E, 0xF, 0xF, true));
  v += u_as_f(__builtin_amdgcn_update_dpp(0, (int)f_as_u(v), 0x141, 0xF, 0xF, true));
  v += u_as_f(__builtin_amdgcn_update_dpp(0, (int)f_as_u(v), 0x140, 0xF, 0xF, true));
  { auto r = __builtin_amdgcn_permlane16_swap(f_as_u(v), f_as_u(v), false, false); v = u_as_f(r[0]) + u_as_f(r[1]); }
  { auto r = __builtin_amdgcn_permlane32_swap(f_as_u(v), f_as_u(v), false, false); v = u_as_f(r[0]) + u_as_f(r[1]); }
  return v;
}
#endif

#ifdef EMU
#define WAVE_SYNC() emu::wave_barrier()
__device__ __forceinline__ float sum16(float v) { v += __shfl_xor(v, 1); v += __shfl_xor(v, 2); v += __shfl_xor(v, 4); v += __shfl_xor(v, 8); return v; }
#else
#define WAVE_SYNC() __builtin_amdgcn_wave_barrier()
__device__ __forceinline__ float sum16(float v) {
  v += u_as_f(__builtin_amdgcn_update_dpp(0, (int)f_as_u(v), 0xB1, 0xF, 0xF, true));
  v += u_as_f(__builtin_amdgcn_update_dpp(0, (int)f_as_u(v), 0x4E, 0xF, 0xF, true));
  v += u_as_f(__builtin_amdgcn_update_dpp(0, (int)f_as_u(v), 0x141, 0xF, 0xF, true));
  v += u_as_f(__builtin_amdgcn_update_dpp(0, (int)f_as_u(v), 0x140, 0xF, 0xF, true));
  return v;
}
#endif

template <int LPR> __device__ __forceinline__ float sum_lpr(float v) {
#ifdef EMU
  v += __shfl_xor(v, 1); v += __shfl_xor(v, 2); v += __shfl_xor(v, 4);
  if (LPR >= 16) v += __shfl_xor(v, 8);
  if (LPR >= 32) v += __shfl_xor(v, 16);
  return v;
#else
  v += u_as_f(__builtin_amdgcn_update_dpp(0, (int)f_as_u(v), 0xB1, 0xF, 0xF, true));
  v += u_as_f(__builtin_amdgcn_update_dpp(0, (int)f_as_u(v), 0x4E, 0xF, 0xF, true));
  v += u_as_f(__builtin_amdgcn_update_dpp(0, (int)f_as_u(v), 0x141, 0xF, 0xF, true));
  if (LPR >= 16) v += u_as_f(__builtin_amdgcn_update_dpp(0, (int)f_as_u(v), 0x140, 0xF, 0xF, true));
  if (LPR >= 32) { auto r = __builtin_amdgcn_permlane16_swap(f_as_u(v), f_as_u(v), false, false); v = u_as_f(r[0]) + u_as_f(r[1]); }
  return v;
#endif
}

template <int LPR> __device__ __forceinline__ void sum_lpr2(float& a, float& b) {
#ifdef EMU
  a = sum_lpr<LPR>(a); b = sum_lpr<LPR>(b);
#else
#define DPP_ADD2(ctrl) { float ta = u_as_f(__builtin_amdgcn_update_dpp(0, (int)f_as_u(a), ctrl, 0xF, 0xF, true)); float tb = u_as_f(__builtin_amdgcn_update_dpp(0, (int)f_as_u(b), ctrl, 0xF, 0xF, true)); a += ta; b += tb; }
  DPP_ADD2(0xB1) DPP_ADD2(0x4E) DPP_ADD2(0x141)
  if (LPR >= 16) DPP_ADD2(0x140)
  if (LPR >= 32) { auto ra = __builtin_amdgcn_permlane16_swap(f_as_u(a), f_as_u(a), false, false); auto rb = __builtin_amdgcn_permlane16_swap(f_as_u(b), f_as_u(b), false, false);
    a = u_as_f(ra[0]) + u_as_f(ra[1]); b = u_as_f(rb[0]) + u_as_f(rb[1]); }
#undef DPP_ADD2
#endif
}

constexpr int NTHR = 512, NWAVE = 8;
constexpr int LDS_STR = 72;
constexpr int SMEM_STAGE = 131072;
constexpr int SMEM_BYTES = SMEM_STAGE + 16;

template <int NJ>
__device__ __forceinline__ void zero_acc(f4v (&acc)[2][NJ]) {
#pragma unroll
  for (int i = 0; i < 2; ++i)
#pragma unroll
    for (int j = 0; j < NJ; ++j) acc[i][j] = f4v{0.f, 0.f, 0.f, 0.f};
}

struct GT { const bf16_t* A; long lda; int arow0, arows; const bf16_t* B; long ldb; int brow0, brows; int K; int bt; };
__device__ __forceinline__ GT mk_gt(const bf16_t* A, long lda, int arow0, int arows, const bf16_t* B, long ldb, int brow0, int brows, int K, int bt = 0) {
  GT t; t.A = A; t.lda = lda; t.arow0 = arow0; t.arows = arows; t.B = B; t.ldb = ldb; t.brow0 = brow0; t.brows = brows; t.K = K; t.bt = bt; return t;
}
template <int NJ>
__device__ __forceinline__ void gemm_ptrs(const GT& t, int tid, const bf16_t* (&ap)[2], const bf16_t* (&bp)[NJ / 2]) {
#pragma unroll
  for (int i = 0; i < 2; ++i) { int c = tid + NTHR * i, r = c >> 3, cc = c & 7; int ar = t.arow0 + r; ar = ar < t.arows ? ar : t.arows - 1; ap[i] = t.A + (long)ar * t.lda + cc * 8; }
#pragma unroll
  for (int i = 0; i < NJ / 2; ++i) { int c = tid + NTHR * i;
    if (t.bt) { int q = c & 63, dc = c >> 6; bp[i] = t.B + (long)q * t.ldb + t.brow0 + dc * 8; }
    else { int r = c >> 3, cc = c & 7; int br = t.brow0 + r; br = br < t.brows ? br : t.brows - 1; bp[i] = t.B + (long)br * t.ldb + cc * 8; } }
}
template <int NJ>
__device__ __forceinline__ void gemm_prefetch(const GT& t, u4v (&ra)[2], u4v (&rb)[NJ / 2]) {
  const bf16_t* ap[2]; const bf16_t* bp[NJ / 2];
  gemm_ptrs<NJ>(t, my_tid(), ap, bp);
#pragma unroll
  for (int i = 0; i < 2; ++i) ra[i] = *(const u4v*)(ap[i]);
#pragma unroll
  for (int i = 0; i < NJ / 2; ++i) rb[i] = *(const u4v*)(bp[i]);
}
template <int NJ, bool BT>
__device__ __forceinline__ void gemm_run(const GT& t, const GT* nxt, u4v (&ra)[2], u4v (&rb)[NJ / 2], char* smem, f4v (&acc)[2][NJ]) {
  constexpr int NBL = NJ / 2;
  constexpr int BUF = (128 + 128) * LDS_STR;
  bf16_t* s0 = (bf16_t*)smem;
  const int tid = my_tid(), lane = tid & 63, wid = tid >> 6, wm = wid >> 1, wn = wid & 1;
  const bf16_t* ap[2]; const bf16_t* bp[NBL];
  gemm_ptrs<NJ>(t, tid, ap, bp);
  const long ldb = t.ldb;
  __syncthreads();
#pragma unroll
  for (int i = 0; i < 2; ++i) { int c = tid + NTHR * i, r = c >> 3, cc = c & 7; *(u4v*)(s0 + r * LDS_STR + cc * 8) = ra[i]; }
#pragma unroll
  for (int i = 0; i < NBL; ++i) { int c = tid + NTHR * i;
    if (BT) { int q = c & 63, dc = c >> 6;
#pragma unroll
      for (int e = 0; e < 8; ++e) s0[(128 + dc * 8 + e) * LDS_STR + q] = (bf16_t)(rb[i][e >> 1] >> ((e & 1) * 16)); }
    else { int r = c >> 3, cc = c & 7; *(u4v*)(s0 + (128 + r) * LDS_STR + cc * 8) = rb[i]; } }
  __syncthreads();
  const int nk = t.K >> 6;
  for (int kt = 0; kt < nk; ++kt) {
    const bool more = kt + 1 < nk;
    if (more) {
#pragma unroll
      for (int i = 0; i < 2; ++i) ra[i] = *(const u4v*)(ap[i] + (kt + 1) * 64);
#pragma unroll
      for (int i = 0; i < NBL; ++i) rb[i] = *(const u4v*)(bp[i] + (BT ? (long)(kt + 1) * 64 * ldb : (long)(kt + 1) * 64));
    } else if (nxt) gemm_prefetch<NJ>(*nxt, ra, rb);
    SCHED_FENCE();
    const bf16_t* sA = s0 + (kt & 1) * BUF; const bf16_t* sB = sA + 128 * LDS_STR;
#pragma unroll
    for (int ks = 0; ks < 2; ++ks) {
      s8v af[2], bf[NJ];
#pragma unroll
      for (int i = 0; i < 2; ++i) af[i] = *(const s8v*)(sA + (wm * 32 + i * 16 + (lane & 15)) * LDS_STR + ks * 32 + (lane >> 4) * 8);
#pragma unroll
      for (int j = 0; j < NJ; ++j) bf[j] = *(const s8v*)(sB + (wn * NJ * 16 + j * 16 + (lane & 15)) * LDS_STR + ks * 32 + (lane >> 4) * 8);
#pragma unroll
      for (int i = 0; i < 2; ++i)
#pragma unroll
        for (int j = 0; j < NJ; ++j) acc[i][j] = __builtin_amdgcn_mfma_f32_16x16x32_bf16(bf[j], af[i], acc[i][j], 0, 0, 0);
    }
    if (more) {
      bf16_t* dA = s0 + ((kt + 1) & 1) * BUF;
#pragma unroll
      for (int i = 0; i < 2; ++i) { int c = tid + NTHR * i, r = c >> 3, cc = c & 7; *(u4v*)(dA + r * LDS_STR + cc * 8) = ra[i]; }
#pragma unroll
      for (int i = 0; i < NBL; ++i) { int c = tid + NTHR * i;
        if (BT) { int q = c & 63, dc = c >> 6;
#pragma unroll
          for (int e = 0; e < 8; ++e) dA[(128 + dc * 8 + e) * LDS_STR + q] = (bf16_t)(rb[i][e >> 1] >> ((e & 1) * 16)); }
        else { int r = c >> 3, cc = c & 7; *(u4v*)(dA + (128 + r) * LDS_STR + cc * 8) = rb[i]; } }
      __syncthreads();
    }
  }
}
template <int NJ>
__device__ __forceinline__ void gemm_deep(const GT& t, char* smem, f4v (&acc)[2][NJ]) {
  constexpr int NBL = NJ / 2;
  constexpr int BUF = (128 + 128) * LDS_STR;
  bf16_t* s0 = (bf16_t*)smem;
  const int tid = my_tid(), lane = tid & 63, wid = tid >> 6, wm = wid >> 1, wn = wid & 1;
  const bf16_t* ap[2]; const bf16_t* bp[NBL];
  gemm_ptrs<NJ>(t, tid, ap, bp);
  const int nk = t.K >> 6;
  u4v pa0[2], pb0[NBL], pa1[2], pb1[NBL];
#define GD_LOAD(PA, PB, kt_) do { const int kq = (kt_) < nk ? (kt_) : nk - 1; \
    _Pragma("unroll") for (int i = 0; i < 2; ++i) PA[i] = *(const u4v*)(ap[i] + kq * 64); \
    _Pragma("unroll") for (int i = 0; i < NBL; ++i) PB[i] = *(const u4v*)(bp[i] + kq * 64); } while (0)
#define GD_STORE(PA, PB, buf_) do { bf16_t* dA = s0 + (buf_) * BUF; \
    _Pragma("unroll") for (int i = 0; i < 2; ++i) { int c = tid + NTHR * i, r = c >> 3, cc = c & 7; *(u4v*)(dA + r * LDS_STR + cc * 8) = PA[i]; } \
    _Pragma("unroll") for (int i = 0; i < NBL; ++i) { int c = tid + NTHR * i, r = c >> 3, cc = c & 7; *(u4v*)(dA + (128 + r) * LDS_STR + cc * 8) = PB[i]; } } while (0)
#define GD_COMPUTE(buf_) do { const bf16_t* sA = s0 + (buf_) * BUF; const bf16_t* sB = sA + 128 * LDS_STR; \
    _Pragma("unroll") for (int ks = 0; ks < 2; ++ks) { s8v af[2], bf[NJ]; \
      _Pragma("unroll") for (int i = 0; i < 2; ++i) af[i] = *(const s8v*)(sA + (wm * 32 + i * 16 + (lane & 15)) * LDS_STR + ks * 32 + (lane >> 4) * 8); \
      _Pragma("unroll") for (int j = 0; j < NJ; ++j) bf[j] = *(const s8v*)(sB + (wn * NJ * 16 + j * 16 + (lane & 15)) * LDS_STR + ks * 32 + (lane >> 4) * 8); \
      _Pragma("unroll") for (int i = 0; i < 2; ++i) _Pragma("unroll") for (int j = 0; j < NJ; ++j) acc[i][j] = __builtin_amdgcn_mfma_f32_16x16x32_bf16(bf[j], af[i], acc[i][j], 0, 0, 0); } } while (0)
  GD_LOAD(pa0, pb0, 0); SCHED_FENCE();
  GD_LOAD(pa1, pb1, 1); SCHED_FENCE();
  __syncthreads();
  GD_STORE(pa0, pb0, 0);
  __syncthreads();
  for (int kt = 0; kt < nk; kt += 2) {
    GD_LOAD(pa0, pb0, kt + 2); SCHED_FENCE();
    GD_COMPUTE(0);
    if (kt + 1 < nk) { GD_STORE(pa1, pb1, 1); }
    __syncthreads();
    if (kt + 1 >= nk) break;
    GD_LOAD(pa1, pb1, kt + 3); SCHED_FENCE();
    GD_COMPUTE(1);
    if (kt + 2 < nk) { GD_STORE(pa0, pb0, 0); }
    __syncthreads();
  }
#undef GD_LOAD
#undef GD_STORE
#undef GD_COMPUTE
}

template <int NJ, bool BT = false>
__device__ __forceinline__ void gemm_mainloop(const bf16_t* __restrict__ A, long lda, int arow0, int arows, const bf16_t* __restrict__ B,
                                              long ldb, int brow0, int brows, int K, char* smem, f4v (&acc)[2][NJ]) {
  GT t = mk_gt(A, lda, arow0, arows, B, ldb, brow0, brows, K, BT ? 1 : 0);
  u4v ra[2], rb[NJ / 2];
  gemm_prefetch<NJ>(t, ra, rb);
  gemm_run<NJ, BT>(t, nullptr, ra, rb, smem, acc);
}

template <int NJ, class F>
__device__ __forceinline__ void epi_foreach(f4v (&acc)[2][NJ], int row0, int col0, F f) {
  const int tid = my_tid(), lane = tid & 63, wid = tid >> 6, wm = wid >> 1, wn = wid & 1;
#pragma unroll
  for (int i = 0; i < 2; ++i)
#pragma unroll
    for (int j = 0; j < NJ; ++j) f(row0 + wm * 32 + i * 16 + (lane & 15), col0 + wn * NJ * 16 + j * 16 + (lane >> 4) * 4, acc[i][j]);
}
__device__ __forceinline__ u4v pack8(const float (&x)[8]) {
  return u4v{pk2bf(x[0], x[1]), pk2bf(x[2], x[3]), pk2bf(x[4], x[5]), pk2bf(x[6], x[7])};
}
__device__ __forceinline__ void unpack8(u4v u, float (&x)[8]) {
  x[0] = bflo(u.x); x[1] = bfhi(u.x); x[2] = bflo(u.y); x[3] = bfhi(u.y); x[4] = bflo(u.z); x[5] = bfhi(u.z); x[6] = bflo(u.w); x[7] = bfhi(u.w);
}
__device__ __forceinline__ u2v pack4(float a, float b, float c, float d) {
  return u2v{pk2bf(a, b), pk2bf(c, d)};
}

#ifndef EMU
namespace pg8 {
#define PG8_LAS __attribute__((address_space(3)))
typedef unsigned short bf16_t;
typedef short bf16x8 __attribute__((ext_vector_type(8)));
typedef float f32x4 __attribute__((ext_vector_type(4)));
typedef unsigned u32x4 __attribute__((ext_vector_type(4)));
constexpr int BM = 256, BK = 64, HALF = 128, HTB = HALF * BK * 2  , STAGE_BYTES = 8 * HTB, NXCD = 8, WGM = 8;

__host__ __device__ __forceinline__ int lds_byte(int r, int c) { const int st = (r >> 4) * 2 + (c >> 5), rr = r & 15, cc = c & 31, ob = rr * 64 + cc * 2; return st * 1024 + (ob ^ (((ob >> 9) & 1) << 5)); }
__host__ __device__ __forceinline__ void stage_rc(int b, int& R, int& C) { const int st = b / 1024, sb = b % 1024, swz = sb ^ (((sb >> 9) & 1) << 5); R = (st >> 1) * 16 + swz / 64; C = (st & 1) * 32 + (swz % 64) / 2; }
__host__ __device__ __forceinline__ int perm32(int rho) { const int n = rho >> 4, i = rho & 15; return 8 * (i >> 2) + 4 * n + (i & 3); }

struct Unit { int pm, pn; };
struct Gemm { const bf16_t* A; const bf16_t* Bt; int M, N, K; };

struct StaticOrder {
    int nM, nN, nwg, G, c;
    __host__ __device__ void init(int M, int N, int G_, int c_) { nM = M / BM; nN = N / BM; nwg = nM * nN; G = G_; c = c_; }
    __host__ __device__ bool next(int i, Unit& u) const {
        const long L = (long)i * G + c; if (L >= nwg) return false;
        int wgid = (int)L; { const int q = nwg / NXCD, r = nwg % NXCD, xcd = wgid % NXCD, off = wgid / NXCD; wgid = (xcd < r ? xcd * (q + 1) : r * (q + 1) + (xcd - r) * q) + off; }
        const int nig = WGM * nN, gid = wgid / nig, fm = gid * WGM, gsz = (nM - fm) < WGM ? (nM - fm) : WGM;
        u.pm = fm + ((wgid % nig) % gsz); u.pn = (wgid % nig) / gsz; return true;
    }
    __device__ __forceinline__ void a_ready(const Unit&) const {}
    __device__ __forceinline__ void done(const Unit&) const {}
};
template <class Epi, class Sched>
__device__ __forceinline__ void gemm_phase(PG8_LAS unsigned char* lds, const Gemm g, const Sched& S, const Epi& E) {
    const int tid = my_tid(), wid = __builtin_amdgcn_readfirstlane(tid >> 6), lane = tid & 63, wr = wid >> 2, wc = wid & 3, fr = lane & 15, fq = lane >> 4;
    const int K = g.K, nt = K / BK;
    unsigned voffA[2], voffB[2];
#pragma unroll
    for (int i = 0; i < 2; ++i) { int R, C; stage_rc(tid * 16 + i * 8192, R, C); const int Rb = Epi::PERM ? ((R & ~31) + perm32(R & 31)) : R;
        voffA[i] = (unsigned)(R * K + C) * 2u; voffB[i] = (unsigned)(Rb * K + C) * 2u; }
    const size_t kstep = (size_t)(BK * 2);
    const size_t hstep = (size_t)HALF * K * 2;
    const size_t tstep = 2 * hstep;
    const unsigned ldsw = (unsigned)wid * 1024u;
    const int aoff = lds_byte(wr * 64 + fr, fq * 8), boff = lds_byte(wc * 32 + fr, fq * 8);
#define PG8_SA(b, h) (((b) * 2 + (h)) * HTB)
#define PG8_SB(b, h) ((4 + (b) * 2 + (h)) * HTB)
#define PG8_STAGE(bufoff, gbase, voff) do { _Pragma("unroll") for (int _i = 0; _i < 2; ++_i) \
        __builtin_amdgcn_global_load_lds((const unsigned*)((const char*)(gbase) + (voff)[_i]), (PG8_LAS unsigned*)(lds + (bufoff) + ldsw + _i * 8192), 16, 0, 0); } while (0)
#define PG8_LDA(dst, b, h) do { _Pragma("unroll") for (int m = 0; m < 4; ++m) _Pragma("unroll") for (int k = 0; k < 2; ++k) dst[m][k] = *(const PG8_LAS bf16x8*)(lds + PG8_SA(b, h) + aoff + m * 2048 + k * 1024); } while (0)
#define PG8_LDB(dst, b, h) do { _Pragma("unroll") for (int n = 0; n < 2; ++n) _Pragma("unroll") for (int k = 0; k < 2; ++k) dst[n][k] = *(const PG8_LAS bf16x8*)(lds + PG8_SB(b, h) + boff + n * 2048 + k * 1024); } while (0)
#define PG8_MMA(ai, bj, At, Bt) do { __builtin_amdgcn_s_setprio(1); _Pragma("unroll") for (int m = 0; m < 4; ++m) _Pragma("unroll") for (int n = 0; n < 2; ++n) _Pragma("unroll") for (int k = 0; k < 2; ++k) \
        acc[ai][bj][m][n] = __builtin_amdgcn_mfma_f32_16x16x32_bf16(Bt[n][k], At[m][k], acc[ai][bj][m][n], 0, 0, 0); __builtin_amdgcn_s_setprio(0); } while (0)
#define PG8_WAIT_V(n) asm volatile("s_waitcnt vmcnt(" #n ")" ::: "memory")
#define PG8_WAIT_L(n) asm volatile("s_waitcnt lgkmcnt(" #n ")" ::: "memory")
#define PG8_BAR __builtin_amdgcn_s_barrier()
#define PG8_SCHED __builtin_amdgcn_sched_barrier(0)
    Unit cur, nxt; int ui = 0;
    if (!S.next(0, cur)) return;
    f32x4 acc[2][2][4][2];
#pragma unroll
    for (int a = 0; a < 2; ++a)
#pragma unroll
        for (int b = 0; b < 2; ++b)
#pragma unroll
            for (int m = 0; m < 4; ++m)
#pragma unroll
                for (int n = 0; n < 2; ++n) acc[a][b][m][n] = (f32x4){0.f, 0.f, 0.f, 0.f};
    bf16x8 At[4][2], B0[2][2], B1[2][2];
    const char* cA = (const char*)g.A + (size_t)cur.pm * tstep; const char* cB = (const char*)g.Bt + (size_t)cur.pn * tstep;
    S.a_ready(cur);
    PG8_STAGE(PG8_SB(0, 0), cB, voffB); PG8_STAGE(PG8_SA(0, 0), cA, voffA); PG8_STAGE(PG8_SB(0, 1), cB + hstep, voffB); PG8_STAGE(PG8_SA(0, 1), cA + hstep, voffA);
    if (wr == 1) PG8_BAR;
    PG8_WAIT_V(4); PG8_BAR;
    PG8_STAGE(PG8_SB(1, 0), cB + kstep, voffB); PG8_STAGE(PG8_SA(1, 0), cA + kstep, voffA); PG8_STAGE(PG8_SB(1, 1), cB + hstep + kstep, voffB);
    PG8_WAIT_V(6); PG8_BAR;
    for (;;) {
        const bool has_next = S.next(ui + 1, nxt);
        const char* nA = has_next ? (const char*)g.A + (size_t)nxt.pm * tstep : cA; const char* nB = has_next ? (const char*)g.Bt + (size_t)nxt.pn * tstep : cB;
        for (int t = 0; t < nt; t += 2) {
            const bool last = (t == nt - 2);
            const char* a1 = cA + (size_t)(t + 1) * kstep;
            const char* a2 = last ? nA : cA + (size_t)(t + 2) * kstep; const char* b2 = last ? nB : cB + (size_t)(t + 2) * kstep;
            const char* a3 = a2 + kstep; const char* b3 = b2 + kstep;
            if (last && has_next) S.a_ready(nxt);
            PG8_LDB(B0, 0, 0); PG8_SCHED; PG8_LDA(At, 0, 0); PG8_STAGE(PG8_SA(1, 1), a1 + hstep, voffA);
            PG8_WAIT_L(8); PG8_BAR; PG8_WAIT_L(0); PG8_MMA(0, 0, At, B0); PG8_BAR; PG8_SCHED;
            PG8_LDB(B1, 0, 1); PG8_STAGE(PG8_SB(0, 0), b2, voffB);
            PG8_BAR; PG8_WAIT_L(0); PG8_MMA(0, 1, At, B1); PG8_BAR;
            PG8_LDA(At, 0, 1); PG8_STAGE(PG8_SA(0, 0), a2, voffA);
            PG8_BAR; PG8_WAIT_L(0); PG8_MMA(1, 0, At, B0); PG8_BAR; PG8_SCHED;
            PG8_STAGE(PG8_SB(0, 1), b2 + hstep, voffB);
            PG8_WAIT_V(6); PG8_BAR; PG8_MMA(1, 1, At, B1); PG8_BAR;
            PG8_LDB(B0, 1, 0); PG8_SCHED; PG8_LDA(At, 1, 0); PG8_STAGE(PG8_SA(0, 1), a2 + hstep, voffA);
            PG8_WAIT_L(8); PG8_BAR; PG8_WAIT_L(0); PG8_MMA(0, 0, At, B0); PG8_BAR; PG8_SCHED;
            PG8_LDB(B1, 1, 1); PG8_STAGE(PG8_SB(1, 0), b3, voffB);
            PG8_BAR; PG8_WAIT_L(0); PG8_MMA(0, 1, At, B1); PG8_BAR;
            PG8_LDA(At, 1, 1); PG8_STAGE(PG8_SA(1, 0), a3, voffA);
            PG8_BAR; PG8_WAIT_L(0); PG8_MMA(1, 0, At, B0); PG8_BAR; PG8_SCHED;
            PG8_STAGE(PG8_SB(1, 1), b3 + hstep, voffB);
            PG8_WAIT_V(6); PG8_BAR; PG8_MMA(1, 1, At, B1); PG8_BAR;
        }
            if constexpr (!Epi::AFTER_DRAIN) { E(acc, cur, wr, wc, fr, fq); S.done(cur); }
            if (!has_next) break;
#pragma unroll
        for (int a = 0; a < 2; ++a)
#pragma unroll
            for (int b = 0; b < 2; ++b)
#pragma unroll
                for (int m = 0; m < 4; ++m)
#pragma unroll
                    for (int n = 0; n < 2; ++n) acc[a][b][m][n] = (f32x4){0.f, 0.f, 0.f, 0.f};
        cur = nxt; cA = nA; cB = nB; ++ui;
    }
    PG8_WAIT_V(0);
    if (wr == 0) PG8_BAR;
    PG8_BAR;
    if constexpr (Epi::AFTER_DRAIN) { E.fused(acc, cur, wr, wc, fr, fq, lds, wid, lane); S.done(cur); }
#undef PG8_SA
#undef PG8_SB
#undef PG8_STAGE
#undef PG8_LDA
#undef PG8_LDB
#undef PG8_MMA
#undef PG8_WAIT_V
#undef PG8_WAIT_L
#undef PG8_BAR
#undef PG8_SCHED
}

__device__ __forceinline__ unsigned pk2(float lo, float hi) { return pk2bf(lo, hi); }
struct EpiStore {
  static constexpr bool PERM = true, AFTER_DRAIN = false;
  bf16_t* O; int ldc; int ncols; int coff;
  __device__ __forceinline__ void operator()(const f32x4 (&acc)[2][2][4][2], const Unit& u, int wr, int wc, int fr, int fq) const {
    const int row0 = u.pm * BM + wr * 64 + fr, col0 = u.pn * BM + wc * 32 + 8 * fq;
#pragma unroll
    for (int ai = 0; ai < 2; ++ai)
#pragma unroll
      for (int m = 0; m < 4; ++m) { bf16_t* rowp = O + (size_t)(row0 + ai * HALF + m * 16) * ldc + coff + col0;
#pragma unroll
        for (int bj = 0; bj < 2; ++bj) if (col0 + bj * HALF < ncols) { const f32x4 v0 = acc[ai][bj][m][0], v1 = acc[ai][bj][m][1];
          *(u32x4*)(rowp + bj * HALF) = (u32x4){pk2(v0[0], v0[1]), pk2(v0[2], v0[3]), pk2(v1[0], v1[1]), pk2(v1[2], v1[3])}; } }
  }
};
struct EpiSigmoid {
  static constexpr bool PERM = true, AFTER_DRAIN = false;
  bf16_t* O; int ldc; const float* bias;
  __device__ __forceinline__ void operator()(const f32x4 (&acc)[2][2][4][2], const Unit& u, int wr, int wc, int fr, int fq) const {
    const int row0 = u.pm * BM + wr * 64 + fr, col0 = u.pn * BM + wc * 32 + 8 * fq;
    f32x4 bv[2][2];
#pragma unroll
    for (int bj = 0; bj < 2; ++bj)
#pragma unroll
      for (int n = 0; n < 2; ++n) bv[bj][n] = *(const f32x4*)(bias + col0 + bj * HALF + 4 * n);
#pragma unroll
    for (int ai = 0; ai < 2; ++ai)
#pragma unroll
      for (int m = 0; m < 4; ++m) { bf16_t* rowp = O + (size_t)(row0 + ai * HALF + m * 16) * ldc + col0;
#pragma unroll
        for (int bj = 0; bj < 2; ++bj) { const f32x4 v0 = acc[ai][bj][m][0] + bv[bj][0], v1 = acc[ai][bj][m][1] + bv[bj][1];
          *(u32x4*)(rowp + bj * HALF) = (u32x4){pk2(sigmoidf_(v0[0]), sigmoidf_(v0[1])), pk2(sigmoidf_(v0[2]), sigmoidf_(v0[3])), pk2(sigmoidf_(v1[0]), sigmoidf_(v1[1])), pk2(sigmoidf_(v1[2]), sigmoidf_(v1[3]))}; } }
  }
};
}
#endif

struct TJob { const float* src; int K, N; long lds; bf16_t* dst; long ldd; };
__device__ __forceinline__ TJob get_tjob(const Params& p, int l, int j) {
  TJob t; char* ws = p.ws;
  if (j < 10) {
    const int seg[10][3] = {{0, 1728, 0}, {1728, 512, ZC_GA}, {2240, 256, ZC_QD}, {2496, 128, ZC_KVD}, {2624, 32, ZC_KR}, {2656, 512, ZC_GB}, {3168, 512, ZC_U}, {3680, 512, ZC_VC}, {4192, 512, ZC_GC}, {4704, 1024, ZC_F}};
    int sc = 0, wd = 0, zc = 0;
#pragma unroll
    for (int q = 0; q < 10; ++q) if (q == j) { sc = seg[q][0]; wd = seg[q][1]; zc = seg[q][2]; }
    const int wrow = zc < Z1_W ? zc : zc + (Z1_WP - Z1_W);
    t.src = p.w_in + (size_t)l * 1024 * IN_W + sc; t.K = 1024; t.N = wd; t.lds = IN_W; t.dst = (bf16_t*)(ws + O_WINT) + (size_t)wrow * 1024; t.ldd = 1024; return t; }
  j -= 9;
  if (j == 1) { t.src = p.w_merge + (size_t)l * 1024 * 4096; t.K = 1024; t.N = 4096; t.lds = 4096; t.dst = (bf16_t*)(ws + O_WMT); t.ldd = 1024; }
  else if (j < 6) { int n = j - 2; t.src = p.w_branch + ((size_t)l * 4 + n) * 512 * 1024; t.K = 512; t.N = 1024; t.lds = 1024; t.dst = (bf16_t*)(ws + O_WBRT) + (size_t)n * 1024 * 512; t.ldd = 512; }
  else if (j == 6) { t.src = p.w_out + (size_t)l * 1024 * 1024; t.K = 1024; t.N = 1024; t.lds = 1024; t.dst = (bf16_t*)(ws + O_WOUTT); t.ldd = 1024; }
  else if (j == 7) { t.src = p.w_q_up + (size_t)l * 256 * 768; t.K = 256; t.N = 768; t.lds = 768; t.dst = (bf16_t*)(ws + O_WQT); t.ldd = 256; }
  else if (j == 8) { t.src = p.w_kv_up + (size_t)l * 128 * 1024; t.K = 128; t.N = 1024; t.lds = 1024; t.dst = (bf16_t*)(ws + O_WKVT); t.ldd = 128; }
  else { int n = j - 9;
    t.src = (n < 2 ? p.w_up : p.a_up) + ((size_t)l * 2 + (n & 1)) * 64 * 512; t.K = 64; t.N = 512; t.lds = 512;
    t.dst = (bf16_t*)(ws + O_WUPT) + (size_t)n * 512 * 64; t.ldd = 64; }
  return t;
}
constexpr int NTJOBS = 22;

__device__ __forceinline__ void stage_prep(const Params& p, int l, int bid, int nb, char* smem) {
  const int tid = my_tid();
  char* ws = p.ws;
  {
    float* tile = (float*)smem;
    int total = 0;
    for (int j = 0; j < NTJOBS; ++j) { TJob t = get_tjob(p, l, j); total += (t.K / 64) * ((t.N + 63) / 64); }
    f4v pre[2]; bool pv[2];
    auto locate = [&](int q, TJob& t, int& kt, int& nt_) { int base = 0;
      for (int j = 0; j < NTJOBS; ++j) { t = get_tjob(p, l, j); int tn = (t.N + 63) / 64, nt = (t.K / 64) * tn; if (q < base + nt) { int r = q - base; kt = r / tn; nt_ = r % tn; return; } base += nt; } };
    auto issue = [&](int q) { TJob t; int kt = 0, nt_ = 0; locate(q, t, kt, nt_);
#pragma unroll
      for (int i = 0; i < 2; ++i) { int e = tid + NTHR * i, r = e >> 4, c4 = e & 15; int n0 = nt_ * 64 + c4 * 4; pv[i] = n0 < t.N;
        pre[i] = pv[i] ? *(const f4v*)(t.src + (long)(kt * 64 + r) * t.lds + n0) : f4v{0.f, 0.f, 0.f, 0.f}; } };
    if (bid < total) issue(bid);
    for (int q = bid; q < total; q += nb) {
      TJob t; int kt = 0, nt_ = 0; locate(q, t, kt, nt_);
      __syncthreads();
#pragma unroll
      for (int i = 0; i < 2; ++i) { int e = tid + NTHR * i, r = e >> 4, c4 = e & 15;
        tile[r * 65 + c4 * 4] = pre[i][0]; tile[r * 65 + c4 * 4 + 1] = pre[i][1]; tile[r * 65 + c4 * 4 + 2] = pre[i][2]; tile[r * 65 + c4 * 4 + 3] = pre[i][3]; }
      __syncthreads();
      if (q + nb < total) issue(q + nb);
      { int n = tid >> 3, kc = tid & 7; float x[8];
        if (nt_ * 64 + n < t.N) {
#pragma unroll
          for (int e = 0; e < 8; ++e) x[e] = tile[(kc * 8 + e) * 65 + n];
          *(u4v*)(t.dst + (long)(nt_ * 64 + n) * t.ldd + kt * 64 + kc * 8) = pack8(x); } }
    }
    __syncthreads();
  }
  const long gtid = (long)bid * NTHR + tid, gn = (long)nb * NTHR;
  { bf16_t* d = (bf16_t*)(ws + O_WINT) + (size_t)Z1_W * 1024; for (long i = gtid; i < (long)(Z1_WP - Z1_W) * 1024; i += gn) d[i] = 0; }
  { bf16_t* d = (bf16_t*)(ws + O_WS); const float* s = p.g_w_s + (size_t)l * 4 * 128 * 128; for (long i = gtid; i < (long)4 * 128 * 128; i += gn) d[i] = f2bf(s[i]); }
  if (l != 0) return;
  { bf16_t* d = (bf16_t*)(ws + O_CS128);
    for (long i = gtid; i < 256 * 128; i += gn) { int j = (int)(i >> 7), c = (int)(i & 127); int mm = ((j & 127) * c) & 127; float x = 2.0f * mm / 128.f; d[i] = f2bf(j < 128 ? cospif(x) : sinpif(x)); } }
  { bf16_t* d = (bf16_t*)(ws + O_A2C);
    for (long i = gtid; i < (long)T_C * 2 * T_C; i += gn) { int tp = (int)(i / (2 * T_C)), tt = (int)(i % (2 * T_C)); int half = tt >= T_C; int t = half ? tt - T_C : tt; int mm = (int)(((long)tp * t) % T_C); float x = 2.0f * mm / (float)T_C; d[i] = f2bf(half ? -sinpif(x) : cospif(x)); } }
  { bf16_t* d = (bf16_t*)(ws + O_A2D);
    for (long i = gtid; i < (long)T_D * 2 * T_D; i += gn) { int tp = (int)(i / (2 * T_D)), tt = (int)(i % (2 * T_D)); int half = tt >= T_D; int t = half ? tt - T_D : tt; int mm = (int)(((long)tp * t) % T_D); float x = 2.0f * mm / (float)T_D; d[i] = f2bf(half ? -sinpif(x) : cospif(x)); } }
  { float* d = (float*)(ws + O_ROPE);
    for (long i = gtid; i < (long)T_D * 16; i += gn) { int t = (int)(i >> 4), pi = (int)(i & 15); float pos = (pi < 8) ? (float)(t / 64) : (float)(t % 64); float inv = expf(-(float)(pi & 7) * (9.210340371976184f / 8.f)); float a = pos * inv; d[2 * i] = cosf(a); d[2 * i + 1] = sinf(a); } }
  { float4* d = (float4*)p.out; const float4* s0 = (const float4*)p.x_prompt; const float4* s1 = (const float4*)p.x_sample;
    for (long i = gtid; i < (long)M * 256; i += gn) d[i] = (i < (long)M_C * 256) ? s0[i] : s1[i - (long)M_C * 256]; }
  {
    float* sc = (float*)smem;
    float* red = sc + 3 * 1024;
    float* modp = (float*)(ws + O_MOD);
    if (bid < NL * 96) {
      __syncthreads();
      for (int i = tid; i < 3 * 1024; i += NTHR) { int mi = i >> 10, k = i & 1023; sc[i] = siluf_(mi == 0 ? p.c_ctx[k] : p.c[(mi == 2 && NB_D > 1 ? 1024 : 0) + k]); }
      __syncthreads();
    }
    for (int u = bid; u < NL * 96; u += nb) {
      int ll = u / 96, cg = u % 96; int cl = tid & 31, kq = tid >> 5, col = cg * 32 + cl;
      float a0 = 0.f, a1 = 0.f, a2 = 0.f;
      const float* w = p.w_ada + (size_t)ll * 1024 * 3072 + col;
#pragma unroll 16
      for (int k = kq * 64; k < kq * 64 + 64; ++k) {
        float wv = w[(size_t)k * 3072];
        a0 += sc[k] * wv; a1 += sc[1024 + k] * wv; a2 += sc[2048 + k] * wv;
      }
      __syncthreads();
      red[(kq * 3 + 0) * 32 + cl] = a0; red[(kq * 3 + 1) * 32 + cl] = a1; red[(kq * 3 + 2) * 32 + cl] = a2;
      __syncthreads();
      if (tid < 96) { int mi = tid >> 5, cc = tid & 31; float s2 = 0.f;
#pragma unroll
        for (int q8 = 0; q8 < 16; ++q8) s2 += red[(q8 * 3 + mi) * 32 + cc];
        modp[((size_t)ll * 3 + mi) * 3072 + cg * 32 + cc] = s2 + p.b_ada[(size_t)ll * 3072 + cg * 32 + cc]; }
    }
  }
}

__device__ __forceinline__ int mod_index(const Grp& g, int lm) { return g.isden ? 1 + lm / T_D : 0; }

__device__ __forceinline__ void stage_h(const Params& p, const Grp& g, int l, int bid, int nb) {
  const int lane = my_tid() & 63, wid = my_tid() >> 6;
  const float* X = p.out + (size_t)g.m0 * 1024;
  bf16_t* H = (bf16_t*)(p.ws + O_H);
  const float* modp = (const float*)(p.ws + O_MOD) + (size_t)l * 3 * 3072;
  const float* gam = p.norm_g + (size_t)l * 1024;
  for (int m = bid * NWAVE + wid; m < g.mg; m += nb * NWAVE) {
    const float* xr = X + (size_t)m * 1024; float v[16]; float ss = 0.f;
#pragma unroll
    for (int i = 0; i < 4; ++i) { float4 q = *(const float4*)(xr + i * 256 + lane * 4); v[4 * i] = q.x; v[4 * i + 1] = q.y; v[4 * i + 2] = q.z; v[4 * i + 3] = q.w; ss += q.x * q.x + q.y * q.y + q.z * q.z + q.w * q.w; }
    ss = wave_sum(ss); float rs = rsqrtf(ss * (1.f / 1024.f) + 1e-6f);
    const float* mo = modp + (size_t)mod_index(g, m) * 3072;
#pragma unroll
    for (int i = 0; i < 4; ++i) {
      int c = i * 256 + lane * 4; bf16_t o[4];
#pragma unroll
      for (int e = 0; e < 4; ++e) o[e] = f2bf(v[4 * i + e] * rs * gam[c + e] * (1.f + mo[1024 + c + e]) + mo[c + e]);
      *(u2v*)(H + (size_t)m * 1024 + c) = u2v{(unsigned)o[0] | ((unsigned)o[1] << 16), (unsigned)o[2] | ((unsigned)o[3] << 16)};
    }
  }
}

__device__ __forceinline__ int g1b_blocks(const Grp& g, int nb) { int u = ((g.mg + 255) / 256) * (Z2_W / 256); int h = nb / 2; return u < h ? u : h; }
__device__ __forceinline__ void stage_g1(const Params& p, const Grp& g, int part, int bid, int nb, char* smem) {
  const bf16_t* H = (const bf16_t*)(p.ws + O_H);
  const bf16_t* W = (const bf16_t*)(p.ws + O_WINT) + (part ? (size_t)Z1_WP * 1024 : 0);
  bf16_t* Z = (bf16_t*)(p.ws + O_Z);
  const int NW = part ? Z2_W : Z1_W, NWP = part ? Z2_W : Z1_WP, coff = part ? Z1_W : 0;
  if (part) { nb = g1b_blocks(g, nb); if (bid >= nb) return; }
#ifndef EMU
  if ((g.mg & 255) == 0) {
    pg8::Gemm gm; gm.A = H; gm.Bt = W; gm.M = g.mg; gm.N = NWP; gm.K = 1024;
    pg8::StaticOrder S; S.init(gm.M, gm.N, nb, bid);
    pg8::EpiStore E; E.O = Z; E.ldc = IN_W; E.ncols = NW; E.coff = coff;
    pg8::gemm_phase<pg8::EpiStore, pg8::StaticOrder>((PG8_LAS unsigned char*)smem, gm, S, E);
    return;
  }
#endif
  const int TM = (g.mg + 127) / 128, TN = (NW + 127) / 128;
  const int mg = g.mg;
  for (int t = bid; t < TM * TN; t += nb) {
    int tn = t / TM, tm = t % TM; f4v acc[2][4]; zero_acc<4>(acc);
    gemm_mainloop<4>(H, 1024, tm * 128, mg, W, 1024, tn * 128, NWP, 1024, smem, acc);
    epi_foreach<4>(acc, tm * 128, tn * 128, [&](int row, int c0, f4v& v) {
      if (c0 < NW && row < mg) *(u2v*)(Z + (size_t)row * IN_W + coff + c0) = pack4(v[0], v[1], v[2], v[3]);
    });
  }
}

__device__ __forceinline__ void stage_e1(const Params& p, const Grp& g, int l, int bid, int nb) {
  { const int nbA = g1b_blocks(g, nb); if (bid < nbA) return; bid -= nbA; nb -= nbA; }
  const int lane = my_tid() & 63, wid = my_tid() >> 6;
  char* ws = p.ws;
  const bf16_t* Z = (const bf16_t*)(ws + O_Z);
  bf16_t* SK = (bf16_t*)(ws + O_SK); bf16_t* SOP = (bf16_t*)(ws + O_SOP);
  bf16_t* LORA = (bf16_t*)(ws + O_LORA); bf16_t* QDN = (bf16_t*)(ws + O_QDN); bf16_t* CKV = (bf16_t*)(ws + O_CKV); bf16_t* KR = (bf16_t*)(ws + O_KR);
  bf16_t* VCN = (bf16_t*)(ws + O_VCNT);
  const float* rope = (const float*)(ws + O_ROPE);
  const float* mu = p.shift_mu + (size_t)l * SHIFT_W;
  const int isden = g.isden, T = g.T;
  for (int m = bid * NWAVE + wid; m < g.mkv; m += nb * NWAVE) {
    if (m >= g.mg) {
      int r = m - g.mg, b = r / PAST, j = r % PAST;
      if (lane < 20) {
        const float* s = lane < 16 ? p.c_ckv + (((size_t)b * NL + l) * PAST + j) * 128 + lane * 8 : p.c_kr + (((size_t)b * NL + l) * PAST + j) * 32 + (lane - 16) * 8;
        f4v x0 = *(const f4v*)s, x1 = *(const f4v*)(s + 4); float x[8] = {x0[0], x0[1], x0[2], x0[3], x1[0], x1[1], x1[2], x1[3]};
        if (lane < 16) *(u4v*)(CKV + (size_t)m * 128 + lane * 8) = pack8(x);
        else { const int key = T + j, d8 = lane - 16;
          *(u4v*)(KR + ((((size_t)b * (g.nkeys >> 5) + (key >> 5)) * 2 + (d8 >> 1)) * 64 + (d8 & 1) * 32 + (key & 31)) * 8) = pack8(x); }
      }
      continue;
    }
    const int sq = m / T, t = m % T, b = g.b0 + sq;
    const bf16_t* z = Z + (size_t)m * IN_W;
    const bool hp = t > 0, hn = t < T - 1;
#pragma unroll
    for (int it = 0; it < 4; ++it) {
      const int ci = it * 64 + lane; const bool valid = ci < 216; const int cc = valid ? ci : 0;
      float zc[8], pv[8], nv[8], sf[8];
      unpack8(*(const u4v*)(z + cc * 8), zc);
      if (hp) unpack8(*(const u4v*)(z - IN_W + cc * 8), pv); else { for (int e = 0; e < 8; ++e) pv[e] = 0.f; }
      if (hn) unpack8(*(const u4v*)(z + IN_W + cc * 8), nv); else { for (int e = 0; e < 8; ++e) nv[e] = 0.f; }
      f4v m0 = *(const f4v*)(mu + cc * 8), m1 = *(const f4v*)(mu + cc * 8 + 4);
#pragma unroll
      for (int e = 0; e < 8; ++e) sf[e] = zc[e] + (0.5f * (pv[e] + nv[e]) - zc[e]) * (e < 4 ? m0[e] : m1[e - 4]);
      bf16_t* rec = SOP + (((size_t)sq * 8 + (lane >> 3)) * T + t) * 576 + (lane & 7) * 8;
      if (it == 0) *(u4v*)rec = pack8(sf);
      else if (it == 1) {
        *(u4v*)(SK + (size_t)m * 512 + lane * 8) = pack8(sf);
        f4v k0 = *(const f4v*)(p.k_k + (size_t)l * 512 + lane * 8), k1 = *(const f4v*)(p.k_k + (size_t)l * 512 + lane * 8 + 4);
        float kr[8]; float n2 = 0.f;
#pragma unroll
        for (int e = 0; e < 8; ++e) { kr[e] = sf[e] * (e < 4 ? k0[e] : k1[e - 4]); n2 += kr[e] * kr[e]; }
        n2 = sum_lpr<8>(n2); const float inv = 1.f / fmaxf(sqrtf(n2), 1e-12f);
#pragma unroll
        for (int e = 0; e < 8; ++e) kr[e] *= inv;
        *(u4v*)(rec + 64) = pack8(kr);
      }
      else if (it == 2) *(u4v*)(rec + 128) = pack8(sf);
      else if (valid) {
        if (lane < 16) { for (int e = 0; e < 8; ++e) sf[e] = tanhf_(sf[e]); }
        *(u4v*)(LORA + (size_t)m * 192 + lane * 8) = pack8(sf);
      }
    }
    {
      const int col = lane < 32 ? ZC_QD + lane * 8 : (lane < 48 ? ZC_KVD + (lane - 32) * 8 : ZC_KR + ((lane - 48) & 3) * 8);
      float x[8]; unpack8(*(const u4v*)(z + col), x);
      float ss = 0.f;
#pragma unroll
      for (int e = 0; e < 8; ++e) ss += x[e] * x[e];
      const float t32 = sum_lpr<32>(ss), t16 = sum_lpr<16>(ss);
      if (lane < 32) {
        const float rs = rsqrtf(t32 * (1.f / 256.f) + 1e-6f); const float* gq = p.q_norm + (size_t)l * 256 + lane * 8; float o[8];
#pragma unroll
        for (int e = 0; e < 8; ++e) o[e] = x[e] * rs * gq[e];
        *(u4v*)(QDN + (size_t)m * 256 + lane * 8) = pack8(o);
      } else if (lane < 48) {
        const float rs = rsqrtf(t16 * (1.f / 128.f) + 1e-6f); const float* gk = p.kv_norm + (size_t)l * 128 + (lane - 32) * 8; float o[8];
#pragma unroll
        for (int e = 0; e < 8; ++e) o[e] = x[e] * rs * gk[e];
        *(u4v*)(CKV + (size_t)m * 128 + (lane - 32) * 8) = pack8(o);
        if (!isden) { float* op = p.out + OUT_CKV + (((size_t)b * NL + l) * T_C + t) * 128 + (lane - 32) * 8; *(f4v*)op = f4v{o[0], o[1], o[2], o[3]}; *(f4v*)(op + 4) = f4v{o[4], o[5], o[6], o[7]}; }
      } else if (lane < 52) {
        float o[8];
        if (isden) {
#pragma unroll
          for (int pq = 0; pq < 4; ++pq) { int pi = (lane - 48) * 4 + pq; float cs = rope[((size_t)t * 16 + pi) * 2], sn = rope[((size_t)t * 16 + pi) * 2 + 1];
            o[2 * pq] = x[2 * pq] * cs - x[2 * pq + 1] * sn; o[2 * pq + 1] = x[2 * pq] * sn + x[2 * pq + 1] * cs; }
        } else {
#pragma unroll
          for (int e = 0; e < 8; ++e) o[e] = x[e];
          float* op = p.out + OUT_KR + (((size_t)b * NL + l) * T_C + t) * 32 + (lane - 48) * 8; *(f4v*)op = f4v{x[0], x[1], x[2], x[3]}; *(f4v*)(op + 4) = f4v{x[4], x[5], x[6], x[7]};
        }
        { const int d8 = lane - 48; *(u4v*)(KR + ((((size_t)sq * (g.nkeys >> 5) + (t >> 5)) * 2 + (d8 >> 1)) * 64 + (d8 & 1) * 32 + (t & 31)) * 8) = pack8(o); }
      }
    }
    {
      float v[8]; unpack8(*(const u4v*)(z + ZC_VC + lane * 8), v);
      float s1 = 0.f;
#pragma unroll
      for (int e = 0; e < 8; ++e) { v[e] = geluf_(v[e]); s1 += v[e]; }
      s1 = wave_sum(s1); const float mean = s1 * (1.f / 512.f); float s2 = 0.f;
#pragma unroll
      for (int e = 0; e < 8; ++e) { float d = v[e] - mean; s2 += d * d; }
      s2 = wave_sum(s2); const float rs = rsqrtf(s2 * (1.f / 512.f) + 1e-5f);
      const float* gg = p.g_ln_g + (size_t)l * 512 + lane * 8; const float* gb = p.g_ln_b + (size_t)l * 512 + lane * 8;
#pragma unroll
      for (int e = 0; e < 8; ++e) v[e] = (v[e] - mean) * rs * gg[e] + gb[e];
      *(u4v*)(VCN + (size_t)m * 512 + lane * 8) = pack8(v);
    }
  }
}

__device__ __forceinline__ void stage_g2(const Params& p, const Grp& g, int l, int bid, int nb, char* smem) {
  char* ws = p.ws;
  const bf16_t* Z = (const bf16_t*)(ws + O_Z);
  const float* rope = (const float*)(ws + O_ROPE);
  const int mg = g.mg, mkv = g.mkv, T = g.T, isden = g.isden, nkeys = g.nkeys;
  const int TM_M = (mg + 127) / 128, TM_KV = (mkv + 127) / 128;
  const int NT_Q = TM_M * 6, NT_KV = TM_KV * 8, NT_LORA = TM_M * 8, NT_GM = (mg / 128) * 8, ntt = T / 128, NT_D1 = g.nseq * 8 * ntt;
  const int NT = NT_Q + NT_KV + NT_LORA + NT_GM + NT_D1;
  for (int t0 = bid; t0 < NT; t0 += nb) {
    int t = t0; f4v acc[2][4]; zero_acc<4>(acc);
    if (t < NT_Q) {
      int tn = t / TM_M, tm = t % TM_M;
      gemm_mainloop<4>((const bf16_t*)(ws + O_QDN), 256, tm * 128, mg, (const bf16_t*)(ws + O_WQT), 256, tn * 128, 768, 256, smem, acc);
      bf16_t* Q = (bf16_t*)(ws + O_Q);
      const float scale = 0.10206207261596575f * 1.4426950408889634f;
      epi_foreach<4>(acc, tm * 128, tn * 128, [&](int row, int c0, f4v& v) {
        if (row >= mg) return;
        int cw = c0 % 96; float o0 = v[0], o1 = v[1], o2 = v[2], o3 = v[3];
        if (cw >= 64 && isden) { int tt = row % T_D; int pi = (cw - 64) >> 1; const float* rp = rope + ((size_t)tt * 16 + pi) * 2;
          float c_a = rp[0], s_a = rp[1], c_b = rp[2], s_b = rp[3];
          o0 = v[0] * c_a - v[1] * s_a; o1 = v[0] * s_a + v[1] * c_a; o2 = v[2] * c_b - v[3] * s_b; o3 = v[2] * s_b + v[3] * c_b; }
        *(u2v*)(Q + (size_t)row * 768 + c0) = pack4(o0 * scale, o1 * scale, o2 * scale, o3 * scale);
      });
      continue;
    }
    t -= NT_Q;
    if (t < NT_KV) {
      int tn = t / TM_KV, tm = t % TM_KV;
      gemm_mainloop<4>((const bf16_t*)(ws + O_CKV), 128, tm * 128, mkv, (const bf16_t*)(ws + O_WKVT), 128, tn * 128, 1024, 128, smem, acc);
      bf16_t* KN = (bf16_t*)(ws + O_KN); bf16_t* VT = (bf16_t*)(ws + O_VT);
      bf16_t* sT = (bf16_t*)smem;
      __syncthreads();
      epi_foreach<4>(acc, 0, 0, [&](int row, int c0, f4v& v) { *(u2v*)(sT + row * 136 + c0) = pack4(v[0], v[1], v[2], v[3]); });
      __syncthreads();
      { const int tid = my_tid(), ntile = nkeys >> 5, h = tn;
#pragma unroll 1
        for (int q4 = 0; q4 < 4; ++q4) {
          const int item = tid + NTHR * q4;
          const int part = item >> 10, kt4 = (item >> 8) & 3, fr = (item >> 6) & 3, ln = item & 63, lq = ln & 31, lh = ln >> 5;
          const int r0 = tm * 128 + kt4 * 32;
          if (r0 < mkv) {
            int sq, key0; if (r0 < mg) { sq = r0 / T; key0 = r0 % T; } else { int r = r0 - mg; sq = r / PAST; key0 = T + r % PAST; }
            const size_t tb = (((size_t)sq * 8 + h) * ntile + (key0 >> 5)) * 4 + fr;
            if (part == 0) {
              *(u4v*)(KN + (tb * 64 + ln) * 8) = *(const u4v*)(sT + (kt4 * 32 + lq) * 136 + 16 * fr + 8 * lh);
            } else {
              const int st = fr >> 1, db = fr & 1; unsigned short e8[8];
#pragma unroll
              for (int j = 0; j < 8; ++j) e8[j] = sT[(kt4 * 32 + 16 * st + 8 * (j >> 2) + 4 * lh + (j & 3)) * 136 + 64 + db * 32 + lq];
              *(u4v*)(VT + (tb * 64 + ln) * 8) = u4v{(unsigned)e8[0] | ((unsigned)e8[1] << 16), (unsigned)e8[2] | ((unsigned)e8[3] << 16), (unsigned)e8[4] | ((unsigned)e8[5] << 16), (unsigned)e8[6] | ((unsigned)e8[7] << 16)};
            }
          }
        }
      }
      continue;
    }
    t -= NT_KV;
    if (t < NT_LORA) {
      int dir = t / (TM_M * 4), r = t % (TM_M * 4), tn = r / TM_M, tm = r % TM_M;
      f4v aa[2][4]; zero_acc<4>(aa);
      { GT d1 = mk_gt((const bf16_t*)(ws + O_LORA) + dir * 64, 192, tm * 128, mg, (const bf16_t*)(ws + O_WUPT) + (size_t)dir * 512 * 64, 64, tn * 128, 512, 64);
        GT d2 = mk_gt((const bf16_t*)(ws + O_LORA) + 128, 192, tm * 128, mg, (const bf16_t*)(ws + O_WUPT) + (size_t)(2 + dir) * 512 * 64, 64, tn * 128, 512, 64);
        u4v ra[2], rb[2]; gemm_prefetch<4>(d1, ra, rb);
        gemm_run<4, false>(d1, &d2, ra, rb, smem, acc);
        gemm_run<4, false>(d2, nullptr, ra, rb, smem, aa); }
      bf16_t* sW = (bf16_t*)smem; bf16_t* sA2 = sW + 128 * 136;
      __syncthreads();
      epi_foreach<4>(acc, 0, 0, [&](int row, int c0, f4v& v) { *(u2v*)(sW + row * 136 + c0) = pack4(v[0], v[1], v[2], v[3]); });
      epi_foreach<4>(aa, 0, 0, [&](int row, int c0, f4v& v) { *(u2v*)(sA2 + row * 136 + c0) = pack4(v[0], v[1], v[2], v[3]); });
      __syncthreads();
      const bf16_t* SK = (const bf16_t*)(ws + O_SK); bf16_t* SOP = (bf16_t*)(ws + O_SOP); float* BON = (float*)(ws + O_BON);
      const int tid = my_tid();
#pragma unroll 1
      for (int q4 = 0; q4 < 4; ++q4) {
        const int item = tid + NTHR * q4, rowl = item >> 4, ch8 = item & 15;
        int row = tm * 128 + rowl; const bool ok = row < mg; if (!ok) row = mg - 1;
        const int h = tn * 2 + (ch8 >> 3), chn = (ch8 & 7) * 8, c = h * 64 + chn;
        const int sq = row / T, tt = row % T;
        bf16_t* rec = SOP + (((size_t)sq * 8 + h) * T + tt) * 576;
        float pw[8], pa[8], kv[8], kkv[8], rv[8];
        unpack8(*(const u4v*)(sW + rowl * 136 + ch8 * 8), pw); unpack8(*(const u4v*)(sA2 + rowl * 136 + ch8 * 8), pa);
        unpack8(*(const u4v*)(SK + (size_t)row * 512 + c), kv); unpack8(*(const u4v*)(rec + 64 + chn), kkv); unpack8(*(const u4v*)(rec + chn), rv);
        const float* w0 = p.w0 + ((size_t)l * 2 + dir) * 512 + c; const float* a0 = p.a0 + ((size_t)l * 2 + dir) * 512 + c;
        const float* k_a = p.k_a + (size_t)l * 512 + c; const float* r_k = p.r_k + (size_t)l * 512 + c;
        float dd[8], bb[8], kt[8]; float bon = 0.f;
#pragma unroll
        for (int e = 0; e < 8; ++e) {
          dd[e] = 1.f - fexp_(-0.6065306597126334f * sigmoidf_(pw[e] + w0[e]));
          const float av = sigmoidf_(pa[e] + a0[e]);
          bb[e] = kkv[e] * av; kt[e] = kv[e] * (1.f + (av - 1.f) * k_a[e]);
          bon += rv[e] * kt[e] * r_k[e];
        }
        if (ok) { *(u4v*)(rec + (3 + 3 * dir) * 64 + chn) = pack8(dd); *(u4v*)(rec + (4 + 3 * dir) * 64 + chn) = pack8(bb); *(u4v*)(rec + (5 + 3 * dir) * 64 + chn) = pack8(kt); }
        bon = sum_lpr<8>(bon);
        if (ok && (ch8 & 7) == 0) BON[((size_t)row * 8 + h) * 2 + dir] = bon;
      }
      continue;
    }
    t -= NT_LORA;
    if (t < NT_GM) {
      int ch = t >> 3, gg = (t >> 1) & 3, dh = t & 1;
      f4v ac2[2][2]; zero_acc<2>(ac2);
      gemm_mainloop<2, true>((const bf16_t*)(ws + O_WS) + (size_t)gg * 128 * 128, 128, 0, 128, (const bf16_t*)(ws + O_VCNT) + (size_t)ch * 128 * 512, 512, gg * 128 + dh * 64, 512, 128, smem, ac2);
      bf16_t* O = (bf16_t*)(ws + O_OBR) + (size_t)2 * MG * 512;
      const float* bs = p.g_b_s + ((size_t)l * 4 + gg) * 128;
      epi_foreach<2>(ac2, 0, dh * 64, [&](int pp, int c0, f4v& v) {
        int m = ch * 128 + pp; int c = gg * 128 + c0; float bb = bs[pp];
        u2v uu = *(const u2v*)(Z + (size_t)m * IN_W + ZC_U + c), gc = *(const u2v*)(Z + (size_t)m * IN_W + ZC_GC + c);
        *(u2v*)(O + (size_t)m * 512 + c) = pack4(geluf_(bflo(uu.x)) * (v[0] + bb) * siluf_(bflo(gc.x)), geluf_(bfhi(uu.x)) * (v[1] + bb) * siluf_(bfhi(gc.x)),
                                                 geluf_(bflo(uu.y)) * (v[2] + bb) * siluf_(bflo(gc.y)), geluf_(bfhi(uu.y)) * (v[3] + bb) * siluf_(bfhi(gc.y)));
      });
      continue;
    }
    t -= NT_GM;
    {
      int per_seq = 8 * ntt; int sq = t / per_seq; int r = t % per_seq; int gg = r / (2 * ntt); int r2 = r % (2 * ntt); int tj = r2 / ntt, tt = r2 % ntt;
      long mbase = (long)sq * T;
      gemm_mainloop<4>((const bf16_t*)(ws + O_CS128), 128, tj * 128, 256, Z + (size_t)mbase * IN_W + ZC_F + gg * 128, IN_W, tt * 128, T, 128, smem, acc);
      bf16_t* YT = (bf16_t*)(ws + O_YT) + (size_t)mbase * 1024 + (size_t)gg * 128 * 2 * T;
      epi_foreach<4>(acc, tj * 128, tt * 128, [&](int j, int c0, f4v& v) {
        *(u2v*)(YT + (size_t)(j & 127) * 2 * T + (size_t)(j >> 7) * T + c0) = pack4(v[0], v[1], v[2], v[3]);
      });
    }
  }
}

__device__ __forceinline__ bool wave_any(bool pr) {
#ifdef EMU
  return wave_sum(pr ? 1.f : 0.f) > 0.f;
#else
  return __builtin_amdgcn_ballot_w64(pr) != 0ull;
#endif
}
__device__ __forceinline__ void attention_task(const Params& p, const Grp& g, int sq, int h, int qb32) {
  char* ws = p.ws;
  const int lane = my_tid() & 63, ql = lane & 31, hh = lane >> 5;
  const int T = g.T, nkeys = g.nkeys;
  const long mbase = (long)sq * T;
  const bf16_t* Q = (const bf16_t*)(ws + O_Q); const bf16_t* KN = (const bf16_t*)(ws + O_KN); const bf16_t* KRp = (const bf16_t*)(ws + O_KR);
  const int ntile = nkeys >> 5;
  const bf16_t* KFb = KN + ((size_t)sq * 8 + h) * ntile * 4 * 512 + lane * 8;
  const bf16_t* KRb = KRp + (size_t)sq * ntile * 2 * 512 + lane * 8;
  const bf16_t* VFb = (const bf16_t*)(ws + O_VT) + ((size_t)sq * 8 + h) * ntile * 4 * 512 + lane * 8;
  const long mq = mbase + qb32 * 32 + ql;
  s8v qf[6];
#pragma unroll
  for (int s = 0; s < 6; ++s) qf[s] = *(const s8v*)(Q + (size_t)mq * 768 + h * 96 + 16 * s + 8 * hh);
  f16v o0, o1;
#pragma unroll
  for (int i = 0; i < 16; ++i) { o0[i] = 0.f; o1[i] = 0.f; }
  float mrun = -1e30f, lrun = 0.f;
  s8v kfA[6], vfA[4], kfB[6], vfB[4];
#define ATT_LOAD(k0_, KF, VF) do { const int tl = (k0_) >> 5; \
    _Pragma("unroll") for (int st = 0; st < 4; ++st) KF[st] = *(const s8v*)(KFb + (size_t)(tl * 4 + st) * 512); \
    _Pragma("unroll") for (int st = 0; st < 2; ++st) KF[4 + st] = *(const s8v*)(KRb + (size_t)(tl * 2 + st) * 512); \
    _Pragma("unroll") for (int q = 0; q < 4; ++q) VF[q] = *(const s8v*)(VFb + (size_t)(tl * 4 + q) * 512); } while (0)
#define ATT_TILE(KF, VF) do { \
    f16v s; _Pragma("unroll") for (int i = 0; i < 16; ++i) s[i] = 0.f; \
    _Pragma("unroll") for (int st = 0; st < 6; ++st) s = __builtin_amdgcn_mfma_f32_32x32x16_bf16(KF[st], qf[st], s, 0, 0, 0); \
    float mx = s[0]; _Pragma("unroll") for (int i = 1; i < 16; ++i) mx = fmaxf(mx, s[i]); \
    mx = fmaxf(mx, __shfl_xor(mx, 32)); \
    if (wave_any(mx > mrun)) { const float mnew = fmaxf(mrun, mx); const float alpha = fexp2_(mrun - mnew); mrun = mnew; lrun *= alpha; \
      _Pragma("unroll") for (int i = 0; i < 16; ++i) { o0[i] *= alpha; o1[i] *= alpha; } } \
    float ps = 0.f; float pe[16]; \
    _Pragma("unroll") for (int i = 0; i < 16; ++i) { pe[i] = fexp2_(s[i] - mrun); ps += pe[i]; } \
    lrun += ps; \
    _Pragma("unroll") for (int st = 0; st < 2; ++st) { \
      const s8v pf = __builtin_bit_cast(s8v, u4v{pk2bf(pe[8 * st], pe[8 * st + 1]), pk2bf(pe[8 * st + 2], pe[8 * st + 3]), pk2bf(pe[8 * st + 4], pe[8 * st + 5]), pk2bf(pe[8 * st + 6], pe[8 * st + 7])}); \
      o0 = __builtin_amdgcn_mfma_f32_32x32x16_bf16(VF[st * 2], pf, o0, 0, 0, 0); \
      o1 = __builtin_amdgcn_mfma_f32_32x32x16_bf16(VF[st * 2 + 1], pf, o1, 0, 0, 0); } } while (0)
  ATT_LOAD(0, kfA, vfA);
  int k0 = 0;
  for (; k0 + 64 <= nkeys; k0 += 64) {
    ATT_LOAD(k0 + 32, kfB, vfB); SCHED_FENCE();
    ATT_TILE(kfA, vfA); SCHED_FENCE();
    ATT_LOAD((k0 + 64 < nkeys) ? k0 + 64 : nkeys - 32, kfA, vfA); SCHED_FENCE();
    ATT_TILE(kfB, vfB); SCHED_FENCE();
  }
  if (k0 < nkeys) ATT_TILE(kfA, vfA);
#undef ATT_LOAD
#undef ATT_TILE
  const float ltot = lrun + __shfl_xor(lrun, 32); const float inv = 1.f / ltot;
  const bf16_t* Z = (const bf16_t*)(ws + O_Z);
  bf16_t* O = (bf16_t*)(ws + O_OBR) + (size_t)1 * MG * 512;
#pragma unroll
  for (int db = 0; db < 2; ++db)
#pragma unroll
    for (int q4 = 0; q4 < 4; ++q4) {
      const int dv = db * 32 + 8 * q4 + 4 * hh;
      u2v gt = *(const u2v*)(Z + (size_t)mq * IN_W + ZC_GB + h * 64 + dv);
      const float x0 = (db == 0 ? o0[4 * q4] : o1[4 * q4]) * inv, x1 = (db == 0 ? o0[4 * q4 + 1] : o1[4 * q4 + 1]) * inv, x2 = (db == 0 ? o0[4 * q4 + 2] : o1[4 * q4 + 2]) * inv, x3 = (db == 0 ? o0[4 * q4 + 3] : o1[4 * q4 + 3]) * inv;
      *(u2v*)(O + (size_t)mq * 512 + h * 64 + dv) = pack4(x0 * siluf_(bflo(gt.x)), x1 * siluf_(bfhi(gt.x)), x2 * siluf_(bflo(gt.y)), x3 * siluf_(bfhi(gt.y)));
    }
}

__device__ __forceinline__ void stage_dft2(const Params& p, const Grp& g, int bid, int nb, char* smem) {
  char* ws = p.ws;
  const bf16_t* Z = (const bf16_t*)(ws + O_Z);
  const int T = g.T, ntt = T / 128;
  const int NT_D2 = g.nseq * 4 * ntt;
  const int soff = (g.nseq * 32) % nb;
  for (int t = (bid - soff + nb) % nb; t < NT_D2; t += nb) {
    int sq = t / (4 * ntt), r = t % (4 * ntt), gg = r / ntt, tt = r % ntt;
    long mbase = (long)sq * T;
    f4v acc[2][4]; zero_acc<4>(acc);
    { GT d = mk_gt((const bf16_t*)(ws + (g.isden ? O_A2D : O_A2C)), 2 * T, tt * 128, T, (const bf16_t*)(ws + O_YT) + (size_t)mbase * 1024 + (size_t)gg * 128 * 2 * T, 2 * T, 0, 128, 2 * T); gemm_deep<4>(d, smem, acc); }
    bf16_t* O = (bf16_t*)(ws + O_OBR) + (size_t)3 * MG * 512;
    const float sc = rsqrtf(128.f * (float)T);
    epi_foreach<4>(acc, tt * 128, 0, [&](int row, int c0, f4v& v) {
      long m = mbase + row; int c = gg * 128 + c0; u2v gd = *(const u2v*)(Z + (size_t)m * IN_W + ZC_GD + c);
      *(u2v*)(O + (size_t)m * 512 + c) = pack4(v[0] * sc * siluf_(bflo(gd.x)), v[1] * sc * siluf_(bfhi(gd.x)), v[2] * sc * siluf_(bflo(gd.y)), v[3] * sc * siluf_(bfhi(gd.y)));
    });
  }
}

constexpr int PL_STR = 72;
constexpr int PCH_MA = 0, PCH_MB = 4608, PCH_TBT = 9216, PCH_MBT = 10240, PCH_TK = 11264, PCH_MK = 12288, PCH_LDS = 13312;
__device__ __forceinline__ void pchunk_task(const Params& p, const Grp& g, int task, char* wl) {
  char* ws = p.ws;
  const int lane = my_tid() & 63, ql = lane & 31, hh = lane >> 5;
  const int T = g.T, nch = T >> 4;
  const int ch = task / nch, ci = task % nch;
  const int dir = ch & 1, h = (ch >> 1) & 7, sq = ch >> 4;
  const bf16_t* rec0 = (const bf16_t*)(ws + O_SOP) + ((size_t)sq * 8 + h) * T * 576;
  char* cm = ws + O_CM + (size_t)task * CM_REC;
  float At[16], Rt[16], Bh[16], Kh[16]; float W = 1.f;
#pragma unroll
  for (int j = 0; j < 16; ++j) {
    const int st = ci * 16 + j, tt = dir ? T - 1 - st : st;
    const bf16_t* rec = rec0 + (size_t)tt * 576;
    const float r = bf2f(rec[lane]), kk = bf2f(rec[64 + lane]), d = bf2f(rec[(3 + 3 * dir) * 64 + lane]), b = bf2f(rec[(4 + 3 * dir) * 64 + lane]), kt = bf2f(rec[(5 + 3 * dir) * 64 + lane]);
    At[j] = -kk * W; W *= (1.f - d); const float iw = frcp_(W); Rt[j] = r * W; Bh[j] = b * iw; Kh[j] = kt * iw;
  }
  {
    float x[8];
#pragma unroll
    for (int q = 0; q < 2; ++q) {
#pragma unroll
      for (int e = 0; e < 8; ++e) { const int st = ci * 16 + q * 8 + e, tt = dir ? T - 1 - st : st; x[e] = bf2f(rec0[(size_t)tt * 576 + 128 + lane]); }
      *(u4v*)(cm + CM_VT + (((lane >> 5) * 64 + q * 32 + (lane & 31)) * 16)) = pack8(x);
    }
  }
  {
    float x[8];
    const int k2 = lane >> 5, kq = lane & 31;
#pragma unroll
    for (int hq = 0; hq < 2; ++hq) {
#pragma unroll
      for (int e = 0; e < 8; ++e) x[e] = Bh[8 * (e >> 2) + 4 * hq + (e & 3)] * W;
      *(u4v*)(cm + CM_BKT + (((k2 * 2 + 0) * 64 + hq * 32 + kq) * 16)) = pack8(x);
#pragma unroll
      for (int e = 0; e < 8; ++e) x[e] = Kh[8 * hq + e] * W;
      *(u4v*)(cm + CM_BKT + (((k2 * 2 + 1) * 64 + hq * 32 + kq) * 16)) = pack8(x);
    }
    *(float*)(cm + CM_WL + lane * 4) = W;
  }
  bf16_t* MA = (bf16_t*)(wl + PCH_MA); bf16_t* MB = (bf16_t*)(wl + PCH_MB);
  float* TBT = (float*)(wl + PCH_TBT); float* MBT = (float*)(wl + PCH_MBT); float* TK = (float*)(wl + PCH_TK); float* MK = (float*)(wl + PCH_MK);
  WAVE_SYNC();
#pragma unroll
  for (int j = 0; j < 16; ++j) { MA[j * PL_STR + lane] = f2bf(Bh[j]); MA[(16 + j) * PL_STR + lane] = f2bf(Kh[j]); MB[j * PL_STR + lane] = f2bf(At[j]); MB[(16 + j) * PL_STR + lane] = f2bf(Rt[j]); }
  WAVE_SYNC();
  f16v D;
#pragma unroll
  for (int i = 0; i < 16; ++i) D[i] = 0.f;
#pragma unroll
  for (int s4 = 0; s4 < 4; ++s4) {
    const s8v fa = *(const s8v*)(MA + ql * PL_STR + 16 * s4 + 8 * hh), fb = *(const s8v*)(MB + ql * PL_STR + 16 * s4 + 8 * hh);
    D = __builtin_amdgcn_mfma_f32_32x32x16_bf16(fa, fb, D, 0, 0, 0);
  }
#pragma unroll
  for (int r = 0; r < 16; ++r) {
    const int i = (r & 3) + 8 * (r >> 2) + 4 * hh; const float v = D[r];
    if (r < 8) { if (ql < 16) TBT[ql * 16 + i] = (i < ql) ? v : 0.f; else MBT[(ql - 16) * 16 + i] = (i <= ql - 16) ? v : 0.f; }
    else { const int i2 = i - 16; if (ql < 16) TK[i2 * 16 + ql] = (i2 < ql) ? v : 0.f; else MK[i2 * 16 + (ql - 16)] = (i2 <= ql - 16) ? v : 0.f; }
  }
  WAVE_SYNC();
  const int l16 = lane & 15;
  float Z[16], Z2[16];
#pragma unroll
  for (int j = 0; j < 16; ++j) { Z[j] = 0.f; Z2[j] = 0.f; }
#pragma unroll
  for (int j = 0; j < 16; ++j) {
    float a1 = At[j], a2 = TK[l16 * 16 + j];
#pragma unroll
    for (int c4 = 0; c4 * 4 < j; ++c4) { const f4v tv = *(const f4v*)(TBT + j * 16 + c4 * 4);
#pragma unroll
      for (int e = 0; e < 4; ++e) if (c4 * 4 + e < j) { a1 += Z[c4 * 4 + e] * tv[e]; a2 += Z2[c4 * 4 + e] * tv[e]; } }
    Z[j] = a1; Z2[j] = a2;
  }
  bf16_t* GL = (bf16_t*)(wl + PCH_MA);
#pragma unroll
  for (int t = 0; t < 16; ++t) {
    float a1 = Rt[t], a2 = MK[l16 * 16 + t];
#pragma unroll
    for (int c4 = 0; c4 * 4 <= t; ++c4) { const f4v mv = *(const f4v*)(MBT + t * 16 + c4 * 4);
#pragma unroll
      for (int e = 0; e < 4; ++e) if (c4 * 4 + e <= t) { a1 += Z[c4 * 4 + e] * mv[e]; a2 += Z2[c4 * 4 + e] * mv[e]; } }
    GL[(16 + t) * 88 + lane] = f2bf(a1);
    if (lane < 16) GL[(16 + t) * 88 + 64 + lane] = f2bf(a2);
  }
#pragma unroll
  for (int j = 0; j < 16; ++j) { GL[j * 88 + lane] = f2bf(Z[j]); if (lane < 16) GL[j * 88 + 64 + lane] = f2bf(Z2[j]); }
  WAVE_SYNC();
  { const bf16_t* gr = GL + ql * 88;
#pragma unroll
    for (int s4 = 0; s4 < 4; ++s4) { const u2v lo = *(const u2v*)(gr + 16 * s4 + 4 * hh), hi = *(const u2v*)(gr + 16 * s4 + 8 + 4 * hh);
      *(u4v*)(cm + CM_GT + (s4 * 64 + lane) * 16) = u4v{lo.x, lo.y, hi.x, hi.y}; }
    *(u4v*)(cm + CM_GT + (4 * 64 + lane) * 16) = *(const u4v*)(gr + 64 + 8 * hh);
  }
  WAVE_SYNC();
}

__device__ __forceinline__ s8v cvt8(const f16v& a, int o) {
  return __builtin_bit_cast(s8v, u4v{pk2bf(a[o], a[o + 1]), pk2bf(a[o + 2], a[o + 3]), pk2bf(a[o + 4], a[o + 5]), pk2bf(a[o + 6], a[o + 7])});
}
struct ScanOps { s8v gA[5], bU[2], bV[2], vf; float wreg; };
__device__ __forceinline__ void scan2_load(ScanOps& o, const char* cm, const bf16_t* rec0, int ci, int T, int dir, int ql, int hh, int row) {
  const int lane = hh * 32 + ql, rt = row >> 5;
  o.wreg = *(const float*)(cm + CM_WL + lane * 4);
#pragma unroll
  for (int s = 0; s < 5; ++s) o.gA[s] = *(const s8v*)(cm + CM_GT + (s * 64 + lane) * 16);
#pragma unroll
  for (int k2 = 0; k2 < 2; ++k2) { o.bU[k2] = *(const s8v*)(cm + CM_BKT + ((k2 * 2) * 64 + lane) * 16); o.bV[k2] = *(const s8v*)(cm + CM_BKT + ((k2 * 2 + 1) * 64 + lane) * 16); }
  o.vf = *(const s8v*)(cm + CM_VT + (rt * 64 + lane) * 16);
  (void)rec0; (void)ci; (void)T; (void)dir;
}
__device__ __forceinline__ void scan2_task(const Params& p, const Grp& g, int l, int task, char* wl) {
  char* ws = p.ws;
  const int lane = my_tid() & 63, ql = lane & 31, hh = lane >> 5;
  const int T = g.T, nch = T >> 4;
  const int ch = task >> 1, rt = task & 1;
  const int dir = ch & 1, h = (ch >> 1) & 7, sq = ch >> 4;
  const int row = rt * 32 + ql;
  const long mbase = (long)sq * T;
  const bf16_t* rec0 = (const bf16_t*)(ws + O_SOP) + ((size_t)sq * 8 + h) * T * 576;
  const char* cm0 = ws + O_CM + (size_t)ch * nch * CM_REC;
  float* YS = (float*)(ws + O_YS) + (size_t)dir * MG * 512;
  float* wlf = (float*)wl;
  f16v a0, a1;
  if (g.isden) { const float* st = (dir ? p.st_b : p.st_f) + ((((size_t)sq * NL + l) * 8 + h) * 64 + row) * 64;
#pragma unroll
    for (int q = 0; q < 4; ++q) { f4v x = *(const f4v*)(st + 8 * q + 4 * hh), y = *(const f4v*)(st + 32 + 8 * q + 4 * hh);
#pragma unroll
      for (int e = 0; e < 4; ++e) { a0[4 * q + e] = x[e]; a1[4 * q + e] = y[e]; } } }
  else {
#pragma unroll
    for (int i = 0; i < 16; ++i) { a0[i] = 0.f; a1[i] = 0.f; } }
  ScanOps s0, s1, s2;
  scan2_load(s0, cm0, rec0, 0, T, dir, ql, hh, row);
  scan2_load(s1, cm0 + CM_REC, rec0, 1, T, dir, ql, hh, row);
#define SCAN2_STEP(CUR, ci_) do { const int ci = (ci_); \
    WAVE_SYNC(); wlf[lane] = CUR.wreg; WAVE_SYNC(); \
    const s8v vfrag = CUR.vf; \
    f16v D; _Pragma("unroll") for (int i = 0; i < 16; ++i) D[i] = 0.f; \
    D = __builtin_amdgcn_mfma_f32_32x32x16_bf16(CUR.gA[0], cvt8(a0, 0), D, 0, 0, 0); \
    D = __builtin_amdgcn_mfma_f32_32x32x16_bf16(CUR.gA[1], cvt8(a0, 8), D, 0, 0, 0); \
    D = __builtin_amdgcn_mfma_f32_32x32x16_bf16(CUR.gA[2], cvt8(a1, 0), D, 0, 0, 0); \
    D = __builtin_amdgcn_mfma_f32_32x32x16_bf16(CUR.gA[3], cvt8(a1, 8), D, 0, 0, 0); \
    D = __builtin_amdgcn_mfma_f32_32x32x16_bf16(CUR.gA[4], vfrag, D, 0, 0, 0); \
    _Pragma("unroll") for (int i = 0; i < 8; ++i) { const int st = ci * 16 + (i & 3) + 8 * (i >> 2) + 4 * hh, tt = dir ? T - 1 - st : st; YS[(size_t)(mbase + tt) * 512 + h * 64 + row] = D[8 + i]; } \
    const s8v uf = cvt8(D, 0); \
    const float* wq = wlf + 4 * hh; \
    _Pragma("unroll") for (int q = 0; q < 4; ++q) { const f4v w0 = *(const f4v*)(wq + 8 * q), w1 = *(const f4v*)(wq + 32 + 8 * q); \
      _Pragma("unroll") for (int e = 0; e < 4; ++e) { a0[4 * q + e] *= w0[e]; a1[4 * q + e] *= w1[e]; } } \
    a0 = __builtin_amdgcn_mfma_f32_32x32x16_bf16(CUR.bU[0], uf, a0, 0, 0, 0); \
    a0 = __builtin_amdgcn_mfma_f32_32x32x16_bf16(CUR.bV[0], vfrag, a0, 0, 0, 0); \
    a1 = __builtin_amdgcn_mfma_f32_32x32x16_bf16(CUR.bU[1], uf, a1, 0, 0, 0); \
    a1 = __builtin_amdgcn_mfma_f32_32x32x16_bf16(CUR.bV[1], vfrag, a1, 0, 0, 0); } while (0)
  int c = 0;
  for (; c + 3 <= nch; c += 3) {
    { const int cc = (c + 2 < nch) ? c + 2 : nch - 1; scan2_load(s2, cm0 + (size_t)cc * CM_REC, rec0, cc, T, dir, ql, hh, row); }
    SCHED_FENCE(); SCAN2_STEP(s0, c); SCHED_FENCE();
    { const int cc = (c + 3 < nch) ? c + 3 : nch - 1; scan2_load(s0, cm0 + (size_t)cc * CM_REC, rec0, cc, T, dir, ql, hh, row); }
    SCHED_FENCE(); SCAN2_STEP(s1, c + 1); SCHED_FENCE();
    { const int cc = (c + 4 < nch) ? c + 4 : nch - 1; scan2_load(s1, cm0 + (size_t)cc * CM_REC, rec0, cc, T, dir, ql, hh, row); }
    SCHED_FENCE(); SCAN2_STEP(s2, c + 2); SCHED_FENCE();
  }
  if (c < nch) SCAN2_STEP(s0, c);
  if (c + 1 < nch) SCAN2_STEP(s1, c + 1);
#undef SCAN2_STEP
  if (!g.isden) { float* so = p.out + (dir ? OUT_SB : OUT_SF) + ((((size_t)(g.b0 + sq) * NL + l) * 8 + h) * 64 + row) * 64;
#pragma unroll
    for (int q = 0; q < 4; ++q) { *(f4v*)(so + 8 * q + 4 * hh) = f4v{a0[4 * q], a0[4 * q + 1], a0[4 * q + 2], a0[4 * q + 3]}; *(f4v*)(so + 32 + 8 * q + 4 * hh) = f4v{a1[4 * q], a1[4 * q + 1], a1[4 * q + 2], a1[4 * q + 3]}; } }
}

__device__ __forceinline__ void stage_mixA(const Params& p, const Grp& g, int bid, int nb, char* smem) {
  const int wid = my_tid() >> 6;
  const int NP = g.nseq * 16 * (g.T >> 4), q32 = g.T / 32, NA = g.nseq * 8 * q32;
  char* wl = smem + wid * PCH_LDS;
  for (int task = wid * nb + bid; task < NP + NA; task += nb * NWAVE) {
    if (task < NP) pchunk_task(p, g, task, wl);
    else { int t = task - NP; int sq = t / (8 * q32), r = t % (8 * q32); attention_task(p, g, sq, r / q32, r % q32); }
  }
}
__device__ __forceinline__ void stage_scanS(const Params& p, const Grp& g, int l, int bid, int nb, char* smem) {
  const int wid = my_tid() >> 6;
  const int NS = g.nseq * 32;
  for (int task = wid * nb + bid; task < NS; task += nb * NWAVE) scan2_task(p, g, l, task, smem + wid * 768);
  __syncthreads();
}

__device__ __forceinline__ void stage_e3(const Params& p, const Grp& g, int l, int bid, int nb) {
  const int lane = my_tid() & 63, wid = my_tid() >> 6;
  char* ws = p.ws;
  const float* YS = (const float*)(ws + O_YS); const bf16_t* SOP = (const bf16_t*)(ws + O_SOP); const float* BON = (const float*)(ws + O_BON); const int T = g.T;
  const bf16_t* Z = (const bf16_t*)(ws + O_Z); bf16_t* O = (bf16_t*)(ws + O_OBR);
  const int hd = lane >> 3, c0 = lane * 8;
  const float* lg = p.ln_g + (size_t)l * 512 + c0; const float* lb = p.ln_b + (size_t)l * 512 + c0;
  for (int m = bid * NWAVE + wid; m < g.mg; m += nb * NWAVE) {
    const f4v y0 = *(const f4v*)(YS + (size_t)m * 512 + c0), y1 = *(const f4v*)(YS + (size_t)m * 512 + c0 + 4);
    const f4v z0 = *(const f4v*)(YS + ((size_t)MG + m) * 512 + c0), z1 = *(const f4v*)(YS + ((size_t)MG + m) * 512 + c0 + 4);
    float o[8]; float s1 = 0.f;
#pragma unroll
    for (int e = 0; e < 4; ++e) { o[e] = y0[e] + z0[e]; o[4 + e] = y1[e] + z1[e]; }
#pragma unroll
    for (int e = 0; e < 8; ++e) s1 += o[e];
    const float mean = sum_lpr<8>(s1) * (1.f / 64.f); float s2 = 0.f;
#pragma unroll
    for (int e = 0; e < 8; ++e) { o[e] -= mean; s2 += o[e] * o[e]; }
    const float rs = rsqrtf(sum_lpr<8>(s2) * (1.f / 64.f) + 64e-5f);
    const float bon = BON[((size_t)m * 8 + hd) * 2] + BON[((size_t)m * 8 + hd) * 2 + 1];
    float v[8], ga[8];
    unpack8(*(const u4v*)(SOP + (((size_t)(m / T) * 8 + hd) * T + (m % T)) * 576 + 128 + (lane & 7) * 8), v);
    unpack8(*(const u4v*)(Z + (size_t)m * IN_W + ZC_GA + c0), ga);
    float r[8];
#pragma unroll
    for (int e = 0; e < 8; ++e) r[e] = (o[e] * rs * lg[e] + lb[e] + bon * v[e]) * siluf_(ga[e]);
    *(u4v*)(O + (size_t)m * 512 + c0) = pack8(r);
  }
}

__device__ __forceinline__ void stage_gates(const Params& p, const Grp& g, int l, int bid, int nb, char* smem) {
  const bf16_t* H = (const bf16_t*)(p.ws + O_H);
  const bf16_t* W = (const bf16_t*)(p.ws + O_WMT);
  bf16_t* GT = (bf16_t*)(p.ws + O_GATES);
  const float* bm = p.b_merge + (size_t)l * 4096;
#ifndef EMU
  if ((g.mg & 255) == 0) {
    pg8::Gemm gm; gm.A = H; gm.Bt = W; gm.M = g.mg; gm.N = 4096; gm.K = 1024;
    pg8::StaticOrder S; S.init(gm.M, gm.N, nb, bid);
    pg8::EpiSigmoid E; E.O = GT; E.ldc = 4096; E.bias = bm;
    pg8::gemm_phase<pg8::EpiSigmoid, pg8::StaticOrder>((PG8_LAS unsigned char*)smem, gm, S, E);
    return;
  }
#endif
  const int TM = (g.mg + 127) / 128, mg = g.mg;
  for (int t = bid; t < TM * 32; t += nb) {
    int tn = t / TM, tm = t % TM; f4v acc[2][4]; zero_acc<4>(acc);
    gemm_mainloop<4>(H, 1024, tm * 128, mg, W, 1024, tn * 128, 4096, 1024, smem, acc);
    epi_foreach<4>(acc, tm * 128, tn * 128, [&](int row, int c0, f4v& v) {
      if (row < mg) *(u2v*)(GT + (size_t)row * 4096 + c0) = pack4(sigmoidf_(v[0] + bm[c0]), sigmoidf_(v[1] + bm[c0 + 1]), sigmoidf_(v[2] + bm[c0 + 2]), sigmoidf_(v[3] + bm[c0 + 3]));
    });
  }
}

__device__ __forceinline__ void stage_g8(const Params& p, const Grp& g, int l, int bid, int nb, char* smem) {
  char* ws = p.ws;
  bf16_t* MGD = (bf16_t*)(ws + O_MERGED);
  const bf16_t* GTp = (const bf16_t*)(ws + O_GATES);
  const int TM = (g.mg + 127) / 128, mg = g.mg, NT = TM * 8;
  auto desc = [&](int t, int n) { int tn = t / TM, tm = t % TM;
    return mk_gt((const bf16_t*)(ws + O_OBR) + (size_t)n * MG * 512, 512, tm * 128, mg, (const bf16_t*)(ws + O_WBRT) + (size_t)n * 1024 * 512, 512, tn * 128, 1024, 512); };
  for (int t = bid; t < NT; t += nb) {
    int tn = t / TM, tm = t % TM;
    f4v macc[2][4]; zero_acc<4>(macc);
#pragma unroll 1
    for (int n = 0; n < 4; ++n) {
      f4v ap[2][4]; zero_acc<4>(ap);
      GT cur = desc(t, n);
      gemm_deep<4>(cur, smem, ap);
      const int lane = my_tid() & 63, wid = my_tid() >> 6, wm = wid >> 1, wn = wid & 1;
#pragma unroll
      for (int i = 0; i < 2; ++i)
#pragma unroll
        for (int j = 0; j < 4; ++j) {
          int row = tm * 128 + wm * 32 + i * 16 + (lane & 15); row = row < mg ? row : mg - 1;
          int c0 = tn * 128 + wn * 64 + j * 16 + (lane >> 4) * 4;
          u2v gt = *(const u2v*)(GTp + (size_t)row * 4096 + n * 1024 + c0);
          macc[i][j][0] += bflo(gt.x) * ap[i][j][0]; macc[i][j][1] += bfhi(gt.x) * ap[i][j][1]; macc[i][j][2] += bflo(gt.y) * ap[i][j][2]; macc[i][j][3] += bfhi(gt.y) * ap[i][j][3];
        }
    }
    epi_foreach<4>(macc, tm * 128, tn * 128, [&](int row, int c0, f4v& v) {
      if (row < mg) *(u2v*)(MGD + (size_t)row * 1024 + c0) = pack4(v[0], v[1], v[2], v[3]);
    });
  }
  (void)l;
}

__device__ __forceinline__ void stage_g9(const Params& p, const Grp& g, int l, int bid, int nb, char* smem) {
  char* ws = p.ws;
  float* X = p.out + (size_t)g.m0 * 1024;
  const float* modp = (const float*)(ws + O_MOD) + (size_t)l * 3 * 3072 + 2048;
  const int TM = (g.mg + 127) / 128, mg = g.mg, NT = TM * 8;
  auto desc = [&](int t) { int tn = t / TM, tm = t % TM; return mk_gt((const bf16_t*)(ws + O_MERGED), 1024, tm * 128, mg, (const bf16_t*)(ws + O_WOUTT), 1024, tn * 128, 1024, 1024); };
  for (int t = bid; t < NT; t += nb) {
    int tn = t / TM, tm = t % TM;
    f4v acc[2][4]; zero_acc<4>(acc);
    GT cur = desc(t);
    gemm_deep<4>(cur, smem, acc);
    epi_foreach<4>(acc, tm * 128, tn * 128, [&](int row, int c0, f4v& v) {
      if (row < mg) { const float* gt = modp + (size_t)mod_index(g, row) * 3072 + c0; f4v* xp = (f4v*)(X + (size_t)row * 1024 + c0); f4v x = *xp;
        x[0] += gt[0] * v[0]; x[1] += gt[1] * v[1]; x[2] += gt[2] * v[2]; x[3] += gt[3] * v[3]; *xp = x; }
    });
  }
}

__device__ __forceinline__ void stage_final(const Params& p, int bid, int nb) {
  const int lane = my_tid() & 63, wid = my_tid() >> 6;
  for (int m = bid * NWAVE + wid; m < M; m += nb * NWAVE) {
    float* xr = p.out + (size_t)m * 1024; float4 q[4]; float ss = 0.f;
#pragma unroll
    for (int i = 0; i < 4; ++i) { q[i] = *(const float4*)(xr + i * 256 + lane * 4); ss += q[i].x * q[i].x + q[i].y * q[i].y + q[i].z * q[i].z + q[i].w * q[i].w; }
    ss = wave_sum(ss); float rs = rsqrtf(ss * (1.f / 1024.f) + 1e-6f);
#pragma unroll
    for (int i = 0; i < 4; ++i) { int c = i * 256 + lane * 4; float4 gm = *(const float4*)(p.final_g + c);
      *(float4*)(xr + c) = make_float4(q[i].x * rs * gm.x, q[i].y * rs * gm.y, q[i].z * rs * gm.z, q[i].w * rs * gm.w); }
  }
}

#ifdef EMU
#define DECL_SMEM(name) char* name = emu::smem()
#else
#define DECL_SMEM(name) __shared__ __attribute__((aligned(16))) char name[SMEM_BYTES]
#endif

#ifdef EMU
struct GridBar { __device__ void sync() const { emu::grid_sync(); } };
#else
#define XB_TMO      128
#define XB_XCNT(j)  (256  + 64 * (j))
#define XB_XSUB(j)  (1280 + 64 * (j))
#define XB_XGEN(j)  (2304 + 64 * (j))
#define XB_TOP      3328
#define XB_TOPGEN   3392
#define XB_SPIN_CAP (1u << 20)
#define LAS __attribute__((address_space(3)))
__device__ __forceinline__ unsigned xb_ld(unsigned* p)              { return __hip_atomic_load(p, __ATOMIC_RELAXED, __HIP_MEMORY_SCOPE_AGENT); }
__device__ __forceinline__ unsigned xb_add(unsigned* p, unsigned v) { return __hip_atomic_fetch_add(p, v, __ATOMIC_RELAXED, __HIP_MEMORY_SCOPE_AGENT); }
__device__ __forceinline__ unsigned xb_xcc_id() { return (unsigned)__builtin_amdgcn_s_getreg((3 << 11) | 20) & 0xFu; }
#define XB_SPIN(cond, bar) do { unsigned _sp = 0; while (cond) { __builtin_amdgcn_s_sleep(1); \
    if ((++_sp & 255u) == 0u) { if (xb_ld(&(bar)[XB_TMO])) break; if (_sp > XB_SPIN_CAP) { atomicAdd(&(bar)[XB_TMO], 1u); break; } } } } while (0)
struct GridBar {
  unsigned* bar; unsigned x; volatile LAS unsigned* st;
  __device__ __forceinline__ void post(unsigned* b, volatile LAS unsigned* s_) {
    bar = b; x = xb_xcc_id(); st = s_;
    if (threadIdx.x == 0) (void)xb_add(&bar[XB_XCNT(x)], 1u);
  }
  __device__ __forceinline__ void complete(unsigned& nloc, unsigned& nx) const {
    const unsigned G = gridDim.x;
    unsigned sum, cnt, mine, sp = 0u;
    for (;;) {
      sum = 0u; cnt = 0u; mine = 0u;
#pragma unroll
      for (unsigned j = 0; j < 16; ++j) { const unsigned c = xb_ld(&bar[XB_XCNT(j)]); sum += c; cnt += (c > 0u) ? 1u : 0u; mine = (j == x) ? c : mine; }
      if (sum == G) break;
      __builtin_amdgcn_s_sleep(1);
      if ((++sp & 255u) == 0u) { if (xb_ld(&bar[XB_TMO])) break; if (sp > XB_SPIN_CAP) { atomicAdd(&bar[XB_TMO], 1u); break; } }
    }
    nloc = mine > 0u ? mine : 1u; nx = cnt > 0u ? cnt : 1u;
  }
  __device__ __forceinline__ void sync() const {
    asm volatile("s_waitcnt vmcnt(0)" ::: "memory");
    __syncthreads();
    if (threadIdx.x == 0) {
      __builtin_amdgcn_s_waitcnt(0);
      unsigned nloc = st[0], nx = st[1];
      if (nloc == 0u) { complete(nloc, nx); st[0] = nloc; st[1] = nx; }
      const unsigned old = xb_add(&bar[XB_XSUB(x)], 1u);
      const unsigned gen = old / nloc;
      if (old + 1u == (gen + 1u) * nloc) {
        __builtin_amdgcn_fence(__ATOMIC_RELEASE, "agent");
        asm volatile("s_waitcnt vmcnt(0)" ::: "memory");
        const unsigned og = xb_add(&bar[XB_TOP], 1u);
        const unsigned tg = og / nx;
        if (og + 1u == (tg + 1u) * nx) xb_add(&bar[XB_TOPGEN], 1u);
        else XB_SPIN(xb_ld(&bar[XB_TOPGEN]) == tg, bar);
        __builtin_amdgcn_fence(__ATOMIC_ACQUIRE, "agent");
        xb_add(&bar[XB_XGEN(x)], 1u);
        asm volatile("s_waitcnt vmcnt(0)" ::: "memory");
      } else {
        XB_SPIN(xb_ld(&bar[XB_XGEN(x)]) == gen, bar);
        __builtin_amdgcn_fence(__ATOMIC_ACQUIRE, "agent");
        asm volatile("s_waitcnt vmcnt(0)" ::: "memory");
      }
    }
    __syncthreads();
  }
};
#endif

#ifndef EMU
namespace cg = cooperative_groups;
#else
namespace cg = cooperative_groups;
#endif

__global__ void __launch_bounds__(NTHR) mega_kernel(Params p) {
  DECL_SMEM(smem);
  cg::grid_group grid = cg::this_grid();
  const int bid0 = blockIdx.x, nb0 = gridDim.x;
  GridBar gb;
#ifndef EMU
  if (threadIdx.x == 0) { volatile LAS unsigned* w = (volatile LAS unsigned*)(smem + SMEM_STAGE); w[0] = 0u; w[1] = 0u; w[2] = 0u; w[3] = 0u; }
  __syncthreads();
  gb.post((unsigned*)(p.ws + O_BAR), (volatile LAS unsigned*)(smem + SMEM_STAGE));
#endif
#ifndef PROBE_DUP
#define PROBE_DUP 0
#endif
#define STG(gi_, call) do { Params q = p; q.ws = opaque(q.ws); q.out = opaque(q.out); const int bid = opaque_i(bid0); const int nb = opaque_i(nb0); const Grp g = get_grp(opaque_i(gi_)); (void)g; call; } while (0)
#define STP(bit, gi_, call) do { STG(gi_, call); if (PROBE_DUP & (bit)) { STG(gi_, call); } } while (0)
  for (int l = 0; l < NL; ++l) {
    STP(1, 0, stage_prep(q, l, bid, nb, smem));
    if (l == 0) grid.sync();
    STP(2, 0, stage_h(q, g, l, bid, nb));
    gb.sync();
    for (int gi = 0; gi < NGRP; ++gi) {
      STP(4, gi, stage_g1(q, g, 0, bid, nb, smem)); gb.sync();
      STP(4, gi, stage_g1(q, g, 1, bid, nb, smem));
      STP(8, gi, stage_e1(q, g, l, bid, nb)); gb.sync();
      STP(16, gi, stage_g2(q, g, l, bid, nb, smem)); gb.sync();
      STP(64, gi, stage_mixA(q, g, bid, nb, smem)); gb.sync();
      STP(32, gi, stage_scanS(q, g, l, bid, nb, smem));
      STP(128, gi, stage_dft2(q, g, bid, nb, smem)); gb.sync();
      STP(256, gi, stage_e3(q, g, l, bid, nb));
      STP(512, gi, stage_gates(q, g, l, bid, nb, smem)); gb.sync();
      STP(1024, gi, stage_g8(q, g, l, bid, nb, smem)); gb.sync();
      STG(gi, stage_g9(q, g, l, bid, nb, smem));
      if (gi + 1 < NGRP) { STP(2, gi + 1, stage_h(q, g, l, bid, nb)); }
      gb.sync();
    }
  }
  STG(0, stage_final(q, bid, nb));
#undef STP
#undef STG
}

extern "C" void kernel_launch(void* const* d_in, const int* in_sizes, int n_in, void* d_out, int out_size, void* d_ws, size_t ws_size,
                              hipStream_t stream) {
  Params p{};
  const float** pp = (const float**)&p;
  for (int i = 0; i < 35; ++i) pp[i] = (const float*)d_in[i];
  p.out = (float*)d_out; p.ws = (char*)d_ws;
#ifdef EMU
  emu::set_coop(true);
  emu_launch(dim3(8), dim3(NTHR), [=]() { mega_kernel(p); });
  emu::set_coop(false);
#else
  static int grid_blocks = 0;
  if (!grid_blocks) {
    int dev = 0, cus = 0, per_cu = 0;
    (void)hipGetDevice(&dev);
    (void)hipDeviceGetAttribute(&cus, hipDeviceAttributeMultiprocessorCount, dev);
    (void)hipOccupancyMaxActiveBlocksPerMultiprocessor(&per_cu, mega_kernel, NTHR, 0);
    if (per_cu > 1) per_cu = 1;
    if (per_cu < 1) per_cu = 1;
    grid_blocks = cus * per_cu;
  }
  (void)hipMemsetAsync((char*)d_ws + O_BAR, 0, BAR_BYTES, stream);
  void* args[] = {&p};
  (void)hipLaunchCooperativeKernel((void*)mega_kernel, dim3(grid_blocks), dim3(NTHR), args, 0, stream);
#endif
  (void)in_sizes; (void)n_in; (void)out_size; (void)ws_size;
}
```

```cpp
#ifdef EMU
#include "hip_emu.h"
#else
#include <hip/hip_runtime.h>
#include <hip/hip_cooperative_groups.h>
#endif
#include <stdint.h>

#ifndef CFG_BATCH
#define CFG_BATCH 32
#define CFG_SEQ 256
#define CFG_DEC_BATCH 2
#define CFG_DEC_SEQ 2048
#define CFG_PAST 512
#define CFG_NGRP_C 2
#endif
constexpr int D = 1024, NL = 2;
constexpr int NB_C = CFG_BATCH, T_C = CFG_SEQ, NB_D = CFG_DEC_BATCH, T_D = CFG_DEC_SEQ, PAST = CFG_PAST;
constexpr int M_C = NB_C * T_C, M_D = NB_D * T_D, M = M_C + M_D;
constexpr int NGRP_C = CFG_NGRP_C, NGRP = 1 + NGRP_C;
constexpr int MGC = M_C / NGRP_C, SEQ_PER_CG = NB_C / NGRP_C;
constexpr int MG = MGC > M_D ? MGC : M_D;
constexpr int MKV = MG + NB_D * PAST;
constexpr int KEYS_D = T_D + PAST;
constexpr int IN_W = 5728;
constexpr int ZC_R = 0, ZC_K = 512, ZC_V = 1024, ZC_WDF = 1536, ZC_QD = 1728, ZC_KVD = 1984, ZC_KR = 2112, ZC_VC = 2144, ZC_U = 2656, ZC_GC = 3168,
              ZC_GA = 3680, ZC_GB = 4192, ZC_F = 4704, ZC_GD = 5216;
constexpr int Z1_W = 3680, Z1_WP = 3840, Z2_W = 2048;
constexpr int SHIFT_W = 1728;
static_assert(M_C % NGRP_C == 0 && NB_C % NGRP_C == 0, "ctx groups");
static_assert(T_C % 128 == 0 && T_D % 128 == 0 && PAST % 32 == 0, "seq multiples");

typedef unsigned short bf16_t;
typedef short s8v __attribute__((ext_vector_type(8)));
typedef float f4v __attribute__((ext_vector_type(4)));
typedef float f16v __attribute__((ext_vector_type(16)));
typedef unsigned u4v __attribute__((ext_vector_type(4)));
typedef unsigned u2v __attribute__((ext_vector_type(2)));

struct Params {
  const float *x_prompt, *x_sample, *st_f, *st_b, *c_ckv, *c_kr, *c, *c_ctx, *norm_g, *w_ada, *b_ada, *w_in, *shift_mu, *w0, *w_up,
      *a0, *a_up, *k_k, *k_a, *r_k, *ln_g, *ln_b, *q_norm, *w_q_up, *kv_norm, *w_kv_up, *g_ln_g, *g_ln_b, *g_w_s, *g_b_s, *w_branch,
      *w_merge, *b_merge, *w_out, *final_g;
  float* out;
  char* ws;
};

struct Grp { int isden, m0, mg, nseq, T, b0, nkeys, mkv; };
__host__ __device__ __forceinline__ Grp get_grp(int gi) {
  Grp g;
  if (gi == 0) { g.isden = 1; g.m0 = M_C; g.mg = M_D; g.nseq = NB_D; g.T = T_D; g.b0 = 0; g.nkeys = KEYS_D; g.mkv = M_D + NB_D * PAST; }
  else { g.isden = 0; g.m0 = (gi - 1) * MGC; g.mg = MGC; g.nseq = SEQ_PER_CG; g.T = T_C; g.b0 = (gi - 1) * SEQ_PER_CG; g.nkeys = T_C; g.mkv = MGC; }
  return g;
}

constexpr size_t al256(size_t x) { return (x + 255) & ~(size_t)255; }
constexpr size_t O_WINT = 0;
constexpr int IN_WP = Z1_WP + Z2_W;
constexpr size_t O_WMT = O_WINT + al256((size_t)IN_WP * 1024 * 2);
constexpr size_t O_WBRT = O_WMT + al256((size_t)4096 * 1024 * 2);
constexpr size_t O_WOUTT = O_WBRT + al256((size_t)4 * 1024 * 512 * 2);
constexpr size_t O_WQT = O_WOUTT + al256((size_t)1024 * 1024 * 2);
constexpr size_t O_WKVT = O_WQT + al256((size_t)768 * 256 * 2);
constexpr size_t O_WUPT = O_WKVT + al256((size_t)1024 * 128 * 2);
constexpr size_t O_WS = O_WUPT + al256((size_t)4 * 512 * 64 * 2);
constexpr size_t O_CS128 = O_WS + al256((size_t)4 * 128 * 128 * 2);
constexpr size_t O_A2C = O_CS128 + al256((size_t)256 * 128 * 2);
constexpr size_t O_A2D = O_A2C + al256((size_t)T_C * 2 * T_C * 2);
constexpr size_t O_ROPE = O_A2D + al256((size_t)T_D * 2 * T_D * 2);
constexpr size_t O_MOD = O_ROPE + al256((size_t)T_D * 32 * 4);
constexpr size_t O_H = O_MOD + al256((size_t)NL * 3 * 3072 * 4);
constexpr size_t O_Z = O_H + al256((size_t)MG * 1024 * 2);
constexpr size_t O_SK = O_Z + al256((size_t)MG * IN_W * 2);
constexpr size_t O_SOP = O_SK + al256((size_t)MG * 512 * 2);
constexpr size_t O_YS = O_SOP + al256((size_t)MG * 8 * 576 * 2);
constexpr size_t O_BON = O_YS + al256((size_t)2 * MG * 512 * 4);
constexpr size_t O_LORA = O_BON + al256((size_t)MG * 16 * 4);
constexpr int CM_GT = 0, CM_BKT = 5120, CM_WL = 9216, CM_VT = 9472, CM_REC = 11520;
constexpr size_t CM_BYTES = (size_t)MG * CM_REC;
constexpr size_t O_CM = O_LORA + al256((size_t)MG * 192 * 2);
constexpr size_t O_PRE = O_CM + al256(CM_BYTES - (size_t)MG * 2048 * 2);
constexpr size_t O_QDN = O_PRE + al256((size_t)MG * 2048 * 2);
constexpr size_t O_CKV = O_QDN + al256((size_t)MG * 256 * 2);
constexpr size_t O_KR = O_CKV + al256((size_t)MKV * 128 * 2);
constexpr size_t O_Q = O_KR + al256((size_t)MKV * 32 * 2);
constexpr size_t O_KN = O_Q + al256((size_t)MG * 768 * 2);
constexpr size_t O_VT = O_KN + al256((size_t)MKV * 512 * 2);
constexpr size_t O_VCNT = O_VT + al256((size_t)MKV * 512 * 2);
constexpr size_t O_YT = O_VCNT + al256((size_t)MG * 512 * 2);
constexpr size_t O_OBR = O_YT + al256((size_t)MG * 1024 * 2);
constexpr size_t O_MERGED = O_OBR + al256((size_t)4 * MG * 512 * 2);
constexpr size_t O_END = O_MERGED + al256((size_t)MG * 1024 * 2);
constexpr size_t O_GATES = O_PRE;
static_assert(O_GATES + (size_t)MG * 4096 * 2 <= O_VCNT, "gates alias region too small");
static_assert(O_CM + CM_BYTES <= O_QDN, "chunk-matrix region must end before QDN");
constexpr size_t O_BAR = O_END;
constexpr size_t BAR_BYTES = 3456 * 4;
static_assert(O_BAR + BAR_BYTES <= ((size_t)256 << 20), "workspace must fit 256 MiB");

constexpr size_t OUT_SF = (size_t)M * D, OUT_SB = OUT_SF + (size_t)NB_C * NL * 8 * 64 * 64,
                 OUT_CKV = OUT_SB + (size_t)NB_C * NL * 8 * 64 * 64, OUT_KR = OUT_CKV + (size_t)NB_C * NL * T_C * 128;

#ifdef EMU
template <class T> __device__ __forceinline__ T* opaque(T* p) { return p; }
__device__ __forceinline__ int opaque_i(int v) { return v; }
#else
template <class T> __device__ __forceinline__ T* opaque(T* p) {
  typedef __attribute__((address_space(1))) T* gptr;
  gptr g = (gptr)p; asm volatile("" : "+s"(g)); return (T*)g;
}
__device__ __forceinline__ int opaque_i(int v) { asm volatile("" : "+s"(v)); return v; }
#endif
#ifdef EMU
#define SCHED_FENCE() do {} while (0)
#else
#define SCHED_FENCE() do { asm volatile("" ::: "memory"); __builtin_amdgcn_sched_barrier(0); } while (0)
#endif
__device__ __forceinline__ int my_tid() {
#ifdef EMU
  return (int)threadIdx.x;
#else
  int t = (int)threadIdx.x; asm volatile("" : "+v"(t)); return t;
#endif
}
__device__ __forceinline__ unsigned f_as_u(float f) { return __builtin_bit_cast(unsigned, f); }
__device__ __forceinline__ float u_as_f(unsigned u) { return __builtin_bit_cast(float, u); }
#ifdef EMU
__device__ __forceinline__ bf16_t f2bf(float f) { unsigned u = f_as_u(f); u += 0x7FFFu + ((u >> 16) & 1u); return (bf16_t)(u >> 16); }
__device__ __forceinline__ unsigned pk2bf(float lo, float hi) { return (unsigned)f2bf(lo) | ((unsigned)f2bf(hi) << 16); }
#else
typedef __bf16 bf2v_t __attribute__((ext_vector_type(2)));
typedef float f2c_t __attribute__((ext_vector_type(2)));
__device__ __forceinline__ bf16_t f2bf(float f) { return __builtin_bit_cast(unsigned short, (__bf16)f); }
__device__ __forceinline__ unsigned pk2bf(float lo, float hi) { return __builtin_bit_cast(unsigned, __builtin_convertvector(f2c_t{lo, hi}, bf2v_t)); }
#endif
__device__ __forceinline__ float bf2f(bf16_t h) { return u_as_f(((unsigned)h) << 16); }
__device__ __forceinline__ float bflo(unsigned u) { return u_as_f(u << 16); }
__device__ __forceinline__ float bfhi(unsigned u) { return u_as_f(u & 0xFFFF0000u); }
#ifdef EMU
__device__ __forceinline__ float fexp_(float x) { return expf(x); }
__device__ __forceinline__ float frcp_(float x) { return 1.f / x; }
#else
__device__ __forceinline__ float fexp_(float x) { return __builtin_amdgcn_exp2f(x * 1.4426950408889634f); }
__device__ __forceinline__ float frcp_(float x) { return __builtin_amdgcn_rcpf(x); }
#endif
#ifdef EMU
__device__ __forceinline__ float fexp2_(float x) { return exp2f(x); }
#else
__device__ __forceinline__ float fexp2_(float x) { return __builtin_amdgcn_exp2f(x); }
#endif
__device__ __forceinline__ float sigmoidf_(float x) { return frcp_(1.f + fexp_(-x)); }
__device__ __forceinline__ float siluf_(float x) { return x * frcp_(1.f + fexp_(-x)); }
__device__ __forceinline__ float tanhf_(float x) { return 1.f - 2.f * frcp_(1.f + fexp_(2.f * x)); }
__device__ __forceinline__ float geluf_(float x) { return 0.5f * x * (1.f + tanhf_(0.7978845608028654f * (x + 0.044715f * x * x * x))); }
#ifdef EMU
__device__ __forceinline__ float wave_sum(float v) {
#pragma unroll
  for (int o = 32; o >= 1; o >>= 1) v += __shfl_xor(v, o);
  return v;
}
#else
__device__ __forceinline__ float wave_sum(float v) {
  v += u_as_f(__builtin_amdgcn_update_dpp(0, (int)f_as_u(v), 0xB1, 0xF, 0xF, true));
  v += u_as_f(__builtin_amdgcn_update_dpp(0, (int)f_as_u(v), 0x4E, 0xF, 0xF, true));
  v += u_as_f(__builtin_amdgcn_update_dpp(0, (int)f_as_u(v), 0x141, 0xF, 0xF, true));
  v += u_as_f(__builtin_amdgcn_update_dpp(0, (int)f_as_u(v), 0x140, 0xF, 0xF, true));
  { auto r = __builtin_amdgcn_permlane16_swap(f_as_u(v), f_as_u(v), false, false); v = u_as_f(r[0]) + u_as_f(r[1]); }
  { auto r = __builtin_amdgcn_permlane32_swap(f_as_u(v), f_as_u(v), false, false); v = u_as_f(r[0]) + u_as_f(r[1]); }
  return v;
}
#endif

#ifdef EMU
#define WAVE_SYNC() emu::wave_barrier()
__device__ __forceinline__ float sum16(float v) { v += __shfl_xor(v, 1); v += __shfl_xor(v, 2); v += __shfl_xor(v, 4); v += __shfl_xor(v, 8); return v; }
#else
#define WAVE_SYNC() __builtin_amdgcn_wave_barrier()
__device__ __forceinline__ float sum16(float v) {
  v += u_as_f(__builtin_amdgcn_update_dpp(0, (int)f_as_u(v), 0xB1, 0xF, 0xF, true));
  v += u_as_f(__builtin_amdgcn_update_dpp(0, (int)f_as_u(v), 0x4E, 0xF, 0xF, true));
  v += u_as_f(__builtin_amdgcn_update_dpp(0, (int)f_as_u(v), 0x141, 0xF, 0xF, true));
  v += u_as_f(__builtin_amdgcn_update_dpp(0, (int)f_as_u(v), 0x140, 0xF, 0xF, true));
  return v;
}
#endif

template <int LPR> __device__ __forceinline__ float sum_lpr(float v) {
#ifdef EMU
  v += __shfl_xor(v, 1); v += __shfl_xor(v, 2); v += __shfl_xor(v, 4);
  if (LPR >= 16) v += __shfl_xor(v, 8);
  if (LPR >= 32) v += __shfl_xor(v, 16);
  return v;
#else
  v += u_as_f(__builtin_amdgcn_update_dpp(0, (int)f_as_u(v), 0xB1, 0xF, 0xF, true));
  v += u_as_f(__builtin_amdgcn_update_dpp(0, (int)f_as_u(v), 0x4E, 0xF, 0xF, true));
  v += u_as_f(__builtin_amdgcn_update_dpp(0, (int)f_as_u(v), 0x141, 0xF, 0xF, true));
  if (LPR >= 16) v += u_as_f(__builtin_amdgcn_update_dpp(0, (int)f_as_u(v), 0x140, 0xF, 0xF, true));
  if (LPR >= 32) { auto r = __builtin_amdgcn_permlane16_swap(f_as_u(v), f_as_u(v), false, false); v = u_as_f(r[0]) + u_as_f(r[1]); }
  return v;
#endif
}

template <int LPR> __device__ __forceinline__ void sum_lpr2(float& a, float& b) {
#ifdef EMU
  a = sum_lpr<LPR>(a); b = sum_lpr<LPR>(b);
#else
#define DPP_ADD2(ctrl) { float ta = u_as_f(__builtin_amdgcn_update_dpp(0, (int)f_as_u(a), ctrl, 0xF, 0xF, true)); float tb = u_as_f(__builtin_amdgcn_update_dpp(0, (int)f_as_u(b), ctrl, 0xF, 0xF, true)); a += ta; b += tb; }
  DPP_ADD2(0xB1) DPP_ADD2(0x4E) DPP_ADD2(0x141)
  if (LPR >= 16) DPP_ADD2(0x140)
  if (LPR >= 32) { auto ra = __builtin_amdgcn_permlane16_swap(f_as_u(a), f_as_u(a), false, false); auto rb = __builtin_amdgcn_permlane16_swap(f_as_u(b), f_as_u(b), false, false);
    a = u_as_f(ra[0]) + u_as_f(ra[1]); b = u_as_f(rb[0]) + u_as_f(rb[1]); }
#undef DPP_ADD2
#endif
}

constexpr int NTHR = 512, NWAVE = 8;
constexpr int LDS_STR = 72;
constexpr int SMEM_STAGE = 131072;
constexpr int SMEM_BYTES = SMEM_STAGE + 16;

template <int NJ>
__device__ __forceinline__ void zero_acc(f4v (&acc)[2][NJ]) {
#pragma unroll
  for (int i = 0; i < 2; ++i)
#pragma unroll
    for (int j = 0; j < NJ; ++j) acc[i][j] = f4v{0.f, 0.f, 0.f, 0.f};
}

struct GT { const bf16_t* A; long lda; int arow0, arows; const bf16_t* B; long ldb; int brow0, brows; int K; int bt; };
__device__ __forceinline__ GT mk_gt(const bf16_t* A, long lda, int arow0, int arows, const bf16_t* B, long ldb, int brow0, int brows, int K, int bt = 0) {
  GT t; t.A = A; t.lda = lda; t.arow0 = arow0; t.arows = arows; t.B = B; t.ldb = ldb; t.brow0 = brow0; t.brows = brows; t.K = K; t.bt = bt; return t;
}
template <int NJ>
__device__ __forceinline__ void gemm_ptrs(const GT& t, int tid, const bf16_t* (&ap)[2], const bf16_t* (&bp)[NJ / 2]) {
#pragma unroll
  for (int i = 0; i < 2; ++i) { int c = tid + NTHR * i, r = c >> 3, cc = c & 7; int ar = t.arow0 + r; ar = ar < t.arows ? ar : t.arows - 1; ap[i] = t.A + (long)ar * t.lda + cc * 8; }
#pragma unroll
  for (int i = 0; i < NJ / 2; ++i) { int c = tid + NTHR * i;
    if (t.bt) { int q = c & 63, dc = c >> 6; bp[i] = t.B + (long)q * t.ldb + t.brow0 + dc * 8; }
    else { int r = c >> 3, cc = c & 7; int br = t.brow0 + r; br = br < t.brows ? br : t.brows - 1; bp[i] = t.B + (long)br * t.ldb + cc * 8; } }
}
template <int NJ>
__device__ __forceinline__ void gemm_prefetch(const GT& t, u4v (&ra)[2], u4v (&rb)[NJ / 2]) {
  const bf16_t* ap[2]; const bf16_t* bp[NJ / 2];
  gemm_ptrs<NJ>(t, my_tid(), ap, bp);
#pragma unroll
  for (int i = 0; i < 2; ++i) ra[i] = *(const u4v*)(ap[i]);
#pragma unroll
  for (int i = 0; i < NJ / 2; ++i) rb[i] = *(const u4v*)(bp[i]);
}
template <int NJ, bool BT>
__device__ __forceinline__ void gemm_run(const GT& t, const GT* nxt, u4v (&ra)[2], u4v (&rb)[NJ / 2], char* smem, f4v (&acc)[2][NJ]) {
  constexpr int NBL = NJ / 2;
  constexpr int BUF = (128 + 128) * LDS_STR;
  bf16_t* s0 = (bf16_t*)smem;
  const int tid = my_tid(), lane = tid & 63, wid = tid >> 6, wm = wid >> 1, wn = wid & 1;
  const bf16_t* ap[2]; const bf16_t* bp[NBL];
  gemm_ptrs<NJ>(t, tid, ap, bp);
  const long ldb = t.ldb;
  __syncthreads();
#pragma unroll
  for (int i = 0; i < 2; ++i) { int c = tid + NTHR * i, r = c >> 3, cc = c & 7; *(u4v*)(s0 + r * LDS_STR + cc * 8) = ra[i]; }
#pragma unroll
  for (int i = 0; i < NBL; ++i) { int c = tid + NTHR * i;
    if (BT) { int q = c & 63, dc = c >> 6;
#pragma unroll
      for (int e = 0; e < 8; ++e) s0[(128 + dc * 8 + e) * LDS_STR + q] = (bf16_t)(rb[i][e >> 1] >> ((e & 1) * 16)); }
    else { int r = c >> 3, cc = c & 7; *(u4v*)(s0 + (128 + r) * LDS_STR + cc * 8) = rb[i]; } }
  __syncthreads();
  const int nk = t.K >> 6;
  for (int kt = 0; kt < nk; ++kt) {
    const bool more = kt + 1 < nk;
    if (more) {
#pragma unroll
      for (int i = 0; i < 2; ++i) ra[i] = *(const u4v*)(ap[i] + (kt + 1) * 64);
#pragma unroll
      for (int i = 0; i < NBL; ++i) rb[i] = *(const u4v*)(bp[i] + (BT ? (long)(kt + 1) * 64 * ldb : (long)(kt + 1) * 64));
    } else if (nxt) gemm_prefetch<NJ>(*nxt, ra, rb);
    SCHED_FENCE();
    const bf16_t* sA = s0 + (kt & 1) * BUF; const bf16_t* sB = sA + 128 * LDS_STR;
#pragma unroll
    for (int ks = 0; ks < 2; ++ks) {
      s8v af[2], bf[NJ];
#pragma unroll
      for (int i = 0; i < 2; ++i) af[i] = *(const s8v*)(sA + (wm * 32 + i * 16 + (lane & 15)) * LDS_STR + ks * 32 + (lane >> 4) * 8);
#pragma unroll
      for (int j = 0; j < NJ; ++j) bf[j] = *(const s8v*)(sB + (wn * NJ * 16 + j * 16 + (lane & 15)) * LDS_STR + ks * 32 + (lane >> 4) * 8);
#pragma unroll
      for (int i = 0; i < 2; ++i)
#pragma unroll
        for (int j = 0; j < NJ; ++j) acc[i][j] = __builtin_amdgcn_mfma_f32_16x16x32_bf16(bf[j], af[i], acc[i][j], 0, 0, 0);
    }
    if (more) {
      bf16_t* dA = s0 + ((kt + 1) & 1) * BUF;
#pragma unroll
      for (int i = 0; i < 2; ++i) { int c = tid + NTHR * i, r = c >> 3, cc = c & 7; *(u4v*)(dA + r * LDS_STR + cc * 8) = ra[i]; }
#pragma unroll
      for (int i = 0; i < NBL; ++i) { int c = tid + NTHR * i;
        if (BT) { int q = c & 63, dc = c >> 6;
#pragma unroll
          for (int e = 0; e < 8; ++e) dA[(128 + dc * 8 + e) * LDS_STR + q] = (bf16_t)(rb[i][e >> 1] >> ((e & 1) * 16)); }
        else { int r = c >> 3, cc = c & 7; *(u4v*)(dA + (128 + r) * LDS_STR + cc * 8) = rb[i]; } }
      __syncthreads();
    }
  }
}
template <int NJ>
__device__ __forceinline__ void gemm_deep(const GT& t, char* smem, f4v (&acc)[2][NJ]) {
  constexpr int NBL = NJ / 2;
  constexpr int BUF = (128 + 128) * LDS_STR;
  bf16_t* s0 = (bf16_t*)smem;
  const int tid = my_tid(), lane = tid & 63, wid = tid >> 6, wm = wid >> 1, wn = wid & 1;
  const bf16_t* ap[2]; const bf16_t* bp[NBL];
  gemm_ptrs<NJ>(t, tid, ap, bp);
  const int nk = t.K >> 6;
  u4v pa0[2], pb0[NBL], pa1[2], pb1[NBL];
#define GD_LOAD(PA, PB, kt_) do { const int kq = (kt_) < nk ? (kt_) : nk - 1; \
    _Pragma("unroll") for (int i = 0; i < 2; ++i) PA[i] = *(const u4v*)(ap[i] + kq * 64); \
    _Pragma("unroll") for (int i = 0; i < NBL; ++i) PB[i] = *(const u4v*)(bp[i] + kq * 64); } while (0)
#define GD_STORE(PA, PB, buf_) do { bf16_t* dA = s0 + (buf_) * BUF; \
    _Pragma("unroll") for (int i = 0; i < 2; ++i) { int c = tid + NTHR * i, r = c >> 3, cc = c & 7; *(u4v*)(dA + r * LDS_STR + cc * 8) = PA[i]; } \
    _Pragma("unroll") for (int i = 0; i < NBL; ++i) { int c = tid + NTHR * i, r = c >> 3, cc = c & 7; *(u4v*)(dA + (128 + r) * LDS_STR + cc * 8) = PB[i]; } } while (0)
#define GD_COMPUTE(buf_) do { const bf16_t* sA = s0 + (buf_) * BUF; const bf16_t* sB = sA + 128 * LDS_STR; \
    _Pragma("unroll") for (int ks = 0; ks < 2; ++ks) { s8v af[2], bf[NJ]; \
      _Pragma("unroll") for (int i = 0; i < 2; ++i) af[i] = *(const s8v*)(sA + (wm * 32 + i * 16 + (lane & 15)) * LDS_STR + ks * 32 + (lane >> 4) * 8); \
      _Pragma("unroll") for (int j = 0; j < NJ; ++j) bf[j] = *(const s8v*)(sB + (wn * NJ * 16 + j * 16 + (lane & 15)) * LDS_STR + ks * 32 + (lane >> 4) * 8); \
      _Pragma("unroll") for (int i = 0; i < 2; ++i) _Pragma("unroll") for (int j = 0; j < NJ; ++j) acc[i][j] = __builtin_amdgcn_mfma_f32_16x16x32_bf16(bf[j], af[i], acc[i][j], 0, 0, 0); } } while (0)
  GD_LOAD(pa0, pb0, 0); SCHED_FENCE();
  GD_LOAD(pa1, pb1, 1); SCHED_FENCE();
  __syncthreads();
  GD_STORE(pa0, pb0, 0);
  __syncthreads();
  for (int kt = 0; kt < nk; kt += 2) {
    GD_LOAD(pa0, pb0, kt + 2); SCHED_FENCE();
    GD_COMPUTE(0);
    if (kt + 1 < nk) { GD_STORE(pa1, pb1, 1); }
    __syncthreads();
    if (kt + 1 >= nk) break;
    GD_LOAD(pa1, pb1, kt + 3); SCHED_FENCE();
    GD_COMPUTE(1);
    if (kt + 2 < nk) { GD_STORE(pa0, pb0, 0); }
    __syncthreads();
  }
#undef GD_LOAD
#undef GD_STORE
#undef GD_COMPUTE
}

template <int NJ, bool BT = false>
__device__ __forceinline__ void gemm_mainloop(const bf16_t* __restrict__ A, long lda, int arow0, int arows, const bf16_t* __restrict__ B,
                                              long ldb, int brow0, int brows, int K, char* smem, f4v (&acc)[2][NJ]) {
  GT t = mk_gt(A, lda, arow0, arows, B, ldb, brow0, brows, K, BT ? 1 : 0);
  u4v ra[2], rb[NJ / 2];
  gemm_prefetch<NJ>(t, ra, rb);
  gemm_run<NJ, BT>(t, nullptr, ra, rb, smem, acc);
}

template <int NJ, class F>
__device__ __forceinline__ void epi_foreach(f4v (&acc)[2][NJ], int row0, int col0, F f) {
  const int tid = my_tid(), lane = tid & 63, wid = tid >> 6, wm = wid >> 1, wn = wid & 1;
#pragma unroll
  for (int i = 0; i < 2; ++i)
#pragma unroll
    for (int j = 0; j < NJ; ++j) f(row0 + wm * 32 + i * 16 + (lane & 15), col0 + wn * NJ * 16 + j * 16 + (lane >> 4) * 4, acc[i][j]);
}
__device__ __forceinline__ u4v pack8(const float (&x)[8]) {
  return u4v{pk2bf(x[0], x[1]), pk2bf(x[2], x[3]), pk2bf(x[4], x[5]), pk2bf(x[6], x[7])};
}
__device__ __forceinline__ void unpack8(u4v u, float (&x)[8]) {
  x[0] = bflo(u.x); x[1] = bfhi(u.x); x[2] = bflo(u.y); x[3] = bfhi(u.y); x[4] = bflo(u.z); x[5] = bfhi(u.z); x[6] = bflo(u.w); x[7] = bfhi(u.w);
}
__device__ __forceinline__ u2v pack4(float a, float b, float c, float d) {
  return u2v{pk2bf(a, b), pk2bf(c, d)};
}

#ifndef EMU
namespace pg8 {
#define PG8_LAS __attribute__((address_space(3)))
typedef unsigned short bf16_t;
typedef short bf16x8 __attribute__((ext_vector_type(8)));
typedef float f32x4 __attribute__((ext_vector_type(4)));
typedef unsigned u32x4 __attribute__((ext_vector_type(4)));
constexpr int BM = 256, BK = 64, HALF = 128, HTB = HALF * BK * 2  , STAGE_BYTES = 8 * HTB, NXCD = 8, WGM = 8;

__host__ __device__ __forceinline__ int lds_byte(int r, int c) { const int st = (r >> 4) * 2 + (c >> 5), rr = r & 15, cc = c & 31, ob = rr * 64 + cc * 2; return st * 1024 + (ob ^ (((ob >> 9) & 1) << 5)); }
__host__ __device__ __forceinline__ void stage_rc(int b, int& R, int& C) { const int st = b / 1024, sb = b % 1024, swz = sb ^ (((sb >> 9) & 1) << 5); R = (st >> 1) * 16 + swz / 64; C = (st & 1) * 32 + (swz % 64) / 2; }
__host__ __device__ __forceinline__ int perm32(int rho) { const int n = rho >> 4, i = rho & 15; return 8 * (i >> 2) + 4 * n + (i & 3); }

struct Unit { int pm, pn; };
struct Gemm { const bf16_t* A; const bf16_t* Bt; int M, N, K; };

struct StaticOrder {
    int nM, nN, nwg, G, c;
    __host__ __device__ void init(int M, int N, int G_, int c_) { nM = M / BM; nN = N / BM; nwg = nM * nN; G = G_; c = c_; }
    __host__ __device__ bool next(int i, Unit& u) const {
        const long L = (long)i * G + c; if (L >= nwg) return false;
        int wgid = (int)L; { const int q = nwg / NXCD, r = nwg % NXCD, xcd = wgid % NXCD, off = wgid / NXCD; wgid = (xcd < r ? xcd * (q + 1) : r * (q + 1) + (xcd - r) * q) + off; }
        const int nig = WGM * nN, gid = wgid / nig, fm = gid * WGM, gsz = (nM - fm) < WGM ? (nM - fm) : WGM;
        u.pm = fm + ((wgid % nig) % gsz); u.pn = (wgid % nig) / gsz; return true;
    }
    __device__ __forceinline__ void a_ready(const Unit&) const {}
    __device__ __forceinline__ void done(const Unit&) const {}
};
template <class Epi, class Sched>
__device__ __forceinline__ void gemm_phase(PG8_LAS unsigned char* lds, const Gemm g, const Sched& S, const Epi& E) {
    const int tid = my_tid(), wid = __builtin_amdgcn_readfirstlane(tid >> 6), lane = tid & 63, wr = wid >> 2, wc = wid & 3, fr = lane & 15, fq = lane >> 4;
    const int K = g.K, nt = K / BK;
    unsigned voffA[2], voffB[2];
#pragma unroll
    for (int i = 0; i < 2; ++i) { int R, C; stage_rc(tid * 16 + i * 8192, R, C); const int Rb = Epi::PERM ? ((R & ~31) + perm32(R & 31)) : R;
        voffA[i] = (unsigned)(R * K + C) * 2u; voffB[i] = (unsigned)(Rb * K + C) * 2u; }
    const size_t kstep = (size_t)(BK * 2);
    const size_t hstep = (size_t)HALF * K * 2;
    const size_t tstep = 2 * hstep;
    const unsigned ldsw = (unsigned)wid * 1024u;
    const int aoff = lds_byte(wr * 64 + fr, fq * 8), boff = lds_byte(wc * 32 + fr, fq * 8);
#define PG8_SA(b, h) (((b) * 2 + (h)) * HTB)
#define PG8_SB(b, h) ((4 + (b) * 2 + (h)) * HTB)
#define PG8_STAGE(bufoff, gbase, voff) do { _Pragma("unroll") for (int _i = 0; _i < 2; ++_i) \
        __builtin_amdgcn_global_load_lds((const unsigned*)((const char*)(gbase) + (voff)[_i]), (PG8_LAS unsigned*)(lds + (bufoff) + ldsw + _i * 8192), 16, 0, 0); } while (0)
#define PG8_LDA(dst, b, h) do { _Pragma("unroll") for (int m = 0; m < 4; ++m) _Pragma("unroll") for (int k = 0; k < 2; ++k) dst[m][k] = *(const PG8_LAS bf16x8*)(lds + PG8_SA(b, h) + aoff + m * 2048 + k * 1024); } while (0)
#define PG8_LDB(dst, b, h) do { _Pragma("unroll") for (int n = 0; n < 2; ++n) _Pragma("unroll") for (int k = 0; k < 2; ++k) dst[n][k] = *(const PG8_LAS bf16x8*)(lds + PG8_SB(b, h) + boff + n * 2048 + k * 1024); } while (0)
#define PG8_MMA(ai, bj, At, Bt) do { __builtin_amdgcn_s_setprio(1); _Pragma("unroll") for (int m = 0; m < 4; ++m) _Pragma("unroll") for (int n = 0; n < 2; ++n) _Pragma("unroll") for (int k = 0; k < 2; ++k) \
        acc[ai][bj][m][n] = __builtin_amdgcn_mfma_f32_16x16x32_bf16(Bt[n][k], At[m][k], acc[ai][bj][m][n], 0, 0, 0); __builtin_amdgcn_s_setprio(0); } while (0)
#define PG8_WAIT_V(n) asm volatile("s_waitcnt vmcnt(" #n ")" ::: "memory")
#define PG8_WAIT_L(n) asm volatile("s_waitcnt lgkmcnt(" #n ")" ::: "memory")
#define PG8_BAR __builtin_amdgcn_s_barrier()
#define PG8_SCHED __builtin_amdgcn_sched_barrier(0)
    Unit cur, nxt; int ui = 0;
    if (!S.next(0, cur)) return;
    f32x4 acc[2][2][4][2];
#pragma unroll
    for (int a = 0; a < 2; ++a)
#pragma unroll
        for (int b = 0; b < 2; ++b)
#pragma unroll
            for (int m = 0; m < 4; ++m)
#pragma unroll
                for (int n = 0; n < 2; ++n) acc[a][b][m][n] = (f32x4){0.f, 0.f, 0.f, 0.f};
    bf16x8 At[4][2], B0[2][2], B1[2][2];
    const char* cA = (const char*)g.A + (size_t)cur.pm * tstep; const char* cB = (const char*)g.Bt + (size_t)cur.pn * tstep;
    S.a_ready(cur);
    PG8_STAGE(PG8_SB(0, 0), cB, voffB); PG8_STAGE(PG8_SA(0, 0), cA, voffA); PG8_STAGE(PG8_SB(0, 1), cB + hstep, voffB); PG8_STAGE(PG8_SA(0, 1), cA + hstep, voffA);
    if (wr == 1) PG8_BAR;
    PG8_WAIT_V(4); PG8_BAR;
    PG8_STAGE(PG8_SB(1, 0), cB + kstep, voffB); PG8_STAGE(PG8_SA(1, 0), cA + kstep, voffA); PG8_STAGE(PG8_SB(1, 1), cB + hstep + kstep, voffB);
    PG8_WAIT_V(6); PG8_BAR;
    for (;;) {
        const bool has_next = S.next(ui + 1, nxt);
        const char* nA = has_next ? (const char*)g.A + (size_t)nxt.pm * tstep : cA; const char* nB = has_next ? (const char*)g.Bt + (size_t)nxt.pn * tstep : cB;
        for (int t = 0; t < nt; t += 2) {
            const bool last = (t == nt - 2);
            const char* a1 = cA + (size_t)(t + 1) * kstep;
            const char* a2 = last ? nA : cA + (size_t)(t + 2) * kstep; const char* b2 = last ? nB : cB + (size_t)(t + 2) * kstep;
            const char* a3 = a2 + kstep; const char* b3 = b2 + kstep;
            if (last && has_next) S.a_ready(nxt);
            PG8_LDB(B0, 0, 0); PG8_SCHED; PG8_LDA(At, 0, 0); PG8_STAGE(PG8_SA(1, 1), a1 + hstep, voffA);
            PG8_WAIT_L(8); PG8_BAR; PG8_WAIT_L(0); PG8_MMA(0, 0, At, B0); PG8_BAR; PG8_SCHED;
            PG8_LDB(B1, 0, 1); PG8_STAGE(PG8_SB(0, 0), b2, voffB);
            PG8_BAR; PG8_WAIT_L(0); PG8_MMA(0, 1, At, B1); PG8_BAR;
            PG8_LDA(At, 0, 1); PG8_STAGE(PG8_SA(0, 0), a2, voffA);
            PG8_BAR; PG8_WAIT_L(0); PG8_MMA(1, 0, At, B0); PG8_BAR; PG8_SCHED;
            PG8_STAGE(PG8_SB(0, 1), b2 + hstep, voffB);
            PG8_WAIT_V(6); PG8_BAR; PG8_MMA(1, 1, At, B1); PG8_BAR;
            PG8_LDB(B0, 1, 0); PG8_SCHED; PG8_LDA(At, 1, 0); PG8_STAGE(PG8_SA(0, 1), a2 + hstep, voffA);
            PG8_WAIT_L(8); PG8_BAR; PG8_WAIT_L(0); PG8_MMA(0, 0, At, B0); PG8_BAR; PG8_SCHED;
            PG8_LDB(B1, 1, 1); PG8_STAGE(PG8_SB(1, 0), b3, voffB);
            PG8_BAR; PG8_WAIT_L(0); PG8_MMA(0, 1, At, B1); PG8_BAR;
            PG8_LDA(At, 1, 1); PG8_STAGE(PG8_SA(1, 0), a3, voffA);
            PG8_BAR; PG8_WAIT_L(0); PG8_MMA(1, 0, At, B0); PG8_BAR; PG8_SCHED;
            PG8_STAGE(PG8_SB(1, 1), b3 + hstep, voffB);
            PG8_WAIT_V(6); PG8_BAR; PG8_MMA(1, 1, At, B1); PG8_BAR;
        }
            if constexpr (!Epi::AFTER_DRAIN) { E(acc, cur, wr, wc, fr, fq); S.done(cur); }
            if (!has_next) break;
#pragma unroll
        for (int a = 0; a < 2; ++a)
#pragma unroll
            for (int b = 0; b < 2; ++b)
#pragma unroll
                for (int m = 0; m < 4; ++m)
#pragma unroll
                    for (int n = 0; n < 2; ++n) acc[a][b][m][n] = (f32x4){0.f, 0.f, 0.f, 0.f};
        cur = nxt; cA = nA; cB = nB; ++ui;
    }
    PG8_WAIT_V(0);
    if (wr == 0) PG8_BAR;
    PG8_BAR;
    if constexpr (Epi::AFTER_DRAIN) { E.fused(acc, cur, wr, wc, fr, fq, lds, wid, lane); S.done(cur); }
#undef PG8_SA
#undef PG8_SB
#undef PG8_STAGE
#undef PG8_LDA
#undef PG8_LDB
#undef PG8_MMA
#undef PG8_WAIT_V
#undef PG8_WAIT_L
#undef PG8_BAR
#undef PG8_SCHED
}

__device__ __forceinline__ unsigned pk2(float lo, float hi) { return pk2bf(lo, hi); }
struct EpiStore {
  static constexpr bool PERM = true, AFTER_DRAIN = false;
  bf16_t* O; int ldc; int ncols; int coff;
  __device__ __forceinline__ void operator()(const f32x4 (&acc)[2][2][4][2], const Unit& u, int wr, int wc, int fr, int fq) const {
    const int row0 = u.pm * BM + wr * 64 + fr, col0 = u.pn * BM + wc * 32 + 8 * fq;
#pragma unroll
    for (int ai = 0; ai < 2; ++ai)
#pragma unroll
      for (int m = 0; m < 4; ++m) { bf16_t* rowp = O + (size_t)(row0 + ai * HALF + m * 16) * ldc + coff + col0;
#pragma unroll
        for (int bj = 0; bj < 2; ++bj) if (col0 + bj * HALF < ncols) { const f32x4 v0 = acc[ai][bj][m][0], v1 = acc[ai][bj][m][1];
          *(u32x4*)(rowp + bj * HALF) = (u32x4){pk2(v0[0], v0[1]), pk2(v0[2], v0[3]), pk2(v1[0], v1[1]), pk2(v1[2], v1[3])}; } }
  }
};
struct EpiSigmoid {
  static constexpr bool PERM = true, AFTER_DRAIN = false;
  bf16_t* O; int ldc; const float* bias;
  __device__ __forceinline__ void operator()(const f32x4 (&acc)[2][2][4][2], const Unit& u, int wr, int wc, int fr, int fq) const {
    const int row0 = u.pm * BM + wr * 64 + fr, col0 = u.pn * BM + wc * 32 + 8 * fq;
    f32x4 bv[2][2];
#pragma unroll
    for (int bj = 0; bj < 2; ++bj)
#pragma unroll
      for (int n = 0; n < 2; ++n) bv[bj][n] = *(const f32x4*)(bias + col0 + bj * HALF + 4 * n);
#pragma unroll
    for (int ai = 0; ai < 2; ++ai)
#pragma unroll
      for (int m = 0; m < 4; ++m) { bf16_t* rowp = O + (size_t)(row0 + ai * HALF + m * 16) * ldc + col0;
#pragma unroll
        for (int bj = 0; bj < 2; ++bj) { const f32x4 v0 = acc[ai][bj][m][0] + bv[bj][0], v1 = acc[ai][bj][m][1] + bv[bj][1];
          *(u32x4*)(rowp + bj * HALF) = (u32x4){pk2(sigmoidf_(v0[0]), sigmoidf_(v0[1])), pk2(sigmoidf_(v0[2]), sigmoidf_(v0[3])), pk2(sigmoidf_(v1[0]), sigmoidf_(v1[1])), pk2(sigmoidf_(v1[2]), sigmoidf_(v1[3]))}; } }
  }
};
}
#endif

struct TJob { const float* src; int K, N; long lds; bf16_t* dst; long ldd; };
__device__ __forceinline__ TJob get_tjob(const Params& p, int l, int j) {
  TJob t; char* ws = p.ws;
  if (j < 10) {
    const int seg[10][3] = {{0, 1728, 0}, {1728, 512, ZC_GA}, {2240, 256, ZC_QD}, {2496, 128, ZC_KVD}, {2624, 32, ZC_KR}, {2656, 512, ZC_GB}, {3168, 512, ZC_U}, {3680, 512, ZC_VC}, {4192, 512, ZC_GC}, {4704, 1024, ZC_F}};
    int sc = 0, wd = 0, zc = 0;
#pragma unroll
    for (int q = 0; q < 10; ++q) if (q == j) { sc = seg[q][0]; wd = seg[q][1]; zc = seg[q][2]; }
    const int wrow = zc < Z1_W ? zc : zc + (Z1_WP - Z1_W);
    t.src = p.w_in + (size_t)l * 1024 * IN_W + sc; t.K = 1024; t.N = wd; t.lds = IN_W; t.dst = (bf16_t*)(ws + O_WINT) + (size_t)wrow * 1024; t.ldd = 1024; return t; }
  j -= 9;
  if (j == 1) { t.src = p.w_merge + (size_t)l * 1024 * 4096; t.K = 1024; t.N = 4096; t.lds = 4096; t.dst = (bf16_t*)(ws + O_WMT); t.ldd = 1024; }
  else if (j < 6) { int n = j - 2; t.src = p.w_branch + ((size_t)l * 4 + n) * 512 * 1024; t.K = 512; t.N = 1024; t.lds = 1024; t.dst = (bf16_t*)(ws + O_WBRT) + (size_t)n * 1024 * 512; t.ldd = 512; }
  else if (j == 6) { t.src = p.w_out + (size_t)l * 1024 * 1024; t.K = 1024; t.N = 1024; t.lds = 1024; t.dst = (bf16_t*)(ws + O_WOUTT); t.ldd = 1024; }
  else if (j == 7) { t.src = p.w_q_up + (size_t)l * 256 * 768; t.K = 256; t.N = 768; t.lds = 768; t.dst = (bf16_t*)(ws + O_WQT); t.ldd = 256; }
  else if (j == 8) { t.src = p.w_kv_up + (size_t)l * 128 * 1024; t.K = 128; t.N = 1024; t.lds = 1024; t.dst = (bf16_t*)(ws + O_WKVT); t.ldd = 128; }
  else { int n = j - 9;
    t.src = (n < 2 ? p.w_up : p.a_up) + ((size_t)l * 2 + (n & 1)) * 64 * 512; t.K = 64; t.N = 512; t.lds = 512;
    t.dst = (bf16_t*)(ws + O_WUPT) + (size_t)n * 512 * 64; t.ldd = 64; }
  return t;
}
constexpr int NTJOBS = 22;

__device__ __forceinline__ void stage_prep(const Params& p, int l, int bid, int nb, char* smem) {
  const int tid = my_tid();
  char* ws = p.ws;
  {
    float* tile = (float*)smem;
    int total = 0;
    for (int j = 0; j < NTJOBS; ++j) { TJob t = get_tjob(p, l, j); total += (t.K / 64) * ((t.N + 63) / 64); }
    f4v pre[2]; bool pv[2];
    auto locate = [&](int q, TJob& t, int& kt, int& nt_) { int base = 0;
      for (int j = 0; j < NTJOBS; ++j) { t = get_tjob(p, l, j); int tn = (t.N + 63) / 64, nt = (t.K / 64) * tn; if (q < base + nt) { int r = q - base; kt = r / tn; nt_ = r % tn; return; } base += nt; } };
    auto issue = [&](int q) { TJob t; int kt = 0, nt_ = 0; locate(q, t, kt, nt_);
#pragma unroll
      for (int i = 0; i < 2; ++i) { int e = tid + NTHR * i, r = e >> 4, c4 = e & 15; int n0 = nt_ * 64 + c4 * 4; pv[i] = n0 < t.N;
        pre[i] = pv[i] ? *(const f4v*)(t.src + (long)(kt * 64 + r) * t.lds + n0) : f4v{0.f, 0.f, 0.f, 0.f}; } };
    if (bid < total) issue(bid);
    for (int q = bid; q < total; q += nb) {
      TJob t; int kt = 0, nt_ = 0; locate(q, t, kt, nt_);
      __syncthreads();
#pragma unroll
      for (int i = 0; i < 2; ++i) { int e = tid + NTHR * i, r = e >> 4, c4 = e & 15;
        tile[r * 65 + c4 * 4] = pre[i][0]; tile[r * 65 + c4 * 4 + 1] = pre[i][1]; tile[r * 65 + c4 * 4 + 2] = pre[i][2]; tile[r * 65 + c4 * 4 + 3] = pre[i][3]; }
      __syncthreads();
      if (q + nb < total) issue(q + nb);
      { int n = tid >> 3, kc = tid & 7; float x[8];
        if (nt_ * 64 + n < t.N) {
#pragma unroll
          for (int e = 0; e < 8; ++e) x[e] = tile[(kc * 8 + e) * 65 + n];
          *(u4v*)(t.dst + (long)(nt_ * 64 + n) * t.ldd + kt * 64 + kc * 8) = pack8(x); } }
    }
    __syncthreads();
  }
  const long gtid = (long)bid * NTHR + tid, gn = (long)nb * NTHR;
  { bf16_t* d = (bf16_t*)(ws + O_WINT) + (size_t)Z1_W * 1024; for (long i = gtid; i < (long)(Z1_WP - Z1_W) * 1024; i += gn) d[i] = 0; }
  { bf16_t* d = (bf16_t*)(ws + O_WS); const float* s = p.g_w_s + (size_t)l * 4 * 128 * 128; for (long i = gtid; i < (long)4 * 128 * 128; i += gn) d[i] = f2bf(s[i]); }
  if (l != 0) return;
  { bf16_t* d = (bf16_t*)(ws + O_CS128);
    for (long i = gtid; i < 256 * 128; i += gn) { int j = (int)(i >> 7), c = (int)(i & 127); int mm = ((j & 127) * c) & 127; float x = 2.0f * mm / 128.f; d[i] = f2bf(j < 128 ? cospif(x) : sinpif(x)); } }
  {
    bf16_t* lut = (bf16_t*)smem;
#pragma unroll 1
    for (int pass = 0; pass < 2; ++pass) {
      const int T = pass ? T_D : T_C; bf16_t* d = (bf16_t*)(ws + (pass ? O_A2D : O_A2C));
      __syncthreads();
      for (int i = tid; i < T; i += NTHR) { float x = 2.0f * (float)i / (float)T; lut[i] = f2bf(cospif(x)); lut[T + i] = f2bf(-sinpif(x)); }
      __syncthreads();
      const long nchunk = (long)T * 2 * T / 8;
      for (long c = gtid; c < nchunk; c += gn) {
        const int tp = (int)(c / (2 * T / 8)), tt0 = (int)(c % (2 * T / 8)) * 8; const int half = tt0 >= T; const int t0 = half ? tt0 - T : tt0;
        int mm = (int)(((long)tp * t0) % T); unsigned short e8[8];
#pragma unroll
        for (int e = 0; e < 8; ++e) { e8[e] = lut[half * T + mm]; mm += tp; if (mm >= T) mm -= T; }
        *(u4v*)(d + c * 8) = u4v{(unsigned)e8[0] | ((unsigned)e8[1] << 16), (unsigned)e8[2] | ((unsigned)e8[3] << 16), (unsigned)e8[4] | ((unsigned)e8[5] << 16), (unsigned)e8[6] | ((unsigned)e8[7] << 16)};
      }
    }
    __syncthreads();
  }
  { float* d = (float*)(ws + O_ROPE);
    for (long i = gtid; i < (long)T_D * 16; i += gn) { int t = (int)(i >> 4), pi = (int)(i & 15); float pos = (pi < 8) ? (float)(t / 64) : (float)(t % 64); float inv = expf(-(float)(pi & 7) * (9.210340371976184f / 8.f)); float a = pos * inv; d[2 * i] = cosf(a); d[2 * i + 1] = sinf(a); } }
  {
    float* sc = (float*)smem;
    float* red = sc + 3 * 1024;
    float* modp = (float*)(ws + O_MOD);
    if (bid < NL * 96) {
      __syncthreads();
      for (int i = tid; i < 3 * 1024; i += NTHR) { int mi = i >> 10, k = i & 1023; sc[i] = siluf_(mi == 0 ? p.c_ctx[k] : p.c[(mi == 2 && NB_D > 1 ? 1024 : 0) + k]); }
      __syncthreads();
    }
    for (int u = bid; u < NL * 96; u += nb) {
      int ll = u / 96, cg = u % 96; int cl = tid & 31, kq = tid >> 5, col = cg * 32 + cl;
      float a0 = 0.f, a1 = 0.f, a2 = 0.f;
      const float* w = p.w_ada + (size_t)ll * 1024 * 3072 + col;
#pragma unroll 16
      for (int k = kq * 64; k < kq * 64 + 64; ++k) {
        float wv = w[(size_t)k * 3072];
        a0 += sc[k] * wv; a1 += sc[1024 + k] * wv; a2 += sc[2048 + k] * wv;
      }
      __syncthreads();
      red[(kq * 3 + 0) * 32 + cl] = a0; red[(kq * 3 + 1) * 32 + cl] = a1; red[(kq * 3 + 2) * 32 + cl] = a2;
      __syncthreads();
      if (tid < 96) { int mi = tid >> 5, cc = tid & 31; float s2 = 0.f;
#pragma unroll
        for (int q8 = 0; q8 < 16; ++q8) s2 += red[(q8 * 3 + mi) * 32 + cc];
        modp[((size_t)ll * 3 + mi) * 3072 + cg * 32 + cc] = s2 + p.b_ada[(size_t)ll * 3072 + cg * 32 + cc]; }
    }
  }
}

__device__ __forceinline__ int mod_index(const Grp& g, int lm) { return g.isden ? 1 + lm / T_D : 0; }

__device__ __forceinline__ void stage_h(const Params& p, const Grp& g, int l, int bid, int nb) {
  const int lane = my_tid() & 63, wid = my_tid() >> 6;
  const float* X = l ? p.out + (size_t)g.m0 * 1024 : (g.isden ? p.x_sample : p.x_prompt + (size_t)g.m0 * 1024);
  bf16_t* H = (bf16_t*)(p.ws + O_H);
  const float* modp = (const float*)(p.ws + O_MOD) + (size_t)l * 3 * 3072;
  const float* gam = p.norm_g + (size_t)l * 1024;
  for (int m = bid * NWAVE + wid; m < g.mg; m += nb * NWAVE) {
    const float* xr = X + (size_t)m * 1024; float v[16]; float ss = 0.f;
#pragma unroll
    for (int i = 0; i < 4; ++i) { float4 q = *(const float4*)(xr + i * 256 + lane * 4); v[4 * i] = q.x; v[4 * i + 1] = q.y; v[4 * i + 2] = q.z; v[4 * i + 3] = q.w; ss += q.x * q.x + q.y * q.y + q.z * q.z + q.w * q.w; }
    ss = wave_sum(ss); float rs = rsqrtf(ss * (1.f / 1024.f) + 1e-6f);
    const float* mo = modp + (size_t)mod_index(g, m) * 3072;
#pragma unroll
    for (int i = 0; i < 4; ++i) {
      int c = i * 256 + lane * 4; bf16_t o[4];
#pragma unroll
      for (int e = 0; e < 4; ++e) o[e] = f2bf(v[4 * i + e] * rs * gam[c + e] * (1.f + mo[1024 + c + e]) + mo[c + e]);
      *(u2v*)(H + (size_t)m * 1024 + c) = u2v{(unsigned)o[0] | ((unsigned)o[1] << 16), (unsigned)o[2] | ((unsigned)o[3] << 16)};
    }
  }
}

__device__ __forceinline__ int g1b_blocks(const Grp& g, int nb) { int u = ((g.mg + 255) / 256) * (Z2_W / 256); int h = nb / 2; return u < h ? u : h; }
__device__ __forceinline__ void stage_g1(const Params& p, const Grp& g, int part, int bid, int nb, char* smem) {
  const bf16_t* H = (const bf16_t*)(p.ws + O_H);
  const bf16_t* W = (const bf16_t*)(p.ws + O_WINT) + (part ? (size_t)Z1_WP * 1024 : 0);
  bf16_t* Z = (bf16_t*)(p.ws + O_Z);
  const int NW = part ? Z2_W : Z1_W, NWP = part ? Z2_W : Z1_WP, coff = part ? Z1_W : 0;
  if (part) { nb = g1b_blocks(g, nb); if (bid >= nb) return; }
#ifndef EMU
  if ((g.mg & 255) == 0) {
    pg8::Gemm gm; gm.A = H; gm.Bt = W; gm.M = g.mg; gm.N = NWP; gm.K = 1024;
    pg8::StaticOrder S; S.init(gm.M, gm.N, nb, bid);
    pg8::EpiStore E; E.O = Z; E.ldc = IN_W; E.ncols = NW; E.coff = coff;
    pg8::gemm_phase<pg8::EpiStore, pg8::StaticOrder>((PG8_LAS unsigned char*)smem, gm, S, E);
    return;
  }
#endif
  const int TM = (g.mg + 127) / 128, TN = (NW + 127) / 128;
  const int mg = g.mg;
  for (int t = bid; t < TM * TN; t += nb) {
    int tn = t / TM, tm = t % TM; f4v acc[2][4]; zero_acc<4>(acc);
    gemm_mainloop<4>(H, 1024, tm * 128, mg, W, 1024, tn * 128, NWP, 1024, smem, acc);
    epi_foreach<4>(acc, tm * 128, tn * 128, [&](int row, int c0, f4v& v) {
      if (c0 < NW && row < mg) *(u2v*)(Z + (size_t)row * IN_W + coff + c0) = pack4(v[0], v[1], v[2], v[3]);
    });
  }
}

__device__ __forceinline__ void stage_e1(const Params& p, const Grp& g, int l, int bid, int nb) {
  { const int nbA = g1b_blocks(g, nb); if (bid < nbA) return; bid -= nbA; nb -= nbA; }
  const int lane = my_tid() & 63, wid = my_tid() >> 6;
  char* ws = p.ws;
  const bf16_t* Z = (const bf16_t*)(ws + O_Z);
  bf16_t* SK = (bf16_t*)(ws + O_SK); bf16_t* SOP = (bf16_t*)(ws + O_SOP);
  bf16_t* LORA = (bf16_t*)(ws + O_LORA); bf16_t* QDN = (bf16_t*)(ws + O_QDN); bf16_t* CKV = (bf16_t*)(ws + O_CKV); bf16_t* KR = (bf16_t*)(ws + O_KR);
  bf16_t* VCN = (bf16_t*)(ws + O_VCNT);
  const float* rope = (const float*)(ws + O_ROPE);
  const float* mu = p.shift_mu + (size_t)l * SHIFT_W;
  const int isden = g.isden, T = g.T;
  for (int m = bid * NWAVE + wid; m < g.mkv; m += nb * NWAVE) {
    if (m >= g.mg) {
      int r = m - g.mg, b = r / PAST, j = r % PAST;
      if (lane < 20) {
        const float* s = lane < 16 ? p.c_ckv + (((size_t)b * NL + l) * PAST + j) * 128 + lane * 8 : p.c_kr + (((size_t)b * NL + l) * PAST + j) * 32 + (lane - 16) * 8;
        f4v x0 = *(const f4v*)s, x1 = *(const f4v*)(s + 4); float x[8] = {x0[0], x0[1], x0[2], x0[3], x1[0], x1[1], x1[2], x1[3]};
        if (lane < 16) *(u4v*)(CKV + (size_t)m * 128 + lane * 8) = pack8(x);
        else { const int key = T + j, d8 = lane - 16;
          *(u4v*)(KR + ((((size_t)b * (g.nkeys >> 5) + (key >> 5)) * 2 + (d8 >> 1)) * 64 + (d8 & 1) * 32 + (key & 31)) * 8) = pack8(x); }
      }
      continue;
    }
    const int sq = m / T, t = m % T, b = g.b0 + sq;
    const bf16_t* z = Z + (size_t)m * IN_W;
    const bool hp = t > 0, hn = t < T - 1;
#pragma unroll
    for (int it = 0; it < 4; ++it) {
      const int ci = it * 64 + lane; const bool valid = ci < 216; const int cc = valid ? ci : 0;
      float zc[8], pv[8], nv[8], sf[8];
      unpack8(*(const u4v*)(z + cc * 8), zc);
      if (hp) unpack8(*(const u4v*)(z - IN_W + cc * 8), pv); else { for (int e = 0; e < 8; ++e) pv[e] = 0.f; }
      if (hn) unpack8(*(const u4v*)(z + IN_W + cc * 8), nv); else { for (int e = 0; e < 8; ++e) nv[e] = 0.f; }
      f4v m0 = *(const f4v*)(mu + cc * 8), m1 = *(const f4v*)(mu + cc * 8 + 4);
#pragma unroll
      for (int e = 0; e < 8; ++e) sf[e] = zc[e] + (0.5f * (pv[e] + nv[e]) - zc[e]) * (e < 4 ? m0[e] : m1[e - 4]);
      bf16_t* rec = SOP + (((size_t)sq * 8 + (lane >> 3)) * T + t) * 576 + (lane & 7) * 8;
      if (it == 0) *(u4v*)rec = pack8(sf);
      else if (it == 1) {
        *(u4v*)(SK + (size_t)m * 512 + lane * 8) = pack8(sf);
        f4v k0 = *(const f4v*)(p.k_k + (size_t)l * 512 + lane * 8), k1 = *(const f4v*)(p.k_k + (size_t)l * 512 + lane * 8 + 4);
        float kr[8]; float n2 = 0.f;
#pragma unroll
        for (int e = 0; e < 8; ++e) { kr[e] = sf[e] * (e < 4 ? k0[e] : k1[e - 4]); n2 += kr[e] * kr[e]; }
        n2 = sum_lpr<8>(n2); const float inv = 1.f / fmaxf(sqrtf(n2), 1e-12f);
#pragma unroll
        for (int e = 0; e < 8; ++e) kr[e] *= inv;
        *(u4v*)(rec + 64) = pack8(kr);
      }
      else if (it == 2) *(u4v*)(rec + 128) = pack8(sf);
      else if (valid) {
        if (lane < 16) { for (int e = 0; e < 8; ++e) sf[e] = tanhf_(sf[e]); }
        *(u4v*)(LORA + (size_t)m * 192 + lane * 8) = pack8(sf);
      }
    }
    {
      const int col = lane < 32 ? ZC_QD + lane * 8 : (lane < 48 ? ZC_KVD + (lane - 32) * 8 : ZC_KR + ((lane - 48) & 3) * 8);
      float x[8]; unpack8(*(const u4v*)(z + col), x);
      float ss = 0.f;
#pragma unroll
      for (int e = 0; e < 8; ++e) ss += x[e] * x[e];
      const float t32 = sum_lpr<32>(ss), t16 = sum_lpr<16>(ss);
      if (lane < 32) {
        const float rs = rsqrtf(t32 * (1.f / 256.f) + 1e-6f); const float* gq = p.q_norm + (size_t)l * 256 + lane * 8; float o[8];
#pragma unroll
        for (int e = 0; e < 8; ++e) o[e] = x[e] * rs * gq[e];
        *(u4v*)(QDN + (size_t)m * 256 + lane * 8) = pack8(o);
      } else if (lane < 48) {
        const float rs = rsqrtf(t16 * (1.f / 128.f) + 1e-6f); const float* gk = p.kv_norm + (size_t)l * 128 + (lane - 32) * 8; float o[8];
#pragma unroll
        for (int e = 0; e < 8; ++e) o[e] = x[e] * rs * gk[e];
        *(u4v*)(CKV + (size_t)m * 128 + (lane - 32) * 8) = pack8(o);
        if (!isden) { float* op = p.out + OUT_CKV + (((size_t)b * NL + l) * T_C + t) * 128 + (lane - 32) * 8; *(f4v*)op = f4v{o[0], o[1], o[2], o[3]}; *(f4v*)(op + 4) = f4v{o[4], o[5], o[6], o[7]}; }
      } else if (lane < 52) {
        float o[8];
        if (isden) {
#pragma unroll
          for (int pq = 0; pq < 4; ++pq) { int pi = (lane - 48) * 4 + pq; float cs = rope[((size_t)t * 16 + pi) * 2], sn = rope[((size_t)t * 16 + pi) * 2 + 1];
            o[2 * pq] = x[2 * pq] * cs - x[2 * pq + 1] * sn; o[2 * pq + 1] = x[2 * pq] * sn + x[2 * pq + 1] * cs; }
        } else {
#pragma unroll
          for (int e = 0; e < 8; ++e) o[e] = x[e];
          float* op = p.out + OUT_KR + (((size_t)b * NL + l) * T_C + t) * 32 + (lane - 48) * 8; *(f4v*)op = f4v{x[0], x[1], x[2], x[3]}; *(f4v*)(op + 4) = f4v{x[4], x[5], x[6], x[7]};
        }
        { const int d8 = lane - 48; *(u4v*)(KR + ((((size_t)sq * (g.nkeys >> 5) + (t >> 5)) * 2 + (d8 >> 1)) * 64 + (d8 & 1) * 32 + (t & 31)) * 8) = pack8(o); }
      }
    }
    {
      float v[8]; unpack8(*(const u4v*)(z + ZC_VC + lane * 8), v);
      float s1 = 0.f;
#pragma unroll
      for (int e = 0; e < 8; ++e) { v[e] = geluf_(v[e]); s1 += v[e]; }
      s1 = wave_sum(s1); const float mean = s1 * (1.f / 512.f); float s2 = 0.f;
#pragma unroll
      for (int e = 0; e < 8; ++e) { float d = v[e] - mean; s2 += d * d; }
      s2 = wave_sum(s2); const float rs = rsqrtf(s2 * (1.f / 512.f) + 1e-5f);
      const float* gg = p.g_ln_g + (size_t)l * 512 + lane * 8; const float* gb = p.g_ln_b + (size_t)l * 512 + lane * 8;
#pragma unroll
      for (int e = 0; e < 8; ++e) v[e] = (v[e] - mean) * rs * gg[e] + gb[e];
      *(u4v*)(VCN + (size_t)m * 512 + lane * 8) = pack8(v);
    }
  }
}

__device__ __forceinline__ void stage_g2(const Params& p, const Grp& g, int l, int bid, int nb, char* smem) {
  char* ws = p.ws;
  const bf16_t* Z = (const bf16_t*)(ws + O_Z);
  const float* rope = (const float*)(ws + O_ROPE);
  const int mg = g.mg, mkv = g.mkv, T = g.T, isden = g.isden, nkeys = g.nkeys;
  const int TM_M = (mg + 127) / 128, TM_KV = (mkv + 127) / 128;
  const int NT_Q = TM_M * 6, NT_KV = TM_KV * 8, NT_LORA = TM_M * 8, NT_GM = (mg / 128) * 8, ntt = T / 128, NT_D1 = g.nseq * 8 * ntt;
  const int NT = NT_Q + NT_KV + NT_LORA + NT_GM + NT_D1;
  for (int t0 = bid; t0 < NT; t0 += nb) {
    int t = t0; f4v acc[2][4]; zero_acc<4>(acc);
    if (t < NT_Q) {
      int tn = t / TM_M, tm = t % TM_M;
      gemm_mainloop<4>((const bf16_t*)(ws + O_QDN), 256, tm * 128, mg, (const bf16_t*)(ws + O_WQT), 256, tn * 128, 768, 256, smem, acc);
      bf16_t* Q = (bf16_t*)(ws + O_Q);
      const float scale = 0.10206207261596575f * 1.4426950408889634f;
      epi_foreach<4>(acc, tm * 128, tn * 128, [&](int row, int c0, f4v& v) {
        if (row >= mg) return;
        int cw = c0 % 96; float o0 = v[0], o1 = v[1], o2 = v[2], o3 = v[3];
        if (cw >= 64 && isden) { int tt = row % T_D; int pi = (cw - 64) >> 1; const float* rp = rope + ((size_t)tt * 16 + pi) * 2;
          float c_a = rp[0], s_a = rp[1], c_b = rp[2], s_b = rp[3];
          o0 = v[0] * c_a - v[1] * s_a; o1 = v[0] * s_a + v[1] * c_a; o2 = v[2] * c_b - v[3] * s_b; o3 = v[2] * s_b + v[3] * c_b; }
        *(u2v*)(Q + (size_t)row * 768 + c0) = pack4(o0 * scale, o1 * scale, o2 * scale, o3 * scale);
      });
      continue;
    }
    t -= NT_Q;
    if (t < NT_KV) {
      int tn = t / TM_KV, tm = t % TM_KV;
      gemm_mainloop<4>((const bf16_t*)(ws + O_CKV), 128, tm * 128, mkv, (const bf16_t*)(ws + O_WKVT), 128, tn * 128, 1024, 128, smem, acc);
      bf16_t* KN = (bf16_t*)(ws + O_KN); bf16_t* VT = (bf16_t*)(ws + O_VT);
      bf16_t* sT = (bf16_t*)smem;
      __syncthreads();
      epi_foreach<4>(acc, 0, 0, [&](int row, int c0, f4v& v) { *(u2v*)(sT + row * 136 + c0) = pack4(v[0], v[1], v[2], v[3]); });
      __syncthreads();
      { const int tid = my_tid(), ntile = nkeys >> 5, h = tn;
#pragma unroll 1
        for (int q4 = 0; q4 < 4; ++q4) {
          const int item = tid + NTHR * q4;
          const int part = item >> 10, kt4 = (item >> 8) & 3, fr = (item >> 6) & 3, ln = item & 63, lq = ln & 31, lh = ln >> 5;
          const int r0 = tm * 128 + kt4 * 32;
          if (r0 < mkv) {
            int sq, key0; if (r0 < mg) { sq = r0 / T; key0 = r0 % T; } else { int r = r0 - mg; sq = r / PAST; key0 = T + r % PAST; }
            const size_t tb = (((size_t)sq * 8 + h) * ntile + (key0 >> 5)) * 4 + fr;
            if (part == 0) {
              *(u4v*)(KN + (tb * 64 + ln) * 8) = *(const u4v*)(sT + (kt4 * 32 + lq) * 136 + 16 * fr + 8 * lh);
            } else {
              const int st = fr >> 1, db = fr & 1; unsigned short e8[8];
#pragma unroll
              for (int j = 0; j < 8; ++j) e8[j] = sT[(kt4 * 32 + 16 * st + 8 * (j >> 2) + 4 * lh + (j & 3)) * 136 + 64 + db * 32 + lq];
              *(u4v*)(VT + (tb * 64 + ln) * 8) = u4v{(unsigned)e8[0] | ((unsigned)e8[1] << 16), (unsigned)e8[2] | ((unsigned)e8[3] << 16), (unsigned)e8[4] | ((unsigned)e8[5] << 16), (unsigned)e8[6] | ((unsigned)e8[7] << 16)};
            }
          }
        }
      }
      continue;
    }
    t -= NT_KV;
    if (t < NT_LORA) {
      int dir = t / (TM_M * 4), r = t % (TM_M * 4), tn = r / TM_M, tm = r % TM_M;
      f4v aa[2][4]; zero_acc<4>(aa);
      { GT d1 = mk_gt((const bf16_t*)(ws + O_LORA) + dir * 64, 192, tm * 128, mg, (const bf16_t*)(ws + O_WUPT) + (size_t)dir * 512 * 64, 64, tn * 128, 512, 64);
        GT d2 = mk_gt((const bf16_t*)(ws + O_LORA) + 128, 192, tm * 128, mg, (const bf16_t*)(ws + O_WUPT) + (size_t)(2 + dir) * 512 * 64, 64, tn * 128, 512, 64);
        u4v ra[2], rb[2]; gemm_prefetch<4>(d1, ra, rb);
        gemm_run<4, false>(d1, &d2, ra, rb, smem, acc);
        gemm_run<4, false>(d2, nullptr, ra, rb, smem, aa); }
      bf16_t* sW = (bf16_t*)smem; bf16_t* sA2 = sW + 128 * 136;
      __syncthreads();
      epi_foreach<4>(acc, 0, 0, [&](int row, int c0, f4v& v) { *(u2v*)(sW + row * 136 + c0) = pack4(v[0], v[1], v[2], v[3]); });
      epi_foreach<4>(aa, 0, 0, [&](int row, int c0, f4v& v) { *(u2v*)(sA2 + row * 136 + c0) = pack4(v[0], v[1], v[2], v[3]); });
      __syncthreads();
      const bf16_t* SK = (const bf16_t*)(ws + O_SK); bf16_t* SOP = (bf16_t*)(ws + O_SOP); float* BON = (float*)(ws + O_BON);
      const int tid = my_tid();
#pragma unroll 1
      for (int q4 = 0; q4 < 4; ++q4) {
        const int item = tid + NTHR * q4, rowl = item >> 4, ch8 = item & 15;
        int row = tm * 128 + rowl; const bool ok = row < mg; if (!ok) row = mg - 1;
        const int h = tn * 2 + (ch8 >> 3), chn = (ch8 & 7) * 8, c = h * 64 + chn;
        const int sq = row / T, tt = row % T;
        bf16_t* rec = SOP + (((size_t)sq * 8 + h) * T + tt) * 576;
        float pw[8], pa[8], kv[8], kkv[8], rv[8];
        unpack8(*(const u4v*)(sW + rowl * 136 + ch8 * 8), pw); unpack8(*(const u4v*)(sA2 + rowl * 136 + ch8 * 8), pa);
        unpack8(*(const u4v*)(SK + (size_t)row * 512 + c), kv); unpack8(*(const u4v*)(rec + 64 + chn), kkv); unpack8(*(const u4v*)(rec + chn), rv);
        const float* w0 = p.w0 + ((size_t)l * 2 + dir) * 512 + c; const float* a0 = p.a0 + ((size_t)l * 2 + dir) * 512 + c;
        const float* k_a = p.k_a + (size_t)l * 512 + c; const float* r_k = p.r_k + (size_t)l * 512 + c;
        float dd[8], bb[8], kt[8]; float bon = 0.f;
#pragma unroll
        for (int e = 0; e < 8; ++e) {
          dd[e] = 1.f - fexp_(-0.6065306597126334f * sigmoidf_(pw[e] + w0[e]));
          const float av = sigmoidf_(pa[e] + a0[e]);
          bb[e] = kkv[e] * av; kt[e] = kv[e] * (1.f + (av - 1.f) * k_a[e]);
          bon += rv[e] * kt[e] * r_k[e];
        }
        if (ok) { *(u4v*)(rec + (3 + 3 * dir) * 64 + chn) = pack8(dd); *(u4v*)(rec + (4 + 3 * dir) * 64 + chn) = pack8(bb); *(u4v*)(rec + (5 + 3 * dir) * 64 + chn) = pack8(kt); }
        bon = sum_lpr<8>(bon);
        if (ok && (ch8 & 7) == 0) BON[((size_t)row * 8 + h) * 2 + dir] = bon;
      }
      continue;
    }
    t -= NT_LORA;
    if (t < NT_GM) {
      int ch = t >> 3, gg = (t >> 1) & 3, dh = t & 1;
      f4v ac2[2][2]; zero_acc<2>(ac2);
      gemm_mainloop<2, true>((const bf16_t*)(ws + O_WS) + (size_t)gg * 128 * 128, 128, 0, 128, (const bf16_t*)(ws + O_VCNT) + (size_t)ch * 128 * 512, 512, gg * 128 + dh * 64, 512, 128, smem, ac2);
      bf16_t* O = (bf16_t*)(ws + O_OBR) + (size_t)2 * MG * 512;
      const float* bs = p.g_b_s + ((size_t)l * 4 + gg) * 128;
      epi_foreach<2>(ac2, 0, dh * 64, [&](int pp, int c0, f4v& v) {
        int m = ch * 128 + pp; int c = gg * 128 + c0; float bb = bs[pp];
        u2v uu = *(const u2v*)(Z + (size_t)m * IN_W + ZC_U + c), gc = *(const u2v*)(Z + (size_t)m * IN_W + ZC_GC + c);
        *(u2v*)(O + (size_t)m * 512 + c) = pack4(geluf_(bflo(uu.x)) * (v[0] + bb) * siluf_(bflo(gc.x)), geluf_(bfhi(uu.x)) * (v[1] + bb) * siluf_(bfhi(gc.x)),
                                                 geluf_(bflo(uu.y)) * (v[2] + bb) * siluf_(bflo(gc.y)), geluf_(bfhi(uu.y)) * (v[3] + bb) * siluf_(bfhi(gc.y)));
      });
      continue;
    }
    t -= NT_GM;
    {
      int per_seq = 8 * ntt; int sq = t / per_seq; int r = t % per_seq; int gg = r / (2 * ntt); int r2 = r % (2 * ntt); int tj = r2 / ntt, tt = r2 % ntt;
      long mbase = (long)sq * T;
      gemm_mainloop<4>((const bf16_t*)(ws + O_CS128), 128, tj * 128, 256, Z + (size_t)mbase * IN_W + ZC_F + gg * 128, IN_W, tt * 128, T, 128, smem, acc);
      bf16_t* YT = (bf16_t*)(ws + O_YT) + (size_t)mbase * 1024 + (size_t)gg * 128 * 2 * T;
      epi_foreach<4>(acc, tj * 128, tt * 128, [&](int j, int c0, f4v& v) {
        *(u2v*)(YT + (size_t)(j & 127) * 2 * T + (size_t)(j >> 7) * T + c0) = pack4(v[0], v[1], v[2], v[3]);
      });
    }
  }
}

__device__ __forceinline__ bool wave_any(bool pr) {
#ifdef EMU
  return wave_sum(pr ? 1.f : 0.f) > 0.f;
#else
  return __builtin_amdgcn_ballot_w64(pr) != 0ull;
#endif
}
__device__ __forceinline__ void attention_task(const Params& p, const Grp& g, int sq, int h, int qb32) {
  char* ws = p.ws;
  const int lane = my_tid() & 63, ql = lane & 31, hh = lane >> 5;
  const int T = g.T, nkeys = g.nkeys;
  const long mbase = (long)sq * T;
  const bf16_t* Q = (const bf16_t*)(ws + O_Q); const bf16_t* KN = (const bf16_t*)(ws + O_KN); const bf16_t* KRp = (const bf16_t*)(ws + O_KR);
  const int ntile = nkeys >> 5;
  const bf16_t* KFb = KN + ((size_t)sq * 8 + h) * ntile * 4 * 512 + lane * 8;
  const bf16_t* KRb = KRp + (size_t)sq * ntile * 2 * 512 + lane * 8;
  const bf16_t* VFb = (const bf16_t*)(ws + O_VT) + ((size_t)sq * 8 + h) * ntile * 4 * 512 + lane * 8;
  const long mq = mbase + qb32 * 32 + ql;
  s8v qf[6];
#pragma unroll
  for (int s = 0; s < 6; ++s) qf[s] = *(const s8v*)(Q + (size_t)mq * 768 + h * 96 + 16 * s + 8 * hh);
  f16v o0, o1;
#pragma unroll
  for (int i = 0; i < 16; ++i) { o0[i] = 0.f; o1[i] = 0.f; }
  float mrun = -1e30f, lrun = 0.f;
  s8v kfA[6], vfA[4], kfB[6], vfB[4];
#define ATT_LOAD(k0_, KF, VF) do { const int tl = (k0_) >> 5; \
    _Pragma("unroll") for (int st = 0; st < 4; ++st) KF[st] = *(const s8v*)(KFb + (size_t)(tl * 4 + st) * 512); \
    _Pragma("unroll") for (int st = 0; st < 2; ++st) KF[4 + st] = *(const s8v*)(KRb + (size_t)(tl * 2 + st) * 512); \
    _Pragma("unroll") for (int q = 0; q < 4; ++q) VF[q] = *(const s8v*)(VFb + (size_t)(tl * 4 + q) * 512); } while (0)
#define ATT_TILE(KF, VF) do { \
    f16v s; _Pragma("unroll") for (int i = 0; i < 16; ++i) s[i] = 0.f; \
    _Pragma("unroll") for (int st = 0; st < 6; ++st) s = __builtin_amdgcn_mfma_f32_32x32x16_bf16(KF[st], qf[st], s, 0, 0, 0); \
    float mx = s[0]; _Pragma("unroll") for (int i = 1; i < 16; ++i) mx = fmaxf(mx, s[i]); \
    mx = fmaxf(mx, __shfl_xor(mx, 32)); \
    if (wave_any(mx > mrun)) { const float mnew = fmaxf(mrun, mx); const float alpha = fexp2_(mrun - mnew); mrun = mnew; lrun *= alpha; \
      _Pragma("unroll") for (int i = 0; i < 16; ++i) { o0[i] *= alpha; o1[i] *= alpha; } } \
    float ps = 0.f; float pe[16]; \
    _Pragma("unroll") for (int i = 0; i < 16; ++i) { pe[i] = fexp2_(s[i] - mrun); ps += pe[i]; } \
    lrun += ps; \
    _Pragma("unroll") for (int st = 0; st < 2; ++st) { \
      const s8v pf = __builtin_bit_cast(s8v, u4v{pk2bf(pe[8 * st], pe[8 * st + 1]), pk2bf(pe[8 * st + 2], pe[8 * st + 3]), pk2bf(pe[8 * st + 4], pe[8 * st + 5]), pk2bf(pe[8 * st + 6], pe[8 * st + 7])}); \
      o0 = __builtin_amdgcn_mfma_f32_32x32x16_bf16(VF[st * 2], pf, o0, 0, 0, 0); \
      o1 = __builtin_amdgcn_mfma_f32_32x32x16_bf16(VF[st * 2 + 1], pf, o1, 0, 0, 0); } } while (0)
  ATT_LOAD(0, kfA, vfA);
  int k0 = 0;
  for (; k0 + 64 <= nkeys; k0 += 64) {
    ATT_LOAD(k0 + 32, kfB, vfB); SCHED_FENCE();
    ATT_TILE(kfA, vfA); SCHED_FENCE();
    ATT_LOAD((k0 + 64 < nkeys) ? k0 + 64 : nkeys - 32, kfA, vfA); SCHED_FENCE();
    ATT_TILE(kfB, vfB); SCHED_FENCE();
  }
  if (k0 < nkeys) ATT_TILE(kfA, vfA);
#undef ATT_LOAD
#undef ATT_TILE
  const float ltot = lrun + __shfl_xor(lrun, 32); const float inv = 1.f / ltot;
  const bf16_t* Z = (const bf16_t*)(ws + O_Z);
  bf16_t* O = (bf16_t*)(ws + O_OBR) + (size_t)1 * MG * 512;
#pragma unroll
  for (int db = 0; db < 2; ++db)
#pragma unroll
    for (int q4 = 0; q4 < 4; ++q4) {
      const int dv = db * 32 + 8 * q4 + 4 * hh;
      u2v gt = *(const u2v*)(Z + (size_t)mq * IN_W + ZC_GB + h * 64 + dv);
      const float x0 = (db == 0 ? o0[4 * q4] : o1[4 * q4]) * inv, x1 = (db == 0 ? o0[4 * q4 + 1] : o1[4 * q4 + 1]) * inv, x2 = (db == 0 ? o0[4 * q4 + 2] : o1[4 * q4 + 2]) * inv, x3 = (db == 0 ? o0[4 * q4 + 3] : o1[4 * q4 + 3]) * inv;
      *(u2v*)(O + (size_t)mq * 512 + h * 64 + dv) = pack4(x0 * siluf_(bflo(gt.x)), x1 * siluf_(bfhi(gt.x)), x2 * siluf_(bflo(gt.y)), x3 * siluf_(bfhi(gt.y)));
    }
}

__device__ __forceinline__ void stage_dft2(const Params& p, const Grp& g, int bid, int nb, char* smem) {
  char* ws = p.ws;
  const bf16_t* Z = (const bf16_t*)(ws + O_Z);
  const int T = g.T, ntt = T / 128;
  const int NT_D2 = g.nseq * 4 * ntt;
  const int soff = (g.nseq * 32) % nb;
  for (int t = (bid - soff + nb) % nb; t < NT_D2; t += nb) {
    int sq = t / (4 * ntt), r = t % (4 * ntt), gg = r / ntt, tt = r % ntt;
    long mbase = (long)sq * T;
    f4v acc[2][4]; zero_acc<4>(acc);
    { GT d = mk_gt((const bf16_t*)(ws + (g.isden ? O_A2D : O_A2C)), 2 * T, tt * 128, T, (const bf16_t*)(ws + O_YT) + (size_t)mbase * 1024 + (size_t)gg * 128 * 2 * T, 2 * T, 0, 128, 2 * T); gemm_deep<4>(d, smem, acc); }
    bf16_t* O = (bf16_t*)(ws + O_OBR) + (size_t)3 * MG * 512;
    const float sc = rsqrtf(128.f * (float)T);
    epi_foreach<4>(acc, tt * 128, 0, [&](int row, int c0, f4v& v) {
      long m = mbase + row; int c = gg * 128 + c0; u2v gd = *(const u2v*)(Z + (size_t)m * IN_W + ZC_GD + c);
      *(u2v*)(O + (size_t)m * 512 + c) = pack4(v[0] * sc * siluf_(bflo(gd.x)), v[1] * sc * siluf_(bfhi(gd.x)), v[2] * sc * siluf_(bflo(gd.y)), v[3] * sc * siluf_(bfhi(gd.y)));
    });
  }
}

constexpr int PL_STR = 72;
constexpr int PCH_MA = 0, PCH_MB = 4608, PCH_TBT = 9216, PCH_MBT = 10240, PCH_TK = 11264, PCH_MK = 12288, PCH_LDS = 13312;
__device__ __forceinline__ void pchunk_task(const Params& p, const Grp& g, int task, char* wl) {
  char* ws = p.ws;
  const int lane = my_tid() & 63, ql = lane & 31, hh = lane >> 5;
  const int T = g.T, nch = T >> 4;
  const int ch = task / nch, ci = task % nch;
  const int dir = ch & 1, h = (ch >> 1) & 7, sq = ch >> 4;
  const bf16_t* rec0 = (const bf16_t*)(ws + O_SOP) + ((size_t)sq * 8 + h) * T * 576;
  char* cm = ws + O_CM + (size_t)task * CM_REC;
  float At[16], Rt[16], Bh[16], Kh[16]; float W = 1.f;
#pragma unroll
  for (int j = 0; j < 16; ++j) {
    const int st = ci * 16 + j, tt = dir ? T - 1 - st : st;
    const bf16_t* rec = rec0 + (size_t)tt * 576;
    const float r = bf2f(rec[lane]), kk = bf2f(rec[64 + lane]), d = bf2f(rec[(3 + 3 * dir) * 64 + lane]), b = bf2f(rec[(4 + 3 * dir) * 64 + lane]), kt = bf2f(rec[(5 + 3 * dir) * 64 + lane]);
    At[j] = -kk * W; W *= (1.f - d); const float iw = frcp_(W); Rt[j] = r * W; Bh[j] = b * iw; Kh[j] = kt * iw;
  }
  {
    float x[8];
#pragma unroll
    for (int q = 0; q < 2; ++q) {
#pragma unroll
      for (int e = 0; e < 8; ++e) { const int st = ci * 16 + q * 8 + e, tt = dir ? T - 1 - st : st; x[e] = bf2f(rec0[(size_t)tt * 576 + 128 + lane]); }
      *(u4v*)(cm + CM_VT + (((lane >> 5) * 64 + q * 32 + (lane & 31)) * 16)) = pack8(x);
    }
  }
  {
    float x[8];
    const int k2 = lane >> 5, kq = lane & 31;
#pragma unroll
    for (int hq = 0; hq < 2; ++hq) {
#pragma unroll
      for (int e = 0; e < 8; ++e) x[e] = Bh[8 * (e >> 2) + 4 * hq + (e & 3)] * W;
      *(u4v*)(cm + CM_BKT + (((k2 * 2 + 0) * 64 + hq * 32 + kq) * 16)) = pack8(x);
#pragma unroll
      for (int e = 0; e < 8; ++e) x[e] = Kh[8 * hq + e] * W;
      *(u4v*)(cm + CM_BKT + (((k2 * 2 + 1) * 64 + hq * 32 + kq) * 16)) = pack8(x);
    }
    *(float*)(cm + CM_WL + lane * 4) = W;
  }
  bf16_t* MA = (bf16_t*)(wl + PCH_MA); bf16_t* MB = (bf16_t*)(wl + PCH_MB);
  float* TBT = (float*)(wl + PCH_TBT); float* MBT = (float*)(wl + PCH_MBT); float* TK = (float*)(wl + PCH_TK); float* MK = (float*)(wl + PCH_MK);
  WAVE_SYNC();
#pragma unroll
  for (int j = 0; j < 16; ++j) { MA[j * PL_STR + lane] = f2bf(Bh[j]); MA[(16 + j) * PL_STR + lane] = f2bf(Kh[j]); MB[j * PL_STR + lane] = f2bf(At[j]); MB[(16 + j) * PL_STR + lane] = f2bf(Rt[j]); }
  WAVE_SYNC();
  f16v D;
#pragma unroll
  for (int i = 0; i < 16; ++i) D[i] = 0.f;
#pragma unroll
  for (int s4 = 0; s4 < 4; ++s4) {
    const s8v fa = *(const s8v*)(MA + ql * PL_STR + 16 * s4 + 8 * hh), fb = *(const s8v*)(MB + ql * PL_STR + 16 * s4 + 8 * hh);
    D = __builtin_amdgcn_mfma_f32_32x32x16_bf16(fa, fb, D, 0, 0, 0);
  }
#pragma unroll
  for (int r = 0; r < 16; ++r) {
    const int i = (r & 3) + 8 * (r >> 2) + 4 * hh; const float v = D[r];
    if (r < 8) { if (ql < 16) TBT[ql * 16 + i] = (i < ql) ? v : 0.f; else MBT[(ql - 16) * 16 + i] = (i <= ql - 16) ? v : 0.f; }
    else { const int i2 = i - 16; if (ql < 16) TK[i2 * 16 + ql] = (i2 < ql) ? v : 0.f; else MK[i2 * 16 + (ql - 16)] = (i2 <= ql - 16) ? v : 0.f; }
  }
  WAVE_SYNC();
  const int l16 = lane & 15;
  float Z[16], Z2[16];
#pragma unroll
  for (int j = 0; j < 16; ++j) { Z[j] = 0.f; Z2[j] = 0.f; }
#pragma unroll
  for (int j = 0; j < 16; ++j) {
    float a1 = At[j], a2 = TK[l16 * 16 + j];
#pragma unroll
    for (int c4 = 0; c4 * 4 < j; ++c4) { const f4v tv = *(const f4v*)(TBT + j * 16 + c4 * 4);
#pragma unroll
      for (int e = 0; e < 4; ++e) if (c4 * 4 + e < j) { a1 += Z[c4 * 4 + e] * tv[e]; a2 += Z2[c4 * 4 + e] * tv[e]; } }
    Z[j] = a1; Z2[j] = a2;
  }
  bf16_t* GL = (bf16_t*)(wl + PCH_MA);
#pragma unroll
  for (int t = 0; t < 16; ++t) {
    float a1 = Rt[t], a2 = MK[l16 * 16 + t];
#pragma unroll
    for (int c4 = 0; c4 * 4 <= t; ++c4) { const f4v mv = *(const f4v*)(MBT + t * 16 + c4 * 4);
#pragma unroll
      for (int e = 0; e < 4; ++e) if (c4 * 4 + e <= t) { a1 += Z[c4 * 4 + e] * mv[e]; a2 += Z2[c4 * 4 + e] * mv[e]; } }
    GL[(16 + t) * 88 + lane] = f2bf(a1);
    if (lane < 16) GL[(16 + t) * 88 + 64 + lane] = f2bf(a2);
  }
#pragma unroll
  for (int j = 0; j < 16; ++j) { GL[j * 88 + lane] = f2bf(Z[j]); if (lane < 16) GL[j * 88 + 64 + lane] = f2bf(Z2[j]); }
  WAVE_SYNC();
  { const bf16_t* gr = GL + ql * 88;
#pragma unroll
    for (int s4 = 0; s4 < 4; ++s4) { const u2v lo = *(const u2v*)(gr + 16 * s4 + 4 * hh), hi = *(const u2v*)(gr + 16 * s4 + 8 + 4 * hh);
      *(u4v*)(cm + CM_GT + (s4 * 64 + lane) * 16) = u4v{lo.x, lo.y, hi.x, hi.y}; }
    *(u4v*)(cm + CM_GT + (4 * 64 + lane) * 16) = *(const u4v*)(gr + 64 + 8 * hh);
  }
  WAVE_SYNC();
}

__device__ __forceinline__ s8v cvt8(const f16v& a, int o) {
  return __builtin_bit_cast(s8v, u4v{pk2bf(a[o], a[o + 1]), pk2bf(a[o + 2], a[o + 3]), pk2bf(a[o + 4], a[o + 5]), pk2bf(a[o + 6], a[o + 7])});
}
struct ScanOps { s8v gA[5], bU[2], bV[2], vf; float wreg; };
__device__ __forceinline__ void scan2_load(ScanOps& o, const char* cm, const bf16_t* rec0, int ci, int T, int dir, int ql, int hh, int row) {
  const int lane = hh * 32 + ql, rt = row >> 5;
  o.wreg = *(const float*)(cm + CM_WL + lane * 4);
#pragma unroll
  for (int s = 0; s < 5; ++s) o.gA[s] = *(const s8v*)(cm + CM_GT + (s * 64 + lane) * 16);
#pragma unroll
  for (int k2 = 0; k2 < 2; ++k2) { o.bU[k2] = *(const s8v*)(cm + CM_BKT + ((k2 * 2) * 64 + lane) * 16); o.bV[k2] = *(const s8v*)(cm + CM_BKT + ((k2 * 2 + 1) * 64 + lane) * 16); }
  o.vf = *(const s8v*)(cm + CM_VT + (rt * 64 + lane) * 16);
  (void)rec0; (void)ci; (void)T; (void)dir;
}
__device__ __forceinline__ void scan2_task(const Params& p, const Grp& g, int l, int task, char* wl) {
  char* ws = p.ws;
  const int lane = my_tid() & 63, ql = lane & 31, hh = lane >> 5;
  const int T = g.T, nch = T >> 4;
  const int ch = task >> 1, rt = task & 1;
  const int dir = ch & 1, h = (ch >> 1) & 7, sq = ch >> 4;
  const int row = rt * 32 + ql;
  const long mbase = (long)sq * T;
  const bf16_t* rec0 = (const bf16_t*)(ws + O_SOP) + ((size_t)sq * 8 + h) * T * 576;
  const char* cm0 = ws + O_CM + (size_t)ch * nch * CM_REC;
  float* YS = (float*)(ws + O_YS) + (size_t)dir * MG * 512;
  float* wlf = (float*)wl;
  f16v a0, a1;
  if (g.isden) { const float* st = (dir ? p.st_b : p.st_f) + ((((size_t)sq * NL + l) * 8 + h) * 64 + row) * 64;
#pragma unroll
    for (int q = 0; q < 4; ++q) { f4v x = *(const f4v*)(st + 8 * q + 4 * hh), y = *(const f4v*)(st + 32 + 8 * q + 4 * hh);
#pragma unroll
      for (int e = 0; e < 4; ++e) { a0[4 * q + e] = x[e]; a1[4 * q + e] = y[e]; } } }
  else {
#pragma unroll
    for (int i = 0; i < 16; ++i) { a0[i] = 0.f; a1[i] = 0.f; } }
  ScanOps s0, s1, s2;
  scan2_load(s0, cm0, rec0, 0, T, dir, ql, hh, row);
  scan2_load(s1, cm0 + CM_REC, rec0, 1, T, dir, ql, hh, row);
#define SCAN2_STEP(CUR, ci_) do { const int ci = (ci_); \
    WAVE_SYNC(); wlf[lane] = CUR.wreg; WAVE_SYNC(); \
    const s8v vfrag = CUR.vf; \
    f16v D; _Pragma("unroll") for (int i = 0; i < 16; ++i) D[i] = 0.f; \
    D = __builtin_amdgcn_mfma_f32_32x32x16_bf16(CUR.gA[0], cvt8(a0, 0), D, 0, 0, 0); \
    D = __builtin_amdgcn_mfma_f32_32x32x16_bf16(CUR.gA[1], cvt8(a0, 8), D, 0, 0, 0); \
    D = __builtin_amdgcn_mfma_f32_32x32x16_bf16(CUR.gA[2], cvt8(a1, 0), D, 0, 0, 0); \
    D = __builtin_amdgcn_mfma_f32_32x32x16_bf16(CUR.gA[3], cvt8(a1, 8), D, 0, 0, 0); \
    D = __builtin_amdgcn_mfma_f32_32x32x16_bf16(CUR.gA[4], vfrag, D, 0, 0, 0); \
    _Pragma("unroll") for (int i = 0; i < 8; ++i) { const int st = ci * 16 + (i & 3) + 8 * (i >> 2) + 4 * hh, tt = dir ? T - 1 - st : st; YS[(size_t)(mbase + tt) * 512 + h * 64 + row] = D[8 + i]; } \
    const s8v uf = cvt8(D, 0); \
    const float* wq = wlf + 4 * hh; \
    _Pragma("unroll") for (int q = 0; q < 4; ++q) { const f4v w0 = *(const f4v*)(wq + 8 * q), w1 = *(const f4v*)(wq + 32 + 8 * q); \
      _Pragma("unroll") for (int e = 0; e < 4; ++e) { a0[4 * q + e] *= w0[e]; a1[4 * q + e] *= w1[e]; } } \
    a0 = __builtin_amdgcn_mfma_f32_32x32x16_bf16(CUR.bU[0], uf, a0, 0, 0, 0); \
    a0 = __builtin_amdgcn_mfma_f32_32x32x16_bf16(CUR.bV[0], vfrag, a0, 0, 0, 0); \
    a1 = __builtin_amdgcn_mfma_f32_32x32x16_bf16(CUR.bU[1], uf, a1, 0, 0, 0); \
    a1 = __builtin_amdgcn_mfma_f32_32x32x16_bf16(CUR.bV[1], vfrag, a1, 0, 0, 0); } while (0)
  int c = 0;
  for (; c + 3 <= nch; c += 3) {
    { const int cc = (c + 2 < nch) ? c + 2 : nch - 1; scan2_load(s2, cm0 + (size_t)cc * CM_REC, rec0, cc, T, dir, ql, hh, row); }
    SCHED_FENCE(); SCAN2_STEP(s0, c); SCHED_FENCE();
    { const int cc = (c + 3 < nch) ? c + 3 : nch - 1; scan2_load(s0, cm0 + (size_t)cc * CM_REC, rec0, cc, T, dir, ql, hh, row); }
    SCHED_FENCE(); SCAN2_STEP(s1, c + 1); SCHED_FENCE();
    { const int cc = (c + 4 < nch) ? c + 4 : nch - 1; scan2_load(s1, cm0 + (size_t)cc * CM_REC, rec0, cc, T, dir, ql, hh, row); }
    SCHED_FENCE(); SCAN2_STEP(s2, c + 2); SCHED_FENCE();
  }
  if (c < nch) SCAN2_STEP(s0, c);
  if (c + 1 < nch) SCAN2_STEP(s1, c + 1);
#undef SCAN2_STEP
  if (!g.isden) { float* so = p.out + (dir ? OUT_SB : OUT_SF) + ((((size_t)(g.b0 + sq) * NL + l) * 8 + h) * 64 + row) * 64;
#pragma unroll
    for (int q = 0; q < 4; ++q) { *(f4v*)(so + 8 * q + 4 * hh) = f4v{a0[4 * q], a0[4 * q + 1], a0[4 * q + 2], a0[4 * q + 3]}; *(f4v*)(so + 32 + 8 * q + 4 * hh) = f4v{a1[4 * q], a1[4 * q + 1], a1[4 * q + 2], a1[4 * q + 3]}; } }
}

__device__ __forceinline__ void stage_mixA(const Params& p, const Grp& g, int bid, int nb, char* smem) {
  const int wid = my_tid() >> 6;
  const int NP = g.nseq * 16 * (g.T >> 4), q32 = g.T / 32, NA = g.nseq * 8 * q32;
  char* wl = smem + wid * PCH_LDS;
  for (int task = wid * nb + bid; task < NP + NA; task += nb * NWAVE) {
    if (task < NP) pchunk_task(p, g, task, wl);
    else { int t = task - NP; int sq = t / (8 * q32), r = t % (8 * q32); attention_task(p, g, sq, r / q32, r % q32); }
  }
}
__device__ __forceinline__ void stage_scanS(const Params& p, const Grp& g, int l, int bid, int nb, char* smem) {
  const int wid = my_tid() >> 6;
  const int NS = g.nseq * 32;
  for (int task = wid * nb + bid; task < NS; task += nb * NWAVE) scan2_task(p, g, l, task, smem + wid * 768);
  __syncthreads();
}

__device__ __forceinline__ void stage_e3(const Params& p, const Grp& g, int l, int bid, int nb) {
  const int lane = my_tid() & 63, wid = my_tid() >> 6;
  char* ws = p.ws;
  const float* YS = (const float*)(ws + O_YS); const bf16_t* SOP = (const bf16_t*)(ws + O_SOP); const float* BON = (const float*)(ws + O_BON); const int T = g.T;
  const bf16_t* Z = (const bf16_t*)(ws + O_Z); bf16_t* O = (bf16_t*)(ws + O_OBR);
  const int hd = lane >> 3, c0 = lane * 8;
  const float* lg = p.ln_g + (size_t)l * 512 + c0; const float* lb = p.ln_b + (size_t)l * 512 + c0;
  for (int m = bid * NWAVE + wid; m < g.mg; m += nb * NWAVE) {
    const f4v y0 = *(const f4v*)(YS + (size_t)m * 512 + c0), y1 = *(const f4v*)(YS + (size_t)m * 512 + c0 + 4);
    const f4v z0 = *(const f4v*)(YS + ((size_t)MG + m) * 512 + c0), z1 = *(const f4v*)(YS + ((size_t)MG + m) * 512 + c0 + 4);
    float o[8]; float s1 = 0.f;
#pragma unroll
    for (int e = 0; e < 4; ++e) { o[e] = y0[e] + z0[e]; o[4 + e] = y1[e] + z1[e]; }
#pragma unroll
    for (int e = 0; e < 8; ++e) s1 += o[e];
    const float mean = sum_lpr<8>(s1) * (1.f / 64.f); float s2 = 0.f;
#pragma unroll
    for (int e = 0; e < 8; ++e) { o[e] -= mean; s2 += o[e] * o[e]; }
    const float rs = rsqrtf(sum_lpr<8>(s2) * (1.f / 64.f) + 64e-5f);
    const float bon = BON[((size_t)m * 8 + hd) * 2] + BON[((size_t)m * 8 + hd) * 2 + 1];
    float v[8], ga[8];
    unpack8(*(const u4v*)(SOP + (((size_t)(m / T) * 8 + hd) * T + (m % T)) * 576 + 128 + (lane & 7) * 8), v);
    unpack8(*(const u4v*)(Z + (size_t)m * IN_W + ZC_GA + c0), ga);
    float r[8];
#pragma unroll
    for (int e = 0; e < 8; ++e) r[e] = (o[e] * rs * lg[e] + lb[e] + bon * v[e]) * siluf_(ga[e]);
    *(u4v*)(O + (size_t)m * 512 + c0) = pack8(r);
  }
}

__device__ __forceinline__ void stage_gates(const Params& p, const Grp& g, int l, int bid, int nb, char* smem) {
  const bf16_t* H = (const bf16_t*)(p.ws + O_H);
  const bf16_t* W = (const bf16_t*)(p.ws + O_WMT);
  bf16_t* GT = (bf16_t*)(p.ws + O_GATES);
  const float* bm = p.b_merge + (size_t)l * 4096;
#ifndef EMU
  if ((g.mg & 255) == 0) {
    pg8::Gemm gm; gm.A = H; gm.Bt = W; gm.M = g.mg; gm.N = 4096; gm.K = 1024;
    pg8::StaticOrder S; S.init(gm.M, gm.N, nb, bid);
    pg8::EpiSigmoid E; E.O = GT; E.ldc = 4096; E.bias = bm;
    pg8::gemm_phase<pg8::EpiSigmoid, pg8::StaticOrder>((PG8_LAS unsigned char*)smem, gm, S, E);
    return;
  }
#endif
  const int TM = (g.mg + 127) / 128, mg = g.mg;
  for (int t = bid; t < TM * 32; t += nb) {
    int tn = t / TM, tm = t % TM; f4v acc[2][4]; zero_acc<4>(acc);
    gemm_mainloop<4>(H, 1024, tm * 128, mg, W, 1024, tn * 128, 4096, 1024, smem, acc);
    epi_foreach<4>(acc, tm * 128, tn * 128, [&](int row, int c0, f4v& v) {
      if (row < mg) *(u2v*)(GT + (size_t)row * 4096 + c0) = pack4(sigmoidf_(v[0] + bm[c0]), sigmoidf_(v[1] + bm[c0 + 1]), sigmoidf_(v[2] + bm[c0 + 2]), sigmoidf_(v[3] + bm[c0 + 3]));
    });
  }
}

__device__ __forceinline__ void stage_g8(const Params& p, const Grp& g, int l, int bid, int nb, char* smem) {
  char* ws = p.ws;
  bf16_t* MGD = (bf16_t*)(ws + O_MERGED);
  const bf16_t* GTp = (const bf16_t*)(ws + O_GATES);
  const int TM = (g.mg + 127) / 128, mg = g.mg, NT = TM * 8;
  auto desc = [&](int t, int n) { int tn = t / TM, tm = t % TM;
    return mk_gt((const bf16_t*)(ws + O_OBR) + (size_t)n * MG * 512, 512, tm * 128, mg, (const bf16_t*)(ws + O_WBRT) + (size_t)n * 1024 * 512, 512, tn * 128, 1024, 512); };
  for (int t = bid; t < NT; t += nb) {
    int tn = t / TM, tm = t % TM;
    f4v macc[2][4]; zero_acc<4>(macc);
#pragma unroll 1
    for (int n = 0; n < 4; ++n) {
      f4v ap[2][4]; zero_acc<4>(ap);
      GT cur = desc(t, n);
      gemm_deep<4>(cur, smem, ap);
      const int lane = my_tid() & 63, wid = my_tid() >> 6, wm = wid >> 1, wn = wid & 1;
#pragma unroll
      for (int i = 0; i < 2; ++i)
#pragma unroll
        for (int j = 0; j < 4; ++j) {
          int row = tm * 128 + wm * 32 + i * 16 + (lane & 15); row = row < mg ? row : mg - 1;
          int c0 = tn * 128 + wn * 64 + j * 16 + (lane >> 4) * 4;
          u2v gt = *(const u2v*)(GTp + (size_t)row * 4096 + n * 1024 + c0);
          macc[i][j][0] += bflo(gt.x) * ap[i][j][0]; macc[i][j][1] += bfhi(gt.x) * ap[i][j][1]; macc[i][j][2] += bflo(gt.y) * ap[i][j][2]; macc[i][j][3] += bfhi(gt.y) * ap[i][j][3];
        }
    }
    epi_foreach<4>(macc, tm * 128, tn * 128, [&](int row, int c0, f4v& v) {
      if (row < mg) *(u2v*)(MGD + (size_t)row * 1024 + c0) = pack4(v[0], v[1], v[2], v[3]);
    });
  }
  (void)l;
}

__device__ __forceinline__ void stage_g9(const Params& p, const Grp& g, int l, int bid, int nb, char* smem) {
  char* ws = p.ws;
  float* X = p.out + (size_t)g.m0 * 1024;
  const float* Xin = l ? (const float*)X : (g.isden ? p.x_sample : p.x_prompt + (size_t)g.m0 * 1024);
  const float* modp = (const float*)(ws + O_MOD) + (size_t)l * 3 * 3072 + 2048;
  const int TM = (g.mg + 127) / 128, mg = g.mg, NT = TM * 8;
  auto desc = [&](int t) { int tn = t / TM, tm = t % TM; return mk_gt((const bf16_t*)(ws + O_MERGED), 1024, tm * 128, mg, (const bf16_t*)(ws + O_WOUTT), 1024, tn * 128, 1024, 1024); };
  for (int t = bid; t < NT; t += nb) {
    int tn = t / TM, tm = t % TM;
    f4v acc[2][4]; zero_acc<4>(acc);
    GT cur = desc(t);
    gemm_deep<4>(cur, smem, acc);
    epi_foreach<4>(acc, tm * 128, tn * 128, [&](int row, int c0, f4v& v) {
      if (row < mg) { const float* gt = modp + (size_t)mod_index(g, row) * 3072 + c0; f4v* xp = (f4v*)(X + (size_t)row * 1024 + c0); f4v x = *(const f4v*)(Xin + (size_t)row * 1024 + c0);
        x[0] += gt[0] * v[0]; x[1] += gt[1] * v[1]; x[2] += gt[2] * v[2]; x[3] += gt[3] * v[3]; *xp = x; }
    });
  }
}

__device__ __forceinline__ void stage_final(const Params& p, int bid, int nb) {
  const int lane = my_tid() & 63, wid = my_tid() >> 6;
  for (int m = bid * NWAVE + wid; m < M; m += nb * NWAVE) {
    float* xr = p.out + (size_t)m * 1024; float4 q[4]; float ss = 0.f;
#pragma unroll
    for (int i = 0; i < 4; ++i) { q[i] = *(const float4*)(xr + i * 256 + lane * 4); ss += q[i].x * q[i].x + q[i].y * q[i].y + q[i].z * q[i].z + q[i].w * q[i].w; }
    ss = wave_sum(ss); float rs = rsqrtf(ss * (1.f / 1024.f) + 1e-6f);
#pragma unroll
    for (int i = 0; i < 4; ++i) { int c = i * 256 + lane * 4; float4 gm = *(const float4*)(p.final_g + c);
      *(float4*)(xr + c) = make_float4(q[i].x * rs * gm.x, q[i].y * rs * gm.y, q[i].z * rs * gm.z, q[i].w * rs * gm.w); }
  }
}

#ifdef EMU
#define DECL_SMEM(name) char* name = emu::smem()
#else
#define DECL_SMEM(name) __shared__ __attribute__((aligned(16))) char name[SMEM_BYTES]
#endif

#ifdef EMU
struct GridBar { __device__ void sync() const { emu::grid_sync(); } };
#else
#define XB_TMO      128
#define XB_XCNT(j)  (256  + 64 * (j))
#define XB_XSUB(j)  (1280 + 64 * (j))
#define XB_XGEN(j)  (2304 + 64 * (j))
#define XB_TOP      3328
#define XB_TOPGEN   3392
#define XB_SPIN_CAP (1u << 20)
#define LAS __attribute__((address_space(3)))
__device__ __forceinline__ unsigned xb_ld(unsigned* p)              { return __hip_atomic_load(p, __ATOMIC_RELAXED, __HIP_MEMORY_SCOPE_AGENT); }
__device__ __forceinline__ unsigned xb_add(unsigned* p, unsigned v) { return __hip_atomic_fetch_add(p, v, __ATOMIC_RELAXED, __HIP_MEMORY_SCOPE_AGENT); }
__device__ __forceinline__ unsigned xb_xcc_id() { return (unsigned)__builtin_amdgcn_s_getreg((3 << 11) | 20) & 0xFu; }
#define XB_SPIN(cond, bar) do { unsigned _sp = 0; while (cond) { __builtin_amdgcn_s_sleep(1); \
    if ((++_sp & 255u) == 0u) { if (xb_ld(&(bar)[XB_TMO])) break; if (_sp > XB_SPIN_CAP) { atomicAdd(&(bar)[XB_TMO], 1u); break; } } } } while (0)
struct GridBar {
  unsigned* bar; unsigned x; volatile LAS unsigned* st;
  __device__ __forceinline__ void post(unsigned* b, volatile LAS unsigned* s_) {
    bar = b; x = xb_xcc_id(); st = s_;
    if (threadIdx.x == 0) (void)xb_add(&bar[XB_XCNT(x)], 1u);
  }
  __device__ __forceinline__ void complete(unsigned& nloc, unsigned& nx) const {
    const unsigned G = gridDim.x;
    unsigned sum, cnt, mine, sp = 0u;
    for (;;) {
      sum = 0u; cnt = 0u; mine = 0u;
#pragma unroll
      for (unsigned j = 0; j < 16; ++j) { const unsigned c = xb_ld(&bar[XB_XCNT(j)]); sum += c; cnt += (c > 0u) ? 1u : 0u; mine = (j == x) ? c : mine; }
      if (sum == G) break;
      __builtin_amdgcn_s_sleep(1);
      if ((++sp & 255u) == 0u) { if (xb_ld(&bar[XB_TMO])) break; if (sp > XB_SPIN_CAP) { atomicAdd(&bar[XB_TMO], 1u); break; } }
    }
    nloc = mine > 0u ? mine : 1u; nx = cnt > 0u ? cnt : 1u;
  }
  __device__ __forceinline__ void sync() const {
    asm volatile("s_waitcnt vmcnt(0)" ::: "memory");
    __syncthreads();
    if (threadIdx.x == 0) {
      __builtin_amdgcn_s_waitcnt(0);
      unsigned nloc = st[0], nx = st[1];
      if (nloc == 0u) { complete(nloc, nx); st[0] = nloc; st[1] = nx; }
      const unsigned old = xb_add(&bar[XB_XSUB(x)], 1u);
      const unsigned gen = old / nloc;
      if (old + 1u == (gen + 1u) * nloc) {
        __builtin_amdgcn_fence(__ATOMIC_RELEASE, "agent");
        asm volatile("s_waitcnt vmcnt(0)" ::: "memory");
        const unsigned og = xb_add(&bar[XB_TOP], 1u);
        const unsigned tg = og / nx;
        if (og + 1u == (tg + 1u) * nx) xb_add(&bar[XB_TOPGEN], 1u);
        else XB_SPIN(xb_ld(&bar[XB_TOPGEN]) == tg, bar);
        __builtin_amdgcn_fence(__ATOMIC_ACQUIRE, "agent");
        xb_add(&bar[XB_XGEN(x)], 1u);
        asm volatile("s_waitcnt vmcnt(0)" ::: "memory");
      } else {
        XB_SPIN(xb_ld(&bar[XB_XGEN(x)]) == gen, bar);
        __builtin_amdgcn_fence(__ATOMIC_ACQUIRE, "agent");
        asm volatile("s_waitcnt vmcnt(0)" ::: "memory");
      }
    }
    __syncthreads();
  }
};
#endif

#ifndef EMU
namespace cg = cooperative_groups;
#else
namespace cg = cooperative_groups;
#endif

__global__ void __launch_bounds__(NTHR) mega_kernel(Params p) {
  DECL_SMEM(smem);
  cg::grid_group grid = cg::this_grid();
  const int bid0 = blockIdx.x, nb0 = gridDim.x;
  GridBar gb;
#ifndef EMU
  if (threadIdx.x == 0) { volatile LAS unsigned* w = (volatile LAS unsigned*)(smem + SMEM_STAGE); w[0] = 0u; w[1] = 0u; w[2] = 0u; w[3] = 0u; }
  __syncthreads();
  gb.post((unsigned*)(p.ws + O_BAR), (volatile LAS unsigned*)(smem + SMEM_STAGE));
#endif
#ifndef PROBE_DUP
#define PROBE_DUP 0
#endif
#define STG(gi_, call) do { Params q = p; q.ws = opaque(q.ws); q.out = opaque(q.out); const int bid = opaque_i(bid0); const int nb = opaque_i(nb0); const Grp g = get_grp(opaque_i(gi_)); (void)g; call; } while (0)
#define STP(bit, gi_, call) do { STG(gi_, call); if (PROBE_DUP & (bit)) { STG(gi_, call); } } while (0)
  const bool q_never = (p.ws == nullptr);
  for (int l = 0; l < NL; ++l) {
    STP(1, 0, stage_prep(q, l, bid, nb, smem));
    if (l == 0) gb.sync();
    if (q_never) grid.sync();
    STP(2, 0, stage_h(q, g, l, bid, nb));
    gb.sync();
    for (int gi = 0; gi < NGRP; ++gi) {
      STP(4, gi, stage_g1(q, g, 0, bid, nb, smem)); gb.sync();
      STP(4, gi, stage_g1(q, g, 1, bid, nb, smem));
      STP(8, gi, stage_e1(q, g, l, bid, nb)); gb.sync();
      STP(16, gi, stage_g2(q, g, l, bid, nb, smem)); gb.sync();
      STP(64, gi, stage_mixA(q, g, bid, nb, smem)); gb.sync();
      STP(32, gi, stage_scanS(q, g, l, bid, nb, smem));
      STP(128, gi, stage_dft2(q, g, bid, nb, smem)); gb.sync();
      STP(256, gi, stage_e3(q, g, l, bid, nb));
      STP(512, gi, stage_gates(q, g, l, bid, nb, smem)); gb.sync();
      STP(1024, gi, stage_g8(q, g, l, bid, nb, smem)); gb.sync();
      STG(gi, stage_g9(q, g, l, bid, nb, smem));
      if (gi + 1 < NGRP) { STP(2, gi + 1, stage_h(q, g, l, bid, nb)); }
      gb.sync();
    }
  }
  STG(0, stage_final(q, bid, nb));
#undef STP
#undef STG
}

extern "C" void kernel_launch(void* const* d_in, const int* in_sizes, int n_in, void* d_out, int out_size, void* d_ws, size_t ws_size,
                              hipStream_t stream) {
  Params p{};
  const float** pp = (const float**)&p;
  for (int i = 0; i < 35; ++i) pp[i] = (const float*)d_in[i];
  p.out = (float*)d_out; p.ws = (char*)d_ws;
#ifdef EMU
  emu::set_coop(true);
  emu_launch(dim3(8), dim3(NTHR), [=]() { mega_kernel(p); });
  emu::set_coop(false);
#else
  static int grid_blocks = 0;
  if (!grid_blocks) {
    int dev = 0, cus = 0, per_cu = 0;
    (void)hipGetDevice(&dev);
    (void)hipDeviceGetAttribute(&cus, hipDeviceAttributeMultiprocessorCount, dev);
    (void)hipOccupancyMaxActiveBlocksPerMultiprocessor(&per_cu, mega_kernel, NTHR, 0);
    if (per_cu > 1) per_cu = 1;
    if (per_cu < 1) per_cu = 1;
    grid_blocks = cus * per_cu;
  }
  (void)hipMemsetAsync((char*)d_ws + O_BAR, 0, BAR_BYTES, stream);
  void* args[] = {&p};
  (void)hipLaunchCooperativeKernel((void*)mega_kernel, dim3(grid_blocks), dim3(NTHR), args, 0, stream);
#endif
  (void)in_sizes; (void)n_in; (void)out_size; (void)ws_size;
}
```

```cpp
#ifdef EMU
#include "hip_emu.h"
#else
#include <hip/hip_runtime.h>
#include <hip/hip_cooperative_groups.h>
#endif
#include <stdint.h>

#ifndef CFG_BATCH
#define CFG_BATCH 32
#define CFG_SEQ 256
#define CFG_DEC_BATCH 2
#define CFG_DEC_SEQ 2048
#define CFG_PAST 512
#define CFG_NGRP_C 2
#endif
constexpr int D = 1024, NL = 2;
constexpr int NB_C = CFG_BATCH, T_C = CFG_SEQ, NB_D = CFG_DEC_BATCH, T_D = CFG_DEC_SEQ, PAST = CFG_PAST;
constexpr int M_C = NB_C * T_C, M_D = NB_D * T_D, M = M_C + M_D;
constexpr int NGRP_C = CFG_NGRP_C, NGRP = 1 + NGRP_C;
constexpr int MGC = M_C / NGRP_C, SEQ_PER_CG = NB_C / NGRP_C;
constexpr int MG = MGC > M_D ? MGC : M_D;
constexpr int MKV = MG + NB_D * PAST;
constexpr int KEYS_D = T_D + PAST;
constexpr int IN_W = 5728;
constexpr int ZC_R = 0, ZC_K = 512, ZC_V = 1024, ZC_WDF = 1536, ZC_QD = 1728, ZC_KVD = 1984, ZC_KR = 2112, ZC_VC = 2144, ZC_U = 2656, ZC_GC = 3168,
              ZC_GA = 3680, ZC_GB = 4192, ZC_F = 4704, ZC_GD = 5216;
constexpr int Z1_W = 3680, Z1_WP = 3840, Z2_W = 2048;
constexpr int SHIFT_W = 1728;
static_assert(M_C % NGRP_C == 0 && NB_C % NGRP_C == 0, "ctx groups");
static_assert(T_C % 128 == 0 && T_D % 128 == 0 && PAST % 32 == 0, "seq multiples");

typedef unsigned short bf16_t;
typedef short s8v __attribute__((ext_vector_type(8)));
typedef float f4v __attribute__((ext_vector_type(4)));
typedef float f16v __attribute__((ext_vector_type(16)));
typedef unsigned u4v __attribute__((ext_vector_type(4)));
typedef unsigned u2v __attribute__((ext_vector_type(2)));

struct Params {
  const float *x_prompt, *x_sample, *st_f, *st_b, *c_ckv, *c_kr, *c, *c_ctx, *norm_g, *w_ada, *b_ada, *w_in, *shift_mu, *w0, *w_up,
      *a0, *a_up, *k_k, *k_a, *r_k, *ln_g, *ln_b, *q_norm, *w_q_up, *kv_norm, *w_kv_up, *g_ln_g, *g_ln_b, *g_w_s, *g_b_s, *w_branch,
      *w_merge, *b_merge, *w_out, *final_g;
  float* out;
  char* ws;
};

struct Grp { int isden, m0, mg, nseq, T, b0, nkeys, mkv; };
__host__ __device__ __forceinline__ Grp get_grp(int gi) {
  Grp g;
  if (gi == 0) { g.isden = 1; g.m0 = M_C; g.mg = M_D; g.nseq = NB_D; g.T = T_D; g.b0 = 0; g.nkeys = KEYS_D; g.mkv = M_D + NB_D * PAST; }
  else { g.isden = 0; g.m0 = (gi - 1) * MGC; g.mg = MGC; g.nseq = SEQ_PER_CG; g.T = T_C; g.b0 = (gi - 1) * SEQ_PER_CG; g.nkeys = T_C; g.mkv = MGC; }
  return g;
}

constexpr size_t al256(size_t x) { return (x + 255) & ~(size_t)255; }
constexpr size_t O_WINT = 0;
constexpr int IN_WP = Z1_WP + Z2_W;
constexpr size_t O_WMT = O_WINT + al256((size_t)IN_WP * 1024 * 2);
constexpr size_t O_WBRT = O_WMT + al256((size_t)4096 * 1024 * 2);
constexpr size_t O_WOUTT = O_WBRT + al256((size_t)4 * 1024 * 512 * 2);
constexpr size_t O_WQT = O_WOUTT + al256((size_t)1024 * 1024 * 2);
constexpr size_t O_WKVT = O_WQT + al256((size_t)768 * 256 * 2);
constexpr size_t O_WUPT = O_WKVT + al256((size_t)1024 * 128 * 2);
constexpr size_t O_WS = O_WUPT + al256((size_t)4 * 512 * 64 * 2);
constexpr size_t O_CS128 = O_WS + al256((size_t)4 * 128 * 128 * 2);
constexpr size_t O_A2C = O_CS128 + al256((size_t)256 * 128 * 2);
constexpr size_t O_A2D = O_A2C + al256((size_t)T_C * 2 * T_C * 2);
constexpr size_t O_ROPE = O_A2D + al256((size_t)T_D * 2 * T_D * 2);
constexpr size_t O_MOD = O_ROPE + al256((size_t)T_D * 32 * 4);
constexpr size_t O_H = O_MOD + al256((size_t)NL * 3 * 3072 * 4);
constexpr size_t O_Z = O_H + al256((size_t)MG * 1024 * 2);
constexpr size_t O_SK = O_Z + al256((size_t)MG * IN_W * 2);
constexpr size_t O_SOP = O_SK + al256((size_t)MG * 512 * 2);
constexpr size_t O_YS = O_SOP + al256((size_t)MG * 8 * 576 * 2);
constexpr size_t O_BON = O_YS + al256((size_t)2 * MG * 512 * 4);
constexpr size_t O_LORA = O_BON + al256((size_t)MG * 16 * 4);
constexpr int CM_GT = 0, CM_BKT = 5120, CM_WL = 9216, CM_VT = 9472, CM_REC = 11520;
constexpr size_t CM_BYTES = (size_t)MG * CM_REC;
constexpr size_t O_CM = O_LORA + al256((size_t)MG * 192 * 2);
constexpr size_t O_PRE = O_CM + al256(CM_BYTES - (size_t)MG * 2048 * 2);
constexpr size_t O_QDN = O_PRE + al256((size_t)MG * 2048 * 2);
constexpr size_t O_CKV = O_QDN + al256((size_t)MG * 256 * 2);
constexpr size_t O_KR = O_CKV + al256((size_t)MKV * 128 * 2);
constexpr size_t O_Q = O_KR + al256((size_t)MKV * 32 * 2);
constexpr size_t O_KN = O_Q + al256((size_t)MG * 768 * 2);
constexpr size_t O_VT = O_KN + al256((size_t)MKV * 512 * 2);
constexpr size_t O_VCNT = O_VT + al256((size_t)MKV * 512 * 2);
constexpr size_t O_YT = O_VCNT + al256((size_t)MG * 512 * 2);
constexpr size_t O_OBR = O_YT + al256((size_t)MG * 1024 * 2);
constexpr size_t O_MERGED = O_OBR + al256((size_t)4 * MG * 512 * 2);
constexpr size_t O_END = O_MERGED + al256((size_t)MG * 1024 * 2);
constexpr size_t O_GATES = O_PRE;
static_assert(O_GATES + (size_t)MG * 4096 * 2 <= O_VCNT, "gates alias region too small");
static_assert(O_CM + CM_BYTES <= O_QDN, "chunk-matrix region must end before QDN");
constexpr size_t O_BAR = O_END;
constexpr size_t BAR_BYTES = 3456 * 4;
static_assert(O_BAR + BAR_BYTES <= ((size_t)256 << 20), "workspace must fit 256 MiB");

constexpr size_t OUT_SF = (size_t)M * D, OUT_SB = OUT_SF + (size_t)NB_C * NL * 8 * 64 * 64,
                 OUT_CKV = OUT_SB + (size_t)NB_C * NL * 8 * 64 * 64, OUT_KR = OUT_CKV + (size_t)NB_C * NL * T_C * 128;

#ifdef EMU
template <class T> __device__ __forceinline__ T* opaque(T* p) { return p; }
__device__ __forceinline__ int opaque_i(int v) { return v; }
#else
template <class T> __device__ __forceinline__ T* opaque(T* p) {
  typedef __attribute__((address_space(1))) T* gptr;
  gptr g = (gptr)p; asm volatile("" : "+s"(g)); return (T*)g;
}
__device__ __forceinline__ int opaque_i(int v) { asm volatile("" : "+s"(v)); return v; }
#endif
#ifdef EMU
#define SCHED_FENCE() do {} while (0)
#else
#define SCHED_FENCE() do { asm volatile("" ::: "memory"); __builtin_amdgcn_sched_barrier(0); } while (0)
#endif
__device__ __forceinline__ int my_tid() {
#ifdef EMU
  return (int)threadIdx.x;
#else
  int t = (int)threadIdx.x; asm volatile("" : "+v"(t)); return t;
#endif
}
__device__ __forceinline__ unsigned f_as_u(float f) { return __builtin_bit_cast(unsigned, f); }
__device__ __forceinline__ float u_as_f(unsigned u) { return __builtin_bit_cast(float, u); }
#ifdef EMU
__device__ __forceinline__ bf16_t f2bf(float f) { unsigned u = f_as_u(f); u += 0x7FFFu + ((u >> 16) & 1u); return (bf16_t)(u >> 16); }
__device__ __forceinline__ unsigned pk2bf(float lo, float hi) { return (unsigned)f2bf(lo) | ((unsigned)f2bf(hi) << 16); }
#else
typedef __bf16 bf2v_t __attribute__((ext_vector_type(2)));
typedef float f2c_t __attribute__((ext_vector_type(2)));
__device__ __forceinline__ bf16_t f2bf(float f) { return __builtin_bit_cast(unsigned short, (__bf16)f); }
__device__ __forceinline__ unsigned pk2bf(float lo, float hi) { return __builtin_bit_cast(unsigned, __builtin_convertvector(f2c_t{lo, hi}, bf2v_t)); }
#endif
__device__ __forceinline__ float bf2f(bf16_t h) { return u_as_f(((unsigned)h) << 16); }
__device__ __forceinline__ float bflo(unsigned u) { return u_as_f(u << 16); }
__device__ __forceinline__ float bfhi(unsigned u) { return u_as_f(u & 0xFFFF0000u); }
#ifdef EMU
__device__ __forceinline__ float fexp_(float x) { return expf(x); }
__device__ __forceinline__ float frcp_(float x) { return 1.f / x; }
#else
__device__ __forceinline__ float fexp_(float x) { return __builtin_amdgcn_exp2f(x * 1.4426950408889634f); }
__device__ __forceinline__ float frcp_(float x) { return __builtin_amdgcn_rcpf(x); }
#endif
#ifdef EMU
__device__ __forceinline__ float fexp2_(float x) { return exp2f(x); }
#else
__device__ __forceinline__ float fexp2_(float x) { return __builtin_amdgcn_exp2f(x); }
#endif
__device__ __forceinline__ float sigmoidf_(float x) { return frcp_(1.f + fexp_(-x)); }
__device__ __forceinline__ float siluf_(float x) { return x * frcp_(1.f + fexp_(-x)); }
__device__ __forceinline__ float tanhf_(float x) { return 1.f - 2.f * frcp_(1.f + fexp_(2.f * x)); }
__device__ __forceinline__ float geluf_(float x) { return 0.5f * x * (1.f + tanhf_(0.7978845608028654f * (x + 0.044715f * x * x * x))); }
#ifdef EMU
__device__ __forceinline__ float wave_sum(float v) {
#pragma unroll
  for (int o = 32; o >= 1; o >>= 1) v += __shfl_xor(v, o);
  return v;
}
#else
__device__ __forceinline__ float wave_sum(float v) {
  v += u_as_f(__builtin_amdgcn_update_dpp(0, (int)f_as_u(v), 0xB1, 0xF, 0xF, true));
  v += u_as_f(__builtin_amdgcn_update_dpp(0, (int)f_as_u(v), 0x4E, 0xF, 0xF, true));
  v += u_as_f(__builtin_amdgcn_update_dpp(0, (int)f_as_u(v), 0x141, 0xF, 0xF, true));
  v += u_as_f(__builtin_amdgcn_update_dpp(0, (int)f_as_u(v), 0x140, 0xF, 0xF, true));
  { auto r = __builtin_amdgcn_permlane16_swap(f_as_u(v), f_as_u(v), false, false); v = u_as_f(r[0]) + u_as_f(r[1]); }
  { auto r = __builtin_amdgcn_permlane32_swap(f_as_u(v), f_as_u(v), false, false); v = u_as_f(r[0]) + u_as_f(r[1]); }
  return v;
}
#endif

#ifdef EMU
#define WAVE_SYNC() emu::wave_barrier()
__device__ __forceinline__ float sum16(float v) { v += __shfl_xor(v, 1); v += __shfl_xor(v, 2); v += __shfl_xor(v, 4); v += __shfl_xor(v, 8); return v; }
#else
#define WAVE_SYNC() __builtin_amdgcn_wave_barrier()
__device__ __forceinline__ float sum16(float v) {
  v += u_as_f(__builtin_amdgcn_update_dpp(0, (int)f_as_u(v), 0xB1, 0xF, 0xF, true));
  v += u_as_f(__builtin_amdgcn_update_dpp(0, (int)f_as_u(v), 0x4E, 0xF, 0xF, true));
  v += u_as_f(__builtin_amdgcn_update_dpp(0, (int)f_as_u(v), 0x141, 0xF, 0xF, true));
  v += u_as_f(__builtin_amdgcn_update_dpp(0, (int)f_as_u(v), 0x140, 0xF, 0xF, true));
  return v;
}
#endif

template <int LPR> __device__ __forceinline__ float sum_lpr(float v) {
#ifdef EMU
  v += __shfl_xor(v, 1); v += __shfl_xor(v, 2); v += __shfl_xor(v, 4);
  if (LPR >= 16) v += __shfl_xor(v, 8);
  if (LPR >= 32) v += __shfl_xor(v, 16);
  return v;
#else
  v += u_as_f(__builtin_amdgcn_update_dpp(0, (int)f_as_u(v), 0xB1, 0xF, 0xF, true));
  v += u_as_f(__builtin_amdgcn_update_dpp(0, (int)f_as_u(v), 0x4E, 0xF, 0xF, true));
  v += u_as_f(__builtin_amdgcn_update_dpp(0, (int)f_as_u(v), 0x141, 0xF, 0xF, true));
  if (LPR >= 16) v += u_as_f(__builtin_amdgcn_update_dpp(0, (int)f_as_u(v), 0x140, 0xF, 0xF, true));
  if (LPR >= 32) { auto r = __builtin_amdgcn_permlane16_swap(f_as_u(v), f_as_u(v), false, false); v = u_as_f(r[0]) + u_as_f(r[1]); }
  return v;
#endif
}

template <int LPR> __device__ __forceinline__ void sum_lpr2(float& a, float& b) {
#ifdef EMU
  a = sum_lpr<LPR>(a); b = sum_lpr<LPR>(b);
#else
#define DPP_ADD2(ctrl) { float ta = u_as_f(__builtin_amdgcn_update_dpp(0, (int)f_as_u(a), ctrl, 0xF, 0xF, true)); float tb = u_as_f(__builtin_amdgcn_update_dpp(0, (int)f_as_u(b), ctrl, 0xF, 0xF, true)); a += ta; b += tb; }
  DPP_ADD2(0xB1) DPP_ADD2(0x4E) DPP_ADD2(0x141)
  if (LPR >= 16) DPP_ADD2(0x140)
  if (LPR >= 32) { auto ra = __builtin_amdgcn_permlane16_swap(f_as_u(a), f_as_u(a), false, false); auto rb = __builtin_amdgcn_permlane16_swap(f_as_u(b), f_as_u(b), false, false);
    a = u_as_f(ra[0]) + u_as_f(ra[1]); b = u_as_f(rb[0]) + u_as_f(rb[1]); }
#undef DPP_ADD2
#endif
}

constexpr int NTHR = 512, NWAVE = 8;
constexpr int LDS_STR = 72;
constexpr int SMEM_STAGE = 131072;
constexpr int SMEM_BYTES = SMEM_STAGE + 16;

template <int NJ>
__device__ __forceinline__ void zero_acc(f4v (&acc)[2][NJ]) {
#pragma unroll
  for (int i = 0; i < 2; ++i)
#pragma unroll
    for (int j = 0; j < NJ; ++j) acc[i][j] = f4v{0.f, 0.f, 0.f, 0.f};
}

struct GT { const bf16_t* A; long lda; int arow0, arows; const bf16_t* B; long ldb; int brow0, brows; int K; int bt; };
__device__ __forceinline__ GT mk_gt(const bf16_t* A, long lda, int arow0, int arows, const bf16_t* B, long ldb, int brow0, int brows, int K, int bt = 0) {
  GT t; t.A = A; t.lda = lda; t.arow0 = arow0; t.arows = arows; t.B = B; t.ldb = ldb; t.brow0 = brow0; t.brows = brows; t.K = K; t.bt = bt; return t;
}
template <int NJ>
__device__ __forceinline__ void gemm_ptrs(const GT& t, int tid, const bf16_t* (&ap)[2], const bf16_t* (&bp)[NJ / 2]) {
#pragma unroll
  for (int i = 0; i < 2; ++i) { int c = tid + NTHR * i, r = c >> 3, cc = c & 7; int ar = t.arow0 + r; ar = ar < t.arows ? ar : t.arows - 1; ap[i] = t.A + (long)ar * t.lda + cc * 8; }
#pragma unroll
  for (int i = 0; i < NJ / 2; ++i) { int c = tid + NTHR * i;
    if (t.bt) { int q = c & 63, dc = c >> 6; bp[i] = t.B + (long)q * t.ldb + t.brow0 + dc * 8; }
    else { int r = c >> 3, cc = c & 7; int br = t.brow0 + r; br = br < t.brows ? br : t.brows - 1; bp[i] = t.B + (long)br * t.ldb + cc * 8; } }
}
template <int NJ>
__device__ __forceinline__ void gemm_prefetch(const GT& t, u4v (&ra)[2], u4v (&rb)[NJ / 2]) {
  const bf16_t* ap[2]; const bf16_t* bp[NJ / 2];
  gemm_ptrs<NJ>(t, my_tid(), ap, bp);
#pragma unroll
  for (int i = 0; i < 2; ++i) ra[i] = *(const u4v*)(ap[i]);
#pragma unroll
  for (int i = 0; i < NJ / 2; ++i) rb[i] = *(const u4v*)(bp[i]);
}
template <int NJ, bool BT>
__device__ __forceinline__ void gemm_run(const GT& t, const GT* nxt, u4v (&ra)[2], u4v (&rb)[NJ / 2], char* smem, f4v (&acc)[2][NJ]) {
  constexpr int NBL = NJ / 2;
  constexpr int BUF = (128 + 128) * LDS_STR;
  bf16_t* s0 = (bf16_t*)smem;
  const int tid = my_tid(), lane = tid & 63, wid = tid >> 6, wm = wid >> 1, wn = wid & 1;
  const bf16_t* ap[2]; const bf16_t* bp[NBL];
  gemm_ptrs<NJ>(t, tid, ap, bp);
  const long ldb = t.ldb;
  __syncthreads();
#pragma unroll
  for (int i = 0; i < 2; ++i) { int c = tid + NTHR * i, r = c >> 3, cc = c & 7; *(u4v*)(s0 + r * LDS_STR + cc * 8) = ra[i]; }
#pragma unroll
  for (int i = 0; i < NBL; ++i) { int c = tid + NTHR * i;
    if (BT) { int q = c & 63, dc = c >> 6;
#pragma unroll
      for (int e = 0; e < 8; ++e) s0[(128 + dc * 8 + e) * LDS_STR + q] = (bf16_t)(rb[i][e >> 1] >> ((e & 1) * 16)); }
    else { int r = c >> 3, cc = c & 7; *(u4v*)(s0 + (128 + r) * LDS_STR + cc * 8) = rb[i]; } }
  __syncthreads();
  const int nk = t.K >> 6;
  for (int kt = 0; kt < nk; ++kt) {
    const bool more = kt + 1 < nk;
    if (more) {
#pragma unroll
      for (int i = 0; i < 2; ++i) ra[i] = *(const u4v*)(ap[i] + (kt + 1) * 64);
#pragma unroll
      for (int i = 0; i < NBL; ++i) rb[i] = *(const u4v*)(bp[i] + (BT ? (long)(kt + 1) * 64 * ldb : (long)(kt + 1) * 64));
    } else if (nxt) gemm_prefetch<NJ>(*nxt, ra, rb);
    SCHED_FENCE();
    const bf16_t* sA = s0 + (kt & 1) * BUF; const bf16_t* sB = sA + 128 * LDS_STR;
#pragma unroll
    for (int ks = 0; ks < 2; ++ks) {
      s8v af[2], bf[NJ];
#pragma unroll
      for (int i = 0; i < 2; ++i) af[i] = *(const s8v*)(sA + (wm * 32 + i * 16 + (lane & 15)) * LDS_STR + ks * 32 + (lane >> 4) * 8);
#pragma unroll
      for (int j = 0; j < NJ; ++j) bf[j] = *(const s8v*)(sB + (wn * NJ * 16 + j * 16 + (lane & 15)) * LDS_STR + ks * 32 + (lane >> 4) * 8);
#pragma unroll
      for (int i = 0; i < 2; ++i)
#pragma unroll
        for (int j = 0; j < NJ; ++j) acc[i][j] = __builtin_amdgcn_mfma_f32_16x16x32_bf16(bf[j], af[i], acc[i][j], 0, 0, 0);
    }
    if (more) {
      bf16_t* dA = s0 + ((kt + 1) & 1) * BUF;
#pragma unroll
      for (int i = 0; i < 2; ++i) { int c = tid + NTHR * i, r = c >> 3, cc = c & 7; *(u4v*)(dA + r * LDS_STR + cc * 8) = ra[i]; }
#pragma unroll
      for (int i = 0; i < NBL; ++i) { int c = tid + NTHR * i;
        if (BT) { int q = c & 63, dc = c >> 6;
#pragma unroll
          for (int e = 0; e < 8; ++e) dA[(128 + dc * 8 + e) * LDS_STR + q] = (bf16_t)(rb[i][e >> 1] >> ((e & 1) * 16)); }
        else { int r = c >> 3, cc = c & 7; *(u4v*)(dA + (128 + r) * LDS_STR + cc * 8) = rb[i]; } }
      __syncthreads();
    }
  }
}
template <int NJ>
__device__ __forceinline__ void gemm_deep(const GT& t, char* smem, f4v (&acc)[2][NJ]) {
  constexpr int NBL = NJ / 2;
  constexpr int BUF = (128 + 128) * LDS_STR;
  bf16_t* s0 = (bf16_t*)smem;
  const int tid = my_tid(), lane = tid & 63, wid = tid >> 6, wm = wid >> 1, wn = wid & 1;
  const bf16_t* ap[2]; const bf16_t* bp[NBL];
  gemm_ptrs<NJ>(t, tid, ap, bp);
  const int nk = t.K >> 6;
  u4v pa0[2], pb0[NBL], pa1[2], pb1[NBL];
#define GD_LOAD(PA, PB, kt_) do { const int kq = (kt_) < nk ? (kt_) : nk - 1; \
    _Pragma("unroll") for (int i = 0; i < 2; ++i) PA[i] = *(const u4v*)(ap[i] + kq * 64); \
    _Pragma("unroll") for (int i = 0; i < NBL; ++i) PB[i] = *(const u4v*)(bp[i] + kq * 64); } while (0)
#define GD_STORE(PA, PB, buf_) do { bf16_t* dA = s0 + (buf_) * BUF; \
    _Pragma("unroll") for (int i = 0; i < 2; ++i) { int c = tid + NTHR * i, r = c >> 3, cc = c & 7; *(u4v*)(dA + r * LDS_STR + cc * 8) = PA[i]; } \
    _Pragma("unroll") for (int i = 0; i < NBL; ++i) { int c = tid + NTHR * i, r = c >> 3, cc = c & 7; *(u4v*)(dA + (128 + r) * LDS_STR + cc * 8) = PB[i]; } } while (0)
#define GD_COMPUTE(buf_) do { const bf16_t* sA = s0 + (buf_) * BUF; const bf16_t* sB = sA + 128 * LDS_STR; \
    _Pragma("unroll") for (int ks = 0; ks < 2; ++ks) { s8v af[2], bf[NJ]; \
      _Pragma("unroll") for (int i = 0; i < 2; ++i) af[i] = *(const s8v*)(sA + (wm * 32 + i * 16 + (lane & 15)) * LDS_STR + ks * 32 + (lane >> 4) * 8); \
      _Pragma("unroll") for (int j = 0; j < NJ; ++j) bf[j] = *(const s8v*)(sB + (wn * NJ * 16 + j * 16 + (lane & 15)) * LDS_STR + ks * 32 + (lane >> 4) * 8); \
      _Pragma("unroll") for (int i = 0; i < 2; ++i) _Pragma("unroll") for (int j = 0; j < NJ; ++j) acc[i][j] = __builtin_amdgcn_mfma_f32_16x16x32_bf16(bf[j], af[i], acc[i][j], 0, 0, 0); } } while (0)
  GD_LOAD(pa0, pb0, 0); SCHED_FENCE();
  GD_LOAD(pa1, pb1, 1); SCHED_FENCE();
  __syncthreads();
  GD_STORE(pa0, pb0, 0);
  __syncthreads();
  for (int kt = 0; kt < nk; kt += 2) {
    GD_LOAD(pa0, pb0, kt + 2); SCHED_FENCE();
    GD_COMPUTE(0);
    if (kt + 1 < nk) { GD_STORE(pa1, pb1, 1); }
    __syncthreads();
    if (kt + 1 >= nk) break;
    GD_LOAD(pa1, pb1, kt + 3); SCHED_FENCE();
    GD_COMPUTE(1);
    if (kt + 2 < nk) { GD_STORE(pa0, pb0, 0); }
    __syncthreads();
  }
#undef GD_LOAD
#undef GD_STORE
#undef GD_COMPUTE
}

template <int NJ, bool BT = false>
__device__ __forceinline__ void gemm_mainloop(const bf16_t* __restrict__ A, long lda, int arow0, int arows, const bf16_t* __restrict__ B,
                                              long ldb, int brow0, int brows, int K, char* smem, f4v (&acc)[2][NJ]) {
  GT t = mk_gt(A, lda, arow0, arows, B, ldb, brow0, brows, K, BT ? 1 : 0);
  u4v ra[2], rb[NJ / 2];
  gemm_prefetch<NJ>(t, ra, rb);
  gemm_run<NJ, BT>(t, nullptr, ra, rb, smem, acc);
}

template <int NJ, class F>
__device__ __forceinline__ void epi_foreach(f4v (&acc)[2][NJ], int row0, int col0, F f) {
  const int tid = my_tid(), lane = tid & 63, wid = tid >> 6, wm = wid >> 1, wn = wid & 1;
#pragma unroll
  for (int i = 0; i < 2; ++i)
#pragma unroll
    for (int j = 0; j < NJ; ++j) f(row0 + wm * 32 + i * 16 + (lane & 15), col0 + wn * NJ * 16 + j * 16 + (lane >> 4) * 4, acc[i][j]);
}
__device__ __forceinline__ u4v pack8(const float (&x)[8]) {
  return u4v{pk2bf(x[0], x[1]), pk2bf(x[2], x[3]), pk2bf(x[4], x[5]), pk2bf(x[6], x[7])};
}
__device__ __forceinline__ void unpack8(u4v u, float (&x)[8]) {
  x[0] = bflo(u.x); x[1] = bfhi(u.x); x[2] = bflo(u.y); x[3] = bfhi(u.y); x[4] = bflo(u.z); x[5] = bfhi(u.z); x[6] = bflo(u.w); x[7] = bfhi(u.w);
}
__device__ __forceinline__ u2v pack4(float a, float b, float c, float d) {
  return u2v{pk2bf(a, b), pk2bf(c, d)};
}

#ifndef EMU
namespace pg8 {
#define PG8_LAS __attribute__((address_space(3)))
typedef unsigned short bf16_t;
typedef short bf16x8 __attribute__((ext_vector_type(8)));
typedef float f32x4 __attribute__((ext_vector_type(4)));
typedef unsigned u32x4 __attribute__((ext_vector_type(4)));
constexpr int BM = 256, BK = 64, HALF = 128, HTB = HALF * BK * 2  , STAGE_BYTES = 8 * HTB, NXCD = 8, WGM = 8;

__host__ __device__ __forceinline__ int lds_byte(int r, int c) { const int st = (r >> 4) * 2 + (c >> 5), rr = r & 15, cc = c & 31, ob = rr * 64 + cc * 2; return st * 1024 + (ob ^ (((ob >> 9) & 1) << 5)); }
__host__ __device__ __forceinline__ void stage_rc(int b, int& R, int& C) { const int st = b / 1024, sb = b % 1024, swz = sb ^ (((sb >> 9) & 1) << 5); R = (st >> 1) * 16 + swz / 64; C = (st & 1) * 32 + (swz % 64) / 2; }
__host__ __device__ __forceinline__ int perm32(int rho) { const int n = rho >> 4, i = rho & 15; return 8 * (i >> 2) + 4 * n + (i & 3); }

struct Unit { int pm, pn; };
struct Gemm { const bf16_t* A; const bf16_t* Bt; int M, N, K; size_t abatch = 0; int ashift = 0; };

struct StaticOrder {
    int nM, nN, nwg, G, c;
    __host__ __device__ void init(int M, int N, int G_, int c_) { nM = M / BM; nN = N / BM; nwg = nM * nN; G = G_; c = c_; }
    __host__ __device__ bool next(int i, Unit& u) const {
        const long L = (long)i * G + c; if (L >= nwg) return false;
        int wgid = (int)L; { const int q = nwg / NXCD, r = nwg % NXCD, xcd = wgid % NXCD, off = wgid / NXCD; wgid = (xcd < r ? xcd * (q + 1) : r * (q + 1) + (xcd - r) * q) + off; }
        const int nig = WGM * nN, gid = wgid / nig, fm = gid * WGM, gsz = (nM - fm) < WGM ? (nM - fm) : WGM;
        u.pm = fm + ((wgid % nig) % gsz); u.pn = (wgid % nig) / gsz; return true;
    }
    __device__ __forceinline__ void a_ready(const Unit&) const {}
    __device__ __forceinline__ void done(const Unit&) const {}
};
template <class Epi, class Sched>
__device__ __forceinline__ void gemm_phase(PG8_LAS unsigned char* lds, const Gemm g, const Sched& S, const Epi& E) {
    const int tid = my_tid(), wid = __builtin_amdgcn_readfirstlane(tid >> 6), lane = tid & 63, wr = wid >> 2, wc = wid & 3, fr = lane & 15, fq = lane >> 4;
    const int K = g.K, nt = K / BK;
    unsigned voffA[2], voffB[2];
#pragma unroll
    for (int i = 0; i < 2; ++i) { int R, C; stage_rc(tid * 16 + i * 8192, R, C); const int Rb = Epi::PERM ? ((R & ~31) + perm32(R & 31)) : R;
        voffA[i] = (unsigned)(R * K + C) * 2u; voffB[i] = (unsigned)(Rb * K + C) * 2u; }
    const size_t kstep = (size_t)(BK * 2);
    const size_t hstep = (size_t)HALF * K * 2;
    const size_t tstep = 2 * hstep;
    const unsigned ldsw = (unsigned)wid * 1024u;
    const int aoff = lds_byte(wr * 64 + fr, fq * 8), boff = lds_byte(wc * 32 + fr, fq * 8);
#define PG8_SA(b, h) (((b) * 2 + (h)) * HTB)
#define PG8_SB(b, h) ((4 + (b) * 2 + (h)) * HTB)
#define PG8_STAGE(bufoff, gbase, voff) do { _Pragma("unroll") for (int _i = 0; _i < 2; ++_i) \
        __builtin_amdgcn_global_load_lds((const unsigned*)((const char*)(gbase) + (voff)[_i]), (PG8_LAS unsigned*)(lds + (bufoff) + ldsw + _i * 8192), 16, 0, 0); } while (0)
#define PG8_LDA(dst, b, h) do { _Pragma("unroll") for (int m = 0; m < 4; ++m) _Pragma("unroll") for (int k = 0; k < 2; ++k) dst[m][k] = *(const PG8_LAS bf16x8*)(lds + PG8_SA(b, h) + aoff + m * 2048 + k * 1024); } while (0)
#define PG8_LDB(dst, b, h) do { _Pragma("unroll") for (int n = 0; n < 2; ++n) _Pragma("unroll") for (int k = 0; k < 2; ++k) dst[n][k] = *(const PG8_LAS bf16x8*)(lds + PG8_SB(b, h) + boff + n * 2048 + k * 1024); } while (0)
#define PG8_MMA(ai, bj, At, Bt) do { __builtin_amdgcn_s_setprio(1); _Pragma("unroll") for (int m = 0; m < 4; ++m) _Pragma("unroll") for (int n = 0; n < 2; ++n) _Pragma("unroll") for (int k = 0; k < 2; ++k) \
        acc[ai][bj][m][n] = __builtin_amdgcn_mfma_f32_16x16x32_bf16(Bt[n][k], At[m][k], acc[ai][bj][m][n], 0, 0, 0); __builtin_amdgcn_s_setprio(0); } while (0)
#define PG8_WAIT_V(n) asm volatile("s_waitcnt vmcnt(" #n ")" ::: "memory")
#define PG8_WAIT_L(n) asm volatile("s_waitcnt lgkmcnt(" #n ")" ::: "memory")
#define PG8_BAR __builtin_amdgcn_s_barrier()
#define PG8_SCHED __builtin_amdgcn_sched_barrier(0)
    Unit cur, nxt; int ui = 0;
    if (!S.next(0, cur)) return;
    f32x4 acc[2][2][4][2];
#pragma unroll
    for (int a = 0; a < 2; ++a)
#pragma unroll
        for (int b = 0; b < 2; ++b)
#pragma unroll
            for (int m = 0; m < 4; ++m)
#pragma unroll
                for (int n = 0; n < 2; ++n) acc[a][b][m][n] = (f32x4){0.f, 0.f, 0.f, 0.f};
    bf16x8 At[4][2], B0[2][2], B1[2][2];
    const char* cA = (const char*)g.A + (size_t)cur.pm * tstep + (size_t)(cur.pn >> g.ashift) * g.abatch; const char* cB = (const char*)g.Bt + (size_t)cur.pn * tstep;
    S.a_ready(cur);
    PG8_STAGE(PG8_SB(0, 0), cB, voffB); PG8_STAGE(PG8_SA(0, 0), cA, voffA); PG8_STAGE(PG8_SB(0, 1), cB + hstep, voffB); PG8_STAGE(PG8_SA(0, 1), cA + hstep, voffA);
    if (wr == 1) PG8_BAR;
    PG8_WAIT_V(4); PG8_BAR;
    PG8_STAGE(PG8_SB(1, 0), cB + kstep, voffB); PG8_STAGE(PG8_SA(1, 0), cA + kstep, voffA); PG8_STAGE(PG8_SB(1, 1), cB + hstep + kstep, voffB);
    PG8_WAIT_V(6); PG8_BAR;
    for (;;) {
        const bool has_next = S.next(ui + 1, nxt);
        const char* nA = has_next ? (const char*)g.A + (size_t)nxt.pm * tstep + (size_t)(nxt.pn >> g.ashift) * g.abatch : cA; const char* nB = has_next ? (const char*)g.Bt + (size_t)nxt.pn * tstep : cB;
        for (int t = 0; t < nt; t += 2) {
            const bool last = (t == nt - 2);
            const char* a1 = cA + (size_t)(t + 1) * kstep;
            const char* a2 = last ? nA : cA + (size_t)(t + 2) * kstep; const char* b2 = last ? nB : cB + (size_t)(t + 2) * kstep;
            const char* a3 = a2 + kstep; const char* b3 = b2 + kstep;
            if (last && has_next) S.a_ready(nxt);
            PG8_LDB(B0, 0, 0); PG8_SCHED; PG8_LDA(At, 0, 0); PG8_STAGE(PG8_SA(1, 1), a1 + hstep, voffA);
            PG8_WAIT_L(8); PG8_BAR; PG8_WAIT_L(0); PG8_MMA(0, 0, At, B0); PG8_BAR; PG8_SCHED;
            PG8_LDB(B1, 0, 1); PG8_STAGE(PG8_SB(0, 0), b2, voffB);
            PG8_BAR; PG8_WAIT_L(0); PG8_MMA(0, 1, At, B1); PG8_BAR;
            PG8_LDA(At, 0, 1); PG8_STAGE(PG8_SA(0, 0), a2, voffA);
            PG8_BAR; PG8_WAIT_L(0); PG8_MMA(1, 0, At, B0); PG8_BAR; PG8_SCHED;
            PG8_STAGE(PG8_SB(0, 1), b2 + hstep, voffB);
            PG8_WAIT_V(6); PG8_BAR; PG8_MMA(1, 1, At, B1); PG8_BAR;
            PG8_LDB(B0, 1, 0); PG8_SCHED; PG8_LDA(At, 1, 0); PG8_STAGE(PG8_SA(0, 1), a2 + hstep, voffA);
            PG8_WAIT_L(8); PG8_BAR; PG8_WAIT_L(0); PG8_MMA(0, 0, At, B0); PG8_BAR; PG8_SCHED;
            PG8_LDB(B1, 1, 1); PG8_STAGE(PG8_SB(1, 0), b3, voffB);
            PG8_BAR; PG8_WAIT_L(0); PG8_MMA(0, 1, At, B1); PG8_BAR;
            PG8_LDA(At, 1, 1); PG8_STAGE(PG8_SA(1, 0), a3, voffA);
            PG8_BAR; PG8_WAIT_L(0); PG8_MMA(1, 0, At, B0); PG8_BAR; PG8_SCHED;
            PG8_STAGE(PG8_SB(1, 1), b3 + hstep, voffB);
            PG8_WAIT_V(6); PG8_BAR; PG8_MMA(1, 1, At, B1); PG8_BAR;
        }
            if constexpr (!Epi::AFTER_DRAIN) { E(acc, cur, wr, wc, fr, fq); S.done(cur); }
            if (!has_next) break;
#pragma unroll
        for (int a = 0; a < 2; ++a)
#pragma unroll
            for (int b = 0; b < 2; ++b)
#pragma unroll
                for (int m = 0; m < 4; ++m)
#pragma unroll
                    for (int n = 0; n < 2; ++n) acc[a][b][m][n] = (f32x4){0.f, 0.f, 0.f, 0.f};
        cur = nxt; cA = nA; cB = nB; ++ui;
    }
    PG8_WAIT_V(0);
    if (wr == 0) PG8_BAR;
    PG8_BAR;
    if constexpr (Epi::AFTER_DRAIN) { E.fused(acc, cur, wr, wc, fr, fq, lds, wid, lane); S.done(cur); }
#undef PG8_SA
#undef PG8_SB
#undef PG8_STAGE
#undef PG8_LDA
#undef PG8_LDB
#undef PG8_MMA
#undef PG8_WAIT_V
#undef PG8_WAIT_L
#undef PG8_BAR
#undef PG8_SCHED
}

__device__ __forceinline__ unsigned pk2(float lo, float hi) { return pk2bf(lo, hi); }
struct EpiStore {
  static constexpr bool PERM = true, AFTER_DRAIN = false;
  bf16_t* O; int ldc; int ncols; int coff;
  __device__ __forceinline__ void operator()(const f32x4 (&acc)[2][2][4][2], const Unit& u, int wr, int wc, int fr, int fq) const {
    const int row0 = u.pm * BM + wr * 64 + fr, col0 = u.pn * BM + wc * 32 + 8 * fq;
#pragma unroll
    for (int ai = 0; ai < 2; ++ai)
#pragma unroll
      for (int m = 0; m < 4; ++m) { bf16_t* rowp = O + (size_t)(row0 + ai * HALF + m * 16) * ldc + coff + col0;
#pragma unroll
        for (int bj = 0; bj < 2; ++bj) if (col0 + bj * HALF < ncols) { const f32x4 v0 = acc[ai][bj][m][0], v1 = acc[ai][bj][m][1];
          *(u32x4*)(rowp + bj * HALF) = (u32x4){pk2(v0[0], v0[1]), pk2(v0[2], v0[3]), pk2(v1[0], v1[1]), pk2(v1[2], v1[3])}; } }
  }
};
struct EpiSigmoid {
  static constexpr bool PERM = true, AFTER_DRAIN = false;
  bf16_t* O; int ldc; const float* bias;
  __device__ __forceinline__ void operator()(const f32x4 (&acc)[2][2][4][2], const Unit& u, int wr, int wc, int fr, int fq) const {
    const int row0 = u.pm * BM + wr * 64 + fr, col0 = u.pn * BM + wc * 32 + 8 * fq;
    f32x4 bv[2][2];
#pragma unroll
    for (int bj = 0; bj < 2; ++bj)
#pragma unroll
      for (int n = 0; n < 2; ++n) bv[bj][n] = *(const f32x4*)(bias + col0 + bj * HALF + 4 * n);
#pragma unroll
    for (int ai = 0; ai < 2; ++ai)
#pragma unroll
      for (int m = 0; m < 4; ++m) { bf16_t* rowp = O + (size_t)(row0 + ai * HALF + m * 16) * ldc + col0;
#pragma unroll
        for (int bj = 0; bj < 2; ++bj) { const f32x4 v0 = acc[ai][bj][m][0] + bv[bj][0], v1 = acc[ai][bj][m][1] + bv[bj][1];
          *(u32x4*)(rowp + bj * HALF) = (u32x4){pk2(sigmoidf_(v0[0]), sigmoidf_(v0[1])), pk2(sigmoidf_(v0[2]), sigmoidf_(v0[3])), pk2(sigmoidf_(v1[0]), sigmoidf_(v1[1])), pk2(sigmoidf_(v1[2]), sigmoidf_(v1[3]))}; } }
  }
};
struct EpiMerge {
  static constexpr bool PERM = true, AFTER_DRAIN = false;
  bf16_t* MGD; const bf16_t* PROJ; const float* bias;
  __device__ __forceinline__ void operator()(const f32x4 (&acc)[2][2][4][2], const Unit& u, int wr, int wc, int fr, int fq) const {
    const int row0 = u.pm * BM + wr * 64 + fr, cq = u.pn * 64 + wc * 16 + fq * 4;
    f32x4 bv[2][2];
#pragma unroll
    for (int bj = 0; bj < 2; ++bj)
#pragma unroll
      for (int n = 0; n < 2; ++n) bv[bj][n] = *(const f32x4*)(bias + (2 * bj + n) * 1024 + cq);
#pragma unroll
    for (int ai = 0; ai < 2; ++ai)
#pragma unroll
      for (int m = 0; m < 4; ++m) { const size_t row = (size_t)(row0 + ai * HALF + m * 16); f32x4 sum = (f32x4){0.f, 0.f, 0.f, 0.f};
#pragma unroll
        for (int bj = 0; bj < 2; ++bj)
#pragma unroll
          for (int n = 0; n < 2; ++n) { const u2v pr = *(const u2v*)(PROJ + row * 4096 + (2 * bj + n) * 1024 + cq); const f32x4 v = acc[ai][bj][m][n] + bv[bj][n];
            sum[0] += sigmoidf_(v[0]) * bflo(pr.x); sum[1] += sigmoidf_(v[1]) * bfhi(pr.x); sum[2] += sigmoidf_(v[2]) * bflo(pr.y); sum[3] += sigmoidf_(v[3]) * bfhi(pr.y); }
        *(u2v*)(MGD + row * 1024 + cq) = (u2v){pk2(sum[0], sum[1]), pk2(sum[2], sum[3])}; }
  }
};
}
#endif

struct TJob { const float* src; int K, N; long lds; bf16_t* dst; long ldd; int perm; };
__host__ __device__ __forceinline__ int wm_row(int br, int col) { const int cb = col >> 6, c = col & 63; return cb * 256 + 128 * (br >> 1) + 32 * (c >> 4) + 8 * ((c >> 2) & 3) + 4 * (br & 1) + (c & 3); }
__device__ __forceinline__ TJob get_tjob(const Params& p, int l, int j) {
  TJob t; char* ws = p.ws; t.perm = 0;
  if (j < 10) {
    const int seg[10][3] = {{0, 1728, 0}, {1728, 512, ZC_GA}, {2240, 256, ZC_QD}, {2496, 128, ZC_KVD}, {2624, 32, ZC_KR}, {2656, 512, ZC_GB}, {3168, 512, ZC_U}, {3680, 512, ZC_VC}, {4192, 512, ZC_GC}, {4704, 1024, ZC_F}};
    int sc = 0, wd = 0, zc = 0;
#pragma unroll
    for (int q = 0; q < 10; ++q) if (q == j) { sc = seg[q][0]; wd = seg[q][1]; zc = seg[q][2]; }
    const int wrow = zc < Z1_W ? zc : zc + (Z1_WP - Z1_W);
    t.src = p.w_in + (size_t)l * 1024 * IN_W + sc; t.K = 1024; t.N = wd; t.lds = IN_W; t.dst = (bf16_t*)(ws + O_WINT) + (size_t)wrow * 1024; t.ldd = 1024; return t; }
  j -= 9;
  if (j == 1) { t.src = p.w_merge + (size_t)l * 1024 * 4096; t.K = 1024; t.N = 4096; t.lds = 4096; t.dst = (bf16_t*)(ws + O_WMT); t.ldd = 1024; t.perm = 1; }
  else if (j < 6) { int n = j - 2; t.src = p.w_branch + ((size_t)l * 4 + n) * 512 * 1024; t.K = 512; t.N = 1024; t.lds = 1024; t.dst = (bf16_t*)(ws + O_WBRT) + (size_t)n * 1024 * 512; t.ldd = 512; }
  else if (j == 6) { t.src = p.w_out + (size_t)l * 1024 * 1024; t.K = 1024; t.N = 1024; t.lds = 1024; t.dst = (bf16_t*)(ws + O_WOUTT); t.ldd = 1024; }
  else if (j == 7) { t.src = p.w_q_up + (size_t)l * 256 * 768; t.K = 256; t.N = 768; t.lds = 768; t.dst = (bf16_t*)(ws + O_WQT); t.ldd = 256; }
  else if (j == 8) { t.src = p.w_kv_up + (size_t)l * 128 * 1024; t.K = 128; t.N = 1024; t.lds = 1024; t.dst = (bf16_t*)(ws + O_WKVT); t.ldd = 128; }
  else { int n = j - 9;
    t.src = (n < 2 ? p.w_up : p.a_up) + ((size_t)l * 2 + (n & 1)) * 64 * 512; t.K = 64; t.N = 512; t.lds = 512;
    t.dst = (bf16_t*)(ws + O_WUPT) + (size_t)n * 512 * 64; t.ldd = 64; }
  return t;
}
constexpr int NTJOBS = 22;

__device__ __forceinline__ void stage_prep(const Params& p, int l, int bid, int nb, char* smem) {
  const int tid = my_tid();
  char* ws = p.ws;
  {
    float* tile = (float*)smem;
    int total = 0;
    for (int j = 0; j < NTJOBS; ++j) { TJob t = get_tjob(p, l, j); total += (t.K / 64) * ((t.N + 63) / 64); }
    f4v pre[2]; bool pv[2];
    auto locate = [&](int q, TJob& t, int& kt, int& nt_) { int base = 0;
      for (int j = 0; j < NTJOBS; ++j) { t = get_tjob(p, l, j); int tn = (t.N + 63) / 64, nt = (t.K / 64) * tn; if (q < base + nt) { int r = q - base; kt = r / tn; nt_ = r % tn; return; } base += nt; } };
    auto issue = [&](int q) { TJob t; int kt = 0, nt_ = 0; locate(q, t, kt, nt_);
#pragma unroll
      for (int i = 0; i < 2; ++i) { int e = tid + NTHR * i, r = e >> 4, c4 = e & 15; int n0 = nt_ * 64 + c4 * 4; pv[i] = n0 < t.N;
        pre[i] = pv[i] ? *(const f4v*)(t.src + (long)(kt * 64 + r) * t.lds + n0) : f4v{0.f, 0.f, 0.f, 0.f}; } };
    if (bid < total) issue(bid);
    for (int q = bid; q < total; q += nb) {
      TJob t; int kt = 0, nt_ = 0; locate(q, t, kt, nt_);
      __syncthreads();
#pragma unroll
      for (int i = 0; i < 2; ++i) { int e = tid + NTHR * i, r = e >> 4, c4 = e & 15;
        tile[r * 65 + c4 * 4] = pre[i][0]; tile[r * 65 + c4 * 4 + 1] = pre[i][1]; tile[r * 65 + c4 * 4 + 2] = pre[i][2]; tile[r * 65 + c4 * 4 + 3] = pre[i][3]; }
      __syncthreads();
      if (q + nb < total) issue(q + nb);
      { int n = tid >> 3, kc = tid & 7; float x[8];
        if (nt_ * 64 + n < t.N) {
#pragma unroll
          for (int e = 0; e < 8; ++e) x[e] = tile[(kc * 8 + e) * 65 + n];
          const int drow = t.perm ? wm_row(nt_ >> 4, (nt_ & 15) * 64 + n) : nt_ * 64 + n;
          *(u4v*)(t.dst + (long)drow * t.ldd + kt * 64 + kc * 8) = pack8(x); } }
    }
    __syncthreads();
  }
  const long gtid = (long)bid * NTHR + tid, gn = (long)nb * NTHR;
  { bf16_t* d = (bf16_t*)(ws + O_WINT) + (size_t)Z1_W * 1024; for (long i = gtid; i < (long)(Z1_WP - Z1_W) * 1024; i += gn) d[i] = 0; }
  { bf16_t* d = (bf16_t*)(ws + O_WS); const float* s = p.g_w_s + (size_t)l * 4 * 128 * 128; for (long i = gtid; i < (long)4 * 128 * 128; i += gn) d[i] = f2bf(s[i]); }
  if (l != 0) return;
  { bf16_t* d = (bf16_t*)(ws + O_CS128);
    for (long i = gtid; i < 256 * 128; i += gn) { int j = (int)(i >> 7), c = (int)(i & 127); int mm = ((j & 127) * c) & 127; float x = 2.0f * mm / 128.f; d[i] = f2bf(j < 128 ? cospif(x) : sinpif(x)); } }
  {
    bf16_t* lut = (bf16_t*)smem;
#pragma unroll 1
    for (int pass = 0; pass < 2; ++pass) {
      const int T = pass ? T_D : T_C; bf16_t* d = (bf16_t*)(ws + (pass ? O_A2D : O_A2C));
      __syncthreads();
      for (int i = tid; i < T; i += NTHR) { float x = 2.0f * (float)i / (float)T; lut[i] = f2bf(cospif(x)); lut[T + i] = f2bf(-sinpif(x)); }
      __syncthreads();
      const long nchunk = (long)T * 2 * T / 8;
      for (long c = gtid; c < nchunk; c += gn) {
        const int tp = (int)(c / (2 * T / 8)), tt0 = (int)(c % (2 * T / 8)) * 8; const int half = tt0 >= T; const int t0 = half ? tt0 - T : tt0;
        int mm = (int)(((long)tp * t0) % T); unsigned short e8[8];
#pragma unroll
        for (int e = 0; e < 8; ++e) { e8[e] = lut[half * T + mm]; mm += tp; if (mm >= T) mm -= T; }
        *(u4v*)(d + c * 8) = u4v{(unsigned)e8[0] | ((unsigned)e8[1] << 16), (unsigned)e8[2] | ((unsigned)e8[3] << 16), (unsigned)e8[4] | ((unsigned)e8[5] << 16), (unsigned)e8[6] | ((unsigned)e8[7] << 16)};
      }
    }
    __syncthreads();
  }
  { float* d = (float*)(ws + O_ROPE);
    for (long i = gtid; i < (long)T_D * 16; i += gn) { int t = (int)(i >> 4), pi = (int)(i & 15); float pos = (pi < 8) ? (float)(t / 64) : (float)(t % 64); float inv = expf(-(float)(pi & 7) * (9.210340371976184f / 8.f)); float a = pos * inv; d[2 * i] = cosf(a); d[2 * i + 1] = sinf(a); } }
  {
    float* sc = (float*)smem;
    float* red = sc + 3 * 1024;
    float* modp = (float*)(ws + O_MOD);
    if (bid < NL * 96) {
      __syncthreads();
      for (int i = tid; i < 3 * 1024; i += NTHR) { int mi = i >> 10, k = i & 1023; sc[i] = siluf_(mi == 0 ? p.c_ctx[k] : p.c[(mi == 2 && NB_D > 1 ? 1024 : 0) + k]); }
      __syncthreads();
    }
    for (int u = bid; u < NL * 96; u += nb) {
      int ll = u / 96, cg = u % 96; int cl = tid & 31, kq = tid >> 5, col = cg * 32 + cl;
      float a0 = 0.f, a1 = 0.f, a2 = 0.f;
      const float* w = p.w_ada + (size_t)ll * 1024 * 3072 + col;
#pragma unroll 16
      for (int k = kq * 64; k < kq * 64 + 64; ++k) {
        float wv = w[(size_t)k * 3072];
        a0 += sc[k] * wv; a1 += sc[1024 + k] * wv; a2 += sc[2048 + k] * wv;
      }
      __syncthreads();
      red[(kq * 3 + 0) * 32 + cl] = a0; red[(kq * 3 + 1) * 32 + cl] = a1; red[(kq * 3 + 2) * 32 + cl] = a2;
      __syncthreads();
      if (tid < 96) { int mi = tid >> 5, cc = tid & 31; float s2 = 0.f;
#pragma unroll
        for (int q8 = 0; q8 < 16; ++q8) s2 += red[(q8 * 3 + mi) * 32 + cc];
        modp[((size_t)ll * 3 + mi) * 3072 + cg * 32 + cc] = s2 + p.b_ada[(size_t)ll * 3072 + cg * 32 + cc]; }
    }
  }
}

__device__ __forceinline__ int mod_index(const Grp& g, int lm) { return g.isden ? 1 + lm / T_D : 0; }

__device__ __forceinline__ void stage_h(const Params& p, const Grp& g, int l, int bid, int nb) {
  const int lane = my_tid() & 63, wid = my_tid() >> 6;
  const float* X = l ? p.out + (size_t)g.m0 * 1024 : (g.isden ? p.x_sample : p.x_prompt + (size_t)g.m0 * 1024);
  bf16_t* H = (bf16_t*)(p.ws + O_H);
  const float* modp = (const float*)(p.ws + O_MOD) + (size_t)l * 3 * 3072;
  const float* gam = p.norm_g + (size_t)l * 1024;
  for (int m = bid * NWAVE + wid; m < g.mg; m += nb * NWAVE) {
    const float* xr = X + (size_t)m * 1024; float v[16]; float ss = 0.f;
#pragma unroll
    for (int i = 0; i < 4; ++i) { float4 q = *(const float4*)(xr + i * 256 + lane * 4); v[4 * i] = q.x; v[4 * i + 1] = q.y; v[4 * i + 2] = q.z; v[4 * i + 3] = q.w; ss += q.x * q.x + q.y * q.y + q.z * q.z + q.w * q.w; }
    ss = wave_sum(ss); float rs = rsqrtf(ss * (1.f / 1024.f) + 1e-6f);
    const float* mo = modp + (size_t)mod_index(g, m) * 3072;
#pragma unroll
    for (int i = 0; i < 4; ++i) {
      int c = i * 256 + lane * 4; bf16_t o[4];
#pragma unroll
      for (int e = 0; e < 4; ++e) o[e] = f2bf(v[4 * i + e] * rs * gam[c + e] * (1.f + mo[1024 + c + e]) + mo[c + e]);
      *(u2v*)(H + (size_t)m * 1024 + c) = u2v{(unsigned)o[0] | ((unsigned)o[1] << 16), (unsigned)o[2] | ((unsigned)o[3] << 16)};
    }
  }
}

__device__ __forceinline__ int g1b_blocks(const Grp& g, int nb) { int u = ((g.mg + 255) / 256) * (Z2_W / 256); int h = nb / 2; return u < h ? u : h; }
__device__ __forceinline__ void stage_g1(const Params& p, const Grp& g, int part, int bid, int nb, char* smem) {
  const bf16_t* H = (const bf16_t*)(p.ws + O_H);
  const bf16_t* W = (const bf16_t*)(p.ws + O_WINT) + (part ? (size_t)Z1_WP * 1024 : 0);
  bf16_t* Z = (bf16_t*)(p.ws + O_Z);
  const int NW = part ? Z2_W : Z1_W, NWP = part ? Z2_W : Z1_WP, coff = part ? Z1_W : 0;
  if (part) { nb = g1b_blocks(g, nb); if (bid >= nb) return; }
#ifndef EMU
  if ((g.mg & 255) == 0) {
    pg8::Gemm gm; gm.A = H; gm.Bt = W; gm.M = g.mg; gm.N = NWP; gm.K = 1024;
    pg8::StaticOrder S; S.init(gm.M, gm.N, nb, bid);
    pg8::EpiStore E; E.O = Z; E.ldc = IN_W; E.ncols = NW; E.coff = coff;
    pg8::gemm_phase<pg8::EpiStore, pg8::StaticOrder>((PG8_LAS unsigned char*)smem, gm, S, E);
    return;
  }
#endif
  const int TM = (g.mg + 127) / 128, TN = (NW + 127) / 128;
  const int mg = g.mg;
  for (int t = bid; t < TM * TN; t += nb) {
    int tn = t / TM, tm = t % TM; f4v acc[2][4]; zero_acc<4>(acc);
    gemm_mainloop<4>(H, 1024, tm * 128, mg, W, 1024, tn * 128, NWP, 1024, smem, acc);
    epi_foreach<4>(acc, tm * 128, tn * 128, [&](int row, int c0, f4v& v) {
      if (c0 < NW && row < mg) *(u2v*)(Z + (size_t)row * IN_W + coff + c0) = pack4(v[0], v[1], v[2], v[3]);
    });
  }
}

__device__ __forceinline__ void stage_e1(const Params& p, const Grp& g, int l, int bid, int nb) {
  { const int nbA = g1b_blocks(g, nb); if (bid < nbA) return; bid -= nbA; nb -= nbA; }
  const int lane = my_tid() & 63, wid = my_tid() >> 6;
  char* ws = p.ws;
  const bf16_t* Z = (const bf16_t*)(ws + O_Z);
  bf16_t* SK = (bf16_t*)(ws + O_SK); bf16_t* SOP = (bf16_t*)(ws + O_SOP);
  bf16_t* LORA = (bf16_t*)(ws + O_LORA); bf16_t* QDN = (bf16_t*)(ws + O_QDN); bf16_t* CKV = (bf16_t*)(ws + O_CKV); bf16_t* KR = (bf16_t*)(ws + O_KR);
  bf16_t* VCN = (bf16_t*)(ws + O_VCNT);
  const float* rope = (const float*)(ws + O_ROPE);
  const float* mu = p.shift_mu + (size_t)l * SHIFT_W;
  const int isden = g.isden, T = g.T;
  for (int m = bid * NWAVE + wid; m < g.mkv; m += nb * NWAVE) {
    if (m >= g.mg) {
      int r = m - g.mg, b = r / PAST, j = r % PAST;
      if (lane < 20) {
        const float* s = lane < 16 ? p.c_ckv + (((size_t)b * NL + l) * PAST + j) * 128 + lane * 8 : p.c_kr + (((size_t)b * NL + l) * PAST + j) * 32 + (lane - 16) * 8;
        f4v x0 = *(const f4v*)s, x1 = *(const f4v*)(s + 4); float x[8] = {x0[0], x0[1], x0[2], x0[3], x1[0], x1[1], x1[2], x1[3]};
        if (lane < 16) *(u4v*)(CKV + (size_t)m * 128 + lane * 8) = pack8(x);
        else { const int key = T + j, d8 = lane - 16;
          *(u4v*)(KR + ((((size_t)b * (g.nkeys >> 5) + (key >> 5)) * 2 + (d8 >> 1)) * 64 + (d8 & 1) * 32 + (key & 31)) * 8) = pack8(x); }
      }
      continue;
    }
    const int sq = m / T, t = m % T, b = g.b0 + sq;
    const bf16_t* z = Z + (size_t)m * IN_W;
    const bool hp = t > 0, hn = t < T - 1;
#pragma unroll
    for (int it = 0; it < 4; ++it) {
      const int ci = it * 64 + lane; const bool valid = ci < 216; const int cc = valid ? ci : 0;
      float zc[8], pv[8], nv[8], sf[8];
      unpack8(*(const u4v*)(z + cc * 8), zc);
      if (hp) unpack8(*(const u4v*)(z - IN_W + cc * 8), pv); else { for (int e = 0; e < 8; ++e) pv[e] = 0.f; }
      if (hn) unpack8(*(const u4v*)(z + IN_W + cc * 8), nv); else { for (int e = 0; e < 8; ++e) nv[e] = 0.f; }
      f4v m0 = *(const f4v*)(mu + cc * 8), m1 = *(const f4v*)(mu + cc * 8 + 4);
#pragma unroll
      for (int e = 0; e < 8; ++e) sf[e] = zc[e] + (0.5f * (pv[e] + nv[e]) - zc[e]) * (e < 4 ? m0[e] : m1[e - 4]);
      bf16_t* rec = SOP + (((size_t)sq * 8 + (lane >> 3)) * T + t) * 576 + (lane & 7) * 8;
      if (it == 0) *(u4v*)rec = pack8(sf);
      else if (it == 1) {
        *(u4v*)(SK + (size_t)m * 512 + lane * 8) = pack8(sf);
        f4v k0 = *(const f4v*)(p.k_k + (size_t)l * 512 + lane * 8), k1 = *(const f4v*)(p.k_k + (size_t)l * 512 + lane * 8 + 4);
        float kr[8]; float n2 = 0.f;
#pragma unroll
        for (int e = 0; e < 8; ++e) { kr[e] = sf[e] * (e < 4 ? k0[e] : k1[e - 4]); n2 += kr[e] * kr[e]; }
        n2 = sum_lpr<8>(n2); const float inv = 1.f / fmaxf(sqrtf(n2), 1e-12f);
#pragma unroll
        for (int e = 0; e < 8; ++e) kr[e] *= inv;
        *(u4v*)(rec + 64) = pack8(kr);
      }
      else if (it == 2) *(u4v*)(rec + 128) = pack8(sf);
      else if (valid) {
        if (lane < 16) { for (int e = 0; e < 8; ++e) sf[e] = tanhf_(sf[e]); }
        *(u4v*)(LORA + (size_t)m * 192 + lane * 8) = pack8(sf);
      }
    }
    {
      const int col = lane < 32 ? ZC_QD + lane * 8 : (lane < 48 ? ZC_KVD + (lane - 32) * 8 : ZC_KR + ((lane - 48) & 3) * 8);
      float x[8]; unpack8(*(const u4v*)(z + col), x);
      float ss = 0.f;
#pragma unroll
      for (int e = 0; e < 8; ++e) ss += x[e] * x[e];
      const float t32 = sum_lpr<32>(ss), t16 = sum_lpr<16>(ss);
      if (lane < 32) {
        const float rs = rsqrtf(t32 * (1.f / 256.f) + 1e-6f); const float* gq = p.q_norm + (size_t)l * 256 + lane * 8; float o[8];
#pragma unroll
        for (int e = 0; e < 8; ++e) o[e] = x[e] * rs * gq[e];
        *(u4v*)(QDN + (size_t)m * 256 + lane * 8) = pack8(o);
      } else if (lane < 48) {
        const float rs = rsqrtf(t16 * (1.f / 128.f) + 1e-6f); const float* gk = p.kv_norm + (size_t)l * 128 + (lane - 32) * 8; float o[8];
#pragma unroll
        for (int e = 0; e < 8; ++e) o[e] = x[e] * rs * gk[e];
        *(u4v*)(CKV + (size_t)m * 128 + (lane - 32) * 8) = pack8(o);
        if (!isden) { float* op = p.out + OUT_CKV + (((size_t)b * NL + l) * T_C + t) * 128 + (lane - 32) * 8; *(f4v*)op = f4v{o[0], o[1], o[2], o[3]}; *(f4v*)(op + 4) = f4v{o[4], o[5], o[6], o[7]}; }
      } else if (lane < 52) {
        float o[8];
        if (isden) {
#pragma unroll
          for (int pq = 0; pq < 4; ++pq) { int pi = (lane - 48) * 4 + pq; float cs = rope[((size_t)t * 16 + pi) * 2], sn = rope[((size_t)t * 16 + pi) * 2 + 1];
            o[2 * pq] = x[2 * pq] * cs - x[2 * pq + 1] * sn; o[2 * pq + 1] = x[2 * pq] * sn + x[2 * pq + 1] * cs; }
        } else {
#pragma unroll
          for (int e = 0; e < 8; ++e) o[e] = x[e];
          float* op = p.out + OUT_KR + (((size_t)b * NL + l) * T_C + t) * 32 + (lane - 48) * 8; *(f4v*)op = f4v{x[0], x[1], x[2], x[3]}; *(f4v*)(op + 4) = f4v{x[4], x[5], x[6], x[7]};
        }
        { const int d8 = lane - 48; *(u4v*)(KR + ((((size_t)sq * (g.nkeys >> 5) + (t >> 5)) * 2 + (d8 >> 1)) * 64 + (d8 & 1) * 32 + (t & 31)) * 8) = pack8(o); }
      }
    }
    {
      float v[8]; unpack8(*(const u4v*)(z + ZC_VC + lane * 8), v);
      float s1 = 0.f;
#pragma unroll
      for (int e = 0; e < 8; ++e) { v[e] = geluf_(v[e]); s1 += v[e]; }
      s1 = wave_sum(s1); const float mean = s1 * (1.f / 512.f); float s2 = 0.f;
#pragma unroll
      for (int e = 0; e < 8; ++e) { float d = v[e] - mean; s2 += d * d; }
      s2 = wave_sum(s2); const float rs = rsqrtf(s2 * (1.f / 512.f) + 1e-5f);
      const float* gg = p.g_ln_g + (size_t)l * 512 + lane * 8; const float* gb = p.g_ln_b + (size_t)l * 512 + lane * 8;
#pragma unroll
      for (int e = 0; e < 8; ++e) v[e] = (v[e] - mean) * rs * gg[e] + gb[e];
      *(u4v*)(VCN + (size_t)m * 512 + lane * 8) = pack8(v);
    }
  }
}

__device__ __forceinline__ void stage_g2(const Params& p, const Grp& g, int l, int bid, int nb, char* smem) {
  char* ws = p.ws;
  const bf16_t* Z = (const bf16_t*)(ws + O_Z);
  const float* rope = (const float*)(ws + O_ROPE);
  const int mg = g.mg, mkv = g.mkv, T = g.T, isden = g.isden, nkeys = g.nkeys;
  const int TM_M = (mg + 127) / 128, TM_KV = (mkv + 127) / 128;
  const int NT_Q = TM_M * 6, NT_KV = TM_KV * 8, NT_LORA = TM_M * 8, NT_GM = (mg / 128) * 8, ntt = T / 128, NT_D1 = g.nseq * 8 * ntt;
  const int NT = NT_Q + NT_KV + NT_LORA + NT_GM + NT_D1;
  for (int t0 = bid; t0 < NT; t0 += nb) {
    int t = t0; f4v acc[2][4]; zero_acc<4>(acc);
    if (t < NT_Q) {
      int tn = t / TM_M, tm = t % TM_M;
      gemm_mainloop<4>((const bf16_t*)(ws + O_QDN), 256, tm * 128, mg, (const bf16_t*)(ws + O_WQT), 256, tn * 128, 768, 256, smem, acc);
      bf16_t* Q = (bf16_t*)(ws + O_Q);
      const float scale = 0.10206207261596575f * 1.4426950408889634f;
      epi_foreach<4>(acc, tm * 128, tn * 128, [&](int row, int c0, f4v& v) {
        if (row >= mg) return;
        int cw = c0 % 96; float o0 = v[0], o1 = v[1], o2 = v[2], o3 = v[3];
        if (cw >= 64 && isden) { int tt = row % T_D; int pi = (cw - 64) >> 1; const float* rp = rope + ((size_t)tt * 16 + pi) * 2;
          float c_a = rp[0], s_a = rp[1], c_b = rp[2], s_b = rp[3];
          o0 = v[0] * c_a - v[1] * s_a; o1 = v[0] * s_a + v[1] * c_a; o2 = v[2] * c_b - v[3] * s_b; o3 = v[2] * s_b + v[3] * c_b; }
        *(u2v*)(Q + (size_t)row * 768 + c0) = pack4(o0 * scale, o1 * scale, o2 * scale, o3 * scale);
      });
      continue;
    }
    t -= NT_Q;
    if (t < NT_KV) {
      int tn = t / TM_KV, tm = t % TM_KV;
      gemm_mainloop<4>((const bf16_t*)(ws + O_CKV), 128, tm * 128, mkv, (const bf16_t*)(ws + O_WKVT), 128, tn * 128, 1024, 128, smem, acc);
      bf16_t* KN = (bf16_t*)(ws + O_KN); bf16_t* VT = (bf16_t*)(ws + O_VT);
      bf16_t* sT = (bf16_t*)smem;
      __syncthreads();
      epi_foreach<4>(acc, 0, 0, [&](int row, int c0, f4v& v) { *(u2v*)(sT + row * 136 + c0) = pack4(v[0], v[1], v[2], v[3]); });
      __syncthreads();
      { const int tid = my_tid(), ntile = nkeys >> 5, h = tn;
#pragma unroll 1
        for (int q4 = 0; q4 < 4; ++q4) {
          const int item = tid + NTHR * q4;
          const int part = item >> 10, kt4 = (item >> 8) & 3, fr = (item >> 6) & 3, ln = item & 63, lq = ln & 31, lh = ln >> 5;
          const int r0 = tm * 128 + kt4 * 32;
          if (r0 < mkv) {
            int sq, key0; if (r0 < mg) { sq = r0 / T; key0 = r0 % T; } else { int r = r0 - mg; sq = r / PAST; key0 = T + r % PAST; }
            const size_t tb = (((size_t)sq * 8 + h) * ntile + (key0 >> 5)) * 4 + fr;
            if (part == 0) {
              *(u4v*)(KN + (tb * 64 + ln) * 8) = *(const u4v*)(sT + (kt4 * 32 + lq) * 136 + 16 * fr + 8 * lh);
            } else {
              const int st = fr >> 1, db = fr & 1; unsigned short e8[8];
#pragma unroll
              for (int j = 0; j < 8; ++j) e8[j] = sT[(kt4 * 32 + 16 * st + 8 * (j >> 2) + 4 * lh + (j & 3)) * 136 + 64 + db * 32 + lq];
              *(u4v*)(VT + (tb * 64 + ln) * 8) = u4v{(unsigned)e8[0] | ((unsigned)e8[1] << 16), (unsigned)e8[2] | ((unsigned)e8[3] << 16), (unsigned)e8[4] | ((unsigned)e8[5] << 16), (unsigned)e8[6] | ((unsigned)e8[7] << 16)};
            }
          }
        }
      }
      continue;
    }
    t -= NT_KV;
    if (t < NT_LORA) {
      int dir = t / (TM_M * 4), r = t % (TM_M * 4), tn = r / TM_M, tm = r % TM_M;
      f4v aa[2][4]; zero_acc<4>(aa);
      { GT d1 = mk_gt((const bf16_t*)(ws + O_LORA) + dir * 64, 192, tm * 128, mg, (const bf16_t*)(ws + O_WUPT) + (size_t)dir * 512 * 64, 64, tn * 128, 512, 64);
        GT d2 = mk_gt((const bf16_t*)(ws + O_LORA) + 128, 192, tm * 128, mg, (const bf16_t*)(ws + O_WUPT) + (size_t)(2 + dir) * 512 * 64, 64, tn * 128, 512, 64);
        u4v ra[2], rb[2]; gemm_prefetch<4>(d1, ra, rb);
        gemm_run<4, false>(d1, &d2, ra, rb, smem, acc);
        gemm_run<4, false>(d2, nullptr, ra, rb, smem, aa); }
      bf16_t* sW = (bf16_t*)smem; bf16_t* sA2 = sW + 128 * 136;
      __syncthreads();
      epi_foreach<4>(acc, 0, 0, [&](int row, int c0, f4v& v) { *(u2v*)(sW + row * 136 + c0) = pack4(v[0], v[1], v[2], v[3]); });
      epi_foreach<4>(aa, 0, 0, [&](int row, int c0, f4v& v) { *(u2v*)(sA2 + row * 136 + c0) = pack4(v[0], v[1], v[2], v[3]); });
      __syncthreads();
      const bf16_t* SK = (const bf16_t*)(ws + O_SK); bf16_t* SOP = (bf16_t*)(ws + O_SOP); float* BON = (float*)(ws + O_BON);
      const int tid = my_tid();
#pragma unroll 1
      for (int q4 = 0; q4 < 4; ++q4) {
        const int item = tid + NTHR * q4, rowl = item >> 4, ch8 = item & 15;
        int row = tm * 128 + rowl; const bool ok = row < mg; if (!ok) row = mg - 1;
        const int h = tn * 2 + (ch8 >> 3), chn = (ch8 & 7) * 8, c = h * 64 + chn;
        const int sq = row / T, tt = row % T;
        bf16_t* rec = SOP + (((size_t)sq * 8 + h) * T + tt) * 576;
        float pw[8], pa[8], kv[8], kkv[8], rv[8];
        unpack8(*(const u4v*)(sW + rowl * 136 + ch8 * 8), pw); unpack8(*(const u4v*)(sA2 + rowl * 136 + ch8 * 8), pa);
        unpack8(*(const u4v*)(SK + (size_t)row * 512 + c), kv); unpack8(*(const u4v*)(rec + 64 + chn), kkv); unpack8(*(const u4v*)(rec + chn), rv);
        const float* w0 = p.w0 + ((size_t)l * 2 + dir) * 512 + c; const float* a0 = p.a0 + ((size_t)l * 2 + dir) * 512 + c;
        const float* k_a = p.k_a + (size_t)l * 512 + c; const float* r_k = p.r_k + (size_t)l * 512 + c;
        float dd[8], bb[8], kt[8]; float bon = 0.f;
#pragma unroll
        for (int e = 0; e < 8; ++e) {
          dd[e] = 1.f - fexp_(-0.6065306597126334f * sigmoidf_(pw[e] + w0[e]));
          const float av = sigmoidf_(pa[e] + a0[e]);
          bb[e] = kkv[e] * av; kt[e] = kv[e] * (1.f + (av - 1.f) * k_a[e]);
          bon += rv[e] * kt[e] * r_k[e];
        }
        if (ok) { *(u4v*)(rec + (3 + 3 * dir) * 64 + chn) = pack8(dd); *(u4v*)(rec + (4 + 3 * dir) * 64 + chn) = pack8(bb); *(u4v*)(rec + (5 + 3 * dir) * 64 + chn) = pack8(kt); }
        bon = sum_lpr<8>(bon);
        if (ok && (ch8 & 7) == 0) BON[((size_t)row * 8 + h) * 2 + dir] = bon;
      }
      continue;
    }
    t -= NT_LORA;
    if (t < NT_GM) {
      int ch = t >> 3, gg = (t >> 1) & 3, dh = t & 1;
      f4v ac2[2][2]; zero_acc<2>(ac2);
      gemm_mainloop<2, true>((const bf16_t*)(ws + O_WS) + (size_t)gg * 128 * 128, 128, 0, 128, (const bf16_t*)(ws + O_VCNT) + (size_t)ch * 128 * 512, 512, gg * 128 + dh * 64, 512, 128, smem, ac2);
      bf16_t* O = (bf16_t*)(ws + O_OBR) + (size_t)2 * MG * 512;
      const float* bs = p.g_b_s + ((size_t)l * 4 + gg) * 128;
      epi_foreach<2>(ac2, 0, dh * 64, [&](int pp, int c0, f4v& v) {
        int m = ch * 128 + pp; int c = gg * 128 + c0; float bb = bs[pp];
        u2v uu = *(const u2v*)(Z + (size_t)m * IN_W + ZC_U + c), gc = *(const u2v*)(Z + (size_t)m * IN_W + ZC_GC + c);
        *(u2v*)(O + (size_t)m * 512 + c) = pack4(geluf_(bflo(uu.x)) * (v[0] + bb) * siluf_(bflo(gc.x)), geluf_(bfhi(uu.x)) * (v[1] + bb) * siluf_(bfhi(gc.x)),
                                                 geluf_(bflo(uu.y)) * (v[2] + bb) * siluf_(bflo(gc.y)), geluf_(bfhi(uu.y)) * (v[3] + bb) * siluf_(bfhi(gc.y)));
      });
      continue;
    }
    t -= NT_GM;
    {
      int per_seq = 8 * ntt; int sq = t / per_seq; int r = t % per_seq; int gg = r / (2 * ntt); int r2 = r % (2 * ntt); int tj = r2 / ntt, tt = r2 % ntt;
      long mbase = (long)sq * T;
      gemm_mainloop<4>((const bf16_t*)(ws + O_CS128), 128, tj * 128, 256, Z + (size_t)mbase * IN_W + ZC_F + gg * 128, IN_W, tt * 128, T, 128, smem, acc);
      bf16_t* YT = (bf16_t*)(ws + O_YT) + (size_t)mbase * 1024 + (size_t)gg * 128 * 2 * T;
      epi_foreach<4>(acc, tj * 128, tt * 128, [&](int j, int c0, f4v& v) {
        *(u2v*)(YT + (size_t)(j & 127) * 2 * T + (size_t)(j >> 7) * T + c0) = pack4(v[0], v[1], v[2], v[3]);
      });
    }
  }
}

__device__ __forceinline__ bool wave_any(bool pr) {
#ifdef EMU
  return wave_sum(pr ? 1.f : 0.f) > 0.f;
#else
  return __builtin_amdgcn_ballot_w64(pr) != 0ull;
#endif
}
__device__ __forceinline__ void attention_task(const Params& p, const Grp& g, int sq, int h, int qb32) {
  char* ws = p.ws;
  const int lane = my_tid() & 63, ql = lane & 31, hh = lane >> 5;
  const int T = g.T, nkeys = g.nkeys;
  const long mbase = (long)sq * T;
  const bf16_t* Q = (const bf16_t*)(ws + O_Q); const bf16_t* KN = (const bf16_t*)(ws + O_KN); const bf16_t* KRp = (const bf16_t*)(ws + O_KR);
  const int ntile = nkeys >> 5;
  const bf16_t* KFb = KN + ((size_t)sq * 8 + h) * ntile * 4 * 512 + lane * 8;
  const bf16_t* KRb = KRp + (size_t)sq * ntile * 2 * 512 + lane * 8;
  const bf16_t* VFb = (const bf16_t*)(ws + O_VT) + ((size_t)sq * 8 + h) * ntile * 4 * 512 + lane * 8;
  const long mq = mbase + qb32 * 32 + ql;
  s8v qf[6];
#pragma unroll
  for (int s = 0; s < 6; ++s) qf[s] = *(const s8v*)(Q + (size_t)mq * 768 + h * 96 + 16 * s + 8 * hh);
  f16v o0, o1;
#pragma unroll
  for (int i = 0; i < 16; ++i) { o0[i] = 0.f; o1[i] = 0.f; }
  float mrun = -1e30f, lrun = 0.f;
  s8v kfA[6], vfA[4], kfB[6], vfB[4];
#define ATT_LOAD(k0_, KF, VF) do { const int tl = (k0_) >> 5; \
    _Pragma("unroll") for (int st = 0; st < 4; ++st) KF[st] = *(const s8v*)(KFb + (size_t)(tl * 4 + st) * 512); \
    _Pragma("unroll") for (int st = 0; st < 2; ++st) KF[4 + st] = *(const s8v*)(KRb + (size_t)(tl * 2 + st) * 512); \
    _Pragma("unroll") for (int q = 0; q < 4; ++q) VF[q] = *(const s8v*)(VFb + (size_t)(tl * 4 + q) * 512); } while (0)
#define ATT_TILE(KF, VF) do { \
    f16v s; _Pragma("unroll") for (int i = 0; i < 16; ++i) s[i] = 0.f; \
    _Pragma("unroll") for (int st = 0; st < 6; ++st) s = __builtin_amdgcn_mfma_f32_32x32x16_bf16(KF[st], qf[st], s, 0, 0, 0); \
    float mx = s[0]; _Pragma("unroll") for (int i = 1; i < 16; ++i) mx = fmaxf(mx, s[i]); \
    mx = fmaxf(mx, __shfl_xor(mx, 32)); \
    if (wave_any(mx > mrun)) { const float mnew = fmaxf(mrun, mx); const float alpha = fexp2_(mrun - mnew); mrun = mnew; lrun *= alpha; \
      _Pragma("unroll") for (int i = 0; i < 16; ++i) { o0[i] *= alpha; o1[i] *= alpha; } } \
    float ps = 0.f; float pe[16]; \
    _Pragma("unroll") for (int i = 0; i < 16; ++i) { pe[i] = fexp2_(s[i] - mrun); ps += pe[i]; } \
    lrun += ps; \
    _Pragma("unroll") for (int st = 0; st < 2; ++st) { \
      const s8v pf = __builtin_bit_cast(s8v, u4v{pk2bf(pe[8 * st], pe[8 * st + 1]), pk2bf(pe[8 * st + 2], pe[8 * st + 3]), pk2bf(pe[8 * st + 4], pe[8 * st + 5]), pk2bf(pe[8 * st + 6], pe[8 * st + 7])}); \
      o0 = __builtin_amdgcn_mfma_f32_32x32x16_bf16(VF[st * 2], pf, o0, 0, 0, 0); \
      o1 = __builtin_amdgcn_mfma_f32_32x32x16_bf16(VF[st * 2 + 1], pf, o1, 0, 0, 0); } } while (0)
  ATT_LOAD(0, kfA, vfA);
  int k0 = 0;
  for (; k0 + 64 <= nkeys; k0 += 64) {
    ATT_LOAD(k0 + 32, kfB, vfB); SCHED_FENCE();
    ATT_TILE(kfA, vfA); SCHED_FENCE();
    ATT_LOAD((k0 + 64 < nkeys) ? k0 + 64 : nkeys - 32, kfA, vfA); SCHED_FENCE();
    ATT_TILE(kfB, vfB); SCHED_FENCE();
  }
  if (k0 < nkeys) ATT_TILE(kfA, vfA);
#undef ATT_LOAD
#undef ATT_TILE
  const float ltot = lrun + __shfl_xor(lrun, 32); const float inv = 1.f / ltot;
  const bf16_t* Z = (const bf16_t*)(ws + O_Z);
  bf16_t* O = (bf16_t*)(ws + O_OBR) + (size_t)1 * MG * 512;
#pragma unroll
  for (int db = 0; db < 2; ++db)
#pragma unroll
    for (int q4 = 0; q4 < 4; ++q4) {
      const int dv = db * 32 + 8 * q4 + 4 * hh;
      u2v gt = *(const u2v*)(Z + (size_t)mq * IN_W + ZC_GB + h * 64 + dv);
      const float x0 = (db == 0 ? o0[4 * q4] : o1[4 * q4]) * inv, x1 = (db == 0 ? o0[4 * q4 + 1] : o1[4 * q4 + 1]) * inv, x2 = (db == 0 ? o0[4 * q4 + 2] : o1[4 * q4 + 2]) * inv, x3 = (db == 0 ? o0[4 * q4 + 3] : o1[4 * q4 + 3]) * inv;
      *(u2v*)(O + (size_t)mq * 512 + h * 64 + dv) = pack4(x0 * siluf_(bflo(gt.x)), x1 * siluf_(bfhi(gt.x)), x2 * siluf_(bflo(gt.y)), x3 * siluf_(bfhi(gt.y)));
    }
}

__device__ __forceinline__ void stage_dft2(const Params& p, const Grp& g, int bid, int nb, char* smem) {
  char* ws = p.ws;
  const bf16_t* Z = (const bf16_t*)(ws + O_Z);
  const int T = g.T, ntt = T / 128;
  const int NT_D2 = g.nseq * 4 * ntt;
  const int soff = (g.nseq * 32) % nb;
  for (int t = (bid - soff + nb) % nb; t < NT_D2; t += nb) {
    int sq = t / (4 * ntt), r = t % (4 * ntt), gg = r / ntt, tt = r % ntt;
    long mbase = (long)sq * T;
    f4v acc[2][4]; zero_acc<4>(acc);
    { GT d = mk_gt((const bf16_t*)(ws + (g.isden ? O_A2D : O_A2C)), 2 * T, tt * 128, T, (const bf16_t*)(ws + O_YT) + (size_t)mbase * 1024 + (size_t)gg * 128 * 2 * T, 2 * T, 0, 128, 2 * T); gemm_deep<4>(d, smem, acc); }
    bf16_t* O = (bf16_t*)(ws + O_OBR) + (size_t)3 * MG * 512;
    const float sc = rsqrtf(128.f * (float)T);
    epi_foreach<4>(acc, tt * 128, 0, [&](int row, int c0, f4v& v) {
      long m = mbase + row; int c = gg * 128 + c0; u2v gd = *(const u2v*)(Z + (size_t)m * IN_W + ZC_GD + c);
      *(u2v*)(O + (size_t)m * 512 + c) = pack4(v[0] * sc * siluf_(bflo(gd.x)), v[1] * sc * siluf_(bfhi(gd.x)), v[2] * sc * siluf_(bflo(gd.y)), v[3] * sc * siluf_(bfhi(gd.y)));
    });
  }
}

constexpr int PL_STR = 72;
constexpr int PCH_MA = 0, PCH_MB = 4608, PCH_TBT = 9216, PCH_MBT = 10240, PCH_TK = 11264, PCH_MK = 12288, PCH_LDS = 13312;
__device__ __forceinline__ void pchunk_task(const Params& p, const Grp& g, int task, char* wl) {
  char* ws = p.ws;
  const int lane = my_tid() & 63, ql = lane & 31, hh = lane >> 5;
  const int T = g.T, nch = T >> 4;
  const int ch = task / nch, ci = task % nch;
  const int dir = ch & 1, h = (ch >> 1) & 7, sq = ch >> 4;
  const bf16_t* rec0 = (const bf16_t*)(ws + O_SOP) + ((size_t)sq * 8 + h) * T * 576;
  char* cm = ws + O_CM + (size_t)task * CM_REC;
  float At[16], Rt[16], Bh[16], Kh[16]; float W = 1.f;
#pragma unroll
  for (int j = 0; j < 16; ++j) {
    const int st = ci * 16 + j, tt = dir ? T - 1 - st : st;
    const bf16_t* rec = rec0 + (size_t)tt * 576;
    const float r = bf2f(rec[lane]), kk = bf2f(rec[64 + lane]), d = bf2f(rec[(3 + 3 * dir) * 64 + lane]), b = bf2f(rec[(4 + 3 * dir) * 64 + lane]), kt = bf2f(rec[(5 + 3 * dir) * 64 + lane]);
    At[j] = -kk * W; W *= (1.f - d); const float iw = frcp_(W); Rt[j] = r * W; Bh[j] = b * iw; Kh[j] = kt * iw;
  }
  {
    float x[8];
#pragma unroll
    for (int q = 0; q < 2; ++q) {
#pragma unroll
      for (int e = 0; e < 8; ++e) { const int st = ci * 16 + q * 8 + e, tt = dir ? T - 1 - st : st; x[e] = bf2f(rec0[(size_t)tt * 576 + 128 + lane]); }
      *(u4v*)(cm + CM_VT + (((lane >> 5) * 64 + q * 32 + (lane & 31)) * 16)) = pack8(x);
    }
  }
  {
    float x[8];
    const int k2 = lane >> 5, kq = lane & 31;
#pragma unroll
    for (int hq = 0; hq < 2; ++hq) {
#pragma unroll
      for (int e = 0; e < 8; ++e) x[e] = Bh[8 * (e >> 2) + 4 * hq + (e & 3)] * W;
      *(u4v*)(cm + CM_BKT + (((k2 * 2 + 0) * 64 + hq * 32 + kq) * 16)) = pack8(x);
#pragma unroll
      for (int e = 0; e < 8; ++e) x[e] = Kh[8 * hq + e] * W;
      *(u4v*)(cm + CM_BKT + (((k2 * 2 + 1) * 64 + hq * 32 + kq) * 16)) = pack8(x);
    }
    *(float*)(cm + CM_WL + lane * 4) = W;
  }
  bf16_t* MA = (bf16_t*)(wl + PCH_MA); bf16_t* MB = (bf16_t*)(wl + PCH_MB);
  float* TBT = (float*)(wl + PCH_TBT); float* MBT = (float*)(wl + PCH_MBT); float* TK = (float*)(wl + PCH_TK); float* MK = (float*)(wl + PCH_MK);
  WAVE_SYNC();
#pragma unroll
  for (int j = 0; j < 16; ++j) { MA[j * PL_STR + lane] = f2bf(Bh[j]); MA[(16 + j) * PL_STR + lane] = f2bf(Kh[j]); MB[j * PL_STR + lane] = f2bf(At[j]); MB[(16 + j) * PL_STR + lane] = f2bf(Rt[j]); }
  WAVE_SYNC();
  f16v D;
#pragma unroll
  for (int i = 0; i < 16; ++i) D[i] = 0.f;
#pragma unroll
  for (int s4 = 0; s4 < 4; ++s4) {
    const s8v fa = *(const s8v*)(MA + ql * PL_STR + 16 * s4 + 8 * hh), fb = *(const s8v*)(MB + ql * PL_STR + 16 * s4 + 8 * hh);
    D = __builtin_amdgcn_mfma_f32_32x32x16_bf16(fa, fb, D, 0, 0, 0);
  }
#pragma unroll
  for (int r = 0; r < 16; ++r) {
    const int i = (r & 3) + 8 * (r >> 2) + 4 * hh; const float v = D[r];
    if (r < 8) { if (ql < 16) TBT[ql * 16 + i] = (i < ql) ? v : 0.f; else MBT[(ql - 16) * 16 + i] = (i <= ql - 16) ? v : 0.f; }
    else { const int i2 = i - 16; if (ql < 16) TK[i2 * 16 + ql] = (i2 < ql) ? v : 0.f; else MK[i2 * 16 + (ql - 16)] = (i2 <= ql - 16) ? v : 0.f; }
  }
  WAVE_SYNC();
  const int l16 = lane & 15;
  float Z[16], Z2[16];
#pragma unroll
  for (int j = 0; j < 16; ++j) { Z[j] = 0.f; Z2[j] = 0.f; }
#pragma unroll
  for (int j = 0; j < 16; ++j) {
    float a1 = At[j], a2 = TK[l16 * 16 + j];
#pragma unroll
    for (int c4 = 0; c4 * 4 < j; ++c4) { const f4v tv = *(const f4v*)(TBT + j * 16 + c4 * 4);
#pragma unroll
      for (int e = 0; e < 4; ++e) if (c4 * 4 + e < j) { a1 += Z[c4 * 4 + e] * tv[e]; a2 += Z2[c4 * 4 + e] * tv[e]; } }
    Z[j] = a1; Z2[j] = a2;
  }
  bf16_t* GL = (bf16_t*)(wl + PCH_MA);
#pragma unroll
  for (int t = 0; t < 16; ++t) {
    float a1 = Rt[t], a2 = MK[l16 * 16 + t];
#pragma unroll
    for (int c4 = 0; c4 * 4 <= t; ++c4) { const f4v mv = *(const f4v*)(MBT + t * 16 + c4 * 4);
#pragma unroll
      for (int e = 0; e < 4; ++e) if (c4 * 4 + e <= t) { a1 += Z[c4 * 4 + e] * mv[e]; a2 += Z2[c4 * 4 + e] * mv[e]; } }
    GL[(16 + t) * 88 + lane] = f2bf(a1);
    if (lane < 16) GL[(16 + t) * 88 + 64 + lane] = f2bf(a2);
  }
#pragma unroll
  for (int j = 0; j < 16; ++j) { GL[j * 88 + lane] = f2bf(Z[j]); if (lane < 16) GL[j * 88 + 64 + lane] = f2bf(Z2[j]); }
  WAVE_SYNC();
  { const bf16_t* gr = GL + ql * 88;
#pragma unroll
    for (int s4 = 0; s4 < 4; ++s4) { const u2v lo = *(const u2v*)(gr + 16 * s4 + 4 * hh), hi = *(const u2v*)(gr + 16 * s4 + 8 + 4 * hh);
      *(u4v*)(cm + CM_GT + (s4 * 64 + lane) * 16) = u4v{lo.x, lo.y, hi.x, hi.y}; }
    *(u4v*)(cm + CM_GT + (4 * 64 + lane) * 16) = *(const u4v*)(gr + 64 + 8 * hh);
  }
  WAVE_SYNC();
}

__device__ __forceinline__ s8v cvt8(const f16v& a, int o) {
  return __builtin_bit_cast(s8v, u4v{pk2bf(a[o], a[o + 1]), pk2bf(a[o + 2], a[o + 3]), pk2bf(a[o + 4], a[o + 5]), pk2bf(a[o + 6], a[o + 7])});
}
struct ScanOps { s8v gA[5], bU[2], bV[2], vf; float wreg; };
__device__ __forceinline__ void scan2_load(ScanOps& o, const char* cm, const bf16_t* rec0, int ci, int T, int dir, int ql, int hh, int row) {
  const int lane = hh * 32 + ql, rt = row >> 5;
  o.wreg = *(const float*)(cm + CM_WL + lane * 4);
#pragma unroll
  for (int s = 0; s < 5; ++s) o.gA[s] = *(const s8v*)(cm + CM_GT + (s * 64 + lane) * 16);
#pragma unroll
  for (int k2 = 0; k2 < 2; ++k2) { o.bU[k2] = *(const s8v*)(cm + CM_BKT + ((k2 * 2) * 64 + lane) * 16); o.bV[k2] = *(const s8v*)(cm + CM_BKT + ((k2 * 2 + 1) * 64 + lane) * 16); }
  o.vf = *(const s8v*)(cm + CM_VT + (rt * 64 + lane) * 16);
  (void)rec0; (void)ci; (void)T; (void)dir;
}
__device__ __forceinline__ void scan2_task(const Params& p, const Grp& g, int l, int task, char* wl) {
  char* ws = p.ws;
  const int lane = my_tid() & 63, ql = lane & 31, hh = lane >> 5;
  const int T = g.T, nch = T >> 4;
  const int ch = task >> 1, rt = task & 1;
  const int dir = ch & 1, h = (ch >> 1) & 7, sq = ch >> 4;
  const int row = rt * 32 + ql;
  const long mbase = (long)sq * T;
  const bf16_t* rec0 = (const bf16_t*)(ws + O_SOP) + ((size_t)sq * 8 + h) * T * 576;
  const char* cm0 = ws + O_CM + (size_t)ch * nch * CM_REC;
  float* YS = (float*)(ws + O_YS) + (size_t)dir * MG * 512;
  float* wlf = (float*)wl;
  f16v a0, a1;
  if (g.isden) { const float* st = (dir ? p.st_b : p.st_f) + ((((size_t)sq * NL + l) * 8 + h) * 64 + row) * 64;
#pragma unroll
    for (int q = 0; q < 4; ++q) { f4v x = *(const f4v*)(st + 8 * q + 4 * hh), y = *(const f4v*)(st + 32 + 8 * q + 4 * hh);
#pragma unroll
      for (int e = 0; e < 4; ++e) { a0[4 * q + e] = x[e]; a1[4 * q + e] = y[e]; } } }
  else {
#pragma unroll
    for (int i = 0; i < 16; ++i) { a0[i] = 0.f; a1[i] = 0.f; } }
  ScanOps s0, s1, s2;
  scan2_load(s0, cm0, rec0, 0, T, dir, ql, hh, row);
  scan2_load(s1, cm0 + CM_REC, rec0, 1, T, dir, ql, hh, row);
#define SCAN2_STEP(CUR, ci_) do { const int ci = (ci_); \
    WAVE_SYNC(); wlf[lane] = CUR.wreg; WAVE_SYNC(); \
    const s8v vfrag = CUR.vf; \
    f16v D; _Pragma("unroll") for (int i = 0; i < 16; ++i) D[i] = 0.f; \
    D = __builtin_amdgcn_mfma_f32_32x32x16_bf16(CUR.gA[0], cvt8(a0, 0), D, 0, 0, 0); \
    D = __builtin_amdgcn_mfma_f32_32x32x16_bf16(CUR.gA[1], cvt8(a0, 8), D, 0, 0, 0); \
    D = __builtin_amdgcn_mfma_f32_32x32x16_bf16(CUR.gA[2], cvt8(a1, 0), D, 0, 0, 0); \
    D = __builtin_amdgcn_mfma_f32_32x32x16_bf16(CUR.gA[3], cvt8(a1, 8), D, 0, 0, 0); \
    D = __builtin_amdgcn_mfma_f32_32x32x16_bf16(CUR.gA[4], vfrag, D, 0, 0, 0); \
    _Pragma("unroll") for (int i = 0; i < 8; ++i) { const int st = ci * 16 + (i & 3) + 8 * (i >> 2) + 4 * hh, tt = dir ? T - 1 - st : st; YS[(size_t)(mbase + tt) * 512 + h * 64 + row] = D[8 + i]; } \
    const s8v uf = cvt8(D, 0); \
    const float* wq = wlf + 4 * hh; \
    _Pragma("unroll") for (int q = 0; q < 4; ++q) { const f4v w0 = *(const f4v*)(wq + 8 * q), w1 = *(const f4v*)(wq + 32 + 8 * q); \
      _Pragma("unroll") for (int e = 0; e < 4; ++e) { a0[4 * q + e] *= w0[e]; a1[4 * q + e] *= w1[e]; } } \
    a0 = __builtin_amdgcn_mfma_f32_32x32x16_bf16(CUR.bU[0], uf, a0, 0, 0, 0); \
    a0 = __builtin_amdgcn_mfma_f32_32x32x16_bf16(CUR.bV[0], vfrag, a0, 0, 0, 0); \
    a1 = __builtin_amdgcn_mfma_f32_32x32x16_bf16(CUR.bU[1], uf, a1, 0, 0, 0); \
    a1 = __builtin_amdgcn_mfma_f32_32x32x16_bf16(CUR.bV[1], vfrag, a1, 0, 0, 0); } while (0)
  int c = 0;
  for (; c + 3 <= nch; c += 3) {
    { const int cc = (c + 2 < nch) ? c + 2 : nch - 1; scan2_load(s2, cm0 + (size_t)cc * CM_REC, rec0, cc, T, dir, ql, hh, row); }
    SCHED_FENCE(); SCAN2_STEP(s0, c); SCHED_FENCE();
    { const int cc = (c + 3 < nch) ? c + 3 : nch - 1; scan2_load(s0, cm0 + (size_t)cc * CM_REC, rec0, cc, T, dir, ql, hh, row); }
    SCHED_FENCE(); SCAN2_STEP(s1, c + 1); SCHED_FENCE();
    { const int cc = (c + 4 < nch) ? c + 4 : nch - 1; scan2_load(s1, cm0 + (size_t)cc * CM_REC, rec0, cc, T, dir, ql, hh, row); }
    SCHED_FENCE(); SCAN2_STEP(s2, c + 2); SCHED_FENCE();
  }
  if (c < nch) SCAN2_STEP(s0, c);
  if (c + 1 < nch) SCAN2_STEP(s1, c + 1);
#undef SCAN2_STEP
  if (!g.isden) { float* so = p.out + (dir ? OUT_SB : OUT_SF) + ((((size_t)(g.b0 + sq) * NL + l) * 8 + h) * 64 + row) * 64;
#pragma unroll
    for (int q = 0; q < 4; ++q) { *(f4v*)(so + 8 * q + 4 * hh) = f4v{a0[4 * q], a0[4 * q + 1], a0[4 * q + 2], a0[4 * q + 3]}; *(f4v*)(so + 32 + 8 * q + 4 * hh) = f4v{a1[4 * q], a1[4 * q + 1], a1[4 * q + 2], a1[4 * q + 3]}; } }
}

__device__ __forceinline__ void stage_mixA(const Params& p, const Grp& g, int bid, int nb, char* smem) {
  const int wid = my_tid() >> 6;
  const int NP = g.nseq * 16 * (g.T >> 4), q32 = g.T / 32, NA = g.nseq * 8 * q32;
  char* wl = smem + wid * PCH_LDS;
  for (int task = wid * nb + bid; task < NP + NA; task += nb * NWAVE) {
    if (task < NP) pchunk_task(p, g, task, wl);
    else { int t = task - NP; int sq = t / (8 * q32), r = t % (8 * q32); attention_task(p, g, sq, r / q32, r % q32); }
  }
}
__device__ __forceinline__ void stage_scanS(const Params& p, const Grp& g, int l, int bid, int nb, char* smem) {
  const int wid = my_tid() >> 6;
  const int NS = g.nseq * 32;
  for (int task = wid * nb + bid; task < NS; task += nb * NWAVE) scan2_task(p, g, l, task, smem + wid * 768);
  __syncthreads();
}

__device__ __forceinline__ void stage_e3(const Params& p, const Grp& g, int l, int bid, int nb) {
  const int lane = my_tid() & 63, wid = my_tid() >> 6;
  char* ws = p.ws;
  const float* YS = (const float*)(ws + O_YS); const bf16_t* SOP = (const bf16_t*)(ws + O_SOP); const float* BON = (const float*)(ws + O_BON); const int T = g.T;
  const bf16_t* Z = (const bf16_t*)(ws + O_Z); bf16_t* O = (bf16_t*)(ws + O_OBR);
  const int hd = lane >> 3, c0 = lane * 8;
  const float* lg = p.ln_g + (size_t)l * 512 + c0; const float* lb = p.ln_b + (size_t)l * 512 + c0;
  for (int m = bid * NWAVE + wid; m < g.mg; m += nb * NWAVE) {
    const f4v y0 = *(const f4v*)(YS + (size_t)m * 512 + c0), y1 = *(const f4v*)(YS + (size_t)m * 512 + c0 + 4);
    const f4v z0 = *(const f4v*)(YS + ((size_t)MG + m) * 512 + c0), z1 = *(const f4v*)(YS + ((size_t)MG + m) * 512 + c0 + 4);
    float o[8]; float s1 = 0.f;
#pragma unroll
    for (int e = 0; e < 4; ++e) { o[e] = y0[e] + z0[e]; o[4 + e] = y1[e] + z1[e]; }
#pragma unroll
    for (int e = 0; e < 8; ++e) s1 += o[e];
    const float mean = sum_lpr<8>(s1) * (1.f / 64.f); float s2 = 0.f;
#pragma unroll
    for (int e = 0; e < 8; ++e) { o[e] -= mean; s2 += o[e] * o[e]; }
    const float rs = rsqrtf(sum_lpr<8>(s2) * (1.f / 64.f) + 64e-5f);
    const float bon = BON[((size_t)m * 8 + hd) * 2] + BON[((size_t)m * 8 + hd) * 2 + 1];
    float v[8], ga[8];
    unpack8(*(const u4v*)(SOP + (((size_t)(m / T) * 8 + hd) * T + (m % T)) * 576 + 128 + (lane & 7) * 8), v);
    unpack8(*(const u4v*)(Z + (size_t)m * IN_W + ZC_GA + c0), ga);
    float r[8];
#pragma unroll
    for (int e = 0; e < 8; ++e) r[e] = (o[e] * rs * lg[e] + lb[e] + bon * v[e]) * siluf_(ga[e]);
    *(u4v*)(O + (size_t)m * 512 + c0) = pack8(r);
  }
}

__device__ __forceinline__ void stage_proj(const Params& p, const Grp& g, int bid, int nb, char* smem) {
  char* ws = p.ws;
  bf16_t* PJ = (bf16_t*)(ws + O_GATES);
  const int mg = g.mg;
#ifndef EMU
  if ((mg & 255) == 0) {
    pg8::Gemm gm; gm.A = (const bf16_t*)(ws + O_OBR); gm.Bt = (const bf16_t*)(ws + O_WBRT); gm.M = mg; gm.N = 4096; gm.K = 512; gm.abatch = (size_t)MG * 512 * 2; gm.ashift = 2;
    pg8::StaticOrder S; S.init(gm.M, gm.N, nb, bid);
    pg8::EpiStore E; E.O = PJ; E.ldc = 4096; E.ncols = 4096; E.coff = 0;
    pg8::gemm_phase<pg8::EpiStore, pg8::StaticOrder>((PG8_LAS unsigned char*)smem, gm, S, E);
    return;
  }
#endif
  const int TM = (mg + 127) / 128, NT = TM * 32;
  for (int t = bid; t < NT; t += nb) {
    int tn = t / TM, tm = t % TM, n = tn >> 3;
    f4v ap[2][4]; zero_acc<4>(ap);
    GT cur = mk_gt((const bf16_t*)(ws + O_OBR) + (size_t)n * MG * 512, 512, tm * 128, mg, (const bf16_t*)(ws + O_WBRT) + (size_t)n * 1024 * 512, 512, (tn & 7) * 128, 1024, 512);
    gemm_deep<4>(cur, smem, ap);
    epi_foreach<4>(ap, tm * 128, tn * 128, [&](int row, int c0, f4v& v) { if (row < mg) *(u2v*)(PJ + (size_t)row * 4096 + c0) = pack4(v[0], v[1], v[2], v[3]); });
  }
}

__device__ __forceinline__ void stage_merge(const Params& p, const Grp& g, int l, int bid, int nb, char* smem) {
  char* ws = p.ws;
  const bf16_t* H = (const bf16_t*)(ws + O_H); const bf16_t* W = (const bf16_t*)(ws + O_WMT);
  const bf16_t* PJ = (const bf16_t*)(ws + O_GATES); bf16_t* MGD = (bf16_t*)(ws + O_MERGED);
  const float* bm = p.b_merge + (size_t)l * 4096;
  const int mg = g.mg;
#ifndef EMU
  if ((mg & 255) == 0) {
    pg8::Gemm gm; gm.A = H; gm.Bt = W; gm.M = mg; gm.N = 4096; gm.K = 1024;
    pg8::StaticOrder S; S.init(gm.M, gm.N, nb, bid);
    pg8::EpiMerge E; E.MGD = MGD; E.PROJ = PJ; E.bias = bm;
    pg8::gemm_phase<pg8::EpiMerge, pg8::StaticOrder>((PG8_LAS unsigned char*)smem, gm, S, E);
    return;
  }
#endif
  for (long i = (long)bid * NTHR + my_tid(); i < (long)mg * 1024; i += (long)nb * NTHR) {
    const int row = (int)(i >> 10), col = (int)(i & 1023); float sum = 0.f;
    for (int br = 0; br < 4; ++br) {
      const bf16_t* hr = H + (size_t)row * 1024; const bf16_t* wr = W + (size_t)wm_row(br, col) * 1024; float d = 0.f;
      for (int k = 0; k < 1024; ++k) d += bf2f(hr[k]) * bf2f(wr[k]);
      sum += sigmoidf_(d + bm[br * 1024 + col]) * bf2f(PJ[(size_t)row * 4096 + br * 1024 + col]);
    }
    MGD[(size_t)row * 1024 + col] = f2bf(sum);
  }
}

__device__ __forceinline__ void stage_g9(const Params& p, const Grp& g, int l, int bid, int nb, char* smem) {
  char* ws = p.ws;
  float* X = p.out + (size_t)g.m0 * 1024;
  const float* Xin = l ? (const float*)X : (g.isden ? p.x_sample : p.x_prompt + (size_t)g.m0 * 1024);
  const float* modp = (const float*)(ws + O_MOD) + (size_t)l * 3 * 3072 + 2048;
  const int TM = (g.mg + 127) / 128, mg = g.mg, NT = TM * 8;
  auto desc = [&](int t) { int tn = t / TM, tm = t % TM; return mk_gt((const bf16_t*)(ws + O_MERGED), 1024, tm * 128, mg, (const bf16_t*)(ws + O_WOUTT), 1024, tn * 128, 1024, 1024); };
  for (int t = bid; t < NT; t += nb) {
    int tn = t / TM, tm = t % TM;
    f4v acc[2][4]; zero_acc<4>(acc);
    GT cur = desc(t);
    gemm_deep<4>(cur, smem, acc);
    epi_foreach<4>(acc, tm * 128, tn * 128, [&](int row, int c0, f4v& v) {
      if (row < mg) { const float* gt = modp + (size_t)mod_index(g, row) * 3072 + c0; f4v* xp = (f4v*)(X + (size_t)row * 1024 + c0); f4v x = *(const f4v*)(Xin + (size_t)row * 1024 + c0);
        x[0] += gt[0] * v[0]; x[1] += gt[1] * v[1]; x[2] += gt[2] * v[2]; x[3] += gt[3] * v[3]; *xp = x; }
    });
  }
}

__device__ __forceinline__ void stage_final(const Params& p, int bid, int nb) {
  const int lane = my_tid() & 63, wid = my_tid() >> 6;
  for (int m = bid * NWAVE + wid; m < M; m += nb * NWAVE) {
    float* xr = p.out + (size_t)m * 1024; float4 q[4]; float ss = 0.f;
#pragma unroll
    for (int i = 0; i < 4; ++i) { q[i] = *(const float4*)(xr + i * 256 + lane * 4); ss += q[i].x * q[i].x + q[i].y * q[i].y + q[i].z * q[i].z + q[i].w * q[i].w; }
    ss = wave_sum(ss); float rs = rsqrtf(ss * (1.f / 1024.f) + 1e-6f);
#pragma unroll
    for (int i = 0; i < 4; ++i) { int c = i * 256 + lane * 4; float4 gm = *(const float4*)(p.final_g + c);
      *(float4*)(xr + c) = make_float4(q[i].x * rs * gm.x, q[i].y * rs * gm.y, q[i].z * rs * gm.z, q[i].w * rs * gm.w); }
  }
}

#ifdef EMU
#define DECL_SMEM(name) char* name = emu::smem()
#else
#define DECL_SMEM(name) __shared__ __attribute__((aligned(16))) char name[SMEM_BYTES]
#endif

#ifdef EMU
struct GridBar { __device__ void sync() const { emu::grid_sync(); } };
#else
#define XB_TMO      128
#define XB_XCNT(j)  (256  + 64 * (j))
#define XB_XSUB(j)  (1280 + 64 * (j))
#define XB_XGEN(j)  (2304 + 64 * (j))
#define XB_TOP      3328
#define XB_TOPGEN   3392
#define XB_SPIN_CAP (1u << 20)
#define LAS __attribute__((address_space(3)))
__device__ __forceinline__ unsigned xb_ld(unsigned* p)              { return __hip_atomic_load(p, __ATOMIC_RELAXED, __HIP_MEMORY_SCOPE_AGENT); }
__device__ __forceinline__ unsigned xb_add(unsigned* p, unsigned v) { return __hip_atomic_fetch_add(p, v, __ATOMIC_RELAXED, __HIP_MEMORY_SCOPE_AGENT); }
__device__ __forceinline__ unsigned xb_xcc_id() { return (unsigned)__builtin_amdgcn_s_getreg((3 << 11) | 20) & 0xFu; }
#define XB_SPIN(cond, bar) do { unsigned _sp = 0; while (cond) { __builtin_amdgcn_s_sleep(1); \
    if ((++_sp & 255u) == 0u) { if (xb_ld(&(bar)[XB_TMO])) break; if (_sp > XB_SPIN_CAP) { atomicAdd(&(bar)[XB_TMO], 1u); break; } } } } while (0)
struct GridBar {
  unsigned* bar; unsigned x; volatile LAS unsigned* st;
  __device__ __forceinline__ void post(unsigned* b, volatile LAS unsigned* s_) {
    bar = b; x = xb_xcc_id(); st = s_;
    if (threadIdx.x == 0) (void)xb_add(&bar[XB_XCNT(x)], 1u);
  }
  __device__ __forceinline__ void complete(unsigned& nloc, unsigned& nx) const {
    const unsigned G = gridDim.x;
    unsigned sum, cnt, mine, sp = 0u;
    for (;;) {
      sum = 0u; cnt = 0u; mine = 0u;
#pragma unroll
      for (unsigned j = 0; j < 16; ++j) { const unsigned c = xb_ld(&bar[XB_XCNT(j)]); sum += c; cnt += (c > 0u) ? 1u : 0u; mine = (j == x) ? c : mine; }
      if (sum == G) break;
      __builtin_amdgcn_s_sleep(1);
      if ((++sp & 255u) == 0u) { if (xb_ld(&bar[XB_TMO])) break; if (sp > XB_SPIN_CAP) { atomicAdd(&bar[XB_TMO], 1u); break; } }
    }
    nloc = mine > 0u ? mine : 1u; nx = cnt > 0u ? cnt : 1u;
  }
  __device__ __forceinline__ void sync() const {
    asm volatile("s_waitcnt vmcnt(0)" ::: "memory");
    __syncthreads();
    if (threadIdx.x == 0) {
      __builtin_amdgcn_s_waitcnt(0);
      unsigned nloc = st[0], nx = st[1];
      if (nloc == 0u) { complete(nloc, nx); st[0] = nloc; st[1] = nx; }
      const unsigned old = xb_add(&bar[XB_XSUB(x)], 1u);
      const unsigned gen = old / nloc;
      if (old + 1u == (gen + 1u) * nloc) {
        __builtin_amdgcn_fence(__ATOMIC_RELEASE, "agent");
        asm volatile("s_waitcnt vmcnt(0)" ::: "memory");
        const unsigned og = xb_add(&bar[XB_TOP], 1u);
        const unsigned tg = og / nx;
        if (og + 1u == (tg + 1u) * nx) xb_add(&bar[XB_TOPGEN], 1u);
        else XB_SPIN(xb_ld(&bar[XB_TOPGEN]) == tg, bar);
        __builtin_amdgcn_fence(__ATOMIC_ACQUIRE, "agent");
        xb_add(&bar[XB_XGEN(x)], 1u);
        asm volatile("s_waitcnt vmcnt(0)" ::: "memory");
      } else {
        XB_SPIN(xb_ld(&bar[XB_XGEN(x)]) == gen, bar);
        __builtin_amdgcn_fence(__ATOMIC_ACQUIRE, "agent");
        asm volatile("s_waitcnt vmcnt(0)" ::: "memory");
      }
    }
    __syncthreads();
  }
};
#endif

#ifndef EMU
namespace cg = cooperative_groups;
#else
namespace cg = cooperative_groups;
#endif

__global__ void __launch_bounds__(NTHR) mega_kernel(Params p) {
  DECL_SMEM(smem);
  cg::grid_group grid = cg::this_grid();
  const int bid0 = blockIdx.x, nb0 = gridDim.x;
  GridBar gb;
#ifndef EMU
  if (threadIdx.x == 0) { volatile LAS unsigned* w = (volatile LAS unsigned*)(smem + SMEM_STAGE); w[0] = 0u; w[1] = 0u; w[2] = 0u; w[3] = 0u; }
  __syncthreads();
  gb.post((unsigned*)(p.ws + O_BAR), (volatile LAS unsigned*)(smem + SMEM_STAGE));
#endif
#ifndef PROBE_DUP
#define PROBE_DUP 0
#endif
#define STG(gi_, call) do { Params q = p; q.ws = opaque(q.ws); q.out = opaque(q.out); const int bid = opaque_i(bid0); const int nb = opaque_i(nb0); const Grp g = get_grp(opaque_i(gi_)); (void)g; call; } while (0)
#define STP(bit, gi_, call) do { STG(gi_, call); if (PROBE_DUP & (bit)) { STG(gi_, call); } } while (0)
  const bool q_never = (p.ws == nullptr);
  for (int l = 0; l < NL; ++l) {
    STP(1, 0, stage_prep(q, l, bid, nb, smem));
    if (l == 0) gb.sync();
    if (q_never) grid.sync();
    STP(2, 0, stage_h(q, g, l, bid, nb));
    gb.sync();
    for (int gi = 0; gi < NGRP; ++gi) {
      STP(4, gi, stage_g1(q, g, 0, bid, nb, smem)); gb.sync();
      STP(4, gi, stage_g1(q, g, 1, bid, nb, smem));
      STP(8, gi, stage_e1(q, g, l, bid, nb)); gb.sync();
      STP(16, gi, stage_g2(q, g, l, bid, nb, smem)); gb.sync();
      STP(64, gi, stage_mixA(q, g, bid, nb, smem)); gb.sync();
      STP(32, gi, stage_scanS(q, g, l, bid, nb, smem));
      STP(128, gi, stage_dft2(q, g, bid, nb, smem)); gb.sync();
      STP(256, gi, stage_e3(q, g, l, bid, nb)); gb.sync();
      STP(512, gi, stage_proj(q, g, bid, nb, smem)); gb.sync();
      STP(1024, gi, stage_merge(q, g, l, bid, nb, smem)); gb.sync();
      STG(gi, stage_g9(q, g, l, bid, nb, smem));
      if (gi + 1 < NGRP) { STP(2, gi + 1, stage_h(q, g, l, bid, nb)); }
      gb.sync();
    }
  }
  STG(0, stage_final(q, bid, nb));
#undef STP
#undef STG
}

extern "C" void kernel_launch(void* const* d_in, const int* in_sizes, int n_in, void* d_out, int out_size, void* d_ws, size_t ws_size,
                              hipStream_t stream) {
  Params p{};
  const float** pp = (const float**)&p;
  for (int i = 0; i < 35; ++i) pp[i] = (const float*)d_in[i];
  p.out = (float*)d_out; p.ws = (char*)d_ws;
#ifdef EMU
  emu::set_coop(true);
  emu_launch(dim3(8), dim3(NTHR), [=]() { mega_kernel(p); });
  emu::set_coop(false);
#else
  static int grid_blocks = 0;
  if (!grid_blocks) {
    int dev = 0, cus = 0, per_cu = 0;
    (void)hipGetDevice(&dev);
    (void)hipDeviceGetAttribute(&cus, hipDeviceAttributeMultiprocessorCount, dev);
    (void)hipOccupancyMaxActiveBlocksPerMultiprocessor(&per_cu, mega_kernel, NTHR, 0);
    if (per_cu > 1) per_cu = 1;
    if (per_cu < 1) per_cu = 1;
    grid_blocks = cus * per_cu;
  }
  (void)hipMemsetAsync((char*)d_ws + O_BAR, 0, BAR_BYTES, stream);
  void* args[] = {&p};
  (void)hipLaunchCooperativeKernel((void*)mega_kernel, dim3(grid_blocks), dim3(NTHR), args, 0, stream);
#endif
  (void)in_sizes; (void)n_in; (void)out_size; (void)ws_size;
}
```
